# Optimizing an MI355X kernel written in HIP

```python
import jax
import jax.numpy as jnp
from jax import lax
import numpy as np

D_MODEL = 1024
BATCH = 16
SEQ = 2048
DEPTH = 2

CTX_LEN = 256
GRID_W = 64
ROPE_THETA = 10000.0
NORM_EPS = 1e-6

A_HEADS = 8
A_KV_HEADS = 2
A_HEAD_DIM = 64
A_WIDTH = A_HEADS * A_HEAD_DIM
WINDOW = 128
WBLK = 128
B_WIDTH = 512
CONV_W = 3
C_HEADS = 8
C_NOPE = 64
C_ROPE = 32
C_VDIM = 64
C_KV_LORA = 256
C_Q_LORA = 768
C_WIDTH = C_HEADS * C_VDIM
QBLK = 128
M_HEADS = 4
M_QK = 64
M_V = 128
M_WIDTH = M_HEADS * M_V
M_CHUNK = 64

E_GATE = A_WIDTH + B_WIDTH
O_GATE = C_WIDTH + M_WIDTH
E_COLS = (A_KV_HEADS * A_HEAD_DIM, A_KV_HEADS * A_HEAD_DIM,
          A_WIDTH,
          B_WIDTH, B_WIDTH, B_WIDTH,
          E_GATE)
E_CTX_COLS = sum(E_COLS[:2])
E_IN = sum(E_COLS)
O_COLS = (C_KV_LORA, C_ROPE,
          M_HEADS * M_QK, M_WIDTH, 4 * M_HEADS,
          C_Q_LORA,
          M_HEADS * M_QK, M_WIDTH,
          O_GATE)
O_CTX_COLS = sum(O_COLS[:5])
O_IN = sum(O_COLS)
N_EVEN = (DEPTH + 1) // 2
N_ODD = DEPTH // 2

kernel_name = 'hybrid_swa_conv_mla_mlstm_dit'


def split_cols(y, sizes):
    idx = np.cumsum(sizes)[:-1].tolist()
    return jnp.split(y, idx, axis=-1)


def rms_norm(x, w):
    xf = x.astype(jnp.float32)
    y = xf * lax.rsqrt(jnp.mean(xf * xf, axis=-1, keepdims=True) + NORM_EPS)
    return (y * w.astype(jnp.float32)).astype(x.dtype)


def axial_rope(rows, rot_dim):
    row = jnp.repeat(jnp.arange(rows), GRID_W).astype(jnp.float32)
    col = jnp.tile(jnp.arange(GRID_W), rows).astype(jnp.float32)
    n_freq = rot_dim // 4
    inv = ROPE_THETA ** (-jnp.arange(n_freq, dtype=jnp.float32) / n_freq)
    ang = jnp.concatenate([row[:, None] * inv, col[:, None] * inv], axis=-1)
    return jnp.cos(ang), jnp.sin(ang)


def apply_rope(x, cos, sin):
    x1, x2 = jnp.split(x.astype(jnp.float32), 2, axis=-1)
    cs, sn = cos[:, None, :], sin[:, None, :]
    return jnp.concatenate([x1 * cs - x2 * sn, x1 * sn + x2 * cs], axis=-1).astype(x.dtype)


def window_attention_latent(q, k, v, k_c, v_c, sink):
    bsz, n_lat = q.shape[:2]
    n_ctx = k_c.shape[1]
    nb = n_lat // WBLK
    grp = A_HEADS // A_KV_HEADS
    span = WBLK + 2 * WINDOW
    scale = A_HEAD_DIM ** -0.5
    qb = q.reshape(bsz, nb, WBLK, A_KV_HEADS, grp, A_HEAD_DIM)
    start = jnp.arange(nb) * WBLK
    idx = start[:, None] + jnp.arange(span)[None, :]
    pad = ((0, 0), (WINDOW, WINDOW), (0, 0), (0, 0))
    kb = jnp.pad(k, pad)[:, idx]
    vb = jnp.pad(v, pad)[:, idx]
    qpos = start[:, None] + jnp.arange(WBLK)[None, :]
    kpos = (idx - WINDOW)[:, None, :]
    valid = (jnp.abs(kpos - qpos[:, :, None]) <= WINDOW) & (kpos >= 0) & (kpos < n_lat)
    s_win = jnp.einsum('bnqhgd,bnkhd->bnhgqk', qb, kb).astype(jnp.float32) * scale
    s_win = jnp.where(valid[None, :, None, None], s_win, -jnp.inf)
    s_ctx = jnp.einsum('bnqhgd,bkhd->bnhgqk', qb, k_c).astype(jnp.float32) * scale
    s_sink = jnp.broadcast_to(sink.astype(jnp.float32).reshape(A_KV_HEADS, grp, 1, 1), s_ctx.shape[:-1] + (1,))
    p = jax.nn.softmax(jnp.concatenate([s_sink, s_ctx, s_win], axis=-1), axis=-1)
    p_ctx = p[..., 1:1 + n_ctx].astype(v.dtype)
    p_win = p[..., 1 + n_ctx:].astype(v.dtype)
    o = jnp.einsum('bnhgqk,bkhd->bnqhgd', p_ctx, v_c) + jnp.einsum('bnhgqk,bnkhd->bnqhgd', p_win, vb)
    return o.reshape(bsz, n_lat, A_WIDTH)


def context_attention_sink(q_c, k_c, v_c, sink):
    bsz, n_ctx = q_c.shape[:2]
    grp = A_HEADS // A_KV_HEADS
    qg = q_c.reshape(bsz, n_ctx, A_KV_HEADS, grp, A_HEAD_DIM)
    s = jnp.einsum('bqhgd,bkhd->bhgqk', qg, k_c).astype(jnp.float32) * (A_HEAD_DIM ** -0.5)
    s_sink = jnp.broadcast_to(sink.astype(jnp.float32).reshape(A_KV_HEADS, grp, 1, 1), s.shape[:-1] + (1,))
    p = jax.nn.softmax(jnp.concatenate([s_sink, s], axis=-1), axis=-1)[..., 1:].astype(v_c.dtype)
    return jnp.einsum('bhgqk,bkhd->bqhgd', p, v_c).reshape(bsz, n_ctx, A_WIDTH)


def short_conv(u, w):
    n = u.shape[1]
    half = CONV_W // 2
    up = jnp.pad(u, ((0, 0), (half, half), (0, 0)))
    return sum(up[:, j:j + n] * w[j] for j in range(CONV_W))


def even_mixer(h, h_c, w_in, sink, conv_w, w_out, rope, ctx_out):
    bsz, n_lat = h.shape[:2]
    n_ctx = h_c.shape[1]
    ak, av, aq, bb, bc, bx, z = split_cols(h @ w_in, E_COLS)
    if ctx_out:
        parts_c = split_cols(h_c @ w_in, E_COLS)
    else:
        parts_c = split_cols(h_c @ w_in[:, :E_CTX_COLS], E_COLS[:2])
    k_c = parts_c[0].reshape(bsz, n_ctx, A_KV_HEADS, A_HEAD_DIM)
    v_c = parts_c[1].reshape(bsz, n_ctx, A_KV_HEADS, A_HEAD_DIM)
    q = apply_rope(aq.reshape(bsz, n_lat, A_HEADS, A_HEAD_DIM), *rope)
    k = apply_rope(ak.reshape(bsz, n_lat, A_KV_HEADS, A_HEAD_DIM), *rope)
    v = av.reshape(bsz, n_lat, A_KV_HEADS, A_HEAD_DIM)
    a_out = window_attention_latent(q, k, v, k_c, v_c, sink)
    b_out = bb * short_conv(bc * bx, conv_w)
    out = (jnp.concatenate([a_out, b_out], axis=-1) * jax.nn.silu(z)) @ w_out
    if not ctx_out:
        return out, None
    q_c = parts_c[2].reshape(bsz, n_ctx, A_HEADS, A_HEAD_DIM)
    a_c = context_attention_sink(q_c, k_c, v_c, sink)
    b_c = parts_c[3] * short_conv(parts_c[4] * parts_c[5], conv_w)
    out_c = (jnp.concatenate([a_c, b_c], axis=-1) * jax.nn.silu(parts_c[6])) @ w_out
    return out, out_c


def mla_keys_values(ckv, kr, kv_norm_w, w_ukv, rope):
    bsz, n = ckv.shape[:2]
    kv = (rms_norm(ckv, kv_norm_w) @ w_ukv).reshape(bsz, n, C_HEADS, C_NOPE + C_VDIM)
    k_nope, v = jnp.split(kv, [C_NOPE], axis=-1)
    kr = kr.reshape(bsz, n, 1, C_ROPE)
    if rope is not None:
        kr = apply_rope(kr, *rope)
    k = jnp.concatenate([k_nope, jnp.broadcast_to(kr, (bsz, n, C_HEADS, C_ROPE))], axis=-1)
    return k, v


def mla_queries(cq, q_norm_w, w_uq, rope):
    bsz, n = cq.shape[:2]
    q = (rms_norm(cq, q_norm_w) @ w_uq).reshape(bsz, n, C_HEADS, C_NOPE + C_ROPE)
    q_nope, q_rope = jnp.split(q, [C_NOPE], axis=-1)
    if rope is not None:
        q_rope = apply_rope(q_rope, *rope)
    return jnp.concatenate([q_nope, q_rope], axis=-1)


def dense_attention_blocks(q, k, v):
    bsz, n_q, nh, dqk = q.shape
    nb = n_q // QBLK
    scale = dqk ** -0.5
    qb = jnp.moveaxis(q.reshape(bsz, nb, QBLK, nh, dqk), 1, 0)

    def one_block(qi):
        s = jnp.einsum('bqhd,bkhd->bhqk', qi, k).astype(jnp.float32) * scale
        p = jax.nn.softmax(s, axis=-1).astype(v.dtype)
        return jnp.einsum('bhqk,bkhd->bqhd', p, v)

    o = lax.map(one_block, qb)
    return jnp.moveaxis(o, 0, 1).reshape(bsz, n_q, nh * v.shape[-1])


def mlstm_chunkwise(q, k, v, log_i, log_f, state, need_h):
    bsz, nh, n, dk = k.shape
    dv = v.shape[-1]
    nc = n // M_CHUNK
    kc = k.reshape(bsz, nh, nc, M_CHUNK, dk)
    vc = v.reshape(bsz, nh, nc, M_CHUNK, dv)
    ic = log_i.reshape(bsz, nh, nc, M_CHUNK)
    b = jnp.cumsum(log_f.reshape(bsz, nh, nc, M_CHUNK), axis=-1)
    g = b[..., -1]
    a = g[..., None] - b + ic
    m_loc = jnp.max(a, axis=-1)
    w = jnp.exp(a - m_loc[..., None])
    c_loc = jnp.einsum('bhcs,bhcsv,bhcsk->bhcvk', w, vc, kc)
    n_loc = jnp.einsum('bhcs,bhcsk->bhck', w, kc)

    def step(carry, inp):
        c_prev, n_prev, m_prev = carry
        g_c, m_l, c_l, n_l = inp
        m_new = jnp.maximum(g_c + m_prev, m_l)
        a_prev = jnp.exp(g_c + m_prev - m_new)
        a_loc = jnp.exp(m_l - m_new)
        c_new = a_prev[..., None, None] * c_prev + a_loc[..., None, None] * c_l
        n_new = a_prev[..., None] * n_prev + a_loc[..., None] * n_l
        return (c_new, n_new, m_new), (c_prev, n_prev, m_prev)

    xs = tuple(jnp.moveaxis(t, 2, 0) for t in (g, m_loc, c_loc, n_loc))
    final, entering = lax.scan(step, state, xs)
    if not need_h:
        return None, final
    c_in, n_in, m_in = (jnp.moveaxis(t, 0, 2) for t in entering)
    qc = q.reshape(bsz, nh, nc, M_CHUNK, dk)
    causal = jnp.tril(jnp.ones((M_CHUNK, M_CHUNK), dtype=bool))
    dmat = jnp.where(causal, b[..., :, None] - b[..., None, :] + ic[..., None, :], -jnp.inf)
    inter = b + m_in[..., None]
    m_t = jnp.maximum(inter, jnp.max(dmat, axis=-1))
    sc = jnp.einsum('bhctk,bhcsk->bhcts', qc, kc) * jnp.exp(dmat - m_t[..., None])
    w_inter = jnp.exp(inter - m_t)
    num = w_inter[..., None] * jnp.einsum('bhcvk,bhctk->bhctv', c_in, qc) + jnp.einsum('bhcts,bhcsv->bhctv', sc, vc)
    den = w_inter * jnp.einsum('bhck,bhctk->bhct', n_in, qc) + jnp.sum(sc, axis=-1)
    h = num / jnp.maximum(jnp.abs(den), jnp.exp(-m_t))[..., None]
    return h.reshape(bsz, nh, n, dv), final


def mlstm_direction(q, k, v, gate_pre, i_bias, f_bias, state, need_h, reverse):
    heads_first = lambda a: jnp.moveaxis(a, 2, 1).astype(jnp.float32)
    kh = heads_first(k) * (M_QK ** -0.5)
    vh = heads_first(v)
    log_i = heads_first(gate_pre[:, :, 0] + i_bias)
    log_f = jax.nn.log_sigmoid(heads_first(gate_pre[:, :, 1] + f_bias))
    qh = heads_first(q) if q is not None else None
    if reverse:
        kh, vh, log_i, log_f = (jnp.flip(t, 2) for t in (kh, vh, log_i, log_f))
        qh = jnp.flip(qh, 2) if qh is not None else None
    h, final = mlstm_chunkwise(qh, kh, vh, log_i, log_f, state, need_h)
    if h is not None and reverse:
        h = jnp.flip(h, 2)
    return h, final


def mlstm_readout(h_sum, o_pre, head_norm_w):
    bsz, nh, n, dv = h_sum.shape
    hs = rms_norm(jnp.moveaxis(h_sum, 1, 2), head_norm_w.reshape(M_HEADS, M_V)).reshape(bsz, n, M_WIDTH)
    return (jax.nn.sigmoid(o_pre.astype(jnp.float32)) * hs).astype(o_pre.dtype)


def odd_mixer(h, h_c, w_in, q_norm_w, kv_norm_w, w_uq, w_ukv, i_bias, f_bias, head_norm_w, w_out, rope, ctx_out):
    bsz, n_lat = h.shape[:2]
    n_ctx = h_c.shape[1]
    ckv, kr, mk, mv, mg, cq, mq, mo, z = split_cols(h @ w_in, O_COLS)
    if ctx_out:
        parts_c = split_cols(h_c @ w_in, O_COLS)
    else:
        parts_c = split_cols(h_c @ w_in[:, :O_CTX_COLS], O_COLS[:5])
    ckv_c, kr_c, mk_c, mv_c, mg_c = parts_c[:5]
    k_c, v_c = mla_keys_values(ckv_c, kr_c, kv_norm_w, w_ukv, None)
    k_x, v_x = mla_keys_values(ckv, kr, kv_norm_w, w_ukv, rope)
    q_x = mla_queries(cq, q_norm_w, w_uq, rope)
    c_out = dense_attention_blocks(q_x, jnp.concatenate([k_c, k_x], axis=1), jnp.concatenate([v_c, v_x], axis=1))
    heads = lambda a, n, dim: a.reshape(bsz, n, M_HEADS, dim)
    gates = lambda a, n: a.reshape(bsz, n, 2, 2, M_HEADS)
    qm, km, vm, gm = heads(mq, n_lat, M_QK), heads(mk, n_lat, M_QK), heads(mv, n_lat, M_V), gates(mg, n_lat)
    qm_c = heads(parts_c[6], n_ctx, M_QK) if ctx_out else None
    km_c, vm_c, gm_c = heads(mk_c, n_ctx, M_QK), heads(mv_c, n_ctx, M_V), gates(mg_c, n_ctx)
    zero = (jnp.zeros((bsz, M_HEADS, M_V, M_QK), jnp.float32),
            jnp.zeros((bsz, M_HEADS, M_QK), jnp.float32),
            jnp.zeros((bsz, M_HEADS), jnp.float32))
    h_lat, h_ctx = [], []
    for d in range(2):
        hc_d, st_d = mlstm_direction(qm_c, km_c, vm_c, gm_c[:, :, d], i_bias[d], f_bias[d], zero, ctx_out, d == 1)
        hx_d, _ = mlstm_direction(qm, km, vm, gm[:, :, d], i_bias[d], f_bias[d], st_d, True, d == 1)
        h_lat.append(hx_d)
        h_ctx.append(hc_d)
    m_out = mlstm_readout(h_lat[0] + h_lat[1], mo, head_norm_w)
    out = (jnp.concatenate([c_out, m_out], axis=-1) * jax.nn.silu(z)) @ w_out
    if not ctx_out:
        return out, None
    q_c = mla_queries(parts_c[5], q_norm_w, w_uq, None)
    c_out_c = dense_attention_blocks(q_c, k_c, v_c)
    m_out_c = mlstm_readout(h_ctx[0] + h_ctx[1], parts_c[7], head_norm_w)
    out_c = (jnp.concatenate([c_out_c, m_out_c], axis=-1) * jax.nn.silu(parts_c[8])) @ w_out
    return out, out_c


def setup_inputs(seed: int = 0) -> dict:
    key = jax.random.key(seed)
    ks = jax.random.split(key, 24)
    nrm = lambda k, shape, s: jax.random.normal(k, shape, jnp.float32) * s
    d = D_MODEL
    return {
        'x': nrm(ks[0], (BATCH, SEQ, d), 1.0),
        'c': nrm(ks[1], (BATCH, d), 1.0),
        'ctx': nrm(ks[2], (BATCH, CTX_LEN, d), 1.0),
        'c_ctx': nrm(ks[3], (d,), 1.0),
        'mod_w': nrm(ks[4], (DEPTH, d, 3 * d), 0.5 * d ** -0.5),
        'mod_b': nrm(ks[5], (DEPTH, 3 * d), 0.02),
        'pre_norm_w': 1.0 + nrm(ks[6], (DEPTH, d), 0.05),
        'post_norm_w': 1.0 + nrm(ks[7], (DEPTH, d), 0.05),
        'e_w_in': nrm(ks[8], (N_EVEN, d, E_IN), d ** -0.5),
        'e_sink': nrm(ks[9], (N_EVEN, A_HEADS), 0.5),
        'e_conv_w': nrm(ks[10], (N_EVEN, CONV_W, B_WIDTH), CONV_W ** -0.5),
        'e_w_out': nrm(ks[11], (N_EVEN, E_GATE, d), E_GATE ** -0.5),
        'o_w_in': nrm(ks[12], (N_ODD, d, O_IN), d ** -0.5),
        'o_q_norm_w': 1.0 + nrm(ks[13], (N_ODD, C_Q_LORA), 0.05),
        'o_kv_norm_w': 1.0 + nrm(ks[14], (N_ODD, C_KV_LORA), 0.05),
        'o_w_uq': nrm(ks[15], (N_ODD, C_Q_LORA, C_HEADS * (C_NOPE + C_ROPE)), C_Q_LORA ** -0.5),
        'o_w_ukv': nrm(ks[16], (N_ODD, C_KV_LORA, C_HEADS * (C_NOPE + C_VDIM)), C_KV_LORA ** -0.5),
        'o_i_bias': nrm(ks[17], (N_ODD, 2, M_HEADS), 0.1),
        'o_f_bias': jnp.linspace(3.0, 6.0, M_HEADS, dtype=jnp.float32) + nrm(ks[18], (N_ODD, 2, M_HEADS), 0.1),
        'o_head_norm_w': 1.0 + nrm(ks[19], (N_ODD, M_WIDTH), 0.05),
        'o_w_out': nrm(ks[20], (N_ODD, O_GATE, d), O_GATE ** -0.5),
    }


def reference(x, c, ctx, c_ctx, mod_w, mod_b, pre_norm_w, post_norm_w, e_w_in, e_sink, e_conv_w, e_w_out,
              o_w_in, o_q_norm_w, o_kv_norm_w, o_w_uq, o_w_ukv, o_i_bias, o_f_bias, o_head_norm_w, o_w_out):
    n_lat = x.shape[1]
    ROWS = n_lat // GRID_W
    rope_a = axial_rope(ROWS, A_HEAD_DIM)
    rope_c = axial_rope(ROWS, C_ROPE)
    for layer in range(DEPTH):
        ctx_out = layer < DEPTH - 1
        mod_x = jax.nn.silu(c) @ mod_w[layer] + mod_b[layer]
        mod_c = jax.nn.silu(c_ctx) @ mod_w[layer] + mod_b[layer]
        sh_x, sc_x, g_x = (m[:, None, :] for m in jnp.split(mod_x, 3, axis=-1))
        sh_c, sc_c, g_c = jnp.split(mod_c, 3, axis=-1)
        h = rms_norm(x, pre_norm_w[layer]) * (1.0 + sc_x) + sh_x
        h_c = rms_norm(ctx, pre_norm_w[layer]) * (1.0 + sc_c) + sh_c
        j = layer // 2
        if layer % 2 == 0:
            y, y_c = even_mixer(h, h_c, e_w_in[j], e_sink[j], e_conv_w[j], e_w_out[j], rope_a, ctx_out)
        else:
            y, y_c = odd_mixer(h, h_c, o_w_in[j], o_q_norm_w[j], o_kv_norm_w[j], o_w_uq[j], o_w_ukv[j],
                               o_i_bias[j], o_f_bias[j], o_head_norm_w[j], o_w_out[j], rope_c, ctx_out)
        x = x + g_x * rms_norm(y, post_norm_w[layer])
        if ctx_out:
            ctx = ctx + g_c * rms_norm(y_c, post_norm_w[layer])
    return x
```

```cpp
#include <hip/hip_runtime.h>
#include <cstdio>
#include <cstdint>

#define LAS __attribute__((address_space(3)))
#define GAS __attribute__((address_space(1)))
typedef unsigned short bf16_t;
typedef short bf16x8 __attribute__((ext_vector_type(8)));
typedef short s16x4 __attribute__((ext_vector_type(4)));
typedef float f32x4 __attribute__((ext_vector_type(4)));
typedef float f32x16 __attribute__((ext_vector_type(16)));
typedef unsigned u32x4 __attribute__((ext_vector_type(4)));
typedef unsigned u32x2 __attribute__((ext_vector_type(2)));
typedef float f32x2_t __attribute__((ext_vector_type(2)));
typedef __bf16 bf16x2_t __attribute__((ext_vector_type(2)));

constexpr int NB = 16, SEQ = 2048, DM = 1024, CL = 256;
constexpr int ML = NB * SEQ, MC = NB * CL, MT = ML + MC;
constexpr float EPS = 1e-6f, LOG2E = 1.4426950408889634f;
constexpr int E_N = 3328, O_NSRC = 3632, O_N = 3840;
constexpr int NWAVES = 8, NTHREADS = 512;

__device__ __forceinline__ float bf_lo(unsigned w) { return __uint_as_float(w << 16); }
__device__ __forceinline__ float bf_hi(unsigned w) { return __uint_as_float(w & 0xffff0000u); }
__device__ __forceinline__ unsigned pk2(float lo, float hi) { f32x2_t v = {lo, hi}; bf16x2_t b = __builtin_convertvector(v, bf16x2_t); return __builtin_bit_cast(unsigned, b); }
__device__ __forceinline__ float silu_f(float x) { return x * __builtin_amdgcn_rcpf(1.f + __expf(-x)); }
__device__ __forceinline__ float sigmoid_f(float x) { return __builtin_amdgcn_rcpf(1.f + __expf(-x)); }
__device__ __forceinline__ float wave_sum(float v) {
#pragma unroll
    for (int o = 1; o < 64; o <<= 1) v += __shfl_xor(v, o);
    return v;
}
#define LDS_WAIT() asm volatile("s_waitcnt lgkmcnt(0)" ::: "memory")
#define VM_WAIT() asm volatile("s_waitcnt vmcnt(0)" ::: "memory")

__device__ __forceinline__ int my_tid() { int t = threadIdx.x; asm volatile("" : "+v"(t)); return t; }

namespace pg8 {
#define PG8_LAS __attribute__((address_space(3)))
typedef unsigned short bf16_t;
typedef short bf16x8 __attribute__((ext_vector_type(8)));
typedef float f32x4 __attribute__((ext_vector_type(4)));
typedef unsigned u32x4 __attribute__((ext_vector_type(4)));
constexpr int BM = 256, BK = 64, HALF = 128, HTB = HALF * BK * 2  , STAGE_BYTES = 8 * HTB, NXCD = 8, WGM = 8;

__host__ __device__ __forceinline__ int lds_byte(int r, int c) { const int st = (r >> 4) * 2 + (c >> 5), rr = r & 15, cc = c & 31, ob = rr * 64 + cc * 2; return st * 1024 + (ob ^ (((ob >> 9) & 1) << 5)); }
__host__ __device__ __forceinline__ void stage_rc(int b, int& R, int& C) { const int st = b / 1024, sb = b % 1024, swz = sb ^ (((sb >> 9) & 1) << 5); R = (st >> 1) * 16 + swz / 64; C = (st & 1) * 32 + (swz % 64) / 2; }
__host__ __device__ __forceinline__ int perm32(int rho) { const int n = rho >> 4, i = rho & 15; return 8 * (i >> 2) + 4 * n + (i & 3); }

struct Unit { int pm, pn; };
struct Gemm { const bf16_t* A; const bf16_t* Bt; int M, N, K; };

struct RectOrder {
    int nM0, nN0, n0, pm1, nM1, nN1, n1, G, c;
    __device__ __forceinline__ void init(int nM0_, int nN0_, int pm1_, int nM1_, int nN1_, int G_, int c_) { nM0 = nM0_; nN0 = nN0_; n0 = nM0_ * nN0_; pm1 = pm1_; nM1 = nM1_; nN1 = nN1_; n1 = nM1_ * nN1_; G = G_; c = c_; }
    __device__ __forceinline__ static void rect(int w, int nM, int nN, int& pm, int& pn) {
        const int nig = WGM * nN, gid = w / nig, fm = gid * WGM, gsz = (nM - fm) < WGM ? (nM - fm) : WGM;
        pm = fm + ((w % nig) % gsz); pn = (w % nig) / gsz;
    }
    __device__ __forceinline__ bool next(int i, Unit& u) const {
        const int nwg = n0 + n1; const long L = (long)i * G + c; if (L >= nwg) return false;
        int wgid = (int)L; { const int q = nwg / NXCD, r = nwg % NXCD, xcd = wgid % NXCD, off = wgid / NXCD; wgid = (xcd < r ? xcd * (q + 1) : r * (q + 1) + (xcd - r) * q) + off; }
        if (wgid < n0) rect(wgid, nM0, nN0, u.pm, u.pn); else { rect(wgid - n0, nM1, nN1, u.pm, u.pn); u.pm += pm1; }
        return true;
    }
    __device__ __forceinline__ void a_ready(const Unit&) const {}
    __device__ __forceinline__ void done(const Unit&) const {}
};

template <class Epi, class Sched, bool ALIGN_EPI = false, bool SP2 = false>
__device__ __forceinline__ void gemm_phase(PG8_LAS unsigned char* lds, const Gemm g, const Sched& S, const Epi& E) {
    const int tid = my_tid(), wid = __builtin_amdgcn_readfirstlane(tid >> 6), lane = tid & 63, wr = wid >> 2, wc = wid & 3, fr = lane & 15, fq = lane >> 4;
    const int K = g.K, nt = K / BK;
    unsigned voffA[2], voffB[2];
#pragma unroll
    for (int i = 0; i < 2; ++i) { int R, C; stage_rc(tid * 16 + i * 8192, R, C); const int Rb = Epi::PERM ? ((R & ~31) + perm32(R & 31)) : R;
        voffA[i] = (unsigned)(R * K + C) * 2u; voffB[i] = (unsigned)(Rb * K + C) * 2u; }
    const size_t kstep = (size_t)(BK * 2);
    const size_t hstep = (size_t)HALF * K * 2;
    const size_t tstep = 2 * hstep;
    const unsigned ldsw = (unsigned)wid * 1024u;
    const int aoff = lds_byte(wr * 64 + fr, fq * 8), boff = lds_byte(wc * 32 + fr, fq * 8);
#define PG8_SA(b, h) (((b) * 2 + (h)) * HTB)
#define PG8_SB(b, h) ((4 + (b) * 2 + (h)) * HTB)
#define PG8_STAGE(bufoff, gbase, voff) do { _Pragma("unroll") for (int _i = 0; _i < 2; ++_i) \
        __builtin_amdgcn_global_load_lds((const unsigned*)((const char*)(gbase) + (voff)[_i]), (PG8_LAS unsigned*)(lds + (bufoff) + ldsw + _i * 8192), 16, 0, 0); } while (0)
#define PG8_LDA(dst, b, h) do { _Pragma("unroll") for (int m = 0; m < 4; ++m) _Pragma("unroll") for (int k = 0; k < 2; ++k) dst[m][k] = *(const PG8_LAS bf16x8*)(lds + PG8_SA(b, h) + aoff + m * 2048 + k * 1024); } while (0)
#define PG8_LDB(dst, b, h) do { _Pragma("unroll") for (int n = 0; n < 2; ++n) _Pragma("unroll") for (int k = 0; k < 2; ++k) dst[n][k] = *(const PG8_LAS bf16x8*)(lds + PG8_SB(b, h) + boff + n * 2048 + k * 1024); } while (0)
#define PG8_MMA(ai, bj, At, Bt) do { __builtin_amdgcn_s_setprio(1); _Pragma("unroll") for (int m = 0; m < 4; ++m) _Pragma("unroll") for (int n = 0; n < 2; ++n) _Pragma("unroll") for (int k = 0; k < 2; ++k) \
        acc[ai][bj][m][n] = __builtin_amdgcn_mfma_f32_16x16x32_bf16(Bt[n][k], At[m][k], acc[ai][bj][m][n], 0, 0, 0); __builtin_amdgcn_s_setprio(0); } while (0)
#define PG8_WAIT_V(n) asm volatile("s_waitcnt vmcnt(" #n ")" ::: "memory")
#define PG8_WAIT_L(n) asm volatile("s_waitcnt lgkmcnt(" #n ")" ::: "memory")
#define PG8_BAR __builtin_amdgcn_s_barrier()
#define PG8_SCHED __builtin_amdgcn_sched_barrier(0)
    Unit cur, nxt; int ui = 0;
    if (!S.next(0, cur)) return;
    f32x4 acc[2][2][4][2];
#pragma unroll
    for (int a = 0; a < 2; ++a)
#pragma unroll
        for (int b = 0; b < 2; ++b)
#pragma unroll
            for (int m = 0; m < 4; ++m)
#pragma unroll
                for (int n = 0; n < 2; ++n) acc[a][b][m][n] = (f32x4){0.f, 0.f, 0.f, 0.f};
    bf16x8 At[4][2], B0[2][2], B1[2][2];
    const char* cA = (const char*)g.A + (size_t)cur.pm * tstep; const char* cB = (const char*)g.Bt + (size_t)cur.pn * tstep;
    S.a_ready(cur);
    if constexpr (SP2) {
        PG8_STAGE(PG8_SB(0, 0), cB, voffB); PG8_STAGE(PG8_SB(0, 1), cB + hstep, voffB); PG8_STAGE(PG8_SA(0, 0), cA, voffA); PG8_STAGE(PG8_SA(0, 1), cA + hstep, voffA);
        if (wr == 1) PG8_BAR;
        PG8_WAIT_V(2); PG8_BAR;
        PG8_STAGE(PG8_SB(1, 0), cB + kstep, voffB); PG8_STAGE(PG8_SA(1, 0), cA + kstep, voffA); PG8_STAGE(PG8_SB(1, 1), cB + hstep + kstep, voffB);
        PG8_WAIT_V(6); PG8_BAR;
    } else {
        PG8_STAGE(PG8_SB(0, 0), cB, voffB); PG8_STAGE(PG8_SA(0, 0), cA, voffA); PG8_STAGE(PG8_SB(0, 1), cB + hstep, voffB); PG8_STAGE(PG8_SA(0, 1), cA + hstep, voffA);
        if (wr == 1) PG8_BAR;
        PG8_WAIT_V(4); PG8_BAR;
        PG8_STAGE(PG8_SB(1, 0), cB + kstep, voffB); PG8_STAGE(PG8_SA(1, 0), cA + kstep, voffA); PG8_STAGE(PG8_SB(1, 1), cB + hstep + kstep, voffB);
        PG8_WAIT_V(6); PG8_BAR;
    }
    for (;;) {
        const bool has_next = S.next(ui + 1, nxt);
        const char* nA = has_next ? (const char*)g.A + (size_t)nxt.pm * tstep : cA; const char* nB = has_next ? (const char*)g.Bt + (size_t)nxt.pn * tstep : cB;
        for (int t = 0; t < nt; t += 2) {
            const bool last = (t == nt - 2);
            const char* a1 = cA + (size_t)(t + 1) * kstep;
            const char* a2 = last ? nA : cA + (size_t)(t + 2) * kstep; const char* b2 = last ? nB : cB + (size_t)(t + 2) * kstep;
            const char* a3 = a2 + kstep; const char* b3 = b2 + kstep;
            if (last && has_next) S.a_ready(nxt);
            if constexpr (SP2) {
            PG8_LDB(B0, 0, 0); PG8_LDB(B1, 0, 1); PG8_SCHED; PG8_LDA(At, 0, 0); PG8_STAGE(PG8_SA(1, 1), a1 + hstep, voffA);
            PG8_WAIT_V(8); PG8_WAIT_L(0); PG8_BAR; PG8_MMA(0, 0, At, B0); PG8_MMA(0, 1, At, B1); PG8_BAR; PG8_SCHED;
            PG8_LDA(At, 0, 1); PG8_STAGE(PG8_SB(0, 0), b2, voffB); PG8_STAGE(PG8_SB(0, 1), b2 + hstep, voffB); PG8_STAGE(PG8_SA(0, 0), a2, voffA);
            PG8_WAIT_V(8); PG8_WAIT_L(0); PG8_BAR; PG8_MMA(1, 0, At, B0); PG8_MMA(1, 1, At, B1); PG8_BAR; PG8_SCHED;
            PG8_LDB(B0, 1, 0); PG8_LDB(B1, 1, 1); PG8_SCHED; PG8_LDA(At, 1, 0); PG8_STAGE(PG8_SA(0, 1), a2 + hstep, voffA);
            PG8_WAIT_V(8); PG8_WAIT_L(0); PG8_BAR; PG8_MMA(0, 0, At, B0); PG8_MMA(0, 1, At, B1); PG8_BAR; PG8_SCHED;
            PG8_LDA(At, 1, 1); PG8_STAGE(PG8_SB(1, 0), b3, voffB); PG8_STAGE(PG8_SB(1, 1), b3 + hstep, voffB); PG8_STAGE(PG8_SA(1, 0), a3, voffA);
            PG8_WAIT_V(8); PG8_WAIT_L(0); PG8_BAR; PG8_MMA(1, 0, At, B0); PG8_MMA(1, 1, At, B1); PG8_BAR; PG8_SCHED;
            } else {
            PG8_LDB(B0, 0, 0); PG8_SCHED; PG8_LDA(At, 0, 0); PG8_STAGE(PG8_SA(1, 1), a1 + hstep, voffA);
            PG8_WAIT_L(8); PG8_BAR; PG8_WAIT_L(0); PG8_MMA(0, 0, At, B0); PG8_BAR; PG8_SCHED;
            PG8_LDB(B1, 0, 1); PG8_STAGE(PG8_SB(0, 0), b2, voffB);
            PG8_BAR; PG8_WAIT_L(0); PG8_MMA(0, 1, At, B1); PG8_BAR;
            PG8_LDA(At, 0, 1); PG8_STAGE(PG8_SA(0, 0), a2, voffA);
            PG8_BAR; PG8_WAIT_L(0); PG8_MMA(1, 0, At, B0); PG8_BAR; PG8_SCHED;
            PG8_STAGE(PG8_SB(0, 1), b2 + hstep, voffB);
            PG8_WAIT_V(6); PG8_BAR; PG8_MMA(1, 1, At, B1); PG8_BAR;
            PG8_LDB(B0, 1, 0); PG8_SCHED; PG8_LDA(At, 1, 0); PG8_STAGE(PG8_SA(0, 1), a2 + hstep, voffA);
            PG8_WAIT_L(8); PG8_BAR; PG8_WAIT_L(0); PG8_MMA(0, 0, At, B0); PG8_BAR; PG8_SCHED;
            PG8_LDB(B1, 1, 1); PG8_STAGE(PG8_SB(1, 0), b3, voffB);
            PG8_BAR; PG8_WAIT_L(0); PG8_MMA(0, 1, At, B1); PG8_BAR;
            PG8_LDA(At, 1, 1); PG8_STAGE(PG8_SA(1, 0), a3, voffA);
            PG8_BAR; PG8_WAIT_L(0); PG8_MMA(1, 0, At, B0); PG8_BAR; PG8_SCHED;
            PG8_STAGE(PG8_SB(1, 1), b3 + hstep, voffB);
            PG8_WAIT_V(6); PG8_BAR; PG8_MMA(1, 1, At, B1); PG8_BAR;
            }
        }
        if constexpr (ALIGN_EPI) { if (wr == 0) PG8_BAR; }
        if constexpr (!Epi::AFTER_DRAIN) { E(acc, cur, wr, wc, fr, fq); S.done(cur); }
        if (!has_next) break;
#pragma unroll
        for (int a = 0; a < 2; ++a)
#pragma unroll
            for (int b = 0; b < 2; ++b)
#pragma unroll
                for (int m = 0; m < 4; ++m)
#pragma unroll
                    for (int n = 0; n < 2; ++n) acc[a][b][m][n] = (f32x4){0.f, 0.f, 0.f, 0.f};
        cur = nxt; cA = nA; cB = nB; ++ui;
        if constexpr (ALIGN_EPI) { if (wr == 1) PG8_BAR; }
    }
    PG8_WAIT_V(0);
    if constexpr (!ALIGN_EPI) { if (wr == 0) PG8_BAR; }
    PG8_BAR;
    if constexpr (Epi::AFTER_DRAIN) { E.fused(acc, cur, wr, wc, fr, fq, lds, wid, lane); S.done(cur); }
#undef PG8_SA
#undef PG8_SB
#undef PG8_STAGE
#undef PG8_LDA
#undef PG8_LDB
#undef PG8_MMA
#undef PG8_WAIT_V
#undef PG8_WAIT_L
#undef PG8_BAR
#undef PG8_SCHED
}
}

constexpr size_t MiB = 1u << 20;
constexpr size_t WS_CTL = 0, CTL_ZERO_BYTES = 1 * MiB;
constexpr size_t WS_MOD = 1 * MiB;
constexpr size_t WS_ROPEA = 2 * MiB;
constexpr size_t WS_ROPEC = 2 * MiB + 512 * 1024;
constexpr size_t WS_WEIN = 3 * MiB, WS_WEOUT = 10 * MiB, WS_WOIN = 12 * MiB, WS_WUQ = 20 * MiB, WS_WUKV = 21 * MiB + 512 * 1024, WS_WOOUT = 22 * MiB;
constexpr size_t WS_H = 24 * MiB;
constexpr size_t WS_U = 96 * MiB;
constexpr size_t WS_Y = 168 * MiB;
constexpr size_t WS_R = 240 * MiB;
constexpr size_t WS_KVE = WS_R  , WS_QE = WS_R + 18 * MiB, WS_PE = WS_R + 54 * MiB, WS_GE = WS_R + 90 * MiB, WS_ZA = WS_R + 126 * MiB, WS_SSQY0 = WS_R + 162 * MiB;
constexpr size_t WS_CKV = WS_R, WS_CQ = WS_R + 18 * MiB, WS_HM = WS_R  , WS_MK = WS_R + 66 * MiB, WS_MV = WS_R + 84 * MiB, WS_KR = WS_R + 120 * MiB, WS_GATES = WS_R + 123 * MiB,
                 WS_SSQCKV = WS_R + 126 * MiB, WS_SSQCQ = WS_R + 127 * MiB, WS_MQ = WS_R + 129 * MiB, WS_MO = WS_R + 145 * MiB, WS_ZO = WS_R + 177 * MiB, WS_SSQY1 = WS_R + 241 * MiB;
constexpr size_t WS_KNV = WS_H  , WS_QO = WS_Y;
constexpr size_t WS_END = WS_R + 244 * MiB;
static_assert(WS_SSQY0 + (size_t)MT * 16 * 4 <= WS_R + 165 * MiB && WS_HM + (size_t)2 * ML * 512 * 2 <= WS_MK && WS_SSQY1 + (size_t)MT * 16 * 4 <= WS_END, "ws map");

__device__ __forceinline__ void st8(bf16_t* p, f32x4 a, f32x4 b) { u32x4 w; w.x = pk2(a[0], a[1]); w.y = pk2(a[2], a[3]); w.z = pk2(b[0], b[1]); w.w = pk2(b[2], b[3]); *(u32x4*)p = w; }
__device__ __forceinline__ bf16_t f2bf(float v) { return (bf16_t)(pk2(v, 0.f) & 0xffffu); }
__device__ __forceinline__ void rope8(f32x4& a, f32x4& b, const float* cosp, const float* sinp) {
    const f32x4 cs = *(const f32x4*)cosp, sn = *(const f32x4*)sinp;
    const float a0 = a[0] * cs[0] - a[1] * sn[0], a1 = a[0] * sn[0] + a[1] * cs[0], a2 = a[2] * cs[1] - a[3] * sn[1], a3 = a[2] * sn[1] + a[3] * cs[1];
    const float b0 = b[0] * cs[2] - b[1] * sn[2], b1 = b[0] * sn[2] + b[1] * cs[2], b2 = b[2] * cs[3] - b[3] * sn[3], b3 = b[2] * sn[3] + b[3] * cs[3];
    a = (f32x4){a0, a1, a2, a3}; b = (f32x4){b0, b1, b2, b3};
}
__device__ __forceinline__ f32x4 silu4(f32x4 v) { return (f32x4){silu_f(v[0]), silu_f(v[1]), silu_f(v[2]), silu_f(v[3])}; }
__device__ __forceinline__ f32x4 sigm4(f32x4 v) { return (f32x4){sigmoid_f(v[0]), sigmoid_f(v[1]), sigmoid_f(v[2]), sigmoid_f(v[3])}; }
__device__ __forceinline__ float sq4(f32x4 v) { return (v[0] * v[0] + v[1] * v[1]) + (v[2] * v[2] + v[3] * v[3]); }

struct EpiEin {
    static constexpr bool PERM = true, AFTER_DRAIN = false;
    unsigned char* ws;
    __device__ __forceinline__ void operator()(const f32x4 (&acc)[2][2][4][2], const pg8::Unit& u, int wr, int wc, int fr, int fq) const {
        const int pn = u.pn, rbase = u.pm * 256 + wr * 64 + fr, cw = wc * 32 + 8 * fq;
        const float* ropeA = (const float*)(ws + WS_ROPEA);
#pragma unroll
        for (int ai = 0; ai < 2; ++ai)
#pragma unroll
            for (int m = 0; m < 4; ++m) {
                asm volatile("" ::: "memory"); const int R = rbase + ai * 128 + m * 16; const bool lat = R < ML; const int pos = R & 2047;
                if (pn == 0) {
                    f32x4 a = acc[ai][0][m][0], b = acc[ai][0][m][1];
                    if (lat) { const int i0 = (cw & 63) >> 1; rope8(a, b, ropeA + pos * 64 + i0, ropeA + pos * 64 + 32 + i0); }
                    st8((bf16_t*)(ws + WS_KVE) + (size_t)R * 256 + cw, a, b);
                    st8((bf16_t*)(ws + WS_KVE) + (size_t)R * 256 + 128 + cw, acc[ai][1][m][0], acc[ai][1][m][1]);
                } else if (pn <= 2) {
#pragma unroll
                    for (int bj = 0; bj < 2; ++bj) {
                        f32x4 a = acc[ai][bj][m][0], b = acc[ai][bj][m][1];
                        if (lat) { const int i0 = (cw & 63) >> 1; rope8(a, b, ropeA + pos * 64 + i0, ropeA + pos * 64 + 32 + i0); }
                        const float sc = 0.125f * LOG2E; a = a * sc; b = b * sc;
                        st8((bf16_t*)(ws + WS_QE) + (size_t)R * 512 + (pn - 1) * 256 + bj * 128 + cw, a, b);
                    }
                } else if (pn <= 6) {
                    st8((bf16_t*)(ws + WS_PE) + (size_t)R * 512 + (pn - 3) * 128 + cw, acc[ai][0][m][0] * acc[ai][1][m][0], acc[ai][0][m][1] * acc[ai][1][m][1]);
                } else if (pn <= 10) {
                    st8((bf16_t*)(ws + WS_GE) + (size_t)R * 512 + (pn - 7) * 128 + cw, acc[ai][0][m][0] * silu4(acc[ai][1][m][0]), acc[ai][0][m][1] * silu4(acc[ai][1][m][1]));
                } else {
#pragma unroll
                    for (int bj = 0; bj < 2; ++bj)
                        st8((bf16_t*)(ws + WS_ZA) + (size_t)R * 512 + (pn - 11) * 256 + bj * 128 + cw, silu4(acc[ai][bj][m][0]), silu4(acc[ai][bj][m][1]));
                }
            }
    }
};

struct EpiY {
    static constexpr bool PERM = true, AFTER_DRAIN = false;
    bf16_t* Y; float* SSQ;
    __device__ __forceinline__ void operator()(const f32x4 (&acc)[2][2][4][2], const pg8::Unit& u, int wr, int wc, int fr, int fq) const {
        const int pn = u.pn, rbase = u.pm * 256 + wr * 64 + fr, cw = wc * 32 + 8 * fq;
#pragma unroll
        for (int ai = 0; ai < 2; ++ai)
#pragma unroll
            for (int m = 0; m < 4; ++m) {
                asm volatile("" ::: "memory"); const int R = rbase + ai * 128 + m * 16; float s = 0.f;
#pragma unroll
                for (int bj = 0; bj < 2; ++bj) { st8(Y + (size_t)R * 1024 + pn * 256 + bj * 128 + cw, acc[ai][bj][m][0], acc[ai][bj][m][1]); s += sq4(acc[ai][bj][m][0]) + sq4(acc[ai][bj][m][1]); }
                s += __shfl_xor(s, 16); s += __shfl_xor(s, 32);
                if (fq == 0) SSQ[(size_t)R * 16 + pn * 4 + wc] = s;
            }
    }
};

struct EpiOin {
    static constexpr bool PERM = true, AFTER_DRAIN = false;
    unsigned char* ws;
    __device__ __forceinline__ void operator()(const f32x4 (&acc)[2][2][4][2], const pg8::Unit& u, int wr, int wc, int fr, int fq) const {
        const int pn = u.pn, rbase = u.pm * 256 + wr * 64 + fr, cw = wc * 32 + 8 * fq;
        const float* ropeC = (const float*)(ws + WS_ROPEC);
#pragma unroll
        for (int ai = 0; ai < 2; ++ai)
#pragma unroll
            for (int m = 0; m < 4; ++m) {
                asm volatile("" ::: "memory"); const int R = rbase + ai * 128 + m * 16; const bool lat = R < ML; const int pos = R & 2047;
                if (pn == 0 || (pn >= 5 && pn <= 7)) {
                    float s = 0.f;
                    bf16_t* dst = (pn == 0) ? (bf16_t*)(ws + WS_CKV) + (size_t)R * 256 : (bf16_t*)(ws + WS_CQ) + (size_t)R * 768 + (pn - 5) * 256;
#pragma unroll
                    for (int bj = 0; bj < 2; ++bj) { st8(dst + bj * 128 + cw, acc[ai][bj][m][0], acc[ai][bj][m][1]); s += sq4(acc[ai][bj][m][0]) + sq4(acc[ai][bj][m][1]); }
                    s += __shfl_xor(s, 16); s += __shfl_xor(s, 32);
                    if (fq == 0) { if (pn == 0) ((float*)(ws + WS_SSQCKV))[(size_t)R * 4 + wc] = s; else ((float*)(ws + WS_SSQCQ))[(size_t)R * 12 + (pn - 5) * 4 + wc] = s; }
                } else if (pn == 4) {
                    if (wc == 0) {
                        f32x4 a = acc[ai][0][m][0], b = acc[ai][0][m][1];
                        if (lat) { const int i0 = cw >> 1; rope8(a, b, ropeC + pos * 32 + i0, ropeC + pos * 32 + 16 + i0); }
                        st8((bf16_t*)(ws + WS_KR) + (size_t)R * 32 + cw, a, b);
                    } else if (wc == 1 && fq < 2) {
                        float* g = (float*)(ws + WS_GATES) + (size_t)R * 16 + 8 * fq;
                        *(f32x4*)g = acc[ai][0][m][0]; *(f32x4*)(g + 4) = acc[ai][0][m][1];
                    }
                } else {
#pragma unroll
                    for (int bj = 0; bj < 2; ++bj) {
                        const f32x4 a = acc[ai][bj][m][0], b = acc[ai][bj][m][1]; const int col = bj * 128 + cw;
                        if (pn == 1) st8((bf16_t*)(ws + WS_MK) + (size_t)R * 256 + col, a * 0.125f, b * 0.125f);
                        else if (pn <= 3) st8((bf16_t*)(ws + WS_MV) + (size_t)R * 512 + (pn - 2) * 256 + col, a, b);
                        else if (pn == 8) st8((bf16_t*)(ws + WS_MQ) + (size_t)R * 256 + col, a, b);
                        else if (pn <= 10) st8((bf16_t*)(ws + WS_MO) + (size_t)R * 512 + (pn - 9) * 256 + col, sigm4(a), sigm4(b));
                        else st8((bf16_t*)(ws + WS_ZO) + (size_t)R * 1024 + (pn - 11) * 256 + col, silu4(a), silu4(b));
                    }
                }
            }
    }
};

struct EpiUkv {
    static constexpr bool PERM = true, AFTER_DRAIN = false;
    unsigned char* ws;
    __device__ __forceinline__ void operator()(const f32x4 (&acc)[2][2][4][2], const pg8::Unit& u, int wr, int wc, int fr, int fq) const {
        const int pn = u.pn, rbase = u.pm * 256 + wr * 64 + fr, cw = wc * 32 + 8 * fq;
#pragma unroll
        for (int ai = 0; ai < 2; ++ai)
#pragma unroll
            for (int m = 0; m < 4; ++m) {
                asm volatile("" ::: "memory"); const int R = rbase + ai * 128 + m * 16;
                const f32x4 sp = *(const f32x4*)((const float*)(ws + WS_SSQCKV) + (size_t)R * 4);
                const float rstd = rsqrtf(((sp[0] + sp[1]) + (sp[2] + sp[3])) * (1.f / 256.f) + EPS);
                int b, pos; if (R < ML) { b = R >> 11; pos = 256 + (R & 2047); } else { const int rc = R - ML; b = rc >> 8; pos = rc & 255; }
#pragma unroll
                for (int bj = 0; bj < 2; ++bj) {
                    const int head = pn * 2 + bj;
                    st8((bf16_t*)(ws + WS_KNV) + ((size_t)(b * 8 + head) * 2304 + pos) * 128 + cw, acc[ai][bj][m][0] * rstd, acc[ai][bj][m][1] * rstd);
                }
            }
    }
};

struct EpiUq {
    static constexpr bool PERM = true, AFTER_DRAIN = false;
    unsigned char* ws;
    __device__ __forceinline__ void operator()(const f32x4 (&acc)[2][2][4][2], const pg8::Unit& u, int wr, int wc, int fr, int fq) const {
        const int pn = u.pn, rbase = u.pm * 256 + wr * 64 + fr, cw = wc * 32 + 8 * fq;
        const float* ropeC = (const float*)(ws + WS_ROPEC);
#pragma unroll
        for (int ai = 0; ai < 2; ++ai)
#pragma unroll
            for (int m = 0; m < 4; ++m) {
                asm volatile("" ::: "memory"); const int R = rbase + ai * 128 + m * 16, pos = R & 2047;
                const float* sp = (const float*)(ws + WS_SSQCQ) + (size_t)R * 12;
                const f32x4 s0 = *(const f32x4*)sp, s1 = *(const f32x4*)(sp + 4), s2 = *(const f32x4*)(sp + 8);
                const float ss = (((s0[0] + s0[1]) + (s0[2] + s0[3])) + ((s1[0] + s1[1]) + (s1[2] + s1[3]))) + ((s2[0] + s2[1]) + (s2[2] + s2[3]));
                const float sc = rsqrtf(ss * (1.f / 768.f) + EPS) * (0.10206207261596575f * LOG2E);
#pragma unroll
                for (int bj = 0; bj < 2; ++bj) {
                    const int c = pn * 256 + bj * 128 + cw, head = c / 96, dd = c - head * 96;
                    f32x4 a = acc[ai][bj][m][0], b = acc[ai][bj][m][1];
                    if (dd >= 64) { const int i0 = (dd - 64) >> 1; rope8(a, b, ropeC + pos * 32 + i0, ropeC + pos * 32 + 16 + i0); }
                    st8((bf16_t*)(ws + WS_QO) + (size_t)R * 768 + c, a * sc, b * sc);
                }
            }
    }
};

#define RLX_AGENT __ATOMIC_RELAXED, __HIP_MEMORY_SCOPE_AGENT
#define XB_TMO      128
#define XB_XCNT(j)  (256  + 64 * (j))
#define XB_XSUB(j)  (1280 + 64 * (j))
#define XB_XGEN(j)  (2304 + 64 * (j))
#define XB_TOP      3328
#define XB_TOPGEN   3392
#define XCD_BAR_WORDS 3456
#define XB_SPIN_CAP (1u << 18)

__device__ __forceinline__ unsigned xb_ld(unsigned* p)              { return __hip_atomic_load(p, __ATOMIC_RELAXED, __HIP_MEMORY_SCOPE_AGENT); }
__device__ __forceinline__ unsigned xb_add(unsigned* p, unsigned v) { return __hip_atomic_fetch_add(p, v, __ATOMIC_RELAXED, __HIP_MEMORY_SCOPE_AGENT); }
__device__ __forceinline__ unsigned xb_xcc_id() { return (unsigned)__builtin_amdgcn_s_getreg((3 << 11) | 20) & 0xFu; }
#define XB_SPIN(cond, bar) do { unsigned _sp = 0; while (cond) { __builtin_amdgcn_s_sleep(1); \
    if ((++_sp & 255u) == 0u) { if (xb_ld(&(bar)[XB_TMO])) break; if (_sp > XB_SPIN_CAP) { atomicAdd(&(bar)[XB_TMO], 1u); break; } } } } while (0)

struct XcdBarrier {
    unsigned* bar; unsigned x;
    volatile LAS unsigned* st;
};

__device__ __forceinline__ XcdBarrier xcd_barrier_post(unsigned* bar, volatile LAS unsigned* st) {
    XcdBarrier b; b.bar = bar; b.x = xb_xcc_id(); b.st = st;
    if (threadIdx.x == 0) (void)xb_add(&bar[XB_XCNT(b.x)], 1u);
    return b;
}
__device__ __forceinline__ void xcd_barrier_complete(unsigned* bar, unsigned x, unsigned& nloc, unsigned& nx) {
    const unsigned G = gridDim.x * gridDim.y * gridDim.z;
    unsigned sum, cnt, mine, sp = 0u;
    for (;;) {
        sum = 0u; cnt = 0u; mine = 0u;
#pragma unroll
        for (unsigned j = 0; j < 16; ++j) { const unsigned c = xb_ld(&bar[XB_XCNT(j)]); sum += c; cnt += (c > 0u) ? 1u : 0u; mine = (j == x) ? c : mine; }
        if (sum == G) break;
        __builtin_amdgcn_s_sleep(1);
        if ((++sp & 255u) == 0u) { if (xb_ld(&bar[XB_TMO])) break; if (sp > XB_SPIN_CAP) { atomicAdd(&bar[XB_TMO], 1u); break; } }
    }
    nloc = mine > 0u ? mine : 1u; nx = cnt > 0u ? cnt : 1u;
}

__device__ __forceinline__ void xcd_barrier(const XcdBarrier& b) {
    asm volatile("s_waitcnt vmcnt(0)" ::: "memory");
    __syncthreads();
    if (threadIdx.x == 0) {
        unsigned* bar = b.bar;
        __builtin_amdgcn_s_waitcnt(0);
        unsigned nloc = b.st[0], nx = b.st[1];
        if (nloc == 0u) { xcd_barrier_complete(bar, b.x, nloc, nx); b.st[0] = nloc; b.st[1] = nx; }
        const unsigned old = xb_add(&bar[XB_XSUB(b.x)], 1u);
        const unsigned gen = old / nloc;
        if (old + 1u == (gen + 1u) * nloc) {
            __builtin_amdgcn_fence(__ATOMIC_RELEASE, "agent");
            asm volatile("s_waitcnt vmcnt(0)" ::: "memory");
            const unsigned og = xb_add(&bar[XB_TOP], 1u);
            const unsigned tg = og / nx;
            if (og + 1u == (tg + 1u) * nx) xb_add(&bar[XB_TOPGEN], 1u);
            else XB_SPIN(xb_ld(&bar[XB_TOPGEN]) == tg, bar);
            __builtin_amdgcn_fence(__ATOMIC_ACQUIRE, "agent");
            xb_add(&bar[XB_XGEN(b.x)], 1u);
            asm volatile("s_waitcnt vmcnt(0)" ::: "memory");
        } else {
            XB_SPIN(xb_ld(&bar[XB_XGEN(b.x)]) == gen, bar);
            __builtin_amdgcn_fence(__ATOMIC_ACQUIRE, "agent");
            asm volatile("s_waitcnt vmcnt(0)" ::: "memory");
        }
    }
    __syncthreads();
}

__device__ __forceinline__ int crow(int r, int hi) { return (r & 3) + 8 * (r >> 2) + 4 * hi; }
typedef short v4i16_t __attribute__((ext_vector_type(4)));
__device__ __forceinline__ s16x4 vtr(const LAS unsigned char* p) { return __builtin_bit_cast(s16x4, __builtin_amdgcn_ds_read_tr16_b64_v4i16((LAS v4i16_t*)p)); }

template <int MODE>
__device__ __forceinline__ void attn_unit(LAS unsigned char* lds, unsigned char* ws, const float* sink, int unit) {
    constexpr int DQK = (MODE == 2) ? 96 : 64, KST = DQK / 16, KS = DQK * 2 + 16, VS = 192, KBUF = 64 * KS, VBUF = 64 * VS;
    const int tid = my_tid(), lane = tid & 63, wid = __builtin_amdgcn_readfirstlane(tid >> 6), r32 = lane & 31, hi = lane >> 5;
    int b, head, hkv = 0, n = 0, Rq0, qpos0 = 0, nt, jlo = 0;
    const bf16_t* Qp; int qstride;
    if (MODE == 0) {
        const int hp = unit & 1; n = (unit >> 1) & 15; hkv = (unit >> 5) & 1; b = unit >> 6;
        head = hkv * 4 + hp * 2 + (wid >> 2); qpos0 = 128 * n + 32 * (wid & 3); Rq0 = b * 2048 + qpos0;
        Qp = (const bf16_t*)(ws + WS_QE) + (size_t)Rq0 * 512 + head * 64; qstride = 512;
        jlo = (n == 0) ? 2 : 0; const int jhi = (n == 15) ? 4 : 6; nt = 4 + (jhi - jlo);
    } else if (MODE == 1) {
        const int qh = unit & 1, hp = (unit >> 1) & 1; hkv = (unit >> 2) & 1; b = unit >> 3;
        head = hkv * 4 + hp * 2 + (wid >> 2); Rq0 = ML + b * 256 + 128 * qh + 32 * (wid & 3);
        Qp = (const bf16_t*)(ws + WS_QE) + (size_t)Rq0 * 512 + head * 64; qstride = 512; nt = 4;
    } else {
        const int qb = unit & 7; head = (unit >> 3) & 7; b = unit >> 6; Rq0 = b * 2048 + 256 * qb + 32 * wid;
        Qp = (const bf16_t*)(ws + WS_QO) + (size_t)Rq0 * 768 + head * 96; qstride = 768; nt = 36;
    }
    bf16x8 qf[KST];
#pragma unroll
    for (int s = 0; s < KST; ++s) qf[s] = *(const bf16x8*)(Qp + (size_t)r32 * qstride + 16 * s + 8 * hi);
    float m_run, l_run;
    if (MODE == 2) { m_run = -1e30f; l_run = 0.f; } else { m_run = sink[head] * LOG2E; l_run = (hi == 0) ? 1.f : 0.f; }
    f32x16 o0, o1;
#pragma unroll
    for (int r = 0; r < 16; ++r) { o0[r] = 0.f; o1[r] = 0.f; }

    const int srow = tid >> 3, sch = tid & 7;
    const int voff = (4 * hi + ((lane & 15) >> 2)) * VS + (((lane >> 4) & 1) * 16 + 4 * (lane & 3)) * 2;
    u32x4 kreg, vreg, kreg2;
    kreg2 = (u32x4){0u, 0u, 0u, 0u};
#define ATT_SRC(t, kp, vp, k2p, kpos0v) do { \
        if (MODE == 0 || MODE == 1) { \
            if ((t) < 4) { kp = (const bf16_t*)(ws + WS_KVE) + (size_t)(ML + b * 256 + 64 * (t) + srow) * 256 + hkv * 64 + sch * 8; kpos0v = -100000; } \
            else { const int kp0_ = 128 * n - 128 + 64 * (jlo + (t) - 4); kpos0v = kp0_; \
                   kp = (const bf16_t*)(ws + WS_KVE) + (size_t)(b * 2048 + kp0_ + srow) * 256 + hkv * 64 + sch * 8; } \
            vp = kp + 128; k2p = kp; \
        } else { \
            const int pos0_ = 64 * (t); kpos0v = -100000; \
            kp = (const bf16_t*)(ws + WS_KNV) + ((size_t)(b * 8 + head) * 2304 + pos0_ + srow) * 128 + sch * 8; \
            vp = kp + 64; \
            const int krow_ = ((t) < 4) ? (ML + b * 256 + pos0_) : (b * 2048 + pos0_ - 256); \
            k2p = (const bf16_t*)(ws + WS_KR) + (size_t)(krow_ + (tid >> 2)) * 32 + (tid & 3) * 8; \
        } } while (0)
#define ATT_LOAD(t) do { const bf16_t *kp_, *vp_, *k2p_; int kq_; ATT_SRC(t, kp_, vp_, k2p_, kq_); (void)kq_; \
        kreg = *(const u32x4*)kp_; vreg = *(const u32x4*)vp_; if (MODE == 2 && tid < 256) kreg2 = *(const u32x4*)k2p_; } while (0)
#define ATT_STORE(buf) do { LAS unsigned char* kb_ = lds + (buf) * KBUF; LAS unsigned char* vb_ = lds + 2 * KBUF + (buf) * VBUF; \
        *(LAS u32x4*)(kb_ + srow * KS + sch * 16) = kreg; \
        if (MODE == 2 && tid < 256) *(LAS u32x4*)(kb_ + (tid >> 2) * KS + 128 + (tid & 3) * 16) = kreg2; \
        *(LAS u32x4*)(vb_ + srow * VS + sch * 16) = vreg; } while (0)

    ATT_LOAD(0); ATT_STORE(0);
    __syncthreads();
    for (int t = 0; t < nt; ++t) {
        const int buf = t & 1;
        if (t + 1 < nt) ATT_LOAD(t + 1);
        int kpos0 = -100000;
        if (MODE == 0 && t >= 4) kpos0 = 128 * n - 128 + 64 * (jlo + t - 4);
        bool active = true;
        if (MODE == 0 && t >= 4) active = (kpos0 + 63 >= qpos0 - 128) && (kpos0 <= qpos0 + 31 + 128);
        if (active) {
            const LAS unsigned char* kb = lds + buf * KBUF; const LAS unsigned char* vb = lds + 2 * KBUF + buf * VBUF;
            f32x16 p0, p1;
#pragma unroll
            for (int r = 0; r < 16; ++r) { p0[r] = 0.f; p1[r] = 0.f; }
#pragma unroll
            for (int s = 0; s < KST; ++s) {
                const bf16x8 a0 = *(const LAS bf16x8*)(kb + r32 * KS + (16 * s + 8 * hi) * 2);
                const bf16x8 a1 = *(const LAS bf16x8*)(kb + (32 + r32) * KS + (16 * s + 8 * hi) * 2);
                p0 = __builtin_amdgcn_mfma_f32_32x32x16_bf16(a0, qf[s], p0, 0, 0, 0);
                p1 = __builtin_amdgcn_mfma_f32_32x32x16_bf16(a1, qf[s], p1, 0, 0, 0);
            }
            if (MODE == 0 && t >= 4) {
                const int qpos = qpos0 + r32;
#pragma unroll
                for (int r = 0; r < 16; ++r) { const int d0 = kpos0 + crow(r, hi) - qpos, d1 = d0 + 32;
                    if (d0 > 128 || d0 < -128) p0[r] = -INFINITY; if (d1 > 128 || d1 < -128) p1[r] = -INFINITY; }
            }
            float mx = fmaxf(p0[0], p1[0]);
#pragma unroll
            for (int r = 1; r < 16; ++r) mx = fmaxf(mx, fmaxf(p0[r], p1[r]));
            mx = fmaxf(mx, __shfl_xor(mx, 32));
            const float m_new = fmaxf(m_run, mx), alpha = __builtin_amdgcn_exp2f(m_run - m_new);
            m_run = m_new;
            float rs = 0.f;
#pragma unroll
            for (int r = 0; r < 16; ++r) { p0[r] = __builtin_amdgcn_exp2f(p0[r] - m_new); p1[r] = __builtin_amdgcn_exp2f(p1[r] - m_new); rs += p0[r] + p1[r]; }
            l_run = l_run * alpha + rs;
#pragma unroll
            for (int r = 0; r < 16; ++r) { o0[r] *= alpha; o1[r] *= alpha; }
            u32x4 pw[4];
            pw[0] = (u32x4){pk2(p0[0], p0[1]), pk2(p0[2], p0[3]), pk2(p0[4], p0[5]), pk2(p0[6], p0[7])};
            pw[1] = (u32x4){pk2(p0[8], p0[9]), pk2(p0[10], p0[11]), pk2(p0[12], p0[13]), pk2(p0[14], p0[15])};
            pw[2] = (u32x4){pk2(p1[0], p1[1]), pk2(p1[2], p1[3]), pk2(p1[4], p1[5]), pk2(p1[6], p1[7])};
            pw[3] = (u32x4){pk2(p1[8], p1[9]), pk2(p1[10], p1[11]), pk2(p1[12], p1[13]), pk2(p1[14], p1[15])};
#pragma unroll
            for (int s2 = 0; s2 < 4; ++s2) {
                const bf16x8 pb = __builtin_bit_cast(bf16x8, pw[s2]);
                const LAS unsigned char* va0 = vb + (16 * s2) * VS + voff;
                const s16x4 l0 = vtr(va0), h0 = vtr(va0 + 8 * VS), l1 = vtr(va0 + 64), h1 = vtr(va0 + 8 * VS + 64);
                const bf16x8 v0 = (bf16x8){l0[0], l0[1], l0[2], l0[3], h0[0], h0[1], h0[2], h0[3]};
                const bf16x8 v1 = (bf16x8){l1[0], l1[1], l1[2], l1[3], h1[0], h1[1], h1[2], h1[3]};
                o0 = __builtin_amdgcn_mfma_f32_32x32x16_bf16(v0, pb, o0, 0, 0, 0);
                o1 = __builtin_amdgcn_mfma_f32_32x32x16_bf16(v1, pb, o1, 0, 0, 0);
            }
        }
        if (t + 1 < nt) ATT_STORE(buf ^ 1);
        __syncthreads();
    }
#undef ATT_SRC
#undef ATT_LOAD
#undef ATT_STORE
    const float l_tot = l_run + __shfl_xor(l_run, 32), inv = __builtin_amdgcn_rcpf(l_tot);
    const int Rq = Rq0 + r32;
    const bf16_t* zrow = (MODE == 2) ? (const bf16_t*)(ws + WS_ZO) + (size_t)Rq * 1024 + head * 64 : (const bf16_t*)(ws + WS_ZA) + (size_t)Rq * 512 + head * 64;
    bf16_t* urow = (bf16_t*)(ws + WS_U) + (size_t)Rq * 1024 + head * 64;
#pragma unroll
    for (int g = 0; g < 4; ++g) {
        const int dv = 8 * g + 4 * hi;
        { const u32x2 z = *(const u32x2*)(zrow + dv);
          u32x2 w; w.x = pk2(o0[4 * g] * inv * bf_lo(z.x), o0[4 * g + 1] * inv * bf_hi(z.x)); w.y = pk2(o0[4 * g + 2] * inv * bf_lo(z.y), o0[4 * g + 3] * inv * bf_hi(z.y));
          *(u32x2*)(urow + dv) = w; }
        { const u32x2 z = *(const u32x2*)(zrow + 32 + dv);
          u32x2 w; w.x = pk2(o1[4 * g] * inv * bf_lo(z.x), o1[4 * g + 1] * inv * bf_hi(z.x)); w.y = pk2(o1[4 * g + 2] * inv * bf_lo(z.y), o1[4 * g + 3] * inv * bf_hi(z.y));
          *(u32x2*)(urow + 32 + dv) = w; }
    }
}


__device__ __forceinline__ int srcmap(int mat, int dn) {
    if (mat == 0) {
        if (dn < 128) { const int d = dn & 63; return (dn & 64) + (d >> 1) + 32 * (d & 1); }
        if (dn < 256) return dn;
        if (dn < 768) { const int j = dn - 256, d = j & 63; return 256 + (j & ~63) + (d >> 1) + 32 * (d & 1); }
        if (dn < 1792) { const int j = dn - 768, blk = j >> 8, w = j & 255; return (w < 128) ? 1280 + blk * 128 + w : 1792 + blk * 128 + (w - 128); }
        if (dn < 2816) { const int j = dn - 1792, blk = j >> 8, w = j & 255; return (w < 128) ? 768 + blk * 128 + w : 2816 + blk * 128 + (w - 128); }
        return 2304 + (dn - 2816);
    }
    if (mat == 2) {
        if (dn < 256) return dn;
        if (dn < 512) return 288 + (dn - 256);
        if (dn < 1024) return 544 + (dn - 512);
        if (dn < 1280) { const int w = dn - 1024; if (w < 32) return 256 + (w >> 1) + 16 * (w & 1); if (w < 48) return 1056 + (w - 32); return -1; }
        if (dn < 2048) return 1072 + (dn - 1280);
        if (dn < 2304) return 1840 + (dn - 2048);
        if (dn < 2816) return 2096 + (dn - 2304);
        return 2608 + (dn - 2816);
    }
    if (mat == 3) {
        const int head = dn / 96, d = dn - head * 96; if (d < 64) return dn; const int w = d - 64; return head * 96 + 64 + (w >> 1) + 16 * (w & 1);
    }
    return dn;
}
__device__ __forceinline__ void p0_transpose_item(const float* W, int K, int Nsrc, bf16_t* WT, int mat, const float* kscale, LAS float* scr, int item, int nblk, int lane) {
    const int kb = item / nblk, nb = item % nblk, k0 = 64 * kb, n0 = 32 * nb;
    const int sc = srcmap(mat, n0 + (lane & 31));
#pragma unroll 8
    for (int i = 0; i < 32; ++i) { const int kk = 2 * i + (lane >> 5); float v = 0.f; if (sc >= 0) v = W[(size_t)(k0 + kk) * Nsrc + sc]; if (kscale) v *= kscale[k0 + kk]; scr[kk * 33 + (lane & 31)] = v; }
    LDS_WAIT(); asm volatile("" ::: "memory");
    const int c = lane & 7;
#pragma unroll
    for (int j = 0; j < 4; ++j) { const int n = (lane >> 3) + 8 * j; const LAS float* s = scr + (8 * c) * 33 + n;
        u32x4 o; o.x = pk2(s[0 * 33], s[1 * 33]); o.y = pk2(s[2 * 33], s[3 * 33]); o.z = pk2(s[4 * 33], s[5 * 33]); o.w = pk2(s[6 * 33], s[7 * 33]);
        *(u32x4*)(WT + (size_t)(n0 + n) * K + k0 + 8 * c) = o; }
    LDS_WAIT(); asm volatile("" ::: "memory");
}

__device__ __forceinline__ void p0_mod(LAS unsigned char* lds, const float* c, const float* c_ctx, const float* mod_w, const float* mod_b, float* MOD, int G) {
    const int tid = my_tid();
    if ((int)blockIdx.x >= 96) return;
    LAS float* scs = (LAS float*)lds;
    LAS float* red = (LAS float*)(lds + 1024 * 20 * 4);
    for (int idx = tid; idx < 17 * 1024; idx += NTHREADS) { const int r = idx >> 10, k = idx & 1023; const float v = (r < 16) ? c[r * 1024 + k] : c_ctx[k]; scs[k * 20 + r] = silu_f(v); }
    __syncthreads();
    for (int item = blockIdx.x; item < 96; item += G) {
        const int l = item / 48, n0 = (item % 48) * 64, col = tid & 63, kg = tid >> 6;
        float acc[20];
#pragma unroll
        for (int r = 0; r < 20; ++r) acc[r] = 0.f;
        const float* wp = mod_w + ((size_t)l * 1024 + kg * 128) * 3072 + n0 + col;
#pragma unroll 4
        for (int kk = 0; kk < 128; ++kk) {
            const float w = wp[(size_t)kk * 3072]; const LAS f32x4* sp = (const LAS f32x4*)(scs + (kg * 128 + kk) * 20);
#pragma unroll
            for (int q = 0; q < 5; ++q) { const f32x4 s = sp[q]; acc[4 * q] += s[0] * w; acc[4 * q + 1] += s[1] * w; acc[4 * q + 2] += s[2] * w; acc[4 * q + 3] += s[3] * w; }
        }
#pragma unroll
        for (int r = 0; r < 17; ++r) red[(kg * 17 + r) * 64 + col] = acc[r];
        __syncthreads();
        for (int o = tid; o < 17 * 64; o += NTHREADS) { const int r = o >> 6, cc = o & 63; float s = mod_b[l * 3072 + n0 + cc];
#pragma unroll
            for (int g = 0; g < 8; ++g) s += red[(g * 17 + r) * 64 + cc];
            MOD[((size_t)l * 17 + r) * 3072 + n0 + cc] = s; }
        __syncthreads();
    }
}

__device__ __forceinline__ void norm_mod_store(const f32x4 (&v)[4], const float* pre_w, const float* modrow, bf16_t* hrow, int lane) {
    float ss = 0.f;
#pragma unroll
    for (int j = 0; j < 4; ++j) ss += sq4(v[j]);
    const float rstd = rsqrtf(wave_sum(ss) * (1.f / 1024.f) + EPS);
#pragma unroll
    for (int j = 0; j < 4; ++j) { const int k = 4 * (lane + 64 * j);
        const f32x4 w = *(const f32x4*)(pre_w + k), sh = *(const f32x4*)(modrow + k), sc = *(const f32x4*)(modrow + 1024 + k);
        const f32x4 h = v[j] * rstd * w * (sc + 1.0f) + sh;
        u32x2 o; o.x = pk2(h[0], h[1]); o.y = pk2(h[2], h[3]); *(u32x2*)(hrow + k) = o; }
}
__device__ __forceinline__ void p1_prenorm(const float* x, const float* ctx, const float* pre_w, const float* MOD, bf16_t* H, int gw, int ngw, int lane) {
    for (int R = gw; R < MT; R += ngw) {
        const float* src = (R < ML) ? x + (size_t)R * 1024 : ctx + (size_t)(R - ML) * 1024; const int bi = (R < ML) ? (R >> 11) : 16;
        f32x4 v[4];
#pragma unroll
        for (int j = 0; j < 4; ++j) v[j] = *(const f32x4*)(src + 4 * (lane + 64 * j));
        norm_mod_store(v, pre_w, MOD + (size_t)bi * 3072, H + (size_t)R * 1024, lane);
    }
}
__device__ __forceinline__ float ssq16(const float* p) {
    const f32x4 a = *(const f32x4*)p, b = *(const f32x4*)(p + 4), c = *(const f32x4*)(p + 8), d = *(const f32x4*)(p + 12);
    return (((a[0] + a[1]) + (a[2] + a[3])) + ((b[0] + b[1]) + (b[2] + b[3]))) + (((c[0] + c[1]) + (c[2] + c[3])) + ((d[0] + d[1]) + (d[2] + d[3])));
}
__device__ __forceinline__ void p5_post_pre(const float* x, const float* ctx, const float* post_w0, const float* pre_w1, const float* MOD, const bf16_t* Y, const float* SSQ, float* X1, bf16_t* H, int gw, int ngw, int lane) {
    for (int R = gw; R < MT; R += ngw) {
        const float* src = (R < ML) ? x + (size_t)R * 1024 : ctx + (size_t)(R - ML) * 1024; const int bi = (R < ML) ? (R >> 11) : 16;
        const float rstd_y = rsqrtf(ssq16(SSQ + (size_t)R * 16) * (1.f / 1024.f) + EPS);
        const float* m0 = MOD + (size_t)bi * 3072;
        f32x4 v[4];
#pragma unroll
        for (int j = 0; j < 4; ++j) { const int k = 4 * (lane + 64 * j);
            const u32x2 yy = *(const u32x2*)(Y + (size_t)R * 1024 + k); const f32x4 y = (f32x4){bf_lo(yy.x), bf_hi(yy.x), bf_lo(yy.y), bf_hi(yy.y)};
            const f32x4 g = *(const f32x4*)(m0 + 2048 + k), pw = *(const f32x4*)(post_w0 + k), xv = *(const f32x4*)(src + k);
            v[j] = xv + g * (y * rstd_y * pw);
            if (R < ML) *(f32x4*)(X1 + (size_t)R * 1024 + k) = v[j]; }
        norm_mod_store(v, pre_w1, MOD + (size_t)(17 + bi) * 3072, H + (size_t)R * 1024, lane);
    }
}
__device__ __forceinline__ void p11_final(const float* post_w1, const float* MOD, const bf16_t* Y, const float* SSQ, float* out, int gw, int ngw, int lane) {
    for (int R = gw; R < ML; R += ngw) {
        const float rstd_y = rsqrtf(ssq16(SSQ + (size_t)R * 16) * (1.f / 1024.f) + EPS);
        const float* m1 = MOD + (size_t)(17 + (R >> 11)) * 3072;
#pragma unroll
        for (int j = 0; j < 4; ++j) { const int k = 4 * (lane + 64 * j);
            const u32x2 yy = *(const u32x2*)(Y + (size_t)R * 1024 + k); const f32x4 y = (f32x4){bf_lo(yy.x), bf_hi(yy.x), bf_lo(yy.y), bf_hi(yy.y)};
            const f32x4 g = *(const f32x4*)(m1 + 2048 + k), pw = *(const f32x4*)(post_w1 + k), xv = *(const f32x4*)(out + (size_t)R * 1024 + k);
            *(f32x4*)(out + (size_t)R * 1024 + k) = xv + g * (y * rstd_y * pw); }
    }
}
__device__ __forceinline__ void p3_conv(unsigned char* ws, const float* conv_w, int gtid, int ngt) {
    const bf16_t* PE = (const bf16_t*)(ws + WS_PE); const bf16_t* GE = (const bf16_t*)(ws + WS_GE); bf16_t* U = (bf16_t*)(ws + WS_U);
    for (int it = gtid; it < MT * 64; it += ngt) {
        const int R = it >> 6, ch = (it & 63) * 8;
        int t, T; if (R < ML) { t = R & 2047; T = 2048; } else { t = (R - ML) & 255; T = 256; }
        const u32x4 z4 = (u32x4){0u, 0u, 0u, 0u};
        const u32x4 pc = *(const u32x4*)(PE + (size_t)R * 512 + ch);
        const u32x4 pm = (t > 0) ? *(const u32x4*)(PE + (size_t)(R - 1) * 512 + ch) : z4;
        const u32x4 pp = (t < T - 1) ? *(const u32x4*)(PE + (size_t)(R + 1) * 512 + ch) : z4;
        const u32x4 g = *(const u32x4*)(GE + (size_t)R * 512 + ch);
        const f32x4 w0a = *(const f32x4*)(conv_w + ch), w0b = *(const f32x4*)(conv_w + ch + 4), w1a = *(const f32x4*)(conv_w + 512 + ch), w1b = *(const f32x4*)(conv_w + 512 + ch + 4),
                    w2a = *(const f32x4*)(conv_w + 1024 + ch), w2b = *(const f32x4*)(conv_w + 1024 + ch + 4);
        u32x4 o;
#define CV(pmw, pcw, ppw, gw_, wa, wb, wc_, e0, e1) pk2(bf_lo(gw_) * (wa[e0] * bf_lo(pmw) + wb[e0] * bf_lo(pcw) + wc_[e0] * bf_lo(ppw)), bf_hi(gw_) * (wa[e1] * bf_hi(pmw) + wb[e1] * bf_hi(pcw) + wc_[e1] * bf_hi(ppw)))
        o.x = CV(pm.x, pc.x, pp.x, g.x, w0a, w1a, w2a, 0, 1); o.y = CV(pm.y, pc.y, pp.y, g.y, w0a, w1a, w2a, 2, 3);
        o.z = CV(pm.z, pc.z, pp.z, g.z, w0b, w1b, w2b, 0, 1); o.w = CV(pm.w, pc.w, pp.w, g.w, w0b, w1b, w2b, 2, 3);
#undef CV
        *(u32x4*)(U + (size_t)R * 1024 + 512 + ch) = o;
    }
}
__device__ __forceinline__ void p9_readout(unsigned char* ws, const float* hn_w, int gw, int ngw, int lane) {
    const bf16_t* HM = (const bf16_t*)(ws + WS_HM); const bf16_t* MO = (const bf16_t*)(ws + WS_MO); const bf16_t* ZO = (const bf16_t*)(ws + WS_ZO); bf16_t* U = (bf16_t*)(ws + WS_U);
    for (int R = gw; R < ML; R += ngw) {
        const int ch = 8 * lane;
        const u32x4 h0 = *(const u32x4*)(HM + (size_t)R * 512 + ch), h1 = *(const u32x4*)(HM + ((size_t)ML + R) * 512 + ch);
        float hs[8] = {bf_lo(h0.x) + bf_lo(h1.x), bf_hi(h0.x) + bf_hi(h1.x), bf_lo(h0.y) + bf_lo(h1.y), bf_hi(h0.y) + bf_hi(h1.y),
                       bf_lo(h0.z) + bf_lo(h1.z), bf_hi(h0.z) + bf_hi(h1.z), bf_lo(h0.w) + bf_lo(h1.w), bf_hi(h0.w) + bf_hi(h1.w)};
        float ss = 0.f;
#pragma unroll
        for (int e = 0; e < 8; ++e) ss += hs[e] * hs[e];
        ss += __shfl_xor(ss, 1); ss += __shfl_xor(ss, 2); ss += __shfl_xor(ss, 4); ss += __shfl_xor(ss, 8);
        const float rstd = rsqrtf(ss * (1.f / 128.f) + EPS);
        const u32x4 mo = *(const u32x4*)(MO + (size_t)R * 512 + ch), zz = *(const u32x4*)(ZO + (size_t)R * 1024 + 512 + ch);
        const f32x4 wa = *(const f32x4*)(hn_w + ch), wb = *(const f32x4*)(hn_w + ch + 4);
        u32x4 o;
        o.x = pk2(hs[0] * rstd * wa[0] * bf_lo(mo.x) * bf_lo(zz.x), hs[1] * rstd * wa[1] * bf_hi(mo.x) * bf_hi(zz.x));
        o.y = pk2(hs[2] * rstd * wa[2] * bf_lo(mo.y) * bf_lo(zz.y), hs[3] * rstd * wa[3] * bf_hi(mo.y) * bf_hi(zz.y));
        o.z = pk2(hs[4] * rstd * wb[0] * bf_lo(mo.z) * bf_lo(zz.z), hs[5] * rstd * wb[1] * bf_hi(mo.z) * bf_hi(zz.z));
        o.w = pk2(hs[6] * rstd * wb[2] * bf_lo(mo.w) * bf_lo(zz.w), hs[7] * rstd * wb[3] * bf_hi(mo.w) * bf_hi(zz.w));
        *(u32x4*)(U + (size_t)R * 1024 + 512 + ch) = o;
    }
}


__device__ __forceinline__ void mlstm_chain(LAS unsigned char* lds, unsigned char* ws, const float* i_bias, const float* f_bias, int chain) {
    const int tid = my_tid(), lane = tid & 63, wid = __builtin_amdgcn_readfirstlane(tid >> 6);
    const int vh = chain & 1, d = (chain >> 1) & 1, h = (chain >> 2) & 3, b = chain >> 4;
    LAS float* Kc = (LAS float*)lds;
    LAS float* Vc = Kc + 4096;
    LAS float* Ct = Vc + 4096;
    LAS float* Qc = Ct + 4096;
    LAS float* Sc = Qc + 64 * 65;
    LAS float* vb_ = Sc + 64 * 65;
    LAS float* vab = vb_ + 64;
    LAS float* vcm = vab + 64;
    LAS float* vw = vcm + 64;
    LAS float* vn = vw + 64;
    LAS float* vsc = vn + 64;
    const bf16_t* MK = (const bf16_t*)(ws + WS_MK); const bf16_t* MV = (const bf16_t*)(ws + WS_MV); const bf16_t* MQ = (const bf16_t*)(ws + WS_MQ);
    const float* GT = (const float*)(ws + WS_GATES); bf16_t* HM = (bf16_t*)(ws + WS_HM);
    const float ib = i_bias[d * 4 + h], fb = f_bias[d * 4 + h];
    float ct[8];
#pragma unroll
    for (int e = 0; e < 8; ++e) ct[e] = 0.f;
    float nreg = 0.f, mst = 0.f;
    for (int idx = tid; idx < 4096; idx += NTHREADS) Ct[idx] = 0.f;
    if (tid < 64) vn[tid] = 0.f;
    const int srow = tid >> 3, sch = tid & 7;
    for (int step = 0; step < 36; ++step) {
        const bool lat = step >= 4; const int c = lat ? step - 4 : step, T = lat ? 2048 : 256, rowb = lat ? b * 2048 : ML + b * 256;
        { const int tok = (d == 0) ? 64 * c + srow : T - 1 - (64 * c + srow); const size_t R = (size_t)(rowb + tok);
          const u32x4 kk = *(const u32x4*)(MK + R * 256 + h * 64 + sch * 8), vv = *(const u32x4*)(MV + R * 512 + h * 128 + vh * 64 + sch * 8);
          *(LAS f32x4*)(Kc + srow * 64 + sch * 8) = (f32x4){bf_lo(kk.x), bf_hi(kk.x), bf_lo(kk.y), bf_hi(kk.y)}; *(LAS f32x4*)(Kc + srow * 64 + sch * 8 + 4) = (f32x4){bf_lo(kk.z), bf_hi(kk.z), bf_lo(kk.w), bf_hi(kk.w)};
          *(LAS f32x4*)(Vc + srow * 64 + sch * 8) = (f32x4){bf_lo(vv.x), bf_hi(vv.x), bf_lo(vv.y), bf_hi(vv.y)}; *(LAS f32x4*)(Vc + srow * 64 + sch * 8 + 4) = (f32x4){bf_lo(vv.z), bf_hi(vv.z), bf_lo(vv.w), bf_hi(vv.w)};
          if (lat) { const u32x4 qq = *(const u32x4*)(MQ + R * 256 + h * 64 + sch * 8); LAS float* qd = Qc + srow * 65 + sch * 8;
              qd[0] = bf_lo(qq.x); qd[1] = bf_hi(qq.x); qd[2] = bf_lo(qq.y); qd[3] = bf_hi(qq.y); qd[4] = bf_lo(qq.z); qd[5] = bf_hi(qq.z); qd[6] = bf_lo(qq.w); qd[7] = bf_hi(qq.w); }
          if (wid == 0) {
              const int tk = (d == 0) ? 64 * c + lane : T - 1 - (64 * c + lane); const float* gp = GT + (size_t)(rowb + tk) * 16 + d * 8 + h;
              const float li = gp[0] + ib, fp = gp[4] + fb;
              const float lf = fminf(fp, 0.f) - __logf(1.f + __expf(-fabsf(fp)));
              float bc = lf;
#pragma unroll
              for (int o = 1; o < 64; o <<= 1) { const float t_ = __shfl_up(bc, o); if (lane >= o) bc += t_; }
              const float ab = li - bc; float cm = ab;
#pragma unroll
              for (int o = 1; o < 64; o <<= 1) { const float t_ = __shfl_up(cm, o); if (lane >= o) cm = fmaxf(cm, t_); }
              const float g = __shfl(bc, 63), cmx = __shfl(cm, 63), mloc = g + cmx;
              vb_[lane] = bc; vab[lane] = ab; vcm[lane] = cm; vw[lane] = __expf(g + ab - mloc);
              if (lane == 0) { vsc[0] = g; vsc[1] = mloc; }
          } }
        __syncthreads();
        const float g = vsc[0], mloc = vsc[1], m_in = mst;
        if (lat) {
            float q[64];
#pragma unroll
            for (int k = 0; k < 64; ++k) q[k] = Qc[lane * 65 + k];
            const float mi = fmaxf(m_in, vcm[lane]);
#pragma unroll
            for (int jj = 0; jj < 8; ++jj) { const int j = 8 * wid + jj; float s = 0.f;
#pragma unroll
                for (int k4 = 0; k4 < 16; ++k4) { const f32x4 kv = *(const LAS f32x4*)(Kc + j * 64 + 4 * k4); s += q[4 * k4] * kv[0] + q[4 * k4 + 1] * kv[1] + q[4 * k4 + 2] * kv[2] + q[4 * k4 + 3] * kv[3]; }
                Sc[lane * 65 + j] = (j <= lane) ? s * __expf(vab[j] - mi) : 0.f; }
            float nq = 0.f;
#pragma unroll
            for (int k4 = 0; k4 < 16; ++k4) { const f32x4 nv = *(const LAS f32x4*)(vn + 4 * k4); nq += q[4 * k4] * nv[0] + q[4 * k4 + 1] * nv[1] + q[4 * k4 + 2] * nv[2] + q[4 * k4 + 3] * nv[3]; }
            __syncthreads();
            const float wi = __expf(m_in - mi);
            float acc[8];
#pragma unroll
            for (int e = 0; e < 8; ++e) acc[e] = 0.f;
#pragma unroll
            for (int k = 0; k < 64; ++k) { const float qk = q[k] * wi; const f32x4 c0 = *(const LAS f32x4*)(Ct + k * 64 + 8 * wid), c1 = *(const LAS f32x4*)(Ct + k * 64 + 8 * wid + 4);
                acc[0] += qk * c0[0]; acc[1] += qk * c0[1]; acc[2] += qk * c0[2]; acc[3] += qk * c0[3]; acc[4] += qk * c1[0]; acc[5] += qk * c1[1]; acc[6] += qk * c1[2]; acc[7] += qk * c1[3]; }
            float den = wi * nq;
#pragma unroll 8
            for (int j = 0; j < 64; ++j) { const float sj = Sc[lane * 65 + j]; den += sj; const f32x4 v0 = *(const LAS f32x4*)(Vc + j * 64 + 8 * wid), v1 = *(const LAS f32x4*)(Vc + j * 64 + 8 * wid + 4);
                acc[0] += sj * v0[0]; acc[1] += sj * v0[1]; acc[2] += sj * v0[2]; acc[3] += sj * v0[3]; acc[4] += sj * v1[0]; acc[5] += sj * v1[1]; acc[6] += sj * v1[2]; acc[7] += sj * v1[3]; }
            const float mt = vb_[lane] + mi, inv = 1.f / fmaxf(fabsf(den), __expf(-mt));
            const int tok = (d == 0) ? 64 * c + lane : T - 1 - (64 * c + lane);
            u32x4 o; o.x = pk2(acc[0] * inv, acc[1] * inv); o.y = pk2(acc[2] * inv, acc[3] * inv); o.z = pk2(acc[4] * inv, acc[5] * inv); o.w = pk2(acc[6] * inv, acc[7] * inv);
            *(u32x4*)(HM + ((size_t)d * ML + rowb + tok) * 512 + h * 128 + vh * 64 + 8 * wid) = o;
        }
        const float m_new = fmaxf(g + m_in, mloc), a_prev = __expf(g + m_in - m_new), a_loc = __expf(mloc - m_new);
        float upd[8];
#pragma unroll
        for (int e = 0; e < 8; ++e) upd[e] = 0.f;
        float nsum = 0.f;
#pragma unroll 8
        for (int j = 0; j < 64; ++j) { const float kw = Kc[j * 64 + lane] * vw[j]; nsum += kw; const f32x4 v0 = *(const LAS f32x4*)(Vc + j * 64 + 8 * wid), v1 = *(const LAS f32x4*)(Vc + j * 64 + 8 * wid + 4);
            upd[0] += kw * v0[0]; upd[1] += kw * v0[1]; upd[2] += kw * v0[2]; upd[3] += kw * v0[3]; upd[4] += kw * v1[0]; upd[5] += kw * v1[1]; upd[6] += kw * v1[2]; upd[7] += kw * v1[3]; }
#pragma unroll
        for (int e = 0; e < 8; ++e) ct[e] = a_prev * ct[e] + a_loc * upd[e];
        nreg = a_prev * nreg + a_loc * nsum; mst = m_new;
        __syncthreads();
        *(LAS f32x4*)(Ct + lane * 64 + 8 * wid) = (f32x4){ct[0], ct[1], ct[2], ct[3]}; *(LAS f32x4*)(Ct + lane * 64 + 8 * wid + 4) = (f32x4){ct[4], ct[5], ct[6], ct[7]};
        if (wid == 0) vn[lane] = nreg;
    }
    __syncthreads();
}


#ifndef MK_N_LAUNCHES
#define MK_N_LAUNCHES 1
#endif
constexpr int N_PHASES = 12;
constexpr int LDS_BYTES = 147456;
constexpr int RING_BYTES = 131072, MISC_OFF = RING_BYTES + 320;
constexpr int CW_BAR = 4096;

struct Args { const float* in[21]; float* out; unsigned char* ws; int ph_lo, ph_hi; };

__global__ void __launch_bounds__(NTHREADS, 2) hybrid_fwd(Args args) {
    extern __shared__ __attribute__((aligned(16))) unsigned char lds_raw[];
    LAS unsigned char* lds = (LAS unsigned char*)lds_raw;
    const int G = gridDim.x, bx = blockIdx.x;
    const int vcu = (G % 8 == 0) ? (bx % 8) * (G / 8) + bx / 8 : bx;
    typedef const __attribute__((address_space(4))) Args* ArgsP;
    ArgsP AP = (ArgsP)__builtin_amdgcn_kernarg_segment_ptr();
    asm volatile("" : "+s"(AP));
    unsigned char* ws = AP->ws;
#define I_x AP->in[0]
#define I_cvec AP->in[1]
#define I_ctx AP->in[2]
#define I_c_ctx AP->in[3]
#define I_mod_w AP->in[4]
#define I_mod_b AP->in[5]
#define I_pre_w AP->in[6]
#define I_post_w AP->in[7]
#define I_e_w_in AP->in[8]
#define I_e_sink AP->in[9]
#define I_e_conv_w AP->in[10]
#define I_e_w_out AP->in[11]
#define I_o_w_in AP->in[12]
#define I_o_qn AP->in[13]
#define I_o_kvn AP->in[14]
#define I_o_w_uq AP->in[15]
#define I_o_w_ukv AP->in[16]
#define I_o_ib AP->in[17]
#define I_o_fb AP->in[18]
#define I_o_hn AP->in[19]
#define I_o_w_out AP->in[20]
#define I_out AP->out
    float* MOD = (float*)(ws + WS_MOD);

    for (int u = threadIdx.x; u < (LDS_BYTES - RING_BYTES) / 4; u += NTHREADS) ((LAS unsigned*)(lds + RING_BYTES))[u] = 0u;
    __syncthreads();
    XcdBarrier bar; bar.bar = (unsigned*)(ws + WS_CTL) + CW_BAR; bar.x = 0; bar.st = nullptr;
    if (MK_N_LAUNCHES == 1) bar = xcd_barrier_post((unsigned*)(ws + WS_CTL) + CW_BAR, (volatile LAS unsigned*)(lds + MISC_OFF) + 8);
    const int lo = AP->ph_lo, hi = AP->ph_hi;
#ifndef PHASE_MASK
#define PHASE_MASK 0xFFF
#endif
#define IN(k) (((PHASE_MASK >> (k)) & 1) && lo <= (k) && (k) < hi)
#define SEAM(k) do { if (MK_N_LAUNCHES == 1 && IN((k) + 1)) xcd_barrier(bar); } while (0)
    const int ngw = G * NWAVES;
#define PH_IDS const int tid = my_tid(), lane = tid & 63, wave = __builtin_amdgcn_readfirstlane(tid >> 6), gw = vcu * NWAVES + wave; (void)lane; (void)gw

    if (IN(0)) { asm volatile("" : "+s"(AP)); PH_IDS;
        p0_mod(lds, I_cvec, I_c_ctx, I_mod_w, I_mod_b, MOD, G);
        __syncthreads();
        LAS float* scr = (LAS float*)(lds + wave * 16384);
        constexpr int I0 = 16 * (E_N / 32), I1 = 16 * 32, I2 = 16 * (O_N / 32), I3 = 12 * 24, I4 = 4 * 32, I5 = 16 * 32, NIT = I0 + I1 + I2 + I3 + I4 + I5;
        for (int it = gw; it < NIT; it += ngw) {
            int r = it;
            if (r < I0) { p0_transpose_item(I_e_w_in, 1024, E_N, (bf16_t*)(ws + WS_WEIN), 0, nullptr, scr, r, E_N / 32, lane); continue; } r -= I0;
            if (r < I1) { p0_transpose_item(I_e_w_out, 1024, 1024, (bf16_t*)(ws + WS_WEOUT), 1, nullptr, scr, r, 32, lane); continue; } r -= I1;
            if (r < I2) { p0_transpose_item(I_o_w_in, 1024, O_NSRC, (bf16_t*)(ws + WS_WOIN), 2, nullptr, scr, r, O_N / 32, lane); continue; } r -= I2;
            if (r < I3) { p0_transpose_item(I_o_w_uq, 768, 768, (bf16_t*)(ws + WS_WUQ), 3, I_o_qn, scr, r, 24, lane); continue; } r -= I3;
            if (r < I4) { p0_transpose_item(I_o_w_ukv, 256, 1024, (bf16_t*)(ws + WS_WUKV), 4, I_o_kvn, scr, r, 32, lane); continue; } r -= I4;
            p0_transpose_item(I_o_w_out, 1024, 1024, (bf16_t*)(ws + WS_WOOUT), 5, nullptr, scr, r, 32, lane);
        }
        float* ropeA = (float*)(ws + WS_ROPEA); float* ropeC = (float*)(ws + WS_ROPEC);
        for (int idx = bx * NTHREADS + tid; idx < 2048 * 48; idx += G * NTHREADS) {
            const int pos = idx / 48, j = idx % 48; const float rowf = (float)(pos >> 6), colf = (float)(pos & 63);
            if (j < 32) { const int f = j & 15; const float inv = exp2f(-(float)f * (13.287712379549449f / 16.f)); const float ang = ((j < 16) ? rowf : colf) * inv;
                ropeA[pos * 64 + j] = __cosf(ang); ropeA[pos * 64 + 32 + j] = __sinf(ang); }
            else { const int jj = j - 32, f = jj & 7; const float inv = exp2f(-(float)f * (13.287712379549449f / 8.f)); const float ang = ((jj < 8) ? rowf : colf) * inv;
                ropeC[pos * 32 + jj] = __cosf(ang); ropeC[pos * 32 + 16 + jj] = __sinf(ang); }
        }
        SEAM(0);
    }
    if (IN(1)) { asm volatile("" : "+s"(AP)); PH_IDS; p1_prenorm(I_x, I_ctx, I_pre_w, MOD, (bf16_t*)(ws + WS_H), gw, ngw, lane); SEAM(1); }
    if (IN(2)) { asm volatile("" : "+s"(AP)); PH_IDS;
        pg8::Gemm g{(const bf16_t*)(ws + WS_H), (const bf16_t*)(ws + WS_WEIN), MT, E_N, 1024}; pg8::RectOrder S; S.init(MT / 256, E_N / 256, 0, 0, 0, G, bx);
        EpiEin E{ws}; pg8::gemm_phase<EpiEin, pg8::RectOrder, true, true>(lds, g, S, E);
        SEAM(2);
    }
    if (IN(3)) { asm volatile("" : "+s"(AP)); PH_IDS;
        for (int un = vcu * 4; un < vcu * 4 + 4; ++un) if (un < 1024) attn_unit<0>(lds, ws, I_e_sink, un);
        if (G != 256) for (int un = 4 * G + bx; un < 1024; un += G) attn_unit<0>(lds, ws, I_e_sink, un);
        for (int un = bx; un < 128; un += G) attn_unit<1>(lds, ws, I_e_sink, un);
        p3_conv(ws, I_e_conv_w, bx * NTHREADS + tid, G * NTHREADS);
        SEAM(3);
    }
    if (IN(4)) { asm volatile("" : "+s"(AP)); PH_IDS;
        pg8::Gemm g{(const bf16_t*)(ws + WS_U), (const bf16_t*)(ws + WS_WEOUT), MT, 1024, 1024}; pg8::RectOrder S; S.init(MT / 256, 4, 0, 0, 0, G, bx);
        EpiY E{(bf16_t*)(ws + WS_Y), (float*)(ws + WS_SSQY0)}; pg8::gemm_phase<EpiY, pg8::RectOrder, true, true>(lds, g, S, E);
        SEAM(4);
    }
    if (IN(5)) { asm volatile("" : "+s"(AP)); PH_IDS; p5_post_pre(I_x, I_ctx, I_post_w, I_pre_w + 1024, MOD, (const bf16_t*)(ws + WS_Y), (const float*)(ws + WS_SSQY0), I_out, (bf16_t*)(ws + WS_H), gw, ngw, lane); SEAM(5); }
    if (IN(6)) { asm volatile("" : "+s"(AP)); PH_IDS;
        pg8::Gemm g{(const bf16_t*)(ws + WS_H), (const bf16_t*)(ws + WS_WOIN), MT, O_N, 1024}; pg8::RectOrder S; S.init(ML / 256, O_N / 256, ML / 256, MC / 256, 5, G, bx);
        EpiOin E{ws}; pg8::gemm_phase<EpiOin, pg8::RectOrder, true, true>(lds, g, S, E);
        SEAM(6);
    }
    if (IN(7)) { asm volatile("" : "+s"(AP)); PH_IDS;
        { pg8::Gemm g{(const bf16_t*)(ws + WS_CQ), (const bf16_t*)(ws + WS_WUQ), ML, 768, 768}; pg8::RectOrder S; S.init(ML / 256, 3, 0, 0, 0, G, bx);
          EpiUq E{ws}; pg8::gemm_phase<EpiUq, pg8::RectOrder, true, true>(lds, g, S, E); }
        __syncthreads();
        { pg8::Gemm g{(const bf16_t*)(ws + WS_CKV), (const bf16_t*)(ws + WS_WUKV), MT, 1024, 256}; pg8::RectOrder S; S.init(MT / 256, 4, 0, 0, 0, G, G - 1 - bx);
          EpiUkv E{ws}; pg8::gemm_phase<EpiUkv, pg8::RectOrder, true, true>(lds, g, S, E); }
        SEAM(7);
    }
    if (IN(8)) { asm volatile("" : "+s"(AP)); PH_IDS;
        for (int ch = bx; ch < 256; ch += G) mlstm_chain(lds, ws, I_o_ib, I_o_fb, ch);
        for (int un = vcu * 4; un < vcu * 4 + 4; ++un) if (un < 1024) attn_unit<2>(lds, ws, nullptr, un);
        if (G != 256) for (int un = 4 * G + bx; un < 1024; un += G) attn_unit<2>(lds, ws, nullptr, un);
        SEAM(8);
    }
    if (IN(9)) { asm volatile("" : "+s"(AP)); PH_IDS; p9_readout(ws, I_o_hn, gw, ngw, lane); SEAM(9); }
    if (IN(10)) { asm volatile("" : "+s"(AP)); PH_IDS;
        pg8::Gemm g{(const bf16_t*)(ws + WS_U), (const bf16_t*)(ws + WS_WOOUT), ML, 1024, 1024}; pg8::RectOrder S; S.init(ML / 256, 4, 0, 0, 0, G, bx);
        EpiY E{(bf16_t*)(ws + WS_Y), (float*)(ws + WS_SSQY1)}; pg8::gemm_phase<EpiY, pg8::RectOrder, true, true>(lds, g, S, E);
        SEAM(10);
    }
    if (IN(11)) { asm volatile("" : "+s"(AP)); PH_IDS; p11_final(I_post_w + 1024, MOD, (const bf16_t*)(ws + WS_Y), (const float*)(ws + WS_SSQY1), I_out, gw, ngw, lane); }
#undef IN
#undef SEAM
#undef I_x
#undef I_cvec
#undef I_ctx
#undef I_c_ctx
#undef I_mod_w
#undef I_mod_b
#undef I_pre_w
#undef I_post_w
#undef I_e_w_in
#undef I_e_sink
#undef I_e_conv_w
#undef I_e_w_out
#undef I_o_w_in
#undef I_o_qn
#undef I_o_kvn
#undef I_o_w_uq
#undef I_o_w_ukv
#undef I_o_ib
#undef I_o_fb
#undef I_o_hn
#undef I_o_w_out
#undef I_out
}

extern "C" void kernel_launch(void* const* d_in, const int* in_sizes, int n_in, void* d_out, int out_size, void* d_ws, size_t ws_size, hipStream_t stream) {
    static int grid = 0;
    if (grid == 0) {
        if (n_in != 21 || in_sizes[0] != ML * DM || out_size != ML * DM || ws_size < WS_END) { fprintf(stderr, "kernel_launch: unexpected shapes / workspace (n_in %d, ws %zu < %zu); nothing launched\n", n_in, ws_size, (size_t)WS_END); grid = -1; return; }
        int dev = 0, cus = 0, per_cu = 0;
        if (hipGetDevice(&dev) != hipSuccess || hipDeviceGetAttribute(&cus, hipDeviceAttributeMultiprocessorCount, dev) != hipSuccess) { grid = -1; return; }
        if (hipFuncSetAttribute((const void*)hybrid_fwd, hipFuncAttributeMaxDynamicSharedMemorySize, LDS_BYTES) != hipSuccess) { fprintf(stderr, "kernel_launch: hipFuncSetAttribute failed\n"); grid = -1; return; }
        if (hipOccupancyMaxActiveBlocksPerMultiprocessor(&per_cu, (const void*)hybrid_fwd, NTHREADS, LDS_BYTES) != hipSuccess || per_cu < 1) fprintf(stderr, "kernel_launch: note: occupancy query reports %d workgroups per CU\n", per_cu);
        (void)hipGetLastError();
        grid = cus;
    }
    if (grid < 0) return;
    if (hipMemsetAsync((char*)d_ws + WS_CTL, 0, CTL_ZERO_BYTES, stream) != hipSuccess) { fprintf(stderr, "kernel_launch: hipMemsetAsync failed\n"); return; }
    Args a{};
    for (int i = 0; i < 21; ++i) a.in[i] = (const float*)d_in[i];
    a.out = (float*)d_out; a.ws = (unsigned char*)d_ws;
    if (MK_N_LAUNCHES == 1) { a.ph_lo = 0; a.ph_hi = N_PHASES; hipLaunchKernelGGL(hybrid_fwd, dim3(grid), dim3(NTHREADS), LDS_BYTES, stream, a); }
    else for (int p = 0; p < N_PHASES; ++p) { a.ph_lo = p; a.ph_hi = p + 1; hipLaunchKernelGGL(hybrid_fwd, dim3(grid), dim3(NTHREADS), LDS_BYTES, stream, a); }
    const hipError_t le = hipPeekAtLastError();
    if (le != hipSuccess) fprintf(stderr, "kernel_launch: launch failed: %s\n", hipGetErrorName(le));
}
```

```cpp
#include <hip/hip_runtime.h>
#include <cstdio>
#include <cstdint>

#define LAS __attribute__((address_space(3)))
#define GAS __attribute__((address_space(1)))
typedef unsigned short bf16_t;
typedef short bf16x8 __attribute__((ext_vector_type(8)));
typedef short s16x4 __attribute__((ext_vector_type(4)));
typedef float f32x4 __attribute__((ext_vector_type(4)));
typedef float f32x16 __attribute__((ext_vector_type(16)));
typedef unsigned u32x4 __attribute__((ext_vector_type(4)));
typedef unsigned u32x2 __attribute__((ext_vector_type(2)));
typedef float f32x2_t __attribute__((ext_vector_type(2)));
typedef __bf16 bf16x2_t __attribute__((ext_vector_type(2)));

constexpr int NB = 16, SEQ = 2048, DM = 1024, CL = 256;
constexpr int ML = NB * SEQ, MC = NB * CL, MT = ML + MC;
constexpr float EPS = 1e-6f, LOG2E = 1.4426950408889634f;
constexpr int E_N = 3328, O_NSRC = 3632, O_N = 3840;
constexpr int NWAVES = 8, NTHREADS = 512;

__device__ __forceinline__ float bf_lo(unsigned w) { return __uint_as_float(w << 16); }
__device__ __forceinline__ float bf_hi(unsigned w) { return __uint_as_float(w & 0xffff0000u); }
__device__ __forceinline__ unsigned pk2(float lo, float hi) { f32x2_t v = {lo, hi}; bf16x2_t b = __builtin_convertvector(v, bf16x2_t); return __builtin_bit_cast(unsigned, b); }
__device__ __forceinline__ float silu_f(float x) { return x * __builtin_amdgcn_rcpf(1.f + __expf(-x)); }
__device__ __forceinline__ float sigmoid_f(float x) { return __builtin_amdgcn_rcpf(1.f + __expf(-x)); }
__device__ __forceinline__ float wave_sum(float v) {
#pragma unroll
    for (int o = 1; o < 64; o <<= 1) v += __shfl_xor(v, o);
    return v;
}
#define LDS_WAIT() asm volatile("s_waitcnt lgkmcnt(0)" ::: "memory")
#define VM_WAIT() asm volatile("s_waitcnt vmcnt(0)" ::: "memory")

__device__ __forceinline__ int my_tid() { int t = threadIdx.x; asm volatile("" : "+v"(t)); return t; }

namespace pg8 {
#define PG8_LAS __attribute__((address_space(3)))
typedef unsigned short bf16_t;
typedef short bf16x8 __attribute__((ext_vector_type(8)));
typedef float f32x4 __attribute__((ext_vector_type(4)));
typedef unsigned u32x4 __attribute__((ext_vector_type(4)));
constexpr int BM = 256, BK = 64, HALF = 128, HTB = HALF * BK * 2  , STAGE_BYTES = 8 * HTB, NXCD = 8, WGM = 8;

__host__ __device__ __forceinline__ int lds_byte(int r, int c) { const int st = (r >> 4) * 2 + (c >> 5), rr = r & 15, cc = c & 31, ob = rr * 64 + cc * 2; return st * 1024 + (ob ^ (((ob >> 9) & 1) << 5)); }
__host__ __device__ __forceinline__ void stage_rc(int b, int& R, int& C) { const int st = b / 1024, sb = b % 1024, swz = sb ^ (((sb >> 9) & 1) << 5); R = (st >> 1) * 16 + swz / 64; C = (st & 1) * 32 + (swz % 64) / 2; }
__host__ __device__ __forceinline__ int perm32(int rho) { const int n = rho >> 4, i = rho & 15; return 8 * (i >> 2) + 4 * n + (i & 3); }

struct Unit { int pm, pn; };
struct Gemm { const bf16_t* A; const bf16_t* Bt; int M, N, K; };

struct RectOrder {
    int nM0, nN0, n0, pm1, nM1, nN1, n1, G, c;
    __device__ __forceinline__ void init(int nM0_, int nN0_, int pm1_, int nM1_, int nN1_, int G_, int c_) { nM0 = nM0_; nN0 = nN0_; n0 = nM0_ * nN0_; pm1 = pm1_; nM1 = nM1_; nN1 = nN1_; n1 = nM1_ * nN1_; G = G_; c = c_; }
    __device__ __forceinline__ static void rect(int w, int nM, int nN, int& pm, int& pn) {
        const int nig = WGM * nN, gid = w / nig, fm = gid * WGM, gsz = (nM - fm) < WGM ? (nM - fm) : WGM;
        pm = fm + ((w % nig) % gsz); pn = (w % nig) / gsz;
    }
    __device__ __forceinline__ bool next(int i, Unit& u) const {
        const int nwg = n0 + n1; const long L = (long)i * G + c; if (L >= nwg) return false;
        int wgid = (int)L; { const int q = nwg / NXCD, r = nwg % NXCD, xcd = wgid % NXCD, off = wgid / NXCD; wgid = (xcd < r ? xcd * (q + 1) : r * (q + 1) + (xcd - r) * q) + off; }
        if (wgid < n0) rect(wgid, nM0, nN0, u.pm, u.pn); else { rect(wgid - n0, nM1, nN1, u.pm, u.pn); u.pm += pm1; }
        return true;
    }
    __device__ __forceinline__ void a_ready(const Unit&) const {}
    __device__ __forceinline__ void done(const Unit&) const {}
};

template <class Epi, class Sched, bool ALIGN_EPI = false, bool SP2 = false>
__device__ __forceinline__ void gemm_phase(PG8_LAS unsigned char* lds, const Gemm g, const Sched& S, const Epi& E) {
    const int tid = my_tid(), wid = __builtin_amdgcn_readfirstlane(tid >> 6), lane = tid & 63, wr = wid >> 2, wc = wid & 3, fr = lane & 15, fq = lane >> 4;
    const int K = g.K, nt = K / BK;
    unsigned voffA[2], voffB[2];
#pragma unroll
    for (int i = 0; i < 2; ++i) { int R, C; stage_rc(tid * 16 + i * 8192, R, C); const int Rb = Epi::PERM ? ((R & ~31) + perm32(R & 31)) : R;
        voffA[i] = (unsigned)(R * K + C) * 2u; voffB[i] = (unsigned)(Rb * K + C) * 2u; }
    const size_t kstep = (size_t)(BK * 2);
    const size_t hstep = (size_t)HALF * K * 2;
    const size_t tstep = 2 * hstep;
    const unsigned ldsw = (unsigned)wid * 1024u;
    const int aoff = lds_byte(wr * 64 + fr, fq * 8), boff = lds_byte(wc * 32 + fr, fq * 8);
#define PG8_SA(b, h) (((b) * 2 + (h)) * HTB)
#define PG8_SB(b, h) ((4 + (b) * 2 + (h)) * HTB)
#define PG8_STAGE(bufoff, gbase, voff) do { _Pragma("unroll") for (int _i = 0; _i < 2; ++_i) \
        __builtin_amdgcn_global_load_lds((const unsigned*)((const char*)(gbase) + (voff)[_i]), (PG8_LAS unsigned*)(lds + (bufoff) + ldsw + _i * 8192), 16, 0, 0); } while (0)
#define PG8_LDA(dst, b, h) do { _Pragma("unroll") for (int m = 0; m < 4; ++m) _Pragma("unroll") for (int k = 0; k < 2; ++k) dst[m][k] = *(const PG8_LAS bf16x8*)(lds + PG8_SA(b, h) + aoff + m * 2048 + k * 1024); } while (0)
#define PG8_LDB(dst, b, h) do { _Pragma("unroll") for (int n = 0; n < 2; ++n) _Pragma("unroll") for (int k = 0; k < 2; ++k) dst[n][k] = *(const PG8_LAS bf16x8*)(lds + PG8_SB(b, h) + boff + n * 2048 + k * 1024); } while (0)
#define PG8_MMA(ai, bj, At, Bt) do { __builtin_amdgcn_s_setprio(1); _Pragma("unroll") for (int m = 0; m < 4; ++m) _Pragma("unroll") for (int n = 0; n < 2; ++n) _Pragma("unroll") for (int k = 0; k < 2; ++k) \
        acc[ai][bj][m][n] = __builtin_amdgcn_mfma_f32_16x16x32_bf16(Bt[n][k], At[m][k], acc[ai][bj][m][n], 0, 0, 0); __builtin_amdgcn_s_setprio(0); } while (0)
#define PG8_WAIT_V(n) asm volatile("s_waitcnt vmcnt(" #n ")" ::: "memory")
#define PG8_WAIT_L(n) asm volatile("s_waitcnt lgkmcnt(" #n ")" ::: "memory")
#define PG8_BAR __builtin_amdgcn_s_barrier()
#define PG8_SCHED __builtin_amdgcn_sched_barrier(0)
    Unit cur, nxt; int ui = 0;
    if (!S.next(0, cur)) return;
    f32x4 acc[2][2][4][2];
#pragma unroll
    for (int a = 0; a < 2; ++a)
#pragma unroll
        for (int b = 0; b < 2; ++b)
#pragma unroll
            for (int m = 0; m < 4; ++m)
#pragma unroll
                for (int n = 0; n < 2; ++n) acc[a][b][m][n] = (f32x4){0.f, 0.f, 0.f, 0.f};
    bf16x8 At[4][2], B0[2][2], B1[2][2];
    const char* cA = (const char*)g.A + (size_t)cur.pm * tstep; const char* cB = (const char*)g.Bt + (size_t)cur.pn * tstep;
    S.a_ready(cur);
    if constexpr (SP2) {
        PG8_STAGE(PG8_SB(0, 0), cB, voffB); PG8_STAGE(PG8_SB(0, 1), cB + hstep, voffB); PG8_STAGE(PG8_SA(0, 0), cA, voffA); PG8_STAGE(PG8_SA(0, 1), cA + hstep, voffA);
        if (wr == 1) PG8_BAR;
        PG8_WAIT_V(2); PG8_BAR;
        PG8_STAGE(PG8_SB(1, 0), cB + kstep, voffB); PG8_STAGE(PG8_SA(1, 0), cA + kstep, voffA); PG8_STAGE(PG8_SB(1, 1), cB + hstep + kstep, voffB);
        PG8_WAIT_V(6); PG8_BAR;
    } else {
        PG8_STAGE(PG8_SB(0, 0), cB, voffB); PG8_STAGE(PG8_SA(0, 0), cA, voffA); PG8_STAGE(PG8_SB(0, 1), cB + hstep, voffB); PG8_STAGE(PG8_SA(0, 1), cA + hstep, voffA);
        if (wr == 1) PG8_BAR;
        PG8_WAIT_V(4); PG8_BAR;
        PG8_STAGE(PG8_SB(1, 0), cB + kstep, voffB); PG8_STAGE(PG8_SA(1, 0), cA + kstep, voffA); PG8_STAGE(PG8_SB(1, 1), cB + hstep + kstep, voffB);
        PG8_WAIT_V(6); PG8_BAR;
    }
    for (;;) {
        const bool has_next = S.next(ui + 1, nxt);
        const char* nA = has_next ? (const char*)g.A + (size_t)nxt.pm * tstep : cA; const char* nB = has_next ? (const char*)g.Bt + (size_t)nxt.pn * tstep : cB;
        for (int t = 0; t < nt; t += 2) {
            const bool last = (t == nt - 2);
            const char* a1 = cA + (size_t)(t + 1) * kstep;
            const char* a2 = last ? nA : cA + (size_t)(t + 2) * kstep; const char* b2 = last ? nB : cB + (size_t)(t + 2) * kstep;
            const char* a3 = a2 + kstep; const char* b3 = b2 + kstep;
            if (last && has_next) S.a_ready(nxt);
            if constexpr (SP2) {
            PG8_LDB(B0, 0, 0); PG8_LDB(B1, 0, 1); PG8_SCHED; PG8_LDA(At, 0, 0); PG8_STAGE(PG8_SA(1, 1), a1 + hstep, voffA);
            PG8_WAIT_V(8); PG8_WAIT_L(0); PG8_BAR; PG8_MMA(0, 0, At, B0); PG8_MMA(0, 1, At, B1); PG8_BAR; PG8_SCHED;
            PG8_LDA(At, 0, 1); PG8_STAGE(PG8_SB(0, 0), b2, voffB); PG8_STAGE(PG8_SB(0, 1), b2 + hstep, voffB); PG8_STAGE(PG8_SA(0, 0), a2, voffA);
            PG8_WAIT_V(8); PG8_WAIT_L(0); PG8_BAR; PG8_MMA(1, 0, At, B0); PG8_MMA(1, 1, At, B1); PG8_BAR; PG8_SCHED;
            PG8_LDB(B0, 1, 0); PG8_LDB(B1, 1, 1); PG8_SCHED; PG8_LDA(At, 1, 0); PG8_STAGE(PG8_SA(0, 1), a2 + hstep, voffA);
            PG8_WAIT_V(8); PG8_WAIT_L(0); PG8_BAR; PG8_MMA(0, 0, At, B0); PG8_MMA(0, 1, At, B1); PG8_BAR; PG8_SCHED;
            PG8_LDA(At, 1, 1); PG8_STAGE(PG8_SB(1, 0), b3, voffB); PG8_STAGE(PG8_SB(1, 1), b3 + hstep, voffB); PG8_STAGE(PG8_SA(1, 0), a3, voffA);
            PG8_WAIT_V(8); PG8_WAIT_L(0); PG8_BAR; PG8_MMA(1, 0, At, B0); PG8_MMA(1, 1, At, B1); PG8_BAR; PG8_SCHED;
            } else {
            PG8_LDB(B0, 0, 0); PG8_SCHED; PG8_LDA(At, 0, 0); PG8_STAGE(PG8_SA(1, 1), a1 + hstep, voffA);
            PG8_WAIT_L(8); PG8_BAR; PG8_WAIT_L(0); PG8_MMA(0, 0, At, B0); PG8_BAR; PG8_SCHED;
            PG8_LDB(B1, 0, 1); PG8_STAGE(PG8_SB(0, 0), b2, voffB);
            PG8_BAR; PG8_WAIT_L(0); PG8_MMA(0, 1, At, B1); PG8_BAR;
            PG8_LDA(At, 0, 1); PG8_STAGE(PG8_SA(0, 0), a2, voffA);
            PG8_BAR; PG8_WAIT_L(0); PG8_MMA(1, 0, At, B0); PG8_BAR; PG8_SCHED;
            PG8_STAGE(PG8_SB(0, 1), b2 + hstep, voffB);
            PG8_WAIT_V(6); PG8_BAR; PG8_MMA(1, 1, At, B1); PG8_BAR;
            PG8_LDB(B0, 1, 0); PG8_SCHED; PG8_LDA(At, 1, 0); PG8_STAGE(PG8_SA(0, 1), a2 + hstep, voffA);
            PG8_WAIT_L(8); PG8_BAR; PG8_WAIT_L(0); PG8_MMA(0, 0, At, B0); PG8_BAR; PG8_SCHED;
            PG8_LDB(B1, 1, 1); PG8_STAGE(PG8_SB(1, 0), b3, voffB);
            PG8_BAR; PG8_WAIT_L(0); PG8_MMA(0, 1, At, B1); PG8_BAR;
            PG8_LDA(At, 1, 1); PG8_STAGE(PG8_SA(1, 0), a3, voffA);
            PG8_BAR; PG8_WAIT_L(0); PG8_MMA(1, 0, At, B0); PG8_BAR; PG8_SCHED;
            PG8_STAGE(PG8_SB(1, 1), b3 + hstep, voffB);
            PG8_WAIT_V(6); PG8_BAR; PG8_MMA(1, 1, At, B1); PG8_BAR;
            }
        }
        if constexpr (ALIGN_EPI) { if (wr == 0) PG8_BAR; }
        if constexpr (!Epi::AFTER_DRAIN) { E(acc, cur, wr, wc, fr, fq); S.done(cur); }
        if (!has_next) break;
#pragma unroll
        for (int a = 0; a < 2; ++a)
#pragma unroll
            for (int b = 0; b < 2; ++b)
#pragma unroll
                for (int m = 0; m < 4; ++m)
#pragma unroll
                    for (int n = 0; n < 2; ++n) acc[a][b][m][n] = (f32x4){0.f, 0.f, 0.f, 0.f};
        cur = nxt; cA = nA; cB = nB; ++ui;
        if constexpr (ALIGN_EPI) { if (wr == 1) PG8_BAR; }
    }
    PG8_WAIT_V(0);
    if constexpr (!ALIGN_EPI) { if (wr == 0) PG8_BAR; }
    PG8_BAR;
    if constexpr (Epi::AFTER_DRAIN) { E.fused(acc, cur, wr, wc, fr, fq, lds, wid, lane); S.done(cur); }
#undef PG8_SA
#undef PG8_SB
#undef PG8_STAGE
#undef PG8_LDA
#undef PG8_LDB
#undef PG8_MMA
#undef PG8_WAIT_V
#undef PG8_WAIT_L
#undef PG8_BAR
#undef PG8_SCHED
}
}

constexpr size_t MiB = 1u << 20;
constexpr size_t WS_CTL = 0, CTL_ZERO_BYTES = 1 * MiB;
constexpr size_t WS_MOD = 1 * MiB;
constexpr size_t WS_ROPEA = 2 * MiB;
constexpr size_t WS_ROPEC = 2 * MiB + 512 * 1024;
constexpr size_t WS_WEIN = 3 * MiB, WS_WEOUT = 10 * MiB, WS_WOIN = 12 * MiB, WS_WUQ = 20 * MiB, WS_WUKV = 21 * MiB + 512 * 1024, WS_WOOUT = 22 * MiB;
constexpr size_t WS_H = 24 * MiB;
constexpr size_t WS_U = 96 * MiB;
constexpr size_t WS_Y = 168 * MiB;
constexpr size_t WS_R = 240 * MiB;
constexpr size_t WS_KVE = WS_R  , WS_QE = WS_R + 18 * MiB, WS_PE = WS_R + 54 * MiB, WS_GE = WS_R + 90 * MiB, WS_ZA = WS_R + 126 * MiB, WS_SSQY0 = WS_R + 162 * MiB;
constexpr size_t WS_CKV = WS_R, WS_CQ = WS_R + 18 * MiB, WS_HM = WS_R  , WS_MK = WS_R + 66 * MiB, WS_MV = WS_R + 84 * MiB, WS_KR = WS_R + 120 * MiB, WS_GATES = WS_R + 123 * MiB,
                 WS_SSQCKV = WS_R + 126 * MiB, WS_SSQCQ = WS_R + 127 * MiB, WS_MQ = WS_R + 129 * MiB, WS_MO = WS_R + 145 * MiB, WS_ZO = WS_R + 177 * MiB, WS_SSQY1 = WS_R + 241 * MiB;
constexpr size_t WS_KNV = WS_H  , WS_QO = WS_Y;
constexpr size_t WS_END = WS_R + 244 * MiB;
static_assert(WS_SSQY0 + (size_t)MT * 16 * 4 <= WS_R + 165 * MiB && WS_HM + (size_t)2 * ML * 512 * 2 <= WS_MK && WS_SSQY1 + (size_t)MT * 16 * 4 <= WS_END, "ws map");

__device__ __forceinline__ void st8(bf16_t* p, f32x4 a, f32x4 b) { u32x4 w; w.x = pk2(a[0], a[1]); w.y = pk2(a[2], a[3]); w.z = pk2(b[0], b[1]); w.w = pk2(b[2], b[3]); *(u32x4*)p = w; }
__device__ __forceinline__ bf16_t f2bf(float v) { return (bf16_t)(pk2(v, 0.f) & 0xffffu); }
__device__ __forceinline__ void rope8(f32x4& a, f32x4& b, const float* cosp, const float* sinp) {
    const f32x4 cs = *(const f32x4*)cosp, sn = *(const f32x4*)sinp;
    const float a0 = a[0] * cs[0] - a[1] * sn[0], a1 = a[0] * sn[0] + a[1] * cs[0], a2 = a[2] * cs[1] - a[3] * sn[1], a3 = a[2] * sn[1] + a[3] * cs[1];
    const float b0 = b[0] * cs[2] - b[1] * sn[2], b1 = b[0] * sn[2] + b[1] * cs[2], b2 = b[2] * cs[3] - b[3] * sn[3], b3 = b[2] * sn[3] + b[3] * cs[3];
    a = (f32x4){a0, a1, a2, a3}; b = (f32x4){b0, b1, b2, b3};
}
__device__ __forceinline__ f32x4 silu4(f32x4 v) { return (f32x4){silu_f(v[0]), silu_f(v[1]), silu_f(v[2]), silu_f(v[3])}; }
__device__ __forceinline__ f32x4 sigm4(f32x4 v) { return (f32x4){sigmoid_f(v[0]), sigmoid_f(v[1]), sigmoid_f(v[2]), sigmoid_f(v[3])}; }
__device__ __forceinline__ float sq4(f32x4 v) { return (v[0] * v[0] + v[1] * v[1]) + (v[2] * v[2] + v[3] * v[3]); }

struct EpiEin {
    static constexpr bool PERM = true, AFTER_DRAIN = false;
    unsigned char* ws;
    __device__ __forceinline__ void operator()(const f32x4 (&acc)[2][2][4][2], const pg8::Unit& u, int wr, int wc, int fr, int fq) const {
        const int pn = u.pn, rbase = u.pm * 256 + wr * 64 + fr, cw = wc * 32 + 8 * fq;
        const float* ropeA = (const float*)(ws + WS_ROPEA);
#pragma unroll
        for (int ai = 0; ai < 2; ++ai)
#pragma unroll
            for (int m = 0; m < 4; ++m) {
                asm volatile("" ::: "memory"); const int R = rbase + ai * 128 + m * 16; const bool lat = R < ML; const int pos = R & 2047;
                if (pn == 0) {
                    f32x4 a = acc[ai][0][m][0], b = acc[ai][0][m][1];
                    if (lat) { const int i0 = (cw & 63) >> 1; rope8(a, b, ropeA + pos * 64 + i0, ropeA + pos * 64 + 32 + i0); }
                    st8((bf16_t*)(ws + WS_KVE) + (size_t)R * 256 + cw, a, b);
                    st8((bf16_t*)(ws + WS_KVE) + (size_t)R * 256 + 128 + cw, acc[ai][1][m][0], acc[ai][1][m][1]);
                } else if (pn <= 2) {
#pragma unroll
                    for (int bj = 0; bj < 2; ++bj) {
                        f32x4 a = acc[ai][bj][m][0], b = acc[ai][bj][m][1];
                        if (lat) { const int i0 = (cw & 63) >> 1; rope8(a, b, ropeA + pos * 64 + i0, ropeA + pos * 64 + 32 + i0); }
                        const float sc = 0.125f * LOG2E; a = a * sc; b = b * sc;
                        st8((bf16_t*)(ws + WS_QE) + (size_t)R * 512 + (pn - 1) * 256 + bj * 128 + cw, a, b);
                    }
                } else if (pn <= 6) {
                    st8((bf16_t*)(ws + WS_PE) + (size_t)R * 512 + (pn - 3) * 128 + cw, acc[ai][0][m][0] * acc[ai][1][m][0], acc[ai][0][m][1] * acc[ai][1][m][1]);
                } else if (pn <= 10) {
                    st8((bf16_t*)(ws + WS_GE) + (size_t)R * 512 + (pn - 7) * 128 + cw, acc[ai][0][m][0] * silu4(acc[ai][1][m][0]), acc[ai][0][m][1] * silu4(acc[ai][1][m][1]));
                } else {
#pragma unroll
                    for (int bj = 0; bj < 2; ++bj)
                        st8((bf16_t*)(ws + WS_ZA) + (size_t)R * 512 + (pn - 11) * 256 + bj * 128 + cw, silu4(acc[ai][bj][m][0]), silu4(acc[ai][bj][m][1]));
                }
            }
    }
};

struct EpiY {
    static constexpr bool PERM = true, AFTER_DRAIN = false;
    bf16_t* Y; float* SSQ;
    __device__ __forceinline__ void operator()(const f32x4 (&acc)[2][2][4][2], const pg8::Unit& u, int wr, int wc, int fr, int fq) const {
        const int pn = u.pn, rbase = u.pm * 256 + wr * 64 + fr, cw = wc * 32 + 8 * fq;
#pragma unroll
        for (int ai = 0; ai < 2; ++ai)
#pragma unroll
            for (int m = 0; m < 4; ++m) {
                asm volatile("" ::: "memory"); const int R = rbase + ai * 128 + m * 16; float s = 0.f;
#pragma unroll
                for (int bj = 0; bj < 2; ++bj) { st8(Y + (size_t)R * 1024 + pn * 256 + bj * 128 + cw, acc[ai][bj][m][0], acc[ai][bj][m][1]); s += sq4(acc[ai][bj][m][0]) + sq4(acc[ai][bj][m][1]); }
                s += __shfl_xor(s, 16); s += __shfl_xor(s, 32);
                if (fq == 0) SSQ[(size_t)R * 16 + pn * 4 + wc] = s;
            }
    }
};

struct EpiOin {
    static constexpr bool PERM = true, AFTER_DRAIN = false;
    unsigned char* ws;
    __device__ __forceinline__ void operator()(const f32x4 (&acc)[2][2][4][2], const pg8::Unit& u, int wr, int wc, int fr, int fq) const {
        const int pn = u.pn, rbase = u.pm * 256 + wr * 64 + fr, cw = wc * 32 + 8 * fq;
        const float* ropeC = (const float*)(ws + WS_ROPEC);
#pragma unroll
        for (int ai = 0; ai < 2; ++ai)
#pragma unroll
            for (int m = 0; m < 4; ++m) {
                asm volatile("" ::: "memory"); const int R = rbase + ai * 128 + m * 16; const bool lat = R < ML; const int pos = R & 2047;
                if (pn == 0 || (pn >= 5 && pn <= 7)) {
                    float s = 0.f;
                    bf16_t* dst = (pn == 0) ? (bf16_t*)(ws + WS_CKV) + (size_t)R * 256 : (bf16_t*)(ws + WS_CQ) + (size_t)R * 768 + (pn - 5) * 256;
#pragma unroll
                    for (int bj = 0; bj < 2; ++bj) { st8(dst + bj * 128 + cw, acc[ai][bj][m][0], acc[ai][bj][m][1]); s += sq4(acc[ai][bj][m][0]) + sq4(acc[ai][bj][m][1]); }
                    s += __shfl_xor(s, 16); s += __shfl_xor(s, 32);
                    if (fq == 0) { if (pn == 0) ((float*)(ws + WS_SSQCKV))[(size_t)R * 4 + wc] = s; else ((float*)(ws + WS_SSQCQ))[(size_t)R * 12 + (pn - 5) * 4 + wc] = s; }
                } else if (pn == 4) {
                    if (wc == 0) {
                        f32x4 a = acc[ai][0][m][0], b = acc[ai][0][m][1];
                        if (lat) { const int i0 = cw >> 1; rope8(a, b, ropeC + pos * 32 + i0, ropeC + pos * 32 + 16 + i0); }
                        st8((bf16_t*)(ws + WS_KR) + (size_t)R * 32 + cw, a, b);
                    } else if (wc == 1 && fq < 2) {
                        float* g = (float*)(ws + WS_GATES) + (size_t)R * 16 + 8 * fq;
                        *(f32x4*)g = acc[ai][0][m][0]; *(f32x4*)(g + 4) = acc[ai][0][m][1];
                    }
                } else {
#pragma unroll
                    for (int bj = 0; bj < 2; ++bj) {
                        const f32x4 a = acc[ai][bj][m][0], b = acc[ai][bj][m][1]; const int col = bj * 128 + cw;
                        if (pn == 1) st8((bf16_t*)(ws + WS_MK) + (size_t)R * 256 + col, a * 0.125f, b * 0.125f);
                        else if (pn <= 3) st8((bf16_t*)(ws + WS_MV) + (size_t)R * 512 + (pn - 2) * 256 + col, a, b);
                        else if (pn == 8) st8((bf16_t*)(ws + WS_MQ) + (size_t)R * 256 + col, a, b);
                        else if (pn <= 10) st8((bf16_t*)(ws + WS_MO) + (size_t)R * 512 + (pn - 9) * 256 + col, sigm4(a), sigm4(b));
                        else st8((bf16_t*)(ws + WS_ZO) + (size_t)R * 1024 + (pn - 11) * 256 + col, silu4(a), silu4(b));
                    }
                }
            }
    }
};

struct EpiUkv {
    static constexpr bool PERM = true, AFTER_DRAIN = false;
    unsigned char* ws;
    __device__ __forceinline__ void operator()(const f32x4 (&acc)[2][2][4][2], const pg8::Unit& u, int wr, int wc, int fr, int fq) const {
        const int pn = u.pn, rbase = u.pm * 256 + wr * 64 + fr, cw = wc * 32 + 8 * fq;
#pragma unroll
        for (int ai = 0; ai < 2; ++ai)
#pragma unroll
            for (int m = 0; m < 4; ++m) {
                asm volatile("" ::: "memory"); const int R = rbase + ai * 128 + m * 16;
                const f32x4 sp = *(const f32x4*)((const float*)(ws + WS_SSQCKV) + (size_t)R * 4);
                const float rstd = rsqrtf(((sp[0] + sp[1]) + (sp[2] + sp[3])) * (1.f / 256.f) + EPS);
                int b, pos; if (R < ML) { b = R >> 11; pos = 256 + (R & 2047); } else { const int rc = R - ML; b = rc >> 8; pos = rc & 255; }
#pragma unroll
                for (int bj = 0; bj < 2; ++bj) {
                    const int head = pn * 2 + bj;
                    st8((bf16_t*)(ws + WS_KNV) + ((size_t)(b * 8 + head) * 2304 + pos) * 128 + cw, acc[ai][bj][m][0] * rstd, acc[ai][bj][m][1] * rstd);
                }
            }
    }
};

struct EpiUq {
    static constexpr bool PERM = true, AFTER_DRAIN = false;
    unsigned char* ws;
    __device__ __forceinline__ void operator()(const f32x4 (&acc)[2][2][4][2], const pg8::Unit& u, int wr, int wc, int fr, int fq) const {
        const int pn = u.pn, rbase = u.pm * 256 + wr * 64 + fr, cw = wc * 32 + 8 * fq;
        const float* ropeC = (const float*)(ws + WS_ROPEC);
#pragma unroll
        for (int ai = 0; ai < 2; ++ai)
#pragma unroll
            for (int m = 0; m < 4; ++m) {
                asm volatile("" ::: "memory"); const int R = rbase + ai * 128 + m * 16, pos = R & 2047;
                const float* sp = (const float*)(ws + WS_SSQCQ) + (size_t)R * 12;
                const f32x4 s0 = *(const f32x4*)sp, s1 = *(const f32x4*)(sp + 4), s2 = *(const f32x4*)(sp + 8);
                const float ss = (((s0[0] + s0[1]) + (s0[2] + s0[3])) + ((s1[0] + s1[1]) + (s1[2] + s1[3]))) + ((s2[0] + s2[1]) + (s2[2] + s2[3]));
                const float sc = rsqrtf(ss * (1.f / 768.f) + EPS) * (0.10206207261596575f * LOG2E);
#pragma unroll
                for (int bj = 0; bj < 2; ++bj) {
                    const int c = pn * 256 + bj * 128 + cw, head = c / 96, dd = c - head * 96;
                    f32x4 a = acc[ai][bj][m][0], b = acc[ai][bj][m][1];
                    if (dd >= 64) { const int i0 = (dd - 64) >> 1; rope8(a, b, ropeC + pos * 32 + i0, ropeC + pos * 32 + 16 + i0); }
                    st8((bf16_t*)(ws + WS_QO) + (size_t)R * 768 + c, a * sc, b * sc);
                }
            }
    }
};

#define RLX_AGENT __ATOMIC_RELAXED, __HIP_MEMORY_SCOPE_AGENT
#define XB_TMO      128
#define XB_XCNT(j)  (256  + 64 * (j))
#define XB_XSUB(j)  (1280 + 64 * (j))
#define XB_XGEN(j)  (2304 + 64 * (j))
#define XB_TOP      3328
#define XB_TOPGEN   3392
#define XCD_BAR_WORDS 3456
#define XB_SPIN_CAP (1u << 18)

__device__ __forceinline__ unsigned xb_ld(unsigned* p)              { return __hip_atomic_load(p, __ATOMIC_RELAXED, __HIP_MEMORY_SCOPE_AGENT); }
__device__ __forceinline__ unsigned xb_add(unsigned* p, unsigned v) { return __hip_atomic_fetch_add(p, v, __ATOMIC_RELAXED, __HIP_MEMORY_SCOPE_AGENT); }
__device__ __forceinline__ unsigned xb_xcc_id() { return (unsigned)__builtin_amdgcn_s_getreg((3 << 11) | 20) & 0xFu; }
#define XB_SPIN(cond, bar) do { unsigned _sp = 0; while (cond) { __builtin_amdgcn_s_sleep(1); \
    if ((++_sp & 255u) == 0u) { if (xb_ld(&(bar)[XB_TMO])) break; if (_sp > XB_SPIN_CAP) { atomicAdd(&(bar)[XB_TMO], 1u); break; } } } } while (0)

struct XcdBarrier {
    unsigned* bar; unsigned x;
    volatile LAS unsigned* st;
};

__device__ __forceinline__ XcdBarrier xcd_barrier_post(unsigned* bar, volatile LAS unsigned* st) {
    XcdBarrier b; b.bar = bar; b.x = xb_xcc_id(); b.st = st;
    if (threadIdx.x == 0) (void)xb_add(&bar[XB_XCNT(b.x)], 1u);
    return b;
}
__device__ __forceinline__ void xcd_barrier_complete(unsigned* bar, unsigned x, unsigned& nloc, unsigned& nx) {
    const unsigned G = gridDim.x * gridDim.y * gridDim.z;
    unsigned sum, cnt, mine, sp = 0u;
    for (;;) {
        sum = 0u; cnt = 0u; mine = 0u;
#pragma unroll
        for (unsigned j = 0; j < 16; ++j) { const unsigned c = xb_ld(&bar[XB_XCNT(j)]); sum += c; cnt += (c > 0u) ? 1u : 0u; mine = (j == x) ? c : mine; }
        if (sum == G) break;
        __builtin_amdgcn_s_sleep(1);
        if ((++sp & 255u) == 0u) { if (xb_ld(&bar[XB_TMO])) break; if (sp > XB_SPIN_CAP) { atomicAdd(&bar[XB_TMO], 1u); break; } }
    }
    nloc = mine > 0u ? mine : 1u; nx = cnt > 0u ? cnt : 1u;
}

__device__ __forceinline__ void xcd_barrier(const XcdBarrier& b) {
    asm volatile("s_waitcnt vmcnt(0)" ::: "memory");
    __syncthreads();
    if (threadIdx.x == 0) {
        unsigned* bar = b.bar;
        __builtin_amdgcn_s_waitcnt(0);
        unsigned nloc = b.st[0], nx = b.st[1];
        if (nloc == 0u) { xcd_barrier_complete(bar, b.x, nloc, nx); b.st[0] = nloc; b.st[1] = nx; }
        const unsigned old = xb_add(&bar[XB_XSUB(b.x)], 1u);
        const unsigned gen = old / nloc;
        if (old + 1u == (gen + 1u) * nloc) {
            __builtin_amdgcn_fence(__ATOMIC_RELEASE, "agent");
            asm volatile("s_waitcnt vmcnt(0)" ::: "memory");
            const unsigned og = xb_add(&bar[XB_TOP], 1u);
            const unsigned tg = og / nx;
            if (og + 1u == (tg + 1u) * nx) xb_add(&bar[XB_TOPGEN], 1u);
            else XB_SPIN(xb_ld(&bar[XB_TOPGEN]) == tg, bar);
            __builtin_amdgcn_fence(__ATOMIC_ACQUIRE, "agent");
            xb_add(&bar[XB_XGEN(b.x)], 1u);
            asm volatile("s_waitcnt vmcnt(0)" ::: "memory");
        } else {
            XB_SPIN(xb_ld(&bar[XB_XGEN(b.x)]) == gen, bar);
            __builtin_amdgcn_fence(__ATOMIC_ACQUIRE, "agent");
            asm volatile("s_waitcnt vmcnt(0)" ::: "memory");
        }
    }
    __syncthreads();
}

__device__ __forceinline__ int crow(int r, int hi) { return (r & 3) + 8 * (r >> 2) + 4 * hi; }
typedef short v4i16_t __attribute__((ext_vector_type(4)));
__device__ __forceinline__ s16x4 vtr(const LAS unsigned char* p) { return __builtin_bit_cast(s16x4, __builtin_amdgcn_ds_read_tr16_b64_v4i16((LAS v4i16_t*)p)); }

template <int MODE>
__device__ __forceinline__ void attn_unit(LAS unsigned char* lds, unsigned char* ws, const float* sink, int unit) {
    constexpr int DQK = (MODE == 2) ? 96 : 64, KST = DQK / 16, KS = DQK * 2 + 16, VS = 192, KBUF = 64 * KS, VBUF = 64 * VS;
    const int tid = my_tid(), lane = tid & 63, wid = __builtin_amdgcn_readfirstlane(tid >> 6), r32 = lane & 31, hi = lane >> 5;
    int b, head, hkv = 0, n = 0, Rq0, qpos0 = 0, nt, jlo = 0;
    const bf16_t* Qp; int qstride;
    if (MODE == 0) {
        const int hp = unit & 1; n = (unit >> 1) & 15; hkv = (unit >> 5) & 1; b = unit >> 6;
        head = hkv * 4 + hp * 2 + (wid >> 2); qpos0 = 128 * n + 32 * (wid & 3); Rq0 = b * 2048 + qpos0;
        Qp = (const bf16_t*)(ws + WS_QE) + (size_t)Rq0 * 512 + head * 64; qstride = 512;
        jlo = (n == 0) ? 2 : 0; const int jhi = (n == 15) ? 4 : 6; nt = 4 + (jhi - jlo);
    } else if (MODE == 1) {
        const int qh = unit & 1, hp = (unit >> 1) & 1; hkv = (unit >> 2) & 1; b = unit >> 3;
        head = hkv * 4 + hp * 2 + (wid >> 2); Rq0 = ML + b * 256 + 128 * qh + 32 * (wid & 3);
        Qp = (const bf16_t*)(ws + WS_QE) + (size_t)Rq0 * 512 + head * 64; qstride = 512; nt = 4;
    } else {
        const int qb = unit & 7; head = (unit >> 3) & 7; b = unit >> 6; Rq0 = b * 2048 + 256 * qb + 32 * wid;
        Qp = (const bf16_t*)(ws + WS_QO) + (size_t)Rq0 * 768 + head * 96; qstride = 768; nt = 36;
    }
    bf16x8 qf[KST];
#pragma unroll
    for (int s = 0; s < KST; ++s) qf[s] = *(const bf16x8*)(Qp + (size_t)r32 * qstride + 16 * s + 8 * hi);
    float m_run, l_run;
    if (MODE == 2) { m_run = -1e30f; l_run = 0.f; } else { m_run = sink[head] * LOG2E; l_run = (hi == 0) ? 1.f : 0.f; }
    f32x16 o0, o1;
#pragma unroll
    for (int r = 0; r < 16; ++r) { o0[r] = 0.f; o1[r] = 0.f; }

    const int srow = tid >> 3, sch = tid & 7;
    const int voff = (4 * hi + ((lane & 15) >> 2)) * VS + (((lane >> 4) & 1) * 16 + 4 * (lane & 3)) * 2;
    u32x4 kreg, vreg, kreg2;
    kreg2 = (u32x4){0u, 0u, 0u, 0u};
#define ATT_SRC(t, kp, vp, k2p, kpos0v) do { \
        if (MODE == 0 || MODE == 1) { \
            if ((t) < 4) { kp = (const bf16_t*)(ws + WS_KVE) + (size_t)(ML + b * 256 + 64 * (t) + srow) * 256 + hkv * 64 + sch * 8; kpos0v = -100000; } \
            else { const int kp0_ = 128 * n - 128 + 64 * (jlo + (t) - 4); kpos0v = kp0_; \
                   kp = (const bf16_t*)(ws + WS_KVE) + (size_t)(b * 2048 + kp0_ + srow) * 256 + hkv * 64 + sch * 8; } \
            vp = kp + 128; k2p = kp; \
        } else { \
            const int pos0_ = 64 * (t); kpos0v = -100000; \
            kp = (const bf16_t*)(ws + WS_KNV) + ((size_t)(b * 8 + head) * 2304 + pos0_ + srow) * 128 + sch * 8; \
            vp = kp + 64; \
            const int krow_ = ((t) < 4) ? (ML + b * 256 + pos0_) : (b * 2048 + pos0_ - 256); \
            k2p = (const bf16_t*)(ws + WS_KR) + (size_t)(krow_ + (tid >> 2)) * 32 + (tid & 3) * 8; \
        } } while (0)
#define ATT_LOAD(t) do { const bf16_t *kp_, *vp_, *k2p_; int kq_; ATT_SRC(t, kp_, vp_, k2p_, kq_); (void)kq_; \
        kreg = *(const u32x4*)kp_; vreg = *(const u32x4*)vp_; if (MODE == 2 && tid < 256) kreg2 = *(const u32x4*)k2p_; } while (0)
#define ATT_STORE(buf) do { LAS unsigned char* kb_ = lds + (buf) * KBUF; LAS unsigned char* vb_ = lds + 2 * KBUF + (buf) * VBUF; \
        *(LAS u32x4*)(kb_ + srow * KS + sch * 16) = kreg; \
        if (MODE == 2 && tid < 256) *(LAS u32x4*)(kb_ + (tid >> 2) * KS + 128 + (tid & 3) * 16) = kreg2; \
        *(LAS u32x4*)(vb_ + srow * VS + sch * 16) = vreg; } while (0)

    ATT_LOAD(0); ATT_STORE(0);
    __syncthreads();
    for (int t = 0; t < nt; ++t) {
        const int buf = t & 1;
        if (t + 1 < nt) ATT_LOAD(t + 1);
        int kpos0 = -100000;
        if (MODE == 0 && t >= 4) kpos0 = 128 * n - 128 + 64 * (jlo + t - 4);
        bool active = true;
        if (MODE == 0 && t >= 4) active = (kpos0 + 63 >= qpos0 - 128) && (kpos0 <= qpos0 + 31 + 128);
        if (active) {
            const LAS unsigned char* kb = lds + buf * KBUF; const LAS unsigned char* vb = lds + 2 * KBUF + buf * VBUF;
            f32x16 p0, p1;
#pragma unroll
            for (int r = 0; r < 16; ++r) { p0[r] = 0.f; p1[r] = 0.f; }
#pragma unroll
            for (int s = 0; s < KST; ++s) {
                const bf16x8 a0 = *(const LAS bf16x8*)(kb + r32 * KS + (16 * s + 8 * hi) * 2);
                const bf16x8 a1 = *(const LAS bf16x8*)(kb + (32 + r32) * KS + (16 * s + 8 * hi) * 2);
                p0 = __builtin_amdgcn_mfma_f32_32x32x16_bf16(a0, qf[s], p0, 0, 0, 0);
                p1 = __builtin_amdgcn_mfma_f32_32x32x16_bf16(a1, qf[s], p1, 0, 0, 0);
            }
            if (MODE == 0 && t >= 4) {
                const int qpos = qpos0 + r32;
#pragma unroll
                for (int r = 0; r < 16; ++r) { const int d0 = kpos0 + crow(r, hi) - qpos, d1 = d0 + 32;
                    if (d0 > 128 || d0 < -128) p0[r] = -INFINITY; if (d1 > 128 || d1 < -128) p1[r] = -INFINITY; }
            }
            float mx = fmaxf(p0[0], p1[0]);
#pragma unroll
            for (int r = 1; r < 16; ++r) mx = fmaxf(mx, fmaxf(p0[r], p1[r]));
            mx = fmaxf(mx, __shfl_xor(mx, 32));
            const float m_new = fmaxf(m_run, mx), alpha = __builtin_amdgcn_exp2f(m_run - m_new);
            m_run = m_new;
            float rs = 0.f;
#pragma unroll
            for (int r = 0; r < 16; ++r) { p0[r] = __builtin_amdgcn_exp2f(p0[r] - m_new); p1[r] = __builtin_amdgcn_exp2f(p1[r] - m_new); rs += p0[r] + p1[r]; }
            l_run = l_run * alpha + rs;
#pragma unroll
            for (int r = 0; r < 16; ++r) { o0[r] *= alpha; o1[r] *= alpha; }
            u32x4 pw[4];
            pw[0] = (u32x4){pk2(p0[0], p0[1]), pk2(p0[2], p0[3]), pk2(p0[4], p0[5]), pk2(p0[6], p0[7])};
            pw[1] = (u32x4){pk2(p0[8], p0[9]), pk2(p0[10], p0[11]), pk2(p0[12], p0[13]), pk2(p0[14], p0[15])};
            pw[2] = (u32x4){pk2(p1[0], p1[1]), pk2(p1[2], p1[3]), pk2(p1[4], p1[5]), pk2(p1[6], p1[7])};
            pw[3] = (u32x4){pk2(p1[8], p1[9]), pk2(p1[10], p1[11]), pk2(p1[12], p1[13]), pk2(p1[14], p1[15])};
#pragma unroll
            for (int s2 = 0; s2 < 4; ++s2) {
                const bf16x8 pb = __builtin_bit_cast(bf16x8, pw[s2]);
                const LAS unsigned char* va0 = vb + (16 * s2) * VS + voff;
                const s16x4 l0 = vtr(va0), h0 = vtr(va0 + 8 * VS), l1 = vtr(va0 + 64), h1 = vtr(va0 + 8 * VS + 64);
                const bf16x8 v0 = (bf16x8){l0[0], l0[1], l0[2], l0[3], h0[0], h0[1], h0[2], h0[3]};
                const bf16x8 v1 = (bf16x8){l1[0], l1[1], l1[2], l1[3], h1[0], h1[1], h1[2], h1[3]};
                o0 = __builtin_amdgcn_mfma_f32_32x32x16_bf16(v0, pb, o0, 0, 0, 0);
                o1 = __builtin_amdgcn_mfma_f32_32x32x16_bf16(v1, pb, o1, 0, 0, 0);
            }
        }
        if (t + 1 < nt) ATT_STORE(buf ^ 1);
        __syncthreads();
    }
#undef ATT_SRC
#undef ATT_LOAD
#undef ATT_STORE
    const float l_tot = l_run + __shfl_xor(l_run, 32), inv = __builtin_amdgcn_rcpf(l_tot);
    const int Rq = Rq0 + r32;
    const bf16_t* zrow = (MODE == 2) ? (const bf16_t*)(ws + WS_ZO) + (size_t)Rq * 1024 + head * 64 : (const bf16_t*)(ws + WS_ZA) + (size_t)Rq * 512 + head * 64;
    bf16_t* urow = (bf16_t*)(ws + WS_U) + (size_t)Rq * 1024 + head * 64;
#pragma unroll
    for (int g = 0; g < 4; ++g) {
        const int dv = 8 * g + 4 * hi;
        { const u32x2 z = *(const u32x2*)(zrow + dv);
          u32x2 w; w.x = pk2(o0[4 * g] * inv * bf_lo(z.x), o0[4 * g + 1] * inv * bf_hi(z.x)); w.y = pk2(o0[4 * g + 2] * inv * bf_lo(z.y), o0[4 * g + 3] * inv * bf_hi(z.y));
          *(u32x2*)(urow + dv) = w; }
        { const u32x2 z = *(const u32x2*)(zrow + 32 + dv);
          u32x2 w; w.x = pk2(o1[4 * g] * inv * bf_lo(z.x), o1[4 * g + 1] * inv * bf_hi(z.x)); w.y = pk2(o1[4 * g + 2] * inv * bf_lo(z.y), o1[4 * g + 3] * inv * bf_hi(z.y));
          *(u32x2*)(urow + 32 + dv) = w; }
    }
}


__device__ __forceinline__ int srcmap(int mat, int dn) {
    if (mat == 0) {
        if (dn < 128) { const int d = dn & 63; return (dn & 64) + (d >> 1) + 32 * (d & 1); }
        if (dn < 256) return dn;
        if (dn < 768) { const int j = dn - 256, d = j & 63; return 256 + (j & ~63) + (d >> 1) + 32 * (d & 1); }
        if (dn < 1792) { const int j = dn - 768, blk = j >> 8, w = j & 255; return (w < 128) ? 1280 + blk * 128 + w : 1792 + blk * 128 + (w - 128); }
        if (dn < 2816) { const int j = dn - 1792, blk = j >> 8, w = j & 255; return (w < 128) ? 768 + blk * 128 + w : 2816 + blk * 128 + (w - 128); }
        return 2304 + (dn - 2816);
    }
    if (mat == 2) {
        if (dn < 256) return dn;
        if (dn < 512) return 288 + (dn - 256);
        if (dn < 1024) return 544 + (dn - 512);
        if (dn < 1280) { const int w = dn - 1024; if (w < 32) return 256 + (w >> 1) + 16 * (w & 1); if (w < 48) return 1056 + (w - 32); return -1; }
        if (dn < 2048) return 1072 + (dn - 1280);
        if (dn < 2304) return 1840 + (dn - 2048);
        if (dn < 2816) return 2096 + (dn - 2304);
        return 2608 + (dn - 2816);
    }
    if (mat == 3) {
        const int head = dn / 96, d = dn - head * 96; if (d < 64) return dn; const int w = d - 64; return head * 96 + 64 + (w >> 1) + 16 * (w & 1);
    }
    return dn;
}
__device__ __forceinline__ void p0_transpose_item(const float* W, int K, int Nsrc, bf16_t* WT, int mat, const float* kscale, LAS float* scr, int item, int nblk, int lane) {
    const int kb = item / nblk, nb = item % nblk, k0 = 64 * kb, n0 = 32 * nb;
    const int sc = srcmap(mat, n0 + (lane & 31));
#pragma unroll 8
    for (int i = 0; i < 32; ++i) { const int kk = 2 * i + (lane >> 5); float v = 0.f; if (sc >= 0) v = W[(size_t)(k0 + kk) * Nsrc + sc]; if (kscale) v *= kscale[k0 + kk]; scr[kk * 33 + (lane & 31)] = v; }
    LDS_WAIT(); asm volatile("" ::: "memory");
    const int c = lane & 7;
#pragma unroll
    for (int j = 0; j < 4; ++j) { const int n = (lane >> 3) + 8 * j; const LAS float* s = scr + (8 * c) * 33 + n;
        u32x4 o; o.x = pk2(s[0 * 33], s[1 * 33]); o.y = pk2(s[2 * 33], s[3 * 33]); o.z = pk2(s[4 * 33], s[5 * 33]); o.w = pk2(s[6 * 33], s[7 * 33]);
        *(u32x4*)(WT + (size_t)(n0 + n) * K + k0 + 8 * c) = o; }
    LDS_WAIT(); asm volatile("" ::: "memory");
}

__device__ __forceinline__ void p0_mod(LAS unsigned char* lds, const float* c, const float* c_ctx, const float* mod_w, const float* mod_b, float* MOD, int G) {
    const int tid = my_tid();
    if ((int)blockIdx.x >= 96) return;
    LAS float* scs = (LAS float*)lds;
    LAS float* red = (LAS float*)(lds + 1024 * 20 * 4);
    for (int idx = tid; idx < 17 * 1024; idx += NTHREADS) { const int r = idx >> 10, k = idx & 1023; const float v = (r < 16) ? c[r * 1024 + k] : c_ctx[k]; scs[k * 20 + r] = silu_f(v); }
    __syncthreads();
    for (int item = blockIdx.x; item < 96; item += G) {
        const int l = item / 48, n0 = (item % 48) * 64, col = tid & 63, kg = tid >> 6;
        float acc[20];
#pragma unroll
        for (int r = 0; r < 20; ++r) acc[r] = 0.f;
        const float* wp = mod_w + ((size_t)l * 1024 + kg * 128) * 3072 + n0 + col;
#pragma unroll 4
        for (int kk = 0; kk < 128; ++kk) {
            const float w = wp[(size_t)kk * 3072]; const LAS f32x4* sp = (const LAS f32x4*)(scs + (kg * 128 + kk) * 20);
#pragma unroll
            for (int q = 0; q < 5; ++q) { const f32x4 s = sp[q]; acc[4 * q] += s[0] * w; acc[4 * q + 1] += s[1] * w; acc[4 * q + 2] += s[2] * w; acc[4 * q + 3] += s[3] * w; }
        }
#pragma unroll
        for (int r = 0; r < 17; ++r) red[(kg * 17 + r) * 64 + col] = acc[r];
        __syncthreads();
        for (int o = tid; o < 17 * 64; o += NTHREADS) { const int r = o >> 6, cc = o & 63; float s = mod_b[l * 3072 + n0 + cc];
#pragma unroll
            for (int g = 0; g < 8; ++g) s += red[(g * 17 + r) * 64 + cc];
            MOD[((size_t)l * 17 + r) * 3072 + n0 + cc] = s; }
        __syncthreads();
    }
}

__device__ __forceinline__ void norm_mod_store(const f32x4 (&v)[4], const float* pre_w, const float* modrow, bf16_t* hrow, int lane) {
    float ss = 0.f;
#pragma unroll
    for (int j = 0; j < 4; ++j) ss += sq4(v[j]);
    const float rstd = rsqrtf(wave_sum(ss) * (1.f / 1024.f) + EPS);
#pragma unroll
    for (int j = 0; j < 4; ++j) { const int k = 4 * (lane + 64 * j);
        const f32x4 w = *(const f32x4*)(pre_w + k), sh = *(const f32x4*)(modrow + k), sc = *(const f32x4*)(modrow + 1024 + k);
        const f32x4 h = v[j] * rstd * w * (sc + 1.0f) + sh;
        u32x2 o; o.x = pk2(h[0], h[1]); o.y = pk2(h[2], h[3]); *(u32x2*)(hrow + k) = o; }
}
__device__ __forceinline__ void p1_prenorm(const float* x, const float* ctx, const float* pre_w, const float* MOD, bf16_t* H, int gw, int ngw, int lane) {
    for (int R = gw; R < MT; R += ngw) {
        const float* src = (R < ML) ? x + (size_t)R * 1024 : ctx + (size_t)(R - ML) * 1024; const int bi = (R < ML) ? (R >> 11) : 16;
        f32x4 v[4];
#pragma unroll
        for (int j = 0; j < 4; ++j) v[j] = *(const f32x4*)(src + 4 * (lane + 64 * j));
        norm_mod_store(v, pre_w, MOD + (size_t)bi * 3072, H + (size_t)R * 1024, lane);
    }
}
__device__ __forceinline__ float ssq16(const float* p) {
    const f32x4 a = *(const f32x4*)p, b = *(const f32x4*)(p + 4), c = *(const f32x4*)(p + 8), d = *(const f32x4*)(p + 12);
    return (((a[0] + a[1]) + (a[2] + a[3])) + ((b[0] + b[1]) + (b[2] + b[3]))) + (((c[0] + c[1]) + (c[2] + c[3])) + ((d[0] + d[1]) + (d[2] + d[3])));
}
__device__ __forceinline__ void p5_post_pre(const float* x, const float* ctx, const float* post_w0, const float* pre_w1, const float* MOD, const bf16_t* Y, const float* SSQ, float* X1, bf16_t* H, int gw, int ngw, int lane) {
    for (int R = gw; R < MT; R += ngw) {
        const float* src = (R < ML) ? x + (size_t)R * 1024 : ctx + (size_t)(R - ML) * 1024; const int bi = (R < ML) ? (R >> 11) : 16;
        const float rstd_y = rsqrtf(ssq16(SSQ + (size_t)R * 16) * (1.f / 1024.f) + EPS);
        const float* m0 = MOD + (size_t)bi * 3072;
        f32x4 v[4];
#pragma unroll
        for (int j = 0; j < 4; ++j) { const int k = 4 * (lane + 64 * j);
            const u32x2 yy = *(const u32x2*)(Y + (size_t)R * 1024 + k); const f32x4 y = (f32x4){bf_lo(yy.x), bf_hi(yy.x), bf_lo(yy.y), bf_hi(yy.y)};
            const f32x4 g = *(const f32x4*)(m0 + 2048 + k), pw = *(const f32x4*)(post_w0 + k), xv = *(const f32x4*)(src + k);
            v[j] = xv + g * (y * rstd_y * pw);
            if (R < ML) *(f32x4*)(X1 + (size_t)R * 1024 + k) = v[j]; }
        norm_mod_store(v, pre_w1, MOD + (size_t)(17 + bi) * 3072, H + (size_t)R * 1024, lane);
    }
}
__device__ __forceinline__ void p11_final(const float* post_w1, const float* MOD, const bf16_t* Y, const float* SSQ, float* out, int gw, int ngw, int lane) {
    for (int R = gw; R < ML; R += ngw) {
        const float rstd_y = rsqrtf(ssq16(SSQ + (size_t)R * 16) * (1.f / 1024.f) + EPS);
        const float* m1 = MOD + (size_t)(17 + (R >> 11)) * 3072;
#pragma unroll
        for (int j = 0; j < 4; ++j) { const int k = 4 * (lane + 64 * j);
            const u32x2 yy = *(const u32x2*)(Y + (size_t)R * 1024 + k); const f32x4 y = (f32x4){bf_lo(yy.x), bf_hi(yy.x), bf_lo(yy.y), bf_hi(yy.y)};
            const f32x4 g = *(const f32x4*)(m1 + 2048 + k), pw = *(const f32x4*)(post_w1 + k), xv = *(const f32x4*)(out + (size_t)R * 1024 + k);
            *(f32x4*)(out + (size_t)R * 1024 + k) = xv + g * (y * rstd_y * pw); }
    }
}
__device__ __forceinline__ void p3_conv(unsigned char* ws, const float* conv_w, int gtid, int ngt) {
    const bf16_t* PE = (const bf16_t*)(ws + WS_PE); const bf16_t* GE = (const bf16_t*)(ws + WS_GE); bf16_t* U = (bf16_t*)(ws + WS_U);
    for (int it = gtid; it < MT * 64; it += ngt) {
        const int R = it >> 6, ch = (it & 63) * 8;
        int t, T; if (R < ML) { t = R & 2047; T = 2048; } else { t = (R - ML) & 255; T = 256; }
        const u32x4 z4 = (u32x4){0u, 0u, 0u, 0u};
        const u32x4 pc = *(const u32x4*)(PE + (size_t)R * 512 + ch);
        const u32x4 pm = (t > 0) ? *(const u32x4*)(PE + (size_t)(R - 1) * 512 + ch) : z4;
        const u32x4 pp = (t < T - 1) ? *(const u32x4*)(PE + (size_t)(R + 1) * 512 + ch) : z4;
        const u32x4 g = *(const u32x4*)(GE + (size_t)R * 512 + ch);
        const f32x4 w0a = *(const f32x4*)(conv_w + ch), w0b = *(const f32x4*)(conv_w + ch + 4), w1a = *(const f32x4*)(conv_w + 512 + ch), w1b = *(const f32x4*)(conv_w + 512 + ch + 4),
                    w2a = *(const f32x4*)(conv_w + 1024 + ch), w2b = *(const f32x4*)(conv_w + 1024 + ch + 4);
        u32x4 o;
#define CV(pmw, pcw, ppw, gw_, wa, wb, wc_, e0, e1) pk2(bf_lo(gw_) * (wa[e0] * bf_lo(pmw) + wb[e0] * bf_lo(pcw) + wc_[e0] * bf_lo(ppw)), bf_hi(gw_) * (wa[e1] * bf_hi(pmw) + wb[e1] * bf_hi(pcw) + wc_[e1] * bf_hi(ppw)))
        o.x = CV(pm.x, pc.x, pp.x, g.x, w0a, w1a, w2a, 0, 1); o.y = CV(pm.y, pc.y, pp.y, g.y, w0a, w1a, w2a, 2, 3);
        o.z = CV(pm.z, pc.z, pp.z, g.z, w0b, w1b, w2b, 0, 1); o.w = CV(pm.w, pc.w, pp.w, g.w, w0b, w1b, w2b, 2, 3);
#undef CV
        *(u32x4*)(U + (size_t)R * 1024 + 512 + ch) = o;
    }
}
__device__ __forceinline__ void p9_readout(unsigned char* ws, const float* hn_w, int gw, int ngw, int lane) {
    const bf16_t* HM = (const bf16_t*)(ws + WS_HM); const bf16_t* MO = (const bf16_t*)(ws + WS_MO); const bf16_t* ZO = (const bf16_t*)(ws + WS_ZO); bf16_t* U = (bf16_t*)(ws + WS_U);
    for (int R = gw; R < ML; R += ngw) {
        const int ch = 8 * lane;
        const u32x4 h0 = *(const u32x4*)(HM + (size_t)R * 512 + ch), h1 = *(const u32x4*)(HM + ((size_t)ML + R) * 512 + ch);
        float hs[8] = {bf_lo(h0.x) + bf_lo(h1.x), bf_hi(h0.x) + bf_hi(h1.x), bf_lo(h0.y) + bf_lo(h1.y), bf_hi(h0.y) + bf_hi(h1.y),
                       bf_lo(h0.z) + bf_lo(h1.z), bf_hi(h0.z) + bf_hi(h1.z), bf_lo(h0.w) + bf_lo(h1.w), bf_hi(h0.w) + bf_hi(h1.w)};
        float ss = 0.f;
#pragma unroll
        for (int e = 0; e < 8; ++e) ss += hs[e] * hs[e];
        ss += __shfl_xor(ss, 1); ss += __shfl_xor(ss, 2); ss += __shfl_xor(ss, 4); ss += __shfl_xor(ss, 8);
        const float rstd = rsqrtf(ss * (1.f / 128.f) + EPS);
        const u32x4 mo = *(const u32x4*)(MO + (size_t)R * 512 + ch), zz = *(const u32x4*)(ZO + (size_t)R * 1024 + 512 + ch);
        const f32x4 wa = *(const f32x4*)(hn_w + ch), wb = *(const f32x4*)(hn_w + ch + 4);
        u32x4 o;
        o.x = pk2(hs[0] * rstd * wa[0] * bf_lo(mo.x) * bf_lo(zz.x), hs[1] * rstd * wa[1] * bf_hi(mo.x) * bf_hi(zz.x));
        o.y = pk2(hs[2] * rstd * wa[2] * bf_lo(mo.y) * bf_lo(zz.y), hs[3] * rstd * wa[3] * bf_hi(mo.y) * bf_hi(zz.y));
        o.z = pk2(hs[4] * rstd * wb[0] * bf_lo(mo.z) * bf_lo(zz.z), hs[5] * rstd * wb[1] * bf_hi(mo.z) * bf_hi(zz.z));
        o.w = pk2(hs[6] * rstd * wb[2] * bf_lo(mo.w) * bf_lo(zz.w), hs[7] * rstd * wb[3] * bf_hi(mo.w) * bf_hi(zz.w));
        *(u32x4*)(U + (size_t)R * 1024 + 512 + ch) = o;
    }
}


__device__ __forceinline__ void mlstm_chain(LAS unsigned char* lds, unsigned char* ws, const float* i_bias, const float* f_bias, int chain) {
    const int tid = my_tid(), lane = tid & 63, wid = __builtin_amdgcn_readfirstlane(tid >> 6);
    const int vh = chain & 1, d = (chain >> 1) & 1, h = (chain >> 2) & 3, b = chain >> 4;
    LAS float* Kc = (LAS float*)lds;
    LAS float* Vc = Kc + 4096;
    LAS float* Ct = Vc + 4096;
    LAS float* Qc = Ct + 4096;
    LAS float* Sc = Qc + 64 * 65;
    LAS float* vb_ = Sc + 64 * 65;
    LAS float* vab = vb_ + 64;
    LAS float* vcm = vab + 64;
    LAS float* vw = vcm + 64;
    LAS float* vn = vw + 64;
    LAS float* vsc = vn + 64;
    const bf16_t* MK = (const bf16_t*)(ws + WS_MK); const bf16_t* MV = (const bf16_t*)(ws + WS_MV); const bf16_t* MQ = (const bf16_t*)(ws + WS_MQ);
    const float* GT = (const float*)(ws + WS_GATES); bf16_t* HM = (bf16_t*)(ws + WS_HM);
    const float ib = i_bias[d * 4 + h], fb = f_bias[d * 4 + h];
    float ct[8];
#pragma unroll
    for (int e = 0; e < 8; ++e) ct[e] = 0.f;
    float nreg = 0.f, mst = 0.f;
    for (int idx = tid; idx < 4096; idx += NTHREADS) Ct[idx] = 0.f;
    if (tid < 64) vn[tid] = 0.f;
    const int srow = tid >> 3, sch = tid & 7;
    for (int step = 0; step < 36; ++step) {
        const bool lat = step >= 4; const int c = lat ? step - 4 : step, T = lat ? 2048 : 256, rowb = lat ? b * 2048 : ML + b * 256;
        { const int tok = (d == 0) ? 64 * c + srow : T - 1 - (64 * c + srow); const size_t R = (size_t)(rowb + tok);
          const u32x4 kk = *(const u32x4*)(MK + R * 256 + h * 64 + sch * 8), vv = *(const u32x4*)(MV + R * 512 + h * 128 + vh * 64 + sch * 8);
          *(LAS f32x4*)(Kc + srow * 64 + sch * 8) = (f32x4){bf_lo(kk.x), bf_hi(kk.x), bf_lo(kk.y), bf_hi(kk.y)}; *(LAS f32x4*)(Kc + srow * 64 + sch * 8 + 4) = (f32x4){bf_lo(kk.z), bf_hi(kk.z), bf_lo(kk.w), bf_hi(kk.w)};
          *(LAS f32x4*)(Vc + srow * 64 + sch * 8) = (f32x4){bf_lo(vv.x), bf_hi(vv.x), bf_lo(vv.y), bf_hi(vv.y)}; *(LAS f32x4*)(Vc + srow * 64 + sch * 8 + 4) = (f32x4){bf_lo(vv.z), bf_hi(vv.z), bf_lo(vv.w), bf_hi(vv.w)};
          if (lat) { const u32x4 qq = *(const u32x4*)(MQ + R * 256 + h * 64 + sch * 8); LAS float* qd = Qc + srow * 65 + sch * 8;
              qd[0] = bf_lo(qq.x); qd[1] = bf_hi(qq.x); qd[2] = bf_lo(qq.y); qd[3] = bf_hi(qq.y); qd[4] = bf_lo(qq.z); qd[5] = bf_hi(qq.z); qd[6] = bf_lo(qq.w); qd[7] = bf_hi(qq.w); }
          if (wid == 0) {
              const int tk = (d == 0) ? 64 * c + lane : T - 1 - (64 * c + lane); const float* gp = GT + (size_t)(rowb + tk) * 16 + d * 8 + h;
              const float li = gp[0] + ib, fp = gp[4] + fb;
              const float lf = fminf(fp, 0.f) - __logf(1.f + __expf(-fabsf(fp)));
              float bc = lf;
#pragma unroll
              for (int o = 1; o < 64; o <<= 1) { const float t_ = __shfl_up(bc, o); if (lane >= o) bc += t_; }
              const float ab = li - bc; float cm = ab;
#pragma unroll
              for (int o = 1; o < 64; o <<= 1) { const float t_ = __shfl_up(cm, o); if (lane >= o) cm = fmaxf(cm, t_); }
              const float g = __shfl(bc, 63), cmx = __shfl(cm, 63), mloc = g + cmx;
              vb_[lane] = bc; vab[lane] = ab; vcm[lane] = cm; vw[lane] = __expf(g + ab - mloc);
              if (lane == 0) { vsc[0] = g; vsc[1] = mloc; }
          } }
        __syncthreads();
        const float g = vsc[0], mloc = vsc[1], m_in = mst;
        if (lat) {
            float q[64];
#pragma unroll
            for (int k = 0; k < 64; ++k) q[k] = Qc[lane * 65 + k];
            const float mi = fmaxf(m_in, vcm[lane]);
#pragma unroll
            for (int jj = 0; jj < 8; ++jj) { const int j = 8 * wid + jj; float s = 0.f;
#pragma unroll
                for (int k4 = 0; k4 < 16; ++k4) { const f32x4 kv = *(const LAS f32x4*)(Kc + j * 64 + 4 * k4); s += q[4 * k4] * kv[0] + q[4 * k4 + 1] * kv[1] + q[4 * k4 + 2] * kv[2] + q[4 * k4 + 3] * kv[3]; }
                Sc[lane * 65 + j] = (j <= lane) ? s * __expf(vab[j] - mi) : 0.f; }
            float nq = 0.f;
#pragma unroll
            for (int k4 = 0; k4 < 16; ++k4) { const f32x4 nv = *(const LAS f32x4*)(vn + 4 * k4); nq += q[4 * k4] * nv[0] + q[4 * k4 + 1] * nv[1] + q[4 * k4 + 2] * nv[2] + q[4 * k4 + 3] * nv[3]; }
            __syncthreads();
            const float wi = __expf(m_in - mi);
            float acc[8];
#pragma unroll
            for (int e = 0; e < 8; ++e) acc[e] = 0.f;
#pragma unroll
            for (int k = 0; k < 64; ++k) { const float qk = q[k] * wi; const f32x4 c0 = *(const LAS f32x4*)(Ct + k * 64 + 8 * wid), c1 = *(const LAS f32x4*)(Ct + k * 64 + 8 * wid + 4);
                acc[0] += qk * c0[0]; acc[1] += qk * c0[1]; acc[2] += qk * c0[2]; acc[3] += qk * c0[3]; acc[4] += qk * c1[0]; acc[5] += qk * c1[1]; acc[6] += qk * c1[2]; acc[7] += qk * c1[3]; }
            float den = wi * nq;
#pragma unroll 8
            for (int j = 0; j < 64; ++j) { const float sj = Sc[lane * 65 + j]; den += sj; const f32x4 v0 = *(const LAS f32x4*)(Vc + j * 64 + 8 * wid), v1 = *(const LAS f32x4*)(Vc + j * 64 + 8 * wid + 4);
                acc[0] += sj * v0[0]; acc[1] += sj * v0[1]; acc[2] += sj * v0[2]; acc[3] += sj * v0[3]; acc[4] += sj * v1[0]; acc[5] += sj * v1[1]; acc[6] += sj * v1[2]; acc[7] += sj * v1[3]; }
            const float mt = vb_[lane] + mi, inv = 1.f / fmaxf(fabsf(den), __expf(-mt));
            const int tok = (d == 0) ? 64 * c + lane : T - 1 - (64 * c + lane);
            u32x4 o; o.x = pk2(acc[0] * inv, acc[1] * inv); o.y = pk2(acc[2] * inv, acc[3] * inv); o.z = pk2(acc[4] * inv, acc[5] * inv); o.w = pk2(acc[6] * inv, acc[7] * inv);
            *(u32x4*)(HM + ((size_t)d * ML + rowb + tok) * 512 + h * 128 + vh * 64 + 8 * wid) = o;
        }
        const float m_new = fmaxf(g + m_in, mloc), a_prev = __expf(g + m_in - m_new), a_loc = __expf(mloc - m_new);
        float upd[8];
#pragma unroll
        for (int e = 0; e < 8; ++e) upd[e] = 0.f;
        float nsum = 0.f;
#pragma unroll 8
        for (int j = 0; j < 64; ++j) { const float kw = Kc[j * 64 + lane] * vw[j]; nsum += kw; const f32x4 v0 = *(const LAS f32x4*)(Vc + j * 64 + 8 * wid), v1 = *(const LAS f32x4*)(Vc + j * 64 + 8 * wid + 4);
            upd[0] += kw * v0[0]; upd[1] += kw * v0[1]; upd[2] += kw * v0[2]; upd[3] += kw * v0[3]; upd[4] += kw * v1[0]; upd[5] += kw * v1[1]; upd[6] += kw * v1[2]; upd[7] += kw * v1[3]; }
#pragma unroll
        for (int e = 0; e < 8; ++e) ct[e] = a_prev * ct[e] + a_loc * upd[e];
        nreg = a_prev * nreg + a_loc * nsum; mst = m_new;
        __syncthreads();
        *(LAS f32x4*)(Ct + lane * 64 + 8 * wid) = (f32x4){ct[0], ct[1], ct[2], ct[3]}; *(LAS f32x4*)(Ct + lane * 64 + 8 * wid + 4) = (f32x4){ct[4], ct[5], ct[6], ct[7]};
        if (wid == 0) vn[lane] = nreg;
    }
    __syncthreads();
}


typedef float f32x4v __attribute__((ext_vector_type(4)));
#define MFMA_FENCE(x) do { __builtin_amdgcn_sched_barrier(0); asm volatile("s_nop 15\n\ts_nop 15" : "+v"(x)); __builtin_amdgcn_sched_barrier(0); } while (0)
__device__ __forceinline__ bf16x8 tr8(const LAS unsigned char* p, int halfstride) {
    const s16x4 lo = vtr(p), hi = vtr(p + halfstride);
    return (bf16x8){lo[0], lo[1], lo[2], lo[3], hi[0], hi[1], hi[2], hi[3]};
}
__device__ __forceinline__ bf16x8 gather8(const LAS unsigned char* img, int stride, int row0, int col) {
    bf16x8 r;
#pragma unroll
    for (int e = 0; e < 8; ++e) r[e] = *(const LAS short*)(img + (row0 + e) * stride + col * 2);
    return r;
}
template <bool DUMMY> __device__ __forceinline__ void mlstm_chain_mfma(LAS unsigned char* lds, unsigned char* ws, const float* i_bias, const float* f_bias, int chain) {
    constexpr int RS = 144, VS = 176;
    constexpr int QI = 0, KI = 9216, SC = 18432, CI = 27648, VI = 39168, VW = 50432, VEC = 61696;
    const int tid = my_tid(), lane = tid & 63, wid = __builtin_amdgcn_readfirstlane(tid >> 6), l15 = lane & 15, kg = lane >> 4;
    const int vh = chain & 1, d = (chain >> 1) & 1, h = (chain >> 2) & 3, b = chain >> 4;
    LAS float* vb_ = (LAS float*)(lds + VEC); LAS float* vab = vb_ + 64; LAS float* vcm = vab + 64; LAS float* vwp = vcm + 64; LAS float* vsc = vwp + 64;
    const bf16_t* MK = (const bf16_t*)(ws + WS_MK); const bf16_t* MV = (const bf16_t*)(ws + WS_MV); const bf16_t* MQ = (const bf16_t*)(ws + WS_MQ);
    const float* GT = (const float*)(ws + WS_GATES); bf16_t* HM = (bf16_t*)(ws + WS_HM);
    const float ib = i_bias[d * 4 + h], fb = f_bias[d * 4 + h];
    for (int idx = tid; idx < 80 * RS / 4; idx += NTHREADS) ((LAS unsigned*)(lds + CI))[idx] = 0u;
    if (tid < 64) { LAS unsigned* a = (LAS unsigned*)(lds + VI + tid * VS + 128); LAS unsigned* w = (LAS unsigned*)(lds + VW + tid * VS + 128);
#pragma unroll
        for (int e = 0; e < 8; ++e) { a[e] = (e == 0) ? 0x3F80u : 0u; w[e] = 0u; } }
    const int it = wid & 3, vg = wid >> 2;
    f32x4v cacc[3];
#pragma unroll
    for (int t = 0; t < 3; ++t) cacc[t] = (f32x4v){0.f, 0.f, 0.f, 0.f};
    float mst = 0.f;
    unsigned nbad = 0u;
    const int srow = tid >> 3, sch = tid & 7;
    const int q4 = l15 >> 2, p4 = l15 & 3;
    for (int step = 0; step < 36; ++step) {
        const bool lat = step >= 4; const int c = lat ? step - 4 : step, T = lat ? 2048 : 256, rowb = lat ? b * 2048 : ML + b * 256;
        const int tok = (d == 0) ? 64 * c + srow : T - 1 - (64 * c + srow); const size_t R = (size_t)(rowb + tok);
        const u32x4 kk = *(const u32x4*)(MK + R * 256 + h * 64 + sch * 8), vv = *(const u32x4*)(MV + R * 512 + h * 128 + vh * 64 + sch * 8);
        u32x4 qq = (u32x4){0u, 0u, 0u, 0u};
        if (lat) qq = *(const u32x4*)(MQ + R * 256 + h * 64 + sch * 8);
        if (wid == 0) {
            const int tk = (d == 0) ? 64 * c + lane : T - 1 - (64 * c + lane); const float* gp = GT + (size_t)(rowb + tk) * 16 + d * 8 + h;
            const float li = gp[0] + ib, fp = gp[4] + fb;
            const float lf = fminf(fp, 0.f) - __logf(1.f + __expf(-fabsf(fp)));
            float bc = lf;
#pragma unroll
            for (int o = 1; o < 64; o <<= 1) { const float t_ = __shfl_up(bc, o); if (lane >= o) bc += t_; }
            const float ab = li - bc; float cm = ab;
#pragma unroll
            for (int o = 1; o < 64; o <<= 1) { const float t_ = __shfl_up(cm, o); if (lane >= o) cm = fmaxf(cm, t_); }
            const float g = __shfl(bc, 63), mloc = g + __shfl(cm, 63), m_new = fmaxf(g + mst, mloc);
            vb_[lane] = bc; vab[lane] = ab; vcm[lane] = cm; vwp[lane] = __expf(g + ab - m_new);
            if (lane == 0) { vsc[0] = mst; vsc[1] = __expf(g + mst - m_new); }
            mst = m_new;
        }
        __syncthreads();
        { const float wj = vwp[srow];
          *(LAS u32x4*)(lds + KI + srow * RS + sch * 16) = kk;
          *(LAS u32x4*)(lds + VI + srow * VS + sch * 16) = vv;
          u32x4 vw; vw.x = pk2(bf_lo(vv.x) * wj, bf_hi(vv.x) * wj); vw.y = pk2(bf_lo(vv.y) * wj, bf_hi(vv.y) * wj); vw.z = pk2(bf_lo(vv.z) * wj, bf_hi(vv.z) * wj); vw.w = pk2(bf_lo(vv.w) * wj, bf_hi(vv.w) * wj);
          *(LAS u32x4*)(lds + VW + srow * VS + sch * 16) = vw;
          if (sch == 0) *(LAS unsigned short*)(lds + VW + srow * VS + 128) = f2bf(wj);
          if (lat) *(LAS u32x4*)(lds + QI + srow * RS + sch * 16) = qq; }
        __syncthreads();
        const float m_in = vsc[0], a_prev = vsc[1];
        bf16x8 qf[2];
        if (lat) {
            qf[0] = *(const LAS bf16x8*)(lds + QI + (16 * it + l15) * RS + (8 * kg) * 2); qf[1] = *(const LAS bf16x8*)(lds + QI + (16 * it + l15) * RS + (8 * kg + 32) * 2);
            const int i = 16 * it + l15; const float mi = fmaxf(m_in, vcm[i]);
#pragma unroll
            for (int t = 0; t < 2; ++t) {
                const int jt = 2 * vg + t; u32x2 o = (u32x2){0u, 0u};
                if (jt <= it) {
                    const bf16x8 k0 = *(const LAS bf16x8*)(lds + KI + (16 * jt + l15) * RS + (8 * kg) * 2), k1 = *(const LAS bf16x8*)(lds + KI + (16 * jt + l15) * RS + (8 * kg + 32) * 2);
                    f32x4v s = (f32x4v){0.f, 0.f, 0.f, 0.f};
                    s = __builtin_amdgcn_mfma_f32_16x16x32_bf16(k0, qf[0], s, 0, 0, 0); s = __builtin_amdgcn_mfma_f32_16x16x32_bf16(k1, qf[1], s, 0, 0, 0); MFMA_FENCE(s);
                    const int j0 = 16 * jt + 4 * kg; const f32x4v abv = *(const LAS f32x4v*)(vab + j0);
                    float e[4];
#pragma unroll
                    for (int r = 0; r < 4; ++r) e[r] = (j0 + r <= i) ? s[r] * __expf(abv[r] - mi) : 0.f;
                    o.x = pk2(e[0], e[1]); o.y = pk2(e[2], e[3]);
                }
                *(LAS u32x2*)(lds + SC + i * RS + (16 * jt + 4 * kg) * 2) = o;
            }
        }
        __syncthreads();
        f32x4v cnew[3];
        { bf16x8 aK[2];
#pragma unroll
          for (int s = 0; s < 2; ++s) aK[s] = tr8(lds + KI + (32 * s + 8 * kg + q4) * RS + (16 * it + 4 * p4) * 2, 4 * RS);
#pragma unroll
          for (int t = 0; t < 3; ++t) { const int vt = (t == 2) ? 4 : 2 * t + vg; f32x4v a = cacc[t] * a_prev;
#pragma unroll
              for (int s = 0; s < 2; ++s) { const bf16x8 bW = tr8(lds + VW + (32 * s + 8 * kg + q4) * VS + (16 * vt + 4 * p4) * 2, 4 * VS); a = __builtin_amdgcn_mfma_f32_16x16x32_bf16(aK[s], bW, a, 0, 0, 0); }
              MFMA_FENCE(a); cnew[t] = a; } }
        if (lat) {
            const int i0 = 16 * it + 4 * kg; const f32x4v cmv = *(const LAS f32x4v*)(vcm + i0), bv = *(const LAS f32x4v*)(vb_ + i0);
            float wi[4], mt[4];
#pragma unroll
            for (int r = 0; r < 4; ++r) { const float mi = fmaxf(m_in, cmv[r]); wi[r] = __expf(m_in - mi); mt[r] = bv[r] + mi; }
            bf16x8 aS[2];
            aS[0] = *(const LAS bf16x8*)(lds + SC + (16 * it + l15) * RS + (8 * kg) * 2); aS[1] = *(const LAS bf16x8*)(lds + SC + (16 * it + l15) * RS + (8 * kg + 32) * 2);
            f32x4v nacc[3];
#pragma unroll
            for (int t = 0; t < 3; ++t) { const int vt = (t == 2) ? 4 : 2 * t + vg; f32x4v a = (f32x4v){0.f, 0.f, 0.f, 0.f};
#pragma unroll
                for (int s = 0; s < 2; ++s) { const bf16x8 bC = *(const LAS bf16x8*)(lds + CI + (16 * vt + l15) * RS + (8 * kg + 32 * s) * 2); a = __builtin_amdgcn_mfma_f32_16x16x32_bf16(qf[s], bC, a, 0, 0, 0); }
                MFMA_FENCE(a);
#pragma unroll
                for (int r = 0; r < 4; ++r) a[r] *= wi[r];
#pragma unroll
                for (int s = 0; s < 2; ++s) { const bf16x8 bV = tr8(lds + VI + (32 * s + 8 * kg + q4) * VS + (16 * vt + 4 * p4) * 2, 4 * VS); a = __builtin_amdgcn_mfma_f32_16x16x32_bf16(aS[s], bV, a, 0, 0, 0); }
                MFMA_FENCE(a); nacc[t] = a; }
            float inv[4];
#pragma unroll
            for (int r = 0; r < 4; ++r) { const float den = __shfl(nacc[2][r], lane & 48); inv[r] = 1.f / fmaxf(fabsf(den), __expf(-mt[r])); }
#pragma unroll
            for (int t = 0; t < 2; ++t) { const int vt = 2 * t + vg;
#pragma unroll
                for (int r = 0; r < 4; ++r) *(LAS unsigned short*)(lds + QI + (i0 + r) * RS + (16 * vt + l15) * 2) = f2bf(nacc[t][r] * inv[r]); }
        }
        __syncthreads();
        if (lat) { const u32x4 hv = *(const LAS u32x4*)(lds + QI + srow * RS + sch * 16);
            if (DUMMY) { const u32x4 rv = *(const u32x4*)(HM + ((size_t)d * ML + R) * 512 + h * 128 + vh * 64 + sch * 8);
#define CMPH(a_, b_) do { const float x_ = (a_), y_ = (b_); if (fabsf(x_ - y_) > 0.05f * fmaxf(fabsf(x_), fabsf(y_)) + 0.02f) ++nbad; } while (0)
                CMPH(bf_lo(hv.x), bf_lo(rv.x)); CMPH(bf_hi(hv.x), bf_hi(rv.x)); CMPH(bf_lo(hv.y), bf_lo(rv.y)); CMPH(bf_hi(hv.y), bf_hi(rv.y));
                CMPH(bf_lo(hv.z), bf_lo(rv.z)); CMPH(bf_hi(hv.z), bf_hi(rv.z)); CMPH(bf_lo(hv.w), bf_lo(rv.w)); CMPH(bf_hi(hv.w), bf_hi(rv.w));
#undef CMPH
            } else *(u32x4*)(HM + ((size_t)d * ML + R) * 512 + h * 128 + vh * 64 + sch * 8) = hv; }
#pragma unroll
        for (int t = 0; t < 3; ++t) { cacc[t] = cnew[t]; const int vt = (t == 2) ? 4 : 2 * t + vg;
            if (t < 2 || wid < 4) { u32x2 o; o.x = pk2(cnew[t][0], cnew[t][1]); o.y = pk2(cnew[t][2], cnew[t][3]); *(LAS u32x2*)(lds + CI + (16 * vt + l15) * RS + (16 * it + 4 * kg) * 2) = o; } }
    }
    if (DUMMY) atomicAdd((unsigned*)(ws + WS_CTL) + 64, nbad);
    __syncthreads();
}


#ifndef MK_N_LAUNCHES
#define MK_N_LAUNCHES 1
#endif
constexpr int N_PHASES = 12;
constexpr int LDS_BYTES = 147456;
constexpr int RING_BYTES = 131072, MISC_OFF = RING_BYTES + 320;
constexpr int CW_BAR = 4096;

struct Args { const float* in[21]; float* out; unsigned char* ws; int ph_lo, ph_hi; };

__global__ void __launch_bounds__(NTHREADS, 2) hybrid_fwd(Args args) {
    extern __shared__ __attribute__((aligned(16))) unsigned char lds_raw[];
    LAS unsigned char* lds = (LAS unsigned char*)lds_raw;
    const int G = gridDim.x, bx = blockIdx.x;
    const int vcu = (G % 8 == 0) ? (bx % 8) * (G / 8) + bx / 8 : bx;
    typedef const __attribute__((address_space(4))) Args* ArgsP;
    ArgsP AP = (ArgsP)__builtin_amdgcn_kernarg_segment_ptr();
    asm volatile("" : "+s"(AP));
    unsigned char* ws = AP->ws;
#define I_x AP->in[0]
#define I_cvec AP->in[1]
#define I_ctx AP->in[2]
#define I_c_ctx AP->in[3]
#define I_mod_w AP->in[4]
#define I_mod_b AP->in[5]
#define I_pre_w AP->in[6]
#define I_post_w AP->in[7]
#define I_e_w_in AP->in[8]
#define I_e_sink AP->in[9]
#define I_e_conv_w AP->in[10]
#define I_e_w_out AP->in[11]
#define I_o_w_in AP->in[12]
#define I_o_qn AP->in[13]
#define I_o_kvn AP->in[14]
#define I_o_w_uq AP->in[15]
#define I_o_w_ukv AP->in[16]
#define I_o_ib AP->in[17]
#define I_o_fb AP->in[18]
#define I_o_hn AP->in[19]
#define I_o_w_out AP->in[20]
#define I_out AP->out
    float* MOD = (float*)(ws + WS_MOD);

    for (int u = threadIdx.x; u < (LDS_BYTES - RING_BYTES) / 4; u += NTHREADS) ((LAS unsigned*)(lds + RING_BYTES))[u] = 0u;
    __syncthreads();
    XcdBarrier bar; bar.bar = (unsigned*)(ws + WS_CTL) + CW_BAR; bar.x = 0; bar.st = nullptr;
    if (MK_N_LAUNCHES == 1) bar = xcd_barrier_post((unsigned*)(ws + WS_CTL) + CW_BAR, (volatile LAS unsigned*)(lds + MISC_OFF) + 8);
    const int lo = AP->ph_lo, hi = AP->ph_hi;
#ifndef PROBE_REP
#define PROBE_REP 0
#endif
#define NREP(k) ((((PROBE_REP) >> (k)) & 1) ? 2 : 1)
#ifndef PHASE_MASK
#define PHASE_MASK 0xFFF
#endif
#define IN(k) (((PHASE_MASK >> (k)) & 1) && lo <= (k) && (k) < hi)
#define SEAM(k) do { if (MK_N_LAUNCHES == 1 && IN((k) + 1)) xcd_barrier(bar); } while (0)
    const int ngw = G * NWAVES;
#define PH_IDS const int tid = my_tid(), lane = tid & 63, wave = __builtin_amdgcn_readfirstlane(tid >> 6), gw = vcu * NWAVES + wave; (void)lane; (void)gw

    if (IN(0)) { asm volatile("" : "+s"(AP)); PH_IDS;
        for (int rep_ = 0; rep_ < NREP(0); ++rep_) { if (rep_) __syncthreads();
        p0_mod(lds, I_cvec, I_c_ctx, I_mod_w, I_mod_b, MOD, G);
        __syncthreads();
        LAS float* scr = (LAS float*)(lds + wave * 16384);
        constexpr int I0 = 16 * (E_N / 32), I1 = 16 * 32, I2 = 16 * (O_N / 32), I3 = 12 * 24, I4 = 4 * 32, I5 = 16 * 32, NIT = I0 + I1 + I2 + I3 + I4 + I5;
        for (int it = gw; it < NIT; it += ngw) {
            int r = it;
            if (r < I0) { p0_transpose_item(I_e_w_in, 1024, E_N, (bf16_t*)(ws + WS_WEIN), 0, nullptr, scr, r, E_N / 32, lane); continue; } r -= I0;
            if (r < I1) { p0_transpose_item(I_e_w_out, 1024, 1024, (bf16_t*)(ws + WS_WEOUT), 1, nullptr, scr, r, 32, lane); continue; } r -= I1;
            if (r < I2) { p0_transpose_item(I_o_w_in, 1024, O_NSRC, (bf16_t*)(ws + WS_WOIN), 2, nullptr, scr, r, O_N / 32, lane); continue; } r -= I2;
            if (r < I3) { p0_transpose_item(I_o_w_uq, 768, 768, (bf16_t*)(ws + WS_WUQ), 3, I_o_qn, scr, r, 24, lane); continue; } r -= I3;
            if (r < I4) { p0_transpose_item(I_o_w_ukv, 256, 1024, (bf16_t*)(ws + WS_WUKV), 4, I_o_kvn, scr, r, 32, lane); continue; } r -= I4;
            p0_transpose_item(I_o_w_out, 1024, 1024, (bf16_t*)(ws + WS_WOOUT), 5, nullptr, scr, r, 32, lane);
        }
        float* ropeA = (float*)(ws + WS_ROPEA); float* ropeC = (float*)(ws + WS_ROPEC);
        for (int idx = bx * NTHREADS + tid; idx < 2048 * 48; idx += G * NTHREADS) {
            const int pos = idx / 48, j = idx % 48; const float rowf = (float)(pos >> 6), colf = (float)(pos & 63);
            if (j < 32) { const int f = j & 15; const float inv = exp2f(-(float)f * (13.287712379549449f / 16.f)); const float ang = ((j < 16) ? rowf : colf) * inv;
                ropeA[pos * 64 + j] = __cosf(ang); ropeA[pos * 64 + 32 + j] = __sinf(ang); }
            else { const int jj = j - 32, f = jj & 7; const float inv = exp2f(-(float)f * (13.287712379549449f / 8.f)); const float ang = ((jj < 8) ? rowf : colf) * inv;
                ropeC[pos * 32 + jj] = __cosf(ang); ropeC[pos * 32 + 16 + jj] = __sinf(ang); }
        }
        }
        SEAM(0);
    }
    if (IN(1)) { asm volatile("" : "+s"(AP)); PH_IDS; for (int rep_ = 0; rep_ < NREP(1); ++rep_) { if (rep_) __syncthreads();
        p1_prenorm(I_x, I_ctx, I_pre_w, MOD, (bf16_t*)(ws + WS_H), gw, ngw, lane); }
        SEAM(1); }
    if (IN(2)) { asm volatile("" : "+s"(AP)); PH_IDS;
        for (int rep_ = 0; rep_ < NREP(2); ++rep_) { if (rep_) __syncthreads();
        pg8::Gemm g{(const bf16_t*)(ws + WS_H), (const bf16_t*)(ws + WS_WEIN), MT, E_N, 1024}; pg8::RectOrder S; S.init(MT / 256, E_N / 256, 0, 0, 0, G, bx);
        EpiEin E{ws}; pg8::gemm_phase<EpiEin, pg8::RectOrder, true, true>(lds, g, S, E);
        }
        SEAM(2);
    }
    if (IN(3)) { asm volatile("" : "+s"(AP)); PH_IDS;
        for (int rep_ = 0; rep_ < NREP(3) + NREP(14) - 1; ++rep_) {
        for (int un = vcu * 4; un < vcu * 4 + 4; ++un) if (un < 1024) attn_unit<0>(lds, ws, I_e_sink, un);
        if (G != 256) for (int un = 4 * G + bx; un < 1024; un += G) attn_unit<0>(lds, ws, I_e_sink, un);
        for (int un = bx; un < 128; un += G) attn_unit<1>(lds, ws, I_e_sink, un);
        }
        for (int rep_ = 0; rep_ < NREP(3) + NREP(15) - 1; ++rep_) { p3_conv(ws, I_e_conv_w, bx * NTHREADS + tid, G * NTHREADS);
        }
        SEAM(3);
    }
    if (IN(4)) { asm volatile("" : "+s"(AP)); PH_IDS;
        for (int rep_ = 0; rep_ < NREP(4); ++rep_) { if (rep_) __syncthreads();
        pg8::Gemm g{(const bf16_t*)(ws + WS_U), (const bf16_t*)(ws + WS_WEOUT), MT, 1024, 1024}; pg8::RectOrder S; S.init(MT / 256, 4, 0, 0, 0, G, bx);
        EpiY E{(bf16_t*)(ws + WS_Y), (float*)(ws + WS_SSQY0)}; pg8::gemm_phase<EpiY, pg8::RectOrder, true, true>(lds, g, S, E);
        }
        SEAM(4);
    }
    if (IN(5)) { asm volatile("" : "+s"(AP)); PH_IDS; for (int rep_ = 0; rep_ < NREP(5); ++rep_) { if (rep_) __syncthreads();
        p5_post_pre(I_x, I_ctx, I_post_w, I_pre_w + 1024, MOD, (const bf16_t*)(ws + WS_Y), (const float*)(ws + WS_SSQY0), I_out, (bf16_t*)(ws + WS_H), gw, ngw, lane); }
        SEAM(5); }
    if (IN(6)) { asm volatile("" : "+s"(AP)); PH_IDS;
        for (int rep_ = 0; rep_ < NREP(6); ++rep_) { if (rep_) __syncthreads();
        pg8::Gemm g{(const bf16_t*)(ws + WS_H), (const bf16_t*)(ws + WS_WOIN), MT, O_N, 1024}; pg8::RectOrder S; S.init(ML / 256, O_N / 256, ML / 256, MC / 256, 5, G, bx);
        EpiOin E{ws}; pg8::gemm_phase<EpiOin, pg8::RectOrder, true, true>(lds, g, S, E);
        }
        SEAM(6);
    }
    if (IN(7)) { asm volatile("" : "+s"(AP)); PH_IDS;
        for (int rep_ = 0; rep_ < NREP(7); ++rep_) { if (rep_) __syncthreads();
        { pg8::Gemm g{(const bf16_t*)(ws + WS_CQ), (const bf16_t*)(ws + WS_WUQ), ML, 768, 768}; pg8::RectOrder S; S.init(ML / 256, 3, 0, 0, 0, G, bx);
          EpiUq E{ws}; pg8::gemm_phase<EpiUq, pg8::RectOrder, true, true>(lds, g, S, E); }
        __syncthreads();
        { pg8::Gemm g{(const bf16_t*)(ws + WS_CKV), (const bf16_t*)(ws + WS_WUKV), MT, 1024, 256}; pg8::RectOrder S; S.init(MT / 256, 4, 0, 0, 0, G, G - 1 - bx);
          EpiUkv E{ws}; pg8::gemm_phase<EpiUkv, pg8::RectOrder, true, true>(lds, g, S, E); }
        }
        SEAM(7);
    }
    if (IN(8)) { asm volatile("" : "+s"(AP)); PH_IDS;
        for (int rep_ = 0; rep_ < NREP(8) + NREP(12) - 1; ++rep_) { for (int ch = bx; ch < 256; ch += G) mlstm_chain_mfma<false>(lds, ws, I_o_ib, I_o_fb, ch);
        }
        for (int rep_ = 0; rep_ < NREP(8) + NREP(13) - 1; ++rep_) {
        for (int un = vcu * 4; un < vcu * 4 + 4; ++un) if (un < 1024) attn_unit<2>(lds, ws, nullptr, un);
        if (G != 256) for (int un = 4 * G + bx; un < 1024; un += G) attn_unit<2>(lds, ws, nullptr, un);
        }
        SEAM(8);
    }
    if (IN(9)) { asm volatile("" : "+s"(AP)); PH_IDS; for (int rep_ = 0; rep_ < NREP(9); ++rep_) { if (rep_) __syncthreads();
        p9_readout(ws, I_o_hn, gw, ngw, lane); }
        SEAM(9); }
    if (IN(10)) { asm volatile("" : "+s"(AP)); PH_IDS;
        for (int rep_ = 0; rep_ < NREP(10); ++rep_) { if (rep_) __syncthreads();
        pg8::Gemm g{(const bf16_t*)(ws + WS_U), (const bf16_t*)(ws + WS_WOOUT), ML, 1024, 1024}; pg8::RectOrder S; S.init(ML / 256, 4, 0, 0, 0, G, bx);
        EpiY E{(bf16_t*)(ws + WS_Y), (float*)(ws + WS_SSQY1)}; pg8::gemm_phase<EpiY, pg8::RectOrder, true, true>(lds, g, S, E);
        }
        SEAM(10);
    }
    if (IN(11)) { asm volatile("" : "+s"(AP)); PH_IDS; p11_final(I_post_w + 1024, MOD, (const bf16_t*)(ws + WS_Y), (const float*)(ws + WS_SSQY1), I_out, gw, ngw, lane); }
#undef IN
#undef SEAM
#undef I_x
#undef I_cvec
#undef I_ctx
#undef I_c_ctx
#undef I_mod_w
#undef I_mod_b
#undef I_pre_w
#undef I_post_w
#undef I_e_w_in
#undef I_e_sink
#undef I_e_conv_w
#undef I_e_w_out
#undef I_o_w_in
#undef I_o_qn
#undef I_o_kvn
#undef I_o_w_uq
#undef I_o_w_ukv
#undef I_o_ib
#undef I_o_fb
#undef I_o_hn
#undef I_o_w_out
#undef I_out
}

extern "C" void kernel_launch(void* const* d_in, const int* in_sizes, int n_in, void* d_out, int out_size, void* d_ws, size_t ws_size, hipStream_t stream) {
    static int grid = 0;
    if (grid == 0) {
        if (n_in != 21 || in_sizes[0] != ML * DM || out_size != ML * DM || ws_size < WS_END) { fprintf(stderr, "kernel_launch: unexpected shapes / workspace (n_in %d, ws %zu < %zu); nothing launched\n", n_in, ws_size, (size_t)WS_END); grid = -1; return; }
        int dev = 0, cus = 0, per_cu = 0;
        if (hipGetDevice(&dev) != hipSuccess || hipDeviceGetAttribute(&cus, hipDeviceAttributeMultiprocessorCount, dev) != hipSuccess) { grid = -1; return; }
        if (hipFuncSetAttribute((const void*)hybrid_fwd, hipFuncAttributeMaxDynamicSharedMemorySize, LDS_BYTES) != hipSuccess) { fprintf(stderr, "kernel_launch: hipFuncSetAttribute failed\n"); grid = -1; return; }
        if (hipOccupancyMaxActiveBlocksPerMultiprocessor(&per_cu, (const void*)hybrid_fwd, NTHREADS, LDS_BYTES) != hipSuccess || per_cu < 1) fprintf(stderr, "kernel_launch: note: occupancy query reports %d workgroups per CU\n", per_cu);
        (void)hipGetLastError();
        grid = cus;
    }
    if (grid < 0) return;
    if (hipMemsetAsync((char*)d_ws + WS_CTL, 0, CTL_ZERO_BYTES, stream) != hipSuccess) { fprintf(stderr, "kernel_launch: hipMemsetAsync failed\n"); return; }
    Args a{};
    for (int i = 0; i < 21; ++i) a.in[i] = (const float*)d_in[i];
    a.out = (float*)d_out; a.ws = (unsigned char*)d_ws;
    if (MK_N_LAUNCHES == 1) { a.ph_lo = 0; a.ph_hi = N_PHASES; hipLaunchKernelGGL(hybrid_fwd, dim3(grid), dim3(NTHREADS), LDS_BYTES, stream, a); }
    else for (int p = 0; p < N_PHASES; ++p) { a.ph_lo = p; a.ph_hi = p + 1; hipLaunchKernelGGL(hybrid_fwd, dim3(grid), dim3(NTHREADS), LDS_BYTES, stream, a); }
    const hipError_t le = hipPeekAtLastError();
    if (le != hipSuccess) fprintf(stderr, "kernel_launch: launch failed: %s\n", hipGetErrorName(le));
}
```

```cpp
#include <hip/hip_runtime.h>
#include <cstdio>
#include <cstdint>

#define LAS __attribute__((address_space(3)))
#define GAS __attribute__((address_space(1)))
typedef unsigned short bf16_t;
typedef short bf16x8 __attribute__((ext_vector_type(8)));
typedef short s16x4 __attribute__((ext_vector_type(4)));
typedef float f32x4 __attribute__((ext_vector_type(4)));
typedef float f32x16 __attribute__((ext_vector_type(16)));
typedef unsigned u32x4 __attribute__((ext_vector_type(4)));
typedef unsigned u32x2 __attribute__((ext_vector_type(2)));
typedef float f32x2_t __attribute__((ext_vector_type(2)));
typedef __bf16 bf16x2_t __attribute__((ext_vector_type(2)));

constexpr int NB = 16, SEQ = 2048, DM = 1024, CL = 256;
constexpr int ML = NB * SEQ, MC = NB * CL, MT = ML + MC;
constexpr float EPS = 1e-6f, LOG2E = 1.4426950408889634f;
constexpr int E_N = 3328, O_NSRC = 3632, O_N = 3840;
constexpr int NWAVES = 8, NTHREADS = 512;

__device__ __forceinline__ float bf_lo(unsigned w) { return __uint_as_float(w << 16); }
__device__ __forceinline__ float bf_hi(unsigned w) { return __uint_as_float(w & 0xffff0000u); }
__device__ __forceinline__ unsigned pk2(float lo, float hi) { f32x2_t v = {lo, hi}; bf16x2_t b = __builtin_convertvector(v, bf16x2_t); return __builtin_bit_cast(unsigned, b); }
__device__ __forceinline__ float silu_f(float x) { return x * __builtin_amdgcn_rcpf(1.f + __expf(-x)); }
__device__ __forceinline__ float sigmoid_f(float x) { return __builtin_amdgcn_rcpf(1.f + __expf(-x)); }
__device__ __forceinline__ float wave_sum(float v) {
#pragma unroll
    for (int o = 1; o < 64; o <<= 1) v += __shfl_xor(v, o);
    return v;
}
#define LDS_WAIT() asm volatile("s_waitcnt lgkmcnt(0)" ::: "memory")
#define VM_WAIT() asm volatile("s_waitcnt vmcnt(0)" ::: "memory")

__device__ __forceinline__ int my_tid() { int t = threadIdx.x; asm volatile("" : "+v"(t)); return t; }

namespace pg8 {
#define PG8_LAS __attribute__((address_space(3)))
typedef unsigned short bf16_t;
typedef short bf16x8 __attribute__((ext_vector_type(8)));
typedef float f32x4 __attribute__((ext_vector_type(4)));
typedef unsigned u32x4 __attribute__((ext_vector_type(4)));
constexpr int BM = 256, BK = 64, HALF = 128, HTB = HALF * BK * 2  , STAGE_BYTES = 8 * HTB, NXCD = 8, WGM = 8;

__host__ __device__ __forceinline__ int lds_byte(int r, int c) { const int st = (r >> 4) * 2 + (c >> 5), rr = r & 15, cc = c & 31, ob = rr * 64 + cc * 2; return st * 1024 + (ob ^ (((ob >> 9) & 1) << 5)); }
__host__ __device__ __forceinline__ void stage_rc(int b, int& R, int& C) { const int st = b / 1024, sb = b % 1024, swz = sb ^ (((sb >> 9) & 1) << 5); R = (st >> 1) * 16 + swz / 64; C = (st & 1) * 32 + (swz % 64) / 2; }
__host__ __device__ __forceinline__ int perm32(int rho) { const int n = rho >> 4, i = rho & 15; return 8 * (i >> 2) + 4 * n + (i & 3); }

struct Unit { int pm, pn; };
struct Gemm { const bf16_t* A; const bf16_t* Bt; int M, N, K; };

struct RectOrder {
    int nM0, nN0, n0, pm1, nM1, nN1, n1, G, c;
    __device__ __forceinline__ void init(int nM0_, int nN0_, int pm1_, int nM1_, int nN1_, int G_, int c_) { nM0 = nM0_; nN0 = nN0_; n0 = nM0_ * nN0_; pm1 = pm1_; nM1 = nM1_; nN1 = nN1_; n1 = nM1_ * nN1_; G = G_; c = c_; }
    __device__ __forceinline__ static void rect(int w, int nM, int nN, int& pm, int& pn) {
        const int nig = WGM * nN, gid = w / nig, fm = gid * WGM, gsz = (nM - fm) < WGM ? (nM - fm) : WGM;
        pm = fm + ((w % nig) % gsz); pn = (w % nig) / gsz;
    }
    __device__ __forceinline__ bool next(int i, Unit& u) const {
        const int nwg = n0 + n1; const long L = (long)i * G + c; if (L >= nwg) return false;
        int wgid = (int)L; { const int q = nwg / NXCD, r = nwg % NXCD, xcd = wgid % NXCD, off = wgid / NXCD; wgid = (xcd < r ? xcd * (q + 1) : r * (q + 1) + (xcd - r) * q) + off; }
        if (wgid < n0) rect(wgid, nM0, nN0, u.pm, u.pn); else { rect(wgid - n0, nM1, nN1, u.pm, u.pn); u.pm += pm1; }
        return true;
    }
    __device__ __forceinline__ void a_ready(const Unit&) const {}
    __device__ __forceinline__ void done(const Unit&) const {}
};

template <class Epi, class Sched, bool ALIGN_EPI = false, bool SP2 = false>
__device__ __forceinline__ void gemm_phase(PG8_LAS unsigned char* lds, const Gemm g, const Sched& S, const Epi& E) {
    const int tid = my_tid(), wid = __builtin_amdgcn_readfirstlane(tid >> 6), lane = tid & 63, wr = wid >> 2, wc = wid & 3, fr = lane & 15, fq = lane >> 4;
    const int K = g.K, nt = K / BK;
    unsigned voffA[2], voffB[2];
#pragma unroll
    for (int i = 0; i < 2; ++i) { int R, C; stage_rc(tid * 16 + i * 8192, R, C); const int Rb = Epi::PERM ? ((R & ~31) + perm32(R & 31)) : R;
        voffA[i] = (unsigned)(R * K + C) * 2u; voffB[i] = (unsigned)(Rb * K + C) * 2u; }
    const size_t kstep = (size_t)(BK * 2);
    const size_t hstep = (size_t)HALF * K * 2;
    const size_t tstep = 2 * hstep;
    const unsigned ldsw = (unsigned)wid * 1024u;
    const int aoff = lds_byte(wr * 64 + fr, fq * 8), boff = lds_byte(wc * 32 + fr, fq * 8);
#define PG8_SA(b, h) (((b) * 2 + (h)) * HTB)
#define PG8_SB(b, h) ((4 + (b) * 2 + (h)) * HTB)
#define PG8_STAGE(bufoff, gbase, voff) do { _Pragma("unroll") for (int _i = 0; _i < 2; ++_i) \
        __builtin_amdgcn_global_load_lds((const unsigned*)((const char*)(gbase) + (voff)[_i]), (PG8_LAS unsigned*)(lds + (bufoff) + ldsw + _i * 8192), 16, 0, 0); } while (0)
#define PG8_LDA(dst, b, h) do { _Pragma("unroll") for (int m = 0; m < 4; ++m) _Pragma("unroll") for (int k = 0; k < 2; ++k) dst[m][k] = *(const PG8_LAS bf16x8*)(lds + PG8_SA(b, h) + aoff + m * 2048 + k * 1024); } while (0)
#define PG8_LDB(dst, b, h) do { _Pragma("unroll") for (int n = 0; n < 2; ++n) _Pragma("unroll") for (int k = 0; k < 2; ++k) dst[n][k] = *(const PG8_LAS bf16x8*)(lds + PG8_SB(b, h) + boff + n * 2048 + k * 1024); } while (0)
#define PG8_MMA(ai, bj, At, Bt) do { __builtin_amdgcn_s_setprio(1); _Pragma("unroll") for (int m = 0; m < 4; ++m) _Pragma("unroll") for (int n = 0; n < 2; ++n) _Pragma("unroll") for (int k = 0; k < 2; ++k) \
        acc[ai][bj][m][n] = __builtin_amdgcn_mfma_f32_16x16x32_bf16(Bt[n][k], At[m][k], acc[ai][bj][m][n], 0, 0, 0); __builtin_amdgcn_s_setprio(0); } while (0)
#define PG8_WAIT_V(n) asm volatile("s_waitcnt vmcnt(" #n ")" ::: "memory")
#define PG8_WAIT_L(n) asm volatile("s_waitcnt lgkmcnt(" #n ")" ::: "memory")
#define PG8_BAR __builtin_amdgcn_s_barrier()
#define PG8_SCHED __builtin_amdgcn_sched_barrier(0)
    Unit cur, nxt; int ui = 0;
    if (!S.next(0, cur)) return;
    f32x4 acc[2][2][4][2];
#pragma unroll
    for (int a = 0; a < 2; ++a)
#pragma unroll
        for (int b = 0; b < 2; ++b)
#pragma unroll
            for (int m = 0; m < 4; ++m)
#pragma unroll
                for (int n = 0; n < 2; ++n) acc[a][b][m][n] = (f32x4){0.f, 0.f, 0.f, 0.f};
    bf16x8 At[4][2], B0[2][2], B1[2][2];
    const char* cA = (const char*)g.A + (size_t)cur.pm * tstep; const char* cB = (const char*)g.Bt + (size_t)cur.pn * tstep;
    S.a_ready(cur);
    if constexpr (SP2) {
        PG8_STAGE(PG8_SB(0, 0), cB, voffB); PG8_STAGE(PG8_SB(0, 1), cB + hstep, voffB); PG8_STAGE(PG8_SA(0, 0), cA, voffA); PG8_STAGE(PG8_SA(0, 1), cA + hstep, voffA);
        if (wr == 1) PG8_BAR;
        PG8_WAIT_V(2); PG8_BAR;
        PG8_STAGE(PG8_SB(1, 0), cB + kstep, voffB); PG8_STAGE(PG8_SA(1, 0), cA + kstep, voffA); PG8_STAGE(PG8_SB(1, 1), cB + hstep + kstep, voffB);
        PG8_WAIT_V(6); PG8_BAR;
    } else {
        PG8_STAGE(PG8_SB(0, 0), cB, voffB); PG8_STAGE(PG8_SA(0, 0), cA, voffA); PG8_STAGE(PG8_SB(0, 1), cB + hstep, voffB); PG8_STAGE(PG8_SA(0, 1), cA + hstep, voffA);
        if (wr == 1) PG8_BAR;
        PG8_WAIT_V(4); PG8_BAR;
        PG8_STAGE(PG8_SB(1, 0), cB + kstep, voffB); PG8_STAGE(PG8_SA(1, 0), cA + kstep, voffA); PG8_STAGE(PG8_SB(1, 1), cB + hstep + kstep, voffB);
        PG8_WAIT_V(6); PG8_BAR;
    }
    for (;;) {
        const bool has_next = S.next(ui + 1, nxt);
        const char* nA = has_next ? (const char*)g.A + (size_t)nxt.pm * tstep : cA; const char* nB = has_next ? (const char*)g.Bt + (size_t)nxt.pn * tstep : cB;
        for (int t = 0; t < nt; t += 2) {
            const bool last = (t == nt - 2);
            const char* a1 = cA + (size_t)(t + 1) * kstep;
            const char* a2 = last ? nA : cA + (size_t)(t + 2) * kstep; const char* b2 = last ? nB : cB + (size_t)(t + 2) * kstep;
            const char* a3 = a2 + kstep; const char* b3 = b2 + kstep;
            if (last && has_next) S.a_ready(nxt);
            if constexpr (SP2) {
            PG8_LDB(B0, 0, 0); PG8_LDB(B1, 0, 1); PG8_SCHED; PG8_LDA(At, 0, 0); PG8_STAGE(PG8_SA(1, 1), a1 + hstep, voffA);
            PG8_WAIT_V(8); PG8_WAIT_L(0); PG8_BAR; PG8_MMA(0, 0, At, B0); PG8_MMA(0, 1, At, B1); PG8_BAR; PG8_SCHED;
            PG8_LDA(At, 0, 1); PG8_STAGE(PG8_SB(0, 0), b2, voffB); PG8_STAGE(PG8_SB(0, 1), b2 + hstep, voffB); PG8_STAGE(PG8_SA(0, 0), a2, voffA);
            PG8_WAIT_V(8); PG8_WAIT_L(0); PG8_BAR; PG8_MMA(1, 0, At, B0); PG8_MMA(1, 1, At, B1); PG8_BAR; PG8_SCHED;
            PG8_LDB(B0, 1, 0); PG8_LDB(B1, 1, 1); PG8_SCHED; PG8_LDA(At, 1, 0); PG8_STAGE(PG8_SA(0, 1), a2 + hstep, voffA);
            PG8_WAIT_V(8); PG8_WAIT_L(0); PG8_BAR; PG8_MMA(0, 0, At, B0); PG8_MMA(0, 1, At, B1); PG8_BAR; PG8_SCHED;
            PG8_LDA(At, 1, 1); PG8_STAGE(PG8_SB(1, 0), b3, voffB); PG8_STAGE(PG8_SB(1, 1), b3 + hstep, voffB); PG8_STAGE(PG8_SA(1, 0), a3, voffA);
            PG8_WAIT_V(8); PG8_WAIT_L(0); PG8_BAR; PG8_MMA(1, 0, At, B0); PG8_MMA(1, 1, At, B1); PG8_BAR; PG8_SCHED;
            } else {
            PG8_LDB(B0, 0, 0); PG8_SCHED; PG8_LDA(At, 0, 0); PG8_STAGE(PG8_SA(1, 1), a1 + hstep, voffA);
            PG8_WAIT_L(8); PG8_BAR; PG8_WAIT_L(0); PG8_MMA(0, 0, At, B0); PG8_BAR; PG8_SCHED;
            PG8_LDB(B1, 0, 1); PG8_STAGE(PG8_SB(0, 0), b2, voffB);
            PG8_BAR; PG8_WAIT_L(0); PG8_MMA(0, 1, At, B1); PG8_BAR;
            PG8_LDA(At, 0, 1); PG8_STAGE(PG8_SA(0, 0), a2, voffA);
            PG8_BAR; PG8_WAIT_L(0); PG8_MMA(1, 0, At, B0); PG8_BAR; PG8_SCHED;
            PG8_STAGE(PG8_SB(0, 1), b2 + hstep, voffB);
            PG8_WAIT_V(6); PG8_BAR; PG8_MMA(1, 1, At, B1); PG8_BAR;
            PG8_LDB(B0, 1, 0); PG8_SCHED; PG8_LDA(At, 1, 0); PG8_STAGE(PG8_SA(0, 1), a2 + hstep, voffA);
            PG8_WAIT_L(8); PG8_BAR; PG8_WAIT_L(0); PG8_MMA(0, 0, At, B0); PG8_BAR; PG8_SCHED;
            PG8_LDB(B1, 1, 1); PG8_STAGE(PG8_SB(1, 0), b3, voffB);
            PG8_BAR; PG8_WAIT_L(0); PG8_MMA(0, 1, At, B1); PG8_BAR;
            PG8_LDA(At, 1, 1); PG8_STAGE(PG8_SA(1, 0), a3, voffA);
            PG8_BAR; PG8_WAIT_L(0); PG8_MMA(1, 0, At, B0); PG8_BAR; PG8_SCHED;
            PG8_STAGE(PG8_SB(1, 1), b3 + hstep, voffB);
            PG8_WAIT_V(6); PG8_BAR; PG8_MMA(1, 1, At, B1); PG8_BAR;
            }
        }
        if constexpr (ALIGN_EPI) { if (wr == 0) PG8_BAR; }
        if constexpr (!Epi::AFTER_DRAIN) { E(acc, cur, wr, wc, fr, fq); S.done(cur); }
        if (!has_next) break;
#pragma unroll
        for (int a = 0; a < 2; ++a)
#pragma unroll
            for (int b = 0; b < 2; ++b)
#pragma unroll
                for (int m = 0; m < 4; ++m)
#pragma unroll
                    for (int n = 0; n < 2; ++n) acc[a][b][m][n] = (f32x4){0.f, 0.f, 0.f, 0.f};
        cur = nxt; cA = nA; cB = nB; ++ui;
        if constexpr (ALIGN_EPI) { if (wr == 1) PG8_BAR; }
    }
    PG8_WAIT_V(0);
    if constexpr (!ALIGN_EPI) { if (wr == 0) PG8_BAR; }
    PG8_BAR;
    if constexpr (Epi::AFTER_DRAIN) { E.fused(acc, cur, wr, wc, fr, fq, lds, wid, lane); S.done(cur); }
#undef PG8_SA
#undef PG8_SB
#undef PG8_STAGE
#undef PG8_LDA
#undef PG8_LDB
#undef PG8_MMA
#undef PG8_WAIT_V
#undef PG8_WAIT_L
#undef PG8_BAR
#undef PG8_SCHED
}
}

constexpr size_t MiB = 1u << 20;
constexpr size_t WS_CTL = 0, CTL_ZERO_BYTES = 1 * MiB;
constexpr size_t WS_MOD = 1 * MiB;
constexpr size_t WS_ROPEA = 2 * MiB;
constexpr size_t WS_ROPEC = 2 * MiB + 512 * 1024;
constexpr size_t WS_WEIN = 3 * MiB, WS_WEOUT = 10 * MiB, WS_WOIN = 12 * MiB, WS_WUQ = 20 * MiB, WS_WUKV = 21 * MiB + 512 * 1024, WS_WOOUT = 22 * MiB;
constexpr size_t WS_H = 24 * MiB;
constexpr size_t WS_U = 96 * MiB;
constexpr size_t WS_Y = 168 * MiB;
constexpr size_t WS_R = 240 * MiB;
constexpr size_t WS_KVE = WS_R  , WS_QE = WS_R + 18 * MiB, WS_PE = WS_R + 54 * MiB, WS_GE = WS_R + 90 * MiB, WS_ZA = WS_R + 126 * MiB, WS_SSQY0 = WS_R + 162 * MiB;
constexpr size_t WS_CKV = WS_R, WS_CQ = WS_R + 18 * MiB, WS_HM = WS_R  , WS_MK = WS_R + 66 * MiB, WS_MV = WS_R + 84 * MiB, WS_KR = WS_R + 120 * MiB, WS_GATES = WS_R + 123 * MiB,
                 WS_SSQCKV = WS_R + 126 * MiB, WS_SSQCQ = WS_R + 127 * MiB, WS_MQ = WS_R + 129 * MiB, WS_MO = WS_R + 145 * MiB, WS_ZO = WS_R + 177 * MiB, WS_SSQY1 = WS_R + 241 * MiB;
constexpr size_t WS_KNV = WS_H  , WS_QO = WS_Y;
constexpr size_t WS_END = WS_R + 244 * MiB;
static_assert(WS_SSQY0 + (size_t)MT * 16 * 4 <= WS_R + 165 * MiB && WS_HM + (size_t)2 * ML * 512 * 2 <= WS_MK && WS_SSQY1 + (size_t)MT * 16 * 4 <= WS_END, "ws map");

__device__ __forceinline__ void st8(bf16_t* p, f32x4 a, f32x4 b) { u32x4 w; w.x = pk2(a[0], a[1]); w.y = pk2(a[2], a[3]); w.z = pk2(b[0], b[1]); w.w = pk2(b[2], b[3]); *(u32x4*)p = w; }
__device__ __forceinline__ bf16_t f2bf(float v) { return (bf16_t)(pk2(v, 0.f) & 0xffffu); }
__device__ __forceinline__ void rope8(f32x4& a, f32x4& b, const float* cosp, const float* sinp) {
    const f32x4 cs = *(const f32x4*)cosp, sn = *(const f32x4*)sinp;
    const float a0 = a[0] * cs[0] - a[1] * sn[0], a1 = a[0] * sn[0] + a[1] * cs[0], a2 = a[2] * cs[1] - a[3] * sn[1], a3 = a[2] * sn[1] + a[3] * cs[1];
    const float b0 = b[0] * cs[2] - b[1] * sn[2], b1 = b[0] * sn[2] + b[1] * cs[2], b2 = b[2] * cs[3] - b[3] * sn[3], b3 = b[2] * sn[3] + b[3] * cs[3];
    a = (f32x4){a0, a1, a2, a3}; b = (f32x4){b0, b1, b2, b3};
}
__device__ __forceinline__ f32x4 silu4(f32x4 v) { return (f32x4){silu_f(v[0]), silu_f(v[1]), silu_f(v[2]), silu_f(v[3])}; }
__device__ __forceinline__ f32x4 sigm4(f32x4 v) { return (f32x4){sigmoid_f(v[0]), sigmoid_f(v[1]), sigmoid_f(v[2]), sigmoid_f(v[3])}; }
__device__ __forceinline__ float sq4(f32x4 v) { return (v[0] * v[0] + v[1] * v[1]) + (v[2] * v[2] + v[3] * v[3]); }

struct EpiEin {
    static constexpr bool PERM = true, AFTER_DRAIN = false;
    unsigned char* ws;
    __device__ __forceinline__ void operator()(const f32x4 (&acc)[2][2][4][2], const pg8::Unit& u, int wr, int wc, int fr, int fq) const {
        const int pn = u.pn, rbase = u.pm * 256 + wr * 64 + fr, cw = wc * 32 + 8 * fq;
        const float* ropeA = (const float*)(ws + WS_ROPEA);
#pragma unroll
        for (int ai = 0; ai < 2; ++ai)
#pragma unroll
            for (int m = 0; m < 4; ++m) {
                asm volatile("" ::: "memory"); const int R = rbase + ai * 128 + m * 16; const bool lat = R < ML; const int pos = R & 2047;
                if (pn == 0) {
                    f32x4 a = acc[ai][0][m][0], b = acc[ai][0][m][1];
                    if (lat) { const int i0 = (cw & 63) >> 1; rope8(a, b, ropeA + pos * 64 + i0, ropeA + pos * 64 + 32 + i0); }
                    st8((bf16_t*)(ws + WS_KVE) + (size_t)R * 256 + cw, a, b);
                    st8((bf16_t*)(ws + WS_KVE) + (size_t)R * 256 + 128 + cw, acc[ai][1][m][0], acc[ai][1][m][1]);
                } else if (pn <= 2) {
#pragma unroll
                    for (int bj = 0; bj < 2; ++bj) {
                        f32x4 a = acc[ai][bj][m][0], b = acc[ai][bj][m][1];
                        if (lat) { const int i0 = (cw & 63) >> 1; rope8(a, b, ropeA + pos * 64 + i0, ropeA + pos * 64 + 32 + i0); }
                        const float sc = 0.125f * LOG2E; a = a * sc; b = b * sc;
                        st8((bf16_t*)(ws + WS_QE) + (size_t)R * 512 + (pn - 1) * 256 + bj * 128 + cw, a, b);
                    }
                } else if (pn <= 6) {
                    st8((bf16_t*)(ws + WS_PE) + (size_t)R * 512 + (pn - 3) * 128 + cw, acc[ai][0][m][0] * acc[ai][1][m][0], acc[ai][0][m][1] * acc[ai][1][m][1]);
                } else if (pn <= 10) {
                    st8((bf16_t*)(ws + WS_GE) + (size_t)R * 512 + (pn - 7) * 128 + cw, acc[ai][0][m][0] * silu4(acc[ai][1][m][0]), acc[ai][0][m][1] * silu4(acc[ai][1][m][1]));
                } else {
#pragma unroll
                    for (int bj = 0; bj < 2; ++bj)
                        st8((bf16_t*)(ws + WS_ZA) + (size_t)R * 512 + (pn - 11) * 256 + bj * 128 + cw, silu4(acc[ai][bj][m][0]), silu4(acc[ai][bj][m][1]));
                }
            }
    }
};

struct EpiY {
    static constexpr bool PERM = true, AFTER_DRAIN = false;
    bf16_t* Y; float* SSQ;
    __device__ __forceinline__ void operator()(const f32x4 (&acc)[2][2][4][2], const pg8::Unit& u, int wr, int wc, int fr, int fq) const {
        const int pn = u.pn, rbase = u.pm * 256 + wr * 64 + fr, cw = wc * 32 + 8 * fq;
#pragma unroll
        for (int ai = 0; ai < 2; ++ai)
#pragma unroll
            for (int m = 0; m < 4; ++m) {
                asm volatile("" ::: "memory"); const int R = rbase + ai * 128 + m * 16; float s = 0.f;
#pragma unroll
                for (int bj = 0; bj < 2; ++bj) { st8(Y + (size_t)R * 1024 + pn * 256 + bj * 128 + cw, acc[ai][bj][m][0], acc[ai][bj][m][1]); s += sq4(acc[ai][bj][m][0]) + sq4(acc[ai][bj][m][1]); }
                s += __shfl_xor(s, 16); s += __shfl_xor(s, 32);
                if (fq == 0) SSQ[(size_t)R * 16 + pn * 4 + wc] = s;
            }
    }
};

struct EpiOin {
    static constexpr bool PERM = true, AFTER_DRAIN = false;
    unsigned char* ws;
    __device__ __forceinline__ void operator()(const f32x4 (&acc)[2][2][4][2], const pg8::Unit& u, int wr, int wc, int fr, int fq) const {
        const int pn = u.pn, rbase = u.pm * 256 + wr * 64 + fr, cw = wc * 32 + 8 * fq;
        const float* ropeC = (const float*)(ws + WS_ROPEC);
#pragma unroll
        for (int ai = 0; ai < 2; ++ai)
#pragma unroll
            for (int m = 0; m < 4; ++m) {
                asm volatile("" ::: "memory"); const int R = rbase + ai * 128 + m * 16; const bool lat = R < ML; const int pos = R & 2047;
                if (pn == 0 || (pn >= 5 && pn <= 7)) {
                    float s = 0.f;
                    bf16_t* dst = (pn == 0) ? (bf16_t*)(ws + WS_CKV) + (size_t)R * 256 : (bf16_t*)(ws + WS_CQ) + (size_t)R * 768 + (pn - 5) * 256;
#pragma unroll
                    for (int bj = 0; bj < 2; ++bj) { st8(dst + bj * 128 + cw, acc[ai][bj][m][0], acc[ai][bj][m][1]); s += sq4(acc[ai][bj][m][0]) + sq4(acc[ai][bj][m][1]); }
                    s += __shfl_xor(s, 16); s += __shfl_xor(s, 32);
                    if (fq == 0) { if (pn == 0) ((float*)(ws + WS_SSQCKV))[(size_t)R * 4 + wc] = s; else ((float*)(ws + WS_SSQCQ))[(size_t)R * 12 + (pn - 5) * 4 + wc] = s; }
                } else if (pn == 4) {
                    if (wc == 0) {
                        f32x4 a = acc[ai][0][m][0], b = acc[ai][0][m][1];
                        if (lat) { const int i0 = cw >> 1; rope8(a, b, ropeC + pos * 32 + i0, ropeC + pos * 32 + 16 + i0); }
                        st8((bf16_t*)(ws + WS_KR) + (size_t)R * 32 + cw, a, b);
                    } else if (wc == 1 && fq < 2) {
                        float* g = (float*)(ws + WS_GATES) + (size_t)R * 16 + 8 * fq;
                        *(f32x4*)g = acc[ai][0][m][0]; *(f32x4*)(g + 4) = acc[ai][0][m][1];
                    }
                } else {
#pragma unroll
                    for (int bj = 0; bj < 2; ++bj) {
                        const f32x4 a = acc[ai][bj][m][0], b = acc[ai][bj][m][1]; const int col = bj * 128 + cw;
                        if (pn == 1) st8((bf16_t*)(ws + WS_MK) + (size_t)R * 256 + col, a * 0.125f, b * 0.125f);
                        else if (pn <= 3) st8((bf16_t*)(ws + WS_MV) + (size_t)R * 512 + (pn - 2) * 256 + col, a, b);
                        else if (pn == 8) st8((bf16_t*)(ws + WS_MQ) + (size_t)R * 256 + col, a, b);
                        else if (pn <= 10) st8((bf16_t*)(ws + WS_MO) + (size_t)R * 512 + (pn - 9) * 256 + col, sigm4(a), sigm4(b));
                        else st8((bf16_t*)(ws + WS_ZO) + (size_t)R * 1024 + (pn - 11) * 256 + col, silu4(a), silu4(b));
                    }
                }
            }
    }
};

struct EpiUkv {
    static constexpr bool PERM = true, AFTER_DRAIN = false;
    unsigned char* ws;
    __device__ __forceinline__ void operator()(const f32x4 (&acc)[2][2][4][2], const pg8::Unit& u, int wr, int wc, int fr, int fq) const {
        const int pn = u.pn, rbase = u.pm * 256 + wr * 64 + fr, cw = wc * 32 + 8 * fq;
#pragma unroll
        for (int ai = 0; ai < 2; ++ai)
#pragma unroll
            for (int m = 0; m < 4; ++m) {
                asm volatile("" ::: "memory"); const int R = rbase + ai * 128 + m * 16;
                const f32x4 sp = *(const f32x4*)((const float*)(ws + WS_SSQCKV) + (size_t)R * 4);
                const float rstd = rsqrtf(((sp[0] + sp[1]) + (sp[2] + sp[3])) * (1.f / 256.f) + EPS);
                int b, pos; if (R < ML) { b = R >> 11; pos = 256 + (R & 2047); } else { const int rc = R - ML; b = rc >> 8; pos = rc & 255; }
#pragma unroll
                for (int bj = 0; bj < 2; ++bj) {
                    const int head = pn * 2 + bj;
                    st8((bf16_t*)(ws + WS_KNV) + ((size_t)(b * 8 + head) * 2304 + pos) * 128 + cw, acc[ai][bj][m][0] * rstd, acc[ai][bj][m][1] * rstd);
                }
            }
    }
};

struct EpiUq {
    static constexpr bool PERM = true, AFTER_DRAIN = false;
    unsigned char* ws;
    __device__ __forceinline__ void operator()(const f32x4 (&acc)[2][2][4][2], const pg8::Unit& u, int wr, int wc, int fr, int fq) const {
        const int pn = u.pn, rbase = u.pm * 256 + wr * 64 + fr, cw = wc * 32 + 8 * fq;
        const float* ropeC = (const float*)(ws + WS_ROPEC);
#pragma unroll
        for (int ai = 0; ai < 2; ++ai)
#pragma unroll
            for (int m = 0; m < 4; ++m) {
                asm volatile("" ::: "memory"); const int R = rbase + ai * 128 + m * 16, pos = R & 2047;
                const float* sp = (const float*)(ws + WS_SSQCQ) + (size_t)R * 12;
                const f32x4 s0 = *(const f32x4*)sp, s1 = *(const f32x4*)(sp + 4), s2 = *(const f32x4*)(sp + 8);
                const float ss = (((s0[0] + s0[1]) + (s0[2] + s0[3])) + ((s1[0] + s1[1]) + (s1[2] + s1[3]))) + ((s2[0] + s2[1]) + (s2[2] + s2[3]));
                const float sc = rsqrtf(ss * (1.f / 768.f) + EPS) * (0.10206207261596575f * LOG2E);
#pragma unroll
                for (int bj = 0; bj < 2; ++bj) {
                    const int c = pn * 256 + bj * 128 + cw, head = c / 96, dd = c - head * 96;
                    f32x4 a = acc[ai][bj][m][0], b = acc[ai][bj][m][1];
                    if (dd >= 64) { const int i0 = (dd - 64) >> 1; rope8(a, b, ropeC + pos * 32 + i0, ropeC + pos * 32 + 16 + i0); }
                    st8((bf16_t*)(ws + WS_QO) + (size_t)R * 768 + c, a * sc, b * sc);
                }
            }
    }
};

#define RLX_AGENT __ATOMIC_RELAXED, __HIP_MEMORY_SCOPE_AGENT
#define XB_TMO      128
#define XB_XCNT(j)  (256  + 64 * (j))
#define XB_XSUB(j)  (1280 + 64 * (j))
#define XB_XGEN(j)  (2304 + 64 * (j))
#define XB_TOP      3328
#define XB_TOPGEN   3392
#define XCD_BAR_WORDS 3456
#define XB_SPIN_CAP (1u << 18)

__device__ __forceinline__ unsigned xb_ld(unsigned* p)              { return __hip_atomic_load(p, __ATOMIC_RELAXED, __HIP_MEMORY_SCOPE_AGENT); }
__device__ __forceinline__ unsigned xb_add(unsigned* p, unsigned v) { return __hip_atomic_fetch_add(p, v, __ATOMIC_RELAXED, __HIP_MEMORY_SCOPE_AGENT); }
__device__ __forceinline__ unsigned xb_xcc_id() { return (unsigned)__builtin_amdgcn_s_getreg((3 << 11) | 20) & 0xFu; }
#define XB_SPIN(cond, bar) do { unsigned _sp = 0; while (cond) { __builtin_amdgcn_s_sleep(1); \
    if ((++_sp & 255u) == 0u) { if (xb_ld(&(bar)[XB_TMO])) break; if (_sp > XB_SPIN_CAP) { atomicAdd(&(bar)[XB_TMO], 1u); break; } } } } while (0)

struct XcdBarrier {
    unsigned* bar; unsigned x;
    volatile LAS unsigned* st;
};

__device__ __forceinline__ XcdBarrier xcd_barrier_post(unsigned* bar, volatile LAS unsigned* st) {
    XcdBarrier b; b.bar = bar; b.x = xb_xcc_id(); b.st = st;
    if (threadIdx.x == 0) (void)xb_add(&bar[XB_XCNT(b.x)], 1u);
    return b;
}
__device__ __forceinline__ void xcd_barrier_complete(unsigned* bar, unsigned x, unsigned& nloc, unsigned& nx) {
    const unsigned G = gridDim.x * gridDim.y * gridDim.z;
    unsigned sum, cnt, mine, sp = 0u;
    for (;;) {
        sum = 0u; cnt = 0u; mine = 0u;
#pragma unroll
        for (unsigned j = 0; j < 16; ++j) { const unsigned c = xb_ld(&bar[XB_XCNT(j)]); sum += c; cnt += (c > 0u) ? 1u : 0u; mine = (j == x) ? c : mine; }
        if (sum == G) break;
        __builtin_amdgcn_s_sleep(1);
        if ((++sp & 255u) == 0u) { if (xb_ld(&bar[XB_TMO])) break; if (sp > XB_SPIN_CAP) { atomicAdd(&bar[XB_TMO], 1u); break; } }
    }
    nloc = mine > 0u ? mine : 1u; nx = cnt > 0u ? cnt : 1u;
}

__device__ __forceinline__ void xcd_barrier(const XcdBarrier& b) {
    asm volatile("s_waitcnt vmcnt(0)" ::: "memory");
    __syncthreads();
    if (threadIdx.x == 0) {
        unsigned* bar = b.bar;
        __builtin_amdgcn_s_waitcnt(0);
        unsigned nloc = b.st[0], nx = b.st[1];
        if (nloc == 0u) { xcd_barrier_complete(bar, b.x, nloc, nx); b.st[0] = nloc; b.st[1] = nx; }
        const unsigned old = xb_add(&bar[XB_XSUB(b.x)], 1u);
        const unsigned gen = old / nloc;
        if (old + 1u == (gen + 1u) * nloc) {
            __builtin_amdgcn_fence(__ATOMIC_RELEASE, "agent");
            asm volatile("s_waitcnt vmcnt(0)" ::: "memory");
            const unsigned og = xb_add(&bar[XB_TOP], 1u);
            const unsigned tg = og / nx;
            if (og + 1u == (tg + 1u) * nx) xb_add(&bar[XB_TOPGEN], 1u);
            else XB_SPIN(xb_ld(&bar[XB_TOPGEN]) == tg, bar);
            __builtin_amdgcn_fence(__ATOMIC_ACQUIRE, "agent");
            xb_add(&bar[XB_XGEN(b.x)], 1u);
            asm volatile("s_waitcnt vmcnt(0)" ::: "memory");
        } else {
            XB_SPIN(xb_ld(&bar[XB_XGEN(b.x)]) == gen, bar);
            __builtin_amdgcn_fence(__ATOMIC_ACQUIRE, "agent");
            asm volatile("s_waitcnt vmcnt(0)" ::: "memory");
        }
    }
    __syncthreads();
}

__device__ __forceinline__ int crow(int r, int hi) { return (r & 3) + 8 * (r >> 2) + 4 * hi; }
typedef short v4i16_t __attribute__((ext_vector_type(4)));
__device__ __forceinline__ s16x4 vtr(const LAS unsigned char* p) { return __builtin_bit_cast(s16x4, __builtin_amdgcn_ds_read_tr16_b64_v4i16((LAS v4i16_t*)p)); }

template <int MODE>
__device__ __forceinline__ void attn_unit(LAS unsigned char* lds, unsigned char* ws, const float* sink, int unit) {
    constexpr int DQK = (MODE == 2) ? 96 : 64, KST = DQK / 16, KS = DQK * 2 + 16, VS = 192, KBUF = 64 * KS, VBUF = 64 * VS;
    const int tid = my_tid(), lane = tid & 63, wid = __builtin_amdgcn_readfirstlane(tid >> 6), r32 = lane & 31, hi = lane >> 5;
    int b, head, hkv = 0, n = 0, Rq0, qpos0 = 0, nt, jlo = 0;
    const bf16_t* Qp; int qstride;
    if (MODE == 0) {
        const int hp = unit & 1; n = (unit >> 1) & 15; hkv = (unit >> 5) & 1; b = unit >> 6;
        head = hkv * 4 + hp * 2 + (wid >> 2); qpos0 = 128 * n + 32 * (wid & 3); Rq0 = b * 2048 + qpos0;
        Qp = (const bf16_t*)(ws + WS_QE) + (size_t)Rq0 * 512 + head * 64; qstride = 512;
        jlo = (n == 0) ? 2 : 0; const int jhi = (n == 15) ? 4 : 6; nt = 4 + (jhi - jlo);
    } else if (MODE == 1) {
        const int qh = unit & 1, hp = (unit >> 1) & 1; hkv = (unit >> 2) & 1; b = unit >> 3;
        head = hkv * 4 + hp * 2 + (wid >> 2); Rq0 = ML + b * 256 + 128 * qh + 32 * (wid & 3);
        Qp = (const bf16_t*)(ws + WS_QE) + (size_t)Rq0 * 512 + head * 64; qstride = 512; nt = 4;
    } else {
        const int qb = unit & 7; head = (unit >> 3) & 7; b = unit >> 6; Rq0 = b * 2048 + 256 * qb + 32 * wid;
        Qp = (const bf16_t*)(ws + WS_QO) + (size_t)Rq0 * 768 + head * 96; qstride = 768; nt = 36;
    }
    bf16x8 qf[KST];
#pragma unroll
    for (int s = 0; s < KST; ++s) qf[s] = *(const bf16x8*)(Qp + (size_t)r32 * qstride + 16 * s + 8 * hi);
    constexpr float THR = 6.0f;
    float mref, l_run;
    if (MODE == 2) { mref = 0.f; l_run = 0.f; } else { mref = sink[head] * LOG2E; l_run = (hi == 0) ? 1.f : 0.f; }
    f32x16 negm;
#pragma unroll
    for (int r = 0; r < 16; ++r) negm[r] = -mref;
    f32x16 o0, o1;
#pragma unroll
    for (int r = 0; r < 16; ++r) { o0[r] = 0.f; o1[r] = 0.f; }

    const int srow = tid >> 3, sch = tid & 7;
    const int voff = (4 * hi + ((lane & 15) >> 2)) * VS + (((lane >> 4) & 1) * 16 + 4 * (lane & 3)) * 2;
    u32x4 kreg, vreg, kreg2;
    kreg2 = (u32x4){0u, 0u, 0u, 0u};
#define ATT_SRC(t, kp, vp, k2p, kpos0v) do { \
        if (MODE == 0 || MODE == 1) { \
            if ((t) < 4) { kp = (const bf16_t*)(ws + WS_KVE) + (size_t)(ML + b * 256 + 64 * (t) + srow) * 256 + hkv * 64 + sch * 8; kpos0v = -100000; } \
            else { const int kp0_ = 128 * n - 128 + 64 * (jlo + (t) - 4); kpos0v = kp0_; \
                   kp = (const bf16_t*)(ws + WS_KVE) + (size_t)(b * 2048 + kp0_ + srow) * 256 + hkv * 64 + sch * 8; } \
            vp = kp + 128; k2p = kp; \
        } else { \
            const int pos0_ = 64 * (t); kpos0v = -100000; \
            kp = (const bf16_t*)(ws + WS_KNV) + ((size_t)(b * 8 + head) * 2304 + pos0_ + srow) * 128 + sch * 8; \
            vp = kp + 64; \
            const int krow_ = ((t) < 4) ? (ML + b * 256 + pos0_) : (b * 2048 + pos0_ - 256); \
            k2p = (const bf16_t*)(ws + WS_KR) + (size_t)(krow_ + (tid >> 2)) * 32 + (tid & 3) * 8; \
        } } while (0)
#define ATT_LOAD(t) do { const bf16_t *kp_, *vp_, *k2p_; int kq_; ATT_SRC(t, kp_, vp_, k2p_, kq_); (void)kq_; \
        kreg = *(const u32x4*)kp_; vreg = *(const u32x4*)vp_; if (MODE == 2 && tid < 256) kreg2 = *(const u32x4*)k2p_; } while (0)
#define ATT_STORE(buf) do { LAS unsigned char* kb_ = lds + (buf) * KBUF; LAS unsigned char* vb_ = lds + 2 * KBUF + (buf) * VBUF; \
        *(LAS u32x4*)(kb_ + srow * KS + sch * 16) = kreg; \
        if (MODE == 2 && tid < 256) *(LAS u32x4*)(kb_ + (tid >> 2) * KS + 128 + (tid & 3) * 16) = kreg2; \
        *(LAS u32x4*)(vb_ + srow * VS + sch * 16) = vreg; } while (0)

    ATT_LOAD(0); ATT_STORE(0);
    __syncthreads();
    for (int t = 0; t < nt; ++t) {
        const int buf = t & 1;
        if (t + 1 < nt) ATT_LOAD(t + 1);
        int kpos0 = -100000;
        if (MODE == 0 && t >= 4) kpos0 = 128 * n - 128 + 64 * (jlo + t - 4);
        bool active = true;
        if (MODE == 0 && t >= 4) active = (kpos0 + 63 >= qpos0 - 128) && (kpos0 <= qpos0 + 31 + 128);
        if (active) {
            const LAS unsigned char* kb = lds + buf * KBUF; const LAS unsigned char* vb = lds + 2 * KBUF + buf * VBUF;
            f32x16 p0 = negm, p1 = negm;
#pragma unroll
            for (int s = 0; s < KST; ++s) {
                const bf16x8 a0 = *(const LAS bf16x8*)(kb + r32 * KS + (16 * s + 8 * hi) * 2);
                const bf16x8 a1 = *(const LAS bf16x8*)(kb + (32 + r32) * KS + (16 * s + 8 * hi) * 2);
                p0 = __builtin_amdgcn_mfma_f32_32x32x16_bf16(a0, qf[s], p0, 0, 0, 0);
                p1 = __builtin_amdgcn_mfma_f32_32x32x16_bf16(a1, qf[s], p1, 0, 0, 0);
            }
            if (MODE == 0 && t >= 4) {
                const int qpos = qpos0 + r32;
#pragma unroll
                for (int r = 0; r < 16; ++r) { const int d0 = kpos0 + crow(r, hi) - qpos, d1 = d0 + 32;
                    if (d0 > 128 || d0 < -128) p0[r] = -INFINITY; if (d1 > 128 || d1 < -128) p1[r] = -INFINITY; }
            }
            float mxa = __builtin_fmaxf(__builtin_fmaxf(p0[0], p0[1]), p1[0]), mxb = __builtin_fmaxf(__builtin_fmaxf(p0[2], p0[3]), p1[1]);
            mxa = __builtin_fmaxf(__builtin_fmaxf(mxa, p1[2]), p1[3]);
#pragma unroll
            for (int r = 4; r < 16; r += 4) { mxa = __builtin_fmaxf(__builtin_fmaxf(mxa, p0[r]), p0[r + 1]); mxb = __builtin_fmaxf(__builtin_fmaxf(mxb, p0[r + 2]), p0[r + 3]);
                mxa = __builtin_fmaxf(__builtin_fmaxf(mxa, p1[r]), p1[r + 1]); mxb = __builtin_fmaxf(__builtin_fmaxf(mxb, p1[r + 2]), p1[r + 3]); }
            float mx = __builtin_fmaxf(mxa, mxb);
            mx = __builtin_fmaxf(mx, __shfl_xor(mx, 32));
            const bool first = (MODE == 2) && (t == 0);
            if (first || __any(mx > THR)) {
                const float delta = first ? mx : __builtin_fmaxf(mx, 0.f), alpha = first ? 1.f : __builtin_amdgcn_exp2f(-delta);
                mref += delta; l_run *= alpha;
#pragma unroll
                for (int r = 0; r < 16; ++r) { o0[r] *= alpha; o1[r] *= alpha; p0[r] -= delta; p1[r] -= delta; negm[r] = -mref; }
            }
            float rs0 = 0.f, rs1 = 0.f;
#pragma unroll
            for (int r = 0; r < 16; ++r) { p0[r] = __builtin_amdgcn_exp2f(p0[r]); p1[r] = __builtin_amdgcn_exp2f(p1[r]); rs0 += p0[r]; rs1 += p1[r]; }
            l_run += rs0 + rs1;
            u32x4 pw[4];
            pw[0] = (u32x4){pk2(p0[0], p0[1]), pk2(p0[2], p0[3]), pk2(p0[4], p0[5]), pk2(p0[6], p0[7])};
            pw[1] = (u32x4){pk2(p0[8], p0[9]), pk2(p0[10], p0[11]), pk2(p0[12], p0[13]), pk2(p0[14], p0[15])};
            pw[2] = (u32x4){pk2(p1[0], p1[1]), pk2(p1[2], p1[3]), pk2(p1[4], p1[5]), pk2(p1[6], p1[7])};
            pw[3] = (u32x4){pk2(p1[8], p1[9]), pk2(p1[10], p1[11]), pk2(p1[12], p1[13]), pk2(p1[14], p1[15])};
#pragma unroll
            for (int s2 = 0; s2 < 4; ++s2) {
                const bf16x8 pb = __builtin_bit_cast(bf16x8, pw[s2]);
                const LAS unsigned char* va0 = vb + (16 * s2) * VS + voff;
                const s16x4 l0 = vtr(va0), h0 = vtr(va0 + 8 * VS), l1 = vtr(va0 + 64), h1 = vtr(va0 + 8 * VS + 64);
                const bf16x8 v0 = (bf16x8){l0[0], l0[1], l0[2], l0[3], h0[0], h0[1], h0[2], h0[3]};
                const bf16x8 v1 = (bf16x8){l1[0], l1[1], l1[2], l1[3], h1[0], h1[1], h1[2], h1[3]};
                o0 = __builtin_amdgcn_mfma_f32_32x32x16_bf16(v0, pb, o0, 0, 0, 0);
                o1 = __builtin_amdgcn_mfma_f32_32x32x16_bf16(v1, pb, o1, 0, 0, 0);
            }
        }
        if (t + 1 < nt) ATT_STORE(buf ^ 1);
        __syncthreads();
    }
#undef ATT_SRC
#undef ATT_LOAD
#undef ATT_STORE
    const float l_tot = l_run + __shfl_xor(l_run, 32), inv = __builtin_amdgcn_rcpf(l_tot);
    const int Rq = Rq0 + r32;
    const bf16_t* zrow = (MODE == 2) ? (const bf16_t*)(ws + WS_ZO) + (size_t)Rq * 1024 + head * 64 : (const bf16_t*)(ws + WS_ZA) + (size_t)Rq * 512 + head * 64;
    bf16_t* urow = (bf16_t*)(ws + WS_U) + (size_t)Rq * 1024 + head * 64;
#pragma unroll
    for (int g = 0; g < 4; ++g) {
        const int dv = 8 * g + 4 * hi;
        { const u32x2 z = *(const u32x2*)(zrow + dv);
          u32x2 w; w.x = pk2(o0[4 * g] * inv * bf_lo(z.x), o0[4 * g + 1] * inv * bf_hi(z.x)); w.y = pk2(o0[4 * g + 2] * inv * bf_lo(z.y), o0[4 * g + 3] * inv * bf_hi(z.y));
          *(u32x2*)(urow + dv) = w; }
        { const u32x2 z = *(const u32x2*)(zrow + 32 + dv);
          u32x2 w; w.x = pk2(o1[4 * g] * inv * bf_lo(z.x), o1[4 * g + 1] * inv * bf_hi(z.x)); w.y = pk2(o1[4 * g + 2] * inv * bf_lo(z.y), o1[4 * g + 3] * inv * bf_hi(z.y));
          *(u32x2*)(urow + 32 + dv) = w; }
    }
}


__device__ __forceinline__ int srcmap(int mat, int dn) {
    if (mat == 0) {
        if (dn < 128) { const int d = dn & 63; return (dn & 64) + (d >> 1) + 32 * (d & 1); }
        if (dn < 256) return dn;
        if (dn < 768) { const int j = dn - 256, d = j & 63; return 256 + (j & ~63) + (d >> 1) + 32 * (d & 1); }
        if (dn < 1792) { const int j = dn - 768, blk = j >> 8, w = j & 255; return (w < 128) ? 1280 + blk * 128 + w : 1792 + blk * 128 + (w - 128); }
        if (dn < 2816) { const int j = dn - 1792, blk = j >> 8, w = j & 255; return (w < 128) ? 768 + blk * 128 + w : 2816 + blk * 128 + (w - 128); }
        return 2304 + (dn - 2816);
    }
    if (mat == 2) {
        if (dn < 256) return dn;
        if (dn < 512) return 288 + (dn - 256);
        if (dn < 1024) return 544 + (dn - 512);
        if (dn < 1280) { const int w = dn - 1024; if (w < 32) return 256 + (w >> 1) + 16 * (w & 1); if (w < 48) return 1056 + (w - 32); return -1; }
        if (dn < 2048) return 1072 + (dn - 1280);
        if (dn < 2304) return 1840 + (dn - 2048);
        if (dn < 2816) return 2096 + (dn - 2304);
        return 2608 + (dn - 2816);
    }
    if (mat == 3) {
        const int head = dn / 96, d = dn - head * 96; if (d < 64) return dn; const int w = d - 64; return head * 96 + 64 + (w >> 1) + 16 * (w & 1);
    }
    return dn;
}
__device__ __forceinline__ void p0_transpose_item(const float* W, int K, int Nsrc, bf16_t* WT, int mat, const float* kscale, LAS float* scr, int item, int nblk, int lane) {
    const int kb = item / nblk, nb = item % nblk, k0 = 64 * kb, n0 = 32 * nb;
    const int sc = srcmap(mat, n0 + (lane & 31));
#pragma unroll 8
    for (int i = 0; i < 32; ++i) { const int kk = 2 * i + (lane >> 5); float v = 0.f; if (sc >= 0) v = W[(size_t)(k0 + kk) * Nsrc + sc]; if (kscale) v *= kscale[k0 + kk]; scr[kk * 33 + (lane & 31)] = v; }
    LDS_WAIT(); asm volatile("" ::: "memory");
    const int c = lane & 7;
#pragma unroll
    for (int j = 0; j < 4; ++j) { const int n = (lane >> 3) + 8 * j; const LAS float* s = scr + (8 * c) * 33 + n;
        u32x4 o; o.x = pk2(s[0 * 33], s[1 * 33]); o.y = pk2(s[2 * 33], s[3 * 33]); o.z = pk2(s[4 * 33], s[5 * 33]); o.w = pk2(s[6 * 33], s[7 * 33]);
        *(u32x4*)(WT + (size_t)(n0 + n) * K + k0 + 8 * c) = o; }
    LDS_WAIT(); asm volatile("" ::: "memory");
}

__device__ __forceinline__ void p0_mod(LAS unsigned char* lds, const float* c, const float* c_ctx, const float* mod_w, const float* mod_b, float* MOD, int G) {
    const int tid = my_tid();
    if ((int)blockIdx.x >= 96) return;
    LAS float* scs = (LAS float*)lds;
    LAS float* red = (LAS float*)(lds + 1024 * 20 * 4);
    for (int idx = tid; idx < 17 * 1024; idx += NTHREADS) { const int r = idx >> 10, k = idx & 1023; const float v = (r < 16) ? c[r * 1024 + k] : c_ctx[k]; scs[k * 20 + r] = silu_f(v); }
    __syncthreads();
    for (int item = blockIdx.x; item < 96; item += G) {
        const int l = item / 48, n0 = (item % 48) * 64, col = tid & 63, kg = tid >> 6;
        float acc[20];
#pragma unroll
        for (int r = 0; r < 20; ++r) acc[r] = 0.f;
        const float* wp = mod_w + ((size_t)l * 1024 + kg * 128) * 3072 + n0 + col;
#pragma unroll 4
        for (int kk = 0; kk < 128; ++kk) {
            const float w = wp[(size_t)kk * 3072]; const LAS f32x4* sp = (const LAS f32x4*)(scs + (kg * 128 + kk) * 20);
#pragma unroll
            for (int q = 0; q < 5; ++q) { const f32x4 s = sp[q]; acc[4 * q] += s[0] * w; acc[4 * q + 1] += s[1] * w; acc[4 * q + 2] += s[2] * w; acc[4 * q + 3] += s[3] * w; }
        }
#pragma unroll
        for (int r = 0; r < 17; ++r) red[(kg * 17 + r) * 64 + col] = acc[r];
        __syncthreads();
        for (int o = tid; o < 17 * 64; o += NTHREADS) { const int r = o >> 6, cc = o & 63; float s = mod_b[l * 3072 + n0 + cc];
#pragma unroll
            for (int g = 0; g < 8; ++g) s += red[(g * 17 + r) * 64 + cc];
            MOD[((size_t)l * 17 + r) * 3072 + n0 + cc] = s; }
        __syncthreads();
    }
}

__device__ __forceinline__ void norm_mod_store(const f32x4 (&v)[4], const float* pre_w, const float* modrow, bf16_t* hrow, int lane) {
    float ss = 0.f;
#pragma unroll
    for (int j = 0; j < 4; ++j) ss += sq4(v[j]);
    const float rstd = rsqrtf(wave_sum(ss) * (1.f / 1024.f) + EPS);
#pragma unroll
    for (int j = 0; j < 4; ++j) { const int k = 4 * (lane + 64 * j);
        const f32x4 w = *(const f32x4*)(pre_w + k), sh = *(const f32x4*)(modrow + k), sc = *(const f32x4*)(modrow + 1024 + k);
        const f32x4 h = v[j] * rstd * w * (sc + 1.0f) + sh;
        u32x2 o; o.x = pk2(h[0], h[1]); o.y = pk2(h[2], h[3]); *(u32x2*)(hrow + k) = o; }
}
__device__ __forceinline__ void p1_prenorm(const float* x, const float* ctx, const float* pre_w, const float* MOD, bf16_t* H, int gw, int ngw, int lane) {
    for (int R = gw; R < MT; R += ngw) {
        const float* src = (R < ML) ? x + (size_t)R * 1024 : ctx + (size_t)(R - ML) * 1024; const int bi = (R < ML) ? (R >> 11) : 16;
        f32x4 v[4];
#pragma unroll
        for (int j = 0; j < 4; ++j) v[j] = *(const f32x4*)(src + 4 * (lane + 64 * j));
        norm_mod_store(v, pre_w, MOD + (size_t)bi * 3072, H + (size_t)R * 1024, lane);
    }
}
__device__ __forceinline__ float ssq16(const float* p) {
    const f32x4 a = *(const f32x4*)p, b = *(const f32x4*)(p + 4), c = *(const f32x4*)(p + 8), d = *(const f32x4*)(p + 12);
    return (((a[0] + a[1]) + (a[2] + a[3])) + ((b[0] + b[1]) + (b[2] + b[3]))) + (((c[0] + c[1]) + (c[2] + c[3])) + ((d[0] + d[1]) + (d[2] + d[3])));
}
__device__ __forceinline__ void p5_post_pre(const float* x, const float* ctx, const float* post_w0, const float* pre_w1, const float* MOD, const bf16_t* Y, const float* SSQ, float* X1, bf16_t* H, int gw, int ngw, int lane) {
    for (int R = gw; R < MT; R += ngw) {
        const float* src = (R < ML) ? x + (size_t)R * 1024 : ctx + (size_t)(R - ML) * 1024; const int bi = (R < ML) ? (R >> 11) : 16;
        const float rstd_y = rsqrtf(ssq16(SSQ + (size_t)R * 16) * (1.f / 1024.f) + EPS);
        const float* m0 = MOD + (size_t)bi * 3072;
        f32x4 v[4];
#pragma unroll
        for (int j = 0; j < 4; ++j) { const int k = 4 * (lane + 64 * j);
            const u32x2 yy = *(const u32x2*)(Y + (size_t)R * 1024 + k); const f32x4 y = (f32x4){bf_lo(yy.x), bf_hi(yy.x), bf_lo(yy.y), bf_hi(yy.y)};
            const f32x4 g = *(const f32x4*)(m0 + 2048 + k), pw = *(const f32x4*)(post_w0 + k), xv = *(const f32x4*)(src + k);
            v[j] = xv + g * (y * rstd_y * pw);
            if (R < ML) *(f32x4*)(X1 + (size_t)R * 1024 + k) = v[j]; }
        norm_mod_store(v, pre_w1, MOD + (size_t)(17 + bi) * 3072, H + (size_t)R * 1024, lane);
    }
}
__device__ __forceinline__ void p11_final(const float* post_w1, const float* MOD, const bf16_t* Y, const float* SSQ, float* out, int gw, int ngw, int lane) {
    for (int R = gw; R < ML; R += ngw) {
        const float rstd_y = rsqrtf(ssq16(SSQ + (size_t)R * 16) * (1.f / 1024.f) + EPS);
        const float* m1 = MOD + (size_t)(17 + (R >> 11)) * 3072;
#pragma unroll
        for (int j = 0; j < 4; ++j) { const int k = 4 * (lane + 64 * j);
            const u32x2 yy = *(const u32x2*)(Y + (size_t)R * 1024 + k); const f32x4 y = (f32x4){bf_lo(yy.x), bf_hi(yy.x), bf_lo(yy.y), bf_hi(yy.y)};
            const f32x4 g = *(const f32x4*)(m1 + 2048 + k), pw = *(const f32x4*)(post_w1 + k), xv = *(const f32x4*)(out + (size_t)R * 1024 + k);
            *(f32x4*)(out + (size_t)R * 1024 + k) = xv + g * (y * rstd_y * pw); }
    }
}
__device__ __forceinline__ void p3_conv(unsigned char* ws, const float* conv_w, int gtid, int ngt) {
    const bf16_t* PE = (const bf16_t*)(ws + WS_PE); const bf16_t* GE = (const bf16_t*)(ws + WS_GE); bf16_t* U = (bf16_t*)(ws + WS_U);
    for (int it = gtid; it < MT * 64; it += ngt) {
        const int R = it >> 6, ch = (it & 63) * 8;
        int t, T; if (R < ML) { t = R & 2047; T = 2048; } else { t = (R - ML) & 255; T = 256; }
        const u32x4 z4 = (u32x4){0u, 0u, 0u, 0u};
        const u32x4 pc = *(const u32x4*)(PE + (size_t)R * 512 + ch);
        const u32x4 pm = (t > 0) ? *(const u32x4*)(PE + (size_t)(R - 1) * 512 + ch) : z4;
        const u32x4 pp = (t < T - 1) ? *(const u32x4*)(PE + (size_t)(R + 1) * 512 + ch) : z4;
        const u32x4 g = *(const u32x4*)(GE + (size_t)R * 512 + ch);
        const f32x4 w0a = *(const f32x4*)(conv_w + ch), w0b = *(const f32x4*)(conv_w + ch + 4), w1a = *(const f32x4*)(conv_w + 512 + ch), w1b = *(const f32x4*)(conv_w + 512 + ch + 4),
                    w2a = *(const f32x4*)(conv_w + 1024 + ch), w2b = *(const f32x4*)(conv_w + 1024 + ch + 4);
        u32x4 o;
#define CV(pmw, pcw, ppw, gw_, wa, wb, wc_, e0, e1) pk2(bf_lo(gw_) * (wa[e0] * bf_lo(pmw) + wb[e0] * bf_lo(pcw) + wc_[e0] * bf_lo(ppw)), bf_hi(gw_) * (wa[e1] * bf_hi(pmw) + wb[e1] * bf_hi(pcw) + wc_[e1] * bf_hi(ppw)))
        o.x = CV(pm.x, pc.x, pp.x, g.x, w0a, w1a, w2a, 0, 1); o.y = CV(pm.y, pc.y, pp.y, g.y, w0a, w1a, w2a, 2, 3);
        o.z = CV(pm.z, pc.z, pp.z, g.z, w0b, w1b, w2b, 0, 1); o.w = CV(pm.w, pc.w, pp.w, g.w, w0b, w1b, w2b, 2, 3);
#undef CV
        *(u32x4*)(U + (size_t)R * 1024 + 512 + ch) = o;
    }
}
__device__ __forceinline__ void p9_readout(unsigned char* ws, const float* hn_w, int gw, int ngw, int lane) {
    const bf16_t* HM = (const bf16_t*)(ws + WS_HM); const bf16_t* MO = (const bf16_t*)(ws + WS_MO); const bf16_t* ZO = (const bf16_t*)(ws + WS_ZO); bf16_t* U = (bf16_t*)(ws + WS_U);
    for (int R = gw; R < ML; R += ngw) {
        const int ch = 8 * lane;
        const u32x4 h0 = *(const u32x4*)(HM + (size_t)R * 512 + ch), h1 = *(const u32x4*)(HM + ((size_t)ML + R) * 512 + ch);
        float hs[8] = {bf_lo(h0.x) + bf_lo(h1.x), bf_hi(h0.x) + bf_hi(h1.x), bf_lo(h0.y) + bf_lo(h1.y), bf_hi(h0.y) + bf_hi(h1.y),
                       bf_lo(h0.z) + bf_lo(h1.z), bf_hi(h0.z) + bf_hi(h1.z), bf_lo(h0.w) + bf_lo(h1.w), bf_hi(h0.w) + bf_hi(h1.w)};
        float ss = 0.f;
#pragma unroll
        for (int e = 0; e < 8; ++e) ss += hs[e] * hs[e];
        ss += __shfl_xor(ss, 1); ss += __shfl_xor(ss, 2); ss += __shfl_xor(ss, 4); ss += __shfl_xor(ss, 8);
        const float rstd = rsqrtf(ss * (1.f / 128.f) + EPS);
        const u32x4 mo = *(const u32x4*)(MO + (size_t)R * 512 + ch), zz = *(const u32x4*)(ZO + (size_t)R * 1024 + 512 + ch);
        const f32x4 wa = *(const f32x4*)(hn_w + ch), wb = *(const f32x4*)(hn_w + ch + 4);
        u32x4 o;
        o.x = pk2(hs[0] * rstd * wa[0] * bf_lo(mo.x) * bf_lo(zz.x), hs[1] * rstd * wa[1] * bf_hi(mo.x) * bf_hi(zz.x));
        o.y = pk2(hs[2] * rstd * wa[2] * bf_lo(mo.y) * bf_lo(zz.y), hs[3] * rstd * wa[3] * bf_hi(mo.y) * bf_hi(zz.y));
        o.z = pk2(hs[4] * rstd * wb[0] * bf_lo(mo.z) * bf_lo(zz.z), hs[5] * rstd * wb[1] * bf_hi(mo.z) * bf_hi(zz.z));
        o.w = pk2(hs[6] * rstd * wb[2] * bf_lo(mo.w) * bf_lo(zz.w), hs[7] * rstd * wb[3] * bf_hi(mo.w) * bf_hi(zz.w));
        *(u32x4*)(U + (size_t)R * 1024 + 512 + ch) = o;
    }
}


__device__ __forceinline__ void mlstm_chain(LAS unsigned char* lds, unsigned char* ws, const float* i_bias, const float* f_bias, int chain) {
    const int tid = my_tid(), lane = tid & 63, wid = __builtin_amdgcn_readfirstlane(tid >> 6);
    const int vh = chain & 1, d = (chain >> 1) & 1, h = (chain >> 2) & 3, b = chain >> 4;
    LAS float* Kc = (LAS float*)lds;
    LAS float* Vc = Kc + 4096;
    LAS float* Ct = Vc + 4096;
    LAS float* Qc = Ct + 4096;
    LAS float* Sc = Qc + 64 * 65;
    LAS float* vb_ = Sc + 64 * 65;
    LAS float* vab = vb_ + 64;
    LAS float* vcm = vab + 64;
    LAS float* vw = vcm + 64;
    LAS float* vn = vw + 64;
    LAS float* vsc = vn + 64;
    const bf16_t* MK = (const bf16_t*)(ws + WS_MK); const bf16_t* MV = (const bf16_t*)(ws + WS_MV); const bf16_t* MQ = (const bf16_t*)(ws + WS_MQ);
    const float* GT = (const float*)(ws + WS_GATES); bf16_t* HM = (bf16_t*)(ws + WS_HM);
    const float ib = i_bias[d * 4 + h], fb = f_bias[d * 4 + h];
    float ct[8];
#pragma unroll
    for (int e = 0; e < 8; ++e) ct[e] = 0.f;
    float nreg = 0.f, mst = 0.f;
    for (int idx = tid; idx < 4096; idx += NTHREADS) Ct[idx] = 0.f;
    if (tid < 64) vn[tid] = 0.f;
    const int srow = tid >> 3, sch = tid & 7;
    for (int step = 0; step < 36; ++step) {
        const bool lat = step >= 4; const int c = lat ? step - 4 : step, T = lat ? 2048 : 256, rowb = lat ? b * 2048 : ML + b * 256;
        { const int tok = (d == 0) ? 64 * c + srow : T - 1 - (64 * c + srow); const size_t R = (size_t)(rowb + tok);
          const u32x4 kk = *(const u32x4*)(MK + R * 256 + h * 64 + sch * 8), vv = *(const u32x4*)(MV + R * 512 + h * 128 + vh * 64 + sch * 8);
          *(LAS f32x4*)(Kc + srow * 64 + sch * 8) = (f32x4){bf_lo(kk.x), bf_hi(kk.x), bf_lo(kk.y), bf_hi(kk.y)}; *(LAS f32x4*)(Kc + srow * 64 + sch * 8 + 4) = (f32x4){bf_lo(kk.z), bf_hi(kk.z), bf_lo(kk.w), bf_hi(kk.w)};
          *(LAS f32x4*)(Vc + srow * 64 + sch * 8) = (f32x4){bf_lo(vv.x), bf_hi(vv.x), bf_lo(vv.y), bf_hi(vv.y)}; *(LAS f32x4*)(Vc + srow * 64 + sch * 8 + 4) = (f32x4){bf_lo(vv.z), bf_hi(vv.z), bf_lo(vv.w), bf_hi(vv.w)};
          if (lat) { const u32x4 qq = *(const u32x4*)(MQ + R * 256 + h * 64 + sch * 8); LAS float* qd = Qc + srow * 65 + sch * 8;
              qd[0] = bf_lo(qq.x); qd[1] = bf_hi(qq.x); qd[2] = bf_lo(qq.y); qd[3] = bf_hi(qq.y); qd[4] = bf_lo(qq.z); qd[5] = bf_hi(qq.z); qd[6] = bf_lo(qq.w); qd[7] = bf_hi(qq.w); }
          if (wid == 0) {
              const int tk = (d == 0) ? 64 * c + lane : T - 1 - (64 * c + lane); const float* gp = GT + (size_t)(rowb + tk) * 16 + d * 8 + h;
              const float li = gp[0] + ib, fp = gp[4] + fb;
              const float lf = fminf(fp, 0.f) - __logf(1.f + __expf(-fabsf(fp)));
              float bc = lf;
#pragma unroll
              for (int o = 1; o < 64; o <<= 1) { const float t_ = __shfl_up(bc, o); if (lane >= o) bc += t_; }
              const float ab = li - bc; float cm = ab;
#pragma unroll
              for (int o = 1; o < 64; o <<= 1) { const float t_ = __shfl_up(cm, o); if (lane >= o) cm = fmaxf(cm, t_); }
              const float g = __shfl(bc, 63), cmx = __shfl(cm, 63), mloc = g + cmx;
              vb_[lane] = bc; vab[lane] = ab; vcm[lane] = cm; vw[lane] = __expf(g + ab - mloc);
              if (lane == 0) { vsc[0] = g; vsc[1] = mloc; }
          } }
        __syncthreads();
        const float g = vsc[0], mloc = vsc[1], m_in = mst;
        if (lat) {
            float q[64];
#pragma unroll
            for (int k = 0; k < 64; ++k) q[k] = Qc[lane * 65 + k];
            const float mi = fmaxf(m_in, vcm[lane]);
#pragma unroll
            for (int jj = 0; jj < 8; ++jj) { const int j = 8 * wid + jj; float s = 0.f;
#pragma unroll
                for (int k4 = 0; k4 < 16; ++k4) { const f32x4 kv = *(const LAS f32x4*)(Kc + j * 64 + 4 * k4); s += q[4 * k4] * kv[0] + q[4 * k4 + 1] * kv[1] + q[4 * k4 + 2] * kv[2] + q[4 * k4 + 3] * kv[3]; }
                Sc[lane * 65 + j] = (j <= lane) ? s * __expf(vab[j] - mi) : 0.f; }
            float nq = 0.f;
#pragma unroll
            for (int k4 = 0; k4 < 16; ++k4) { const f32x4 nv = *(const LAS f32x4*)(vn + 4 * k4); nq += q[4 * k4] * nv[0] + q[4 * k4 + 1] * nv[1] + q[4 * k4 + 2] * nv[2] + q[4 * k4 + 3] * nv[3]; }
            __syncthreads();
            const float wi = __expf(m_in - mi);
            float acc[8];
#pragma unroll
            for (int e = 0; e < 8; ++e) acc[e] = 0.f;
#pragma unroll
            for (int k = 0; k < 64; ++k) { const float qk = q[k] * wi; const f32x4 c0 = *(const LAS f32x4*)(Ct + k * 64 + 8 * wid), c1 = *(const LAS f32x4*)(Ct + k * 64 + 8 * wid + 4);
                acc[0] += qk * c0[0]; acc[1] += qk * c0[1]; acc[2] += qk * c0[2]; acc[3] += qk * c0[3]; acc[4] += qk * c1[0]; acc[5] += qk * c1[1]; acc[6] += qk * c1[2]; acc[7] += qk * c1[3]; }
            float den = wi * nq;
#pragma unroll 8
            for (int j = 0; j < 64; ++j) { const float sj = Sc[lane * 65 + j]; den += sj; const f32x4 v0 = *(const LAS f32x4*)(Vc + j * 64 + 8 * wid), v1 = *(const LAS f32x4*)(Vc + j * 64 + 8 * wid + 4);
                acc[0] += sj * v0[0]; acc[1] += sj * v0[1]; acc[2] += sj * v0[2]; acc[3] += sj * v0[3]; acc[4] += sj * v1[0]; acc[5] += sj * v1[1]; acc[6] += sj * v1[2]; acc[7] += sj * v1[3]; }
            const float mt = vb_[lane] + mi, inv = 1.f / fmaxf(fabsf(den), __expf(-mt));
            const int tok = (d == 0) ? 64 * c + lane : T - 1 - (64 * c + lane);
            u32x4 o; o.x = pk2(acc[0] * inv, acc[1] * inv); o.y = pk2(acc[2] * inv, acc[3] * inv); o.z = pk2(acc[4] * inv, acc[5] * inv); o.w = pk2(acc[6] * inv, acc[7] * inv);
            *(u32x4*)(HM + ((size_t)d * ML + rowb + tok) * 512 + h * 128 + vh * 64 + 8 * wid) = o;
        }
        const float m_new = fmaxf(g + m_in, mloc), a_prev = __expf(g + m_in - m_new), a_loc = __expf(mloc - m_new);
        float upd[8];
#pragma unroll
        for (int e = 0; e < 8; ++e) upd[e] = 0.f;
        float nsum = 0.f;
#pragma unroll 8
        for (int j = 0; j < 64; ++j) { const float kw = Kc[j * 64 + lane] * vw[j]; nsum += kw; const f32x4 v0 = *(const LAS f32x4*)(Vc + j * 64 + 8 * wid), v1 = *(const LAS f32x4*)(Vc + j * 64 + 8 * wid + 4);
            upd[0] += kw * v0[0]; upd[1] += kw * v0[1]; upd[2] += kw * v0[2]; upd[3] += kw * v0[3]; upd[4] += kw * v1[0]; upd[5] += kw * v1[1]; upd[6] += kw * v1[2]; upd[7] += kw * v1[3]; }
#pragma unroll
        for (int e = 0; e < 8; ++e) ct[e] = a_prev * ct[e] + a_loc * upd[e];
        nreg = a_prev * nreg + a_loc * nsum; mst = m_new;
        __syncthreads();
        *(LAS f32x4*)(Ct + lane * 64 + 8 * wid) = (f32x4){ct[0], ct[1], ct[2], ct[3]}; *(LAS f32x4*)(Ct + lane * 64 + 8 * wid + 4) = (f32x4){ct[4], ct[5], ct[6], ct[7]};
        if (wid == 0) vn[lane] = nreg;
    }
    __syncthreads();
}


typedef float f32x4v __attribute__((ext_vector_type(4)));
#define MFMA_FENCE(x) do { __builtin_amdgcn_sched_barrier(0); asm volatile("s_nop 15\n\ts_nop 15" : "+v"(x)); __builtin_amdgcn_sched_barrier(0); } while (0)
__device__ __forceinline__ bf16x8 tr8(const LAS unsigned char* p, int halfstride) {
    const s16x4 lo = vtr(p), hi = vtr(p + halfstride);
    return (bf16x8){lo[0], lo[1], lo[2], lo[3], hi[0], hi[1], hi[2], hi[3]};
}
__device__ __forceinline__ bf16x8 gather8(const LAS unsigned char* img, int stride, int row0, int col) {
    bf16x8 r;
#pragma unroll
    for (int e = 0; e < 8; ++e) r[e] = *(const LAS short*)(img + (row0 + e) * stride + col * 2);
    return r;
}
template <bool DUMMY> __device__ __forceinline__ void mlstm_chain_mfma(LAS unsigned char* lds, unsigned char* ws, const float* i_bias, const float* f_bias, int chain) {
    constexpr int RS = 144, VS = 176;
    constexpr int QI = 0, KI = 9216, SC = 18432, CI = 27648, VI = 39168, VW = 50432, VEC = 61696;
    const int tid = my_tid(), lane = tid & 63, wid = __builtin_amdgcn_readfirstlane(tid >> 6), l15 = lane & 15, kg = lane >> 4;
    const int vh = chain & 1, d = (chain >> 1) & 1, h = (chain >> 2) & 3, b = chain >> 4;
    LAS float* vb_ = (LAS float*)(lds + VEC); LAS float* vab = vb_ + 64; LAS float* vcm = vab + 64; LAS float* vwp = vcm + 64; LAS float* vsc = vwp + 64;
    const bf16_t* MK = (const bf16_t*)(ws + WS_MK); const bf16_t* MV = (const bf16_t*)(ws + WS_MV); const bf16_t* MQ = (const bf16_t*)(ws + WS_MQ);
    const float* GT = (const float*)(ws + WS_GATES); bf16_t* HM = (bf16_t*)(ws + WS_HM);
    const float ib = i_bias[d * 4 + h], fb = f_bias[d * 4 + h];
    for (int idx = tid; idx < 80 * RS / 4; idx += NTHREADS) ((LAS unsigned*)(lds + CI))[idx] = 0u;
    if (tid < 64) { LAS unsigned* a = (LAS unsigned*)(lds + VI + tid * VS + 128); LAS unsigned* w = (LAS unsigned*)(lds + VW + tid * VS + 128);
#pragma unroll
        for (int e = 0; e < 8; ++e) { a[e] = (e == 0) ? 0x3F80u : 0u; w[e] = 0u; } }
    const int it = wid & 3, vg = wid >> 2;
    f32x4v cacc[3];
#pragma unroll
    for (int t = 0; t < 3; ++t) cacc[t] = (f32x4v){0.f, 0.f, 0.f, 0.f};
    float mst = 0.f;
    unsigned nbad = 0u;
    const int srow = tid >> 3, sch = tid & 7;
    const int q4 = l15 >> 2, p4 = l15 & 3;
    for (int step = 0; step < 36; ++step) {
        const bool lat = step >= 4; const int c = lat ? step - 4 : step, T = lat ? 2048 : 256, rowb = lat ? b * 2048 : ML + b * 256;
        const int tok = (d == 0) ? 64 * c + srow : T - 1 - (64 * c + srow); const size_t R = (size_t)(rowb + tok);
        const u32x4 kk = *(const u32x4*)(MK + R * 256 + h * 64 + sch * 8), vv = *(const u32x4*)(MV + R * 512 + h * 128 + vh * 64 + sch * 8);
        u32x4 qq = (u32x4){0u, 0u, 0u, 0u};
        if (lat) qq = *(const u32x4*)(MQ + R * 256 + h * 64 + sch * 8);
        if (wid == 0) {
            const int tk = (d == 0) ? 64 * c + lane : T - 1 - (64 * c + lane); const float* gp = GT + (size_t)(rowb + tk) * 16 + d * 8 + h;
            const float li = gp[0] + ib, fp = gp[4] + fb;
            const float lf = fminf(fp, 0.f) - __logf(1.f + __expf(-fabsf(fp)));
            float bc = lf;
#pragma unroll
            for (int o = 1; o < 64; o <<= 1) { const float t_ = __shfl_up(bc, o); if (lane >= o) bc += t_; }
            const float ab = li - bc; float cm = ab;
#pragma unroll
            for (int o = 1; o < 64; o <<= 1) { const float t_ = __shfl_up(cm, o); if (lane >= o) cm = fmaxf(cm, t_); }
            const float g = __shfl(bc, 63), mloc = g + __shfl(cm, 63), m_new = fmaxf(g + mst, mloc);
            vb_[lane] = bc; vab[lane] = ab; vcm[lane] = cm; vwp[lane] = __expf(g + ab - m_new);
            if (lane == 0) { vsc[0] = mst; vsc[1] = __expf(g + mst - m_new); }
            mst = m_new;
        }
        __syncthreads();
        { const float wj = vwp[srow];
          *(LAS u32x4*)(lds + KI + srow * RS + sch * 16) = kk;
          *(LAS u32x4*)(lds + VI + srow * VS + sch * 16) = vv;
          u32x4 vw; vw.x = pk2(bf_lo(vv.x) * wj, bf_hi(vv.x) * wj); vw.y = pk2(bf_lo(vv.y) * wj, bf_hi(vv.y) * wj); vw.z = pk2(bf_lo(vv.z) * wj, bf_hi(vv.z) * wj); vw.w = pk2(bf_lo(vv.w) * wj, bf_hi(vv.w) * wj);
          *(LAS u32x4*)(lds + VW + srow * VS + sch * 16) = vw;
          if (sch == 0) *(LAS unsigned short*)(lds + VW + srow * VS + 128) = f2bf(wj);
          if (lat) *(LAS u32x4*)(lds + QI + srow * RS + sch * 16) = qq; }
        __syncthreads();
        const float m_in = vsc[0], a_prev = vsc[1];
        bf16x8 qf[2];
        if (lat) {
            qf[0] = *(const LAS bf16x8*)(lds + QI + (16 * it + l15) * RS + (8 * kg) * 2); qf[1] = *(const LAS bf16x8*)(lds + QI + (16 * it + l15) * RS + (8 * kg + 32) * 2);
            const int i = 16 * it + l15; const float mi = fmaxf(m_in, vcm[i]);
#pragma unroll
            for (int t = 0; t < 2; ++t) {
                const int jt = 2 * vg + t; u32x2 o = (u32x2){0u, 0u};
                if (jt <= it) {
                    const bf16x8 k0 = *(const LAS bf16x8*)(lds + KI + (16 * jt + l15) * RS + (8 * kg) * 2), k1 = *(const LAS bf16x8*)(lds + KI + (16 * jt + l15) * RS + (8 * kg + 32) * 2);
                    f32x4v s = (f32x4v){0.f, 0.f, 0.f, 0.f};
                    s = __builtin_amdgcn_mfma_f32_16x16x32_bf16(k0, qf[0], s, 0, 0, 0); s = __builtin_amdgcn_mfma_f32_16x16x32_bf16(k1, qf[1], s, 0, 0, 0); MFMA_FENCE(s);
                    const int j0 = 16 * jt + 4 * kg; const f32x4v abv = *(const LAS f32x4v*)(vab + j0);
                    float e[4];
#pragma unroll
                    for (int r = 0; r < 4; ++r) e[r] = (j0 + r <= i) ? s[r] * __expf(abv[r] - mi) : 0.f;
                    o.x = pk2(e[0], e[1]); o.y = pk2(e[2], e[3]);
                }
                *(LAS u32x2*)(lds + SC + i * RS + (16 * jt + 4 * kg) * 2) = o;
            }
        }
        __syncthreads();
        f32x4v cnew[3];
        { bf16x8 aK[2];
#pragma unroll
          for (int s = 0; s < 2; ++s) aK[s] = tr8(lds + KI + (32 * s + 8 * kg + q4) * RS + (16 * it + 4 * p4) * 2, 4 * RS);
#pragma unroll
          for (int t = 0; t < 3; ++t) { const int vt = (t == 2) ? 4 : 2 * t + vg; f32x4v a = cacc[t] * a_prev;
#pragma unroll
              for (int s = 0; s < 2; ++s) { const bf16x8 bW = tr8(lds + VW + (32 * s + 8 * kg + q4) * VS + (16 * vt + 4 * p4) * 2, 4 * VS); a = __builtin_amdgcn_mfma_f32_16x16x32_bf16(aK[s], bW, a, 0, 0, 0); }
              MFMA_FENCE(a); cnew[t] = a; } }
        if (lat) {
            const int i0 = 16 * it + 4 * kg; const f32x4v cmv = *(const LAS f32x4v*)(vcm + i0), bv = *(const LAS f32x4v*)(vb_ + i0);
            float wi[4], mt[4];
#pragma unroll
            for (int r = 0; r < 4; ++r) { const float mi = fmaxf(m_in, cmv[r]); wi[r] = __expf(m_in - mi); mt[r] = bv[r] + mi; }
            bf16x8 aS[2];
            aS[0] = *(const LAS bf16x8*)(lds + SC + (16 * it + l15) * RS + (8 * kg) * 2); aS[1] = *(const LAS bf16x8*)(lds + SC + (16 * it + l15) * RS + (8 * kg + 32) * 2);
            f32x4v nacc[3];
#pragma unroll
            for (int t = 0; t < 3; ++t) { const int vt = (t == 2) ? 4 : 2 * t + vg; f32x4v a = (f32x4v){0.f, 0.f, 0.f, 0.f};
#pragma unroll
                for (int s = 0; s < 2; ++s) { const bf16x8 bC = *(const LAS bf16x8*)(lds + CI + (16 * vt + l15) * RS + (8 * kg + 32 * s) * 2); a = __builtin_amdgcn_mfma_f32_16x16x32_bf16(qf[s], bC, a, 0, 0, 0); }
                MFMA_FENCE(a);
#pragma unroll
                for (int r = 0; r < 4; ++r) a[r] *= wi[r];
#pragma unroll
                for (int s = 0; s < 2; ++s) { const bf16x8 bV = tr8(lds + VI + (32 * s + 8 * kg + q4) * VS + (16 * vt + 4 * p4) * 2, 4 * VS); a = __builtin_amdgcn_mfma_f32_16x16x32_bf16(aS[s], bV, a, 0, 0, 0); }
                MFMA_FENCE(a); nacc[t] = a; }
            float inv[4];
#pragma unroll
            for (int r = 0; r < 4; ++r) { const float den = __shfl(nacc[2][r], lane & 48); inv[r] = 1.f / fmaxf(fabsf(den), __expf(-mt[r])); }
#pragma unroll
            for (int t = 0; t < 2; ++t) { const int vt = 2 * t + vg;
#pragma unroll
                for (int r = 0; r < 4; ++r) *(LAS unsigned short*)(lds + QI + (i0 + r) * RS + (16 * vt + l15) * 2) = f2bf(nacc[t][r] * inv[r]); }
        }
        __syncthreads();
        if (lat) { const u32x4 hv = *(const LAS u32x4*)(lds + QI + srow * RS + sch * 16);
            if (DUMMY) { const u32x4 rv = *(const u32x4*)(HM + ((size_t)d * ML + R) * 512 + h * 128 + vh * 64 + sch * 8);
#define CMPH(a_, b_) do { const float x_ = (a_), y_ = (b_); if (fabsf(x_ - y_) > 0.05f * fmaxf(fabsf(x_), fabsf(y_)) + 0.02f) ++nbad; } while (0)
                CMPH(bf_lo(hv.x), bf_lo(rv.x)); CMPH(bf_hi(hv.x), bf_hi(rv.x)); CMPH(bf_lo(hv.y), bf_lo(rv.y)); CMPH(bf_hi(hv.y), bf_hi(rv.y));
                CMPH(bf_lo(hv.z), bf_lo(rv.z)); CMPH(bf_hi(hv.z), bf_hi(rv.z)); CMPH(bf_lo(hv.w), bf_lo(rv.w)); CMPH(bf_hi(hv.w), bf_hi(rv.w));
#undef CMPH
            } else *(u32x4*)(HM + ((size_t)d * ML + R) * 512 + h * 128 + vh * 64 + sch * 8) = hv; }
#pragma unroll
        for (int t = 0; t < 3; ++t) { cacc[t] = cnew[t]; const int vt = (t == 2) ? 4 : 2 * t + vg;
            if (t < 2 || wid < 4) { u32x2 o; o.x = pk2(cnew[t][0], cnew[t][1]); o.y = pk2(cnew[t][2], cnew[t][3]); *(LAS u32x2*)(lds + CI + (16 * vt + l15) * RS + (16 * it + 4 * kg) * 2) = o; } }
    }
    if (DUMMY) atomicAdd((unsigned*)(ws + WS_CTL) + 64, nbad);
    __syncthreads();
}


#ifndef MK_N_LAUNCHES
#define MK_N_LAUNCHES 1
#endif
constexpr int N_PHASES = 12;
constexpr int LDS_BYTES = 147456;
constexpr int RING_BYTES = 131072, MISC_OFF = RING_BYTES + 320;
constexpr int CW_BAR = 4096;

struct Args { const float* in[21]; float* out; unsigned char* ws; int ph_lo, ph_hi; };

__global__ void __launch_bounds__(NTHREADS, 2) hybrid_fwd(Args args) {
    extern __shared__ __attribute__((aligned(16))) unsigned char lds_raw[];
    LAS unsigned char* lds = (LAS unsigned char*)lds_raw;
    const int G = gridDim.x, bx = blockIdx.x;
    const int vcu = (G % 8 == 0) ? (bx % 8) * (G / 8) + bx / 8 : bx;
    typedef const __attribute__((address_space(4))) Args* ArgsP;
    ArgsP AP = (ArgsP)__builtin_amdgcn_kernarg_segment_ptr();
    asm volatile("" : "+s"(AP));
    unsigned char* ws = AP->ws;
#define I_x AP->in[0]
#define I_cvec AP->in[1]
#define I_ctx AP->in[2]
#define I_c_ctx AP->in[3]
#define I_mod_w AP->in[4]
#define I_mod_b AP->in[5]
#define I_pre_w AP->in[6]
#define I_post_w AP->in[7]
#define I_e_w_in AP->in[8]
#define I_e_sink AP->in[9]
#define I_e_conv_w AP->in[10]
#define I_e_w_out AP->in[11]
#define I_o_w_in AP->in[12]
#define I_o_qn AP->in[13]
#define I_o_kvn AP->in[14]
#define I_o_w_uq AP->in[15]
#define I_o_w_ukv AP->in[16]
#define I_o_ib AP->in[17]
#define I_o_fb AP->in[18]
#define I_o_hn AP->in[19]
#define I_o_w_out AP->in[20]
#define I_out AP->out
    float* MOD = (float*)(ws + WS_MOD);

    for (int u = threadIdx.x; u < (LDS_BYTES - RING_BYTES) / 4; u += NTHREADS) ((LAS unsigned*)(lds + RING_BYTES))[u] = 0u;
    __syncthreads();
    XcdBarrier bar; bar.bar = (unsigned*)(ws + WS_CTL) + CW_BAR; bar.x = 0; bar.st = nullptr;
    if (MK_N_LAUNCHES == 1) bar = xcd_barrier_post((unsigned*)(ws + WS_CTL) + CW_BAR, (volatile LAS unsigned*)(lds + MISC_OFF) + 8);
    const int lo = AP->ph_lo, hi = AP->ph_hi;
#ifndef PROBE_REP
#define PROBE_REP 0
#endif
#define NREP(k) ((((PROBE_REP) >> (k)) & 1) ? 2 : 1)
#ifndef PHASE_MASK
#define PHASE_MASK 0xFFF
#endif
#define IN(k) (((PHASE_MASK >> (k)) & 1) && lo <= (k) && (k) < hi)
#define SEAM(k) do { if (MK_N_LAUNCHES == 1 && IN((k) + 1)) xcd_barrier(bar); } while (0)
    const int ngw = G * NWAVES;
#define PH_IDS const int tid = my_tid(), lane = tid & 63, wave = __builtin_amdgcn_readfirstlane(tid >> 6), gw = vcu * NWAVES + wave; (void)lane; (void)gw

    if (IN(0)) { asm volatile("" : "+s"(AP)); PH_IDS;
        for (int rep_ = 0; rep_ < NREP(0); ++rep_) { if (rep_) __syncthreads();
        p0_mod(lds, I_cvec, I_c_ctx, I_mod_w, I_mod_b, MOD, G);
        __syncthreads();
        LAS float* scr = (LAS float*)(lds + wave * 16384);
        constexpr int I0 = 16 * (E_N / 32), I1 = 16 * 32, I2 = 16 * (O_N / 32), I3 = 12 * 24, I4 = 4 * 32, I5 = 16 * 32, NIT = I0 + I1 + I2 + I3 + I4 + I5;
        for (int it = gw; it < NIT; it += ngw) {
            int r = it;
            if (r < I0) { p0_transpose_item(I_e_w_in, 1024, E_N, (bf16_t*)(ws + WS_WEIN), 0, nullptr, scr, r, E_N / 32, lane); continue; } r -= I0;
            if (r < I1) { p0_transpose_item(I_e_w_out, 1024, 1024, (bf16_t*)(ws + WS_WEOUT), 1, nullptr, scr, r, 32, lane); continue; } r -= I1;
            if (r < I2) { p0_transpose_item(I_o_w_in, 1024, O_NSRC, (bf16_t*)(ws + WS_WOIN), 2, nullptr, scr, r, O_N / 32, lane); continue; } r -= I2;
            if (r < I3) { p0_transpose_item(I_o_w_uq, 768, 768, (bf16_t*)(ws + WS_WUQ), 3, I_o_qn, scr, r, 24, lane); continue; } r -= I3;
            if (r < I4) { p0_transpose_item(I_o_w_ukv, 256, 1024, (bf16_t*)(ws + WS_WUKV), 4, I_o_kvn, scr, r, 32, lane); continue; } r -= I4;
            p0_transpose_item(I_o_w_out, 1024, 1024, (bf16_t*)(ws + WS_WOOUT), 5, nullptr, scr, r, 32, lane);
        }
        float* ropeA = (float*)(ws + WS_ROPEA); float* ropeC = (float*)(ws + WS_ROPEC);
        for (int idx = bx * NTHREADS + tid; idx < 2048 * 48; idx += G * NTHREADS) {
            const int pos = idx / 48, j = idx % 48; const float rowf = (float)(pos >> 6), colf = (float)(pos & 63);
            if (j < 32) { const int f = j & 15; const float inv = exp2f(-(float)f * (13.287712379549449f / 16.f)); const float ang = ((j < 16) ? rowf : colf) * inv;
                ropeA[pos * 64 + j] = __cosf(ang); ropeA[pos * 64 + 32 + j] = __sinf(ang); }
            else { const int jj = j - 32, f = jj & 7; const float inv = exp2f(-(float)f * (13.287712379549449f / 8.f)); const float ang = ((jj < 8) ? rowf : colf) * inv;
                ropeC[pos * 32 + jj] = __cosf(ang); ropeC[pos * 32 + 16 + jj] = __sinf(ang); }
        }
        }
        SEAM(0);
    }
    if (IN(1)) { asm volatile("" : "+s"(AP)); PH_IDS; for (int rep_ = 0; rep_ < NREP(1); ++rep_) { if (rep_) __syncthreads();
        p1_prenorm(I_x, I_ctx, I_pre_w, MOD, (bf16_t*)(ws + WS_H), gw, ngw, lane); }
        SEAM(1); }
    if (IN(2)) { asm volatile("" : "+s"(AP)); PH_IDS;
        for (int rep_ = 0; rep_ < NREP(2); ++rep_) { if (rep_) __syncthreads();
        pg8::Gemm g{(const bf16_t*)(ws + WS_H), (const bf16_t*)(ws + WS_WEIN), MT, E_N, 1024}; pg8::RectOrder S; S.init(MT / 256, E_N / 256, 0, 0, 0, G, bx);
        EpiEin E{ws}; pg8::gemm_phase<EpiEin, pg8::RectOrder, true, true>(lds, g, S, E);
        }
        SEAM(2);
    }
    if (IN(3)) { asm volatile("" : "+s"(AP)); PH_IDS;
        for (int rep_ = 0; rep_ < NREP(3) + NREP(14) - 1; ++rep_) {
        for (int un = vcu * 4; un < vcu * 4 + 4; ++un) if (un < 1024) attn_unit<0>(lds, ws, I_e_sink, un);
        if (G != 256) for (int un = 4 * G + bx; un < 1024; un += G) attn_unit<0>(lds, ws, I_e_sink, un);
        for (int un = bx; un < 128; un += G) attn_unit<1>(lds, ws, I_e_sink, un);
        }
        for (int rep_ = 0; rep_ < NREP(3) + NREP(15) - 1; ++rep_) { p3_conv(ws, I_e_conv_w, bx * NTHREADS + tid, G * NTHREADS);
        }
        SEAM(3);
    }
    if (IN(4)) { asm volatile("" : "+s"(AP)); PH_IDS;
        for (int rep_ = 0; rep_ < NREP(4); ++rep_) { if (rep_) __syncthreads();
        pg8::Gemm g{(const bf16_t*)(ws + WS_U), (const bf16_t*)(ws + WS_WEOUT), MT, 1024, 1024}; pg8::RectOrder S; S.init(MT / 256, 4, 0, 0, 0, G, bx);
        EpiY E{(bf16_t*)(ws + WS_Y), (float*)(ws + WS_SSQY0)}; pg8::gemm_phase<EpiY, pg8::RectOrder, true, true>(lds, g, S, E);
        }
        SEAM(4);
    }
    if (IN(5)) { asm volatile("" : "+s"(AP)); PH_IDS; for (int rep_ = 0; rep_ < NREP(5); ++rep_) { if (rep_) __syncthreads();
        p5_post_pre(I_x, I_ctx, I_post_w, I_pre_w + 1024, MOD, (const bf16_t*)(ws + WS_Y), (const float*)(ws + WS_SSQY0), I_out, (bf16_t*)(ws + WS_H), gw, ngw, lane); }
        SEAM(5); }
    if (IN(6)) { asm volatile("" : "+s"(AP)); PH_IDS;
        for (int rep_ = 0; rep_ < NREP(6); ++rep_) { if (rep_) __syncthreads();
        pg8::Gemm g{(const bf16_t*)(ws + WS_H), (const bf16_t*)(ws + WS_WOIN), MT, O_N, 1024}; pg8::RectOrder S; S.init(ML / 256, O_N / 256, ML / 256, MC / 256, 5, G, bx);
        EpiOin E{ws}; pg8::gemm_phase<EpiOin, pg8::RectOrder, true, true>(lds, g, S, E);
        }
        SEAM(6);
    }
    if (IN(7)) { asm volatile("" : "+s"(AP)); PH_IDS;
        for (int rep_ = 0; rep_ < NREP(7); ++rep_) { if (rep_) __syncthreads();
        { pg8::Gemm g{(const bf16_t*)(ws + WS_CQ), (const bf16_t*)(ws + WS_WUQ), ML, 768, 768}; pg8::RectOrder S; S.init(ML / 256, 3, 0, 0, 0, G, bx);
          EpiUq E{ws}; pg8::gemm_phase<EpiUq, pg8::RectOrder, true, true>(lds, g, S, E); }
        __syncthreads();
        { pg8::Gemm g{(const bf16_t*)(ws + WS_CKV), (const bf16_t*)(ws + WS_WUKV), MT, 1024, 256}; pg8::RectOrder S; S.init(MT / 256, 4, 0, 0, 0, G, G - 1 - bx);
          EpiUkv E{ws}; pg8::gemm_phase<EpiUkv, pg8::RectOrder, true, true>(lds, g, S, E); }
        }
        SEAM(7);
    }
    if (IN(8)) { asm volatile("" : "+s"(AP)); PH_IDS;
        for (int rep_ = 0; rep_ < NREP(8) + NREP(12) - 1; ++rep_) { for (int ch = bx; ch < 256; ch += G) mlstm_chain_mfma<false>(lds, ws, I_o_ib, I_o_fb, ch);
        }
        for (int rep_ = 0; rep_ < NREP(8) + NREP(13) - 1; ++rep_) {
        for (int un = vcu * 4; un < vcu * 4 + 4; ++un) if (un < 1024) attn_unit<2>(lds, ws, nullptr, un);
        if (G != 256) for (int un = 4 * G + bx; un < 1024; un += G) attn_unit<2>(lds, ws, nullptr, un);
        }
        SEAM(8);
    }
    if (IN(9)) { asm volatile("" : "+s"(AP)); PH_IDS; for (int rep_ = 0; rep_ < NREP(9); ++rep_) { if (rep_) __syncthreads();
        p9_readout(ws, I_o_hn, gw, ngw, lane); }
        SEAM(9); }
    if (IN(10)) { asm volatile("" : "+s"(AP)); PH_IDS;
        for (int rep_ = 0; rep_ < NREP(10); ++rep_) { if (rep_) __syncthreads();
        pg8::Gemm g{(const bf16_t*)(ws + WS_U), (const bf16_t*)(ws + WS_WOOUT), ML, 1024, 1024}; pg8::RectOrder S; S.init(ML / 256, 4, 0, 0, 0, G, bx);
        EpiY E{(bf16_t*)(ws + WS_Y), (float*)(ws + WS_SSQY1)}; pg8::gemm_phase<EpiY, pg8::RectOrder, true, true>(lds, g, S, E);
        }
        SEAM(10);
    }
    if (IN(11)) { asm volatile("" : "+s"(AP)); PH_IDS; p11_final(I_post_w + 1024, MOD, (const bf16_t*)(ws + WS_Y), (const float*)(ws + WS_SSQY1), I_out, gw, ngw, lane); }
#undef IN
#undef SEAM
#undef I_x
#undef I_cvec
#undef I_ctx
#undef I_c_ctx
#undef I_mod_w
#undef I_mod_b
#undef I_pre_w
#undef I_post_w
#undef I_e_w_in
#undef I_e_sink
#undef I_e_conv_w
#undef I_e_w_out
#undef I_o_w_in
#undef I_o_qn
#undef I_o_kvn
#undef I_o_w_uq
#undef I_o_w_ukv
#undef I_o_ib
#undef I_o_fb
#undef I_o_hn
#undef I_o_w_out
#undef I_out
}

extern "C" void kernel_launch(void* const* d_in, const int* in_sizes, int n_in, void* d_out, int out_size, void* d_ws, size_t ws_size, hipStream_t stream) {
    static int grid = 0;
    if (grid == 0) {
        if (n_in != 21 || in_sizes[0] != ML * DM || out_size != ML * DM || ws_size < WS_END) { fprintf(stderr, "kernel_launch: unexpected shapes / workspace (n_in %d, ws %zu < %zu); nothing launched\n", n_in, ws_size, (size_t)WS_END); grid = -1; return; }
        int dev = 0, cus = 0, per_cu = 0;
        if (hipGetDevice(&dev) != hipSuccess || hipDeviceGetAttribute(&cus, hipDeviceAttributeMultiprocessorCount, dev) != hipSuccess) { grid = -1; return; }
        if (hipFuncSetAttribute((const void*)hybrid_fwd, hipFuncAttributeMaxDynamicSharedMemorySize, LDS_BYTES) != hipSuccess) { fprintf(stderr, "kernel_launch: hipFuncSetAttribute failed\n"); grid = -1; return; }
        if (hipOccupancyMaxActiveBlocksPerMultiprocessor(&per_cu, (const void*)hybrid_fwd, NTHREADS, LDS_BYTES) != hipSuccess || per_cu < 1) fprintf(stderr, "kernel_launch: note: occupancy query reports %d workgroups per CU\n", per_cu);
        (void)hipGetLastError();
        grid = cus;
    }
    if (grid < 0) return;
    if (hipMemsetAsync((char*)d_ws + WS_CTL, 0, CTL_ZERO_BYTES, stream) != hipSuccess) { fprintf(stderr, "kernel_launch: hipMemsetAsync failed\n"); return; }
    Args a{};
    for (int i = 0; i < 21; ++i) a.in[i] = (const float*)d_in[i];
    a.out = (float*)d_out; a.ws = (unsigned char*)d_ws;
    if (MK_N_LAUNCHES == 1) { a.ph_lo = 0; a.ph_hi = N_PHASES; hipLaunchKernelGGL(hybrid_fwd, dim3(grid), dim3(NTHREADS), LDS_BYTES, stream, a); }
    else for (int p = 0; p < N_PHASES; ++p) { a.ph_lo = p; a.ph_hi = p + 1; hipLaunchKernelGGL(hybrid_fwd, dim3(grid), dim3(NTHREADS), LDS_BYTES, stream, a); }
    const hipError_t le = hipPeekAtLastError();
    if (le != hipSuccess) fprintf(stderr, "kernel_launch: launch failed: %s\n", hipGetErrorName(le));
}
```

```cpp
#include <hip/hip_runtime.h>
#include <cstdio>
#include <cstdint>

#define LAS __attribute__((address_space(3)))
#define GAS __attribute__((address_space(1)))
typedef unsigned short bf16_t;
typedef short bf16x8 __attribute__((ext_vector_type(8)));
typedef short s16x4 __attribute__((ext_vector_type(4)));
typedef float f32x4 __attribute__((ext_vector_type(4)));
typedef float f32x16 __attribute__((ext_vector_type(16)));
typedef unsigned u32x4 __attribute__((ext_vector_type(4)));
typedef unsigned u32x2 __attribute__((ext_vector_type(2)));
typedef float f32x2_t __attribute__((ext_vector_type(2)));
typedef __bf16 bf16x2_t __attribute__((ext_vector_type(2)));

constexpr int NB = 16, SEQ = 2048, DM = 1024, CL = 256;
constexpr int ML = NB * SEQ, MC = NB * CL, MT = ML + MC;
constexpr float EPS = 1e-6f, LOG2E = 1.4426950408889634f;
constexpr int E_N = 3328, O_NSRC = 3632, O_N = 3840;
constexpr int NWAVES = 8, NTHREADS = 512;

__device__ __forceinline__ float bf_lo(unsigned w) { return __uint_as_float(w << 16); }
__device__ __forceinline__ float bf_hi(unsigned w) { return __uint_as_float(w & 0xffff0000u); }
__device__ __forceinline__ unsigned pk2(float lo, float hi) { f32x2_t v = {lo, hi}; bf16x2_t b = __builtin_convertvector(v, bf16x2_t); return __builtin_bit_cast(unsigned, b); }
__device__ __forceinline__ float silu_f(float x) { return x * __builtin_amdgcn_rcpf(1.f + __expf(-x)); }
__device__ __forceinline__ float sigmoid_f(float x) { return __builtin_amdgcn_rcpf(1.f + __expf(-x)); }
__device__ __forceinline__ float wave_sum(float v) {
#pragma unroll
    for (int o = 1; o < 64; o <<= 1) v += __shfl_xor(v, o);
    return v;
}
#define LDS_WAIT() asm volatile("s_waitcnt lgkmcnt(0)" ::: "memory")
#define VM_WAIT() asm volatile("s_waitcnt vmcnt(0)" ::: "memory")

__device__ __forceinline__ int my_tid() { int t = threadIdx.x; asm volatile("" : "+v"(t)); return t; }

namespace pg8 {
#define PG8_LAS __attribute__((address_space(3)))
typedef unsigned short bf16_t;
typedef short bf16x8 __attribute__((ext_vector_type(8)));
typedef float f32x4 __attribute__((ext_vector_type(4)));
typedef unsigned u32x4 __attribute__((ext_vector_type(4)));
constexpr int BM = 256, BK = 64, HALF = 128, HTB = HALF * BK * 2  , STAGE_BYTES = 8 * HTB, NXCD = 8, WGM = 8;

__host__ __device__ __forceinline__ int lds_byte(int r, int c) { const int st = (r >> 4) * 2 + (c >> 5), rr = r & 15, cc = c & 31, ob = rr * 64 + cc * 2; return st * 1024 + (ob ^ (((ob >> 9) & 1) << 5)); }
__host__ __device__ __forceinline__ void stage_rc(int b, int& R, int& C) { const int st = b / 1024, sb = b % 1024, swz = sb ^ (((sb >> 9) & 1) << 5); R = (st >> 1) * 16 + swz / 64; C = (st & 1) * 32 + (swz % 64) / 2; }
__host__ __device__ __forceinline__ int perm32(int rho) { const int n = rho >> 4, i = rho & 15; return 8 * (i >> 2) + 4 * n + (i & 3); }

struct Unit { int pm, pn; };
struct Gemm { const bf16_t* A; const bf16_t* Bt; int M, N, K; };

struct RectOrder {
    int nM0, nN0, n0, pm1, nM1, nN1, n1, G, c;
    __device__ __forceinline__ void init(int nM0_, int nN0_, int pm1_, int nM1_, int nN1_, int G_, int c_) { nM0 = nM0_; nN0 = nN0_; n0 = nM0_ * nN0_; pm1 = pm1_; nM1 = nM1_; nN1 = nN1_; n1 = nM1_ * nN1_; G = G_; c = c_; }
    __device__ __forceinline__ static void rect(int w, int nM, int nN, int& pm, int& pn) {
        const int nig = WGM * nN, gid = w / nig, fm = gid * WGM, gsz = (nM - fm) < WGM ? (nM - fm) : WGM;
        pm = fm + ((w % nig) % gsz); pn = (w % nig) / gsz;
    }
    __device__ __forceinline__ bool next(int i, Unit& u) const {
        const int nwg = n0 + n1; const long L = (long)i * G + c; if (L >= nwg) return false;
        int wgid = (int)L; { const int q = nwg / NXCD, r = nwg % NXCD, xcd = wgid % NXCD, off = wgid / NXCD; wgid = (xcd < r ? xcd * (q + 1) : r * (q + 1) + (xcd - r) * q) + off; }
        if (wgid < n0) rect(wgid, nM0, nN0, u.pm, u.pn); else { rect(wgid - n0, nM1, nN1, u.pm, u.pn); u.pm += pm1; }
        return true;
    }
    __device__ __forceinline__ void a_ready(const Unit&) const {}
    __device__ __forceinline__ void done(const Unit&) const {}
};

template <class Epi, class Sched, bool ALIGN_EPI = false, bool SP2 = false>
__device__ __forceinline__ void gemm_phase(PG8_LAS unsigned char* lds, const Gemm g, const Sched& S, const Epi& E) {
    const int tid = my_tid(), wid = __builtin_amdgcn_readfirstlane(tid >> 6), lane = tid & 63, wr = wid >> 2, wc = wid & 3, fr = lane & 15, fq = lane >> 4;
    const int K = g.K, nt = K / BK;
    unsigned voffA[2], voffB[2];
#pragma unroll
    for (int i = 0; i < 2; ++i) { int R, C; stage_rc(tid * 16 + i * 8192, R, C); const int Rb = Epi::PERM ? ((R & ~31) + perm32(R & 31)) : R;
        voffA[i] = (unsigned)(R * K + C) * 2u; voffB[i] = (unsigned)(Rb * K + C) * 2u; }
    const size_t kstep = (size_t)(BK * 2);
    const size_t hstep = (size_t)HALF * K * 2;
    const size_t tstep = 2 * hstep;
    const unsigned ldsw = (unsigned)wid * 1024u;
    const int aoff = lds_byte(wr * 64 + fr, fq * 8), boff = lds_byte(wc * 32 + fr, fq * 8);
#define PG8_SA(b, h) (((b) * 2 + (h)) * HTB)
#define PG8_SB(b, h) ((4 + (b) * 2 + (h)) * HTB)
#define PG8_STAGE(bufoff, gbase, voff) do { _Pragma("unroll") for (int _i = 0; _i < 2; ++_i) \
        __builtin_amdgcn_global_load_lds((const unsigned*)((const char*)(gbase) + (voff)[_i]), (PG8_LAS unsigned*)(lds + (bufoff) + ldsw + _i * 8192), 16, 0, 0); } while (0)
#define PG8_LDA(dst, b, h) do { _Pragma("unroll") for (int m = 0; m < 4; ++m) _Pragma("unroll") for (int k = 0; k < 2; ++k) dst[m][k] = *(const PG8_LAS bf16x8*)(lds + PG8_SA(b, h) + aoff + m * 2048 + k * 1024); } while (0)
#define PG8_LDB(dst, b, h) do { _Pragma("unroll") for (int n = 0; n < 2; ++n) _Pragma("unroll") for (int k = 0; k < 2; ++k) dst[n][k] = *(const PG8_LAS bf16x8*)(lds + PG8_SB(b, h) + boff + n * 2048 + k * 1024); } while (0)
#define PG8_MMA(ai, bj, At, Bt) do { __builtin_amdgcn_s_setprio(1); _Pragma("unroll") for (int m = 0; m < 4; ++m) _Pragma("unroll") for (int n = 0; n < 2; ++n) _Pragma("unroll") for (int k = 0; k < 2; ++k) \
        acc[ai][bj][m][n] = __builtin_amdgcn_mfma_f32_16x16x32_bf16(Bt[n][k], At[m][k], acc[ai][bj][m][n], 0, 0, 0); __builtin_amdgcn_s_setprio(0); } while (0)
#define PG8_WAIT_V(n) asm volatile("s_waitcnt vmcnt(" #n ")" ::: "memory")
#define PG8_WAIT_L(n) asm volatile("s_waitcnt lgkmcnt(" #n ")" ::: "memory")
#define PG8_BAR __builtin_amdgcn_s_barrier()
#define PG8_SCHED __builtin_amdgcn_sched_barrier(0)
    Unit cur, nxt; int ui = 0;
    if (!S.next(0, cur)) return;
    f32x4 acc[2][2][4][2];
#pragma unroll
    for (int a = 0; a < 2; ++a)
#pragma unroll
        for (int b = 0; b < 2; ++b)
#pragma unroll
            for (int m = 0; m < 4; ++m)
#pragma unroll
                for (int n = 0; n < 2; ++n) acc[a][b][m][n] = (f32x4){0.f, 0.f, 0.f, 0.f};
    bf16x8 At[4][2], B0[2][2], B1[2][2];
    const char* cA = (const char*)g.A + (size_t)cur.pm * tstep; const char* cB = (const char*)g.Bt + (size_t)cur.pn * tstep;
    S.a_ready(cur);
    if constexpr (SP2) {
        PG8_STAGE(PG8_SB(0, 0), cB, voffB); PG8_STAGE(PG8_SB(0, 1), cB + hstep, voffB); PG8_STAGE(PG8_SA(0, 0), cA, voffA); PG8_STAGE(PG8_SA(0, 1), cA + hstep, voffA);
        if (wr == 1) PG8_BAR;
        PG8_WAIT_V(2); PG8_BAR;
        PG8_STAGE(PG8_SB(1, 0), cB + kstep, voffB); PG8_STAGE(PG8_SA(1, 0), cA + kstep, voffA); PG8_STAGE(PG8_SB(1, 1), cB + hstep + kstep, voffB);
        PG8_WAIT_V(6); PG8_BAR;
    } else {
        PG8_STAGE(PG8_SB(0, 0), cB, voffB); PG8_STAGE(PG8_SA(0, 0), cA, voffA); PG8_STAGE(PG8_SB(0, 1), cB + hstep, voffB); PG8_STAGE(PG8_SA(0, 1), cA + hstep, voffA);
        if (wr == 1) PG8_BAR;
        PG8_WAIT_V(4); PG8_BAR;
        PG8_STAGE(PG8_SB(1, 0), cB + kstep, voffB); PG8_STAGE(PG8_SA(1, 0), cA + kstep, voffA); PG8_STAGE(PG8_SB(1, 1), cB + hstep + kstep, voffB);
        PG8_WAIT_V(6); PG8_BAR;
    }
    for (;;) {
        const bool has_next = S.next(ui + 1, nxt);
        const char* nA = has_next ? (const char*)g.A + (size_t)nxt.pm * tstep : cA; const char* nB = has_next ? (const char*)g.Bt + (size_t)nxt.pn * tstep : cB;
        for (int t = 0; t < nt; t += 2) {
            const bool last = (t == nt - 2);
            const char* a1 = cA + (size_t)(t + 1) * kstep;
            const char* a2 = last ? nA : cA + (size_t)(t + 2) * kstep; const char* b2 = last ? nB : cB + (size_t)(t + 2) * kstep;
            const char* a3 = a2 + kstep; const char* b3 = b2 + kstep;
            if (last && has_next) S.a_ready(nxt);
            if constexpr (SP2) {
            PG8_LDB(B0, 0, 0); PG8_LDB(B1, 0, 1); PG8_SCHED; PG8_LDA(At, 0, 0); PG8_STAGE(PG8_SA(1, 1), a1 + hstep, voffA);
            PG8_WAIT_V(8); PG8_WAIT_L(0); PG8_BAR; PG8_MMA(0, 0, At, B0); PG8_MMA(0, 1, At, B1); PG8_BAR; PG8_SCHED;
            PG8_LDA(At, 0, 1); PG8_STAGE(PG8_SB(0, 0), b2, voffB); PG8_STAGE(PG8_SB(0, 1), b2 + hstep, voffB); PG8_STAGE(PG8_SA(0, 0), a2, voffA);
            PG8_WAIT_V(8); PG8_WAIT_L(0); PG8_BAR; PG8_MMA(1, 0, At, B0); PG8_MMA(1, 1, At, B1); PG8_BAR; PG8_SCHED;
            PG8_LDB(B0, 1, 0); PG8_LDB(B1, 1, 1); PG8_SCHED; PG8_LDA(At, 1, 0); PG8_STAGE(PG8_SA(0, 1), a2 + hstep, voffA);
            PG8_WAIT_V(8); PG8_WAIT_L(0); PG8_BAR; PG8_MMA(0, 0, At, B0); PG8_MMA(0, 1, At, B1); PG8_BAR; PG8_SCHED;
            PG8_LDA(At, 1, 1); PG8_STAGE(PG8_SB(1, 0), b3, voffB); PG8_STAGE(PG8_SB(1, 1), b3 + hstep, voffB); PG8_STAGE(PG8_SA(1, 0), a3, voffA);
            PG8_WAIT_V(8); PG8_WAIT_L(0); PG8_BAR; PG8_MMA(1, 0, At, B0); PG8_MMA(1, 1, At, B1); PG8_BAR; PG8_SCHED;
            } else {
            PG8_LDB(B0, 0, 0); PG8_SCHED; PG8_LDA(At, 0, 0); PG8_STAGE(PG8_SA(1, 1), a1 + hstep, voffA);
            PG8_WAIT_L(8); PG8_BAR; PG8_WAIT_L(0); PG8_MMA(0, 0, At, B0); PG8_BAR; PG8_SCHED;
            PG8_LDB(B1, 0, 1); PG8_STAGE(PG8_SB(0, 0), b2, voffB);
            PG8_BAR; PG8_WAIT_L(0); PG8_MMA(0, 1, At, B1); PG8_BAR;
            PG8_LDA(At, 0, 1); PG8_STAGE(PG8_SA(0, 0), a2, voffA);
            PG8_BAR; PG8_WAIT_L(0); PG8_MMA(1, 0, At, B0); PG8_BAR; PG8_SCHED;
            PG8_STAGE(PG8_SB(0, 1), b2 + hstep, voffB);
            PG8_WAIT_V(6); PG8_BAR; PG8_MMA(1, 1, At, B1); PG8_BAR;
            PG8_LDB(B0, 1, 0); PG8_SCHED; PG8_LDA(At, 1, 0); PG8_STAGE(PG8_SA(0, 1), a2 + hstep, voffA);
            PG8_WAIT_L(8); PG8_BAR; PG8_WAIT_L(0); PG8_MMA(0, 0, At, B0); PG8_BAR; PG8_SCHED;
            PG8_LDB(B1, 1, 1); PG8_STAGE(PG8_SB(1, 0), b3, voffB);
            PG8_BAR; PG8_WAIT_L(0); PG8_MMA(0, 1, At, B1); PG8_BAR;
            PG8_LDA(At, 1, 1); PG8_STAGE(PG8_SA(1, 0), a3, voffA);
            PG8_BAR; PG8_WAIT_L(0); PG8_MMA(1, 0, At, B0); PG8_BAR; PG8_SCHED;
            PG8_STAGE(PG8_SB(1, 1), b3 + hstep, voffB);
            PG8_WAIT_V(6); PG8_BAR; PG8_MMA(1, 1, At, B1); PG8_BAR;
            }
        }
        if constexpr (ALIGN_EPI) { if (wr == 0) PG8_BAR; }
        if constexpr (!Epi::AFTER_DRAIN) { E(acc, cur, wr, wc, fr, fq); S.done(cur); }
        if (!has_next) break;
#pragma unroll
        for (int a = 0; a < 2; ++a)
#pragma unroll
            for (int b = 0; b < 2; ++b)
#pragma unroll
                for (int m = 0; m < 4; ++m)
#pragma unroll
                    for (int n = 0; n < 2; ++n) acc[a][b][m][n] = (f32x4){0.f, 0.f, 0.f, 0.f};
        cur = nxt; cA = nA; cB = nB; ++ui;
        if constexpr (ALIGN_EPI) { if (wr == 1) PG8_BAR; }
    }
    PG8_WAIT_V(0);
    if constexpr (!ALIGN_EPI) { if (wr == 0) PG8_BAR; }
    PG8_BAR;
    if constexpr (Epi::AFTER_DRAIN) { E.fused(acc, cur, wr, wc, fr, fq, lds, wid, lane); S.done(cur); }
#undef PG8_SA
#undef PG8_SB
#undef PG8_STAGE
#undef PG8_LDA
#undef PG8_LDB
#undef PG8_MMA
#undef PG8_WAIT_V
#undef PG8_WAIT_L
#undef PG8_BAR
#undef PG8_SCHED
}
}

constexpr size_t MiB = 1u << 20;
constexpr size_t WS_CTL = 0, CTL_ZERO_BYTES = 1 * MiB;
constexpr size_t WS_MOD = 1 * MiB;
constexpr size_t WS_ROPEA = 2 * MiB;
constexpr size_t WS_ROPEC = 2 * MiB + 512 * 1024;
constexpr size_t WS_WEIN = 3 * MiB, WS_WEOUT = 10 * MiB, WS_WOIN = 12 * MiB, WS_WUQ = 20 * MiB, WS_WUKV = 21 * MiB + 512 * 1024, WS_WOOUT = 22 * MiB;
constexpr size_t WS_H = 24 * MiB;
constexpr size_t WS_U = 96 * MiB;
constexpr size_t WS_Y = 168 * MiB;
constexpr size_t WS_R = 240 * MiB;
constexpr size_t WS_KVE = WS_R  , WS_QE = WS_R + 18 * MiB, WS_PE = WS_R + 54 * MiB, WS_GE = WS_R + 90 * MiB, WS_ZA = WS_R + 126 * MiB, WS_SSQY0 = WS_R + 162 * MiB;
constexpr size_t WS_CKV = WS_R, WS_CQ = WS_R + 18 * MiB, WS_HM = WS_R  , WS_MK = WS_R + 66 * MiB, WS_MV = WS_R + 84 * MiB, WS_KR = WS_R + 120 * MiB, WS_GATES = WS_R + 123 * MiB,
                 WS_SSQCKV = WS_R + 126 * MiB, WS_SSQCQ = WS_R + 127 * MiB, WS_MQ = WS_R + 129 * MiB, WS_MO = WS_R + 145 * MiB, WS_ZO = WS_R + 177 * MiB, WS_SSQY1 = WS_R + 241 * MiB;
constexpr size_t WS_KNV = WS_H  , WS_QO = WS_Y;
constexpr size_t WS_END = WS_R + 244 * MiB;
static_assert(WS_SSQY0 + (size_t)MT * 16 * 4 <= WS_R + 165 * MiB && WS_HM + (size_t)2 * ML * 512 * 2 <= WS_MK && WS_SSQY1 + (size_t)MT * 16 * 4 <= WS_END, "ws map");

__device__ __forceinline__ void st8(bf16_t* p, f32x4 a, f32x4 b) { u32x4 w; w.x = pk2(a[0], a[1]); w.y = pk2(a[2], a[3]); w.z = pk2(b[0], b[1]); w.w = pk2(b[2], b[3]); *(u32x4*)p = w; }
__device__ __forceinline__ bf16_t f2bf(float v) { return (bf16_t)(pk2(v, 0.f) & 0xffffu); }
__device__ __forceinline__ void rope8(f32x4& a, f32x4& b, const float* cosp, const float* sinp) {
    const f32x4 cs = *(const f32x4*)cosp, sn = *(const f32x4*)sinp;
    const float a0 = a[0] * cs[0] - a[1] * sn[0], a1 = a[0] * sn[0] + a[1] * cs[0], a2 = a[2] * cs[1] - a[3] * sn[1], a3 = a[2] * sn[1] + a[3] * cs[1];
    const float b0 = b[0] * cs[2] - b[1] * sn[2], b1 = b[0] * sn[2] + b[1] * cs[2], b2 = b[2] * cs[3] - b[3] * sn[3], b3 = b[2] * sn[3] + b[3] * cs[3];
    a = (f32x4){a0, a1, a2, a3}; b = (f32x4){b0, b1, b2, b3};
}
__device__ __forceinline__ f32x4 silu4(f32x4 v) { return (f32x4){silu_f(v[0]), silu_f(v[1]), silu_f(v[2]), silu_f(v[3])}; }
__device__ __forceinline__ f32x4 sigm4(f32x4 v) { return (f32x4){sigmoid_f(v[0]), sigmoid_f(v[1]), sigmoid_f(v[2]), sigmoid_f(v[3])}; }
__device__ __forceinline__ float sq4(f32x4 v) { return (v[0] * v[0] + v[1] * v[1]) + (v[2] * v[2] + v[3] * v[3]); }

struct EpiEin {
    static constexpr bool PERM = true, AFTER_DRAIN = false;
    unsigned char* ws;
    __device__ __forceinline__ void operator()(const f32x4 (&acc)[2][2][4][2], const pg8::Unit& u, int wr, int wc, int fr, int fq) const {
        const int pn = u.pn, rbase = u.pm * 256 + wr * 64 + fr, cw = wc * 32 + 8 * fq;
        const float* ropeA = (const float*)(ws + WS_ROPEA);
#pragma unroll
        for (int ai = 0; ai < 2; ++ai)
#pragma unroll
            for (int m = 0; m < 4; ++m) {
                asm volatile("" ::: "memory"); const int R = rbase + ai * 128 + m * 16; const bool lat = R < ML; const int pos = R & 2047;
                if (pn == 0) {
                    f32x4 a = acc[ai][0][m][0], b = acc[ai][0][m][1];
                    if (lat) { const int i0 = (cw & 63) >> 1; rope8(a, b, ropeA + pos * 64 + i0, ropeA + pos * 64 + 32 + i0); }
                    st8((bf16_t*)(ws + WS_KVE) + (size_t)R * 256 + cw, a, b);
                    st8((bf16_t*)(ws + WS_KVE) + (size_t)R * 256 + 128 + cw, acc[ai][1][m][0], acc[ai][1][m][1]);
                } else if (pn <= 2) {
#pragma unroll
                    for (int bj = 0; bj < 2; ++bj) {
                        f32x4 a = acc[ai][bj][m][0], b = acc[ai][bj][m][1];
                        if (lat) { const int i0 = (cw & 63) >> 1; rope8(a, b, ropeA + pos * 64 + i0, ropeA + pos * 64 + 32 + i0); }
                        const float sc = 0.125f * LOG2E; a = a * sc; b = b * sc;
                        st8((bf16_t*)(ws + WS_QE) + (size_t)R * 512 + (pn - 1) * 256 + bj * 128 + cw, a, b);
                    }
                } else if (pn <= 6) {
                    st8((bf16_t*)(ws + WS_PE) + (size_t)R * 512 + (pn - 3) * 128 + cw, acc[ai][0][m][0] * acc[ai][1][m][0], acc[ai][0][m][1] * acc[ai][1][m][1]);
                } else if (pn <= 10) {
                    st8((bf16_t*)(ws + WS_GE) + (size_t)R * 512 + (pn - 7) * 128 + cw, acc[ai][0][m][0] * silu4(acc[ai][1][m][0]), acc[ai][0][m][1] * silu4(acc[ai][1][m][1]));
                } else {
#pragma unroll
                    for (int bj = 0; bj < 2; ++bj)
                        st8((bf16_t*)(ws + WS_ZA) + (size_t)R * 512 + (pn - 11) * 256 + bj * 128 + cw, silu4(acc[ai][bj][m][0]), silu4(acc[ai][bj][m][1]));
                }
            }
    }
};

struct EpiY {
    static constexpr bool PERM = true, AFTER_DRAIN = false;
    bf16_t* Y; float* SSQ;
    __device__ __forceinline__ void operator()(const f32x4 (&acc)[2][2][4][2], const pg8::Unit& u, int wr, int wc, int fr, int fq) const {
        const int pn = u.pn, rbase = u.pm * 256 + wr * 64 + fr, cw = wc * 32 + 8 * fq;
#pragma unroll
        for (int ai = 0; ai < 2; ++ai)
#pragma unroll
            for (int m = 0; m < 4; ++m) {
                asm volatile("" ::: "memory"); const int R = rbase + ai * 128 + m * 16; float s = 0.f;
#pragma unroll
                for (int bj = 0; bj < 2; ++bj) { st8(Y + (size_t)R * 1024 + pn * 256 + bj * 128 + cw, acc[ai][bj][m][0], acc[ai][bj][m][1]); s += sq4(acc[ai][bj][m][0]) + sq4(acc[ai][bj][m][1]); }
                s += __shfl_xor(s, 16); s += __shfl_xor(s, 32);
                if (fq == 0) SSQ[(size_t)R * 16 + pn * 4 + wc] = s;
            }
    }
};

struct EpiOin {
    static constexpr bool PERM = true, AFTER_DRAIN = false;
    unsigned char* ws;
    __device__ __forceinline__ void operator()(const f32x4 (&acc)[2][2][4][2], const pg8::Unit& u, int wr, int wc, int fr, int fq) const {
        const int pn = u.pn, rbase = u.pm * 256 + wr * 64 + fr, cw = wc * 32 + 8 * fq;
        const float* ropeC = (const float*)(ws + WS_ROPEC);
#pragma unroll
        for (int ai = 0; ai < 2; ++ai)
#pragma unroll
            for (int m = 0; m < 4; ++m) {
                asm volatile("" ::: "memory"); const int R = rbase + ai * 128 + m * 16; const bool lat = R < ML; const int pos = R & 2047;
                if (pn == 0 || (pn >= 5 && pn <= 7)) {
                    float s = 0.f;
                    bf16_t* dst = (pn == 0) ? (bf16_t*)(ws + WS_CKV) + (size_t)R * 256 : (bf16_t*)(ws + WS_CQ) + (size_t)R * 768 + (pn - 5) * 256;
#pragma unroll
                    for (int bj = 0; bj < 2; ++bj) { st8(dst + bj * 128 + cw, acc[ai][bj][m][0], acc[ai][bj][m][1]); s += sq4(acc[ai][bj][m][0]) + sq4(acc[ai][bj][m][1]); }
                    s += __shfl_xor(s, 16); s += __shfl_xor(s, 32);
                    if (fq == 0) { if (pn == 0) ((float*)(ws + WS_SSQCKV))[(size_t)R * 4 + wc] = s; else ((float*)(ws + WS_SSQCQ))[(size_t)R * 12 + (pn - 5) * 4 + wc] = s; }
                } else if (pn == 4) {
                    if (wc == 0) {
                        f32x4 a = acc[ai][0][m][0], b = acc[ai][0][m][1];
                        if (lat) { const int i0 = cw >> 1; rope8(a, b, ropeC + pos * 32 + i0, ropeC + pos * 32 + 16 + i0); }
                        st8((bf16_t*)(ws + WS_KR) + (size_t)R * 32 + cw, a, b);
                    } else if (wc == 1 && fq < 2) {
                        float* g = (float*)(ws + WS_GATES) + (size_t)R * 16 + 8 * fq;
                        *(f32x4*)g = acc[ai][0][m][0]; *(f32x4*)(g + 4) = acc[ai][0][m][1];
                    }
                } else {
#pragma unroll
                    for (int bj = 0; bj < 2; ++bj) {
                        const f32x4 a = acc[ai][bj][m][0], b = acc[ai][bj][m][1]; const int col = bj * 128 + cw;
                        if (pn == 1) st8((bf16_t*)(ws + WS_MK) + (size_t)R * 256 + col, a * 0.125f, b * 0.125f);
                        else if (pn <= 3) st8((bf16_t*)(ws + WS_MV) + (size_t)R * 512 + (pn - 2) * 256 + col, a, b);
                        else if (pn == 8) st8((bf16_t*)(ws + WS_MQ) + (size_t)R * 256 + col, a, b);
                        else if (pn <= 10) st8((bf16_t*)(ws + WS_MO) + (size_t)R * 512 + (pn - 9) * 256 + col, sigm4(a), sigm4(b));
                        else st8((bf16_t*)(ws + WS_ZO) + (size_t)R * 1024 + (pn - 11) * 256 + col, silu4(a), silu4(b));
                    }
                }
            }
    }
};

struct EpiUkv {
    static constexpr bool PERM = true, AFTER_DRAIN = false;
    unsigned char* ws;
    __device__ __forceinline__ void operator()(const f32x4 (&acc)[2][2][4][2], const pg8::Unit& u, int wr, int wc, int fr, int fq) const {
        const int pn = u.pn, rbase = u.pm * 256 + wr * 64 + fr, cw = wc * 32 + 8 * fq;
#pragma unroll
        for (int ai = 0; ai < 2; ++ai)
#pragma unroll
            for (int m = 0; m < 4; ++m) {
                asm volatile("" ::: "memory"); const int R = rbase + ai * 128 + m * 16;
                const f32x4 sp = *(const f32x4*)((const float*)(ws + WS_SSQCKV) + (size_t)R * 4);
                const float rstd = rsqrtf(((sp[0] + sp[1]) + (sp[2] + sp[3])) * (1.f / 256.f) + EPS);
                int b, pos; if (R < ML) { b = R >> 11; pos = 256 + (R & 2047); } else { const int rc = R - ML; b = rc >> 8; pos = rc & 255; }
#pragma unroll
                for (int bj = 0; bj < 2; ++bj) {
                    const int head = pn * 2 + bj;
                    st8((bf16_t*)(ws + WS_KNV) + ((size_t)(b * 8 + head) * 2304 + pos) * 128 + cw, acc[ai][bj][m][0] * rstd, acc[ai][bj][m][1] * rstd);
                }
            }
    }
};

struct EpiUq {
    static constexpr bool PERM = true, AFTER_DRAIN = false;
    unsigned char* ws;
    __device__ __forceinline__ void operator()(const f32x4 (&acc)[2][2][4][2], const pg8::Unit& u, int wr, int wc, int fr, int fq) const {
        const int pn = u.pn, rbase = u.pm * 256 + wr * 64 + fr, cw = wc * 32 + 8 * fq;
        const float* ropeC = (const float*)(ws + WS_ROPEC);
#pragma unroll
        for (int ai = 0; ai < 2; ++ai)
#pragma unroll
            for (int m = 0; m < 4; ++m) {
                asm volatile("" ::: "memory"); const int R = rbase + ai * 128 + m * 16, pos = R & 2047;
                const float* sp = (const float*)(ws + WS_SSQCQ) + (size_t)R * 12;
                const f32x4 s0 = *(const f32x4*)sp, s1 = *(const f32x4*)(sp + 4), s2 = *(const f32x4*)(sp + 8);
                const float ss = (((s0[0] + s0[1]) + (s0[2] + s0[3])) + ((s1[0] + s1[1]) + (s1[2] + s1[3]))) + ((s2[0] + s2[1]) + (s2[2] + s2[3]));
                const float sc = rsqrtf(ss * (1.f / 768.f) + EPS) * (0.10206207261596575f * LOG2E);
#pragma unroll
                for (int bj = 0; bj < 2; ++bj) {
                    const int c = pn * 256 + bj * 128 + cw, head = c / 96, dd = c - head * 96;
                    f32x4 a = acc[ai][bj][m][0], b = acc[ai][bj][m][1];
                    if (dd >= 64) { const int i0 = (dd - 64) >> 1; rope8(a, b, ropeC + pos * 32 + i0, ropeC + pos * 32 + 16 + i0); }
                    st8((bf16_t*)(ws + WS_QO) + (size_t)R * 768 + c, a * sc, b * sc);
                }
            }
    }
};

#define RLX_AGENT __ATOMIC_RELAXED, __HIP_MEMORY_SCOPE_AGENT
#define XB_TMO      128
#define XB_XCNT(j)  (256  + 64 * (j))
#define XB_XSUB(j)  (1280 + 64 * (j))
#define XB_XGEN(j)  (2304 + 64 * (j))
#define XB_TOP      3328
#define XB_TOPGEN   3392
#define XCD_BAR_WORDS 3456
#define XB_SPIN_CAP (1u << 18)

__device__ __forceinline__ unsigned xb_ld(unsigned* p)              { return __hip_atomic_load(p, __ATOMIC_RELAXED, __HIP_MEMORY_SCOPE_AGENT); }
__device__ __forceinline__ unsigned xb_add(unsigned* p, unsigned v) { return __hip_atomic_fetch_add(p, v, __ATOMIC_RELAXED, __HIP_MEMORY_SCOPE_AGENT); }
__device__ __forceinline__ unsigned xb_xcc_id() { return (unsigned)__builtin_amdgcn_s_getreg((3 << 11) | 20) & 0xFu; }
#define XB_SPIN(cond, bar) do { unsigned _sp = 0; while (cond) { __builtin_amdgcn_s_sleep(1); \
    if ((++_sp & 255u) == 0u) { if (xb_ld(&(bar)[XB_TMO])) break; if (_sp > XB_SPIN_CAP) { atomicAdd(&(bar)[XB_TMO], 1u); break; } } } } while (0)

struct XcdBarrier {
    unsigned* bar; unsigned x;
    volatile LAS unsigned* st;
};

__device__ __forceinline__ XcdBarrier xcd_barrier_post(unsigned* bar, volatile LAS unsigned* st) {
    XcdBarrier b; b.bar = bar; b.x = xb_xcc_id(); b.st = st;
    if (threadIdx.x == 0) (void)xb_add(&bar[XB_XCNT(b.x)], 1u);
    return b;
}
__device__ __forceinline__ void xcd_barrier_complete(unsigned* bar, unsigned x, unsigned& nloc, unsigned& nx) {
    const unsigned G = gridDim.x * gridDim.y * gridDim.z;
    unsigned sum, cnt, mine, sp = 0u;
    for (;;) {
        sum = 0u; cnt = 0u; mine = 0u;
#pragma unroll
        for (unsigned j = 0; j < 16; ++j) { const unsigned c = xb_ld(&bar[XB_XCNT(j)]); sum += c; cnt += (c > 0u) ? 1u : 0u; mine = (j == x) ? c : mine; }
        if (sum == G) break;
        __builtin_amdgcn_s_sleep(1);
        if ((++sp & 255u) == 0u) { if (xb_ld(&bar[XB_TMO])) break; if (sp > XB_SPIN_CAP) { atomicAdd(&bar[XB_TMO], 1u); break; } }
    }
    nloc = mine > 0u ? mine : 1u; nx = cnt > 0u ? cnt : 1u;
}

__device__ __forceinline__ void xcd_barrier(const XcdBarrier& b) {
    asm volatile("s_waitcnt vmcnt(0)" ::: "memory");
    __syncthreads();
    if (threadIdx.x == 0) {
        unsigned* bar = b.bar;
        __builtin_amdgcn_s_waitcnt(0);
        unsigned nloc = b.st[0], nx = b.st[1];
        if (nloc == 0u) { xcd_barrier_complete(bar, b.x, nloc, nx); b.st[0] = nloc; b.st[1] = nx; }
        const unsigned old = xb_add(&bar[XB_XSUB(b.x)], 1u);
        const unsigned gen = old / nloc;
        if (old + 1u == (gen + 1u) * nloc) {
            __builtin_amdgcn_fence(__ATOMIC_RELEASE, "agent");
            asm volatile("s_waitcnt vmcnt(0)" ::: "memory");
            const unsigned og = xb_add(&bar[XB_TOP], 1u);
            const unsigned tg = og / nx;
            if (og + 1u == (tg + 1u) * nx) xb_add(&bar[XB_TOPGEN], 1u);
            else XB_SPIN(xb_ld(&bar[XB_TOPGEN]) == tg, bar);
            __builtin_amdgcn_fence(__ATOMIC_ACQUIRE, "agent");
            xb_add(&bar[XB_XGEN(b.x)], 1u);
            asm volatile("s_waitcnt vmcnt(0)" ::: "memory");
        } else {
            XB_SPIN(xb_ld(&bar[XB_XGEN(b.x)]) == gen, bar);
            __builtin_amdgcn_fence(__ATOMIC_ACQUIRE, "agent");
            asm volatile("s_waitcnt vmcnt(0)" ::: "memory");
        }
    }
    __syncthreads();
}

__device__ __forceinline__ int crow(int r, int hi) { return (r & 3) + 8 * (r >> 2) + 4 * hi; }
typedef short v4i16_t __attribute__((ext_vector_type(4)));
__device__ __forceinline__ s16x4 vtr(const LAS unsigned char* p) { return __builtin_bit_cast(s16x4, __builtin_amdgcn_ds_read_tr16_b64_v4i16((LAS v4i16_t*)p)); }

template <int MODE>
__device__ __forceinline__ void attn_unit(LAS unsigned char* lds, unsigned char* ws, const float* sink, int unit) {
    constexpr int DQK = (MODE == 2) ? 96 : 64, KST = DQK / 16, KS = DQK * 2 + 16, VS = 192, KBUF = 64 * KS, VBUF = 64 * VS;
    const int tid = my_tid(), lane = tid & 63, wid = __builtin_amdgcn_readfirstlane(tid >> 6), r32 = lane & 31, hi = lane >> 5;
    int b, head, hkv = 0, n = 0, Rq0, qpos0 = 0, nt, jlo = 0;
    const bf16_t* Qp; int qstride;
    if (MODE == 0) {
        const int hp = unit & 1; n = (unit >> 1) & 15; hkv = (unit >> 5) & 1; b = unit >> 6;
        head = hkv * 4 + hp * 2 + (wid >> 2); qpos0 = 128 * n + 32 * (wid & 3); Rq0 = b * 2048 + qpos0;
        Qp = (const bf16_t*)(ws + WS_QE) + (size_t)Rq0 * 512 + head * 64; qstride = 512;
        jlo = (n == 0) ? 2 : 0; const int jhi = (n == 15) ? 4 : 6; nt = 4 + (jhi - jlo);
    } else if (MODE == 1) {
        const int qh = unit & 1, hp = (unit >> 1) & 1; hkv = (unit >> 2) & 1; b = unit >> 3;
        head = hkv * 4 + hp * 2 + (wid >> 2); Rq0 = ML + b * 256 + 128 * qh + 32 * (wid & 3);
        Qp = (const bf16_t*)(ws + WS_QE) + (size_t)Rq0 * 512 + head * 64; qstride = 512; nt = 4;
    } else {
        const int qb = unit & 7; head = (unit >> 3) & 7; b = unit >> 6; Rq0 = b * 2048 + 256 * qb + 32 * wid;
        Qp = (const bf16_t*)(ws + WS_QO) + (size_t)Rq0 * 768 + head * 96; qstride = 768; nt = 36;
    }
    bf16x8 qf[KST];
#pragma unroll
    for (int s = 0; s < KST; ++s) qf[s] = *(const bf16x8*)(Qp + (size_t)r32 * qstride + 16 * s + 8 * hi);
    constexpr float THR = 6.0f;
    float mref, l_run;
    if (MODE == 2) { mref = 0.f; l_run = 0.f; } else { mref = sink[head] * LOG2E; l_run = (hi == 0) ? 1.f : 0.f; }
    f32x16 negm;
#pragma unroll
    for (int r = 0; r < 16; ++r) negm[r] = -mref;
    f32x16 o0, o1;
#pragma unroll
    for (int r = 0; r < 16; ++r) { o0[r] = 0.f; o1[r] = 0.f; }

    const int srow = tid >> 3, sch = tid & 7;
    const int voff = (4 * hi + ((lane & 15) >> 2)) * VS + (((lane >> 4) & 1) * 16 + 4 * (lane & 3)) * 2;
    u32x4 kreg, vreg, kreg2;
    kreg2 = (u32x4){0u, 0u, 0u, 0u};
#define ATT_SRC(t, kp, vp, k2p, kpos0v) do { \
        if (MODE == 0 || MODE == 1) { \
            if ((t) < 4) { kp = (const bf16_t*)(ws + WS_KVE) + (size_t)(ML + b * 256 + 64 * (t) + srow) * 256 + hkv * 64 + sch * 8; kpos0v = -100000; } \
            else { const int kp0_ = 128 * n - 128 + 64 * (jlo + (t) - 4); kpos0v = kp0_; \
                   kp = (const bf16_t*)(ws + WS_KVE) + (size_t)(b * 2048 + kp0_ + srow) * 256 + hkv * 64 + sch * 8; } \
            vp = kp + 128; k2p = kp; \
        } else { \
            const int pos0_ = 64 * (t); kpos0v = -100000; \
            kp = (const bf16_t*)(ws + WS_KNV) + ((size_t)(b * 8 + head) * 2304 + pos0_ + srow) * 128 + sch * 8; \
            vp = kp + 64; \
            const int krow_ = ((t) < 4) ? (ML + b * 256 + pos0_) : (b * 2048 + pos0_ - 256); \
            k2p = (const bf16_t*)(ws + WS_KR) + (size_t)(krow_ + (tid >> 2)) * 32 + (tid & 3) * 8; \
        } } while (0)
#define ATT_LOAD(t) do { const bf16_t *kp_, *vp_, *k2p_; int kq_; ATT_SRC(t, kp_, vp_, k2p_, kq_); (void)kq_; \
        kreg = *(const u32x4*)kp_; vreg = *(const u32x4*)vp_; if (MODE == 2 && tid < 256) kreg2 = *(const u32x4*)k2p_; } while (0)
#define ATT_STORE(buf) do { LAS unsigned char* kb_ = lds + (buf) * KBUF; LAS unsigned char* vb_ = lds + 2 * KBUF + (buf) * VBUF; \
        *(LAS u32x4*)(kb_ + srow * KS + sch * 16) = kreg; \
        if (MODE == 2 && tid < 256) *(LAS u32x4*)(kb_ + (tid >> 2) * KS + 128 + (tid & 3) * 16) = kreg2; \
        *(LAS u32x4*)(vb_ + srow * VS + sch * 16) = vreg; } while (0)

    ATT_LOAD(0); ATT_STORE(0);
    __syncthreads();
    for (int t = 0; t < nt; ++t) {
        const int buf = t & 1;
        if (t + 1 < nt) ATT_LOAD(t + 1);
        int kpos0 = -100000;
        if (MODE == 0 && t >= 4) kpos0 = 128 * n - 128 + 64 * (jlo + t - 4);
        bool active = true;
        if (MODE == 0 && t >= 4) active = (kpos0 + 63 >= qpos0 - 128) && (kpos0 <= qpos0 + 31 + 128);
        if (active) {
            const LAS unsigned char* kb = lds + buf * KBUF; const LAS unsigned char* vb = lds + 2 * KBUF + buf * VBUF;
            f32x16 p0 = negm, p1 = negm;
#pragma unroll
            for (int s = 0; s < KST; ++s) {
                const bf16x8 a0 = *(const LAS bf16x8*)(kb + r32 * KS + (16 * s + 8 * hi) * 2);
                const bf16x8 a1 = *(const LAS bf16x8*)(kb + (32 + r32) * KS + (16 * s + 8 * hi) * 2);
                p0 = __builtin_amdgcn_mfma_f32_32x32x16_bf16(a0, qf[s], p0, 0, 0, 0);
                p1 = __builtin_amdgcn_mfma_f32_32x32x16_bf16(a1, qf[s], p1, 0, 0, 0);
            }
            if (MODE == 0 && t >= 4) {
                const int qpos = qpos0 + r32;
#pragma unroll
                for (int r = 0; r < 16; ++r) { const int d0 = kpos0 + crow(r, hi) - qpos, d1 = d0 + 32;
                    if (d0 > 128 || d0 < -128) p0[r] = -INFINITY; if (d1 > 128 || d1 < -128) p1[r] = -INFINITY; }
            }
            float mxa = __builtin_fmaxf(__builtin_fmaxf(p0[0], p0[1]), p1[0]), mxb = __builtin_fmaxf(__builtin_fmaxf(p0[2], p0[3]), p1[1]);
            mxa = __builtin_fmaxf(__builtin_fmaxf(mxa, p1[2]), p1[3]);
#pragma unroll
            for (int r = 4; r < 16; r += 4) { mxa = __builtin_fmaxf(__builtin_fmaxf(mxa, p0[r]), p0[r + 1]); mxb = __builtin_fmaxf(__builtin_fmaxf(mxb, p0[r + 2]), p0[r + 3]);
                mxa = __builtin_fmaxf(__builtin_fmaxf(mxa, p1[r]), p1[r + 1]); mxb = __builtin_fmaxf(__builtin_fmaxf(mxb, p1[r + 2]), p1[r + 3]); }
            float mx = __builtin_fmaxf(mxa, mxb);
            mx = __builtin_fmaxf(mx, __shfl_xor(mx, 32));
            const bool first = (MODE == 2) && (t == 0);
            if (first || __any(mx > THR)) {
                const float delta = first ? mx : __builtin_fmaxf(mx, 0.f), alpha = first ? 1.f : __builtin_amdgcn_exp2f(-delta);
                mref += delta; l_run *= alpha;
#pragma unroll
                for (int r = 0; r < 16; ++r) { o0[r] *= alpha; o1[r] *= alpha; p0[r] -= delta; p1[r] -= delta; negm[r] = -mref; }
            }
            float rs0 = 0.f, rs1 = 0.f;
#pragma unroll
            for (int r = 0; r < 16; ++r) { p0[r] = __builtin_amdgcn_exp2f(p0[r]); p1[r] = __builtin_amdgcn_exp2f(p1[r]); rs0 += p0[r]; rs1 += p1[r]; }
            l_run += rs0 + rs1;
            u32x4 pw[4];
            pw[0] = (u32x4){pk2(p0[0], p0[1]), pk2(p0[2], p0[3]), pk2(p0[4], p0[5]), pk2(p0[6], p0[7])};
            pw[1] = (u32x4){pk2(p0[8], p0[9]), pk2(p0[10], p0[11]), pk2(p0[12], p0[13]), pk2(p0[14], p0[15])};
            pw[2] = (u32x4){pk2(p1[0], p1[1]), pk2(p1[2], p1[3]), pk2(p1[4], p1[5]), pk2(p1[6], p1[7])};
            pw[3] = (u32x4){pk2(p1[8], p1[9]), pk2(p1[10], p1[11]), pk2(p1[12], p1[13]), pk2(p1[14], p1[15])};
#pragma unroll
            for (int s2 = 0; s2 < 4; ++s2) {
                const bf16x8 pb = __builtin_bit_cast(bf16x8, pw[s2]);
                const LAS unsigned char* va0 = vb + (16 * s2) * VS + voff;
                const s16x4 l0 = vtr(va0), h0 = vtr(va0 + 8 * VS), l1 = vtr(va0 + 64), h1 = vtr(va0 + 8 * VS + 64);
                const bf16x8 v0 = (bf16x8){l0[0], l0[1], l0[2], l0[3], h0[0], h0[1], h0[2], h0[3]};
                const bf16x8 v1 = (bf16x8){l1[0], l1[1], l1[2], l1[3], h1[0], h1[1], h1[2], h1[3]};
                o0 = __builtin_amdgcn_mfma_f32_32x32x16_bf16(v0, pb, o0, 0, 0, 0);
                o1 = __builtin_amdgcn_mfma_f32_32x32x16_bf16(v1, pb, o1, 0, 0, 0);
            }
        }
        if (t + 1 < nt) ATT_STORE(buf ^ 1);
        __syncthreads();
    }
#undef ATT_SRC
#undef ATT_LOAD
#undef ATT_STORE
    const float l_tot = l_run + __shfl_xor(l_run, 32), inv = __builtin_amdgcn_rcpf(l_tot);
    const int Rq = Rq0 + r32;
    const bf16_t* zrow = (MODE == 2) ? (const bf16_t*)(ws + WS_ZO) + (size_t)Rq * 1024 + head * 64 : (const bf16_t*)(ws + WS_ZA) + (size_t)Rq * 512 + head * 64;
    bf16_t* urow = (bf16_t*)(ws + WS_U) + (size_t)Rq * 1024 + head * 64;
#pragma unroll
    for (int g = 0; g < 4; ++g) {
        const int dv = 8 * g + 4 * hi;
        { const u32x2 z = *(const u32x2*)(zrow + dv);
          u32x2 w; w.x = pk2(o0[4 * g] * inv * bf_lo(z.x), o0[4 * g + 1] * inv * bf_hi(z.x)); w.y = pk2(o0[4 * g + 2] * inv * bf_lo(z.y), o0[4 * g + 3] * inv * bf_hi(z.y));
          *(u32x2*)(urow + dv) = w; }
        { const u32x2 z = *(const u32x2*)(zrow + 32 + dv);
          u32x2 w; w.x = pk2(o1[4 * g] * inv * bf_lo(z.x), o1[4 * g + 1] * inv * bf_hi(z.x)); w.y = pk2(o1[4 * g + 2] * inv * bf_lo(z.y), o1[4 * g + 3] * inv * bf_hi(z.y));
          *(u32x2*)(urow + 32 + dv) = w; }
    }
}


__device__ __forceinline__ int srcmap(int mat, int dn) {
    if (mat == 0) {
        if (dn < 128) { const int d = dn & 63; return (dn & 64) + (d >> 1) + 32 * (d & 1); }
        if (dn < 256) return dn;
        if (dn < 768) { const int j = dn - 256, d = j & 63; return 256 + (j & ~63) + (d >> 1) + 32 * (d & 1); }
        if (dn < 1792) { const int j = dn - 768, blk = j >> 8, w = j & 255; return (w < 128) ? 1280 + blk * 128 + w : 1792 + blk * 128 + (w - 128); }
        if (dn < 2816) { const int j = dn - 1792, blk = j >> 8, w = j & 255; return (w < 128) ? 768 + blk * 128 + w : 2816 + blk * 128 + (w - 128); }
        return 2304 + (dn - 2816);
    }
    if (mat == 2) {
        if (dn < 256) return dn;
        if (dn < 512) return 288 + (dn - 256);
        if (dn < 1024) return 544 + (dn - 512);
        if (dn < 1280) { const int w = dn - 1024; if (w < 32) return 256 + (w >> 1) + 16 * (w & 1); if (w < 48) return 1056 + (w - 32); return -1; }
        if (dn < 2048) return 1072 + (dn - 1280);
        if (dn < 2304) return 1840 + (dn - 2048);
        if (dn < 2816) return 2096 + (dn - 2304);
        return 2608 + (dn - 2816);
    }
    if (mat == 3) {
        const int head = dn / 96, d = dn - head * 96; if (d < 64) return dn; const int w = d - 64; return head * 96 + 64 + (w >> 1) + 16 * (w & 1);
    }
    return dn;
}
__device__ __forceinline__ void p0_transpose_item(const float* W, int K, int Nsrc, bf16_t* WT, int mat, const float* kscale, LAS float* scr, int item, int nblk, int lane) {
    const int kb = item / nblk, nb = item % nblk, k0 = 64 * kb, n0 = 32 * nb;
    const int sc = srcmap(mat, n0 + (lane & 31));
#pragma unroll 8
    for (int i = 0; i < 32; ++i) { const int kk = 2 * i + (lane >> 5); float v = 0.f; if (sc >= 0) v = W[(size_t)(k0 + kk) * Nsrc + sc]; if (kscale) v *= kscale[k0 + kk]; scr[kk * 33 + (lane & 31)] = v; }
    LDS_WAIT(); asm volatile("" ::: "memory");
    const int c = lane & 7;
#pragma unroll
    for (int j = 0; j < 4; ++j) { const int n = (lane >> 3) + 8 * j; const LAS float* s = scr + (8 * c) * 33 + n;
        u32x4 o; o.x = pk2(s[0 * 33], s[1 * 33]); o.y = pk2(s[2 * 33], s[3 * 33]); o.z = pk2(s[4 * 33], s[5 * 33]); o.w = pk2(s[6 * 33], s[7 * 33]);
        *(u32x4*)(WT + (size_t)(n0 + n) * K + k0 + 8 * c) = o; }
    LDS_WAIT(); asm volatile("" ::: "memory");
}

__device__ __forceinline__ void p0_mod(LAS unsigned char* lds, const float* c, const float* c_ctx, const float* mod_w, const float* mod_b, float* MOD, int G) {
    const int tid = my_tid();
    if ((int)blockIdx.x >= 96) return;
    LAS float* scs = (LAS float*)lds;
    LAS float* red = (LAS float*)(lds + 1024 * 20 * 4);
    for (int idx = tid; idx < 17 * 1024; idx += NTHREADS) { const int r = idx >> 10, k = idx & 1023; const float v = (r < 16) ? c[r * 1024 + k] : c_ctx[k]; scs[k * 20 + r] = silu_f(v); }
    __syncthreads();
    for (int item = blockIdx.x; item < 96; item += G) {
        const int l = item / 48, n0 = (item % 48) * 64, col = tid & 63, kg = tid >> 6;
        float acc[20];
#pragma unroll
        for (int r = 0; r < 20; ++r) acc[r] = 0.f;
        const float* wp = mod_w + ((size_t)l * 1024 + kg * 128) * 3072 + n0 + col;
#pragma unroll 4
        for (int kk = 0; kk < 128; ++kk) {
            const float w = wp[(size_t)kk * 3072]; const LAS f32x4* sp = (const LAS f32x4*)(scs + (kg * 128 + kk) * 20);
#pragma unroll
            for (int q = 0; q < 5; ++q) { const f32x4 s = sp[q]; acc[4 * q] += s[0] * w; acc[4 * q + 1] += s[1] * w; acc[4 * q + 2] += s[2] * w; acc[4 * q + 3] += s[3] * w; }
        }
#pragma unroll
        for (int r = 0; r < 17; ++r) red[(kg * 17 + r) * 64 + col] = acc[r];
        __syncthreads();
        for (int o = tid; o < 17 * 64; o += NTHREADS) { const int r = o >> 6, cc = o & 63; float s = mod_b[l * 3072 + n0 + cc];
#pragma unroll
            for (int g = 0; g < 8; ++g) s += red[(g * 17 + r) * 64 + cc];
            MOD[((size_t)l * 17 + r) * 3072 + n0 + cc] = s; }
        __syncthreads();
    }
}

__device__ __forceinline__ void norm_mod_store(const f32x4 (&v)[4], const float* pre_w, const float* modrow, bf16_t* hrow, int lane) {
    float ss = 0.f;
#pragma unroll
    for (int j = 0; j < 4; ++j) ss += sq4(v[j]);
    const float rstd = rsqrtf(wave_sum(ss) * (1.f / 1024.f) + EPS);
#pragma unroll
    for (int j = 0; j < 4; ++j) { const int k = 4 * (lane + 64 * j);
        const f32x4 w = *(const f32x4*)(pre_w + k), sh = *(const f32x4*)(modrow + k), sc = *(const f32x4*)(modrow + 1024 + k);
        const f32x4 h = v[j] * rstd * w * (sc + 1.0f) + sh;
        u32x2 o; o.x = pk2(h[0], h[1]); o.y = pk2(h[2], h[3]); *(u32x2*)(hrow + k) = o; }
}
__device__ __forceinline__ void p1_prenorm(const float* x, const float* ctx, const float* pre_w, const float* MOD, bf16_t* H, int gw, int ngw, int lane) {
    for (int R = gw; R < MT; R += ngw) {
        const float* src = (R < ML) ? x + (size_t)R * 1024 : ctx + (size_t)(R - ML) * 1024; const int bi = (R < ML) ? (R >> 11) : 16;
        f32x4 v[4];
#pragma unroll
        for (int j = 0; j < 4; ++j) v[j] = *(const f32x4*)(src + 4 * (lane + 64 * j));
        norm_mod_store(v, pre_w, MOD + (size_t)bi * 3072, H + (size_t)R * 1024, lane);
    }
}
__device__ __forceinline__ float ssq16(const float* p) {
    const f32x4 a = *(const f32x4*)p, b = *(const f32x4*)(p + 4), c = *(const f32x4*)(p + 8), d = *(const f32x4*)(p + 12);
    return (((a[0] + a[1]) + (a[2] + a[3])) + ((b[0] + b[1]) + (b[2] + b[3]))) + (((c[0] + c[1]) + (c[2] + c[3])) + ((d[0] + d[1]) + (d[2] + d[3])));
}
__device__ __forceinline__ void p5_post_pre(const float* x, const float* ctx, const float* post_w0, const float* pre_w1, const float* MOD, const bf16_t* Y, const float* SSQ, float* X1, bf16_t* H, int gw, int ngw, int lane) {
    for (int R = gw; R < MT; R += ngw) {
        const float* src = (R < ML) ? x + (size_t)R * 1024 : ctx + (size_t)(R - ML) * 1024; const int bi = (R < ML) ? (R >> 11) : 16;
        const float rstd_y = rsqrtf(ssq16(SSQ + (size_t)R * 16) * (1.f / 1024.f) + EPS);
        const float* m0 = MOD + (size_t)bi * 3072;
        f32x4 v[4];
#pragma unroll
        for (int j = 0; j < 4; ++j) { const int k = 4 * (lane + 64 * j);
            const u32x2 yy = *(const u32x2*)(Y + (size_t)R * 1024 + k); const f32x4 y = (f32x4){bf_lo(yy.x), bf_hi(yy.x), bf_lo(yy.y), bf_hi(yy.y)};
            const f32x4 g = *(const f32x4*)(m0 + 2048 + k), pw = *(const f32x4*)(post_w0 + k), xv = *(const f32x4*)(src + k);
            v[j] = xv + g * (y * rstd_y * pw);
            if (R < ML) *(f32x4*)(X1 + (size_t)R * 1024 + k) = v[j]; }
        norm_mod_store(v, pre_w1, MOD + (size_t)(17 + bi) * 3072, H + (size_t)R * 1024, lane);
    }
}
__device__ __forceinline__ void p11_final(const float* post_w1, const float* MOD, const bf16_t* Y, const float* SSQ, float* out, int gw, int ngw, int lane) {
    for (int R = gw; R < ML; R += ngw) {
        const float rstd_y = rsqrtf(ssq16(SSQ + (size_t)R * 16) * (1.f / 1024.f) + EPS);
        const float* m1 = MOD + (size_t)(17 + (R >> 11)) * 3072;
#pragma unroll
        for (int j = 0; j < 4; ++j) { const int k = 4 * (lane + 64 * j);
            const u32x2 yy = *(const u32x2*)(Y + (size_t)R * 1024 + k); const f32x4 y = (f32x4){bf_lo(yy.x), bf_hi(yy.x), bf_lo(yy.y), bf_hi(yy.y)};
            const f32x4 g = *(const f32x4*)(m1 + 2048 + k), pw = *(const f32x4*)(post_w1 + k), xv = *(const f32x4*)(out + (size_t)R * 1024 + k);
            *(f32x4*)(out + (size_t)R * 1024 + k) = xv + g * (y * rstd_y * pw); }
    }
}
__device__ __forceinline__ void p3_conv(unsigned char* ws, const float* conv_w, int gtid, int ngt) {
    const bf16_t* PE = (const bf16_t*)(ws + WS_PE); const bf16_t* GE = (const bf16_t*)(ws + WS_GE); bf16_t* U = (bf16_t*)(ws + WS_U);
    for (int it = gtid; it < MT * 64; it += ngt) {
        const int R = it >> 6, ch = (it & 63) * 8;
        int t, T; if (R < ML) { t = R & 2047; T = 2048; } else { t = (R - ML) & 255; T = 256; }
        const u32x4 z4 = (u32x4){0u, 0u, 0u, 0u};
        const u32x4 pc = *(const u32x4*)(PE + (size_t)R * 512 + ch);
        const u32x4 pm = (t > 0) ? *(const u32x4*)(PE + (size_t)(R - 1) * 512 + ch) : z4;
        const u32x4 pp = (t < T - 1) ? *(const u32x4*)(PE + (size_t)(R + 1) * 512 + ch) : z4;
        const u32x4 g = *(const u32x4*)(GE + (size_t)R * 512 + ch);
        const f32x4 w0a = *(const f32x4*)(conv_w + ch), w0b = *(const f32x4*)(conv_w + ch + 4), w1a = *(const f32x4*)(conv_w + 512 + ch), w1b = *(const f32x4*)(conv_w + 512 + ch + 4),
                    w2a = *(const f32x4*)(conv_w + 1024 + ch), w2b = *(const f32x4*)(conv_w + 1024 + ch + 4);
        u32x4 o;
#define CV(pmw, pcw, ppw, gw_, wa, wb, wc_, e0, e1) pk2(bf_lo(gw_) * (wa[e0] * bf_lo(pmw) + wb[e0] * bf_lo(pcw) + wc_[e0] * bf_lo(ppw)), bf_hi(gw_) * (wa[e1] * bf_hi(pmw) + wb[e1] * bf_hi(pcw) + wc_[e1] * bf_hi(ppw)))
        o.x = CV(pm.x, pc.x, pp.x, g.x, w0a, w1a, w2a, 0, 1); o.y = CV(pm.y, pc.y, pp.y, g.y, w0a, w1a, w2a, 2, 3);
        o.z = CV(pm.z, pc.z, pp.z, g.z, w0b, w1b, w2b, 0, 1); o.w = CV(pm.w, pc.w, pp.w, g.w, w0b, w1b, w2b, 2, 3);
#undef CV
        *(u32x4*)(U + (size_t)R * 1024 + 512 + ch) = o;
    }
}
__device__ __forceinline__ void p9_readout(unsigned char* ws, const float* hn_w, int gw, int ngw, int lane) {
    const bf16_t* HM = (const bf16_t*)(ws + WS_HM); const bf16_t* MO = (const bf16_t*)(ws + WS_MO); const bf16_t* ZO = (const bf16_t*)(ws + WS_ZO); bf16_t* U = (bf16_t*)(ws + WS_U);
    for (int R = gw; R < ML; R += ngw) {
        const int ch = 8 * lane;
        const u32x4 h0 = *(const u32x4*)(HM + (size_t)R * 512 + ch), h1 = *(const u32x4*)(HM + ((size_t)ML + R) * 512 + ch);
        float hs[8] = {bf_lo(h0.x) + bf_lo(h1.x), bf_hi(h0.x) + bf_hi(h1.x), bf_lo(h0.y) + bf_lo(h1.y), bf_hi(h0.y) + bf_hi(h1.y),
                       bf_lo(h0.z) + bf_lo(h1.z), bf_hi(h0.z) + bf_hi(h1.z), bf_lo(h0.w) + bf_lo(h1.w), bf_hi(h0.w) + bf_hi(h1.w)};
        float ss = 0.f;
#pragma unroll
        for (int e = 0; e < 8; ++e) ss += hs[e] * hs[e];
        ss += __shfl_xor(ss, 1); ss += __shfl_xor(ss, 2); ss += __shfl_xor(ss, 4); ss += __shfl_xor(ss, 8);
        const float rstd = rsqrtf(ss * (1.f / 128.f) + EPS);
        const u32x4 mo = *(const u32x4*)(MO + (size_t)R * 512 + ch), zz = *(const u32x4*)(ZO + (size_t)R * 1024 + 512 + ch);
        const f32x4 wa = *(const f32x4*)(hn_w + ch), wb = *(const f32x4*)(hn_w + ch + 4);
        u32x4 o;
        o.x = pk2(hs[0] * rstd * wa[0] * bf_lo(mo.x) * bf_lo(zz.x), hs[1] * rstd * wa[1] * bf_hi(mo.x) * bf_hi(zz.x));
        o.y = pk2(hs[2] * rstd * wa[2] * bf_lo(mo.y) * bf_lo(zz.y), hs[3] * rstd * wa[3] * bf_hi(mo.y) * bf_hi(zz.y));
        o.z = pk2(hs[4] * rstd * wb[0] * bf_lo(mo.z) * bf_lo(zz.z), hs[5] * rstd * wb[1] * bf_hi(mo.z) * bf_hi(zz.z));
        o.w = pk2(hs[6] * rstd * wb[2] * bf_lo(mo.w) * bf_lo(zz.w), hs[7] * rstd * wb[3] * bf_hi(mo.w) * bf_hi(zz.w));
        *(u32x4*)(U + (size_t)R * 1024 + 512 + ch) = o;
    }
}


__device__ __forceinline__ void mlstm_chain(LAS unsigned char* lds, unsigned char* ws, const float* i_bias, const float* f_bias, int chain) {
    const int tid = my_tid(), lane = tid & 63, wid = __builtin_amdgcn_readfirstlane(tid >> 6);
    const int vh = chain & 1, d = (chain >> 1) & 1, h = (chain >> 2) & 3, b = chain >> 4;
    LAS float* Kc = (LAS float*)lds;
    LAS float* Vc = Kc + 4096;
    LAS float* Ct = Vc + 4096;
    LAS float* Qc = Ct + 4096;
    LAS float* Sc = Qc + 64 * 65;
    LAS float* vb_ = Sc + 64 * 65;
    LAS float* vab = vb_ + 64;
    LAS float* vcm = vab + 64;
    LAS float* vw = vcm + 64;
    LAS float* vn = vw + 64;
    LAS float* vsc = vn + 64;
    const bf16_t* MK = (const bf16_t*)(ws + WS_MK); const bf16_t* MV = (const bf16_t*)(ws + WS_MV); const bf16_t* MQ = (const bf16_t*)(ws + WS_MQ);
    const float* GT = (const float*)(ws + WS_GATES); bf16_t* HM = (bf16_t*)(ws + WS_HM);
    const float ib = i_bias[d * 4 + h], fb = f_bias[d * 4 + h];
    float ct[8];
#pragma unroll
    for (int e = 0; e < 8; ++e) ct[e] = 0.f;
    float nreg = 0.f, mst = 0.f;
    for (int idx = tid; idx < 4096; idx += NTHREADS) Ct[idx] = 0.f;
    if (tid < 64) vn[tid] = 0.f;
    const int srow = tid >> 3, sch = tid & 7;
    for (int step = 0; step < 36; ++step) {
        const bool lat = step >= 4; const int c = lat ? step - 4 : step, T = lat ? 2048 : 256, rowb = lat ? b * 2048 : ML + b * 256;
        { const int tok = (d == 0) ? 64 * c + srow : T - 1 - (64 * c + srow); const size_t R = (size_t)(rowb + tok);
          const u32x4 kk = *(const u32x4*)(MK + R * 256 + h * 64 + sch * 8), vv = *(const u32x4*)(MV + R * 512 + h * 128 + vh * 64 + sch * 8);
          *(LAS f32x4*)(Kc + srow * 64 + sch * 8) = (f32x4){bf_lo(kk.x), bf_hi(kk.x), bf_lo(kk.y), bf_hi(kk.y)}; *(LAS f32x4*)(Kc + srow * 64 + sch * 8 + 4) = (f32x4){bf_lo(kk.z), bf_hi(kk.z), bf_lo(kk.w), bf_hi(kk.w)};
          *(LAS f32x4*)(Vc + srow * 64 + sch * 8) = (f32x4){bf_lo(vv.x), bf_hi(vv.x), bf_lo(vv.y), bf_hi(vv.y)}; *(LAS f32x4*)(Vc + srow * 64 + sch * 8 + 4) = (f32x4){bf_lo(vv.z), bf_hi(vv.z), bf_lo(vv.w), bf_hi(vv.w)};
          if (lat) { const u32x4 qq = *(const u32x4*)(MQ + R * 256 + h * 64 + sch * 8); LAS float* qd = Qc + srow * 65 + sch * 8;
              qd[0] = bf_lo(qq.x); qd[1] = bf_hi(qq.x); qd[2] = bf_lo(qq.y); qd[3] = bf_hi(qq.y); qd[4] = bf_lo(qq.z); qd[5] = bf_hi(qq.z); qd[6] = bf_lo(qq.w); qd[7] = bf_hi(qq.w); }
          if (wid == 0) {
              const int tk = (d == 0) ? 64 * c + lane : T - 1 - (64 * c + lane); const float* gp = GT + (size_t)(rowb + tk) * 16 + d * 8 + h;
              const float li = gp[0] + ib, fp = gp[4] + fb;
              const float lf = fminf(fp, 0.f) - __logf(1.f + __expf(-fabsf(fp)));
              float bc = lf;
#pragma unroll
              for (int o = 1; o < 64; o <<= 1) { const float t_ = __shfl_up(bc, o); if (lane >= o) bc += t_; }
              const float ab = li - bc; float cm = ab;
#pragma unroll
              for (int o = 1; o < 64; o <<= 1) { const float t_ = __shfl_up(cm, o); if (lane >= o) cm = fmaxf(cm, t_); }
              const float g = __shfl(bc, 63), cmx = __shfl(cm, 63), mloc = g + cmx;
              vb_[lane] = bc; vab[lane] = ab; vcm[lane] = cm; vw[lane] = __expf(g + ab - mloc);
              if (lane == 0) { vsc[0] = g; vsc[1] = mloc; }
          } }
        __syncthreads();
        const float g = vsc[0], mloc = vsc[1], m_in = mst;
        if (lat) {
            float q[64];
#pragma unroll
            for (int k = 0; k < 64; ++k) q[k] = Qc[lane * 65 + k];
            const float mi = fmaxf(m_in, vcm[lane]);
#pragma unroll
            for (int jj = 0; jj < 8; ++jj) { const int j = 8 * wid + jj; float s = 0.f;
#pragma unroll
                for (int k4 = 0; k4 < 16; ++k4) { const f32x4 kv = *(const LAS f32x4*)(Kc + j * 64 + 4 * k4); s += q[4 * k4] * kv[0] + q[4 * k4 + 1] * kv[1] + q[4 * k4 + 2] * kv[2] + q[4 * k4 + 3] * kv[3]; }
                Sc[lane * 65 + j] = (j <= lane) ? s * __expf(vab[j] - mi) : 0.f; }
            float nq = 0.f;
#pragma unroll
            for (int k4 = 0; k4 < 16; ++k4) { const f32x4 nv = *(const LAS f32x4*)(vn + 4 * k4); nq += q[4 * k4] * nv[0] + q[4 * k4 + 1] * nv[1] + q[4 * k4 + 2] * nv[2] + q[4 * k4 + 3] * nv[3]; }
            __syncthreads();
            const float wi = __expf(m_in - mi);
            float acc[8];
#pragma unroll
            for (int e = 0; e < 8; ++e) acc[e] = 0.f;
#pragma unroll
            for (int k = 0; k < 64; ++k) { const float qk = q[k] * wi; const f32x4 c0 = *(const LAS f32x4*)(Ct + k * 64 + 8 * wid), c1 = *(const LAS f32x4*)(Ct + k * 64 + 8 * wid + 4);
                acc[0] += qk * c0[0]; acc[1] += qk * c0[1]; acc[2] += qk * c0[2]; acc[3] += qk * c0[3]; acc[4] += qk * c1[0]; acc[5] += qk * c1[1]; acc[6] += qk * c1[2]; acc[7] += qk * c1[3]; }
            float den = wi * nq;
#pragma unroll 8
            for (int j = 0; j < 64; ++j) { const float sj = Sc[lane * 65 + j]; den += sj; const f32x4 v0 = *(const LAS f32x4*)(Vc + j * 64 + 8 * wid), v1 = *(const LAS f32x4*)(Vc + j * 64 + 8 * wid + 4);
                acc[0] += sj * v0[0]; acc[1] += sj * v0[1]; acc[2] += sj * v0[2]; acc[3] += sj * v0[3]; acc[4] += sj * v1[0]; acc[5] += sj * v1[1]; acc[6] += sj * v1[2]; acc[7] += sj * v1[3]; }
            const float mt = vb_[lane] + mi, inv = 1.f / fmaxf(fabsf(den), __expf(-mt));
            const int tok = (d == 0) ? 64 * c + lane : T - 1 - (64 * c + lane);
            u32x4 o; o.x = pk2(acc[0] * inv, acc[1] * inv); o.y = pk2(acc[2] * inv, acc[3] * inv); o.z = pk2(acc[4] * inv, acc[5] * inv); o.w = pk2(acc[6] * inv, acc[7] * inv);
            *(u32x4*)(HM + ((size_t)d * ML + rowb + tok) * 512 + h * 128 + vh * 64 + 8 * wid) = o;
        }
        const float m_new = fmaxf(g + m_in, mloc), a_prev = __expf(g + m_in - m_new), a_loc = __expf(mloc - m_new);
        float upd[8];
#pragma unroll
        for (int e = 0; e < 8; ++e) upd[e] = 0.f;
        float nsum = 0.f;
#pragma unroll 8
        for (int j = 0; j < 64; ++j) { const float kw = Kc[j * 64 + lane] * vw[j]; nsum += kw; const f32x4 v0 = *(const LAS f32x4*)(Vc + j * 64 + 8 * wid), v1 = *(const LAS f32x4*)(Vc + j * 64 + 8 * wid + 4);
            upd[0] += kw * v0[0]; upd[1] += kw * v0[1]; upd[2] += kw * v0[2]; upd[3] += kw * v0[3]; upd[4] += kw * v1[0]; upd[5] += kw * v1[1]; upd[6] += kw * v1[2]; upd[7] += kw * v1[3]; }
#pragma unroll
        for (int e = 0; e < 8; ++e) ct[e] = a_prev * ct[e] + a_loc * upd[e];
        nreg = a_prev * nreg + a_loc * nsum; mst = m_new;
        __syncthreads();
        *(LAS f32x4*)(Ct + lane * 64 + 8 * wid) = (f32x4){ct[0], ct[1], ct[2], ct[3]}; *(LAS f32x4*)(Ct + lane * 64 + 8 * wid + 4) = (f32x4){ct[4], ct[5], ct[6], ct[7]};
        if (wid == 0) vn[lane] = nreg;
    }
    __syncthreads();
}


typedef float f32x4v __attribute__((ext_vector_type(4)));
#define LDS_BARRIER() do { asm volatile("s_waitcnt lgkmcnt(0)" ::: "memory"); __builtin_amdgcn_s_barrier(); asm volatile("" ::: "memory"); } while (0)
#define MFMA_FENCE(x) do { __builtin_amdgcn_sched_barrier(0); asm volatile("s_nop 15\n\ts_nop 15" : "+v"(x)); __builtin_amdgcn_sched_barrier(0); } while (0)
__device__ __forceinline__ bf16x8 tr8(const LAS unsigned char* p, int halfstride) {
    const s16x4 lo = vtr(p), hi = vtr(p + halfstride);
    return (bf16x8){lo[0], lo[1], lo[2], lo[3], hi[0], hi[1], hi[2], hi[3]};
}
__device__ __forceinline__ bf16x8 gather8(const LAS unsigned char* img, int stride, int row0, int col) {
    bf16x8 r;
#pragma unroll
    for (int e = 0; e < 8; ++e) r[e] = *(const LAS short*)(img + (row0 + e) * stride + col * 2);
    return r;
}
template <int CTRL, int RM> __device__ __forceinline__ float dppf(float oldv, float v) {
    return __int_as_float(__builtin_amdgcn_update_dpp(__float_as_int(oldv), __float_as_int(v), CTRL, RM, 0xf, false));
}
__device__ __forceinline__ float wave_scan_add(float v) {
    v += dppf<0x111, 0xf>(0.f, v); v += dppf<0x112, 0xf>(0.f, v); v += dppf<0x114, 0xf>(0.f, v); v += dppf<0x118, 0xf>(0.f, v);
    v += dppf<0x142, 0xa>(0.f, v); v += dppf<0x143, 0xc>(0.f, v);
    return v;
}
__device__ __forceinline__ float wave_scan_max(float v) {
    const float ninf = -INFINITY;
    v = fmaxf(v, dppf<0x111, 0xf>(ninf, v)); v = fmaxf(v, dppf<0x112, 0xf>(ninf, v)); v = fmaxf(v, dppf<0x114, 0xf>(ninf, v)); v = fmaxf(v, dppf<0x118, 0xf>(ninf, v));
    v = fmaxf(v, dppf<0x142, 0xa>(ninf, v)); v = fmaxf(v, dppf<0x143, 0xc>(ninf, v));
    return v;
}
template <bool DUMMY> __device__ __forceinline__ void mlstm_chain_mfma(LAS unsigned char* lds, unsigned char* ws, const float* i_bias, const float* f_bias, int chain) {
    constexpr int RS = 144, VS = 176;
    constexpr int QI = 0, KI = 9216, SC = 18432, CI = 27648, VI = 39168, VW = 50432, VEC = 61696;
    const int tid = my_tid(), lane = tid & 63, wid = __builtin_amdgcn_readfirstlane(tid >> 6), l15 = lane & 15, kg = lane >> 4;
    const int vh = chain & 1, d = (chain >> 1) & 1, h = (chain >> 2) & 3, b = chain >> 4;
    LAS float* vb_ = (LAS float*)(lds + VEC); LAS float* vab = vb_ + 64; LAS float* vcm = vab + 64; LAS float* vwp = vcm + 64; LAS float* vsc = vwp + 64;
    const bf16_t* MK = (const bf16_t*)(ws + WS_MK); const bf16_t* MV = (const bf16_t*)(ws + WS_MV); const bf16_t* MQ = (const bf16_t*)(ws + WS_MQ);
    const float* GT = (const float*)(ws + WS_GATES); bf16_t* HM = (bf16_t*)(ws + WS_HM);
    const float ib = i_bias[d * 4 + h], fb = f_bias[d * 4 + h];
    for (int idx = tid; idx < 80 * RS / 4; idx += NTHREADS) ((LAS unsigned*)(lds + CI))[idx] = 0u;
    if (tid < 64) { LAS unsigned* a = (LAS unsigned*)(lds + VI + tid * VS + 128); LAS unsigned* w = (LAS unsigned*)(lds + VW + tid * VS + 128);
#pragma unroll
        for (int e = 0; e < 8; ++e) { a[e] = (e == 0) ? 0x3F80u : 0u; w[e] = 0u; } }
    const int it = wid & 3, vg = wid >> 2;
    f32x4v cacc[3];
#pragma unroll
    for (int t = 0; t < 3; ++t) cacc[t] = (f32x4v){0.f, 0.f, 0.f, 0.f};
    float mst = 0.f;
    unsigned nbad = 0u;
    const int srow = tid >> 3, sch = tid & 7;
    const int q4 = l15 >> 2, p4 = l15 & 3;
    u32x4 kkN, vvN, qqN = (u32x4){0u, 0u, 0u, 0u}; float liN = 0.f, fpN = 0.f;
#define MLSTM_LOADS(S_) do { const bool lat_ = (S_) >= 4; const int c_ = lat_ ? (S_) - 4 : (S_), T_ = lat_ ? 2048 : 256, rowb_ = lat_ ? b * 2048 : ML + b * 256; \
        const int tok_ = (d == 0) ? 64 * c_ + srow : T_ - 1 - (64 * c_ + srow); const size_t R_ = (size_t)(rowb_ + tok_); \
        kkN = *(const u32x4*)(MK + R_ * 256 + h * 64 + sch * 8); vvN = *(const u32x4*)(MV + R_ * 512 + h * 128 + vh * 64 + sch * 8); \
        if (lat_) qqN = *(const u32x4*)(MQ + R_ * 256 + h * 64 + sch * 8); \
        if (wid == 0) { const int tk_ = (d == 0) ? 64 * c_ + lane : T_ - 1 - (64 * c_ + lane); const float* gp_ = GT + (size_t)(rowb_ + tk_) * 16 + d * 8 + h; liN = gp_[0]; fpN = gp_[4]; } } while (0)
    MLSTM_LOADS(0);
    for (int step = 0; step < 36; ++step) {
        const bool lat = step >= 4; const int c = lat ? step - 4 : step, T = lat ? 2048 : 256, rowb = lat ? b * 2048 : ML + b * 256;
        const int tok = (d == 0) ? 64 * c + srow : T - 1 - (64 * c + srow); const size_t R = (size_t)(rowb + tok);
        const u32x4 kk = kkN, vv = vvN, qq = qqN;
        if (wid == 0) {
            const float li = liN + ib, fp = fpN + fb;
            const float lf = fminf(fp, 0.f) - __logf(1.f + __expf(-fabsf(fp)));
            const float bc = wave_scan_add(lf);
            const float ab = li - bc; const float cm = wave_scan_max(ab);
            const float g = __int_as_float(__builtin_amdgcn_readlane(__float_as_int(bc), 63)), mloc = g + __int_as_float(__builtin_amdgcn_readlane(__float_as_int(cm), 63)), m_new = fmaxf(g + mst, mloc);
            vb_[lane] = bc; vab[lane] = ab; vcm[lane] = cm; vwp[lane] = __expf(g + ab - m_new);
            if (lane == 0) { vsc[0] = mst; vsc[1] = __expf(g + mst - m_new); }
            mst = m_new;
        }
        LDS_BARRIER();
        { const float wj = vwp[srow];
          *(LAS u32x4*)(lds + KI + srow * RS + sch * 16) = kk;
          *(LAS u32x4*)(lds + VI + srow * VS + sch * 16) = vv;
          u32x4 vw; vw.x = pk2(bf_lo(vv.x) * wj, bf_hi(vv.x) * wj); vw.y = pk2(bf_lo(vv.y) * wj, bf_hi(vv.y) * wj); vw.z = pk2(bf_lo(vv.z) * wj, bf_hi(vv.z) * wj); vw.w = pk2(bf_lo(vv.w) * wj, bf_hi(vv.w) * wj);
          *(LAS u32x4*)(lds + VW + srow * VS + sch * 16) = vw;
          if (sch == 0) *(LAS unsigned short*)(lds + VW + srow * VS + 128) = f2bf(wj);
          if (lat) *(LAS u32x4*)(lds + QI + srow * RS + sch * 16) = qq; }
        LDS_BARRIER();
        const float m_in = vsc[0], a_prev = vsc[1];
        if (step + 1 < 36) MLSTM_LOADS(step + 1);
        bf16x8 qf[2];
        if (lat) {
            qf[0] = *(const LAS bf16x8*)(lds + QI + (16 * it + l15) * RS + (8 * kg) * 2); qf[1] = *(const LAS bf16x8*)(lds + QI + (16 * it + l15) * RS + (8 * kg + 32) * 2);
            const int i = 16 * it + l15; const float mi = fmaxf(m_in, vcm[i]);
#pragma unroll
            for (int t = 0; t < 2; ++t) {
                const int jt = 2 * vg + t; u32x2 o = (u32x2){0u, 0u};
                if (jt <= it) {
                    const bf16x8 k0 = *(const LAS bf16x8*)(lds + KI + (16 * jt + l15) * RS + (8 * kg) * 2), k1 = *(const LAS bf16x8*)(lds + KI + (16 * jt + l15) * RS + (8 * kg + 32) * 2);
                    f32x4v s = (f32x4v){0.f, 0.f, 0.f, 0.f};
                    s = __builtin_amdgcn_mfma_f32_16x16x32_bf16(k0, qf[0], s, 0, 0, 0); s = __builtin_amdgcn_mfma_f32_16x16x32_bf16(k1, qf[1], s, 0, 0, 0); MFMA_FENCE(s);
                    const int j0 = 16 * jt + 4 * kg; const f32x4v abv = *(const LAS f32x4v*)(vab + j0);
                    float e[4];
#pragma unroll
                    for (int r = 0; r < 4; ++r) e[r] = (j0 + r <= i) ? s[r] * __expf(abv[r] - mi) : 0.f;
                    o.x = pk2(e[0], e[1]); o.y = pk2(e[2], e[3]);
                }
                *(LAS u32x2*)(lds + SC + i * RS + (16 * jt + 4 * kg) * 2) = o;
            }
        }
        LDS_BARRIER();
        f32x4v cnew[3];
        { bf16x8 aK[2];
#pragma unroll
          for (int s = 0; s < 2; ++s) aK[s] = tr8(lds + KI + (32 * s + 8 * kg + q4) * RS + (16 * it + 4 * p4) * 2, 4 * RS);
#pragma unroll
          for (int t = 0; t < 3; ++t) { const int vt = (t == 2) ? 4 : 2 * t + vg; f32x4v a = cacc[t] * a_prev;
#pragma unroll
              for (int s = 0; s < 2; ++s) { const bf16x8 bW = tr8(lds + VW + (32 * s + 8 * kg + q4) * VS + (16 * vt + 4 * p4) * 2, 4 * VS); a = __builtin_amdgcn_mfma_f32_16x16x32_bf16(aK[s], bW, a, 0, 0, 0); }
              MFMA_FENCE(a); cnew[t] = a; } }
        if (lat) {
            const int i0 = 16 * it + 4 * kg; const f32x4v cmv = *(const LAS f32x4v*)(vcm + i0), bv = *(const LAS f32x4v*)(vb_ + i0);
            float wi[4], mt[4];
#pragma unroll
            for (int r = 0; r < 4; ++r) { const float mi = fmaxf(m_in, cmv[r]); wi[r] = __expf(m_in - mi); mt[r] = bv[r] + mi; }
            bf16x8 aS[2];
            aS[0] = *(const LAS bf16x8*)(lds + SC + (16 * it + l15) * RS + (8 * kg) * 2); aS[1] = *(const LAS bf16x8*)(lds + SC + (16 * it + l15) * RS + (8 * kg + 32) * 2);
            f32x4v nacc[3];
#pragma unroll
            for (int t = 0; t < 3; ++t) { const int vt = (t == 2) ? 4 : 2 * t + vg; f32x4v a = (f32x4v){0.f, 0.f, 0.f, 0.f};
#pragma unroll
                for (int s = 0; s < 2; ++s) { const bf16x8 bC = *(const LAS bf16x8*)(lds + CI + (16 * vt + l15) * RS + (8 * kg + 32 * s) * 2); a = __builtin_amdgcn_mfma_f32_16x16x32_bf16(qf[s], bC, a, 0, 0, 0); }
                MFMA_FENCE(a);
#pragma unroll
                for (int r = 0; r < 4; ++r) a[r] *= wi[r];
#pragma unroll
                for (int s = 0; s < 2; ++s) { const bf16x8 bV = tr8(lds + VI + (32 * s + 8 * kg + q4) * VS + (16 * vt + 4 * p4) * 2, 4 * VS); a = __builtin_amdgcn_mfma_f32_16x16x32_bf16(aS[s], bV, a, 0, 0, 0); }
                MFMA_FENCE(a); nacc[t] = a; }
            float inv[4];
#pragma unroll
            for (int r = 0; r < 4; ++r) { const float den = __shfl(nacc[2][r], lane & 48); inv[r] = 1.f / fmaxf(fabsf(den), __expf(-mt[r])); }
#pragma unroll
            for (int t = 0; t < 2; ++t) { const int vt = 2 * t + vg;
#pragma unroll
                for (int r = 0; r < 4; ++r) *(LAS unsigned short*)(lds + QI + (i0 + r) * RS + (16 * vt + l15) * 2) = f2bf(nacc[t][r] * inv[r]); }
        }
        LDS_BARRIER();
        if (lat) { const u32x4 hv = *(const LAS u32x4*)(lds + QI + srow * RS + sch * 16);
            if (DUMMY) { const u32x4 rv = *(const u32x4*)(HM + ((size_t)d * ML + R) * 512 + h * 128 + vh * 64 + sch * 8);
#define CMPH(a_, b_) do { const float x_ = (a_), y_ = (b_); if (fabsf(x_ - y_) > 0.05f * fmaxf(fabsf(x_), fabsf(y_)) + 0.02f) ++nbad; } while (0)
                CMPH(bf_lo(hv.x), bf_lo(rv.x)); CMPH(bf_hi(hv.x), bf_hi(rv.x)); CMPH(bf_lo(hv.y), bf_lo(rv.y)); CMPH(bf_hi(hv.y), bf_hi(rv.y));
                CMPH(bf_lo(hv.z), bf_lo(rv.z)); CMPH(bf_hi(hv.z), bf_hi(rv.z)); CMPH(bf_lo(hv.w), bf_lo(rv.w)); CMPH(bf_hi(hv.w), bf_hi(rv.w));
#undef CMPH
            } else *(u32x4*)(HM + ((size_t)d * ML + R) * 512 + h * 128 + vh * 64 + sch * 8) = hv; }
#pragma unroll
        for (int t = 0; t < 3; ++t) { cacc[t] = cnew[t]; const int vt = (t == 2) ? 4 : 2 * t + vg;
            if (t < 2 || wid < 4) { u32x2 o; o.x = pk2(cnew[t][0], cnew[t][1]); o.y = pk2(cnew[t][2], cnew[t][3]); *(LAS u32x2*)(lds + CI + (16 * vt + l15) * RS + (16 * it + 4 * kg) * 2) = o; } }
    }
#undef MLSTM_LOADS
    if (DUMMY) atomicAdd((unsigned*)(ws + WS_CTL) + 64, nbad);
    __syncthreads();
}


#ifndef MK_N_LAUNCHES
#define MK_N_LAUNCHES 1
#endif
constexpr int N_PHASES = 12;
constexpr int LDS_BYTES = 147456;
constexpr int RING_BYTES = 131072, MISC_OFF = RING_BYTES + 320;
constexpr int CW_BAR = 4096;

struct Args { const float* in[21]; float* out; unsigned char* ws; int ph_lo, ph_hi; };

__global__ void __launch_bounds__(NTHREADS, 2) hybrid_fwd(Args args) {
    extern __shared__ __attribute__((aligned(16))) unsigned char lds_raw[];
    LAS unsigned char* lds = (LAS unsigned char*)lds_raw;
    const int G = gridDim.x, bx = blockIdx.x;
    const int vcu = (G % 8 == 0) ? (bx % 8) * (G / 8) + bx / 8 : bx;
    typedef const __attribute__((address_space(4))) Args* ArgsP;
    ArgsP AP = (ArgsP)__builtin_amdgcn_kernarg_segment_ptr();
    asm volatile("" : "+s"(AP));
    unsigned char* ws = AP->ws;
#define I_x AP->in[0]
#define I_cvec AP->in[1]
#define I_ctx AP->in[2]
#define I_c_ctx AP->in[3]
#define I_mod_w AP->in[4]
#define I_mod_b AP->in[5]
#define I_pre_w AP->in[6]
#define I_post_w AP->in[7]
#define I_e_w_in AP->in[8]
#define I_e_sink AP->in[9]
#define I_e_conv_w AP->in[10]
#define I_e_w_out AP->in[11]
#define I_o_w_in AP->in[12]
#define I_o_qn AP->in[13]
#define I_o_kvn AP->in[14]
#define I_o_w_uq AP->in[15]
#define I_o_w_ukv AP->in[16]
#define I_o_ib AP->in[17]
#define I_o_fb AP->in[18]
#define I_o_hn AP->in[19]
#define I_o_w_out AP->in[20]
#define I_out AP->out
    float* MOD = (float*)(ws + WS_MOD);

    for (int u = threadIdx.x; u < (LDS_BYTES - RING_BYTES) / 4; u += NTHREADS) ((LAS unsigned*)(lds + RING_BYTES))[u] = 0u;
    __syncthreads();
    XcdBarrier bar; bar.bar = (unsigned*)(ws + WS_CTL) + CW_BAR; bar.x = 0; bar.st = nullptr;
    if (MK_N_LAUNCHES == 1) bar = xcd_barrier_post((unsigned*)(ws + WS_CTL) + CW_BAR, (volatile LAS unsigned*)(lds + MISC_OFF) + 8);
    const int lo = AP->ph_lo, hi = AP->ph_hi;
#ifndef PROBE_REP
#define PROBE_REP 0
#endif
#define NREP(k) ((((PROBE_REP) >> (k)) & 1) ? 2 : 1)
#ifndef PHASE_MASK
#define PHASE_MASK 0xFFF
#endif
#define IN(k) (((PHASE_MASK >> (k)) & 1) && lo <= (k) && (k) < hi)
#define SEAM(k) do { if (MK_N_LAUNCHES == 1 && IN((k) + 1)) xcd_barrier(bar); } while (0)
    const int ngw = G * NWAVES;
#define PH_IDS const int tid = my_tid(), lane = tid & 63, wave = __builtin_amdgcn_readfirstlane(tid >> 6), gw = vcu * NWAVES + wave; (void)lane; (void)gw

    if (IN(0)) { asm volatile("" : "+s"(AP)); PH_IDS;
        for (int rep_ = 0; rep_ < NREP(0); ++rep_) { if (rep_) __syncthreads();
        p0_mod(lds, I_cvec, I_c_ctx, I_mod_w, I_mod_b, MOD, G);
        __syncthreads();
        LAS float* scr = (LAS float*)(lds + wave * 16384);
        constexpr int I0 = 16 * (E_N / 32), I1 = 16 * 32, I2 = 16 * (O_N / 32), I3 = 12 * 24, I4 = 4 * 32, I5 = 16 * 32, NIT = I0 + I1 + I2 + I3 + I4 + I5;
        for (int it = gw; it < NIT; it += ngw) {
            int r = it;
            if (r < I0) { p0_transpose_item(I_e_w_in, 1024, E_N, (bf16_t*)(ws + WS_WEIN), 0, nullptr, scr, r, E_N / 32, lane); continue; } r -= I0;
            if (r < I1) { p0_transpose_item(I_e_w_out, 1024, 1024, (bf16_t*)(ws + WS_WEOUT), 1, nullptr, scr, r, 32, lane); continue; } r -= I1;
            if (r < I2) { p0_transpose_item(I_o_w_in, 1024, O_NSRC, (bf16_t*)(ws + WS_WOIN), 2, nullptr, scr, r, O_N / 32, lane); continue; } r -= I2;
            if (r < I3) { p0_transpose_item(I_o_w_uq, 768, 768, (bf16_t*)(ws + WS_WUQ), 3, I_o_qn, scr, r, 24, lane); continue; } r -= I3;
            if (r < I4) { p0_transpose_item(I_o_w_ukv, 256, 1024, (bf16_t*)(ws + WS_WUKV), 4, I_o_kvn, scr, r, 32, lane); continue; } r -= I4;
            p0_transpose_item(I_o_w_out, 1024, 1024, (bf16_t*)(ws + WS_WOOUT), 5, nullptr, scr, r, 32, lane);
        }
        float* ropeA = (float*)(ws + WS_ROPEA); float* ropeC = (float*)(ws + WS_ROPEC);
        for (int idx = bx * NTHREADS + tid; idx < 2048 * 48; idx += G * NTHREADS) {
            const int pos = idx / 48, j = idx % 48; const float rowf = (float)(pos >> 6), colf = (float)(pos & 63);
            if (j < 32) { const int f = j & 15; const float inv = exp2f(-(float)f * (13.287712379549449f / 16.f)); const float ang = ((j < 16) ? rowf : colf) * inv;
                ropeA[pos * 64 + j] = __cosf(ang); ropeA[pos * 64 + 32 + j] = __sinf(ang); }
            else { const int jj = j - 32, f = jj & 7; const float inv = exp2f(-(float)f * (13.287712379549449f / 8.f)); const float ang = ((jj < 8) ? rowf : colf) * inv;
                ropeC[pos * 32 + jj] = __cosf(ang); ropeC[pos * 32 + 16 + jj] = __sinf(ang); }
        }
        }
        SEAM(0);
    }
    if (IN(1)) { asm volatile("" : "+s"(AP)); PH_IDS; for (int rep_ = 0; rep_ < NREP(1); ++rep_) { if (rep_) __syncthreads();
        p1_prenorm(I_x, I_ctx, I_pre_w, MOD, (bf16_t*)(ws + WS_H), gw, ngw, lane); }
        SEAM(1); }
    if (IN(2)) { asm volatile("" : "+s"(AP)); PH_IDS;
        for (int rep_ = 0; rep_ < NREP(2); ++rep_) { if (rep_) __syncthreads();
        pg8::Gemm g{(const bf16_t*)(ws + WS_H), (const bf16_t*)(ws + WS_WEIN), MT, E_N, 1024}; pg8::RectOrder S; S.init(MT / 256, E_N / 256, 0, 0, 0, G, bx);
        EpiEin E{ws}; pg8::gemm_phase<EpiEin, pg8::RectOrder, true, true>(lds, g, S, E);
        }
        SEAM(2);
    }
    if (IN(3)) { asm volatile("" : "+s"(AP)); PH_IDS;
        for (int rep_ = 0; rep_ < NREP(3) + NREP(14) - 1; ++rep_) {
        for (int un = vcu; un < 1024; un += G) attn_unit<0>(lds, ws, I_e_sink, un);
        for (int un = bx; un < 128; un += G) attn_unit<1>(lds, ws, I_e_sink, un);
        }
        for (int rep_ = 0; rep_ < NREP(3) + NREP(15) - 1; ++rep_) { p3_conv(ws, I_e_conv_w, bx * NTHREADS + tid, G * NTHREADS);
        }
        SEAM(3);
    }
    if (IN(4)) { asm volatile("" : "+s"(AP)); PH_IDS;
        for (int rep_ = 0; rep_ < NREP(4); ++rep_) { if (rep_) __syncthreads();
        pg8::Gemm g{(const bf16_t*)(ws + WS_U), (const bf16_t*)(ws + WS_WEOUT), MT, 1024, 1024}; pg8::RectOrder S; S.init(MT / 256, 4, 0, 0, 0, G, bx);
        EpiY E{(bf16_t*)(ws + WS_Y), (float*)(ws + WS_SSQY0)}; pg8::gemm_phase<EpiY, pg8::RectOrder, true, true>(lds, g, S, E);
        }
        SEAM(4);
    }
    if (IN(5)) { asm volatile("" : "+s"(AP)); PH_IDS; for (int rep_ = 0; rep_ < NREP(5); ++rep_) { if (rep_) __syncthreads();
        p5_post_pre(I_x, I_ctx, I_post_w, I_pre_w + 1024, MOD, (const bf16_t*)(ws + WS_Y), (const float*)(ws + WS_SSQY0), I_out, (bf16_t*)(ws + WS_H), gw, ngw, lane); }
        SEAM(5); }
    if (IN(6)) { asm volatile("" : "+s"(AP)); PH_IDS;
        for (int rep_ = 0; rep_ < NREP(6); ++rep_) { if (rep_) __syncthreads();
        pg8::Gemm g{(const bf16_t*)(ws + WS_H), (const bf16_t*)(ws + WS_WOIN), MT, O_N, 1024}; pg8::RectOrder S; S.init(ML / 256, O_N / 256, ML / 256, MC / 256, 5, G, bx);
        EpiOin E{ws}; pg8::gemm_phase<EpiOin, pg8::RectOrder, true, true>(lds, g, S, E);
        }
        SEAM(6);
    }
    if (IN(7)) { asm volatile("" : "+s"(AP)); PH_IDS;
        for (int rep_ = 0; rep_ < NREP(7); ++rep_) { if (rep_) __syncthreads();
        { pg8::Gemm g{(const bf16_t*)(ws + WS_CQ), (const bf16_t*)(ws + WS_WUQ), ML, 768, 768}; pg8::RectOrder S; S.init(ML / 256, 3, 0, 0, 0, G, bx);
          EpiUq E{ws}; pg8::gemm_phase<EpiUq, pg8::RectOrder, true, true>(lds, g, S, E); }
        __syncthreads();
        { pg8::Gemm g{(const bf16_t*)(ws + WS_CKV), (const bf16_t*)(ws + WS_WUKV), MT, 1024, 256}; pg8::RectOrder S; S.init(MT / 256, 4, 0, 0, 0, G, G - 1 - bx);
          EpiUkv E{ws}; pg8::gemm_phase<EpiUkv, pg8::RectOrder, true, true>(lds, g, S, E); }
        }
        SEAM(7);
    }
    if (IN(8)) { asm volatile("" : "+s"(AP)); PH_IDS;
        for (int rep_ = 0; rep_ < NREP(8) + NREP(12) - 1; ++rep_) { for (int ch = bx; ch < 256; ch += G) mlstm_chain_mfma<false>(lds, ws, I_o_ib, I_o_fb, ch);
        }
        for (int rep_ = 0; rep_ < NREP(8) + NREP(13) - 1; ++rep_) {
        for (int un = vcu; un < 1024; un += G) attn_unit<2>(lds, ws, nullptr, un);
        }
        SEAM(8);
    }
    if (IN(9)) { asm volatile("" : "+s"(AP)); PH_IDS; for (int rep_ = 0; rep_ < NREP(9); ++rep_) { if (rep_) __syncthreads();
        p9_readout(ws, I_o_hn, gw, ngw, lane); }
        SEAM(9); }
    if (IN(10)) { asm volatile("" : "+s"(AP)); PH_IDS;
        for (int rep_ = 0; rep_ < NREP(10); ++rep_) { if (rep_) __syncthreads();
        pg8::Gemm g{(const bf16_t*)(ws + WS_U), (const bf16_t*)(ws + WS_WOOUT), ML, 1024, 1024}; pg8::RectOrder S; S.init(ML / 256, 4, 0, 0, 0, G, bx);
        EpiY E{(bf16_t*)(ws + WS_Y), (float*)(ws + WS_SSQY1)}; pg8::gemm_phase<EpiY, pg8::RectOrder, true, true>(lds, g, S, E);
        }
        SEAM(10);
    }
    if (IN(11)) { asm volatile("" : "+s"(AP)); PH_IDS; p11_final(I_post_w + 1024, MOD, (const bf16_t*)(ws + WS_Y), (const float*)(ws + WS_SSQY1), I_out, gw, ngw, lane); }
#undef IN
#undef SEAM
#undef I_x
#undef I_cvec
#undef I_ctx
#undef I_c_ctx
#undef I_mod_w
#undef I_mod_b
#undef I_pre_w
#undef I_post_w
#undef I_e_w_in
#undef I_e_sink
#undef I_e_conv_w
#undef I_e_w_out
#undef I_o_w_in
#undef I_o_qn
#undef I_o_kvn
#undef I_o_w_uq
#undef I_o_w_ukv
#undef I_o_ib
#undef I_o_fb
#undef I_o_hn
#undef I_o_w_out
#undef I_out
}

extern "C" void kernel_launch(void* const* d_in, const int* in_sizes, int n_in, void* d_out, int out_size, void* d_ws, size_t ws_size, hipStream_t stream) {
    static int grid = 0;
    if (grid == 0) {
        if (n_in != 21 || in_sizes[0] != ML * DM || out_size != ML * DM || ws_size < WS_END) { fprintf(stderr, "kernel_launch: unexpected shapes / workspace (n_in %d, ws %zu < %zu); nothing launched\n", n_in, ws_size, (size_t)WS_END); grid = -1; return; }
        int dev = 0, cus = 0, per_cu = 0;
        if (hipGetDevice(&dev) != hipSuccess || hipDeviceGetAttribute(&cus, hipDeviceAttributeMultiprocessorCount, dev) != hipSuccess) { grid = -1; return; }
        if (hipFuncSetAttribute((const void*)hybrid_fwd, hipFuncAttributeMaxDynamicSharedMemorySize, LDS_BYTES) != hipSuccess) { fprintf(stderr, "kernel_launch: hipFuncSetAttribute failed\n"); grid = -1; return; }
        if (hipOccupancyMaxActiveBlocksPerMultiprocessor(&per_cu, (const void*)hybrid_fwd, NTHREADS, LDS_BYTES) != hipSuccess || per_cu < 1) fprintf(stderr, "kernel_launch: note: occupancy query reports %d workgroups per CU\n", per_cu);
        (void)hipGetLastError();
        grid = cus;
    }
    if (grid < 0) return;
    if (hipMemsetAsync((char*)d_ws + WS_CTL, 0, CTL_ZERO_BYTES, stream) != hipSuccess) { fprintf(stderr, "kernel_launch: hipMemsetAsync failed\n"); return; }
    Args a{};
    for (int i = 0; i < 21; ++i) a.in[i] = (const float*)d_in[i];
    a.out = (float*)d_out; a.ws = (unsigned char*)d_ws;
    if (MK_N_LAUNCHES == 1) { a.ph_lo = 0; a.ph_hi = N_PHASES; hipLaunchKernelGGL(hybrid_fwd, dim3(grid), dim3(NTHREADS), LDS_BYTES, stream, a); }
    else for (int p = 0; p < N_PHASES; ++p) { a.ph_lo = p; a.ph_hi = p + 1; hipLaunchKernelGGL(hybrid_fwd, dim3(grid), dim3(NTHREADS), LDS_BYTES, stream, a); }
    const hipError_t le = hipPeekAtLastError();
    if (le != hipSuccess) fprintf(stderr, "kernel_launch: launch failed: %s\n", hipGetErrorName(le));
}
```

```cpp
#include <hip/hip_runtime.h>
#include <cstdio>
#include <cstdint>

#define LAS __attribute__((address_space(3)))
#define GAS __attribute__((address_space(1)))
typedef unsigned short bf16_t;
typedef short bf16x8 __attribute__((ext_vector_type(8)));
typedef short s16x4 __attribute__((ext_vector_type(4)));
typedef float f32x4 __attribute__((ext_vector_type(4)));
typedef float f32x16 __attribute__((ext_vector_type(16)));
typedef unsigned u32x4 __attribute__((ext_vector_type(4)));
typedef unsigned u32x2 __attribute__((ext_vector_type(2)));
typedef float f32x2_t __attribute__((ext_vector_type(2)));
typedef __bf16 bf16x2_t __attribute__((ext_vector_type(2)));

constexpr int NB = 16, SEQ = 2048, DM = 1024, CL = 256;
constexpr int ML = NB * SEQ, MC = NB * CL, MT = ML + MC;
constexpr float EPS = 1e-6f, LOG2E = 1.4426950408889634f;
constexpr int E_N = 3328, O_NSRC = 3632, O_N = 3840;
constexpr int NWAVES = 8, NTHREADS = 512;

__device__ __forceinline__ float bf_lo(unsigned w) { return __uint_as_float(w << 16); }
__device__ __forceinline__ float bf_hi(unsigned w) { return __uint_as_float(w & 0xffff0000u); }
__device__ __forceinline__ unsigned pk2(float lo, float hi) { f32x2_t v = {lo, hi}; bf16x2_t b = __builtin_convertvector(v, bf16x2_t); return __builtin_bit_cast(unsigned, b); }
__device__ __forceinline__ float silu_f(float x) { return x * __builtin_amdgcn_rcpf(1.f + __expf(-x)); }
__device__ __forceinline__ float sigmoid_f(float x) { return __builtin_amdgcn_rcpf(1.f + __expf(-x)); }
__device__ __forceinline__ float wave_sum(float v) {
#pragma unroll
    for (int o = 1; o < 64; o <<= 1) v += __shfl_xor(v, o);
    return v;
}
#define LDS_WAIT() asm volatile("s_waitcnt lgkmcnt(0)" ::: "memory")
#define VM_WAIT() asm volatile("s_waitcnt vmcnt(0)" ::: "memory")

__device__ __forceinline__ int my_tid() { int t = threadIdx.x; asm volatile("" : "+v"(t)); return t; }

namespace pg8 {
#define PG8_LAS __attribute__((address_space(3)))
typedef unsigned short bf16_t;
typedef short bf16x8 __attribute__((ext_vector_type(8)));
typedef float f32x4 __attribute__((ext_vector_type(4)));
typedef unsigned u32x4 __attribute__((ext_vector_type(4)));
constexpr int BM = 256, BK = 64, HALF = 128, HTB = HALF * BK * 2  , STAGE_BYTES = 8 * HTB, NXCD = 8, WGM = 8;

__host__ __device__ __forceinline__ int lds_byte(int r, int c) { const int st = (r >> 4) * 2 + (c >> 5), rr = r & 15, cc = c & 31, ob = rr * 64 + cc * 2; return st * 1024 + (ob ^ (((ob >> 9) & 1) << 5)); }
__host__ __device__ __forceinline__ void stage_rc(int b, int& R, int& C) { const int st = b / 1024, sb = b % 1024, swz = sb ^ (((sb >> 9) & 1) << 5); R = (st >> 1) * 16 + swz / 64; C = (st & 1) * 32 + (swz % 64) / 2; }
__host__ __device__ __forceinline__ int perm32(int rho) { const int n = rho >> 4, i = rho & 15; return 8 * (i >> 2) + 4 * n + (i & 3); }

struct Unit { int pm, pn; };
struct Gemm { const bf16_t* A; const bf16_t* Bt; int M, N, K; };

struct RectOrder {
    int nM0, nN0, n0, pm1, nM1, nN1, n1, G, c;
    __device__ __forceinline__ void init(int nM0_, int nN0_, int pm1_, int nM1_, int nN1_, int G_, int c_) { nM0 = nM0_; nN0 = nN0_; n0 = nM0_ * nN0_; pm1 = pm1_; nM1 = nM1_; nN1 = nN1_; n1 = nM1_ * nN1_; G = G_; c = c_; }
    __device__ __forceinline__ static void rect(int w, int nM, int nN, int& pm, int& pn) {
        const int nig = WGM * nN, gid = w / nig, fm = gid * WGM, gsz = (nM - fm) < WGM ? (nM - fm) : WGM;
        pm = fm + ((w % nig) % gsz); pn = (w % nig) / gsz;
    }
    __device__ __forceinline__ bool next(int i, Unit& u) const {
        const int nwg = n0 + n1; const long L = (long)i * G + c; if (L >= nwg) return false;
        int wgid = (int)L; { const int q = nwg / NXCD, r = nwg % NXCD, xcd = wgid % NXCD, off = wgid / NXCD; wgid = (xcd < r ? xcd * (q + 1) : r * (q + 1) + (xcd - r) * q) + off; }
        if (wgid < n0) rect(wgid, nM0, nN0, u.pm, u.pn); else { rect(wgid - n0, nM1, nN1, u.pm, u.pn); u.pm += pm1; }
        return true;
    }
    __device__ __forceinline__ void a_ready(const Unit&) const {}
    __device__ __forceinline__ void done(const Unit&) const {}
};

template <class Epi, class Sched, bool ALIGN_EPI = false, bool SP2 = false>
__device__ __forceinline__ void gemm_phase(PG8_LAS unsigned char* lds, const Gemm g, const Sched& S, const Epi& E) {
    const int tid = my_tid(), wid = __builtin_amdgcn_readfirstlane(tid >> 6), lane = tid & 63, wr = wid >> 2, wc = wid & 3, fr = lane & 15, fq = lane >> 4;
    const int K = g.K, nt = K / BK;
    unsigned voffA[2], voffB[2];
#pragma unroll
    for (int i = 0; i < 2; ++i) { int R, C; stage_rc(tid * 16 + i * 8192, R, C); const int Rb = Epi::PERM ? ((R & ~31) + perm32(R & 31)) : R;
        voffA[i] = (unsigned)(R * K + C) * 2u; voffB[i] = (unsigned)(Rb * K + C) * 2u; }
    const size_t kstep = (size_t)(BK * 2);
    const size_t hstep = (size_t)HALF * K * 2;
    const size_t tstep = 2 * hstep;
    const unsigned ldsw = (unsigned)wid * 1024u;
    const int aoff = lds_byte(wr * 64 + fr, fq * 8), boff = lds_byte(wc * 32 + fr, fq * 8);
#define PG8_SA(b, h) (((b) * 2 + (h)) * HTB)
#define PG8_SB(b, h) ((4 + (b) * 2 + (h)) * HTB)
#define PG8_STAGE(bufoff, gbase, voff) do { _Pragma("unroll") for (int _i = 0; _i < 2; ++_i) \
        __builtin_amdgcn_global_load_lds((const unsigned*)((const char*)(gbase) + (voff)[_i]), (PG8_LAS unsigned*)(lds + (bufoff) + ldsw + _i * 8192), 16, 0, 0); } while (0)
#define PG8_LDA(dst, b, h) do { _Pragma("unroll") for (int m = 0; m < 4; ++m) _Pragma("unroll") for (int k = 0; k < 2; ++k) dst[m][k] = *(const PG8_LAS bf16x8*)(lds + PG8_SA(b, h) + aoff + m * 2048 + k * 1024); } while (0)
#define PG8_LDB(dst, b, h) do { _Pragma("unroll") for (int n = 0; n < 2; ++n) _Pragma("unroll") for (int k = 0; k < 2; ++k) dst[n][k] = *(const PG8_LAS bf16x8*)(lds + PG8_SB(b, h) + boff + n * 2048 + k * 1024); } while (0)
#define PG8_MMA(ai, bj, At, Bt) do { __builtin_amdgcn_s_setprio(1); _Pragma("unroll") for (int m = 0; m < 4; ++m) _Pragma("unroll") for (int n = 0; n < 2; ++n) _Pragma("unroll") for (int k = 0; k < 2; ++k) \
        acc[ai][bj][m][n] = __builtin_amdgcn_mfma_f32_16x16x32_bf16(Bt[n][k], At[m][k], acc[ai][bj][m][n], 0, 0, 0); __builtin_amdgcn_s_setprio(0); } while (0)
#define PG8_WAIT_V(n) asm volatile("s_waitcnt vmcnt(" #n ")" ::: "memory")
#define PG8_WAIT_L(n) asm volatile("s_waitcnt lgkmcnt(" #n ")" ::: "memory")
#define PG8_BAR __builtin_amdgcn_s_barrier()
#define PG8_SCHED __builtin_amdgcn_sched_barrier(0)
    Unit cur, nxt; int ui = 0;
    if (!S.next(0, cur)) return;
    f32x4 acc[2][2][4][2];
#pragma unroll
    for (int a = 0; a < 2; ++a)
#pragma unroll
        for (int b = 0; b < 2; ++b)
#pragma unroll
            for (int m = 0; m < 4; ++m)
#pragma unroll
                for (int n = 0; n < 2; ++n) acc[a][b][m][n] = (f32x4){0.f, 0.f, 0.f, 0.f};
    bf16x8 At[4][2], B0[2][2], B1[2][2];
    const char* cA = (const char*)g.A + (size_t)cur.pm * tstep; const char* cB = (const char*)g.Bt + (size_t)cur.pn * tstep;
    S.a_ready(cur);
    if constexpr (SP2) {
        PG8_STAGE(PG8_SB(0, 0), cB, voffB); PG8_STAGE(PG8_SB(0, 1), cB + hstep, voffB); PG8_STAGE(PG8_SA(0, 0), cA, voffA); PG8_STAGE(PG8_SA(0, 1), cA + hstep, voffA);
        if (wr == 1) PG8_BAR;
        PG8_WAIT_V(2); PG8_BAR;
        PG8_STAGE(PG8_SB(1, 0), cB + kstep, voffB); PG8_STAGE(PG8_SA(1, 0), cA + kstep, voffA); PG8_STAGE(PG8_SB(1, 1), cB + hstep + kstep, voffB);
        PG8_WAIT_V(6); PG8_BAR;
    } else {
        PG8_STAGE(PG8_SB(0, 0), cB, voffB); PG8_STAGE(PG8_SA(0, 0), cA, voffA); PG8_STAGE(PG8_SB(0, 1), cB + hstep, voffB); PG8_STAGE(PG8_SA(0, 1), cA + hstep, voffA);
        if (wr == 1) PG8_BAR;
        PG8_WAIT_V(4); PG8_BAR;
        PG8_STAGE(PG8_SB(1, 0), cB + kstep, voffB); PG8_STAGE(PG8_SA(1, 0), cA + kstep, voffA); PG8_STAGE(PG8_SB(1, 1), cB + hstep + kstep, voffB);
        PG8_WAIT_V(6); PG8_BAR;
    }
    for (;;) {
        const bool has_next = S.next(ui + 1, nxt);
        const char* nA = has_next ? (const char*)g.A + (size_t)nxt.pm * tstep : cA; const char* nB = has_next ? (const char*)g.Bt + (size_t)nxt.pn * tstep : cB;
        for (int t = 0; t < nt; t += 2) {
            const bool last = (t == nt - 2);
            const char* a1 = cA + (size_t)(t + 1) * kstep;
            const char* a2 = last ? nA : cA + (size_t)(t + 2) * kstep; const char* b2 = last ? nB : cB + (size_t)(t + 2) * kstep;
            const char* a3 = a2 + kstep; const char* b3 = b2 + kstep;
            if (last && has_next) S.a_ready(nxt);
            if constexpr (SP2) {
            PG8_LDB(B0, 0, 0); PG8_LDB(B1, 0, 1); PG8_SCHED; PG8_LDA(At, 0, 0); PG8_STAGE(PG8_SA(1, 1), a1 + hstep, voffA);
            PG8_WAIT_V(8); PG8_WAIT_L(0); PG8_BAR; PG8_MMA(0, 0, At, B0); PG8_MMA(0, 1, At, B1); PG8_BAR; PG8_SCHED;
            PG8_LDA(At, 0, 1); PG8_STAGE(PG8_SB(0, 0), b2, voffB); PG8_STAGE(PG8_SB(0, 1), b2 + hstep, voffB); PG8_STAGE(PG8_SA(0, 0), a2, voffA);
            PG8_WAIT_V(8); PG8_WAIT_L(0); PG8_BAR; PG8_MMA(1, 0, At, B0); PG8_MMA(1, 1, At, B1); PG8_BAR; PG8_SCHED;
            PG8_LDB(B0, 1, 0); PG8_LDB(B1, 1, 1); PG8_SCHED; PG8_LDA(At, 1, 0); PG8_STAGE(PG8_SA(0, 1), a2 + hstep, voffA);
            PG8_WAIT_V(8); PG8_WAIT_L(0); PG8_BAR; PG8_MMA(0, 0, At, B0); PG8_MMA(0, 1, At, B1); PG8_BAR; PG8_SCHED;
            PG8_LDA(At, 1, 1); PG8_STAGE(PG8_SB(1, 0), b3, voffB); PG8_STAGE(PG8_SB(1, 1), b3 + hstep, voffB); PG8_STAGE(PG8_SA(1, 0), a3, voffA);
            PG8_WAIT_V(8); PG8_WAIT_L(0); PG8_BAR; PG8_MMA(1, 0, At, B0); PG8_MMA(1, 1, At, B1); PG8_BAR; PG8_SCHED;
            } else {
            PG8_LDB(B0, 0, 0); PG8_SCHED; PG8_LDA(At, 0, 0); PG8_STAGE(PG8_SA(1, 1), a1 + hstep, voffA);
            PG8_WAIT_L(8); PG8_BAR; PG8_WAIT_L(0); PG8_MMA(0, 0, At, B0); PG8_BAR; PG8_SCHED;
            PG8_LDB(B1, 0, 1); PG8_STAGE(PG8_SB(0, 0), b2, voffB);
            PG8_BAR; PG8_WAIT_L(0); PG8_MMA(0, 1, At, B1); PG8_BAR;
            PG8_LDA(At, 0, 1); PG8_STAGE(PG8_SA(0, 0), a2, voffA);
            PG8_BAR; PG8_WAIT_L(0); PG8_MMA(1, 0, At, B0); PG8_BAR; PG8_SCHED;
            PG8_STAGE(PG8_SB(0, 1), b2 + hstep, voffB);
            PG8_WAIT_V(6); PG8_BAR; PG8_MMA(1, 1, At, B1); PG8_BAR;
            PG8_LDB(B0, 1, 0); PG8_SCHED; PG8_LDA(At, 1, 0); PG8_STAGE(PG8_SA(0, 1), a2 + hstep, voffA);
            PG8_WAIT_L(8); PG8_BAR; PG8_WAIT_L(0); PG8_MMA(0, 0, At, B0); PG8_BAR; PG8_SCHED;
            PG8_LDB(B1, 1, 1); PG8_STAGE(PG8_SB(1, 0), b3, voffB);
            PG8_BAR; PG8_WAIT_L(0); PG8_MMA(0, 1, At, B1); PG8_BAR;
            PG8_LDA(At, 1, 1); PG8_STAGE(PG8_SA(1, 0), a3, voffA);
            PG8_BAR; PG8_WAIT_L(0); PG8_MMA(1, 0, At, B0); PG8_BAR; PG8_SCHED;
            PG8_STAGE(PG8_SB(1, 1), b3 + hstep, voffB);
            PG8_WAIT_V(6); PG8_BAR; PG8_MMA(1, 1, At, B1); PG8_BAR;
            }
        }
        if constexpr (ALIGN_EPI) { if (wr == 0) PG8_BAR; }
        if constexpr (!Epi::AFTER_DRAIN) { E(acc, cur, wr, wc, fr, fq); S.done(cur); }
        if (!has_next) break;
#pragma unroll
        for (int a = 0; a < 2; ++a)
#pragma unroll
            for (int b = 0; b < 2; ++b)
#pragma unroll
                for (int m = 0; m < 4; ++m)
#pragma unroll
                    for (int n = 0; n < 2; ++n) acc[a][b][m][n] = (f32x4){0.f, 0.f, 0.f, 0.f};
        cur = nxt; cA = nA; cB = nB; ++ui;
        if constexpr (ALIGN_EPI) { if (wr == 1) PG8_BAR; }
    }
    PG8_WAIT_V(0);
    if constexpr (!ALIGN_EPI) { if (wr == 0) PG8_BAR; }
    PG8_BAR;
    if constexpr (Epi::AFTER_DRAIN) { E.fused(acc, cur, wr, wc, fr, fq, lds, wid, lane); S.done(cur); }
#undef PG8_SA
#undef PG8_SB
#undef PG8_STAGE
#undef PG8_LDA
#undef PG8_LDB
#undef PG8_MMA
#undef PG8_WAIT_V
#undef PG8_WAIT_L
#undef PG8_BAR
#undef PG8_SCHED
}
}

constexpr size_t MiB = 1u << 20;
constexpr size_t WS_CTL = 0, CTL_ZERO_BYTES = 1 * MiB;
constexpr size_t WS_MOD = 1 * MiB;
constexpr size_t WS_ROPEA = 2 * MiB;
constexpr size_t WS_ROPEC = 2 * MiB + 512 * 1024;
constexpr size_t WS_WEIN = 3 * MiB, WS_WEOUT = 10 * MiB, WS_WOIN = 12 * MiB, WS_WUQ = 20 * MiB, WS_WUKV = 21 * MiB + 512 * 1024, WS_WOOUT = 22 * MiB;
constexpr size_t WS_H = 24 * MiB;
constexpr size_t WS_U = 96 * MiB;
constexpr size_t WS_Y = 168 * MiB;
constexpr size_t WS_R = 240 * MiB;
constexpr size_t WS_KVE = WS_R  , WS_QE = WS_R + 18 * MiB, WS_PE = WS_R + 54 * MiB, WS_GE = WS_R + 90 * MiB, WS_ZA = WS_R + 126 * MiB, WS_SSQY0 = WS_R + 241 * MiB  ;
constexpr size_t WS_CKV = WS_R, WS_CQ = WS_R + 18 * MiB, WS_HM = WS_R  , WS_MK = WS_R + 66 * MiB, WS_MV = WS_R + 84 * MiB, WS_KR = WS_R + 120 * MiB, WS_GATES = WS_R + 123 * MiB,
                 WS_SSQCKV = WS_R + 126 * MiB, WS_SSQCQ = WS_R + 127 * MiB, WS_X1 = WS_R + 129 * MiB  , WS_SSQY1 = WS_R + 241 * MiB;
constexpr size_t AUX_MQ = 0, AUX_MO = 16 * MiB, AUX_ZO = 48 * MiB;
constexpr size_t WS_KNV = WS_H  , WS_QO = WS_Y;
constexpr size_t WS_END = WS_R + 244 * MiB;
static_assert(WS_ZA + (size_t)MT * 512 * 2 <= WS_R + 162 * MiB && WS_X1 + (size_t)ML * 1024 * 2 <= WS_R + 241 * MiB && WS_HM + (size_t)2 * ML * 512 * 2 <= WS_MK && WS_SSQY1 + (size_t)MT * 16 * 4 <= WS_END, "ws map");

__device__ __forceinline__ void st8(bf16_t* p, f32x4 a, f32x4 b) { u32x4 w; w.x = pk2(a[0], a[1]); w.y = pk2(a[2], a[3]); w.z = pk2(b[0], b[1]); w.w = pk2(b[2], b[3]); *(u32x4*)p = w; }
__device__ __forceinline__ bf16_t f2bf(float v) { return (bf16_t)(pk2(v, 0.f) & 0xffffu); }
__device__ __forceinline__ void rope8(f32x4& a, f32x4& b, const float* cosp, const float* sinp) {
    const f32x4 cs = *(const f32x4*)cosp, sn = *(const f32x4*)sinp;
    const float a0 = a[0] * cs[0] - a[1] * sn[0], a1 = a[0] * sn[0] + a[1] * cs[0], a2 = a[2] * cs[1] - a[3] * sn[1], a3 = a[2] * sn[1] + a[3] * cs[1];
    const float b0 = b[0] * cs[2] - b[1] * sn[2], b1 = b[0] * sn[2] + b[1] * cs[2], b2 = b[2] * cs[3] - b[3] * sn[3], b3 = b[2] * sn[3] + b[3] * cs[3];
    a = (f32x4){a0, a1, a2, a3}; b = (f32x4){b0, b1, b2, b3};
}
__device__ __forceinline__ f32x4 silu4(f32x4 v) { return (f32x4){silu_f(v[0]), silu_f(v[1]), silu_f(v[2]), silu_f(v[3])}; }
__device__ __forceinline__ f32x4 sigm4(f32x4 v) { return (f32x4){sigmoid_f(v[0]), sigmoid_f(v[1]), sigmoid_f(v[2]), sigmoid_f(v[3])}; }
__device__ __forceinline__ float sq4(f32x4 v) { return (v[0] * v[0] + v[1] * v[1]) + (v[2] * v[2] + v[3] * v[3]); }

struct EpiEin {
    static constexpr bool PERM = true, AFTER_DRAIN = false;
    unsigned char* ws;
    __device__ __forceinline__ void operator()(const f32x4 (&acc)[2][2][4][2], const pg8::Unit& u, int wr, int wc, int fr, int fq) const {
        const int pn = u.pn, rbase = u.pm * 256 + wr * 64 + fr, cw = wc * 32 + 8 * fq;
        const float* ropeA = (const float*)(ws + WS_ROPEA);
#pragma unroll
        for (int ai = 0; ai < 2; ++ai)
#pragma unroll
            for (int m = 0; m < 4; ++m) {
                asm volatile("" ::: "memory"); const int R = rbase + ai * 128 + m * 16; const bool lat = R < ML; const int pos = R & 2047;
                if (pn == 0) {
                    f32x4 a = acc[ai][0][m][0], b = acc[ai][0][m][1];
                    if (lat) { const int i0 = (cw & 63) >> 1; rope8(a, b, ropeA + pos * 64 + i0, ropeA + pos * 64 + 32 + i0); }
                    st8((bf16_t*)(ws + WS_KVE) + (size_t)R * 256 + cw, a, b);
                    st8((bf16_t*)(ws + WS_KVE) + (size_t)R * 256 + 128 + cw, acc[ai][1][m][0], acc[ai][1][m][1]);
                } else if (pn <= 2) {
#pragma unroll
                    for (int bj = 0; bj < 2; ++bj) {
                        f32x4 a = acc[ai][bj][m][0], b = acc[ai][bj][m][1];
                        if (lat) { const int i0 = (cw & 63) >> 1; rope8(a, b, ropeA + pos * 64 + i0, ropeA + pos * 64 + 32 + i0); }
                        const float sc = 0.125f * LOG2E; a = a * sc; b = b * sc;
                        st8((bf16_t*)(ws + WS_QE) + (size_t)R * 512 + (pn - 1) * 256 + bj * 128 + cw, a, b);
                    }
                } else if (pn <= 6) {
                    st8((bf16_t*)(ws + WS_PE) + (size_t)R * 512 + (pn - 3) * 128 + cw, acc[ai][0][m][0] * acc[ai][1][m][0], acc[ai][0][m][1] * acc[ai][1][m][1]);
                } else if (pn <= 10) {
                    st8((bf16_t*)(ws + WS_GE) + (size_t)R * 512 + (pn - 7) * 128 + cw, acc[ai][0][m][0] * silu4(acc[ai][1][m][0]), acc[ai][0][m][1] * silu4(acc[ai][1][m][1]));
                } else {
#pragma unroll
                    for (int bj = 0; bj < 2; ++bj)
                        st8((bf16_t*)(ws + WS_ZA) + (size_t)R * 512 + (pn - 11) * 256 + bj * 128 + cw, silu4(acc[ai][bj][m][0]), silu4(acc[ai][bj][m][1]));
                }
            }
    }
};

struct EpiY {
    static constexpr bool PERM = true, AFTER_DRAIN = false;
    bf16_t* Y; float* SSQ;
    __device__ __forceinline__ void operator()(const f32x4 (&acc)[2][2][4][2], const pg8::Unit& u, int wr, int wc, int fr, int fq) const {
        const int pn = u.pn, rbase = u.pm * 256 + wr * 64 + fr, cw = wc * 32 + 8 * fq;
#pragma unroll
        for (int ai = 0; ai < 2; ++ai)
#pragma unroll
            for (int m = 0; m < 4; ++m) {
                asm volatile("" ::: "memory"); const int R = rbase + ai * 128 + m * 16; float s = 0.f;
#pragma unroll
                for (int bj = 0; bj < 2; ++bj) { st8(Y + (size_t)R * 1024 + pn * 256 + bj * 128 + cw, acc[ai][bj][m][0], acc[ai][bj][m][1]); s += sq4(acc[ai][bj][m][0]) + sq4(acc[ai][bj][m][1]); }
                s += __shfl_xor(s, 16); s += __shfl_xor(s, 32);
                if (fq == 0) SSQ[(size_t)R * 16 + pn * 4 + wc] = s;
            }
    }
};

struct EpiOin {
    static constexpr bool PERM = true, AFTER_DRAIN = false;
    unsigned char* ws; unsigned char* aux;
    __device__ __forceinline__ void operator()(const f32x4 (&acc)[2][2][4][2], const pg8::Unit& u, int wr, int wc, int fr, int fq) const {
        const int pn = u.pn, rbase = u.pm * 256 + wr * 64 + fr, cw = wc * 32 + 8 * fq;
        const float* ropeC = (const float*)(ws + WS_ROPEC);
#pragma unroll
        for (int ai = 0; ai < 2; ++ai)
#pragma unroll
            for (int m = 0; m < 4; ++m) {
                asm volatile("" ::: "memory"); const int R = rbase + ai * 128 + m * 16; const bool lat = R < ML; const int pos = R & 2047;
                if (pn == 0 || (pn >= 5 && pn <= 7)) {
                    float s = 0.f;
                    bf16_t* dst = (pn == 0) ? (bf16_t*)(ws + WS_CKV) + (size_t)R * 256 : (bf16_t*)(ws + WS_CQ) + (size_t)R * 768 + (pn - 5) * 256;
#pragma unroll
                    for (int bj = 0; bj < 2; ++bj) { st8(dst + bj * 128 + cw, acc[ai][bj][m][0], acc[ai][bj][m][1]); s += sq4(acc[ai][bj][m][0]) + sq4(acc[ai][bj][m][1]); }
                    s += __shfl_xor(s, 16); s += __shfl_xor(s, 32);
                    if (fq == 0) { if (pn == 0) ((float*)(ws + WS_SSQCKV))[(size_t)R * 4 + wc] = s; else ((float*)(ws + WS_SSQCQ))[(size_t)R * 12 + (pn - 5) * 4 + wc] = s; }
                } else if (pn == 4) {
                    if (wc == 0) {
                        f32x4 a = acc[ai][0][m][0], b = acc[ai][0][m][1];
                        if (lat) { const int i0 = cw >> 1; rope8(a, b, ropeC + pos * 32 + i0, ropeC + pos * 32 + 16 + i0); }
                        st8((bf16_t*)(ws + WS_KR) + (size_t)R * 32 + cw, a, b);
                    } else if (wc == 1 && fq < 2) {
                        float* g = (float*)(ws + WS_GATES) + (size_t)R * 16 + 8 * fq;
                        *(f32x4*)g = acc[ai][0][m][0]; *(f32x4*)(g + 4) = acc[ai][0][m][1];
                    }
                } else {
#pragma unroll
                    for (int bj = 0; bj < 2; ++bj) {
                        const f32x4 a = acc[ai][bj][m][0], b = acc[ai][bj][m][1]; const int col = bj * 128 + cw;
                        if (pn == 1) st8((bf16_t*)(ws + WS_MK) + (size_t)R * 256 + col, a * 0.125f, b * 0.125f);
                        else if (pn <= 3) st8((bf16_t*)(ws + WS_MV) + (size_t)R * 512 + (pn - 2) * 256 + col, a, b);
                        else if (pn == 8) st8((bf16_t*)(aux + AUX_MQ) + (size_t)R * 256 + col, a, b);
                        else if (pn >= 13) st8((bf16_t*)(aux + AUX_ZO) + (size_t)R * 512 + (pn - 13) * 256 + col, silu4(a), silu4(b));
                        else if (bj == 0) st8((bf16_t*)(aux + AUX_MO) + (size_t)R * 512 + (pn - 9) * 128 + cw, sigm4(a) * silu4(acc[ai][1][m][0]), sigm4(b) * silu4(acc[ai][1][m][1]));
                    }
                }
            }
    }
};

struct EpiUkv {
    static constexpr bool PERM = true, AFTER_DRAIN = false;
    unsigned char* ws;
    __device__ __forceinline__ void operator()(const f32x4 (&acc)[2][2][4][2], const pg8::Unit& u, int wr, int wc, int fr, int fq) const {
        const int pn = u.pn, rbase = u.pm * 256 + wr * 64 + fr, cw = wc * 32 + 8 * fq;
#pragma unroll
        for (int ai = 0; ai < 2; ++ai)
#pragma unroll
            for (int m = 0; m < 4; ++m) {
                asm volatile("" ::: "memory"); const int R = rbase + ai * 128 + m * 16;
                const f32x4 sp = *(const f32x4*)((const float*)(ws + WS_SSQCKV) + (size_t)R * 4);
                const float rstd = rsqrtf(((sp[0] + sp[1]) + (sp[2] + sp[3])) * (1.f / 256.f) + EPS);
                int b, pos; if (R < ML) { b = R >> 11; pos = 256 + (R & 2047); } else { const int rc = R - ML; b = rc >> 8; pos = rc & 255; }
#pragma unroll
                for (int bj = 0; bj < 2; ++bj) {
                    const int head = pn * 2 + bj;
                    st8((bf16_t*)(ws + WS_KNV) + ((size_t)(b * 8 + head) * 2304 + pos) * 128 + cw, acc[ai][bj][m][0] * rstd, acc[ai][bj][m][1] * rstd);
                }
            }
    }
};

struct EpiUq {
    static constexpr bool PERM = true, AFTER_DRAIN = false;
    unsigned char* ws;
    __device__ __forceinline__ void operator()(const f32x4 (&acc)[2][2][4][2], const pg8::Unit& u, int wr, int wc, int fr, int fq) const {
        const int pn = u.pn, rbase = u.pm * 256 + wr * 64 + fr, cw = wc * 32 + 8 * fq;
        const float* ropeC = (const float*)(ws + WS_ROPEC);
#pragma unroll
        for (int ai = 0; ai < 2; ++ai)
#pragma unroll
            for (int m = 0; m < 4; ++m) {
                asm volatile("" ::: "memory"); const int R = rbase + ai * 128 + m * 16, pos = R & 2047;
                const float* sp = (const float*)(ws + WS_SSQCQ) + (size_t)R * 12;
                const f32x4 s0 = *(const f32x4*)sp, s1 = *(const f32x4*)(sp + 4), s2 = *(const f32x4*)(sp + 8);
                const float ss = (((s0[0] + s0[1]) + (s0[2] + s0[3])) + ((s1[0] + s1[1]) + (s1[2] + s1[3]))) + ((s2[0] + s2[1]) + (s2[2] + s2[3]));
                const float sc = rsqrtf(ss * (1.f / 768.f) + EPS) * (0.10206207261596575f * LOG2E);
#pragma unroll
                for (int bj = 0; bj < 2; ++bj) {
                    const int c = pn * 256 + bj * 128 + cw, head = c / 96, dd = c - head * 96;
                    f32x4 a = acc[ai][bj][m][0], b = acc[ai][bj][m][1];
                    if (dd >= 64) { const int i0 = (dd - 64) >> 1; rope8(a, b, ropeC + pos * 32 + i0, ropeC + pos * 32 + 16 + i0); }
                    st8((bf16_t*)(ws + WS_QO) + (size_t)R * 768 + c, a * sc, b * sc);
                }
            }
    }
};

#define RLX_AGENT __ATOMIC_RELAXED, __HIP_MEMORY_SCOPE_AGENT
#define XB_TMO      128
#define XB_XCNT(j)  (256  + 64 * (j))
#define XB_XSUB(j)  (1280 + 64 * (j))
#define XB_XGEN(j)  (2304 + 64 * (j))
#define XB_TOP      3328
#define XB_TOPGEN   3392
#define XCD_BAR_WORDS 3456
#define XB_SPIN_CAP (1u << 18)

__device__ __forceinline__ unsigned xb_ld(unsigned* p)              { return __hip_atomic_load(p, __ATOMIC_RELAXED, __HIP_MEMORY_SCOPE_AGENT); }
__device__ __forceinline__ unsigned xb_add(unsigned* p, unsigned v) { return __hip_atomic_fetch_add(p, v, __ATOMIC_RELAXED, __HIP_MEMORY_SCOPE_AGENT); }
__device__ __forceinline__ unsigned xb_xcc_id() { return (unsigned)__builtin_amdgcn_s_getreg((3 << 11) | 20) & 0xFu; }
#define XB_SPIN(cond, bar) do { unsigned _sp = 0; while (cond) { __builtin_amdgcn_s_sleep(1); \
    if ((++_sp & 255u) == 0u) { if (xb_ld(&(bar)[XB_TMO])) break; if (_sp > XB_SPIN_CAP) { atomicAdd(&(bar)[XB_TMO], 1u); break; } } } } while (0)

struct XcdBarrier {
    unsigned* bar; unsigned x;
    volatile LAS unsigned* st;
};

__device__ __forceinline__ XcdBarrier xcd_barrier_post(unsigned* bar, volatile LAS unsigned* st) {
    XcdBarrier b; b.bar = bar; b.x = xb_xcc_id(); b.st = st;
    if (threadIdx.x == 0) (void)xb_add(&bar[XB_XCNT(b.x)], 1u);
    return b;
}
__device__ __forceinline__ void xcd_barrier_complete(unsigned* bar, unsigned x, unsigned& nloc, unsigned& nx) {
    const unsigned G = gridDim.x * gridDim.y * gridDim.z;
    unsigned sum, cnt, mine, sp = 0u;
    for (;;) {
        sum = 0u; cnt = 0u; mine = 0u;
#pragma unroll
        for (unsigned j = 0; j < 16; ++j) { const unsigned c = xb_ld(&bar[XB_XCNT(j)]); sum += c; cnt += (c > 0u) ? 1u : 0u; mine = (j == x) ? c : mine; }
        if (sum == G) break;
        __builtin_amdgcn_s_sleep(1);
        if ((++sp & 255u) == 0u) { if (xb_ld(&bar[XB_TMO])) break; if (sp > XB_SPIN_CAP) { atomicAdd(&bar[XB_TMO], 1u); break; } }
    }
    nloc = mine > 0u ? mine : 1u; nx = cnt > 0u ? cnt : 1u;
}

__device__ __forceinline__ void xcd_barrier(const XcdBarrier& b) {
    asm volatile("s_waitcnt vmcnt(0)" ::: "memory");
    __syncthreads();
    if (threadIdx.x == 0) {
        unsigned* bar = b.bar;
        __builtin_amdgcn_s_waitcnt(0);
        unsigned nloc = b.st[0], nx = b.st[1];
        if (nloc == 0u) { xcd_barrier_complete(bar, b.x, nloc, nx); b.st[0] = nloc; b.st[1] = nx; }
        const unsigned old = xb_add(&bar[XB_XSUB(b.x)], 1u);
        const unsigned gen = old / nloc;
        if (old + 1u == (gen + 1u) * nloc) {
            __builtin_amdgcn_fence(__ATOMIC_RELEASE, "agent");
            asm volatile("s_waitcnt vmcnt(0)" ::: "memory");
            const unsigned og = xb_add(&bar[XB_TOP], 1u);
            const unsigned tg = og / nx;
            if (og + 1u == (tg + 1u) * nx) xb_add(&bar[XB_TOPGEN], 1u);
            else XB_SPIN(xb_ld(&bar[XB_TOPGEN]) == tg, bar);
            __builtin_amdgcn_fence(__ATOMIC_ACQUIRE, "agent");
            xb_add(&bar[XB_XGEN(b.x)], 1u);
            asm volatile("s_waitcnt vmcnt(0)" ::: "memory");
        } else {
            XB_SPIN(xb_ld(&bar[XB_XGEN(b.x)]) == gen, bar);
            __builtin_amdgcn_fence(__ATOMIC_ACQUIRE, "agent");
            asm volatile("s_waitcnt vmcnt(0)" ::: "memory");
        }
    }
    __syncthreads();
}

__device__ __forceinline__ int crow(int r, int hi) { return (r & 3) + 8 * (r >> 2) + 4 * hi; }
typedef short v4i16_t __attribute__((ext_vector_type(4)));
__device__ __forceinline__ s16x4 vtr(const LAS unsigned char* p) { return __builtin_bit_cast(s16x4, __builtin_amdgcn_ds_read_tr16_b64_v4i16((LAS v4i16_t*)p)); }

template <int MODE>
__device__ __forceinline__ void attn_unit(LAS unsigned char* lds, unsigned char* ws, unsigned char* aux, const float* sink, int unit) {
    constexpr int DQK = (MODE == 2) ? 96 : 64, KST = DQK / 16, KS = DQK * 2 + 16, VS = 192, KBUF = 64 * KS, VBUF = 64 * VS;
    const int tid = my_tid(), lane = tid & 63, wid = __builtin_amdgcn_readfirstlane(tid >> 6), r32 = lane & 31, hi = lane >> 5;
    int b, head, hkv = 0, n = 0, Rq0, qpos0 = 0, nt, jlo = 0;
    const bf16_t* Qp; int qstride;
    if (MODE == 0) {
        const int hp = unit & 1; n = (unit >> 1) & 15; hkv = (unit >> 5) & 1; b = unit >> 6;
        head = hkv * 4 + hp * 2 + (wid >> 2); qpos0 = 128 * n + 32 * (wid & 3); Rq0 = b * 2048 + qpos0;
        Qp = (const bf16_t*)(ws + WS_QE) + (size_t)Rq0 * 512 + head * 64; qstride = 512;
        jlo = (n == 0) ? 2 : 0; const int jhi = (n == 15) ? 4 : 6; nt = 4 + (jhi - jlo);
    } else if (MODE == 1) {
        const int qh = unit & 1, hp = (unit >> 1) & 1; hkv = (unit >> 2) & 1; b = unit >> 3;
        head = hkv * 4 + hp * 2 + (wid >> 2); Rq0 = ML + b * 256 + 128 * qh + 32 * (wid & 3);
        Qp = (const bf16_t*)(ws + WS_QE) + (size_t)Rq0 * 512 + head * 64; qstride = 512; nt = 4;
    } else {
        const int qb = unit & 7; head = (unit >> 3) & 7; b = unit >> 6; Rq0 = b * 2048 + 256 * qb + 32 * wid;
        Qp = (const bf16_t*)(ws + WS_QO) + (size_t)Rq0 * 768 + head * 96; qstride = 768; nt = 36;
    }
    bf16x8 qf[KST];
#pragma unroll
    for (int s = 0; s < KST; ++s) qf[s] = *(const bf16x8*)(Qp + (size_t)r32 * qstride + 16 * s + 8 * hi);
    constexpr float THR = 6.0f;
    float mref, l_run;
    if (MODE == 2) { mref = 0.f; l_run = 0.f; } else { mref = sink[head] * LOG2E; l_run = (hi == 0) ? 1.f : 0.f; }
    f32x16 negm;
#pragma unroll
    for (int r = 0; r < 16; ++r) negm[r] = -mref;
    f32x16 o0, o1;
#pragma unroll
    for (int r = 0; r < 16; ++r) { o0[r] = 0.f; o1[r] = 0.f; }

    const int srow = tid >> 3, sch = tid & 7;
    const int voff = (4 * hi + ((lane & 15) >> 2)) * VS + (((lane >> 4) & 1) * 16 + 4 * (lane & 3)) * 2;
    u32x4 kreg, vreg, kreg2;
    kreg2 = (u32x4){0u, 0u, 0u, 0u};
#define ATT_SRC(t, kp, vp, k2p, kpos0v) do { \
        if (MODE == 0 || MODE == 1) { \
            if ((t) < 4) { kp = (const bf16_t*)(ws + WS_KVE) + (size_t)(ML + b * 256 + 64 * (t) + srow) * 256 + hkv * 64 + sch * 8; kpos0v = -100000; } \
            else { const int kp0_ = 128 * n - 128 + 64 * (jlo + (t) - 4); kpos0v = kp0_; \
                   kp = (const bf16_t*)(ws + WS_KVE) + (size_t)(b * 2048 + kp0_ + srow) * 256 + hkv * 64 + sch * 8; } \
            vp = kp + 128; k2p = kp; \
        } else { \
            const int pos0_ = 64 * (t); kpos0v = -100000; \
            kp = (const bf16_t*)(ws + WS_KNV) + ((size_t)(b * 8 + head) * 2304 + pos0_ + srow) * 128 + sch * 8; \
            vp = kp + 64; \
            const int krow_ = ((t) < 4) ? (ML + b * 256 + pos0_) : (b * 2048 + pos0_ - 256); \
            k2p = (const bf16_t*)(ws + WS_KR) + (size_t)(krow_ + (tid >> 2)) * 32 + (tid & 3) * 8; \
        } } while (0)
#define ATT_LOAD(t) do { const bf16_t *kp_, *vp_, *k2p_; int kq_; ATT_SRC(t, kp_, vp_, k2p_, kq_); (void)kq_; \
        kreg = *(const u32x4*)kp_; vreg = *(const u32x4*)vp_; if (MODE == 2 && tid < 256) kreg2 = *(const u32x4*)k2p_; } while (0)
#define ATT_STORE(buf) do { LAS unsigned char* kb_ = lds + (buf) * KBUF; LAS unsigned char* vb_ = lds + 2 * KBUF + (buf) * VBUF; \
        *(LAS u32x4*)(kb_ + srow * KS + sch * 16) = kreg; \
        if (MODE == 2 && tid < 256) *(LAS u32x4*)(kb_ + (tid >> 2) * KS + 128 + (tid & 3) * 16) = kreg2; \
        *(LAS u32x4*)(vb_ + srow * VS + sch * 16) = vreg; } while (0)

    ATT_LOAD(0); ATT_STORE(0);
    __syncthreads();
    for (int t = 0; t < nt; ++t) {
        const int buf = t & 1;
        if (t + 1 < nt) ATT_LOAD(t + 1);
        int kpos0 = -100000;
        if (MODE == 0 && t >= 4) kpos0 = 128 * n - 128 + 64 * (jlo + t - 4);
        bool active = true;
        if (MODE == 0 && t >= 4) active = (kpos0 + 63 >= qpos0 - 128) && (kpos0 <= qpos0 + 31 + 128);
        if (active) {
            const LAS unsigned char* kb = lds + buf * KBUF; const LAS unsigned char* vb = lds + 2 * KBUF + buf * VBUF;
            f32x16 p0 = negm, p1 = negm;
#pragma unroll
            for (int s = 0; s < KST; ++s) {
                const bf16x8 a0 = *(const LAS bf16x8*)(kb + r32 * KS + (16 * s + 8 * hi) * 2);
                const bf16x8 a1 = *(const LAS bf16x8*)(kb + (32 + r32) * KS + (16 * s + 8 * hi) * 2);
                p0 = __builtin_amdgcn_mfma_f32_32x32x16_bf16(a0, qf[s], p0, 0, 0, 0);
                p1 = __builtin_amdgcn_mfma_f32_32x32x16_bf16(a1, qf[s], p1, 0, 0, 0);
            }
            if (MODE == 0 && t >= 4) {
                const int qpos = qpos0 + r32;
#pragma unroll
                for (int r = 0; r < 16; ++r) { const int d0 = kpos0 + crow(r, hi) - qpos, d1 = d0 + 32;
                    if (d0 > 128 || d0 < -128) p0[r] = -INFINITY; if (d1 > 128 || d1 < -128) p1[r] = -INFINITY; }
            }
            float mxa = __builtin_fmaxf(__builtin_fmaxf(p0[0], p0[1]), p1[0]), mxb = __builtin_fmaxf(__builtin_fmaxf(p0[2], p0[3]), p1[1]);
            mxa = __builtin_fmaxf(__builtin_fmaxf(mxa, p1[2]), p1[3]);
#pragma unroll
            for (int r = 4; r < 16; r += 4) { mxa = __builtin_fmaxf(__builtin_fmaxf(mxa, p0[r]), p0[r + 1]); mxb = __builtin_fmaxf(__builtin_fmaxf(mxb, p0[r + 2]), p0[r + 3]);
                mxa = __builtin_fmaxf(__builtin_fmaxf(mxa, p1[r]), p1[r + 1]); mxb = __builtin_fmaxf(__builtin_fmaxf(mxb, p1[r + 2]), p1[r + 3]); }
            float mx = __builtin_fmaxf(mxa, mxb);
            mx = __builtin_fmaxf(mx, __shfl_xor(mx, 32));
            const bool first = (MODE == 2) && (t == 0);
            if (first || __any(mx > THR)) {
                const float delta = first ? mx : __builtin_fmaxf(mx, 0.f), alpha = first ? 1.f : __builtin_amdgcn_exp2f(-delta);
                mref += delta; l_run *= alpha;
#pragma unroll
                for (int r = 0; r < 16; ++r) { o0[r] *= alpha; o1[r] *= alpha; p0[r] -= delta; p1[r] -= delta; negm[r] = -mref; }
            }
            float rs0 = 0.f, rs1 = 0.f;
#pragma unroll
            for (int r = 0; r < 16; ++r) { p0[r] = __builtin_amdgcn_exp2f(p0[r]); p1[r] = __builtin_amdgcn_exp2f(p1[r]); rs0 += p0[r]; rs1 += p1[r]; }
            l_run += rs0 + rs1;
            u32x4 pw[4];
            pw[0] = (u32x4){pk2(p0[0], p0[1]), pk2(p0[2], p0[3]), pk2(p0[4], p0[5]), pk2(p0[6], p0[7])};
            pw[1] = (u32x4){pk2(p0[8], p0[9]), pk2(p0[10], p0[11]), pk2(p0[12], p0[13]), pk2(p0[14], p0[15])};
            pw[2] = (u32x4){pk2(p1[0], p1[1]), pk2(p1[2], p1[3]), pk2(p1[4], p1[5]), pk2(p1[6], p1[7])};
            pw[3] = (u32x4){pk2(p1[8], p1[9]), pk2(p1[10], p1[11]), pk2(p1[12], p1[13]), pk2(p1[14], p1[15])};
#pragma unroll
            for (int s2 = 0; s2 < 4; ++s2) {
                const bf16x8 pb = __builtin_bit_cast(bf16x8, pw[s2]);
                const LAS unsigned char* va0 = vb + (16 * s2) * VS + voff;
                const s16x4 l0 = vtr(va0), h0 = vtr(va0 + 8 * VS), l1 = vtr(va0 + 64), h1 = vtr(va0 + 8 * VS + 64);
                const bf16x8 v0 = (bf16x8){l0[0], l0[1], l0[2], l0[3], h0[0], h0[1], h0[2], h0[3]};
                const bf16x8 v1 = (bf16x8){l1[0], l1[1], l1[2], l1[3], h1[0], h1[1], h1[2], h1[3]};
                o0 = __builtin_amdgcn_mfma_f32_32x32x16_bf16(v0, pb, o0, 0, 0, 0);
                o1 = __builtin_amdgcn_mfma_f32_32x32x16_bf16(v1, pb, o1, 0, 0, 0);
            }
        }
        if (t + 1 < nt) ATT_STORE(buf ^ 1);
        __syncthreads();
    }
#undef ATT_SRC
#undef ATT_LOAD
#undef ATT_STORE
    const float l_tot = l_run + __shfl_xor(l_run, 32), inv = __builtin_amdgcn_rcpf(l_tot);
    const int Rq = Rq0 + r32;
    const bf16_t* zrow = (MODE == 2) ? (const bf16_t*)(aux + AUX_ZO) + (size_t)Rq * 512 + head * 64 : (const bf16_t*)(ws + WS_ZA) + (size_t)Rq * 512 + head * 64;
    bf16_t* urow = (bf16_t*)(ws + WS_U) + (size_t)Rq * 1024 + head * 64;
#pragma unroll
    for (int g = 0; g < 4; ++g) {
        const int dv = 8 * g + 4 * hi;
        { const u32x2 z = *(const u32x2*)(zrow + dv);
          u32x2 w; w.x = pk2(o0[4 * g] * inv * bf_lo(z.x), o0[4 * g + 1] * inv * bf_hi(z.x)); w.y = pk2(o0[4 * g + 2] * inv * bf_lo(z.y), o0[4 * g + 3] * inv * bf_hi(z.y));
          *(u32x2*)(urow + dv) = w; }
        { const u32x2 z = *(const u32x2*)(zrow + 32 + dv);
          u32x2 w; w.x = pk2(o1[4 * g] * inv * bf_lo(z.x), o1[4 * g + 1] * inv * bf_hi(z.x)); w.y = pk2(o1[4 * g + 2] * inv * bf_lo(z.y), o1[4 * g + 3] * inv * bf_hi(z.y));
          *(u32x2*)(urow + 32 + dv) = w; }
    }
}


__device__ __forceinline__ int srcmap(int mat, int dn) {
    if (mat == 0) {
        if (dn < 128) { const int d = dn & 63; return (dn & 64) + (d >> 1) + 32 * (d & 1); }
        if (dn < 256) return dn;
        if (dn < 768) { const int j = dn - 256, d = j & 63; return 256 + (j & ~63) + (d >> 1) + 32 * (d & 1); }
        if (dn < 1792) { const int j = dn - 768, blk = j >> 8, w = j & 255; return (w < 128) ? 1280 + blk * 128 + w : 1792 + blk * 128 + (w - 128); }
        if (dn < 2816) { const int j = dn - 1792, blk = j >> 8, w = j & 255; return (w < 128) ? 768 + blk * 128 + w : 2816 + blk * 128 + (w - 128); }
        return 2304 + (dn - 2816);
    }
    if (mat == 2) {
        if (dn < 256) return dn;
        if (dn < 512) return 288 + (dn - 256);
        if (dn < 1024) return 544 + (dn - 512);
        if (dn < 1280) { const int w = dn - 1024; if (w < 32) return 256 + (w >> 1) + 16 * (w & 1); if (w < 48) return 1056 + (w - 32); return -1; }
        if (dn < 2048) return 1072 + (dn - 1280);
        if (dn < 2304) return 1840 + (dn - 2048);
        if (dn < 3328) { const int j = dn - 2304, blk = j >> 8, w = j & 255; return (w < 128) ? 2096 + blk * 128 + w : 2608 + 512 + blk * 128 + (w - 128); }
        return 2608 + (dn - 3328);
    }
    if (mat == 3) {
        const int head = dn / 96, d = dn - head * 96; if (d < 64) return dn; const int w = d - 64; return head * 96 + 64 + (w >> 1) + 16 * (w & 1);
    }
    return dn;
}
__device__ __forceinline__ void p0_transpose_item(const float* W, int K, int Nsrc, bf16_t* WT, int mat, const float* kscale, LAS float* scr, int item, int nblk, int lane) {
    const int kb = item / nblk, nb = item % nblk, k0 = 64 * kb, n0 = 32 * nb;
    const int sc = srcmap(mat, n0 + (lane & 31));
#pragma unroll 8
    for (int i = 0; i < 32; ++i) { const int kk = 2 * i + (lane >> 5); float v = 0.f; if (sc >= 0) v = W[(size_t)(k0 + kk) * Nsrc + sc]; if (kscale) v *= kscale[k0 + kk]; scr[kk * 33 + (lane & 31)] = v; }
    LDS_WAIT(); asm volatile("" ::: "memory");
    const int c = lane & 7;
#pragma unroll
    for (int j = 0; j < 4; ++j) { const int n = (lane >> 3) + 8 * j; const LAS float* s = scr + (8 * c) * 33 + n;
        u32x4 o; o.x = pk2(s[0 * 33], s[1 * 33]); o.y = pk2(s[2 * 33], s[3 * 33]); o.z = pk2(s[4 * 33], s[5 * 33]); o.w = pk2(s[6 * 33], s[7 * 33]);
        *(u32x4*)(WT + (size_t)(n0 + n) * K + k0 + 8 * c) = o; }
    LDS_WAIT(); asm volatile("" ::: "memory");
}

__device__ __forceinline__ void p0_mod(LAS unsigned char* lds, const float* c, const float* c_ctx, const float* mod_w, const float* mod_b, float* MOD, int G) {
    const int tid = my_tid();
    if ((int)blockIdx.x >= 96) return;
    LAS float* scs = (LAS float*)lds;
    LAS float* red = (LAS float*)(lds + 1024 * 20 * 4);
    for (int idx = tid; idx < 17 * 1024; idx += NTHREADS) { const int r = idx >> 10, k = idx & 1023; const float v = (r < 16) ? c[r * 1024 + k] : c_ctx[k]; scs[k * 20 + r] = silu_f(v); }
    __syncthreads();
    for (int item = blockIdx.x; item < 96; item += G) {
        const int l = item / 48, n0 = (item % 48) * 64, col = tid & 63, kg = tid >> 6;
        float acc[20];
#pragma unroll
        for (int r = 0; r < 20; ++r) acc[r] = 0.f;
        const float* wp = mod_w + ((size_t)l * 1024 + kg * 128) * 3072 + n0 + col;
#pragma unroll 4
        for (int kk = 0; kk < 128; ++kk) {
            const float w = wp[(size_t)kk * 3072]; const LAS f32x4* sp = (const LAS f32x4*)(scs + (kg * 128 + kk) * 20);
#pragma unroll
            for (int q = 0; q < 5; ++q) { const f32x4 s = sp[q]; acc[4 * q] += s[0] * w; acc[4 * q + 1] += s[1] * w; acc[4 * q + 2] += s[2] * w; acc[4 * q + 3] += s[3] * w; }
        }
#pragma unroll
        for (int r = 0; r < 17; ++r) red[(kg * 17 + r) * 64 + col] = acc[r];
        __syncthreads();
        for (int o = tid; o < 17 * 64; o += NTHREADS) { const int r = o >> 6, cc = o & 63; float s = mod_b[l * 3072 + n0 + cc];
#pragma unroll
            for (int g = 0; g < 8; ++g) s += red[(g * 17 + r) * 64 + cc];
            MOD[((size_t)l * 17 + r) * 3072 + n0 + cc] = s; }
        __syncthreads();
    }
}

__device__ __forceinline__ void norm_mod_store(const f32x4 (&v)[4], const float* pre_w, const float* modrow, bf16_t* hrow, int lane) {
    float ss = 0.f;
#pragma unroll
    for (int j = 0; j < 4; ++j) ss += sq4(v[j]);
    const float rstd = rsqrtf(wave_sum(ss) * (1.f / 1024.f) + EPS);
#pragma unroll
    for (int j = 0; j < 4; ++j) { const int k = 4 * (lane + 64 * j);
        const f32x4 w = *(const f32x4*)(pre_w + k), sh = *(const f32x4*)(modrow + k), sc = *(const f32x4*)(modrow + 1024 + k);
        const f32x4 h = v[j] * rstd * w * (sc + 1.0f) + sh;
        u32x2 o; o.x = pk2(h[0], h[1]); o.y = pk2(h[2], h[3]); *(u32x2*)(hrow + k) = o; }
}
__device__ __forceinline__ void p1_prenorm(const float* x, const float* ctx, const float* pre_w, const float* MOD, bf16_t* H, int gw, int ngw, int lane) {
    for (int R = gw; R < MT; R += ngw) {
        const float* src = (R < ML) ? x + (size_t)R * 1024 : ctx + (size_t)(R - ML) * 1024; const int bi = (R < ML) ? (R >> 11) : 16;
        f32x4 v[4];
#pragma unroll
        for (int j = 0; j < 4; ++j) v[j] = *(const f32x4*)(src + 4 * (lane + 64 * j));
        norm_mod_store(v, pre_w, MOD + (size_t)bi * 3072, H + (size_t)R * 1024, lane);
    }
}
__device__ __forceinline__ float ssq16(const float* p) {
    const f32x4 a = *(const f32x4*)p, b = *(const f32x4*)(p + 4), c = *(const f32x4*)(p + 8), d = *(const f32x4*)(p + 12);
    return (((a[0] + a[1]) + (a[2] + a[3])) + ((b[0] + b[1]) + (b[2] + b[3]))) + (((c[0] + c[1]) + (c[2] + c[3])) + ((d[0] + d[1]) + (d[2] + d[3])));
}
__device__ __forceinline__ void p5_post_pre(const float* x, const float* ctx, const float* post_w0, const float* pre_w1, const float* MOD, const bf16_t* Y, const float* SSQ, bf16_t* X1, bf16_t* H, int gw, int ngw, int lane) {
    for (int R = gw; R < MT; R += ngw) {
        const float* src = (R < ML) ? x + (size_t)R * 1024 : ctx + (size_t)(R - ML) * 1024; const int bi = (R < ML) ? (R >> 11) : 16;
        const float rstd_y = rsqrtf(ssq16(SSQ + (size_t)R * 16) * (1.f / 1024.f) + EPS);
        const float* m0 = MOD + (size_t)bi * 3072;
        f32x4 v[4];
#pragma unroll
        for (int j = 0; j < 4; ++j) { const int k = 4 * (lane + 64 * j);
            const u32x2 yy = *(const u32x2*)(Y + (size_t)R * 1024 + k); const f32x4 y = (f32x4){bf_lo(yy.x), bf_hi(yy.x), bf_lo(yy.y), bf_hi(yy.y)};
            const f32x4 g = *(const f32x4*)(m0 + 2048 + k), pw = *(const f32x4*)(post_w0 + k), xv = *(const f32x4*)(src + k);
            v[j] = xv + g * (y * rstd_y * pw);
            if (R < ML) { u32x2 o; o.x = pk2(v[j][0], v[j][1]); o.y = pk2(v[j][2], v[j][3]); *(u32x2*)(X1 + (size_t)R * 1024 + k) = o; } }
        norm_mod_store(v, pre_w1, MOD + (size_t)(17 + bi) * 3072, H + (size_t)R * 1024, lane);
    }
}
__device__ __forceinline__ void p11_final(const float* post_w1, const float* MOD, const bf16_t* Y, const float* SSQ, const bf16_t* X1, float* out, int gw, int ngw, int lane) {
    for (int R = gw; R < ML; R += ngw) {
        const float rstd_y = rsqrtf(ssq16(SSQ + (size_t)R * 16) * (1.f / 1024.f) + EPS);
        const float* m1 = MOD + (size_t)(17 + (R >> 11)) * 3072;
#pragma unroll
        for (int j = 0; j < 4; ++j) { const int k = 4 * (lane + 64 * j);
            const u32x2 yy = *(const u32x2*)(Y + (size_t)R * 1024 + k); const f32x4 y = (f32x4){bf_lo(yy.x), bf_hi(yy.x), bf_lo(yy.y), bf_hi(yy.y)};
            const u32x2 xx = *(const u32x2*)(X1 + (size_t)R * 1024 + k);
            const f32x4 g = *(const f32x4*)(m1 + 2048 + k), pw = *(const f32x4*)(post_w1 + k), xv = (f32x4){bf_lo(xx.x), bf_hi(xx.x), bf_lo(xx.y), bf_hi(xx.y)};
            *(f32x4*)(out + (size_t)R * 1024 + k) = xv + g * (y * rstd_y * pw); }
    }
}
__device__ __forceinline__ void p3_conv(unsigned char* ws, const float* conv_w, int gtid, int ngt) {
    const bf16_t* PE = (const bf16_t*)(ws + WS_PE); const bf16_t* GE = (const bf16_t*)(ws + WS_GE); bf16_t* U = (bf16_t*)(ws + WS_U);
    for (int it = gtid; it < MT * 64; it += ngt) {
        const int R = it >> 6, ch = (it & 63) * 8;
        int t, T; if (R < ML) { t = R & 2047; T = 2048; } else { t = (R - ML) & 255; T = 256; }
        const u32x4 z4 = (u32x4){0u, 0u, 0u, 0u};
        const u32x4 pc = *(const u32x4*)(PE + (size_t)R * 512 + ch);
        const u32x4 pm = (t > 0) ? *(const u32x4*)(PE + (size_t)(R - 1) * 512 + ch) : z4;
        const u32x4 pp = (t < T - 1) ? *(const u32x4*)(PE + (size_t)(R + 1) * 512 + ch) : z4;
        const u32x4 g = *(const u32x4*)(GE + (size_t)R * 512 + ch);
        const f32x4 w0a = *(const f32x4*)(conv_w + ch), w0b = *(const f32x4*)(conv_w + ch + 4), w1a = *(const f32x4*)(conv_w + 512 + ch), w1b = *(const f32x4*)(conv_w + 512 + ch + 4),
                    w2a = *(const f32x4*)(conv_w + 1024 + ch), w2b = *(const f32x4*)(conv_w + 1024 + ch + 4);
        u32x4 o;
#define CV(pmw, pcw, ppw, gw_, wa, wb, wc_, e0, e1) pk2(bf_lo(gw_) * (wa[e0] * bf_lo(pmw) + wb[e0] * bf_lo(pcw) + wc_[e0] * bf_lo(ppw)), bf_hi(gw_) * (wa[e1] * bf_hi(pmw) + wb[e1] * bf_hi(pcw) + wc_[e1] * bf_hi(ppw)))
        o.x = CV(pm.x, pc.x, pp.x, g.x, w0a, w1a, w2a, 0, 1); o.y = CV(pm.y, pc.y, pp.y, g.y, w0a, w1a, w2a, 2, 3);
        o.z = CV(pm.z, pc.z, pp.z, g.z, w0b, w1b, w2b, 0, 1); o.w = CV(pm.w, pc.w, pp.w, g.w, w0b, w1b, w2b, 2, 3);
#undef CV
        *(u32x4*)(U + (size_t)R * 1024 + 512 + ch) = o;
    }
}
__device__ __forceinline__ void p9_readout(unsigned char* ws, unsigned char* aux, const float* hn_w, int gw, int ngw, int lane) {
    const bf16_t* HM = (const bf16_t*)(ws + WS_HM); const bf16_t* MO = (const bf16_t*)(aux + AUX_MO); bf16_t* U = (bf16_t*)(ws + WS_U);
    for (int R = gw; R < ML; R += ngw) {
        const int ch = 8 * lane;
        const u32x4 h0 = *(const u32x4*)(HM + (size_t)R * 512 + ch), h1 = *(const u32x4*)(HM + ((size_t)ML + R) * 512 + ch);
        float hs[8] = {bf_lo(h0.x) + bf_lo(h1.x), bf_hi(h0.x) + bf_hi(h1.x), bf_lo(h0.y) + bf_lo(h1.y), bf_hi(h0.y) + bf_hi(h1.y),
                       bf_lo(h0.z) + bf_lo(h1.z), bf_hi(h0.z) + bf_hi(h1.z), bf_lo(h0.w) + bf_lo(h1.w), bf_hi(h0.w) + bf_hi(h1.w)};
        float ss = 0.f;
#pragma unroll
        for (int e = 0; e < 8; ++e) ss += hs[e] * hs[e];
        ss += __shfl_xor(ss, 1); ss += __shfl_xor(ss, 2); ss += __shfl_xor(ss, 4); ss += __shfl_xor(ss, 8);
        const float rstd = rsqrtf(ss * (1.f / 128.f) + EPS);
        const u32x4 mo = *(const u32x4*)(MO + (size_t)R * 512 + ch);
        const f32x4 wa = *(const f32x4*)(hn_w + ch), wb = *(const f32x4*)(hn_w + ch + 4);
        u32x4 o;
        o.x = pk2(hs[0] * rstd * wa[0] * bf_lo(mo.x), hs[1] * rstd * wa[1] * bf_hi(mo.x));
        o.y = pk2(hs[2] * rstd * wa[2] * bf_lo(mo.y), hs[3] * rstd * wa[3] * bf_hi(mo.y));
        o.z = pk2(hs[4] * rstd * wb[0] * bf_lo(mo.z), hs[5] * rstd * wb[1] * bf_hi(mo.z));
        o.w = pk2(hs[6] * rstd * wb[2] * bf_lo(mo.w), hs[7] * rstd * wb[3] * bf_hi(mo.w));
        *(u32x4*)(U + (size_t)R * 1024 + 512 + ch) = o;
    }
}


typedef float f32x4v __attribute__((ext_vector_type(4)));
#define LDS_BARRIER() do { asm volatile("s_waitcnt lgkmcnt(0)" ::: "memory"); __builtin_amdgcn_s_barrier(); asm volatile("" ::: "memory"); } while (0)
#define MFMA_FENCE(x) do { __builtin_amdgcn_sched_barrier(0); asm volatile("s_nop 15\n\ts_nop 15" : "+v"(x)); __builtin_amdgcn_sched_barrier(0); } while (0)
__device__ __forceinline__ bf16x8 tr8(const LAS unsigned char* p, int halfstride) {
    const s16x4 lo = vtr(p), hi = vtr(p + halfstride);
    return (bf16x8){lo[0], lo[1], lo[2], lo[3], hi[0], hi[1], hi[2], hi[3]};
}
__device__ __forceinline__ bf16x8 gather8(const LAS unsigned char* img, int stride, int row0, int col) {
    bf16x8 r;
#pragma unroll
    for (int e = 0; e < 8; ++e) r[e] = *(const LAS short*)(img + (row0 + e) * stride + col * 2);
    return r;
}
template <int CTRL, int RM> __device__ __forceinline__ float dppf(float oldv, float v) {
    return __int_as_float(__builtin_amdgcn_update_dpp(__float_as_int(oldv), __float_as_int(v), CTRL, RM, 0xf, false));
}
__device__ __forceinline__ float wave_scan_add(float v) {
    v += dppf<0x111, 0xf>(0.f, v); v += dppf<0x112, 0xf>(0.f, v); v += dppf<0x114, 0xf>(0.f, v); v += dppf<0x118, 0xf>(0.f, v);
    v += dppf<0x142, 0xa>(0.f, v); v += dppf<0x143, 0xc>(0.f, v);
    return v;
}
__device__ __forceinline__ float wave_scan_max(float v) {
    const float ninf = -INFINITY;
    v = fmaxf(v, dppf<0x111, 0xf>(ninf, v)); v = fmaxf(v, dppf<0x112, 0xf>(ninf, v)); v = fmaxf(v, dppf<0x114, 0xf>(ninf, v)); v = fmaxf(v, dppf<0x118, 0xf>(ninf, v));
    v = fmaxf(v, dppf<0x142, 0xa>(ninf, v)); v = fmaxf(v, dppf<0x143, 0xc>(ninf, v));
    return v;
}
template <bool DUMMY> __device__ __forceinline__ void mlstm_chain_mfma(LAS unsigned char* lds, unsigned char* ws, unsigned char* aux, const float* i_bias, const float* f_bias, int chain) {
    constexpr int RS = 144, VS = 176;
    constexpr int QI = 0, KI = 9216, SC = 18432, CI = 27648, VI = 39168, VW = 50432, VEC = 61696;
    const int tid = my_tid(), lane = tid & 63, wid = __builtin_amdgcn_readfirstlane(tid >> 6), l15 = lane & 15, kg = lane >> 4;
    const int vh = chain & 1, d = (chain >> 1) & 1, h = (chain >> 2) & 3, b = chain >> 4;
    LAS float* vb_ = (LAS float*)(lds + VEC); LAS float* vab = vb_ + 64; LAS float* vcm = vab + 64; LAS float* vwp = vcm + 64; LAS float* vsc = vwp + 64;
    const bf16_t* MK = (const bf16_t*)(ws + WS_MK); const bf16_t* MV = (const bf16_t*)(ws + WS_MV); const bf16_t* MQ = (const bf16_t*)(aux + AUX_MQ);
    const float* GT = (const float*)(ws + WS_GATES); bf16_t* HM = (bf16_t*)(ws + WS_HM);
    const float ib = i_bias[d * 4 + h], fb = f_bias[d * 4 + h];
    for (int idx = tid; idx < 80 * RS / 4; idx += NTHREADS) ((LAS unsigned*)(lds + CI))[idx] = 0u;
    if (tid < 64) { LAS unsigned* a = (LAS unsigned*)(lds + VI + tid * VS + 128); LAS unsigned* w = (LAS unsigned*)(lds + VW + tid * VS + 128);
#pragma unroll
        for (int e = 0; e < 8; ++e) { a[e] = (e == 0) ? 0x3F80u : 0u; w[e] = 0u; } }
    const int it = wid & 3, vg = wid >> 2;
    f32x4v cacc[3];
#pragma unroll
    for (int t = 0; t < 3; ++t) cacc[t] = (f32x4v){0.f, 0.f, 0.f, 0.f};
    float mst = 0.f;
    unsigned nbad = 0u;
    const int srow = tid >> 3, sch = tid & 7;
    const int q4 = l15 >> 2, p4 = l15 & 3;
    u32x4 kkN, vvN, qqN = (u32x4){0u, 0u, 0u, 0u}; float liN = 0.f, fpN = 0.f;
#define MLSTM_LOADS(S_) do { const bool lat_ = (S_) >= 4; const int c_ = lat_ ? (S_) - 4 : (S_), T_ = lat_ ? 2048 : 256, rowb_ = lat_ ? b * 2048 : ML + b * 256; \
        const int tok_ = (d == 0) ? 64 * c_ + srow : T_ - 1 - (64 * c_ + srow); const size_t R_ = (size_t)(rowb_ + tok_); \
        kkN = *(const u32x4*)(MK + R_ * 256 + h * 64 + sch * 8); vvN = *(const u32x4*)(MV + R_ * 512 + h * 128 + vh * 64 + sch * 8); \
        if (lat_) qqN = *(const u32x4*)(MQ + R_ * 256 + h * 64 + sch * 8); \
        if (wid == 0) { const int tk_ = (d == 0) ? 64 * c_ + lane : T_ - 1 - (64 * c_ + lane); const float* gp_ = GT + (size_t)(rowb_ + tk_) * 16 + d * 8 + h; liN = gp_[0]; fpN = gp_[4]; } } while (0)
    MLSTM_LOADS(0);
    for (int step = 0; step < 36; ++step) {
        const bool lat = step >= 4; const int c = lat ? step - 4 : step, T = lat ? 2048 : 256, rowb = lat ? b * 2048 : ML + b * 256;
        const int tok = (d == 0) ? 64 * c + srow : T - 1 - (64 * c + srow); const size_t R = (size_t)(rowb + tok);
        const u32x4 kk = kkN, vv = vvN, qq = qqN;
        if (wid == 0) {
            const float li = liN + ib, fp = fpN + fb;
            const float lf = fminf(fp, 0.f) - __logf(1.f + __expf(-fabsf(fp)));
            const float bc = wave_scan_add(lf);
            const float ab = li - bc; const float cm = wave_scan_max(ab);
            const float g = __int_as_float(__builtin_amdgcn_readlane(__float_as_int(bc), 63)), mloc = g + __int_as_float(__builtin_amdgcn_readlane(__float_as_int(cm), 63)), m_new = fmaxf(g + mst, mloc);
            vb_[lane] = bc; vab[lane] = ab; vcm[lane] = cm; vwp[lane] = __expf(g + ab - m_new);
            if (lane == 0) { vsc[0] = mst; vsc[1] = __expf(g + mst - m_new); }
            mst = m_new;
        }
        LDS_BARRIER();
        { const float wj = vwp[srow];
          *(LAS u32x4*)(lds + KI + srow * RS + sch * 16) = kk;
          *(LAS u32x4*)(lds + VI + srow * VS + sch * 16) = vv;
          u32x4 vw; vw.x = pk2(bf_lo(vv.x) * wj, bf_hi(vv.x) * wj); vw.y = pk2(bf_lo(vv.y) * wj, bf_hi(vv.y) * wj); vw.z = pk2(bf_lo(vv.z) * wj, bf_hi(vv.z) * wj); vw.w = pk2(bf_lo(vv.w) * wj, bf_hi(vv.w) * wj);
          *(LAS u32x4*)(lds + VW + srow * VS + sch * 16) = vw;
          if (sch == 0) *(LAS unsigned short*)(lds + VW + srow * VS + 128) = f2bf(wj);
          if (lat) *(LAS u32x4*)(lds + QI + srow * RS + sch * 16) = qq; }
        LDS_BARRIER();
        const float m_in = vsc[0], a_prev = vsc[1];
        if (step + 1 < 36) MLSTM_LOADS(step + 1);
        bf16x8 qf[2];
        if (lat) {
            qf[0] = *(const LAS bf16x8*)(lds + QI + (16 * it + l15) * RS + (8 * kg) * 2); qf[1] = *(const LAS bf16x8*)(lds + QI + (16 * it + l15) * RS + (8 * kg + 32) * 2);
            const int i = 16 * it + l15; const float mi = fmaxf(m_in, vcm[i]);
#pragma unroll
            for (int t = 0; t < 2; ++t) {
                const int jt = 2 * vg + t; u32x2 o = (u32x2){0u, 0u};
                if (jt <= it) {
                    const bf16x8 k0 = *(const LAS bf16x8*)(lds + KI + (16 * jt + l15) * RS + (8 * kg) * 2), k1 = *(const LAS bf16x8*)(lds + KI + (16 * jt + l15) * RS + (8 * kg + 32) * 2);
                    f32x4v s = (f32x4v){0.f, 0.f, 0.f, 0.f};
                    s = __builtin_amdgcn_mfma_f32_16x16x32_bf16(k0, qf[0], s, 0, 0, 0); s = __builtin_amdgcn_mfma_f32_16x16x32_bf16(k1, qf[1], s, 0, 0, 0); MFMA_FENCE(s);
                    const int j0 = 16 * jt + 4 * kg; const f32x4v abv = *(const LAS f32x4v*)(vab + j0);
                    float e[4];
#pragma unroll
                    for (int r = 0; r < 4; ++r) e[r] = (j0 + r <= i) ? s[r] * __expf(abv[r] - mi) : 0.f;
                    o.x = pk2(e[0], e[1]); o.y = pk2(e[2], e[3]);
                }
                *(LAS u32x2*)(lds + SC + i * RS + (16 * jt + 4 * kg) * 2) = o;
            }
        }
        LDS_BARRIER();
        f32x4v cnew[3];
        { bf16x8 aK[2];
#pragma unroll
          for (int s = 0; s < 2; ++s) aK[s] = tr8(lds + KI + (32 * s + 8 * kg + q4) * RS + (16 * it + 4 * p4) * 2, 4 * RS);
#pragma unroll
          for (int t = 0; t < 3; ++t) { const int vt = (t == 2) ? 4 : 2 * t + vg; f32x4v a = cacc[t] * a_prev;
#pragma unroll
              for (int s = 0; s < 2; ++s) { const bf16x8 bW = tr8(lds + VW + (32 * s + 8 * kg + q4) * VS + (16 * vt + 4 * p4) * 2, 4 * VS); a = __builtin_amdgcn_mfma_f32_16x16x32_bf16(aK[s], bW, a, 0, 0, 0); }
              MFMA_FENCE(a); cnew[t] = a; } }
        if (lat) {
            const int i0 = 16 * it + 4 * kg; const f32x4v cmv = *(const LAS f32x4v*)(vcm + i0), bv = *(const LAS f32x4v*)(vb_ + i0);
            float wi[4], mt[4];
#pragma unroll
            for (int r = 0; r < 4; ++r) { const float mi = fmaxf(m_in, cmv[r]); wi[r] = __expf(m_in - mi); mt[r] = bv[r] + mi; }
            bf16x8 aS[2];
            aS[0] = *(const LAS bf16x8*)(lds + SC + (16 * it + l15) * RS + (8 * kg) * 2); aS[1] = *(const LAS bf16x8*)(lds + SC + (16 * it + l15) * RS + (8 * kg + 32) * 2);
            f32x4v nacc[3];
#pragma unroll
            for (int t = 0; t < 3; ++t) { const int vt = (t == 2) ? 4 : 2 * t + vg; f32x4v a = (f32x4v){0.f, 0.f, 0.f, 0.f};
#pragma unroll
                for (int s = 0; s < 2; ++s) { const bf16x8 bC = *(const LAS bf16x8*)(lds + CI + (16 * vt + l15) * RS + (8 * kg + 32 * s) * 2); a = __builtin_amdgcn_mfma_f32_16x16x32_bf16(qf[s], bC, a, 0, 0, 0); }
                MFMA_FENCE(a);
#pragma unroll
                for (int r = 0; r < 4; ++r) a[r] *= wi[r];
#pragma unroll
                for (int s = 0; s < 2; ++s) { const bf16x8 bV = tr8(lds + VI + (32 * s + 8 * kg + q4) * VS + (16 * vt + 4 * p4) * 2, 4 * VS); a = __builtin_amdgcn_mfma_f32_16x16x32_bf16(aS[s], bV, a, 0, 0, 0); }
                MFMA_FENCE(a); nacc[t] = a; }
            float inv[4];
#pragma unroll
            for (int r = 0; r < 4; ++r) { const float den = __shfl(nacc[2][r], lane & 48); inv[r] = 1.f / fmaxf(fabsf(den), __expf(-mt[r])); }
#pragma unroll
            for (int t = 0; t < 2; ++t) { const int vt = 2 * t + vg;
#pragma unroll
                for (int r = 0; r < 4; ++r) *(LAS unsigned short*)(lds + QI + (i0 + r) * RS + (16 * vt + l15) * 2) = f2bf(nacc[t][r] * inv[r]); }
        }
        LDS_BARRIER();
        if (lat) { const u32x4 hv = *(const LAS u32x4*)(lds + QI + srow * RS + sch * 16);
            if (DUMMY) { const u32x4 rv = *(const u32x4*)(HM + ((size_t)d * ML + R) * 512 + h * 128 + vh * 64 + sch * 8);
#define CMPH(a_, b_) do { const float x_ = (a_), y_ = (b_); if (fabsf(x_ - y_) > 0.05f * fmaxf(fabsf(x_), fabsf(y_)) + 0.02f) ++nbad; } while (0)
                CMPH(bf_lo(hv.x), bf_lo(rv.x)); CMPH(bf_hi(hv.x), bf_hi(rv.x)); CMPH(bf_lo(hv.y), bf_lo(rv.y)); CMPH(bf_hi(hv.y), bf_hi(rv.y));
                CMPH(bf_lo(hv.z), bf_lo(rv.z)); CMPH(bf_hi(hv.z), bf_hi(rv.z)); CMPH(bf_lo(hv.w), bf_lo(rv.w)); CMPH(bf_hi(hv.w), bf_hi(rv.w));
#undef CMPH
            } else *(u32x4*)(HM + ((size_t)d * ML + R) * 512 + h * 128 + vh * 64 + sch * 8) = hv; }
#pragma unroll
        for (int t = 0; t < 3; ++t) { cacc[t] = cnew[t]; const int vt = (t == 2) ? 4 : 2 * t + vg;
            if (t < 2 || wid < 4) { u32x2 o; o.x = pk2(cnew[t][0], cnew[t][1]); o.y = pk2(cnew[t][2], cnew[t][3]); *(LAS u32x2*)(lds + CI + (16 * vt + l15) * RS + (16 * it + 4 * kg) * 2) = o; } }
    }
#undef MLSTM_LOADS
    if (DUMMY) atomicAdd((unsigned*)(ws + WS_CTL) + 64, nbad);
    __syncthreads();
}


#ifndef MK_N_LAUNCHES
#define MK_N_LAUNCHES 1
#endif
constexpr int N_PHASES = 12;
constexpr int LDS_BYTES = 147456;
constexpr int RING_BYTES = 131072, MISC_OFF = RING_BYTES + 320;
constexpr int CW_BAR = 4096;

struct Args { const float* in[21]; float* out; unsigned char* ws; int ph_lo, ph_hi; };

__global__ void __launch_bounds__(NTHREADS, 2) hybrid_fwd(Args args) {
    extern __shared__ __attribute__((aligned(16))) unsigned char lds_raw[];
    LAS unsigned char* lds = (LAS unsigned char*)lds_raw;
    const int G = gridDim.x, bx = blockIdx.x;
    const int vcu = (G % 8 == 0) ? (bx % 8) * (G / 8) + bx / 8 : bx;
    typedef const __attribute__((address_space(4))) Args* ArgsP;
    ArgsP AP = (ArgsP)__builtin_amdgcn_kernarg_segment_ptr();
    asm volatile("" : "+s"(AP));
    unsigned char* ws = AP->ws;
#define I_x AP->in[0]
#define I_cvec AP->in[1]
#define I_ctx AP->in[2]
#define I_c_ctx AP->in[3]
#define I_mod_w AP->in[4]
#define I_mod_b AP->in[5]
#define I_pre_w AP->in[6]
#define I_post_w AP->in[7]
#define I_e_w_in AP->in[8]
#define I_e_sink AP->in[9]
#define I_e_conv_w AP->in[10]
#define I_e_w_out AP->in[11]
#define I_o_w_in AP->in[12]
#define I_o_qn AP->in[13]
#define I_o_kvn AP->in[14]
#define I_o_w_uq AP->in[15]
#define I_o_w_ukv AP->in[16]
#define I_o_ib AP->in[17]
#define I_o_fb AP->in[18]
#define I_o_hn AP->in[19]
#define I_o_w_out AP->in[20]
#define I_out AP->out
    float* MOD = (float*)(ws + WS_MOD);

    for (int u = threadIdx.x; u < (LDS_BYTES - RING_BYTES) / 4; u += NTHREADS) ((LAS unsigned*)(lds + RING_BYTES))[u] = 0u;
    __syncthreads();
    XcdBarrier bar; bar.bar = (unsigned*)(ws + WS_CTL) + CW_BAR; bar.x = 0; bar.st = nullptr;
    if (MK_N_LAUNCHES == 1) bar = xcd_barrier_post((unsigned*)(ws + WS_CTL) + CW_BAR, (volatile LAS unsigned*)(lds + MISC_OFF) + 8);
    const int lo = AP->ph_lo, hi = AP->ph_hi;
#ifndef PROBE_REP
#define PROBE_REP 0
#endif
#define NREP(k) ((((PROBE_REP) >> (k)) & 1) ? 2 : 1)
#ifndef PHASE_MASK
#define PHASE_MASK 0xFFF
#endif
#define IN(k) (((PHASE_MASK >> (k)) & 1) && lo <= (k) && (k) < hi)
#ifndef PROBE_DBLBAR
#define PROBE_DBLBAR 0
#endif
#define SEAM(k) do { if (MK_N_LAUNCHES == 1 && IN((k) + 1)) { xcd_barrier(bar); if (PROBE_DBLBAR) xcd_barrier(bar); } } while (0)
    const int ngw = G * NWAVES;
#define PH_IDS const int tid = my_tid(), lane = tid & 63, wave = __builtin_amdgcn_readfirstlane(tid >> 6), gw = vcu * NWAVES + wave; (void)lane; (void)gw

    if (IN(0)) { asm volatile("" : "+s"(AP)); PH_IDS;
        for (int rep_ = 0; rep_ < NREP(0); ++rep_) { if (rep_) __syncthreads();
        p0_mod(lds, I_cvec, I_c_ctx, I_mod_w, I_mod_b, MOD, G);
        __syncthreads();
        LAS float* scr = (LAS float*)(lds + wave * 16384);
        constexpr int I0 = 16 * (E_N / 32), I1 = 16 * 32, I2 = 16 * (O_N / 32), I3 = 12 * 24, I4 = 4 * 32, I5 = 16 * 32, NIT = I0 + I1 + I2 + I3 + I4 + I5;
        for (int it = gw; it < NIT; it += ngw) {
            int r = it;
            if (r < I0) { p0_transpose_item(I_e_w_in, 1024, E_N, (bf16_t*)(ws + WS_WEIN), 0, nullptr, scr, r, E_N / 32, lane); continue; } r -= I0;
            if (r < I1) { p0_transpose_item(I_e_w_out, 1024, 1024, (bf16_t*)(ws + WS_WEOUT), 1, nullptr, scr, r, 32, lane); continue; } r -= I1;
            if (r < I2) { p0_transpose_item(I_o_w_in, 1024, O_NSRC, (bf16_t*)(ws + WS_WOIN), 2, nullptr, scr, r, O_N / 32, lane); continue; } r -= I2;
            if (r < I3) { p0_transpose_item(I_o_w_uq, 768, 768, (bf16_t*)(ws + WS_WUQ), 3, I_o_qn, scr, r, 24, lane); continue; } r -= I3;
            if (r < I4) { p0_transpose_item(I_o_w_ukv, 256, 1024, (bf16_t*)(ws + WS_WUKV), 4, I_o_kvn, scr, r, 32, lane); continue; } r -= I4;
            p0_transpose_item(I_o_w_out, 1024, 1024, (bf16_t*)(ws + WS_WOOUT), 5, nullptr, scr, r, 32, lane);
        }
        float* ropeA = (float*)(ws + WS_ROPEA); float* ropeC = (float*)(ws + WS_ROPEC);
        for (int idx = bx * NTHREADS + tid; idx < 2048 * 48; idx += G * NTHREADS) {
            const int pos = idx / 48, j = idx % 48; const float rowf = (float)(pos >> 6), colf = (float)(pos & 63);
            if (j < 32) { const int f = j & 15; const float inv = exp2f(-(float)f * (13.287712379549449f / 16.f)); const float ang = ((j < 16) ? rowf : colf) * inv;
                ropeA[pos * 64 + j] = __cosf(ang); ropeA[pos * 64 + 32 + j] = __sinf(ang); }
            else { const int jj = j - 32, f = jj & 7; const float inv = exp2f(-(float)f * (13.287712379549449f / 8.f)); const float ang = ((jj < 8) ? rowf : colf) * inv;
                ropeC[pos * 32 + jj] = __cosf(ang); ropeC[pos * 32 + 16 + jj] = __sinf(ang); }
        }
        }
        SEAM(0);
    }
    if (IN(1)) { asm volatile("" : "+s"(AP)); PH_IDS; for (int rep_ = 0; rep_ < NREP(1); ++rep_) { if (rep_) __syncthreads();
        p1_prenorm(I_x, I_ctx, I_pre_w, MOD, (bf16_t*)(ws + WS_H), gw, ngw, lane); }
        SEAM(1); }
    if (IN(2)) { asm volatile("" : "+s"(AP)); PH_IDS;
        for (int rep_ = 0; rep_ < NREP(2); ++rep_) { if (rep_) __syncthreads();
        pg8::Gemm g{(const bf16_t*)(ws + WS_H), (const bf16_t*)(ws + WS_WEIN), MT, E_N, 1024}; pg8::RectOrder S; S.init(MT / 256, E_N / 256, 0, 0, 0, G, bx);
        EpiEin E{ws}; pg8::gemm_phase<EpiEin, pg8::RectOrder, true, true>(lds, g, S, E);
        }
        SEAM(2);
    }
    if (IN(3)) { asm volatile("" : "+s"(AP)); PH_IDS;
        for (int rep_ = 0; rep_ < NREP(3) + NREP(14) - 1; ++rep_) {
        for (int un = vcu; un < 1024; un += G) attn_unit<0>(lds, ws, nullptr, I_e_sink, un);
        for (int un = bx; un < 128; un += G) attn_unit<1>(lds, ws, nullptr, I_e_sink, un);
        }
        for (int rep_ = 0; rep_ < NREP(3) + NREP(15) - 1; ++rep_) { p3_conv(ws, I_e_conv_w, bx * NTHREADS + tid, G * NTHREADS);
        }
        SEAM(3);
    }
    if (IN(4)) { asm volatile("" : "+s"(AP)); PH_IDS;
        for (int rep_ = 0; rep_ < NREP(4); ++rep_) { if (rep_) __syncthreads();
        pg8::Gemm g{(const bf16_t*)(ws + WS_U), (const bf16_t*)(ws + WS_WEOUT), MT, 1024, 1024}; pg8::RectOrder S; S.init(MT / 256, 4, 0, 0, 0, G, bx);
        EpiY E{(bf16_t*)(ws + WS_Y), (float*)(ws + WS_SSQY0)}; pg8::gemm_phase<EpiY, pg8::RectOrder, true, true>(lds, g, S, E);
        }
        SEAM(4);
    }
    if (IN(5)) { asm volatile("" : "+s"(AP)); PH_IDS; for (int rep_ = 0; rep_ < NREP(5); ++rep_) { if (rep_) __syncthreads();
        p5_post_pre(I_x, I_ctx, I_post_w, I_pre_w + 1024, MOD, (const bf16_t*)(ws + WS_Y), (const float*)(ws + WS_SSQY0), (bf16_t*)(ws + WS_X1), (bf16_t*)(ws + WS_H), gw, ngw, lane); }
        SEAM(5); }
    if (IN(6)) { asm volatile("" : "+s"(AP)); PH_IDS;
        for (int rep_ = 0; rep_ < NREP(6); ++rep_) { if (rep_) __syncthreads();
        pg8::Gemm g{(const bf16_t*)(ws + WS_H), (const bf16_t*)(ws + WS_WOIN), MT, O_N, 1024}; pg8::RectOrder S; S.init(ML / 256, O_N / 256, ML / 256, MC / 256, 5, G, bx);
        EpiOin E{ws, (unsigned char*)I_out}; pg8::gemm_phase<EpiOin, pg8::RectOrder, true, true>(lds, g, S, E);
        }
        SEAM(6);
    }
    if (IN(7)) { asm volatile("" : "+s"(AP)); PH_IDS;
        for (int rep_ = 0; rep_ < NREP(7); ++rep_) { if (rep_) __syncthreads();
        { pg8::Gemm g{(const bf16_t*)(ws + WS_CQ), (const bf16_t*)(ws + WS_WUQ), ML, 768, 768}; pg8::RectOrder S; S.init(ML / 256, 3, 0, 0, 0, G, bx);
          EpiUq E{ws}; pg8::gemm_phase<EpiUq, pg8::RectOrder, true, true>(lds, g, S, E); }
        __syncthreads();
        { pg8::Gemm g{(const bf16_t*)(ws + WS_CKV), (const bf16_t*)(ws + WS_WUKV), MT, 1024, 256}; pg8::RectOrder S; S.init(MT / 256, 4, 0, 0, 0, G, G - 1 - bx);
          EpiUkv E{ws}; pg8::gemm_phase<EpiUkv, pg8::RectOrder, true, true>(lds, g, S, E); }
        }
        SEAM(7);
    }
    if (IN(8)) { asm volatile("" : "+s"(AP)); PH_IDS;
        for (int rep_ = 0; rep_ < NREP(8) + NREP(12) - 1; ++rep_) { for (int ch = bx; ch < 256; ch += G) mlstm_chain_mfma<false>(lds, ws, (unsigned char*)I_out, I_o_ib, I_o_fb, ch);
        }
        for (int rep_ = 0; rep_ < NREP(8) + NREP(13) - 1; ++rep_) {
        for (int un = vcu; un < 1024; un += G) attn_unit<2>(lds, ws, (unsigned char*)I_out, nullptr, un);
        }
        SEAM(8);
    }
    if (IN(9)) { asm volatile("" : "+s"(AP)); PH_IDS; for (int rep_ = 0; rep_ < NREP(9); ++rep_) { if (rep_) __syncthreads();
        p9_readout(ws, (unsigned char*)I_out, I_o_hn, gw, ngw, lane); }
        SEAM(9); }
    if (IN(10)) { asm volatile("" : "+s"(AP)); PH_IDS;
        for (int rep_ = 0; rep_ < NREP(10); ++rep_) { if (rep_) __syncthreads();
        pg8::Gemm g{(const bf16_t*)(ws + WS_U), (const bf16_t*)(ws + WS_WOOUT), ML, 1024, 1024}; pg8::RectOrder S; S.init(ML / 256, 4, 0, 0, 0, G, bx);
        EpiY E{(bf16_t*)(ws + WS_Y), (float*)(ws + WS_SSQY1)}; pg8::gemm_phase<EpiY, pg8::RectOrder, true, true>(lds, g, S, E);
        }
        SEAM(10);
    }
    if (IN(11)) { asm volatile("" : "+s"(AP)); PH_IDS; p11_final(I_post_w + 1024, MOD, (const bf16_t*)(ws + WS_Y), (const float*)(ws + WS_SSQY1), (const bf16_t*)(ws + WS_X1), I_out, gw, ngw, lane); }
#undef IN
#undef SEAM
#undef I_x
#undef I_cvec
#undef I_ctx
#undef I_c_ctx
#undef I_mod_w
#undef I_mod_b
#undef I_pre_w
#undef I_post_w
#undef I_e_w_in
#undef I_e_sink
#undef I_e_conv_w
#undef I_e_w_out
#undef I_o_w_in
#undef I_o_qn
#undef I_o_kvn
#undef I_o_w_uq
#undef I_o_w_ukv
#undef I_o_ib
#undef I_o_fb
#undef I_o_hn
#undef I_o_w_out
#undef I_out
}

extern "C" void kernel_launch(void* const* d_in, const int* in_sizes, int n_in, void* d_out, int out_size, void* d_ws, size_t ws_size, hipStream_t stream) {
    static int grid = 0;
    if (grid == 0) {
        if (n_in != 21 || in_sizes[0] != ML * DM || out_size != ML * DM || ws_size < WS_END) { fprintf(stderr, "kernel_launch: unexpected shapes / workspace (n_in %d, ws %zu < %zu); nothing launched\n", n_in, ws_size, (size_t)WS_END); grid = -1; return; }
        int dev = 0, cus = 0, per_cu = 0;
        if (hipGetDevice(&dev) != hipSuccess || hipDeviceGetAttribute(&cus, hipDeviceAttributeMultiprocessorCount, dev) != hipSuccess) { grid = -1; return; }
        if (hipFuncSetAttribute((const void*)hybrid_fwd, hipFuncAttributeMaxDynamicSharedMemorySize, LDS_BYTES) != hipSuccess) { fprintf(stderr, "kernel_launch: hipFuncSetAttribute failed\n"); grid = -1; return; }
        if (hipOccupancyMaxActiveBlocksPerMultiprocessor(&per_cu, (const void*)hybrid_fwd, NTHREADS, LDS_BYTES) != hipSuccess || per_cu < 1) fprintf(stderr, "kernel_launch: note: occupancy query reports %d workgroups per CU\n", per_cu);
        (void)hipGetLastError();
        grid = cus;
    }
    if (grid < 0) return;
    if (hipMemsetAsync((char*)d_ws + WS_CTL, 0, CTL_ZERO_BYTES, stream) != hipSuccess) { fprintf(stderr, "kernel_launch: hipMemsetAsync failed\n"); return; }
    Args a{};
    for (int i = 0; i < 21; ++i) a.in[i] = (const float*)d_in[i];
    a.out = (float*)d_out; a.ws = (unsigned char*)d_ws;
    if (MK_N_LAUNCHES == 1) { a.ph_lo = 0; a.ph_hi = N_PHASES; hipLaunchKernelGGL(hybrid_fwd, dim3(grid), dim3(NTHREADS), LDS_BYTES, stream, a); }
    else for (int p = 0; p < N_PHASES; ++p) { a.ph_lo = p; a.ph_hi = p + 1; hipLaunchKernelGGL(hybrid_fwd, dim3(grid), dim3(NTHREADS), LDS_BYTES, stream, a); }
    const hipError_t le = hipPeekAtLastError();
    if (le != hipSuccess) fprintf(stderr, "kernel_launch: launch failed: %s\n", hipGetErrorName(le));
}
```

```cpp
#include <hip/hip_runtime.h>
#include <cstdio>
#include <cstdint>

#define LAS __attribute__((address_space(3)))
#define GAS __attribute__((address_space(1)))
typedef unsigned short bf16_t;
typedef short bf16x8 __attribute__((ext_vector_type(8)));
typedef short s16x4 __attribute__((ext_vector_type(4)));
typedef float f32x4 __attribute__((ext_vector_type(4)));
typedef float f32x16 __attribute__((ext_vector_type(16)));
typedef unsigned u32x4 __attribute__((ext_vector_type(4)));
typedef unsigned u32x2 __attribute__((ext_vector_type(2)));
typedef float f32x2_t __attribute__((ext_vector_type(2)));
typedef __bf16 bf16x2_t __attribute__((ext_vector_type(2)));

constexpr int NB = 16, SEQ = 2048, DM = 1024, CL = 256;
constexpr int ML = NB * SEQ, MC = NB * CL, MT = ML + MC;
constexpr float EPS = 1e-6f, LOG2E = 1.4426950408889634f;
constexpr int E_N = 3328, O_NSRC = 3632, O_N = 3840;
constexpr int NWAVES = 8, NTHREADS = 512;

__device__ __forceinline__ float bf_lo(unsigned w) { return __uint_as_float(w << 16); }
__device__ __forceinline__ float bf_hi(unsigned w) { return __uint_as_float(w & 0xffff0000u); }
__device__ __forceinline__ unsigned pk2(float lo, float hi) { f32x2_t v = {lo, hi}; bf16x2_t b = __builtin_convertvector(v, bf16x2_t); return __builtin_bit_cast(unsigned, b); }
__device__ __forceinline__ float silu_f(float x) { return x * __builtin_amdgcn_rcpf(1.f + __expf(-x)); }
__device__ __forceinline__ float sigmoid_f(float x) { return __builtin_amdgcn_rcpf(1.f + __expf(-x)); }
__device__ __forceinline__ float wave_sum(float v) {
#pragma unroll
    for (int o = 1; o < 64; o <<= 1) v += __shfl_xor(v, o);
    return v;
}
#define LDS_WAIT() asm volatile("s_waitcnt lgkmcnt(0)" ::: "memory")
#define VM_WAIT() asm volatile("s_waitcnt vmcnt(0)" ::: "memory")

__device__ __forceinline__ int my_tid() { int t = threadIdx.x; asm volatile("" : "+v"(t)); return t; }

namespace pg8 {
#define PG8_LAS __attribute__((address_space(3)))
typedef unsigned short bf16_t;
typedef short bf16x8 __attribute__((ext_vector_type(8)));
typedef float f32x4 __attribute__((ext_vector_type(4)));
typedef unsigned u32x4 __attribute__((ext_vector_type(4)));
constexpr int BM = 256, BK = 64, HALF = 128, HTB = HALF * BK * 2  , STAGE_BYTES = 8 * HTB, NXCD = 8, WGM = 8;

__host__ __device__ __forceinline__ int lds_byte(int r, int c) { const int st = (r >> 4) * 2 + (c >> 5), rr = r & 15, cc = c & 31, ob = rr * 64 + cc * 2; return st * 1024 + (ob ^ (((ob >> 9) & 1) << 5)); }
__host__ __device__ __forceinline__ void stage_rc(int b, int& R, int& C) { const int st = b / 1024, sb = b % 1024, swz = sb ^ (((sb >> 9) & 1) << 5); R = (st >> 1) * 16 + swz / 64; C = (st & 1) * 32 + (swz % 64) / 2; }
__host__ __device__ __forceinline__ int perm32(int rho) { const int n = rho >> 4, i = rho & 15; return 8 * (i >> 2) + 4 * n + (i & 3); }

struct Unit { int pm, pn; };
struct Gemm { const bf16_t* A; const bf16_t* Bt; int M, N, K; };

struct RectOrder {
    int nM0, nN0, n0, pm1, nM1, nN1, n1, G, c;
    __device__ __forceinline__ void init(int nM0_, int nN0_, int pm1_, int nM1_, int nN1_, int G_, int c_) { nM0 = nM0_; nN0 = nN0_; n0 = nM0_ * nN0_; pm1 = pm1_; nM1 = nM1_; nN1 = nN1_; n1 = nM1_ * nN1_; G = G_; c = c_; }
    __device__ __forceinline__ static void rect(int w, int nM, int nN, int& pm, int& pn) {
        const int nig = WGM * nN, gid = w / nig, fm = gid * WGM, gsz = (nM - fm) < WGM ? (nM - fm) : WGM;
        pm = fm + ((w % nig) % gsz); pn = (w % nig) / gsz;
    }
    __device__ __forceinline__ bool next(int i, Unit& u) const {
        const int nwg = n0 + n1; const long L = (long)i * G + c; if (L >= nwg) return false;
        int wgid = (int)L; { const int q = nwg / NXCD, r = nwg % NXCD, xcd = wgid % NXCD, off = wgid / NXCD; wgid = (xcd < r ? xcd * (q + 1) : r * (q + 1) + (xcd - r) * q) + off; }
        if (wgid < n0) rect(wgid, nM0, nN0, u.pm, u.pn); else { rect(wgid - n0, nM1, nN1, u.pm, u.pn); u.pm += pm1; }
        return true;
    }
    __device__ __forceinline__ void a_ready(const Unit&) const {}
    __device__ __forceinline__ void done(const Unit&) const {}
};

struct ListOrder4 {
    int start, cnt;
    __device__ __forceinline__ bool next(int i, Unit& u) const { if (i >= cnt) return false; const int L = start + i; u.pm = L >> 2; u.pn = L & 3; return true; }
    __device__ __forceinline__ void a_ready(const Unit&) const {}
    __device__ __forceinline__ void done(const Unit&) const {}
};

struct PanelOrder {
    int nM0, nN0, nN1, total, first, step, cnt;
    const unsigned* ready; unsigned need; unsigned* tmo;
    __device__ __forceinline__ bool next(int i, Unit& u) const {
        if (i >= cnt) return false; int L = first + step * i; if (L >= total) return false;
        const int n0 = nM0 * nN0; if (L < n0) { u.pm = L / nN0; u.pn = L - u.pm * nN0; } else { L -= n0; const int q = L / nN1; u.pm = nM0 + q; u.pn = L - q * nN1; }
        return true;
    }
    __device__ __forceinline__ void a_ready(const Unit& u) const {
        if (ready == nullptr) return;
        if (threadIdx.x < 64) {
            const unsigned long long t0 = __builtin_amdgcn_s_memrealtime(); unsigned polls = 0;
            while ((unsigned)__builtin_amdgcn_readfirstlane(__hip_atomic_load(ready + 64 * u.pm, __ATOMIC_RELAXED, __HIP_MEMORY_SCOPE_AGENT)) < need) {
                if ((++polls & 255u) == 0u && __builtin_amdgcn_readfirstlane(__hip_atomic_load(tmo, __ATOMIC_RELAXED, __HIP_MEMORY_SCOPE_AGENT)) != 0u) break;
                if (__builtin_amdgcn_s_memrealtime() - t0 > 2000000ull) { if (threadIdx.x == 0) __hip_atomic_store(tmo, 1u, __ATOMIC_RELAXED, __HIP_MEMORY_SCOPE_AGENT); break; }
                __builtin_amdgcn_s_sleep(2); }
            asm volatile("s_waitcnt vmcnt(0)" ::: "memory");
        }
        asm volatile("" ::: "memory"); __builtin_amdgcn_s_barrier(); asm volatile("" ::: "memory");
    }
    __device__ __forceinline__ void done(const Unit&) const {}
};

template <class Epi, class Sched, bool ALIGN_EPI = false, bool SP2 = false>
__device__ __forceinline__ void gemm_phase(PG8_LAS unsigned char* lds, const Gemm g, const Sched& S, const Epi& E) {
    const int tid = my_tid(), wid = __builtin_amdgcn_readfirstlane(tid >> 6), lane = tid & 63, wr = wid >> 2, wc = wid & 3, fr = lane & 15, fq = lane >> 4;
    const int K = g.K, nt = K / BK;
    unsigned voffA[2], voffB[2];
#pragma unroll
    for (int i = 0; i < 2; ++i) { int R, C; stage_rc(tid * 16 + i * 8192, R, C); const int Rb = Epi::PERM ? ((R & ~31) + perm32(R & 31)) : R;
        voffA[i] = (unsigned)(R * K + C) * 2u; voffB[i] = (unsigned)(Rb * K + C) * 2u; }
    const size_t kstep = (size_t)(BK * 2);
    const size_t hstep = (size_t)HALF * K * 2;
    const size_t tstep = 2 * hstep;
    const unsigned ldsw = (unsigned)wid * 1024u;
    const int aoff = lds_byte(wr * 64 + fr, fq * 8), boff = lds_byte(wc * 32 + fr, fq * 8);
#define PG8_SA(b, h) (((b) * 2 + (h)) * HTB)
#define PG8_SB(b, h) ((4 + (b) * 2 + (h)) * HTB)
#define PG8_STAGE(bufoff, gbase, voff) do { _Pragma("unroll") for (int _i = 0; _i < 2; ++_i) \
        __builtin_amdgcn_global_load_lds((const unsigned*)((const char*)(gbase) + (voff)[_i]), (PG8_LAS unsigned*)(lds + (bufoff) + ldsw + _i * 8192), 16, 0, 0); } while (0)
#define PG8_LDA(dst, b, h) do { _Pragma("unroll") for (int m = 0; m < 4; ++m) _Pragma("unroll") for (int k = 0; k < 2; ++k) dst[m][k] = *(const PG8_LAS bf16x8*)(lds + PG8_SA(b, h) + aoff + m * 2048 + k * 1024); } while (0)
#define PG8_LDB(dst, b, h) do { _Pragma("unroll") for (int n = 0; n < 2; ++n) _Pragma("unroll") for (int k = 0; k < 2; ++k) dst[n][k] = *(const PG8_LAS bf16x8*)(lds + PG8_SB(b, h) + boff + n * 2048 + k * 1024); } while (0)
#define PG8_MMA(ai, bj, At, Bt) do { __builtin_amdgcn_s_setprio(1); _Pragma("unroll") for (int m = 0; m < 4; ++m) _Pragma("unroll") for (int n = 0; n < 2; ++n) _Pragma("unroll") for (int k = 0; k < 2; ++k) \
        acc[ai][bj][m][n] = __builtin_amdgcn_mfma_f32_16x16x32_bf16(Bt[n][k], At[m][k], acc[ai][bj][m][n], 0, 0, 0); __builtin_amdgcn_s_setprio(0); } while (0)
#define PG8_WAIT_V(n) asm volatile("s_waitcnt vmcnt(" #n ")" ::: "memory")
#define PG8_WAIT_L(n) asm volatile("s_waitcnt lgkmcnt(" #n ")" ::: "memory")
#define PG8_BAR __builtin_amdgcn_s_barrier()
#define PG8_SCHED __builtin_amdgcn_sched_barrier(0)
    Unit cur, nxt; int ui = 0;
    if (!S.next(0, cur)) return;
    f32x4 acc[2][2][4][2];
#pragma unroll
    for (int a = 0; a < 2; ++a)
#pragma unroll
        for (int b = 0; b < 2; ++b)
#pragma unroll
            for (int m = 0; m < 4; ++m)
#pragma unroll
                for (int n = 0; n < 2; ++n) acc[a][b][m][n] = (f32x4){0.f, 0.f, 0.f, 0.f};
    bf16x8 At[4][2], B0[2][2], B1[2][2];
    const char* cA = (const char*)g.A + (size_t)cur.pm * tstep; const char* cB = (const char*)g.Bt + (size_t)cur.pn * tstep;
    S.a_ready(cur);
    if constexpr (SP2) {
        PG8_STAGE(PG8_SB(0, 0), cB, voffB); PG8_STAGE(PG8_SB(0, 1), cB + hstep, voffB); PG8_STAGE(PG8_SA(0, 0), cA, voffA); PG8_STAGE(PG8_SA(0, 1), cA + hstep, voffA);
        if (wr == 1) PG8_BAR;
        PG8_WAIT_V(2); PG8_BAR;
        PG8_STAGE(PG8_SB(1, 0), cB + kstep, voffB); PG8_STAGE(PG8_SA(1, 0), cA + kstep, voffA); PG8_STAGE(PG8_SB(1, 1), cB + hstep + kstep, voffB);
        PG8_WAIT_V(6); PG8_BAR;
    } else {
        PG8_STAGE(PG8_SB(0, 0), cB, voffB); PG8_STAGE(PG8_SA(0, 0), cA, voffA); PG8_STAGE(PG8_SB(0, 1), cB + hstep, voffB); PG8_STAGE(PG8_SA(0, 1), cA + hstep, voffA);
        if (wr == 1) PG8_BAR;
        PG8_WAIT_V(4); PG8_BAR;
        PG8_STAGE(PG8_SB(1, 0), cB + kstep, voffB); PG8_STAGE(PG8_SA(1, 0), cA + kstep, voffA); PG8_STAGE(PG8_SB(1, 1), cB + hstep + kstep, voffB);
        PG8_WAIT_V(6); PG8_BAR;
    }
    for (;;) {
        const bool has_next = S.next(ui + 1, nxt);
        const char* nA = has_next ? (const char*)g.A + (size_t)nxt.pm * tstep : cA; const char* nB = has_next ? (const char*)g.Bt + (size_t)nxt.pn * tstep : cB;
        for (int t = 0; t < nt; t += 2) {
            const bool last = (t == nt - 2);
            const char* a1 = cA + (size_t)(t + 1) * kstep;
            const char* a2 = last ? nA : cA + (size_t)(t + 2) * kstep; const char* b2 = last ? nB : cB + (size_t)(t + 2) * kstep;
            const char* a3 = a2 + kstep; const char* b3 = b2 + kstep;
            if (last && has_next) S.a_ready(nxt);
            if constexpr (SP2) {
            PG8_LDB(B0, 0, 0); PG8_LDB(B1, 0, 1); PG8_SCHED; PG8_LDA(At, 0, 0); PG8_STAGE(PG8_SA(1, 1), a1 + hstep, voffA);
            PG8_WAIT_V(8); PG8_WAIT_L(0); PG8_BAR; PG8_MMA(0, 0, At, B0); PG8_MMA(0, 1, At, B1); PG8_BAR; PG8_SCHED;
            PG8_LDA(At, 0, 1); PG8_STAGE(PG8_SB(0, 0), b2, voffB); PG8_STAGE(PG8_SB(0, 1), b2 + hstep, voffB); PG8_STAGE(PG8_SA(0, 0), a2, voffA);
            PG8_WAIT_V(8); PG8_WAIT_L(0); PG8_BAR; PG8_MMA(1, 0, At, B0); PG8_MMA(1, 1, At, B1); PG8_BAR; PG8_SCHED;
            PG8_LDB(B0, 1, 0); PG8_LDB(B1, 1, 1); PG8_SCHED; PG8_LDA(At, 1, 0); PG8_STAGE(PG8_SA(0, 1), a2 + hstep, voffA);
            PG8_WAIT_V(8); PG8_WAIT_L(0); PG8_BAR; PG8_MMA(0, 0, At, B0); PG8_MMA(0, 1, At, B1); PG8_BAR; PG8_SCHED;
            PG8_LDA(At, 1, 1); PG8_STAGE(PG8_SB(1, 0), b3, voffB); PG8_STAGE(PG8_SB(1, 1), b3 + hstep, voffB); PG8_STAGE(PG8_SA(1, 0), a3, voffA);
            PG8_WAIT_V(8); PG8_WAIT_L(0); PG8_BAR; PG8_MMA(1, 0, At, B0); PG8_MMA(1, 1, At, B1); PG8_BAR; PG8_SCHED;
            } else {
            PG8_LDB(B0, 0, 0); PG8_SCHED; PG8_LDA(At, 0, 0); PG8_STAGE(PG8_SA(1, 1), a1 + hstep, voffA);
            PG8_WAIT_L(8); PG8_BAR; PG8_WAIT_L(0); PG8_MMA(0, 0, At, B0); PG8_BAR; PG8_SCHED;
            PG8_LDB(B1, 0, 1); PG8_STAGE(PG8_SB(0, 0), b2, voffB);
            PG8_BAR; PG8_WAIT_L(0); PG8_MMA(0, 1, At, B1); PG8_BAR;
            PG8_LDA(At, 0, 1); PG8_STAGE(PG8_SA(0, 0), a2, voffA);
            PG8_BAR; PG8_WAIT_L(0); PG8_MMA(1, 0, At, B0); PG8_BAR; PG8_SCHED;
            PG8_STAGE(PG8_SB(0, 1), b2 + hstep, voffB);
            PG8_WAIT_V(6); PG8_BAR; PG8_MMA(1, 1, At, B1); PG8_BAR;
            PG8_LDB(B0, 1, 0); PG8_SCHED; PG8_LDA(At, 1, 0); PG8_STAGE(PG8_SA(0, 1), a2 + hstep, voffA);
            PG8_WAIT_L(8); PG8_BAR; PG8_WAIT_L(0); PG8_MMA(0, 0, At, B0); PG8_BAR; PG8_SCHED;
            PG8_LDB(B1, 1, 1); PG8_STAGE(PG8_SB(1, 0), b3, voffB);
            PG8_BAR; PG8_WAIT_L(0); PG8_MMA(0, 1, At, B1); PG8_BAR;
            PG8_LDA(At, 1, 1); PG8_STAGE(PG8_SA(1, 0), a3, voffA);
            PG8_BAR; PG8_WAIT_L(0); PG8_MMA(1, 0, At, B0); PG8_BAR; PG8_SCHED;
            PG8_STAGE(PG8_SB(1, 1), b3 + hstep, voffB);
            PG8_WAIT_V(6); PG8_BAR; PG8_MMA(1, 1, At, B1); PG8_BAR;
            }
        }
        if constexpr (ALIGN_EPI) { if (wr == 0) PG8_BAR; }
        if constexpr (!Epi::AFTER_DRAIN) { E(acc, cur, wr, wc, fr, fq); S.done(cur); }
        if (!has_next) break;
#pragma unroll
        for (int a = 0; a < 2; ++a)
#pragma unroll
            for (int b = 0; b < 2; ++b)
#pragma unroll
                for (int m = 0; m < 4; ++m)
#pragma unroll
                    for (int n = 0; n < 2; ++n) acc[a][b][m][n] = (f32x4){0.f, 0.f, 0.f, 0.f};
        cur = nxt; cA = nA; cB = nB; ++ui;
        if constexpr (ALIGN_EPI) { if (wr == 1) PG8_BAR; }
    }
    PG8_WAIT_V(0);
    if constexpr (!ALIGN_EPI) { if (wr == 0) PG8_BAR; }
    PG8_BAR;
    if constexpr (Epi::AFTER_DRAIN) { E.fused(acc, cur, wr, wc, fr, fq, lds, wid, lane); S.done(cur); }
#undef PG8_SA
#undef PG8_SB
#undef PG8_STAGE
#undef PG8_LDA
#undef PG8_LDB
#undef PG8_MMA
#undef PG8_WAIT_V
#undef PG8_WAIT_L
#undef PG8_BAR
#undef PG8_SCHED
}
}

constexpr size_t MiB = 1u << 20;
constexpr size_t WS_CTL = 0, CTL_ZERO_BYTES = 128 * 1024;
constexpr int CW_PANEL = 8192, PANEL_BANK = 144 * 64;
constexpr size_t WS_MOD = 1 * MiB;
constexpr size_t WS_ROPEA = 2 * MiB;
constexpr size_t WS_ROPEC = 2 * MiB + 512 * 1024;
constexpr size_t WS_WEIN = 3 * MiB, WS_WEOUT = 10 * MiB, WS_WOIN = 12 * MiB, WS_WUQ = 20 * MiB, WS_WUKV = 21 * MiB + 512 * 1024, WS_WOOUT = 22 * MiB;
constexpr size_t WS_H = 24 * MiB;
constexpr size_t WS_U = 96 * MiB;
constexpr size_t WS_Y = 168 * MiB;
constexpr size_t WS_R = 240 * MiB;
constexpr size_t WS_KVE = WS_R  , WS_QE = WS_R + 18 * MiB, WS_PE = WS_R + 54 * MiB, WS_GE = WS_R + 90 * MiB, WS_ZA = WS_R + 126 * MiB, WS_SSQY0 = WS_R + 241 * MiB  ;
constexpr size_t WS_CKV = WS_R, WS_CQ = WS_R + 18 * MiB, WS_HM = WS_R  , WS_MK = WS_R + 66 * MiB, WS_MV = WS_R + 84 * MiB, WS_KR = WS_R + 120 * MiB, WS_GATES = WS_R + 123 * MiB,
                 WS_SSQCKV = WS_R + 126 * MiB, WS_SSQCQ = WS_R + 127 * MiB, WS_X1 = WS_R + 129 * MiB  , WS_SSQY1 = WS_R + 241 * MiB;
constexpr size_t AUX_MQ = 0, AUX_MO = 16 * MiB, AUX_ZO = 48 * MiB;
constexpr size_t WS_KNV = WS_H  , WS_QO = WS_Y;
constexpr size_t WS_END = WS_R + 244 * MiB;
static_assert(WS_ZA + (size_t)MT * 512 * 2 <= WS_R + 162 * MiB && WS_X1 + (size_t)ML * 1024 * 2 <= WS_R + 241 * MiB && WS_HM + (size_t)2 * ML * 512 * 2 <= WS_MK && WS_SSQY1 + (size_t)MT * 16 * 4 <= WS_END, "ws map");

__device__ __forceinline__ void st8(bf16_t* p, f32x4 a, f32x4 b) { u32x4 w; w.x = pk2(a[0], a[1]); w.y = pk2(a[2], a[3]); w.z = pk2(b[0], b[1]); w.w = pk2(b[2], b[3]); *(u32x4*)p = w; }
__device__ __forceinline__ bf16_t f2bf(float v) { return (bf16_t)(pk2(v, 0.f) & 0xffffu); }
__device__ __forceinline__ void rope8(f32x4& a, f32x4& b, const float* cosp, const float* sinp) {
    const f32x4 cs = *(const f32x4*)cosp, sn = *(const f32x4*)sinp;
    const float a0 = a[0] * cs[0] - a[1] * sn[0], a1 = a[0] * sn[0] + a[1] * cs[0], a2 = a[2] * cs[1] - a[3] * sn[1], a3 = a[2] * sn[1] + a[3] * cs[1];
    const float b0 = b[0] * cs[2] - b[1] * sn[2], b1 = b[0] * sn[2] + b[1] * cs[2], b2 = b[2] * cs[3] - b[3] * sn[3], b3 = b[2] * sn[3] + b[3] * cs[3];
    a = (f32x4){a0, a1, a2, a3}; b = (f32x4){b0, b1, b2, b3};
}
__device__ __forceinline__ void rope8v(f32x4& a, f32x4& b, const f32x4 cs, const f32x4 sn) {
    const float a0 = a[0] * cs[0] - a[1] * sn[0], a1 = a[0] * sn[0] + a[1] * cs[0], a2 = a[2] * cs[1] - a[3] * sn[1], a3 = a[2] * sn[1] + a[3] * cs[1];
    const float b0 = b[0] * cs[2] - b[1] * sn[2], b1 = b[0] * sn[2] + b[1] * cs[2], b2 = b[2] * cs[3] - b[3] * sn[3], b3 = b[2] * sn[3] + b[3] * cs[3];
    a = (f32x4){a0, a1, a2, a3}; b = (f32x4){b0, b1, b2, b3};
}
__device__ __forceinline__ f32x4 silu4(f32x4 v) { return (f32x4){silu_f(v[0]), silu_f(v[1]), silu_f(v[2]), silu_f(v[3])}; }
__device__ __forceinline__ f32x4 sigm4(f32x4 v) { return (f32x4){sigmoid_f(v[0]), sigmoid_f(v[1]), sigmoid_f(v[2]), sigmoid_f(v[3])}; }
__device__ __forceinline__ float sq4(f32x4 v) { return (v[0] * v[0] + v[1] * v[1]) + (v[2] * v[2] + v[3] * v[3]); }

struct EpiEin {
    static constexpr bool PERM = true, AFTER_DRAIN = false;
    unsigned char* ws;
    __device__ __forceinline__ void operator()(const f32x4 (&acc)[2][2][4][2], const pg8::Unit& u, int wr, int wc, int fr, int fq) const {
        const int pn = u.pn, rbase = u.pm * 256 + wr * 64 + fr, cw = wc * 32 + 8 * fq;
        const float* ropeA = (const float*)(ws + WS_ROPEA);
#pragma unroll
        for (int ai = 0; ai < 2; ++ai) {
            f32x4 rcs[4], rsn[4];
            if (pn <= 2 && u.pm * 256 < ML) { const int i0 = (cw & 63) >> 1;
#pragma unroll
                for (int q = 0; q < 4; ++q) { const int pos = (rbase + ai * 128 + q * 16) & 2047; rcs[q] = *(const f32x4*)(ropeA + pos * 64 + i0); rsn[q] = *(const f32x4*)(ropeA + pos * 64 + 32 + i0); } }
#pragma unroll
            for (int m = 0; m < 4; ++m) {
                asm volatile("" ::: "memory"); const int R = rbase + ai * 128 + m * 16; const bool lat = R < ML;
                if (pn == 0) {
                    f32x4 a = acc[ai][0][m][0], b = acc[ai][0][m][1];
                    if (lat) rope8v(a, b, rcs[m], rsn[m]);
                    st8((bf16_t*)(ws + WS_KVE) + (size_t)R * 256 + cw, a, b);
                    st8((bf16_t*)(ws + WS_KVE) + (size_t)R * 256 + 128 + cw, acc[ai][1][m][0], acc[ai][1][m][1]);
                } else if (pn <= 2) {
#pragma unroll
                    for (int bj = 0; bj < 2; ++bj) {
                        f32x4 a = acc[ai][bj][m][0], b = acc[ai][bj][m][1];
                        if (lat) rope8v(a, b, rcs[m], rsn[m]);
                        const float sc = 0.125f * LOG2E; a = a * sc; b = b * sc;
                        st8((bf16_t*)(ws + WS_QE) + (size_t)R * 512 + (pn - 1) * 256 + bj * 128 + cw, a, b);
                    }
                } else if (pn <= 6) {
                    st8((bf16_t*)(ws + WS_PE) + (size_t)R * 512 + (pn - 3) * 128 + cw, acc[ai][0][m][0] * acc[ai][1][m][0], acc[ai][0][m][1] * acc[ai][1][m][1]);
                } else if (pn <= 10) {
                    st8((bf16_t*)(ws + WS_GE) + (size_t)R * 512 + (pn - 7) * 128 + cw, acc[ai][0][m][0] * silu4(acc[ai][1][m][0]), acc[ai][0][m][1] * silu4(acc[ai][1][m][1]));
                } else {
#pragma unroll
                    for (int bj = 0; bj < 2; ++bj)
                        st8((bf16_t*)(ws + WS_ZA) + (size_t)R * 512 + (pn - 11) * 256 + bj * 128 + cw, silu4(acc[ai][bj][m][0]), silu4(acc[ai][bj][m][1]));
                }
            }
        }
    }
};

struct EpiY {
    static constexpr bool PERM = true, AFTER_DRAIN = false;
    bf16_t* Y; float* SSQ;
    __device__ __forceinline__ void operator()(const f32x4 (&acc)[2][2][4][2], const pg8::Unit& u, int wr, int wc, int fr, int fq) const {
        const int pn = u.pn, rbase = u.pm * 256 + wr * 64 + fr, cw = wc * 32 + 8 * fq;
#pragma unroll
        for (int ai = 0; ai < 2; ++ai)
#pragma unroll
            for (int m = 0; m < 4; ++m) {
                asm volatile("" ::: "memory"); const int R = rbase + ai * 128 + m * 16; float s = 0.f;
#pragma unroll
                for (int bj = 0; bj < 2; ++bj) { st8(Y + (size_t)R * 1024 + pn * 256 + bj * 128 + cw, acc[ai][bj][m][0], acc[ai][bj][m][1]); s += sq4(acc[ai][bj][m][0]) + sq4(acc[ai][bj][m][1]); }
                s += __shfl_xor(s, 16); s += __shfl_xor(s, 32);
                if (fq == 0) SSQ[(size_t)R * 16 + pn * 4 + wc] = s;
            }
    }
};

struct EpiOin {
    static constexpr bool PERM = true, AFTER_DRAIN = false;
    unsigned char* ws; unsigned char* aux;
    __device__ __forceinline__ void operator()(const f32x4 (&acc)[2][2][4][2], const pg8::Unit& u, int wr, int wc, int fr, int fq) const {
        const int pn = u.pn, rbase = u.pm * 256 + wr * 64 + fr, cw = wc * 32 + 8 * fq;
        const float* ropeC = (const float*)(ws + WS_ROPEC);
#pragma unroll
        for (int ai = 0; ai < 2; ++ai) {
            f32x4 rcs[4], rsn[4];
            if (pn == 4 && wc == 0 && u.pm * 256 < ML) { const int i0 = cw >> 1;
#pragma unroll
                for (int q = 0; q < 4; ++q) { const int pos = (rbase + ai * 128 + q * 16) & 2047; rcs[q] = *(const f32x4*)(ropeC + pos * 32 + i0); rsn[q] = *(const f32x4*)(ropeC + pos * 32 + 16 + i0); } }
#pragma unroll
            for (int m = 0; m < 4; ++m) {
                asm volatile("" ::: "memory"); const int R = rbase + ai * 128 + m * 16; const bool lat = R < ML;
                if (pn == 0 || (pn >= 5 && pn <= 7)) {
                    float s = 0.f;
                    bf16_t* dst = (pn == 0) ? (bf16_t*)(ws + WS_CKV) + (size_t)R * 256 : (bf16_t*)(ws + WS_CQ) + (size_t)R * 768 + (pn - 5) * 256;
#pragma unroll
                    for (int bj = 0; bj < 2; ++bj) { st8(dst + bj * 128 + cw, acc[ai][bj][m][0], acc[ai][bj][m][1]); s += sq4(acc[ai][bj][m][0]) + sq4(acc[ai][bj][m][1]); }
                    s += __shfl_xor(s, 16); s += __shfl_xor(s, 32);
                    if (fq == 0) { if (pn == 0) ((float*)(ws + WS_SSQCKV))[(size_t)R * 4 + wc] = s; else ((float*)(ws + WS_SSQCQ))[(size_t)R * 12 + (pn - 5) * 4 + wc] = s; }
                } else if (pn == 4) {
                    if (wc == 0) {
                        f32x4 a = acc[ai][0][m][0], b = acc[ai][0][m][1];
                        if (lat) rope8v(a, b, rcs[m], rsn[m]);
                        st8((bf16_t*)(ws + WS_KR) + (size_t)R * 32 + cw, a, b);
                    } else if (wc == 1 && fq < 2) {
                        float* g = (float*)(ws + WS_GATES) + (size_t)R * 16 + 8 * fq;
                        *(f32x4*)g = acc[ai][0][m][0]; *(f32x4*)(g + 4) = acc[ai][0][m][1];
                    }
                } else {
#pragma unroll
                    for (int bj = 0; bj < 2; ++bj) {
                        const f32x4 a = acc[ai][bj][m][0], b = acc[ai][bj][m][1]; const int col = bj * 128 + cw;
                        if (pn == 1) st8((bf16_t*)(ws + WS_MK) + (size_t)R * 256 + col, a * 0.125f, b * 0.125f);
                        else if (pn <= 3) st8((bf16_t*)(ws + WS_MV) + (size_t)R * 512 + (pn - 2) * 256 + col, a, b);
                        else if (pn == 8) st8((bf16_t*)(aux + AUX_MQ) + (size_t)R * 256 + col, a, b);
                        else if (pn >= 13) st8((bf16_t*)(aux + AUX_ZO) + (size_t)R * 512 + (pn - 13) * 256 + col, silu4(a), silu4(b));
                        else if (bj == 0) st8((bf16_t*)(aux + AUX_MO) + (size_t)R * 512 + (pn - 9) * 128 + cw, sigm4(a) * silu4(acc[ai][1][m][0]), sigm4(b) * silu4(acc[ai][1][m][1]));
                    }
                }
            }
        }
    }
};

struct EpiUkv {
    static constexpr bool PERM = true, AFTER_DRAIN = false;
    unsigned char* ws;
    __device__ __forceinline__ void operator()(const f32x4 (&acc)[2][2][4][2], const pg8::Unit& u, int wr, int wc, int fr, int fq) const {
        const int pn = u.pn, rbase = u.pm * 256 + wr * 64 + fr, cw = wc * 32 + 8 * fq;
#pragma unroll
        for (int ai = 0; ai < 2; ++ai)
#pragma unroll
            for (int m = 0; m < 4; ++m) {
                asm volatile("" ::: "memory"); const int R = rbase + ai * 128 + m * 16;
                const f32x4 sp = *(const f32x4*)((const float*)(ws + WS_SSQCKV) + (size_t)R * 4);
                const float rstd = rsqrtf(((sp[0] + sp[1]) + (sp[2] + sp[3])) * (1.f / 256.f) + EPS);
                int b, pos; if (R < ML) { b = R >> 11; pos = 256 + (R & 2047); } else { const int rc = R - ML; b = rc >> 8; pos = rc & 255; }
#pragma unroll
                for (int bj = 0; bj < 2; ++bj) {
                    const int head = pn * 2 + bj;
                    st8((bf16_t*)(ws + WS_KNV) + ((size_t)(b * 8 + head) * 2304 + pos) * 128 + cw, acc[ai][bj][m][0] * rstd, acc[ai][bj][m][1] * rstd);
                }
            }
    }
};

struct EpiUq {
    static constexpr bool PERM = true, AFTER_DRAIN = false;
    unsigned char* ws;
    __device__ __forceinline__ void operator()(const f32x4 (&acc)[2][2][4][2], const pg8::Unit& u, int wr, int wc, int fr, int fq) const {
        const int pn = u.pn, rbase = u.pm * 256 + wr * 64 + fr, cw = wc * 32 + 8 * fq;
        const float* ropeC = (const float*)(ws + WS_ROPEC);
        __builtin_amdgcn_sched_barrier(0); asm volatile("" ::: "memory");
        float scv[8];
        { f32x4 sp[8];
#pragma unroll
          for (int q = 0; q < 8; ++q) sp[q] = *(const f32x4*)((const float*)(ws + WS_SSQCQ) + (size_t)(rbase + (q >> 2) * 128 + (q & 3) * 16) * 12 + 4 * (fq < 3 ? fq : 2));
#pragma unroll
          for (int q = 0; q < 8; ++q) { const float t = (sp[q][0] + sp[q][1]) + (sp[q][2] + sp[q][3]);
              const float t0 = __shfl(t, fr), t1 = __shfl(t, fr + 16), t2 = __shfl(t, fr + 32);
              scv[q] = rsqrtf(((t0 + t1) + t2) * (1.f / 768.f) + EPS) * (0.10206207261596575f * LOG2E); } }
        const int dd0 = (pn * 256 + cw) % 96, dd1 = (pn * 256 + 128 + cw) % 96;
        const int rb = (dd0 >= 64) ? 0 : ((dd1 >= 64) ? 1 : -1), ri0 = (((rb == 0) ? dd0 : dd1) - 64) >> 1;
#pragma unroll
        for (int ai = 0; ai < 2; ++ai) {
            f32x4 rcs[4], rsn[4];
            if (rb >= 0) {
#pragma unroll
                for (int m = 0; m < 4; ++m) { const int pos = (rbase + ai * 128 + m * 16) & 2047; rcs[m] = *(const f32x4*)(ropeC + pos * 32 + ri0); rsn[m] = *(const f32x4*)(ropeC + pos * 32 + 16 + ri0); } }
#pragma unroll
            for (int m = 0; m < 4; ++m) {
                asm volatile("" ::: "memory"); const int R = rbase + ai * 128 + m * 16;
                const float sc = scv[ai * 4 + m];
#pragma unroll
                for (int bj = 0; bj < 2; ++bj) {
                    const int c = pn * 256 + bj * 128 + cw, head = c / 96, dd = c - head * 96;
                    f32x4 a = acc[ai][bj][m][0], b = acc[ai][bj][m][1];
                    if (bj == rb) rope8v(a, b, rcs[m], rsn[m]);
                    st8((bf16_t*)(ws + WS_QO) + (size_t)R * 768 + c, a * sc, b * sc);
                }
            }
        }
    }
};

#define RLX_AGENT __ATOMIC_RELAXED, __HIP_MEMORY_SCOPE_AGENT
#define XB_TMO      128
#define XB_XCNT(j)  (256  + 64 * (j))
#define XB_XSUB(j)  (1280 + 64 * (j))
#define XB_XGEN(j)  (2304 + 64 * (j))
#define XB_TOP      3328
#define XB_TOPGEN   3392
#define XCD_BAR_WORDS 3456
#define XB_SPIN_CAP (1u << 18)

__device__ __forceinline__ unsigned xb_ld(unsigned* p)              { return __hip_atomic_load(p, __ATOMIC_RELAXED, __HIP_MEMORY_SCOPE_AGENT); }
__device__ __forceinline__ unsigned xb_add(unsigned* p, unsigned v) { return __hip_atomic_fetch_add(p, v, __ATOMIC_RELAXED, __HIP_MEMORY_SCOPE_AGENT); }
__device__ __forceinline__ unsigned xb_xcc_id() { return (unsigned)__builtin_amdgcn_s_getreg((3 << 11) | 20) & 0xFu; }
#define XB_SPIN(cond, bar) do { unsigned _sp = 0; while (cond) { __builtin_amdgcn_s_sleep(1); \
    if ((++_sp & 255u) == 0u) { if (xb_ld(&(bar)[XB_TMO])) break; if (_sp > XB_SPIN_CAP) { atomicAdd(&(bar)[XB_TMO], 1u); break; } } } } while (0)

struct XcdBarrier {
    unsigned* bar; unsigned x;
    volatile LAS unsigned* st;
};

__device__ __forceinline__ XcdBarrier xcd_barrier_post(unsigned* bar, volatile LAS unsigned* st) {
    XcdBarrier b; b.bar = bar; b.x = xb_xcc_id(); b.st = st;
    if (threadIdx.x == 0) (void)xb_add(&bar[XB_XCNT(b.x)], 1u);
    return b;
}
__device__ __forceinline__ void xcd_barrier_complete(unsigned* bar, unsigned x, unsigned& nloc, unsigned& nx) {
    const unsigned G = gridDim.x * gridDim.y * gridDim.z;
    unsigned sum, cnt, mine, sp = 0u;
    for (;;) {
        sum = 0u; cnt = 0u; mine = 0u;
#pragma unroll
        for (unsigned j = 0; j < 16; ++j) { const unsigned c = xb_ld(&bar[XB_XCNT(j)]); sum += c; cnt += (c > 0u) ? 1u : 0u; mine = (j == x) ? c : mine; }
        if (sum == G) break;
        __builtin_amdgcn_s_sleep(1);
        if ((++sp & 255u) == 0u) { if (xb_ld(&bar[XB_TMO])) break; if (sp > XB_SPIN_CAP) { atomicAdd(&bar[XB_TMO], 1u); break; } }
    }
    nloc = mine > 0u ? mine : 1u; nx = cnt > 0u ? cnt : 1u;
}

__device__ __forceinline__ void xcd_barrier(const XcdBarrier& b) {
    asm volatile("s_waitcnt vmcnt(0)" ::: "memory");
    __syncthreads();
    if (threadIdx.x == 0) {
        unsigned* bar = b.bar;
        __builtin_amdgcn_s_waitcnt(0);
        unsigned nloc = b.st[0], nx = b.st[1];
        if (nloc == 0u) { xcd_barrier_complete(bar, b.x, nloc, nx); b.st[0] = nloc; b.st[1] = nx; }
        const unsigned old = xb_add(&bar[XB_XSUB(b.x)], 1u);
        const unsigned gen = old / nloc;
        if (old + 1u == (gen + 1u) * nloc) {
            __builtin_amdgcn_fence(__ATOMIC_RELEASE, "agent");
            asm volatile("s_waitcnt vmcnt(0)" ::: "memory");
            (void)xb_add(&bar[XB_TOP], 1u);
        }
        const unsigned target = (gen + 1u) * nx;
        XB_SPIN((int)(xb_ld(&bar[XB_TOP]) - target) < 0, bar);
        __builtin_amdgcn_fence(__ATOMIC_ACQUIRE, "agent");
        asm volatile("s_waitcnt vmcnt(0)" ::: "memory");
    }
    __syncthreads();
}

__device__ __forceinline__ int crow(int r, int hi) { return (r & 3) + 8 * (r >> 2) + 4 * hi; }
typedef short v4i16_t __attribute__((ext_vector_type(4)));
__device__ __forceinline__ s16x4 vtr(const LAS unsigned char* p) { return __builtin_bit_cast(s16x4, __builtin_amdgcn_ds_read_tr16_b64_v4i16((LAS v4i16_t*)p)); }

template <int MODE>
__device__ __forceinline__ void attn_unit(LAS unsigned char* lds, unsigned char* ws, unsigned char* aux, const float* sink, int unit) {
    constexpr int DQK = (MODE == 2) ? 96 : 64, KST = DQK / 16, KS = DQK * 2 + 16, VS = 192, KBUF = 64 * KS, VBUF = 64 * VS;
    const int tid = my_tid(), lane = tid & 63, wid = __builtin_amdgcn_readfirstlane(tid >> 6), r32 = lane & 31, hi = lane >> 5;
    int b, head, hkv = 0, n = 0, Rq0, qpos0 = 0, nt, jlo = 0;
    const bf16_t* Qp; int qstride;
    if (MODE == 0) {
        const int hp = unit & 1; n = (unit >> 1) & 15; hkv = (unit >> 5) & 1; b = unit >> 6;
        head = hkv * 4 + hp * 2 + (wid >> 2); qpos0 = 128 * n + 32 * (wid & 3); Rq0 = b * 2048 + qpos0;
        Qp = (const bf16_t*)(ws + WS_QE) + (size_t)Rq0 * 512 + head * 64; qstride = 512;
        jlo = (n == 0) ? 2 : 0; const int jhi = (n == 15) ? 4 : 6; nt = 4 + (jhi - jlo);
    } else if (MODE == 1) {
        const int qh = unit & 1, hp = (unit >> 1) & 1; hkv = (unit >> 2) & 1; b = unit >> 3;
        head = hkv * 4 + hp * 2 + (wid >> 2); Rq0 = ML + b * 256 + 128 * qh + 32 * (wid & 3);
        Qp = (const bf16_t*)(ws + WS_QE) + (size_t)Rq0 * 512 + head * 64; qstride = 512; nt = 4;
    } else {
        const int qb = unit & 7; head = (unit >> 3) & 7; b = unit >> 6; Rq0 = b * 2048 + 256 * qb + 32 * wid;
        Qp = (const bf16_t*)(ws + WS_QO) + (size_t)Rq0 * 768 + head * 96; qstride = 768; nt = 36;
    }
    bf16x8 qf[KST];
#pragma unroll
    for (int s = 0; s < KST; ++s) qf[s] = *(const bf16x8*)(Qp + (size_t)r32 * qstride + 16 * s + 8 * hi);
    constexpr float THR = 6.0f;
    float mref, l_run;
    if (MODE == 2) { mref = 0.f; l_run = 0.f; } else { mref = sink[head] * LOG2E; l_run = (hi == 0) ? 1.f : 0.f; }
    f32x16 negm;
#pragma unroll
    for (int r = 0; r < 16; ++r) negm[r] = -mref;
    f32x16 o0, o1;
#pragma unroll
    for (int r = 0; r < 16; ++r) { o0[r] = 0.f; o1[r] = 0.f; }

    const int srow = tid >> 3, sch = tid & 7;
    const int voff = (4 * hi + ((lane & 15) >> 2)) * VS + (((lane >> 4) & 1) * 16 + 4 * (lane & 3)) * 2;
    u32x4 kregA, vregA, kreg2A, kregB, vregB, kreg2B;
    kreg2A = (u32x4){0u, 0u, 0u, 0u}; kreg2B = kreg2A;
#define ATT_SRC(t, kp, vp, k2p, kpos0v) do { \
        if (MODE == 0 || MODE == 1) { \
            if ((t) < 4) { kp = (const bf16_t*)(ws + WS_KVE) + (size_t)(ML + b * 256 + 64 * (t) + srow) * 256 + hkv * 64 + sch * 8; kpos0v = -100000; } \
            else { const int kp0_ = 128 * n - 128 + 64 * (jlo + (t) - 4); kpos0v = kp0_; \
                   kp = (const bf16_t*)(ws + WS_KVE) + (size_t)(b * 2048 + kp0_ + srow) * 256 + hkv * 64 + sch * 8; } \
            vp = kp + 128; k2p = kp; \
        } else { \
            const int pos0_ = 64 * (t); kpos0v = -100000; \
            kp = (const bf16_t*)(ws + WS_KNV) + ((size_t)(b * 8 + head) * 2304 + pos0_ + srow) * 128 + sch * 8; \
            vp = kp + 64; \
            const int krow_ = ((t) < 4) ? (ML + b * 256 + pos0_) : (b * 2048 + pos0_ - 256); \
            k2p = (const bf16_t*)(ws + WS_KR) + (size_t)(krow_ + (tid >> 2)) * 32 + (tid & 3) * 8; \
        } } while (0)
#define ATT_LOAD(t, KR_, VR_, K2_) do { const bf16_t *kp_, *vp_, *k2p_; int kq_; ATT_SRC(t, kp_, vp_, k2p_, kq_); (void)kq_; \
        KR_ = *(const u32x4*)kp_; VR_ = *(const u32x4*)vp_; if (MODE == 2 && tid < 256) K2_ = *(const u32x4*)k2p_; } while (0)
#define ATT_STORE(buf, KR_, VR_, K2_) do { LAS unsigned char* kb_ = lds + (buf) * KBUF; LAS unsigned char* vb_ = lds + 4 * KBUF + (buf) * VBUF; \
        *(LAS u32x4*)(kb_ + srow * KS + sch * 16) = KR_; \
        if (MODE == 2 && tid < 256) *(LAS u32x4*)(kb_ + (tid >> 2) * KS + 128 + (tid & 3) * 16) = K2_; \
        *(LAS u32x4*)(vb_ + srow * VS + sch * 16) = VR_; } while (0)
#define ATT_BARRIER() do { asm volatile("s_waitcnt lgkmcnt(0)" ::: "memory"); __builtin_amdgcn_s_barrier(); asm volatile("" ::: "memory"); } while (0)

#define ATT_COMPUTE(TT) do { const int buf = (TT) & 3; \
        int kpos0 = -100000; \
        if (MODE == 0 && (TT) >= 4) kpos0 = 128 * n - 128 + 64 * (jlo + (TT) - 4); \
        bool active = true; \
        if (MODE == 0 && (TT) >= 4) active = (kpos0 + 63 >= qpos0 - 128) && (kpos0 <= qpos0 + 31 + 128); \
        if (active) { \
            const LAS unsigned char* kb = lds + buf * KBUF; const LAS unsigned char* vb = lds + 4 * KBUF + buf * VBUF; \
            f32x16 p0 = negm, p1 = negm; \
_Pragma("unroll") \
            for (int s = 0; s < KST; ++s) { \
                const bf16x8 a0 = *(const LAS bf16x8*)(kb + r32 * KS + (16 * s + 8 * hi) * 2); \
                const bf16x8 a1 = *(const LAS bf16x8*)(kb + (32 + r32) * KS + (16 * s + 8 * hi) * 2); \
                p0 = __builtin_amdgcn_mfma_f32_32x32x16_bf16(a0, qf[s], p0, 0, 0, 0); \
                p1 = __builtin_amdgcn_mfma_f32_32x32x16_bf16(a1, qf[s], p1, 0, 0, 0); \
            } \
            if (MODE == 0 && (TT) >= 4 && !((kpos0 >= qpos0 - 97) && (kpos0 <= qpos0 + 65))) {     \
                const int qpos = qpos0 + r32; \
_Pragma("unroll") \
                for (int r = 0; r < 16; ++r) { const int d0 = kpos0 + crow(r, hi) - qpos, d1 = d0 + 32; \
                    if (d0 > 128 || d0 < -128) p0[r] = -INFINITY; if (d1 > 128 || d1 < -128) p1[r] = -INFINITY; } \
            } \
            float mxa = __builtin_fmaxf(__builtin_fmaxf(p0[0], p0[1]), p1[0]), mxb = __builtin_fmaxf(__builtin_fmaxf(p0[2], p0[3]), p1[1]); \
            mxa = __builtin_fmaxf(__builtin_fmaxf(mxa, p1[2]), p1[3]); \
_Pragma("unroll") \
            for (int r = 4; r < 16; r += 4) { mxa = __builtin_fmaxf(__builtin_fmaxf(mxa, p0[r]), p0[r + 1]); mxb = __builtin_fmaxf(__builtin_fmaxf(mxb, p0[r + 2]), p0[r + 3]); \
                mxa = __builtin_fmaxf(__builtin_fmaxf(mxa, p1[r]), p1[r + 1]); mxb = __builtin_fmaxf(__builtin_fmaxf(mxb, p1[r + 2]), p1[r + 3]); } \
            float mx = __builtin_fmaxf(mxa, mxb); \
            mx = __builtin_fmaxf(mx, __shfl_xor(mx, 32)); \
            const bool first = (MODE == 2) && ((TT) == 0); \
            if (first || __any(mx > THR)) { \
                const float delta = first ? mx : __builtin_fmaxf(mx, 0.f), alpha = first ? 1.f : __builtin_amdgcn_exp2f(-delta); \
                mref += delta; l_run *= alpha; \
_Pragma("unroll") \
                for (int r = 0; r < 16; ++r) { o0[r] *= alpha; o1[r] *= alpha; p0[r] -= delta; p1[r] -= delta; negm[r] = -mref; } \
            } \
            float rs0 = 0.f, rs1 = 0.f; \
_Pragma("unroll") \
            for (int r = 0; r < 16; ++r) { p0[r] = __builtin_amdgcn_exp2f(p0[r]); p1[r] = __builtin_amdgcn_exp2f(p1[r]); rs0 += p0[r]; rs1 += p1[r]; } \
            l_run += rs0 + rs1; \
            u32x4 pw[4]; \
            pw[0] = (u32x4){pk2(p0[0], p0[1]), pk2(p0[2], p0[3]), pk2(p0[4], p0[5]), pk2(p0[6], p0[7])}; \
            pw[1] = (u32x4){pk2(p0[8], p0[9]), pk2(p0[10], p0[11]), pk2(p0[12], p0[13]), pk2(p0[14], p0[15])}; \
            pw[2] = (u32x4){pk2(p1[0], p1[1]), pk2(p1[2], p1[3]), pk2(p1[4], p1[5]), pk2(p1[6], p1[7])}; \
            pw[3] = (u32x4){pk2(p1[8], p1[9]), pk2(p1[10], p1[11]), pk2(p1[12], p1[13]), pk2(p1[14], p1[15])}; \
_Pragma("unroll") \
            for (int s2 = 0; s2 < 4; ++s2) { \
                const bf16x8 pb = __builtin_bit_cast(bf16x8, pw[s2]); \
                const LAS unsigned char* va0 = vb + (16 * s2) * VS + voff; \
                const s16x4 l0 = vtr(va0), h0 = vtr(va0 + 8 * VS), l1 = vtr(va0 + 64), h1 = vtr(va0 + 8 * VS + 64); \
                const bf16x8 v0 = (bf16x8){l0[0], l0[1], l0[2], l0[3], h0[0], h0[1], h0[2], h0[3]}; \
                const bf16x8 v1 = (bf16x8){l1[0], l1[1], l1[2], l1[3], h1[0], h1[1], h1[2], h1[3]}; \
                o0 = __builtin_amdgcn_mfma_f32_32x32x16_bf16(v0, pb, o0, 0, 0, 0); \
                o1 = __builtin_amdgcn_mfma_f32_32x32x16_bf16(v1, pb, o1, 0, 0, 0); \
            } \
        } \
        } while (0)

    ATT_LOAD(0, kregA, vregA, kreg2A); ATT_LOAD(1, kregB, vregB, kreg2B);
    ATT_STORE(0, kregA, vregA, kreg2A); ATT_STORE(1, kregB, vregB, kreg2B);
    if (2 < nt) { ATT_LOAD(2, kregA, vregA, kreg2A); ATT_LOAD(3, kregB, vregB, kreg2B); }
    ATT_BARRIER();
    const int Rq = Rq0 + r32;
    const bf16_t* zrow = (MODE == 2) ? (const bf16_t*)(aux + AUX_ZO) + (size_t)Rq * 512 + head * 64 : (const bf16_t*)(ws + WS_ZA) + (size_t)Rq * 512 + head * 64;
    u32x2 zz[8];
#pragma unroll
    for (int g = 0; g < 8; ++g) zz[g] = (u32x2){0u, 0u};
    for (int t = 0; t < nt; t += 2) {
        if (t + 2 >= nt) {
#pragma unroll
            for (int g = 0; g < 4; ++g) { zz[2 * g] = *(const u32x2*)(zrow + 8 * g + 4 * hi); zz[2 * g + 1] = *(const u32x2*)(zrow + 32 + 8 * g + 4 * hi); } }
        ATT_COMPUTE(t);
        ATT_COMPUTE(t + 1);
        if (t + 2 < nt) { ATT_STORE((t + 2) & 3, kregA, vregA, kreg2A); ATT_STORE((t + 3) & 3, kregB, vregB, kreg2B); }
        if (t + 4 < nt) { ATT_LOAD(t + 4, kregA, vregA, kreg2A); ATT_LOAD(t + 5, kregB, vregB, kreg2B); }
        ATT_BARRIER();
    }
#undef ATT_COMPUTE
#undef ATT_BARRIER
#undef ATT_SRC
#undef ATT_LOAD
#undef ATT_STORE
    const float l_tot = l_run + __shfl_xor(l_run, 32), inv = __builtin_amdgcn_rcpf(l_tot);
    bf16_t* urow = (bf16_t*)(ws + WS_U) + (size_t)Rq * 1024 + head * 64;
#pragma unroll
    for (int g = 0; g < 4; ++g) {
        const int dv = 8 * g + 4 * hi;
        { const u32x2 z = zz[2 * g];
          u32x2 w; w.x = pk2(o0[4 * g] * inv * bf_lo(z.x), o0[4 * g + 1] * inv * bf_hi(z.x)); w.y = pk2(o0[4 * g + 2] * inv * bf_lo(z.y), o0[4 * g + 3] * inv * bf_hi(z.y));
          *(u32x2*)(urow + dv) = w; }
        { const u32x2 z = zz[2 * g + 1];
          u32x2 w; w.x = pk2(o1[4 * g] * inv * bf_lo(z.x), o1[4 * g + 1] * inv * bf_hi(z.x)); w.y = pk2(o1[4 * g + 2] * inv * bf_lo(z.y), o1[4 * g + 3] * inv * bf_hi(z.y));
          *(u32x2*)(urow + 32 + dv) = w; }
    }
}


__device__ __forceinline__ int srcmap(int mat, int dn) {
    if (mat == 0) {
        if (dn < 128) { const int d = dn & 63; return (dn & 64) + (d >> 1) + 32 * (d & 1); }
        if (dn < 256) return dn;
        if (dn < 768) { const int j = dn - 256, d = j & 63; return 256 + (j & ~63) + (d >> 1) + 32 * (d & 1); }
        if (dn < 1792) { const int j = dn - 768, blk = j >> 8, w = j & 255; return (w < 128) ? 1280 + blk * 128 + w : 1792 + blk * 128 + (w - 128); }
        if (dn < 2816) { const int j = dn - 1792, blk = j >> 8, w = j & 255; return (w < 128) ? 768 + blk * 128 + w : 2816 + blk * 128 + (w - 128); }
        return 2304 + (dn - 2816);
    }
    if (mat == 2) {
        if (dn < 256) return dn;
        if (dn < 512) return 288 + (dn - 256);
        if (dn < 1024) return 544 + (dn - 512);
        if (dn < 1280) { const int w = dn - 1024; if (w < 32) return 256 + (w >> 1) + 16 * (w & 1); if (w < 48) return 1056 + (w - 32); return -1; }
        if (dn < 2048) return 1072 + (dn - 1280);
        if (dn < 2304) return 1840 + (dn - 2048);
        if (dn < 3328) { const int j = dn - 2304, blk = j >> 8, w = j & 255; return (w < 128) ? 2096 + blk * 128 + w : 2608 + 512 + blk * 128 + (w - 128); }
        return 2608 + (dn - 3328);
    }
    if (mat == 3) {
        const int head = dn / 96, d = dn - head * 96; if (d < 64) return dn; const int w = d - 64; return head * 96 + 64 + (w >> 1) + 16 * (w & 1);
    }
    return dn;
}
__device__ __forceinline__ void p0_transpose_item(const float* W, int K, int Nsrc, bf16_t* WT, int mat, const float* kscale, LAS float* scr, int item, int nblk, int lane) {
    const int kb = item / nblk, nb = item % nblk, k0 = 64 * kb, n0 = 32 * nb;
    const int sc = srcmap(mat, n0 + (lane & 31));
    float v[32];
    const float* wp = W + (size_t)(k0 + (lane >> 5)) * Nsrc + (sc >= 0 ? sc : 0);
#pragma unroll
    for (int i = 0; i < 32; ++i) v[i] = wp[(size_t)(2 * i) * Nsrc];
#pragma unroll
    for (int i = 0; i < 32; ++i) { const int kk = 2 * i + (lane >> 5); float x = (sc >= 0) ? v[i] : 0.f; if (kscale) x *= kscale[k0 + kk]; scr[kk * 33 + (lane & 31)] = x; }
    LDS_WAIT(); asm volatile("" ::: "memory");
    const int c = lane & 7;
#pragma unroll
    for (int j = 0; j < 4; ++j) { const int n = (lane >> 3) + 8 * j; const LAS float* s = scr + (8 * c) * 33 + n;
        u32x4 o; o.x = pk2(s[0 * 33], s[1 * 33]); o.y = pk2(s[2 * 33], s[3 * 33]); o.z = pk2(s[4 * 33], s[5 * 33]); o.w = pk2(s[6 * 33], s[7 * 33]);
        *(u32x4*)(WT + (size_t)(n0 + n) * K + k0 + 8 * c) = o; }
    LDS_WAIT(); asm volatile("" ::: "memory");
}

__device__ __forceinline__ void p0_mod(LAS unsigned char* lds, const float* c, const float* c_ctx, const float* mod_w, const float* mod_b, float* MOD, int G) {
    const int tid = my_tid();
    if ((int)blockIdx.x >= 192) return;
    LAS float* scs = (LAS float*)lds;
    LAS float* red = (LAS float*)(lds + 1024 * 20 * 4);
    { float cv[34];
#pragma unroll
      for (int u = 0; u < 34; ++u) { const int idx = tid + u * NTHREADS, r = idx >> 10, k = idx & 1023; cv[u] = (r < 16) ? c[r * 1024 + k] : c_ctx[k]; }
#pragma unroll
      for (int u = 0; u < 34; ++u) { const int idx = tid + u * NTHREADS, r = idx >> 10, k = idx & 1023; scs[k * 20 + r] = silu_f(cv[u]); } }
    __syncthreads();
    for (int item = blockIdx.x; item < 192; item += G) {
        const int l = item / 96, n0 = (item % 96) * 32, col = tid & 31, kg = tid >> 5;
        float acc[20];
#pragma unroll
        for (int r = 0; r < 20; ++r) acc[r] = 0.f;
        const float* wp = mod_w + ((size_t)l * 1024 + kg * 64) * 3072 + n0 + col;
#pragma unroll
        for (int kb = 0; kb < 4; ++kb) {
            float w[16];
#pragma unroll
            for (int u = 0; u < 16; ++u) w[u] = wp[(size_t)(kb * 16 + u) * 3072];
#pragma unroll
            for (int u = 0; u < 16; ++u) { const LAS f32x4* sp = (const LAS f32x4*)(scs + (kg * 64 + kb * 16 + u) * 20);
#pragma unroll
                for (int q = 0; q < 5; ++q) { const f32x4 s = sp[q]; acc[4 * q] += s[0] * w[u]; acc[4 * q + 1] += s[1] * w[u]; acc[4 * q + 2] += s[2] * w[u]; acc[4 * q + 3] += s[3] * w[u]; } }
        }
#pragma unroll
        for (int r = 0; r < 17; ++r) red[(kg * 17 + r) * 32 + col] = acc[r];
        __syncthreads();
        for (int o = tid; o < 17 * 32; o += NTHREADS) { const int r = o >> 5, cc = o & 31; float s = mod_b[l * 3072 + n0 + cc];
#pragma unroll
            for (int g = 0; g < 16; ++g) s += red[(g * 17 + r) * 32 + cc];
            MOD[((size_t)l * 17 + r) * 3072 + n0 + cc] = s; }
        __syncthreads();
    }
}

__device__ __forceinline__ void norm_mod_store(const f32x4 (&v)[4], const float* pre_w, const float* modrow, bf16_t* hrow, int lane) {
    float ss = 0.f;
#pragma unroll
    for (int j = 0; j < 4; ++j) ss += sq4(v[j]);
    const float rstd = rsqrtf(wave_sum(ss) * (1.f / 1024.f) + EPS);
#pragma unroll
    for (int j = 0; j < 4; ++j) { const int k = 4 * (lane + 64 * j);
        const f32x4 w = *(const f32x4*)(pre_w + k), sh = *(const f32x4*)(modrow + k), sc = *(const f32x4*)(modrow + 1024 + k);
        const f32x4 h = v[j] * rstd * w * (sc + 1.0f) + sh;
        u32x2 o; o.x = pk2(h[0], h[1]); o.y = pk2(h[2], h[3]); *(u32x2*)(hrow + k) = o; }
}
__device__ __forceinline__ void norm_mod_store_wt(const f32x4 (&v)[4], const float* pre_w, const float* modrow, bf16_t* hrow, int lane) {
    float ss = 0.f;
#pragma unroll
    for (int j = 0; j < 4; ++j) ss += sq4(v[j]);
    const float rstd = rsqrtf(wave_sum(ss) * (1.f / 1024.f) + EPS);
#pragma unroll
    for (int j = 0; j < 4; ++j) { const int k = 4 * (lane + 64 * j);
        const f32x4 w = *(const f32x4*)(pre_w + k), sh = *(const f32x4*)(modrow + k), sc = *(const f32x4*)(modrow + 1024 + k);
        const f32x4 h = v[j] * rstd * w * (sc + 1.0f) + sh;
        __hip_atomic_store((unsigned long long*)(hrow + k), (unsigned long long)pk2(h[0], h[1]) | ((unsigned long long)pk2(h[2], h[3]) << 32), __ATOMIC_RELAXED, __HIP_MEMORY_SCOPE_AGENT); }
}
__device__ __forceinline__ void p1_stream(const float* x, const float* ctx, const float* pre_w, const float* MOD, bf16_t* H, unsigned* ready, int sw, int nsw, int lane) {
    f32x4 cur[4][4], nxt[4][4];
#define P1_LOAD(dst, R_) do { if ((R_) < MT) { const float* src_ = ((R_) < ML) ? x + (size_t)(R_) * 1024 : ctx + (size_t)((R_) - ML) * 1024; \
        _Pragma("unroll") for (int j = 0; j < 4; ++j) dst[j] = *(const f32x4*)(src_ + 4 * (lane + 64 * j)); } } while (0)
#pragma unroll
    for (int q = 0; q < 4; ++q) P1_LOAD(cur[q], sw + nsw * q);
    for (int R0 = sw; R0 < MT; R0 += 4 * nsw) {
#pragma unroll
        for (int q = 0; q < 4; ++q) P1_LOAD(nxt[q], R0 + nsw * (4 + q));
#pragma unroll
        for (int q = 0; q < 4; ++q) { const int R = R0 + nsw * q; if (R < MT) { const int bi = (R < ML) ? (R >> 11) : 16;
            norm_mod_store_wt(cur[q], pre_w, MOD + (size_t)bi * 3072, H + (size_t)R * 1024, lane); } }
        asm volatile("s_waitcnt vmcnt(0)" ::: "memory");
        if (lane < 4) { const int R = R0 + nsw * lane; if (R < MT) __hip_atomic_fetch_add(ready + 64 * (R >> 8), 1u, __ATOMIC_RELAXED, __HIP_MEMORY_SCOPE_AGENT); }
#pragma unroll
        for (int q = 0; q < 4; ++q)
#pragma unroll
            for (int j = 0; j < 4; ++j) cur[q][j] = nxt[q][j];
    }
#undef P1_LOAD
}
__device__ __forceinline__ void p1_prenorm(const float* x, const float* ctx, const float* pre_w, const float* MOD, bf16_t* H, int gw, int ngw, int lane) {
    f32x4 cur[4], nxt[4];
#define P1_LOAD(dst, R_) do { const float* src_ = ((R_) < ML) ? x + (size_t)(R_) * 1024 : ctx + (size_t)((R_) - ML) * 1024; \
        _Pragma("unroll") for (int j = 0; j < 4; ++j) dst[j] = *(const f32x4*)(src_ + 4 * (lane + 64 * j)); } while (0)
    if (gw < MT) P1_LOAD(cur, gw);
    for (int R = gw; R < MT; R += ngw) {
        const int Rn = R + ngw; if (Rn < MT) P1_LOAD(nxt, Rn);
        const int bi = (R < ML) ? (R >> 11) : 16;
        norm_mod_store(cur, pre_w, MOD + (size_t)bi * 3072, H + (size_t)R * 1024, lane);
#pragma unroll
        for (int j = 0; j < 4; ++j) cur[j] = nxt[j];
    }
#undef P1_LOAD
}
__device__ __forceinline__ float ssq16(const float* p) {
    const f32x4 a = *(const f32x4*)p, b = *(const f32x4*)(p + 4), c = *(const f32x4*)(p + 8), d = *(const f32x4*)(p + 12);
    return (((a[0] + a[1]) + (a[2] + a[3])) + ((b[0] + b[1]) + (b[2] + b[3]))) + (((c[0] + c[1]) + (c[2] + c[3])) + ((d[0] + d[1]) + (d[2] + d[3])));
}
__device__ __forceinline__ void p5_post_pre(const float* x, const float* ctx, const float* post_w0, const float* pre_w1, const float* MOD, const bf16_t* Y, const float* SSQ, bf16_t* X1, bf16_t* H, int gw, int ngw, int lane) {
    f32x4 xc[4], xn[4]; u32x2 yc[4], yn[4];
#define P5_LOAD(xd, yd, R_) do { const float* src_ = ((R_) < ML) ? x + (size_t)(R_) * 1024 : ctx + (size_t)((R_) - ML) * 1024; \
        _Pragma("unroll") for (int j = 0; j < 4; ++j) { xd[j] = *(const f32x4*)(src_ + 4 * (lane + 64 * j)); yd[j] = *(const u32x2*)(Y + (size_t)(R_) * 1024 + 4 * (lane + 64 * j)); } } while (0)
    if (gw < MT) P5_LOAD(xc, yc, gw);
    for (int R = gw; R < MT; R += ngw) {
        const int Rn = R + ngw; if (Rn < MT) P5_LOAD(xn, yn, Rn);
        const int bi = (R < ML) ? (R >> 11) : 16;
        const float rstd_y = rsqrtf(ssq16(SSQ + (size_t)R * 16) * (1.f / 1024.f) + EPS);
        const float* m0 = MOD + (size_t)bi * 3072;
        f32x4 v[4];
#pragma unroll
        for (int j = 0; j < 4; ++j) { const int k = 4 * (lane + 64 * j);
            const f32x4 y = (f32x4){bf_lo(yc[j].x), bf_hi(yc[j].x), bf_lo(yc[j].y), bf_hi(yc[j].y)};
            const f32x4 g = *(const f32x4*)(m0 + 2048 + k), pw = *(const f32x4*)(post_w0 + k);
            v[j] = xc[j] + g * (y * rstd_y * pw);
            if (R < ML) { u32x2 o; o.x = pk2(v[j][0], v[j][1]); o.y = pk2(v[j][2], v[j][3]); *(u32x2*)(X1 + (size_t)R * 1024 + k) = o; } }
        norm_mod_store(v, pre_w1, MOD + (size_t)(17 + bi) * 3072, H + (size_t)R * 1024, lane);
#pragma unroll
        for (int j = 0; j < 4; ++j) { xc[j] = xn[j]; yc[j] = yn[j]; }
    }
#undef P5_LOAD
}
__device__ __forceinline__ void p11_final(const float* post_w1, const float* MOD, const bf16_t* Y, const float* SSQ, const bf16_t* X1, float* out, int gw, int ngw, int lane) {
    u32x2 xc[4], xn[4], yc[4], yn[4];
#define P11_LOAD(xd, yd, R_) do { _Pragma("unroll") for (int j = 0; j < 4; ++j) { xd[j] = *(const u32x2*)(X1 + (size_t)(R_) * 1024 + 4 * (lane + 64 * j)); yd[j] = *(const u32x2*)(Y + (size_t)(R_) * 1024 + 4 * (lane + 64 * j)); } } while (0)
    if (gw < ML) P11_LOAD(xc, yc, gw);
    for (int R = gw; R < ML; R += ngw) {
        const int Rn = R + ngw; if (Rn < ML) P11_LOAD(xn, yn, Rn);
        const float rstd_y = rsqrtf(ssq16(SSQ + (size_t)R * 16) * (1.f / 1024.f) + EPS);
        const float* m1 = MOD + (size_t)(17 + (R >> 11)) * 3072;
#pragma unroll
        for (int j = 0; j < 4; ++j) { const int k = 4 * (lane + 64 * j);
            const f32x4 y = (f32x4){bf_lo(yc[j].x), bf_hi(yc[j].x), bf_lo(yc[j].y), bf_hi(yc[j].y)};
            const f32x4 g = *(const f32x4*)(m1 + 2048 + k), pw = *(const f32x4*)(post_w1 + k), xv = (f32x4){bf_lo(xc[j].x), bf_hi(xc[j].x), bf_lo(xc[j].y), bf_hi(xc[j].y)};
            *(f32x4*)(out + (size_t)R * 1024 + k) = xv + g * (y * rstd_y * pw); }
#pragma unroll
        for (int j = 0; j < 4; ++j) { xc[j] = xn[j]; yc[j] = yn[j]; }
    }
#undef P11_LOAD
}
__device__ __forceinline__ void p3_conv(unsigned char* ws, const float* conv_w, int gtid, int ngt) {
    const bf16_t* PE = (const bf16_t*)(ws + WS_PE); const bf16_t* GE = (const bf16_t*)(ws + WS_GE); bf16_t* U = (bf16_t*)(ws + WS_U);
    for (int it = gtid; it < MT * 64; it += ngt) {
        const int R = it >> 6, ch = (it & 63) * 8;
        int t, T; if (R < ML) { t = R & 2047; T = 2048; } else { t = (R - ML) & 255; T = 256; }
        const u32x4 z4 = (u32x4){0u, 0u, 0u, 0u};
        const u32x4 pc = *(const u32x4*)(PE + (size_t)R * 512 + ch);
        const u32x4 pm = (t > 0) ? *(const u32x4*)(PE + (size_t)(R - 1) * 512 + ch) : z4;
        const u32x4 pp = (t < T - 1) ? *(const u32x4*)(PE + (size_t)(R + 1) * 512 + ch) : z4;
        const u32x4 g = *(const u32x4*)(GE + (size_t)R * 512 + ch);
        const f32x4 w0a = *(const f32x4*)(conv_w + ch), w0b = *(const f32x4*)(conv_w + ch + 4), w1a = *(const f32x4*)(conv_w + 512 + ch), w1b = *(const f32x4*)(conv_w + 512 + ch + 4),
                    w2a = *(const f32x4*)(conv_w + 1024 + ch), w2b = *(const f32x4*)(conv_w + 1024 + ch + 4);
        u32x4 o;
#define CV(pmw, pcw, ppw, gw_, wa, wb, wc_, e0, e1) pk2(bf_lo(gw_) * (wa[e0] * bf_lo(pmw) + wb[e0] * bf_lo(pcw) + wc_[e0] * bf_lo(ppw)), bf_hi(gw_) * (wa[e1] * bf_hi(pmw) + wb[e1] * bf_hi(pcw) + wc_[e1] * bf_hi(ppw)))
        o.x = CV(pm.x, pc.x, pp.x, g.x, w0a, w1a, w2a, 0, 1); o.y = CV(pm.y, pc.y, pp.y, g.y, w0a, w1a, w2a, 2, 3);
        o.z = CV(pm.z, pc.z, pp.z, g.z, w0b, w1b, w2b, 0, 1); o.w = CV(pm.w, pc.w, pp.w, g.w, w0b, w1b, w2b, 2, 3);
#undef CV
        *(u32x4*)(U + (size_t)R * 1024 + 512 + ch) = o;
    }
}
__device__ __forceinline__ void p9_readout(unsigned char* ws, unsigned char* aux, const float* hn_w, int gw, int ngw, int lane) {
    const bf16_t* HM = (const bf16_t*)(ws + WS_HM); const bf16_t* MO = (const bf16_t*)(aux + AUX_MO); bf16_t* U = (bf16_t*)(ws + WS_U);
    for (int R = gw; R < ML; R += ngw) {
        const int ch = 8 * lane;
        const u32x4 h0 = *(const u32x4*)(HM + (size_t)R * 512 + ch), h1 = *(const u32x4*)(HM + ((size_t)ML + R) * 512 + ch);
        float hs[8] = {bf_lo(h0.x) + bf_lo(h1.x), bf_hi(h0.x) + bf_hi(h1.x), bf_lo(h0.y) + bf_lo(h1.y), bf_hi(h0.y) + bf_hi(h1.y),
                       bf_lo(h0.z) + bf_lo(h1.z), bf_hi(h0.z) + bf_hi(h1.z), bf_lo(h0.w) + bf_lo(h1.w), bf_hi(h0.w) + bf_hi(h1.w)};
        float ss = 0.f;
#pragma unroll
        for (int e = 0; e < 8; ++e) ss += hs[e] * hs[e];
        ss += __shfl_xor(ss, 1); ss += __shfl_xor(ss, 2); ss += __shfl_xor(ss, 4); ss += __shfl_xor(ss, 8);
        const float rstd = rsqrtf(ss * (1.f / 128.f) + EPS);
        const u32x4 mo = *(const u32x4*)(MO + (size_t)R * 512 + ch);
        const f32x4 wa = *(const f32x4*)(hn_w + ch), wb = *(const f32x4*)(hn_w + ch + 4);
        u32x4 o;
        o.x = pk2(hs[0] * rstd * wa[0] * bf_lo(mo.x), hs[1] * rstd * wa[1] * bf_hi(mo.x));
        o.y = pk2(hs[2] * rstd * wa[2] * bf_lo(mo.y), hs[3] * rstd * wa[3] * bf_hi(mo.y));
        o.z = pk2(hs[4] * rstd * wb[0] * bf_lo(mo.z), hs[5] * rstd * wb[1] * bf_hi(mo.z));
        o.w = pk2(hs[6] * rstd * wb[2] * bf_lo(mo.w), hs[7] * rstd * wb[3] * bf_hi(mo.w));
        *(u32x4*)(U + (size_t)R * 1024 + 512 + ch) = o;
    }
}


typedef float f32x4v __attribute__((ext_vector_type(4)));
#define LDS_BARRIER() do { asm volatile("s_waitcnt lgkmcnt(0)" ::: "memory"); __builtin_amdgcn_s_barrier(); asm volatile("" ::: "memory"); } while (0)
#define MFMA_FENCE(x) do { __builtin_amdgcn_sched_barrier(0); asm volatile("s_nop 15\n\ts_nop 15" : "+v"(x)); __builtin_amdgcn_sched_barrier(0); } while (0)
__device__ __forceinline__ bf16x8 tr8(const LAS unsigned char* p, int halfstride) {
    const s16x4 lo = vtr(p), hi = vtr(p + halfstride);
    return (bf16x8){lo[0], lo[1], lo[2], lo[3], hi[0], hi[1], hi[2], hi[3]};
}
__device__ __forceinline__ bf16x8 gather8(const LAS unsigned char* img, int stride, int row0, int col) {
    bf16x8 r;
#pragma unroll
    for (int e = 0; e < 8; ++e) r[e] = *(const LAS short*)(img + (row0 + e) * stride + col * 2);
    return r;
}
template <int CTRL, int RM> __device__ __forceinline__ float dppf(float oldv, float v) {
    return __int_as_float(__builtin_amdgcn_update_dpp(__float_as_int(oldv), __float_as_int(v), CTRL, RM, 0xf, false));
}
__device__ __forceinline__ float wave_scan_add(float v) {
    v += dppf<0x111, 0xf>(0.f, v); v += dppf<0x112, 0xf>(0.f, v); v += dppf<0x114, 0xf>(0.f, v); v += dppf<0x118, 0xf>(0.f, v);
    v += dppf<0x142, 0xa>(0.f, v); v += dppf<0x143, 0xc>(0.f, v);
    return v;
}
__device__ __forceinline__ float wave_scan_max(float v) {
    const float ninf = -INFINITY;
    v = fmaxf(v, dppf<0x111, 0xf>(ninf, v)); v = fmaxf(v, dppf<0x112, 0xf>(ninf, v)); v = fmaxf(v, dppf<0x114, 0xf>(ninf, v)); v = fmaxf(v, dppf<0x118, 0xf>(ninf, v));
    v = fmaxf(v, dppf<0x142, 0xa>(ninf, v)); v = fmaxf(v, dppf<0x143, 0xc>(ninf, v));
    return v;
}
template <bool DUMMY> __device__ __forceinline__ void mlstm_chain_mfma(LAS unsigned char* lds, unsigned char* ws, unsigned char* aux, const float* i_bias, const float* f_bias, int chain) {
    constexpr int RS = 144, VS = 176;
    constexpr int QI = 0, KI = 9216, SC = 18432, CI = 27648, VI = 39168, VW = 50432, VEC = 61696;
    const int tid = my_tid(), lane = tid & 63, wid = __builtin_amdgcn_readfirstlane(tid >> 6), l15 = lane & 15, kg = lane >> 4;
    const int vh = chain & 1, d = (chain >> 1) & 1, h = (chain >> 2) & 3, b = chain >> 4;
    LAS float* vb_ = (LAS float*)(lds + VEC); LAS float* vab = vb_ + 64; LAS float* vcm = vab + 64; LAS float* vwp = vcm + 64; LAS float* vsc = vwp + 64;
    const bf16_t* MK = (const bf16_t*)(ws + WS_MK); const bf16_t* MV = (const bf16_t*)(ws + WS_MV); const bf16_t* MQ = (const bf16_t*)(aux + AUX_MQ);
    const float* GT = (const float*)(ws + WS_GATES); bf16_t* HM = (bf16_t*)(ws + WS_HM);
    const float ib = i_bias[d * 4 + h], fb = f_bias[d * 4 + h];
    for (int idx = tid; idx < 80 * RS / 4; idx += NTHREADS) ((LAS unsigned*)(lds + CI))[idx] = 0u;
    if (tid < 64) { LAS unsigned* a = (LAS unsigned*)(lds + VI + tid * VS + 128); LAS unsigned* w = (LAS unsigned*)(lds + VW + tid * VS + 128);
#pragma unroll
        for (int e = 0; e < 8; ++e) { a[e] = (e == 0) ? 0x3F80u : 0u; w[e] = 0u; } }
    const int it = wid & 3, vg = wid >> 2;
    f32x4v cacc[3];
#pragma unroll
    for (int t = 0; t < 3; ++t) cacc[t] = (f32x4v){0.f, 0.f, 0.f, 0.f};
    float mst = 0.f;
    unsigned nbad = 0u;
    const int srow = tid >> 3, sch = tid & 7;
    const int q4 = l15 >> 2, p4 = l15 & 3;
    u32x4 kkN, vvN, qqN = (u32x4){0u, 0u, 0u, 0u}; float liN = 0.f, fpN = 0.f;
#define MLSTM_LOADS(S_) do { const bool lat_ = (S_) >= 4; const int c_ = lat_ ? (S_) - 4 : (S_), T_ = lat_ ? 2048 : 256, rowb_ = lat_ ? b * 2048 : ML + b * 256; \
        const int tok_ = (d == 0) ? 64 * c_ + srow : T_ - 1 - (64 * c_ + srow); const size_t R_ = (size_t)(rowb_ + tok_); \
        kkN = *(const u32x4*)(MK + R_ * 256 + h * 64 + sch * 8); vvN = *(const u32x4*)(MV + R_ * 512 + h * 128 + vh * 64 + sch * 8); \
        if (lat_) qqN = *(const u32x4*)(MQ + R_ * 256 + h * 64 + sch * 8); \
        if (wid == 0) { const int tk_ = (d == 0) ? 64 * c_ + lane : T_ - 1 - (64 * c_ + lane); const float* gp_ = GT + (size_t)(rowb_ + tk_) * 16 + d * 8 + h; liN = gp_[0]; fpN = gp_[4]; } } while (0)
    MLSTM_LOADS(0);
    for (int step = 0; step < 36; ++step) {
        const bool lat = step >= 4; const int c = lat ? step - 4 : step, T = lat ? 2048 : 256, rowb = lat ? b * 2048 : ML + b * 256;
        const int tok = (d == 0) ? 64 * c + srow : T - 1 - (64 * c + srow); const size_t R = (size_t)(rowb + tok);
        const u32x4 kk = kkN, vv = vvN, qq = qqN;
        if (wid == 0) {
            const float li = liN + ib, fp = fpN + fb;
            const float lf = fminf(fp, 0.f) - __logf(1.f + __expf(-fabsf(fp)));
            const float bc = wave_scan_add(lf);
            const float ab = li - bc; const float cm = wave_scan_max(ab);
            const float g = __int_as_float(__builtin_amdgcn_readlane(__float_as_int(bc), 63)), mloc = g + __int_as_float(__builtin_amdgcn_readlane(__float_as_int(cm), 63)), m_new = fmaxf(g + mst, mloc);
            vb_[lane] = bc; vab[lane] = ab; vcm[lane] = cm; vwp[lane] = __expf(g + ab - m_new);
            if (lane == 0) { vsc[0] = mst; vsc[1] = __expf(g + mst - m_new); }
            mst = m_new;
        }
        LDS_BARRIER();
        { const float wj = vwp[srow];
          *(LAS u32x4*)(lds + KI + srow * RS + sch * 16) = kk;
          *(LAS u32x4*)(lds + VI + srow * VS + sch * 16) = vv;
          u32x4 vw; vw.x = pk2(bf_lo(vv.x) * wj, bf_hi(vv.x) * wj); vw.y = pk2(bf_lo(vv.y) * wj, bf_hi(vv.y) * wj); vw.z = pk2(bf_lo(vv.z) * wj, bf_hi(vv.z) * wj); vw.w = pk2(bf_lo(vv.w) * wj, bf_hi(vv.w) * wj);
          *(LAS u32x4*)(lds + VW + srow * VS + sch * 16) = vw;
          if (sch == 0) *(LAS unsigned short*)(lds + VW + srow * VS + 128) = f2bf(wj);
          if (lat) *(LAS u32x4*)(lds + QI + srow * RS + sch * 16) = qq; }
        LDS_BARRIER();
        const float m_in = vsc[0], a_prev = vsc[1];
        if (step + 1 < 36) MLSTM_LOADS(step + 1);
        bf16x8 qf[2];
        if (lat) {
            qf[0] = *(const LAS bf16x8*)(lds + QI + (16 * it + l15) * RS + (8 * kg) * 2); qf[1] = *(const LAS bf16x8*)(lds + QI + (16 * it + l15) * RS + (8 * kg + 32) * 2);
            const int i = 16 * it + l15; const float mi = fmaxf(m_in, vcm[i]);
#pragma unroll
            for (int t = 0; t < 2; ++t) {
                const int jt = 2 * vg + t; u32x2 o = (u32x2){0u, 0u};
                if (jt <= it) {
                    const bf16x8 k0 = *(const LAS bf16x8*)(lds + KI + (16 * jt + l15) * RS + (8 * kg) * 2), k1 = *(const LAS bf16x8*)(lds + KI + (16 * jt + l15) * RS + (8 * kg + 32) * 2);
                    f32x4v s = (f32x4v){0.f, 0.f, 0.f, 0.f};
                    s = __builtin_amdgcn_mfma_f32_16x16x32_bf16(k0, qf[0], s, 0, 0, 0); s = __builtin_amdgcn_mfma_f32_16x16x32_bf16(k1, qf[1], s, 0, 0, 0); MFMA_FENCE(s);
                    const int j0 = 16 * jt + 4 * kg; const f32x4v abv = *(const LAS f32x4v*)(vab + j0);
                    float e[4];
#pragma unroll
                    for (int r = 0; r < 4; ++r) e[r] = (j0 + r <= i) ? s[r] * __expf(abv[r] - mi) : 0.f;
                    o.x = pk2(e[0], e[1]); o.y = pk2(e[2], e[3]);
                }
                *(LAS u32x2*)(lds + SC + i * RS + (16 * jt + 4 * kg) * 2) = o;
            }
        }
        LDS_BARRIER();
        f32x4v cnew[3];
        { bf16x8 aK[2];
#pragma unroll
          for (int s = 0; s < 2; ++s) aK[s] = tr8(lds + KI + (32 * s + 8 * kg + q4) * RS + (16 * it + 4 * p4) * 2, 4 * RS);
#pragma unroll
          for (int t = 0; t < 3; ++t) { const int vt = (t == 2) ? 4 : 2 * t + vg; f32x4v a = cacc[t] * a_prev;
#pragma unroll
              for (int s = 0; s < 2; ++s) { const bf16x8 bW = tr8(lds + VW + (32 * s + 8 * kg + q4) * VS + (16 * vt + 4 * p4) * 2, 4 * VS); a = __builtin_amdgcn_mfma_f32_16x16x32_bf16(aK[s], bW, a, 0, 0, 0); }
              MFMA_FENCE(a); cnew[t] = a; } }
        if (lat) {
            const int i0 = 16 * it + 4 * kg; const f32x4v cmv = *(const LAS f32x4v*)(vcm + i0), bv = *(const LAS f32x4v*)(vb_ + i0);
            float wi[4], mt[4];
#pragma unroll
            for (int r = 0; r < 4; ++r) { const float mi = fmaxf(m_in, cmv[r]); wi[r] = __expf(m_in - mi); mt[r] = bv[r] + mi; }
            bf16x8 aS[2];
            aS[0] = *(const LAS bf16x8*)(lds + SC + (16 * it + l15) * RS + (8 * kg) * 2); aS[1] = *(const LAS bf16x8*)(lds + SC + (16 * it + l15) * RS + (8 * kg + 32) * 2);
            f32x4v nacc[3];
#pragma unroll
            for (int t = 0; t < 3; ++t) { const int vt = (t == 2) ? 4 : 2 * t + vg; f32x4v a = (f32x4v){0.f, 0.f, 0.f, 0.f};
#pragma unroll
                for (int s = 0; s < 2; ++s) { const bf16x8 bC = *(const LAS bf16x8*)(lds + CI + (16 * vt + l15) * RS + (8 * kg + 32 * s) * 2); a = __builtin_amdgcn_mfma_f32_16x16x32_bf16(qf[s], bC, a, 0, 0, 0); }
                MFMA_FENCE(a);
#pragma unroll
                for (int r = 0; r < 4; ++r) a[r] *= wi[r];
#pragma unroll
                for (int s = 0; s < 2; ++s) { const bf16x8 bV = tr8(lds + VI + (32 * s + 8 * kg + q4) * VS + (16 * vt + 4 * p4) * 2, 4 * VS); a = __builtin_amdgcn_mfma_f32_16x16x32_bf16(aS[s], bV, a, 0, 0, 0); }
                MFMA_FENCE(a); nacc[t] = a; }
            float inv[4];
#pragma unroll
            for (int r = 0; r < 4; ++r) { const float den = __shfl(nacc[2][r], lane & 48); inv[r] = 1.f / fmaxf(fabsf(den), __expf(-mt[r])); }
#pragma unroll
            for (int t = 0; t < 2; ++t) { const int vt = 2 * t + vg;
#pragma unroll
                for (int r = 0; r < 4; ++r) *(LAS unsigned short*)(lds + QI + (i0 + r) * RS + (16 * vt + l15) * 2) = f2bf(nacc[t][r] * inv[r]); }
        }
        LDS_BARRIER();
        if (lat) { const u32x4 hv = *(const LAS u32x4*)(lds + QI + srow * RS + sch * 16);
            if (DUMMY) { const u32x4 rv = *(const u32x4*)(HM + ((size_t)d * ML + R) * 512 + h * 128 + vh * 64 + sch * 8);
#define CMPH(a_, b_) do { const float x_ = (a_), y_ = (b_); if (fabsf(x_ - y_) > 0.05f * fmaxf(fabsf(x_), fabsf(y_)) + 0.02f) ++nbad; } while (0)
                CMPH(bf_lo(hv.x), bf_lo(rv.x)); CMPH(bf_hi(hv.x), bf_hi(rv.x)); CMPH(bf_lo(hv.y), bf_lo(rv.y)); CMPH(bf_hi(hv.y), bf_hi(rv.y));
                CMPH(bf_lo(hv.z), bf_lo(rv.z)); CMPH(bf_hi(hv.z), bf_hi(rv.z)); CMPH(bf_lo(hv.w), bf_lo(rv.w)); CMPH(bf_hi(hv.w), bf_hi(rv.w));
#undef CMPH
            } else *(u32x4*)(HM + ((size_t)d * ML + R) * 512 + h * 128 + vh * 64 + sch * 8) = hv; }
#pragma unroll
        for (int t = 0; t < 3; ++t) { cacc[t] = cnew[t]; const int vt = (t == 2) ? 4 : 2 * t + vg;
            if (t < 2 || wid < 4) { u32x2 o; o.x = pk2(cnew[t][0], cnew[t][1]); o.y = pk2(cnew[t][2], cnew[t][3]); *(LAS u32x2*)(lds + CI + (16 * vt + l15) * RS + (16 * it + 4 * kg) * 2) = o; } }
    }
#undef MLSTM_LOADS
    if (DUMMY) atomicAdd((unsigned*)(ws + WS_CTL) + 64, nbad);
    __syncthreads();
}

#ifndef MK_N_LAUNCHES
#define MK_N_LAUNCHES 1
#endif
constexpr int N_PHASES = 12;
constexpr int LDS_BYTES = 147456;
constexpr int RING_BYTES = 131072, MISC_OFF = RING_BYTES + 320;
constexpr int CW_BAR = 4096;

struct Args { const float* in[21]; float* out; unsigned char* ws; int ph_lo, ph_hi; };

__global__ void __launch_bounds__(NTHREADS, 2) hybrid_fwd(Args args) {
    extern __shared__ __attribute__((aligned(16))) unsigned char lds_raw[];
    LAS unsigned char* lds = (LAS unsigned char*)lds_raw;
    const int G = gridDim.x, bx = blockIdx.x;
    const int vcu = (G % 8 == 0) ? (bx % 8) * (G / 8) + bx / 8 : bx;
    typedef const __attribute__((address_space(4))) Args* ArgsP;
    ArgsP AP = (ArgsP)__builtin_amdgcn_kernarg_segment_ptr();
    asm volatile("" : "+s"(AP));
    unsigned char* ws = AP->ws;
#define I_x AP->in[0]
#define I_cvec AP->in[1]
#define I_ctx AP->in[2]
#define I_c_ctx AP->in[3]
#define I_mod_w AP->in[4]
#define I_mod_b AP->in[5]
#define I_pre_w AP->in[6]
#define I_post_w AP->in[7]
#define I_e_w_in AP->in[8]
#define I_e_sink AP->in[9]
#define I_e_conv_w AP->in[10]
#define I_e_w_out AP->in[11]
#define I_o_w_in AP->in[12]
#define I_o_qn AP->in[13]
#define I_o_kvn AP->in[14]
#define I_o_w_uq AP->in[15]
#define I_o_w_ukv AP->in[16]
#define I_o_ib AP->in[17]
#define I_o_fb AP->in[18]
#define I_o_hn AP->in[19]
#define I_o_w_out AP->in[20]
#define I_out AP->out
    float* MOD = (float*)(ws + WS_MOD);

    for (int u = threadIdx.x; u < (LDS_BYTES - RING_BYTES) / 4; u += NTHREADS) ((LAS unsigned*)(lds + RING_BYTES))[u] = 0u;
    __syncthreads();
    XcdBarrier bar; bar.bar = (unsigned*)(ws + WS_CTL) + CW_BAR; bar.x = 0; bar.st = nullptr;
    if (MK_N_LAUNCHES == 1) bar = xcd_barrier_post((unsigned*)(ws + WS_CTL) + CW_BAR, (volatile LAS unsigned*)(lds + MISC_OFF) + 8);
    const int lo = AP->ph_lo, hi = AP->ph_hi;
#ifndef PROBE_REP
#define PROBE_REP 0
#endif
#define NREP(k) ((((PROBE_REP) >> (k)) & 1) ? 2 : 1)
#ifndef PHASE_MASK
#define PHASE_MASK 0xFFF
#endif
#define IN(k) (((PHASE_MASK >> (k)) & 1) && lo <= (k) && (k) < hi)
#ifndef PROBE_DBLBAR
#define PROBE_DBLBAR 0
#endif
#ifndef PROBE_TS
#define PROBE_TS -1
#endif
#define STAMP(k) do { if (PROBE_TS >= 0 && bx == 0 && threadIdx.x == 0) ((unsigned long long*)(ws + WS_CTL + 512 * 1024))[(k)] = __builtin_amdgcn_s_memrealtime(); } while (0)
#define SEAM(k) do { if (MK_N_LAUNCHES == 1 && IN((k) + 1)) { xcd_barrier(bar); if (PROBE_DBLBAR) xcd_barrier(bar); } STAMP((k) + 1); } while (0)
    const int ngw = G * NWAVES;
#define PH_IDS const int tid = my_tid(), lane = tid & 63, wave = __builtin_amdgcn_readfirstlane(tid >> 6), gw = vcu * NWAVES + wave; (void)lane; (void)gw

    STAMP(0);
    if (IN(0)) { asm volatile("" : "+s"(AP)); PH_IDS;
        for (int rep_ = 0; rep_ < NREP(0); ++rep_) { if (rep_) __syncthreads();
        STAMP(20); p0_mod(lds, I_cvec, I_c_ctx, I_mod_w, I_mod_b, MOD, G);
        __syncthreads(); STAMP(21);
        LAS float* scr = (LAS float*)(lds + wave * 16384);
        constexpr int I0 = 16 * (E_N / 32), I1 = 16 * 32;
        { const bool split = (G == 256); const int cw0 = split ? (bx - 192) * NWAVES + wave : gw, ncw = split ? 64 * NWAVES : ngw;
          if (!split || bx >= 192) for (int it = cw0; it < I0 + I1; it += ncw) {
            if (it < I0) p0_transpose_item(I_e_w_in, 1024, E_N, (bf16_t*)(ws + WS_WEIN), 0, nullptr, scr, it, E_N / 32, lane);
            else p0_transpose_item(I_e_w_out, 1024, 1024, (bf16_t*)(ws + WS_WEOUT), 1, nullptr, scr, it - I0, 32, lane); } }
        STAMP(22);
        float* ropeA = (float*)(ws + WS_ROPEA); float* ropeC = (float*)(ws + WS_ROPEC);
        for (int idx = bx * NTHREADS + tid; idx < 2048 * 48; idx += G * NTHREADS) {
            const int pos = idx / 48, j = idx % 48; const float rowf = (float)(pos >> 6), colf = (float)(pos & 63);
            if (j < 32) { const int f = j & 15; const float inv = exp2f(-(float)f * (13.287712379549449f / 16.f)); const float ang = ((j < 16) ? rowf : colf) * inv;
                ropeA[pos * 64 + j] = __cosf(ang); ropeA[pos * 64 + 32 + j] = __sinf(ang); }
            else { const int jj = j - 32, f = jj & 7; const float inv = exp2f(-(float)f * (13.287712379549449f / 8.f)); const float ang = ((jj < 8) ? rowf : colf) * inv;
                ropeC[pos * 32 + jj] = __cosf(ang); ropeC[pos * 32 + 16 + jj] = __sinf(ang); }
        }
        STAMP(23);
        }
        SEAM(0); STAMP(24);
    }
    if (IN(1)) { asm volatile("" : "+s"(AP)); PH_IDS; for (int rep_ = 0; rep_ < NREP(1); ++rep_) { if (rep_) __syncthreads();
        { LAS float* scr = (LAS float*)(lds + wave * 16384);
          constexpr int I2 = 16 * (O_N / 32), I3 = 12 * 24, I4 = 4 * 32, I5 = 16 * 32;
          for (int it = gw; it < I2 + I3 + I4 + I5; it += ngw) { int r = it;
            if (r < I2) { p0_transpose_item(I_o_w_in, 1024, O_NSRC, (bf16_t*)(ws + WS_WOIN), 2, nullptr, scr, r, O_N / 32, lane); continue; } r -= I2;
            if (r < I3) { p0_transpose_item(I_o_w_uq, 768, 768, (bf16_t*)(ws + WS_WUQ), 3, I_o_qn, scr, r, 24, lane); continue; } r -= I3;
            if (r < I4) { p0_transpose_item(I_o_w_ukv, 256, 1024, (bf16_t*)(ws + WS_WUKV), 4, I_o_kvn, scr, r, 32, lane); continue; } r -= I4;
            p0_transpose_item(I_o_w_out, 1024, 1024, (bf16_t*)(ws + WS_WOOUT), 5, nullptr, scr, r, 32, lane); } }
        p1_prenorm(I_x, I_ctx, I_pre_w, MOD, (bf16_t*)(ws + WS_H), gw, ngw, lane); }
        SEAM(1); }
    if (IN(2)) { asm volatile("" : "+s"(AP)); PH_IDS;
        for (int rep_ = 0; rep_ < NREP(2); ++rep_) { if (rep_) __syncthreads();
        pg8::Gemm g{(const bf16_t*)(ws + WS_H), (const bf16_t*)(ws + WS_WEIN), MT, E_N, 1024}; pg8::RectOrder S; S.init(MT / 256, E_N / 256, 0, 0, 0, G, bx);
        EpiEin E{ws}; pg8::gemm_phase<EpiEin, pg8::RectOrder, true, true>(lds, g, S, E);
        }
        SEAM(2);
    }
    if (IN(3)) { asm volatile("" : "+s"(AP)); PH_IDS;
        for (int rep_ = 0; rep_ < NREP(3) + NREP(14) - 1; ++rep_) {
        for (int un = vcu; un < 1024; un += G) attn_unit<0>(lds, ws, nullptr, I_e_sink, un);
        for (int un = bx; un < 128; un += G) attn_unit<1>(lds, ws, nullptr, I_e_sink, un);
        }
        for (int rep_ = 0; rep_ < NREP(3) + NREP(15) - 1; ++rep_) { p3_conv(ws, I_e_conv_w, bx * NTHREADS + tid, G * NTHREADS);
        }
        SEAM(3);
    }
    if (IN(4)) { asm volatile("" : "+s"(AP)); PH_IDS;
        for (int rep_ = 0; rep_ < NREP(4); ++rep_) { if (rep_) __syncthreads();
        pg8::Gemm g{(const bf16_t*)(ws + WS_U), (const bf16_t*)(ws + WS_WEOUT), MT, 1024, 1024}; pg8::RectOrder S; S.init(MT / 256, 4, 0, 0, 0, G, bx);
        EpiY E{(bf16_t*)(ws + WS_Y), (float*)(ws + WS_SSQY0)}; pg8::gemm_phase<EpiY, pg8::RectOrder, true, true>(lds, g, S, E);
        }
        SEAM(4);
    }
    if (IN(5)) { asm volatile("" : "+s"(AP)); PH_IDS; for (int rep_ = 0; rep_ < NREP(5); ++rep_) { if (rep_) __syncthreads();
        p5_post_pre(I_x, I_ctx, I_post_w, I_pre_w + 1024, MOD, (const bf16_t*)(ws + WS_Y), (const float*)(ws + WS_SSQY0), (bf16_t*)(ws + WS_X1), (bf16_t*)(ws + WS_H), gw, ngw, lane); }
        SEAM(5); }
    if (IN(6)) { asm volatile("" : "+s"(AP)); PH_IDS;
        for (int rep_ = 0; rep_ < NREP(6); ++rep_) { if (rep_) __syncthreads();
        pg8::Gemm g{(const bf16_t*)(ws + WS_H), (const bf16_t*)(ws + WS_WOIN), MT, O_N, 1024}; pg8::RectOrder S; S.init(ML / 256, O_N / 256, ML / 256, MC / 256, 5, G, bx);
        EpiOin E{ws, (unsigned char*)I_out}; pg8::gemm_phase<EpiOin, pg8::RectOrder, true, true>(lds, g, S, E);
        }
        SEAM(6);
    }
    if (IN(7)) { asm volatile("" : "+s"(AP)); PH_IDS;
        for (int rep_ = 0; rep_ < NREP(7); ++rep_) { if (rep_) __syncthreads();
        { pg8::Gemm g{(const bf16_t*)(ws + WS_CQ), (const bf16_t*)(ws + WS_WUQ), ML, 768, 768}; pg8::RectOrder S; S.init(ML / 256, 3, 0, 0, 0, G, bx);
          EpiUq E{ws}; pg8::gemm_phase<EpiUq, pg8::RectOrder, true, true>(lds, g, S, E); }
        __syncthreads();
        { pg8::Gemm g{(const bf16_t*)(ws + WS_CKV), (const bf16_t*)(ws + WS_WUKV), MT, 1024, 256}; EpiUkv E{ws};
          if (G == 256) {
              pg8::ListOrder4 S; if (bx < 128) { S.start = bx; S.cnt = 1; } else if (bx < 192) { S.start = 128 + 3 * (bx - 128); S.cnt = 3; } else { S.start = 320 + 4 * (bx - 192); S.cnt = 4; }
              pg8::gemm_phase<EpiUkv, pg8::ListOrder4, true, true>(lds, g, S, E);
          } else { pg8::RectOrder S; S.init(MT / 256, 4, 0, 0, 0, G, G - 1 - bx); pg8::gemm_phase<EpiUkv, pg8::RectOrder, true, true>(lds, g, S, E); } }
        }
        SEAM(7);
    }
    if (IN(8)) { asm volatile("" : "+s"(AP)); PH_IDS;
        for (int rep_ = 0; rep_ < NREP(8) + NREP(12) - 1; ++rep_) { for (int ch = bx; ch < 256; ch += G) { STAMP(30); mlstm_chain_mfma<false>(lds, ws, (unsigned char*)I_out, I_o_ib, I_o_fb, ch); STAMP(31); }
        }
        for (int rep_ = 0; rep_ < NREP(8) + NREP(13) - 1; ++rep_) {
        for (int un = vcu; un < 1024; un += G) attn_unit<2>(lds, ws, (unsigned char*)I_out, nullptr, un);
        }
        STAMP(32); SEAM(8); STAMP(33);
    }
    if (IN(9)) { asm volatile("" : "+s"(AP)); PH_IDS; for (int rep_ = 0; rep_ < NREP(9); ++rep_) { if (rep_) __syncthreads();
        p9_readout(ws, (unsigned char*)I_out, I_o_hn, gw, ngw, lane); }
        SEAM(9); }
    if (IN(10)) { asm volatile("" : "+s"(AP)); PH_IDS;
        for (int rep_ = 0; rep_ < NREP(10); ++rep_) { if (rep_) __syncthreads();
        pg8::Gemm g{(const bf16_t*)(ws + WS_U), (const bf16_t*)(ws + WS_WOOUT), ML, 1024, 1024}; pg8::RectOrder S; S.init(ML / 256, 4, 0, 0, 0, G, bx);
        EpiY E{(bf16_t*)(ws + WS_Y), (float*)(ws + WS_SSQY1)}; pg8::gemm_phase<EpiY, pg8::RectOrder, true, true>(lds, g, S, E);
        }
        SEAM(10);
    }
    if (IN(11)) { asm volatile("" : "+s"(AP)); PH_IDS; p11_final(I_post_w + 1024, MOD, (const bf16_t*)(ws + WS_Y), (const float*)(ws + WS_SSQY1), (const bf16_t*)(ws + WS_X1), I_out, gw, ngw, lane);
        if (PROBE_TS >= 0 && bx == 0 && threadIdx.x == 0) { asm volatile("s_waitcnt vmcnt(0)" ::: "memory"); const unsigned long long* ts = (const unsigned long long*)(ws + WS_CTL + 512 * 1024);
            const unsigned long long t1 = (PROBE_TS == 11) ? __builtin_amdgcn_s_memrealtime() : ts[PROBE_TS + 1]; I_out[5 * 1024 * 7 + 3] += floorf((float)(t1 - ts[PROBE_TS]) * 0.01f * (1.f / 50.f)) * 50.f; } }
#undef IN
#undef SEAM
#undef I_x
#undef I_cvec
#undef I_ctx
#undef I_c_ctx
#undef I_mod_w
#undef I_mod_b
#undef I_pre_w
#undef I_post_w
#undef I_e_w_in
#undef I_e_sink
#undef I_e_conv_w
#undef I_e_w_out
#undef I_o_w_in
#undef I_o_qn
#undef I_o_kvn
#undef I_o_w_uq
#undef I_o_w_ukv
#undef I_o_ib
#undef I_o_fb
#undef I_o_hn
#undef I_o_w_out
#undef I_out
}

extern "C" void kernel_launch(void* const* d_in, const int* in_sizes, int n_in, void* d_out, int out_size, void* d_ws, size_t ws_size, hipStream_t stream) {
    static int grid = 0;
    if (grid == 0) {
        if (n_in != 21 || in_sizes[0] != ML * DM || out_size != ML * DM || ws_size < WS_END) { fprintf(stderr, "kernel_launch: unexpected shapes / workspace (n_in %d, ws %zu < %zu); nothing launched\n", n_in, ws_size, (size_t)WS_END); grid = -1; return; }
        int dev = 0, cus = 0, per_cu = 0;
        if (hipGetDevice(&dev) != hipSuccess || hipDeviceGetAttribute(&cus, hipDeviceAttributeMultiprocessorCount, dev) != hipSuccess) { grid = -1; return; }
        if (hipFuncSetAttribute((const void*)hybrid_fwd, hipFuncAttributeMaxDynamicSharedMemorySize, LDS_BYTES) != hipSuccess) { fprintf(stderr, "kernel_launch: hipFuncSetAttribute failed\n"); grid = -1; return; }
        if (hipOccupancyMaxActiveBlocksPerMultiprocessor(&per_cu, (const void*)hybrid_fwd, NTHREADS, LDS_BYTES) != hipSuccess || per_cu < 1) fprintf(stderr, "kernel_launch: note: occupancy query reports %d workgroups per CU\n", per_cu);
        (void)hipGetLastError();
        grid = cus;
    }
    if (grid < 0) return;
    if (hipMemsetAsync((char*)d_ws + WS_CTL, 0, CTL_ZERO_BYTES, stream) != hipSuccess) { fprintf(stderr, "kernel_launch: hipMemsetAsync failed\n"); return; }
    Args a{};
    for (int i = 0; i < 21; ++i) a.in[i] = (const float*)d_in[i];
    a.out = (float*)d_out; a.ws = (unsigned char*)d_ws;
    if (MK_N_LAUNCHES == 1) { a.ph_lo = 0; a.ph_hi = N_PHASES; hipLaunchKernelGGL(hybrid_fwd, dim3(grid), dim3(NTHREADS), LDS_BYTES, stream, a); }
    else for (int p = 0; p < N_PHASES; ++p) { a.ph_lo = p; a.ph_hi = p + 1; hipLaunchKernelGGL(hybrid_fwd, dim3(grid), dim3(NTHREADS), LDS_BYTES, stream, a); }
    const hipError_t le = hipPeekAtLastError();
    if (le != hipSuccess) fprintf(stderr, "kernel_launch: launch failed: %s\n", hipGetErrorName(le));
}
```

```cpp
#include <hip/hip_runtime.h>
#include <cstdio>
#include <cstdint>

#define LAS __attribute__((address_space(3)))
#define GAS __attribute__((address_space(1)))
typedef unsigned short bf16_t;
typedef short bf16x8 __attribute__((ext_vector_type(8)));
typedef short s16x4 __attribute__((ext_vector_type(4)));
typedef float f32x4 __attribute__((ext_vector_type(4)));
typedef float f32x16 __attribute__((ext_vector_type(16)));
typedef unsigned u32x4 __attribute__((ext_vector_type(4)));
typedef unsigned u32x2 __attribute__((ext_vector_type(2)));
typedef float f32x2_t __attribute__((ext_vector_type(2)));
typedef __bf16 bf16x2_t __attribute__((ext_vector_type(2)));

constexpr int NB = 16, SEQ = 2048, DM = 1024, CL = 256;
constexpr int ML = NB * SEQ, MC = NB * CL, MT = ML + MC;
constexpr float EPS = 1e-6f, LOG2E = 1.4426950408889634f;
constexpr int E_N = 3328, O_NSRC = 3632, O_N = 3840;
constexpr int NWAVES = 8, NTHREADS = 512;

__device__ __forceinline__ float bf_lo(unsigned w) { return __uint_as_float(w << 16); }
__device__ __forceinline__ float bf_hi(unsigned w) { return __uint_as_float(w & 0xffff0000u); }
__device__ __forceinline__ unsigned pk2(float lo, float hi) { f32x2_t v = {lo, hi}; bf16x2_t b = __builtin_convertvector(v, bf16x2_t); return __builtin_bit_cast(unsigned, b); }
__device__ __forceinline__ float silu_f(float x) { return x * __builtin_amdgcn_rcpf(1.f + __expf(-x)); }
__device__ __forceinline__ float sigmoid_f(float x) { return __builtin_amdgcn_rcpf(1.f + __expf(-x)); }
__device__ __forceinline__ float wave_sum(float v) {
#pragma unroll
    for (int o = 1; o < 64; o <<= 1) v += __shfl_xor(v, o);
    return v;
}
#define LDS_WAIT() asm volatile("s_waitcnt lgkmcnt(0)" ::: "memory")
#define VM_WAIT() asm volatile("s_waitcnt vmcnt(0)" ::: "memory")

__device__ __forceinline__ int my_tid() { int t = threadIdx.x; asm volatile("" : "+v"(t)); return t; }

namespace pg8 {
#define PG8_LAS __attribute__((address_space(3)))
typedef unsigned short bf16_t;
typedef short bf16x8 __attribute__((ext_vector_type(8)));
typedef float f32x4 __attribute__((ext_vector_type(4)));
typedef unsigned u32x4 __attribute__((ext_vector_type(4)));
constexpr int BM = 256, BK = 64, HALF = 128, HTB = HALF * BK * 2  , STAGE_BYTES = 8 * HTB, NXCD = 8, WGM = 8;

__host__ __device__ __forceinline__ int lds_byte(int r, int c) { const int st = (r >> 4) * 2 + (c >> 5), rr = r & 15, cc = c & 31, ob = rr * 64 + cc * 2; return st * 1024 + (ob ^ (((ob >> 9) & 1) << 5)); }
__host__ __device__ __forceinline__ void stage_rc(int b, int& R, int& C) { const int st = b / 1024, sb = b % 1024, swz = sb ^ (((sb >> 9) & 1) << 5); R = (st >> 1) * 16 + swz / 64; C = (st & 1) * 32 + (swz % 64) / 2; }
__host__ __device__ __forceinline__ int perm32(int rho) { const int n = rho >> 4, i = rho & 15; return 8 * (i >> 2) + 4 * n + (i & 3); }

struct Unit { int pm, pn; };
struct Gemm { const bf16_t* A; const bf16_t* Bt; int M, N, K; };

struct RectOrder {
    int nM0, nN0, n0, pm1, nM1, nN1, n1, G, c;
    __device__ __forceinline__ void init(int nM0_, int nN0_, int pm1_, int nM1_, int nN1_, int G_, int c_) { nM0 = nM0_; nN0 = nN0_; n0 = nM0_ * nN0_; pm1 = pm1_; nM1 = nM1_; nN1 = nN1_; n1 = nM1_ * nN1_; G = G_; c = c_; }
    __device__ __forceinline__ static void rect(int w, int nM, int nN, int& pm, int& pn) {
        const int nig = WGM * nN, gid = w / nig, fm = gid * WGM, gsz = (nM - fm) < WGM ? (nM - fm) : WGM;
        pm = fm + ((w % nig) % gsz); pn = (w % nig) / gsz;
    }
    __device__ __forceinline__ bool next(int i, Unit& u) const {
        const int nwg = n0 + n1; const long L = (long)i * G + c; if (L >= nwg) return false;
        int wgid = (int)L; { const int q = nwg / NXCD, r = nwg % NXCD, xcd = wgid % NXCD, off = wgid / NXCD; wgid = (xcd < r ? xcd * (q + 1) : r * (q + 1) + (xcd - r) * q) + off; }
        if (wgid < n0) rect(wgid, nM0, nN0, u.pm, u.pn); else { rect(wgid - n0, nM1, nN1, u.pm, u.pn); u.pm += pm1; }
        return true;
    }
    __device__ __forceinline__ void a_ready(const Unit&) const {}
    __device__ __forceinline__ void done(const Unit&) const {}
};

struct ListOrder4 {
    int start, cnt;
    __device__ __forceinline__ bool next(int i, Unit& u) const { if (i >= cnt) return false; const int L = start + i; u.pm = L >> 2; u.pn = L & 3; return true; }
    __device__ __forceinline__ void a_ready(const Unit&) const {}
    __device__ __forceinline__ void done(const Unit&) const {}
};

struct PanelOrder {
    int nM0, nN0, nN1, total, first, step, cnt;
    const unsigned* ready; unsigned need; unsigned* tmo;
    __device__ __forceinline__ bool next(int i, Unit& u) const {
        if (i >= cnt) return false; int L = first + step * i; if (L >= total) return false;
        const int n0 = nM0 * nN0; if (L < n0) { u.pm = L / nN0; u.pn = L - u.pm * nN0; } else { L -= n0; const int q = L / nN1; u.pm = nM0 + q; u.pn = L - q * nN1; }
        return true;
    }
    __device__ __forceinline__ void a_ready(const Unit& u) const {
        if (ready == nullptr) return;
        if (threadIdx.x < 64) {
            const unsigned long long t0 = __builtin_amdgcn_s_memrealtime(); unsigned polls = 0;
            while ((unsigned)__builtin_amdgcn_readfirstlane(__hip_atomic_load(ready + 64 * u.pm, __ATOMIC_RELAXED, __HIP_MEMORY_SCOPE_AGENT)) < need) {
                if ((++polls & 255u) == 0u && __builtin_amdgcn_readfirstlane(__hip_atomic_load(tmo, __ATOMIC_RELAXED, __HIP_MEMORY_SCOPE_AGENT)) != 0u) break;
                if (__builtin_amdgcn_s_memrealtime() - t0 > 2000000ull) { if (threadIdx.x == 0) __hip_atomic_store(tmo, 1u, __ATOMIC_RELAXED, __HIP_MEMORY_SCOPE_AGENT); break; }
                __builtin_amdgcn_s_sleep(2); }
            asm volatile("s_waitcnt vmcnt(0)" ::: "memory");
        }
        asm volatile("" ::: "memory"); __builtin_amdgcn_s_barrier(); asm volatile("" ::: "memory");
    }
    __device__ __forceinline__ void done(const Unit&) const {}
};

template <class Epi, class Sched, bool ALIGN_EPI = false, bool SP2 = false>
__device__ __forceinline__ void gemm_phase(PG8_LAS unsigned char* lds, const Gemm g, const Sched& S, const Epi& E) {
    const int tid = my_tid(), wid = __builtin_amdgcn_readfirstlane(tid >> 6), lane = tid & 63, wr = wid >> 2, wc = wid & 3, fr = lane & 15, fq = lane >> 4;
    const int K = g.K, nt = K / BK;
    unsigned voffA[2], voffB[2];
#pragma unroll
    for (int i = 0; i < 2; ++i) { int R, C; stage_rc(tid * 16 + i * 8192, R, C); const int Rb = Epi::PERM ? ((R & ~31) + perm32(R & 31)) : R;
        voffA[i] = (unsigned)(R * K + C) * 2u; voffB[i] = (unsigned)(Rb * K + C) * 2u; }
    const size_t kstep = (size_t)(BK * 2);
    const size_t hstep = (size_t)HALF * K * 2;
    const size_t tstep = 2 * hstep;
    const unsigned ldsw = (unsigned)wid * 1024u;
    const int aoff = lds_byte(wr * 64 + fr, fq * 8), boff = lds_byte(wc * 32 + fr, fq * 8);
#define PG8_SA(b, h) (((b) * 2 + (h)) * HTB)
#define PG8_SB(b, h) ((4 + (b) * 2 + (h)) * HTB)
#define PG8_STAGE(bufoff, gbase, voff) do { _Pragma("unroll") for (int _i = 0; _i < 2; ++_i) \
        __builtin_amdgcn_global_load_lds((const unsigned*)((const char*)(gbase) + (voff)[_i]), (PG8_LAS unsigned*)(lds + (bufoff) + ldsw + _i * 8192), 16, 0, 0); } while (0)
#define PG8_LDA(dst, b, h) do { _Pragma("unroll") for (int m = 0; m < 4; ++m) _Pragma("unroll") for (int k = 0; k < 2; ++k) dst[m][k] = *(const PG8_LAS bf16x8*)(lds + PG8_SA(b, h) + aoff + m * 2048 + k * 1024); } while (0)
#define PG8_LDB(dst, b, h) do { _Pragma("unroll") for (int n = 0; n < 2; ++n) _Pragma("unroll") for (int k = 0; k < 2; ++k) dst[n][k] = *(const PG8_LAS bf16x8*)(lds + PG8_SB(b, h) + boff + n * 2048 + k * 1024); } while (0)
#define PG8_MMA(ai, bj, At, Bt) do { __builtin_amdgcn_s_setprio(1); _Pragma("unroll") for (int m = 0; m < 4; ++m) _Pragma("unroll") for (int n = 0; n < 2; ++n) _Pragma("unroll") for (int k = 0; k < 2; ++k) \
        acc[ai][bj][m][n] = __builtin_amdgcn_mfma_f32_16x16x32_bf16(Bt[n][k], At[m][k], acc[ai][bj][m][n], 0, 0, 0); __builtin_amdgcn_s_setprio(0); } while (0)
#define PG8_WAIT_V(n) asm volatile("s_waitcnt vmcnt(" #n ")" ::: "memory")
#define PG8_WAIT_L(n) asm volatile("s_waitcnt lgkmcnt(" #n ")" ::: "memory")
#define PG8_BAR __builtin_amdgcn_s_barrier()
#define PG8_SCHED __builtin_amdgcn_sched_barrier(0)
    Unit cur, nxt; int ui = 0;
    if (!S.next(0, cur)) return;
    f32x4 acc[2][2][4][2];
#pragma unroll
    for (int a = 0; a < 2; ++a)
#pragma unroll
        for (int b = 0; b < 2; ++b)
#pragma unroll
            for (int m = 0; m < 4; ++m)
#pragma unroll
                for (int n = 0; n < 2; ++n) acc[a][b][m][n] = (f32x4){0.f, 0.f, 0.f, 0.f};
    bf16x8 At[4][2], B0[2][2], B1[2][2];
    const char* cA = (const char*)g.A + (size_t)cur.pm * tstep; const char* cB = (const char*)g.Bt + (size_t)cur.pn * tstep;
    S.a_ready(cur);
    if constexpr (SP2) {
        PG8_STAGE(PG8_SB(0, 0), cB, voffB); PG8_STAGE(PG8_SB(0, 1), cB + hstep, voffB); PG8_STAGE(PG8_SA(0, 0), cA, voffA); PG8_STAGE(PG8_SA(0, 1), cA + hstep, voffA);
        if (wr == 1) PG8_BAR;
        PG8_WAIT_V(2); PG8_BAR;
        PG8_STAGE(PG8_SB(1, 0), cB + kstep, voffB); PG8_STAGE(PG8_SA(1, 0), cA + kstep, voffA); PG8_STAGE(PG8_SB(1, 1), cB + hstep + kstep, voffB);
        PG8_WAIT_V(6); PG8_BAR;
    } else {
        PG8_STAGE(PG8_SB(0, 0), cB, voffB); PG8_STAGE(PG8_SA(0, 0), cA, voffA); PG8_STAGE(PG8_SB(0, 1), cB + hstep, voffB); PG8_STAGE(PG8_SA(0, 1), cA + hstep, voffA);
        if (wr == 1) PG8_BAR;
        PG8_WAIT_V(4); PG8_BAR;
        PG8_STAGE(PG8_SB(1, 0), cB + kstep, voffB); PG8_STAGE(PG8_SA(1, 0), cA + kstep, voffA); PG8_STAGE(PG8_SB(1, 1), cB + hstep + kstep, voffB);
        PG8_WAIT_V(6); PG8_BAR;
    }
    for (;;) {
        const bool has_next = S.next(ui + 1, nxt);
        const char* nA = has_next ? (const char*)g.A + (size_t)nxt.pm * tstep : cA; const char* nB = has_next ? (const char*)g.Bt + (size_t)nxt.pn * tstep : cB;
        for (int t = 0; t < nt; t += 2) {
            const bool last = (t == nt - 2);
            const char* a1 = cA + (size_t)(t + 1) * kstep;
            const char* a2 = last ? nA : cA + (size_t)(t + 2) * kstep; const char* b2 = last ? nB : cB + (size_t)(t + 2) * kstep;
            const char* a3 = a2 + kstep; const char* b3 = b2 + kstep;
            if (last && has_next) S.a_ready(nxt);
            if constexpr (SP2) {
            PG8_LDB(B0, 0, 0); PG8_LDB(B1, 0, 1); PG8_SCHED; PG8_LDA(At, 0, 0); PG8_STAGE(PG8_SA(1, 1), a1 + hstep, voffA);
            PG8_WAIT_V(8); PG8_WAIT_L(0); PG8_BAR; PG8_MMA(0, 0, At, B0); PG8_MMA(0, 1, At, B1); PG8_BAR; PG8_SCHED;
            PG8_LDA(At, 0, 1); PG8_STAGE(PG8_SB(0, 0), b2, voffB); PG8_STAGE(PG8_SB(0, 1), b2 + hstep, voffB); PG8_STAGE(PG8_SA(0, 0), a2, voffA);
            PG8_WAIT_V(8); PG8_WAIT_L(0); PG8_BAR; PG8_MMA(1, 0, At, B0); PG8_MMA(1, 1, At, B1); PG8_BAR; PG8_SCHED;
            PG8_LDB(B0, 1, 0); PG8_LDB(B1, 1, 1); PG8_SCHED; PG8_LDA(At, 1, 0); PG8_STAGE(PG8_SA(0, 1), a2 + hstep, voffA);
            PG8_WAIT_V(8); PG8_WAIT_L(0); PG8_BAR; PG8_MMA(0, 0, At, B0); PG8_MMA(0, 1, At, B1); PG8_BAR; PG8_SCHED;
            PG8_LDA(At, 1, 1); PG8_STAGE(PG8_SB(1, 0), b3, voffB); PG8_STAGE(PG8_SB(1, 1), b3 + hstep, voffB); PG8_STAGE(PG8_SA(1, 0), a3, voffA);
            PG8_WAIT_V(8); PG8_WAIT_L(0); PG8_BAR; PG8_MMA(1, 0, At, B0); PG8_MMA(1, 1, At, B1); PG8_BAR; PG8_SCHED;
            } else {
            PG8_LDB(B0, 0, 0); PG8_SCHED; PG8_LDA(At, 0, 0); PG8_STAGE(PG8_SA(1, 1), a1 + hstep, voffA);
            PG8_WAIT_L(8); PG8_BAR; PG8_WAIT_L(0); PG8_MMA(0, 0, At, B0); PG8_BAR; PG8_SCHED;
            PG8_LDB(B1, 0, 1); PG8_STAGE(PG8_SB(0, 0), b2, voffB);
            PG8_BAR; PG8_WAIT_L(0); PG8_MMA(0, 1, At, B1); PG8_BAR;
            PG8_LDA(At, 0, 1); PG8_STAGE(PG8_SA(0, 0), a2, voffA);
            PG8_BAR; PG8_WAIT_L(0); PG8_MMA(1, 0, At, B0); PG8_BAR; PG8_SCHED;
            PG8_STAGE(PG8_SB(0, 1), b2 + hstep, voffB);
            PG8_WAIT_V(6); PG8_BAR; PG8_MMA(1, 1, At, B1); PG8_BAR;
            PG8_LDB(B0, 1, 0); PG8_SCHED; PG8_LDA(At, 1, 0); PG8_STAGE(PG8_SA(0, 1), a2 + hstep, voffA);
            PG8_WAIT_L(8); PG8_BAR; PG8_WAIT_L(0); PG8_MMA(0, 0, At, B0); PG8_BAR; PG8_SCHED;
            PG8_LDB(B1, 1, 1); PG8_STAGE(PG8_SB(1, 0), b3, voffB);
            PG8_BAR; PG8_WAIT_L(0); PG8_MMA(0, 1, At, B1); PG8_BAR;
            PG8_LDA(At, 1, 1); PG8_STAGE(PG8_SA(1, 0), a3, voffA);
            PG8_BAR; PG8_WAIT_L(0); PG8_MMA(1, 0, At, B0); PG8_BAR; PG8_SCHED;
            PG8_STAGE(PG8_SB(1, 1), b3 + hstep, voffB);
            PG8_WAIT_V(6); PG8_BAR; PG8_MMA(1, 1, At, B1); PG8_BAR;
            }
        }
        if constexpr (ALIGN_EPI) { if (wr == 0) PG8_BAR; }
        if constexpr (!Epi::AFTER_DRAIN) { E(acc, cur, wr, wc, fr, fq); S.done(cur); }
        if (!has_next) break;
#pragma unroll
        for (int a = 0; a < 2; ++a)
#pragma unroll
            for (int b = 0; b < 2; ++b)
#pragma unroll
                for (int m = 0; m < 4; ++m)
#pragma unroll
                    for (int n = 0; n < 2; ++n) acc[a][b][m][n] = (f32x4){0.f, 0.f, 0.f, 0.f};
        cur = nxt; cA = nA; cB = nB; ++ui;
        if constexpr (ALIGN_EPI) { if (wr == 1) PG8_BAR; }
    }
    PG8_WAIT_V(0);
    if constexpr (!ALIGN_EPI) { if (wr == 0) PG8_BAR; }
    PG8_BAR;
    if constexpr (Epi::AFTER_DRAIN) { E.fused(acc, cur, wr, wc, fr, fq, lds, wid, lane); S.done(cur); }
#undef PG8_SA
#undef PG8_SB
#undef PG8_STAGE
#undef PG8_LDA
#undef PG8_LDB
#undef PG8_MMA
#undef PG8_WAIT_V
#undef PG8_WAIT_L
#undef PG8_BAR
#undef PG8_SCHED
}
}

constexpr size_t MiB = 1u << 20;
constexpr size_t WS_CTL = 0, CTL_ZERO_BYTES = 128 * 1024;
constexpr int CW_PANEL = 8192, PANEL_BANK = 144 * 64;
constexpr size_t WS_MOD = 1 * MiB;
constexpr size_t WS_ROPEA = 2 * MiB;
constexpr size_t WS_ROPEC = 2 * MiB + 512 * 1024;
constexpr size_t WS_WEIN = 3 * MiB, WS_WEOUT = 10 * MiB, WS_WOIN = 12 * MiB, WS_WUQ = 20 * MiB, WS_WUKV = 21 * MiB + 512 * 1024, WS_WOOUT = 22 * MiB;
constexpr size_t WS_H = 24 * MiB;
constexpr size_t WS_U = 96 * MiB;
constexpr size_t WS_Y = 168 * MiB;
constexpr size_t WS_R = 240 * MiB;
constexpr size_t WS_KVE = WS_R  , WS_QE = WS_R + 18 * MiB, WS_PE = WS_R + 54 * MiB, WS_GE = WS_R + 90 * MiB, WS_ZA = WS_R + 126 * MiB, WS_SSQY0 = WS_R + 241 * MiB  ;
constexpr size_t WS_CKV = WS_R, WS_CQ = WS_R + 18 * MiB, WS_HM = WS_R  , WS_MK = WS_R + 66 * MiB, WS_MV = WS_R + 84 * MiB, WS_KR = WS_R + 120 * MiB, WS_GATES = WS_R + 123 * MiB,
                 WS_SSQCKV = WS_R + 126 * MiB, WS_SSQCQ = WS_R + 127 * MiB, WS_X1 = WS_R + 129 * MiB  , WS_SSQY1 = WS_R + 241 * MiB;
constexpr size_t AUX_MQ = 0, AUX_MO = 16 * MiB, AUX_ZO = 48 * MiB;
constexpr size_t WS_KNV = WS_H  , WS_QO = WS_Y;
constexpr size_t WS_END = WS_R + 244 * MiB;
static_assert(WS_ZA + (size_t)MT * 512 * 2 <= WS_R + 162 * MiB && WS_X1 + (size_t)ML * 1024 * 2 <= WS_R + 241 * MiB && WS_HM + (size_t)2 * ML * 512 * 2 <= WS_MK && WS_SSQY1 + (size_t)MT * 16 * 4 <= WS_END, "ws map");

__device__ __forceinline__ void st8(bf16_t* p, f32x4 a, f32x4 b) { u32x4 w; w.x = pk2(a[0], a[1]); w.y = pk2(a[2], a[3]); w.z = pk2(b[0], b[1]); w.w = pk2(b[2], b[3]); *(u32x4*)p = w; }
__device__ __forceinline__ bf16_t f2bf(float v) { return (bf16_t)(pk2(v, 0.f) & 0xffffu); }
__device__ __forceinline__ void rope8(f32x4& a, f32x4& b, const float* cosp, const float* sinp) {
    const f32x4 cs = *(const f32x4*)cosp, sn = *(const f32x4*)sinp;
    const float a0 = a[0] * cs[0] - a[1] * sn[0], a1 = a[0] * sn[0] + a[1] * cs[0], a2 = a[2] * cs[1] - a[3] * sn[1], a3 = a[2] * sn[1] + a[3] * cs[1];
    const float b0 = b[0] * cs[2] - b[1] * sn[2], b1 = b[0] * sn[2] + b[1] * cs[2], b2 = b[2] * cs[3] - b[3] * sn[3], b3 = b[2] * sn[3] + b[3] * cs[3];
    a = (f32x4){a0, a1, a2, a3}; b = (f32x4){b0, b1, b2, b3};
}
__device__ __forceinline__ f32x4 silu4(f32x4 v) { return (f32x4){silu_f(v[0]), silu_f(v[1]), silu_f(v[2]), silu_f(v[3])}; }
__device__ __forceinline__ f32x4 sigm4(f32x4 v) { return (f32x4){sigmoid_f(v[0]), sigmoid_f(v[1]), sigmoid_f(v[2]), sigmoid_f(v[3])}; }
__device__ __forceinline__ float sq4(f32x4 v) { return (v[0] * v[0] + v[1] * v[1]) + (v[2] * v[2] + v[3] * v[3]); }

struct EpiEin {
    static constexpr bool PERM = true, AFTER_DRAIN = false;
    unsigned char* ws;
    __device__ __forceinline__ void operator()(const f32x4 (&acc)[2][2][4][2], const pg8::Unit& u, int wr, int wc, int fr, int fq) const {
        const int pn = u.pn, rbase = u.pm * 256 + wr * 64 + fr, cw = wc * 32 + 8 * fq;
        const float* ropeA = (const float*)(ws + WS_ROPEA);
#pragma unroll
        for (int ai = 0; ai < 2; ++ai)
#pragma unroll
            for (int m = 0; m < 4; ++m) {
                asm volatile("" ::: "memory"); const int R = rbase + ai * 128 + m * 16; const bool lat = R < ML; const int pos = R & 2047;
                if (pn == 0) {
                    f32x4 a = acc[ai][0][m][0], b = acc[ai][0][m][1];
                    if (lat) { const int i0 = (cw & 63) >> 1; rope8(a, b, ropeA + pos * 64 + i0, ropeA + pos * 64 + 32 + i0); }
                    st8((bf16_t*)(ws + WS_KVE) + (size_t)R * 256 + cw, a, b);
                    st8((bf16_t*)(ws + WS_KVE) + (size_t)R * 256 + 128 + cw, acc[ai][1][m][0], acc[ai][1][m][1]);
                } else if (pn <= 2) {
#pragma unroll
                    for (int bj = 0; bj < 2; ++bj) {
                        f32x4 a = acc[ai][bj][m][0], b = acc[ai][bj][m][1];
                        if (lat) { const int i0 = (cw & 63) >> 1; rope8(a, b, ropeA + pos * 64 + i0, ropeA + pos * 64 + 32 + i0); }
                        const float sc = 0.125f * LOG2E; a = a * sc; b = b * sc;
                        st8((bf16_t*)(ws + WS_QE) + (size_t)R * 512 + (pn - 1) * 256 + bj * 128 + cw, a, b);
                    }
                } else if (pn <= 6) {
                    st8((bf16_t*)(ws + WS_PE) + (size_t)R * 512 + (pn - 3) * 128 + cw, acc[ai][0][m][0] * acc[ai][1][m][0], acc[ai][0][m][1] * acc[ai][1][m][1]);
                } else if (pn <= 10) {
                    st8((bf16_t*)(ws + WS_GE) + (size_t)R * 512 + (pn - 7) * 128 + cw, acc[ai][0][m][0] * silu4(acc[ai][1][m][0]), acc[ai][0][m][1] * silu4(acc[ai][1][m][1]));
                } else {
#pragma unroll
                    for (int bj = 0; bj < 2; ++bj)
                        st8((bf16_t*)(ws + WS_ZA) + (size_t)R * 512 + (pn - 11) * 256 + bj * 128 + cw, silu4(acc[ai][bj][m][0]), silu4(acc[ai][bj][m][1]));
                }
            }
    }
};

struct EpiY {
    static constexpr bool PERM = true, AFTER_DRAIN = false;
    bf16_t* Y; float* SSQ;
    __device__ __forceinline__ void operator()(const f32x4 (&acc)[2][2][4][2], const pg8::Unit& u, int wr, int wc, int fr, int fq) const {
        const int pn = u.pn, rbase = u.pm * 256 + wr * 64 + fr, cw = wc * 32 + 8 * fq;
#pragma unroll
        for (int ai = 0; ai < 2; ++ai)
#pragma unroll
            for (int m = 0; m < 4; ++m) {
                asm volatile("" ::: "memory"); const int R = rbase + ai * 128 + m * 16; float s = 0.f;
#pragma unroll
                for (int bj = 0; bj < 2; ++bj) { st8(Y + (size_t)R * 1024 + pn * 256 + bj * 128 + cw, acc[ai][bj][m][0], acc[ai][bj][m][1]); s += sq4(acc[ai][bj][m][0]) + sq4(acc[ai][bj][m][1]); }
                s += __shfl_xor(s, 16); s += __shfl_xor(s, 32);
                if (fq == 0) SSQ[(size_t)R * 16 + pn * 4 + wc] = s;
            }
    }
};

struct EpiOin {
    static constexpr bool PERM = true, AFTER_DRAIN = false;
    unsigned char* ws; unsigned char* aux;
    __device__ __forceinline__ void operator()(const f32x4 (&acc)[2][2][4][2], const pg8::Unit& u, int wr, int wc, int fr, int fq) const {
        const int pn = u.pn, rbase = u.pm * 256 + wr * 64 + fr, cw = wc * 32 + 8 * fq;
        const float* ropeC = (const float*)(ws + WS_ROPEC);
#pragma unroll
        for (int ai = 0; ai < 2; ++ai)
#pragma unroll
            for (int m = 0; m < 4; ++m) {
                asm volatile("" ::: "memory"); const int R = rbase + ai * 128 + m * 16; const bool lat = R < ML; const int pos = R & 2047;
                if (pn == 0 || (pn >= 5 && pn <= 7)) {
                    float s = 0.f;
                    bf16_t* dst = (pn == 0) ? (bf16_t*)(ws + WS_CKV) + (size_t)R * 256 : (bf16_t*)(ws + WS_CQ) + (size_t)R * 768 + (pn - 5) * 256;
#pragma unroll
                    for (int bj = 0; bj < 2; ++bj) { st8(dst + bj * 128 + cw, acc[ai][bj][m][0], acc[ai][bj][m][1]); s += sq4(acc[ai][bj][m][0]) + sq4(acc[ai][bj][m][1]); }
                    s += __shfl_xor(s, 16); s += __shfl_xor(s, 32);
                    if (fq == 0) { if (pn == 0) ((float*)(ws + WS_SSQCKV))[(size_t)R * 4 + wc] = s; else ((float*)(ws + WS_SSQCQ))[(size_t)R * 12 + (pn - 5) * 4 + wc] = s; }
                } else if (pn == 4) {
                    if (wc == 0) {
                        f32x4 a = acc[ai][0][m][0], b = acc[ai][0][m][1];
                        if (lat) { const int i0 = cw >> 1; rope8(a, b, ropeC + pos * 32 + i0, ropeC + pos * 32 + 16 + i0); }
                        st8((bf16_t*)(ws + WS_KR) + (size_t)R * 32 + cw, a, b);
                    } else if (wc == 1 && fq < 2) {
                        float* g = (float*)(ws + WS_GATES) + (size_t)R * 16 + 8 * fq;
                        *(f32x4*)g = acc[ai][0][m][0]; *(f32x4*)(g + 4) = acc[ai][0][m][1];
                    }
                } else {
#pragma unroll
                    for (int bj = 0; bj < 2; ++bj) {
                        const f32x4 a = acc[ai][bj][m][0], b = acc[ai][bj][m][1]; const int col = bj * 128 + cw;
                        if (pn == 1) st8((bf16_t*)(ws + WS_MK) + (size_t)R * 256 + col, a * 0.125f, b * 0.125f);
                        else if (pn <= 3) st8((bf16_t*)(ws + WS_MV) + (size_t)R * 512 + (pn - 2) * 256 + col, a, b);
                        else if (pn == 8) st8((bf16_t*)(aux + AUX_MQ) + (size_t)R * 256 + col, a, b);
                        else if (pn >= 13) st8((bf16_t*)(aux + AUX_ZO) + (size_t)R * 512 + (pn - 13) * 256 + col, silu4(a), silu4(b));
                        else if (bj == 0) st8((bf16_t*)(aux + AUX_MO) + (size_t)R * 512 + (pn - 9) * 128 + cw, sigm4(a) * silu4(acc[ai][1][m][0]), sigm4(b) * silu4(acc[ai][1][m][1]));
                    }
                }
            }
    }
};

struct EpiUkv {
    static constexpr bool PERM = true, AFTER_DRAIN = false;
    unsigned char* ws;
    __device__ __forceinline__ void operator()(const f32x4 (&acc)[2][2][4][2], const pg8::Unit& u, int wr, int wc, int fr, int fq) const {
        const int pn = u.pn, rbase = u.pm * 256 + wr * 64 + fr, cw = wc * 32 + 8 * fq;
#pragma unroll
        for (int ai = 0; ai < 2; ++ai)
#pragma unroll
            for (int m = 0; m < 4; ++m) {
                asm volatile("" ::: "memory"); const int R = rbase + ai * 128 + m * 16;
                const f32x4 sp = *(const f32x4*)((const float*)(ws + WS_SSQCKV) + (size_t)R * 4);
                const float rstd = rsqrtf(((sp[0] + sp[1]) + (sp[2] + sp[3])) * (1.f / 256.f) + EPS);
                int b, pos; if (R < ML) { b = R >> 11; pos = 256 + (R & 2047); } else { const int rc = R - ML; b = rc >> 8; pos = rc & 255; }
#pragma unroll
                for (int bj = 0; bj < 2; ++bj) {
                    const int head = pn * 2 + bj;
                    st8((bf16_t*)(ws + WS_KNV) + ((size_t)(b * 8 + head) * 2304 + pos) * 128 + cw, acc[ai][bj][m][0] * rstd, acc[ai][bj][m][1] * rstd);
                }
            }
    }
};

struct EpiUq {
    static constexpr bool PERM = true, AFTER_DRAIN = false;
    unsigned char* ws;
    __device__ __forceinline__ void operator()(const f32x4 (&acc)[2][2][4][2], const pg8::Unit& u, int wr, int wc, int fr, int fq) const {
        const int pn = u.pn, rbase = u.pm * 256 + wr * 64 + fr, cw = wc * 32 + 8 * fq;
        const float* ropeC = (const float*)(ws + WS_ROPEC);
#pragma unroll
        for (int ai = 0; ai < 2; ++ai)
#pragma unroll
            for (int m = 0; m < 4; ++m) {
                asm volatile("" ::: "memory"); const int R = rbase + ai * 128 + m * 16, pos = R & 2047;
                const float* sp = (const float*)(ws + WS_SSQCQ) + (size_t)R * 12;
                const f32x4 s0 = *(const f32x4*)sp, s1 = *(const f32x4*)(sp + 4), s2 = *(const f32x4*)(sp + 8);
                const float ss = (((s0[0] + s0[1]) + (s0[2] + s0[3])) + ((s1[0] + s1[1]) + (s1[2] + s1[3]))) + ((s2[0] + s2[1]) + (s2[2] + s2[3]));
                const float sc = rsqrtf(ss * (1.f / 768.f) + EPS) * (0.10206207261596575f * LOG2E);
#pragma unroll
                for (int bj = 0; bj < 2; ++bj) {
                    const int c = pn * 256 + bj * 128 + cw, head = c / 96, dd = c - head * 96;
                    f32x4 a = acc[ai][bj][m][0], b = acc[ai][bj][m][1];
                    if (dd >= 64) { const int i0 = (dd - 64) >> 1; rope8(a, b, ropeC + pos * 32 + i0, ropeC + pos * 32 + 16 + i0); }
                    st8((bf16_t*)(ws + WS_QO) + (size_t)R * 768 + c, a * sc, b * sc);
                }
            }
    }
};

#define RLX_AGENT __ATOMIC_RELAXED, __HIP_MEMORY_SCOPE_AGENT
#define XB_TMO      128
#define XB_XCNT(j)  (256  + 64 * (j))
#define XB_XSUB(j)  (1280 + 64 * (j))
#define XB_XGEN(j)  (2304 + 64 * (j))
#define XB_TOP      3328
#define XB_TOPGEN   3392
#define XCD_BAR_WORDS 3456
#define XB_SPIN_CAP (1u << 18)

__device__ __forceinline__ unsigned xb_ld(unsigned* p)              { return __hip_atomic_load(p, __ATOMIC_RELAXED, __HIP_MEMORY_SCOPE_AGENT); }
__device__ __forceinline__ unsigned xb_add(unsigned* p, unsigned v) { return __hip_atomic_fetch_add(p, v, __ATOMIC_RELAXED, __HIP_MEMORY_SCOPE_AGENT); }
__device__ __forceinline__ unsigned xb_xcc_id() { return (unsigned)__builtin_amdgcn_s_getreg((3 << 11) | 20) & 0xFu; }
#define XB_SPIN(cond, bar) do { unsigned _sp = 0; while (cond) { __builtin_amdgcn_s_sleep(1); \
    if ((++_sp & 255u) == 0u) { if (xb_ld(&(bar)[XB_TMO])) break; if (_sp > XB_SPIN_CAP) { atomicAdd(&(bar)[XB_TMO], 1u); break; } } } } while (0)

struct XcdBarrier {
    unsigned* bar; unsigned x;
    volatile LAS unsigned* st;
};

__device__ __forceinline__ XcdBarrier xcd_barrier_post(unsigned* bar, volatile LAS unsigned* st) {
    XcdBarrier b; b.bar = bar; b.x = xb_xcc_id(); b.st = st;
    if (threadIdx.x == 0) (void)xb_add(&bar[XB_XCNT(b.x)], 1u);
    return b;
}
__device__ __forceinline__ void xcd_barrier_complete(unsigned* bar, unsigned x, unsigned& nloc, unsigned& nx) {
    const unsigned G = gridDim.x * gridDim.y * gridDim.z;
    unsigned sum, cnt, mine, sp = 0u;
    for (;;) {
        sum = 0u; cnt = 0u; mine = 0u;
#pragma unroll
        for (unsigned j = 0; j < 16; ++j) { const unsigned c = xb_ld(&bar[XB_XCNT(j)]); sum += c; cnt += (c > 0u) ? 1u : 0u; mine = (j == x) ? c : mine; }
        if (sum == G) break;
        __builtin_amdgcn_s_sleep(1);
        if ((++sp & 255u) == 0u) { if (xb_ld(&bar[XB_TMO])) break; if (sp > XB_SPIN_CAP) { atomicAdd(&bar[XB_TMO], 1u); break; } }
    }
    nloc = mine > 0u ? mine : 1u; nx = cnt > 0u ? cnt : 1u;
}

__device__ __forceinline__ void xcd_barrier(const XcdBarrier& b) {
    asm volatile("s_waitcnt vmcnt(0)" ::: "memory");
    __syncthreads();
    if (threadIdx.x == 0) {
        unsigned* bar = b.bar;
        __builtin_amdgcn_s_waitcnt(0);
        unsigned nloc = b.st[0], nx = b.st[1];
        if (nloc == 0u) { xcd_barrier_complete(bar, b.x, nloc, nx); b.st[0] = nloc; b.st[1] = nx; }
        const unsigned old = xb_add(&bar[XB_XSUB(b.x)], 1u);
        const unsigned gen = old / nloc;
        if (old + 1u == (gen + 1u) * nloc) {
            __builtin_amdgcn_fence(__ATOMIC_RELEASE, "agent");
            asm volatile("s_waitcnt vmcnt(0)" ::: "memory");
            (void)xb_add(&bar[XB_TOP], 1u);
        }
        const unsigned target = (gen + 1u) * nx;
        XB_SPIN((int)(xb_ld(&bar[XB_TOP]) - target) < 0, bar);
        __builtin_amdgcn_fence(__ATOMIC_ACQUIRE, "agent");
        asm volatile("s_waitcnt vmcnt(0)" ::: "memory");
    }
    __syncthreads();
}

__device__ __forceinline__ int crow(int r, int hi) { return (r & 3) + 8 * (r >> 2) + 4 * hi; }
typedef short v4i16_t __attribute__((ext_vector_type(4)));
__device__ __forceinline__ s16x4 vtr(const LAS unsigned char* p) { return __builtin_bit_cast(s16x4, __builtin_amdgcn_ds_read_tr16_b64_v4i16((LAS v4i16_t*)p)); }

template <int MODE>
__device__ __forceinline__ void attn_unit(LAS unsigned char* lds, unsigned char* ws, unsigned char* aux, const float* sink, int unit) {
    constexpr int DQK = (MODE == 2) ? 96 : 64, KST = DQK / 16, KS = DQK * 2 + 16, VS = 192, KBUF = 64 * KS, VBUF = 64 * VS;
    const int tid = my_tid(), lane = tid & 63, wid = __builtin_amdgcn_readfirstlane(tid >> 6), r32 = lane & 31, hi = lane >> 5;
    int b, head, hkv = 0, n = 0, Rq0, qpos0 = 0, nt, jlo = 0;
    const bf16_t* Qp; int qstride;
    if (MODE == 0) {
        const int hp = unit & 1; n = (unit >> 1) & 15; hkv = (unit >> 5) & 1; b = unit >> 6;
        head = hkv * 4 + hp * 2 + (wid >> 2); qpos0 = 128 * n + 32 * (wid & 3); Rq0 = b * 2048 + qpos0;
        Qp = (const bf16_t*)(ws + WS_QE) + (size_t)Rq0 * 512 + head * 64; qstride = 512;
        jlo = (n == 0) ? 2 : 0; const int jhi = (n == 15) ? 4 : 6; nt = 4 + (jhi - jlo);
    } else if (MODE == 1) {
        const int qh = unit & 1, hp = (unit >> 1) & 1; hkv = (unit >> 2) & 1; b = unit >> 3;
        head = hkv * 4 + hp * 2 + (wid >> 2); Rq0 = ML + b * 256 + 128 * qh + 32 * (wid & 3);
        Qp = (const bf16_t*)(ws + WS_QE) + (size_t)Rq0 * 512 + head * 64; qstride = 512; nt = 4;
    } else {
        const int qb = unit & 7; head = (unit >> 3) & 7; b = unit >> 6; Rq0 = b * 2048 + 256 * qb + 32 * wid;
        Qp = (const bf16_t*)(ws + WS_QO) + (size_t)Rq0 * 768 + head * 96; qstride = 768; nt = 36;
    }
    bf16x8 qf[KST];
#pragma unroll
    for (int s = 0; s < KST; ++s) qf[s] = *(const bf16x8*)(Qp + (size_t)r32 * qstride + 16 * s + 8 * hi);
    constexpr float THR = 6.0f;
    float mref, l_run;
    if (MODE == 2) { mref = 0.f; l_run = 0.f; } else { mref = sink[head] * LOG2E; l_run = (hi == 0) ? 1.f : 0.f; }
    f32x16 negm;
#pragma unroll
    for (int r = 0; r < 16; ++r) negm[r] = -mref;
    f32x16 o0, o1;
#pragma unroll
    for (int r = 0; r < 16; ++r) { o0[r] = 0.f; o1[r] = 0.f; }

    const int srow = tid >> 3, sch = tid & 7;
    const int voff = (4 * hi + ((lane & 15) >> 2)) * VS + (((lane >> 4) & 1) * 16 + 4 * (lane & 3)) * 2;
    u32x4 kregA, vregA, kreg2A, kregB, vregB, kreg2B;
    kreg2A = (u32x4){0u, 0u, 0u, 0u}; kreg2B = kreg2A;
#define ATT_SRC(t, kp, vp, k2p, kpos0v) do { \
        if (MODE == 0 || MODE == 1) { \
            if ((t) < 4) { kp = (const bf16_t*)(ws + WS_KVE) + (size_t)(ML + b * 256 + 64 * (t) + srow) * 256 + hkv * 64 + sch * 8; kpos0v = -100000; } \
            else { const int kp0_ = 128 * n - 128 + 64 * (jlo + (t) - 4); kpos0v = kp0_; \
                   kp = (const bf16_t*)(ws + WS_KVE) + (size_t)(b * 2048 + kp0_ + srow) * 256 + hkv * 64 + sch * 8; } \
            vp = kp + 128; k2p = kp; \
        } else { \
            const int pos0_ = 64 * (t); kpos0v = -100000; \
            kp = (const bf16_t*)(ws + WS_KNV) + ((size_t)(b * 8 + head) * 2304 + pos0_ + srow) * 128 + sch * 8; \
            vp = kp + 64; \
            const int krow_ = ((t) < 4) ? (ML + b * 256 + pos0_) : (b * 2048 + pos0_ - 256); \
            k2p = (const bf16_t*)(ws + WS_KR) + (size_t)(krow_ + (tid >> 2)) * 32 + (tid & 3) * 8; \
        } } while (0)
#define ATT_LOAD(t, KR_, VR_, K2_) do { const bf16_t *kp_, *vp_, *k2p_; int kq_; ATT_SRC(t, kp_, vp_, k2p_, kq_); (void)kq_; \
        KR_ = *(const u32x4*)kp_; VR_ = *(const u32x4*)vp_; if (MODE == 2 && tid < 256) K2_ = *(const u32x4*)k2p_; } while (0)
#define ATT_STORE(buf, KR_, VR_, K2_) do { LAS unsigned char* kb_ = lds + (buf) * KBUF; LAS unsigned char* vb_ = lds + 4 * KBUF + (buf) * VBUF; \
        *(LAS u32x4*)(kb_ + srow * KS + sch * 16) = KR_; \
        if (MODE == 2 && tid < 256) *(LAS u32x4*)(kb_ + (tid >> 2) * KS + 128 + (tid & 3) * 16) = K2_; \
        *(LAS u32x4*)(vb_ + srow * VS + sch * 16) = VR_; } while (0)
#define ATT_BARRIER() do { asm volatile("s_waitcnt lgkmcnt(0)" ::: "memory"); __builtin_amdgcn_s_barrier(); asm volatile("" ::: "memory"); } while (0)

#define ATT_COMPUTE(TT) do { const int buf = (TT) & 3; \
        int kpos0 = -100000; \
        if (MODE == 0 && (TT) >= 4) kpos0 = 128 * n - 128 + 64 * (jlo + (TT) - 4); \
        bool active = true; \
        if (MODE == 0 && (TT) >= 4) active = (kpos0 + 63 >= qpos0 - 128) && (kpos0 <= qpos0 + 31 + 128); \
        if (active) { \
            const LAS unsigned char* kb = lds + buf * KBUF; const LAS unsigned char* vb = lds + 4 * KBUF + buf * VBUF; \
            f32x16 p0 = negm, p1 = negm; \
_Pragma("unroll") \
            for (int s = 0; s < KST; ++s) { \
                const bf16x8 a0 = *(const LAS bf16x8*)(kb + r32 * KS + (16 * s + 8 * hi) * 2); \
                const bf16x8 a1 = *(const LAS bf16x8*)(kb + (32 + r32) * KS + (16 * s + 8 * hi) * 2); \
                p0 = __builtin_amdgcn_mfma_f32_32x32x16_bf16(a0, qf[s], p0, 0, 0, 0); \
                p1 = __builtin_amdgcn_mfma_f32_32x32x16_bf16(a1, qf[s], p1, 0, 0, 0); \
            } \
            if (MODE == 0 && (TT) >= 4 && !((kpos0 >= qpos0 - 97) && (kpos0 <= qpos0 + 65))) {     \
                const int qpos = qpos0 + r32; \
_Pragma("unroll") \
                for (int r = 0; r < 16; ++r) { const int d0 = kpos0 + crow(r, hi) - qpos, d1 = d0 + 32; \
                    if (d0 > 128 || d0 < -128) p0[r] = -INFINITY; if (d1 > 128 || d1 < -128) p1[r] = -INFINITY; } \
            } \
            float mxa = __builtin_fmaxf(__builtin_fmaxf(p0[0], p0[1]), p1[0]), mxb = __builtin_fmaxf(__builtin_fmaxf(p0[2], p0[3]), p1[1]); \
            mxa = __builtin_fmaxf(__builtin_fmaxf(mxa, p1[2]), p1[3]); \
_Pragma("unroll") \
            for (int r = 4; r < 16; r += 4) { mxa = __builtin_fmaxf(__builtin_fmaxf(mxa, p0[r]), p0[r + 1]); mxb = __builtin_fmaxf(__builtin_fmaxf(mxb, p0[r + 2]), p0[r + 3]); \
                mxa = __builtin_fmaxf(__builtin_fmaxf(mxa, p1[r]), p1[r + 1]); mxb = __builtin_fmaxf(__builtin_fmaxf(mxb, p1[r + 2]), p1[r + 3]); } \
            float mx = __builtin_fmaxf(mxa, mxb); \
            mx = __builtin_fmaxf(mx, __shfl_xor(mx, 32)); \
            const bool first = (MODE == 2) && ((TT) == 0); \
            if (first || __any(mx > THR)) { \
                const float delta = first ? mx : __builtin_fmaxf(mx, 0.f), alpha = first ? 1.f : __builtin_amdgcn_exp2f(-delta); \
                mref += delta; l_run *= alpha; \
_Pragma("unroll") \
                for (int r = 0; r < 16; ++r) { o0[r] *= alpha; o1[r] *= alpha; p0[r] -= delta; p1[r] -= delta; negm[r] = -mref; } \
            } \
            float rs0 = 0.f, rs1 = 0.f; \
_Pragma("unroll") \
            for (int r = 0; r < 16; ++r) { p0[r] = __builtin_amdgcn_exp2f(p0[r]); p1[r] = __builtin_amdgcn_exp2f(p1[r]); rs0 += p0[r]; rs1 += p1[r]; } \
            l_run += rs0 + rs1; \
            u32x4 pw[4]; \
            pw[0] = (u32x4){pk2(p0[0], p0[1]), pk2(p0[2], p0[3]), pk2(p0[4], p0[5]), pk2(p0[6], p0[7])}; \
            pw[1] = (u32x4){pk2(p0[8], p0[9]), pk2(p0[10], p0[11]), pk2(p0[12], p0[13]), pk2(p0[14], p0[15])}; \
            pw[2] = (u32x4){pk2(p1[0], p1[1]), pk2(p1[2], p1[3]), pk2(p1[4], p1[5]), pk2(p1[6], p1[7])}; \
            pw[3] = (u32x4){pk2(p1[8], p1[9]), pk2(p1[10], p1[11]), pk2(p1[12], p1[13]), pk2(p1[14], p1[15])}; \
_Pragma("unroll") \
            for (int s2 = 0; s2 < 4; ++s2) { \
                const bf16x8 pb = __builtin_bit_cast(bf16x8, pw[s2]); \
                const LAS unsigned char* va0 = vb + (16 * s2) * VS + voff; \
                const s16x4 l0 = vtr(va0), h0 = vtr(va0 + 8 * VS), l1 = vtr(va0 + 64), h1 = vtr(va0 + 8 * VS + 64); \
                const bf16x8 v0 = (bf16x8){l0[0], l0[1], l0[2], l0[3], h0[0], h0[1], h0[2], h0[3]}; \
                const bf16x8 v1 = (bf16x8){l1[0], l1[1], l1[2], l1[3], h1[0], h1[1], h1[2], h1[3]}; \
                o0 = __builtin_amdgcn_mfma_f32_32x32x16_bf16(v0, pb, o0, 0, 0, 0); \
                o1 = __builtin_amdgcn_mfma_f32_32x32x16_bf16(v1, pb, o1, 0, 0, 0); \
            } \
        } \
        } while (0)

    ATT_LOAD(0, kregA, vregA, kreg2A); ATT_LOAD(1, kregB, vregB, kreg2B);
    ATT_STORE(0, kregA, vregA, kreg2A); ATT_STORE(1, kregB, vregB, kreg2B);
    if (2 < nt) { ATT_LOAD(2, kregA, vregA, kreg2A); ATT_LOAD(3, kregB, vregB, kreg2B); }
    ATT_BARRIER();
    const int Rq = Rq0 + r32;
    const bf16_t* zrow = (MODE == 2) ? (const bf16_t*)(aux + AUX_ZO) + (size_t)Rq * 512 + head * 64 : (const bf16_t*)(ws + WS_ZA) + (size_t)Rq * 512 + head * 64;
    u32x2 zz[8];
#pragma unroll
    for (int g = 0; g < 8; ++g) zz[g] = (u32x2){0u, 0u};
    for (int t = 0; t < nt; t += 2) {
        if (t + 2 >= nt) {
#pragma unroll
            for (int g = 0; g < 4; ++g) { zz[2 * g] = *(const u32x2*)(zrow + 8 * g + 4 * hi); zz[2 * g + 1] = *(const u32x2*)(zrow + 32 + 8 * g + 4 * hi); } }
        ATT_COMPUTE(t);
        ATT_COMPUTE(t + 1);
        if (t + 2 < nt) { ATT_STORE((t + 2) & 3, kregA, vregA, kreg2A); ATT_STORE((t + 3) & 3, kregB, vregB, kreg2B); }
        if (t + 4 < nt) { ATT_LOAD(t + 4, kregA, vregA, kreg2A); ATT_LOAD(t + 5, kregB, vregB, kreg2B); }
        ATT_BARRIER();
    }
#undef ATT_COMPUTE
#undef ATT_BARRIER
#undef ATT_SRC
#undef ATT_LOAD
#undef ATT_STORE
    const float l_tot = l_run + __shfl_xor(l_run, 32), inv = __builtin_amdgcn_rcpf(l_tot);
    bf16_t* urow = (bf16_t*)(ws + WS_U) + (size_t)Rq * 1024 + head * 64;
#pragma unroll
    for (int g = 0; g < 4; ++g) {
        const int dv = 8 * g + 4 * hi;
        { const u32x2 z = zz[2 * g];
          u32x2 w; w.x = pk2(o0[4 * g] * inv * bf_lo(z.x), o0[4 * g + 1] * inv * bf_hi(z.x)); w.y = pk2(o0[4 * g + 2] * inv * bf_lo(z.y), o0[4 * g + 3] * inv * bf_hi(z.y));
          *(u32x2*)(urow + dv) = w; }
        { const u32x2 z = zz[2 * g + 1];
          u32x2 w; w.x = pk2(o1[4 * g] * inv * bf_lo(z.x), o1[4 * g + 1] * inv * bf_hi(z.x)); w.y = pk2(o1[4 * g + 2] * inv * bf_lo(z.y), o1[4 * g + 3] * inv * bf_hi(z.y));
          *(u32x2*)(urow + 32 + dv) = w; }
    }
}


__device__ __forceinline__ int srcmap(int mat, int dn) {
    if (mat == 0) {
        if (dn < 128) { const int d = dn & 63; return (dn & 64) + (d >> 1) + 32 * (d & 1); }
        if (dn < 256) return dn;
        if (dn < 768) { const int j = dn - 256, d = j & 63; return 256 + (j & ~63) + (d >> 1) + 32 * (d & 1); }
        if (dn < 1792) { const int j = dn - 768, blk = j >> 8, w = j & 255; return (w < 128) ? 1280 + blk * 128 + w : 1792 + blk * 128 + (w - 128); }
        if (dn < 2816) { const int j = dn - 1792, blk = j >> 8, w = j & 255; return (w < 128) ? 768 + blk * 128 + w : 2816 + blk * 128 + (w - 128); }
        return 2304 + (dn - 2816);
    }
    if (mat == 2) {
        if (dn < 256) return dn;
        if (dn < 512) return 288 + (dn - 256);
        if (dn < 1024) return 544 + (dn - 512);
        if (dn < 1280) { const int w = dn - 1024; if (w < 32) return 256 + (w >> 1) + 16 * (w & 1); if (w < 48) return 1056 + (w - 32); return -1; }
        if (dn < 2048) return 1072 + (dn - 1280);
        if (dn < 2304) return 1840 + (dn - 2048);
        if (dn < 3328) { const int j = dn - 2304, blk = j >> 8, w = j & 255; return (w < 128) ? 2096 + blk * 128 + w : 2608 + 512 + blk * 128 + (w - 128); }
        return 2608 + (dn - 3328);
    }
    if (mat == 3) {
        const int head = dn / 96, d = dn - head * 96; if (d < 64) return dn; const int w = d - 64; return head * 96 + 64 + (w >> 1) + 16 * (w & 1);
    }
    return dn;
}
__device__ __forceinline__ void p0_transpose_item(const float* W, int K, int Nsrc, bf16_t* WT, int mat, const float* kscale, LAS float* scr, int item, int nblk, int lane) {
    const int kb = item / nblk, nb = item % nblk, k0 = 64 * kb, n0 = 32 * nb;
    const int sc = srcmap(mat, n0 + (lane & 31));
    float v[32];
    const float* wp = W + (size_t)(k0 + (lane >> 5)) * Nsrc + (sc >= 0 ? sc : 0);
#pragma unroll
    for (int i = 0; i < 32; ++i) v[i] = wp[(size_t)(2 * i) * Nsrc];
#pragma unroll
    for (int i = 0; i < 32; ++i) { const int kk = 2 * i + (lane >> 5); float x = (sc >= 0) ? v[i] : 0.f; if (kscale) x *= kscale[k0 + kk]; scr[kk * 33 + (lane & 31)] = x; }
    LDS_WAIT(); asm volatile("" ::: "memory");
    const int c = lane & 7;
#pragma unroll
    for (int j = 0; j < 4; ++j) { const int n = (lane >> 3) + 8 * j; const LAS float* s = scr + (8 * c) * 33 + n;
        u32x4 o; o.x = pk2(s[0 * 33], s[1 * 33]); o.y = pk2(s[2 * 33], s[3 * 33]); o.z = pk2(s[4 * 33], s[5 * 33]); o.w = pk2(s[6 * 33], s[7 * 33]);
        *(u32x4*)(WT + (size_t)(n0 + n) * K + k0 + 8 * c) = o; }
    LDS_WAIT(); asm volatile("" ::: "memory");
}

__device__ __forceinline__ void p0_mod(LAS unsigned char* lds, const float* c, const float* c_ctx, const float* mod_w, const float* mod_b, float* MOD, int G) {
    const int tid = my_tid();
    if ((int)blockIdx.x >= 192) return;
    LAS float* scs = (LAS float*)lds;
    LAS float* red = (LAS float*)(lds + 1024 * 20 * 4);
    { float cv[34];
#pragma unroll
      for (int u = 0; u < 34; ++u) { const int idx = tid + u * NTHREADS, r = idx >> 10, k = idx & 1023; cv[u] = (r < 16) ? c[r * 1024 + k] : c_ctx[k]; }
#pragma unroll
      for (int u = 0; u < 34; ++u) { const int idx = tid + u * NTHREADS, r = idx >> 10, k = idx & 1023; scs[k * 20 + r] = silu_f(cv[u]); } }
    __syncthreads();
    for (int item = blockIdx.x; item < 192; item += G) {
        const int l = item / 96, n0 = (item % 96) * 32, col = tid & 31, kg = tid >> 5;
        float acc[20];
#pragma unroll
        for (int r = 0; r < 20; ++r) acc[r] = 0.f;
        const float* wp = mod_w + ((size_t)l * 1024 + kg * 64) * 3072 + n0 + col;
#pragma unroll
        for (int kb = 0; kb < 4; ++kb) {
            float w[16];
#pragma unroll
            for (int u = 0; u < 16; ++u) w[u] = wp[(size_t)(kb * 16 + u) * 3072];
#pragma unroll
            for (int u = 0; u < 16; ++u) { const LAS f32x4* sp = (const LAS f32x4*)(scs + (kg * 64 + kb * 16 + u) * 20);
#pragma unroll
                for (int q = 0; q < 5; ++q) { const f32x4 s = sp[q]; acc[4 * q] += s[0] * w[u]; acc[4 * q + 1] += s[1] * w[u]; acc[4 * q + 2] += s[2] * w[u]; acc[4 * q + 3] += s[3] * w[u]; } }
        }
#pragma unroll
        for (int r = 0; r < 17; ++r) red[(kg * 17 + r) * 32 + col] = acc[r];
        __syncthreads();
        for (int o = tid; o < 17 * 32; o += NTHREADS) { const int r = o >> 5, cc = o & 31; float s = mod_b[l * 3072 + n0 + cc];
#pragma unroll
            for (int g = 0; g < 16; ++g) s += red[(g * 17 + r) * 32 + cc];
            MOD[((size_t)l * 17 + r) * 3072 + n0 + cc] = s; }
        __syncthreads();
    }
}

__device__ __forceinline__ void norm_mod_store(const f32x4 (&v)[4], const float* pre_w, const float* modrow, bf16_t* hrow, int lane) {
    float ss = 0.f;
#pragma unroll
    for (int j = 0; j < 4; ++j) ss += sq4(v[j]);
    const float rstd = rsqrtf(wave_sum(ss) * (1.f / 1024.f) + EPS);
#pragma unroll
    for (int j = 0; j < 4; ++j) { const int k = 4 * (lane + 64 * j);
        const f32x4 w = *(const f32x4*)(pre_w + k), sh = *(const f32x4*)(modrow + k), sc = *(const f32x4*)(modrow + 1024 + k);
        const f32x4 h = v[j] * rstd * w * (sc + 1.0f) + sh;
        u32x2 o; o.x = pk2(h[0], h[1]); o.y = pk2(h[2], h[3]); *(u32x2*)(hrow + k) = o; }
}
__device__ __forceinline__ void norm_mod_store_wt(const f32x4 (&v)[4], const float* pre_w, const float* modrow, bf16_t* hrow, int lane) {
    float ss = 0.f;
#pragma unroll
    for (int j = 0; j < 4; ++j) ss += sq4(v[j]);
    const float rstd = rsqrtf(wave_sum(ss) * (1.f / 1024.f) + EPS);
#pragma unroll
    for (int j = 0; j < 4; ++j) { const int k = 4 * (lane + 64 * j);
        const f32x4 w = *(const f32x4*)(pre_w + k), sh = *(const f32x4*)(modrow + k), sc = *(const f32x4*)(modrow + 1024 + k);
        const f32x4 h = v[j] * rstd * w * (sc + 1.0f) + sh;
        __hip_atomic_store((unsigned long long*)(hrow + k), (unsigned long long)pk2(h[0], h[1]) | ((unsigned long long)pk2(h[2], h[3]) << 32), __ATOMIC_RELAXED, __HIP_MEMORY_SCOPE_AGENT); }
}
__device__ __forceinline__ void p1_stream(const float* x, const float* ctx, const float* pre_w, const float* MOD, bf16_t* H, unsigned* ready, int sw, int nsw, int lane) {
    f32x4 cur[4][4], nxt[4][4];
#define P1_LOAD(dst, R_) do { if ((R_) < MT) { const float* src_ = ((R_) < ML) ? x + (size_t)(R_) * 1024 : ctx + (size_t)((R_) - ML) * 1024; \
        _Pragma("unroll") for (int j = 0; j < 4; ++j) dst[j] = *(const f32x4*)(src_ + 4 * (lane + 64 * j)); } } while (0)
#pragma unroll
    for (int q = 0; q < 4; ++q) P1_LOAD(cur[q], sw + nsw * q);
    for (int R0 = sw; R0 < MT; R0 += 4 * nsw) {
#pragma unroll
        for (int q = 0; q < 4; ++q) P1_LOAD(nxt[q], R0 + nsw * (4 + q));
#pragma unroll
        for (int q = 0; q < 4; ++q) { const int R = R0 + nsw * q; if (R < MT) { const int bi = (R < ML) ? (R >> 11) : 16;
            norm_mod_store_wt(cur[q], pre_w, MOD + (size_t)bi * 3072, H + (size_t)R * 1024, lane); } }
        asm volatile("s_waitcnt vmcnt(0)" ::: "memory");
        if (lane < 4) { const int R = R0 + nsw * lane; if (R < MT) __hip_atomic_fetch_add(ready + 64 * (R >> 8), 1u, __ATOMIC_RELAXED, __HIP_MEMORY_SCOPE_AGENT); }
#pragma unroll
        for (int q = 0; q < 4; ++q)
#pragma unroll
            for (int j = 0; j < 4; ++j) cur[q][j] = nxt[q][j];
    }
#undef P1_LOAD
}
__device__ __forceinline__ void p1_prenorm(const float* x, const float* ctx, const float* pre_w, const float* MOD, bf16_t* H, int gw, int ngw, int lane) {
    f32x4 cur[4], nxt[4];
#define P1_LOAD(dst, R_) do { const float* src_ = ((R_) < ML) ? x + (size_t)(R_) * 1024 : ctx + (size_t)((R_) - ML) * 1024; \
        _Pragma("unroll") for (int j = 0; j < 4; ++j) dst[j] = *(const f32x4*)(src_ + 4 * (lane + 64 * j)); } while (0)
    if (gw < MT) P1_LOAD(cur, gw);
    for (int R = gw; R < MT; R += ngw) {
        const int Rn = R + ngw; if (Rn < MT) P1_LOAD(nxt, Rn);
        const int bi = (R < ML) ? (R >> 11) : 16;
        norm_mod_store(cur, pre_w, MOD + (size_t)bi * 3072, H + (size_t)R * 1024, lane);
#pragma unroll
        for (int j = 0; j < 4; ++j) cur[j] = nxt[j];
    }
#undef P1_LOAD
}
__device__ __forceinline__ float ssq16(const float* p) {
    const f32x4 a = *(const f32x4*)p, b = *(const f32x4*)(p + 4), c = *(const f32x4*)(p + 8), d = *(const f32x4*)(p + 12);
    return (((a[0] + a[1]) + (a[2] + a[3])) + ((b[0] + b[1]) + (b[2] + b[3]))) + (((c[0] + c[1]) + (c[2] + c[3])) + ((d[0] + d[1]) + (d[2] + d[3])));
}
__device__ __forceinline__ void p5_post_pre(const float* x, const float* ctx, const float* post_w0, const float* pre_w1, const float* MOD, const bf16_t* Y, const float* SSQ, bf16_t* X1, bf16_t* H, int gw, int ngw, int lane) {
    const int per = (MT + ngw - 1) / ngw, r0 = gw * per, r1 = (r0 + per < MT) ? r0 + per : MT;
    f32x4 xc[4], xn[4], sqc[4], sqn[4]; u32x2 yc[4], yn[4];
    f32x4 pg[4], pw[4], w1[4], sc1[4], sh1[4];
#pragma unroll
    for (int j = 0; j < 4; ++j) { const int k = 4 * (lane + 64 * j); pw[j] = *(const f32x4*)(post_w0 + k); w1[j] = *(const f32x4*)(pre_w1 + k); pg[j] = pw[j]; sc1[j] = pw[j]; sh1[j] = pw[j]; }
#define P5_LOAD(xd, yd, sd, R_) do { const float* src_ = ((R_) < ML) ? x + (size_t)(R_) * 1024 : ctx + (size_t)((R_) - ML) * 1024; \
        _Pragma("unroll") for (int j = 0; j < 4; ++j) { xd[j] = *(const f32x4*)(src_ + 4 * (lane + 64 * j)); yd[j] = *(const u32x2*)(Y + (size_t)(R_) * 1024 + 4 * (lane + 64 * j)); \
            sd[j] = *(const f32x4*)(SSQ + (size_t)(R_) * 16 + 4 * j); } } while (0)
    if (r0 < r1) P5_LOAD(xc, yc, sqc, r0);
    int cur_bi = -1;
    for (int R = r0; R < r1; ++R) {
        if (R + 1 < r1) P5_LOAD(xn, yn, sqn, R + 1);
        const int bi = (R < ML) ? (R >> 11) : 16;
        if (bi != cur_bi) { cur_bi = bi; const float* m0 = MOD + (size_t)bi * 3072; const float* m1 = MOD + (size_t)(17 + bi) * 3072;
#pragma unroll
            for (int j = 0; j < 4; ++j) { const int k = 4 * (lane + 64 * j); pg[j] = *(const f32x4*)(m0 + 2048 + k); sh1[j] = *(const f32x4*)(m1 + k); sc1[j] = *(const f32x4*)(m1 + 1024 + k) + 1.0f; } }
        const float ssy = (((sqc[0][0] + sqc[0][1]) + (sqc[0][2] + sqc[0][3])) + ((sqc[1][0] + sqc[1][1]) + (sqc[1][2] + sqc[1][3]))) + (((sqc[2][0] + sqc[2][1]) + (sqc[2][2] + sqc[2][3])) + ((sqc[3][0] + sqc[3][1]) + (sqc[3][2] + sqc[3][3])));
        const float rstd_y = rsqrtf(ssy * (1.f / 1024.f) + EPS);
        f32x4 v[4]; float ss = 0.f;
#pragma unroll
        for (int j = 0; j < 4; ++j) { const int k = 4 * (lane + 64 * j);
            const f32x4 y = (f32x4){bf_lo(yc[j].x), bf_hi(yc[j].x), bf_lo(yc[j].y), bf_hi(yc[j].y)};
            v[j] = xc[j] + pg[j] * (y * rstd_y * pw[j]);
            ss += sq4(v[j]);
            if (R < ML) { u32x2 o; o.x = pk2(v[j][0], v[j][1]); o.y = pk2(v[j][2], v[j][3]); *(u32x2*)(X1 + (size_t)R * 1024 + k) = o; } }
        const float rstd = rsqrtf(wave_sum(ss) * (1.f / 1024.f) + EPS);
#pragma unroll
        for (int j = 0; j < 4; ++j) { const int k = 4 * (lane + 64 * j);
            const f32x4 h = v[j] * rstd * w1[j] * sc1[j] + sh1[j];
            u32x2 o; o.x = pk2(h[0], h[1]); o.y = pk2(h[2], h[3]); *(u32x2*)(H + (size_t)R * 1024 + k) = o; }
#pragma unroll
        for (int j = 0; j < 4; ++j) { xc[j] = xn[j]; yc[j] = yn[j]; sqc[j] = sqn[j]; }
    }
#undef P5_LOAD
}
__device__ __forceinline__ void p11_final(const float* post_w1, const float* MOD, const bf16_t* Y, const float* SSQ, const bf16_t* X1, float* out, int gw, int ngw, int lane) {
    u32x2 xc[4], xn[4], yc[4], yn[4];
#define P11_LOAD(xd, yd, R_) do { _Pragma("unroll") for (int j = 0; j < 4; ++j) { xd[j] = *(const u32x2*)(X1 + (size_t)(R_) * 1024 + 4 * (lane + 64 * j)); yd[j] = *(const u32x2*)(Y + (size_t)(R_) * 1024 + 4 * (lane + 64 * j)); } } while (0)
    if (gw < ML) P11_LOAD(xc, yc, gw);
    for (int R = gw; R < ML; R += ngw) {
        const int Rn = R + ngw; if (Rn < ML) P11_LOAD(xn, yn, Rn);
        const float rstd_y = rsqrtf(ssq16(SSQ + (size_t)R * 16) * (1.f / 1024.f) + EPS);
        const float* m1 = MOD + (size_t)(17 + (R >> 11)) * 3072;
#pragma unroll
        for (int j = 0; j < 4; ++j) { const int k = 4 * (lane + 64 * j);
            const f32x4 y = (f32x4){bf_lo(yc[j].x), bf_hi(yc[j].x), bf_lo(yc[j].y), bf_hi(yc[j].y)};
            const f32x4 g = *(const f32x4*)(m1 + 2048 + k), pw = *(const f32x4*)(post_w1 + k), xv = (f32x4){bf_lo(xc[j].x), bf_hi(xc[j].x), bf_lo(xc[j].y), bf_hi(xc[j].y)};
            *(f32x4*)(out + (size_t)R * 1024 + k) = xv + g * (y * rstd_y * pw); }
#pragma unroll
        for (int j = 0; j < 4; ++j) { xc[j] = xn[j]; yc[j] = yn[j]; }
    }
#undef P11_LOAD
}
__device__ __forceinline__ void p3_conv(unsigned char* ws, const float* conv_w, int gtid, int ngt) {
    const bf16_t* PE = (const bf16_t*)(ws + WS_PE); const bf16_t* GE = (const bf16_t*)(ws + WS_GE); bf16_t* U = (bf16_t*)(ws + WS_U);
    for (int it = gtid; it < MT * 64; it += ngt) {
        const int R = it >> 6, ch = (it & 63) * 8;
        int t, T; if (R < ML) { t = R & 2047; T = 2048; } else { t = (R - ML) & 255; T = 256; }
        const u32x4 z4 = (u32x4){0u, 0u, 0u, 0u};
        const u32x4 pc = *(const u32x4*)(PE + (size_t)R * 512 + ch);
        const u32x4 pm = (t > 0) ? *(const u32x4*)(PE + (size_t)(R - 1) * 512 + ch) : z4;
        const u32x4 pp = (t < T - 1) ? *(const u32x4*)(PE + (size_t)(R + 1) * 512 + ch) : z4;
        const u32x4 g = *(const u32x4*)(GE + (size_t)R * 512 + ch);
        const f32x4 w0a = *(const f32x4*)(conv_w + ch), w0b = *(const f32x4*)(conv_w + ch + 4), w1a = *(const f32x4*)(conv_w + 512 + ch), w1b = *(const f32x4*)(conv_w + 512 + ch + 4),
                    w2a = *(const f32x4*)(conv_w + 1024 + ch), w2b = *(const f32x4*)(conv_w + 1024 + ch + 4);
        u32x4 o;
#define CV(pmw, pcw, ppw, gw_, wa, wb, wc_, e0, e1) pk2(bf_lo(gw_) * (wa[e0] * bf_lo(pmw) + wb[e0] * bf_lo(pcw) + wc_[e0] * bf_lo(ppw)), bf_hi(gw_) * (wa[e1] * bf_hi(pmw) + wb[e1] * bf_hi(pcw) + wc_[e1] * bf_hi(ppw)))
        o.x = CV(pm.x, pc.x, pp.x, g.x, w0a, w1a, w2a, 0, 1); o.y = CV(pm.y, pc.y, pp.y, g.y, w0a, w1a, w2a, 2, 3);
        o.z = CV(pm.z, pc.z, pp.z, g.z, w0b, w1b, w2b, 0, 1); o.w = CV(pm.w, pc.w, pp.w, g.w, w0b, w1b, w2b, 2, 3);
#undef CV
        *(u32x4*)(U + (size_t)R * 1024 + 512 + ch) = o;
    }
}
__device__ __forceinline__ void p9_readout(unsigned char* ws, unsigned char* aux, const float* hn_w, int gw, int ngw, int lane) {
    const bf16_t* HM = (const bf16_t*)(ws + WS_HM); const bf16_t* MO = (const bf16_t*)(aux + AUX_MO); bf16_t* U = (bf16_t*)(ws + WS_U);
    for (int R = gw; R < ML; R += ngw) {
        const int ch = 8 * lane;
        const u32x4 h0 = *(const u32x4*)(HM + (size_t)R * 512 + ch), h1 = *(const u32x4*)(HM + ((size_t)ML + R) * 512 + ch);
        float hs[8] = {bf_lo(h0.x) + bf_lo(h1.x), bf_hi(h0.x) + bf_hi(h1.x), bf_lo(h0.y) + bf_lo(h1.y), bf_hi(h0.y) + bf_hi(h1.y),
                       bf_lo(h0.z) + bf_lo(h1.z), bf_hi(h0.z) + bf_hi(h1.z), bf_lo(h0.w) + bf_lo(h1.w), bf_hi(h0.w) + bf_hi(h1.w)};
        float ss = 0.f;
#pragma unroll
        for (int e = 0; e < 8; ++e) ss += hs[e] * hs[e];
        ss += __shfl_xor(ss, 1); ss += __shfl_xor(ss, 2); ss += __shfl_xor(ss, 4); ss += __shfl_xor(ss, 8);
        const float rstd = rsqrtf(ss * (1.f / 128.f) + EPS);
        const u32x4 mo = *(const u32x4*)(MO + (size_t)R * 512 + ch);
        const f32x4 wa = *(const f32x4*)(hn_w + ch), wb = *(const f32x4*)(hn_w + ch + 4);
        u32x4 o;
        o.x = pk2(hs[0] * rstd * wa[0] * bf_lo(mo.x), hs[1] * rstd * wa[1] * bf_hi(mo.x));
        o.y = pk2(hs[2] * rstd * wa[2] * bf_lo(mo.y), hs[3] * rstd * wa[3] * bf_hi(mo.y));
        o.z = pk2(hs[4] * rstd * wb[0] * bf_lo(mo.z), hs[5] * rstd * wb[1] * bf_hi(mo.z));
        o.w = pk2(hs[6] * rstd * wb[2] * bf_lo(mo.w), hs[7] * rstd * wb[3] * bf_hi(mo.w));
        *(u32x4*)(U + (size_t)R * 1024 + 512 + ch) = o;
    }
}


typedef float f32x4v __attribute__((ext_vector_type(4)));
#define LDS_BARRIER() do { asm volatile("s_waitcnt lgkmcnt(0)" ::: "memory"); __builtin_amdgcn_s_barrier(); asm volatile("" ::: "memory"); } while (0)
#define MFMA_FENCE(x) do { __builtin_amdgcn_sched_barrier(0); asm volatile("s_nop 15\n\ts_nop 15" : "+v"(x)); __builtin_amdgcn_sched_barrier(0); } while (0)
__device__ __forceinline__ bf16x8 tr8(const LAS unsigned char* p, int halfstride) {
    const s16x4 lo = vtr(p), hi = vtr(p + halfstride);
    return (bf16x8){lo[0], lo[1], lo[2], lo[3], hi[0], hi[1], hi[2], hi[3]};
}
__device__ __forceinline__ bf16x8 gather8(const LAS unsigned char* img, int stride, int row0, int col) {
    bf16x8 r;
#pragma unroll
    for (int e = 0; e < 8; ++e) r[e] = *(const LAS short*)(img + (row0 + e) * stride + col * 2);
    return r;
}
template <int CTRL, int RM> __device__ __forceinline__ float dppf(float oldv, float v) {
    return __int_as_float(__builtin_amdgcn_update_dpp(__float_as_int(oldv), __float_as_int(v), CTRL, RM, 0xf, false));
}
__device__ __forceinline__ float wave_scan_add(float v) {
    v += dppf<0x111, 0xf>(0.f, v); v += dppf<0x112, 0xf>(0.f, v); v += dppf<0x114, 0xf>(0.f, v); v += dppf<0x118, 0xf>(0.f, v);
    v += dppf<0x142, 0xa>(0.f, v); v += dppf<0x143, 0xc>(0.f, v);
    return v;
}
__device__ __forceinline__ float wave_scan_max(float v) {
    const float ninf = -INFINITY;
    v = fmaxf(v, dppf<0x111, 0xf>(ninf, v)); v = fmaxf(v, dppf<0x112, 0xf>(ninf, v)); v = fmaxf(v, dppf<0x114, 0xf>(ninf, v)); v = fmaxf(v, dppf<0x118, 0xf>(ninf, v));
    v = fmaxf(v, dppf<0x142, 0xa>(ninf, v)); v = fmaxf(v, dppf<0x143, 0xc>(ninf, v));
    return v;
}
template <bool DUMMY> __device__ __forceinline__ void mlstm_chain_mfma(LAS unsigned char* lds, unsigned char* ws, unsigned char* aux, const float* i_bias, const float* f_bias, int chain) {
    constexpr int RS = 144, VS = 176;
    constexpr int QI = 0, KI = 9216, SC = 18432, CI = 27648, VI = 39168, VW = 50432, VEC = 61696;
    const int tid = my_tid(), lane = tid & 63, wid = __builtin_amdgcn_readfirstlane(tid >> 6), l15 = lane & 15, kg = lane >> 4;
    const int vh = chain & 1, d = (chain >> 1) & 1, h = (chain >> 2) & 3, b = chain >> 4;
    LAS float* vb_ = (LAS float*)(lds + VEC); LAS float* vab = vb_ + 64; LAS float* vcm = vab + 64; LAS float* vwp = vcm + 64; LAS float* vsc = vwp + 64;
    const bf16_t* MK = (const bf16_t*)(ws + WS_MK); const bf16_t* MV = (const bf16_t*)(ws + WS_MV); const bf16_t* MQ = (const bf16_t*)(aux + AUX_MQ);
    const float* GT = (const float*)(ws + WS_GATES); bf16_t* HM = (bf16_t*)(ws + WS_HM);
    const float ib = i_bias[d * 4 + h], fb = f_bias[d * 4 + h];
    for (int idx = tid; idx < 80 * RS / 4; idx += NTHREADS) ((LAS unsigned*)(lds + CI))[idx] = 0u;
    if (tid < 64) { LAS unsigned* a = (LAS unsigned*)(lds + VI + tid * VS + 128); LAS unsigned* w = (LAS unsigned*)(lds + VW + tid * VS + 128);
#pragma unroll
        for (int e = 0; e < 8; ++e) { a[e] = (e == 0) ? 0x3F80u : 0u; w[e] = 0u; } }
    const int it = wid & 3, vg = wid >> 2;
    f32x4v cacc[3];
#pragma unroll
    for (int t = 0; t < 3; ++t) cacc[t] = (f32x4v){0.f, 0.f, 0.f, 0.f};
    float mst = 0.f;
    unsigned nbad = 0u;
    const int srow = tid >> 3, sch = tid & 7;
    const int q4 = l15 >> 2, p4 = l15 & 3;
    u32x4 kkN, vvN, qqN = (u32x4){0u, 0u, 0u, 0u}; float liN = 0.f, fpN = 0.f;
#define MLSTM_LOADS(S_) do { const bool lat_ = (S_) >= 4; const int c_ = lat_ ? (S_) - 4 : (S_), T_ = lat_ ? 2048 : 256, rowb_ = lat_ ? b * 2048 : ML + b * 256; \
        const int tok_ = (d == 0) ? 64 * c_ + srow : T_ - 1 - (64 * c_ + srow); const size_t R_ = (size_t)(rowb_ + tok_); \
        kkN = *(const u32x4*)(MK + R_ * 256 + h * 64 + sch * 8); vvN = *(const u32x4*)(MV + R_ * 512 + h * 128 + vh * 64 + sch * 8); \
        if (lat_) qqN = *(const u32x4*)(MQ + R_ * 256 + h * 64 + sch * 8); \
        if (wid == 0) { const int tk_ = (d == 0) ? 64 * c_ + lane : T_ - 1 - (64 * c_ + lane); const float* gp_ = GT + (size_t)(rowb_ + tk_) * 16 + d * 8 + h; liN = gp_[0]; fpN = gp_[4]; } } while (0)
    MLSTM_LOADS(0);
    for (int step = 0; step < 36; ++step) {
        const bool lat = step >= 4; const int c = lat ? step - 4 : step, T = lat ? 2048 : 256, rowb = lat ? b * 2048 : ML + b * 256;
        const int tok = (d == 0) ? 64 * c + srow : T - 1 - (64 * c + srow); const size_t R = (size_t)(rowb + tok);
        const u32x4 kk = kkN, vv = vvN, qq = qqN;
        if (wid == 0) {
            const float li = liN + ib, fp = fpN + fb;
            const float lf = fminf(fp, 0.f) - __logf(1.f + __expf(-fabsf(fp)));
            const float bc = wave_scan_add(lf);
            const float ab = li - bc; const float cm = wave_scan_max(ab);
            const float g = __int_as_float(__builtin_amdgcn_readlane(__float_as_int(bc), 63)), mloc = g + __int_as_float(__builtin_amdgcn_readlane(__float_as_int(cm), 63)), m_new = fmaxf(g + mst, mloc);
            vb_[lane] = bc; vab[lane] = ab; vcm[lane] = cm; vwp[lane] = __expf(g + ab - m_new);
            if (lane == 0) { vsc[0] = mst; vsc[1] = __expf(g + mst - m_new); }
            mst = m_new;
        }
        LDS_BARRIER();
        { const float wj = vwp[srow];
          *(LAS u32x4*)(lds + KI + srow * RS + sch * 16) = kk;
          *(LAS u32x4*)(lds + VI + srow * VS + sch * 16) = vv;
          u32x4 vw; vw.x = pk2(bf_lo(vv.x) * wj, bf_hi(vv.x) * wj); vw.y = pk2(bf_lo(vv.y) * wj, bf_hi(vv.y) * wj); vw.z = pk2(bf_lo(vv.z) * wj, bf_hi(vv.z) * wj); vw.w = pk2(bf_lo(vv.w) * wj, bf_hi(vv.w) * wj);
          *(LAS u32x4*)(lds + VW + srow * VS + sch * 16) = vw;
          if (sch == 0) *(LAS unsigned short*)(lds + VW + srow * VS + 128) = f2bf(wj);
          if (lat) *(LAS u32x4*)(lds + QI + srow * RS + sch * 16) = qq; }
        LDS_BARRIER();
        const float m_in = vsc[0], a_prev = vsc[1];
        if (step + 1 < 36) MLSTM_LOADS(step + 1);
        bf16x8 qf[2];
        if (lat) {
            qf[0] = *(const LAS bf16x8*)(lds + QI + (16 * it + l15) * RS + (8 * kg) * 2); qf[1] = *(const LAS bf16x8*)(lds + QI + (16 * it + l15) * RS + (8 * kg + 32) * 2);
            const int i = 16 * it + l15; const float mi = fmaxf(m_in, vcm[i]);
#pragma unroll
            for (int t = 0; t < 2; ++t) {
                const int jt = 2 * vg + t; u32x2 o = (u32x2){0u, 0u};
                if (jt <= it) {
                    const bf16x8 k0 = *(const LAS bf16x8*)(lds + KI + (16 * jt + l15) * RS + (8 * kg) * 2), k1 = *(const LAS bf16x8*)(lds + KI + (16 * jt + l15) * RS + (8 * kg + 32) * 2);
                    f32x4v s = (f32x4v){0.f, 0.f, 0.f, 0.f};
                    s = __builtin_amdgcn_mfma_f32_16x16x32_bf16(k0, qf[0], s, 0, 0, 0); s = __builtin_amdgcn_mfma_f32_16x16x32_bf16(k1, qf[1], s, 0, 0, 0); MFMA_FENCE(s);
                    const int j0 = 16 * jt + 4 * kg; const f32x4v abv = *(const LAS f32x4v*)(vab + j0);
                    float e[4];
#pragma unroll
                    for (int r = 0; r < 4; ++r) e[r] = (j0 + r <= i) ? s[r] * __expf(abv[r] - mi) : 0.f;
                    o.x = pk2(e[0], e[1]); o.y = pk2(e[2], e[3]);
                }
                *(LAS u32x2*)(lds + SC + i * RS + (16 * jt + 4 * kg) * 2) = o;
            }
        }
        LDS_BARRIER();
        f32x4v cnew[3];
        { bf16x8 aK[2];
#pragma unroll
          for (int s = 0; s < 2; ++s) aK[s] = tr8(lds + KI + (32 * s + 8 * kg + q4) * RS + (16 * it + 4 * p4) * 2, 4 * RS);
#pragma unroll
          for (int t = 0; t < 3; ++t) { const int vt = (t == 2) ? 4 : 2 * t + vg; f32x4v a = cacc[t] * a_prev;
#pragma unroll
              for (int s = 0; s < 2; ++s) { const bf16x8 bW = tr8(lds + VW + (32 * s + 8 * kg + q4) * VS + (16 * vt + 4 * p4) * 2, 4 * VS); a = __builtin_amdgcn_mfma_f32_16x16x32_bf16(aK[s], bW, a, 0, 0, 0); }
              MFMA_FENCE(a); cnew[t] = a; } }
        if (lat) {
            const int i0 = 16 * it + 4 * kg; const f32x4v cmv = *(const LAS f32x4v*)(vcm + i0), bv = *(const LAS f32x4v*)(vb_ + i0);
            float wi[4], mt[4];
#pragma unroll
            for (int r = 0; r < 4; ++r) { const float mi = fmaxf(m_in, cmv[r]); wi[r] = __expf(m_in - mi); mt[r] = bv[r] + mi; }
            bf16x8 aS[2];
            aS[0] = *(const LAS bf16x8*)(lds + SC + (16 * it + l15) * RS + (8 * kg) * 2); aS[1] = *(const LAS bf16x8*)(lds + SC + (16 * it + l15) * RS + (8 * kg + 32) * 2);
            f32x4v nacc[3];
#pragma unroll
            for (int t = 0; t < 3; ++t) { const int vt = (t == 2) ? 4 : 2 * t + vg; f32x4v a = (f32x4v){0.f, 0.f, 0.f, 0.f};
#pragma unroll
                for (int s = 0; s < 2; ++s) { const bf16x8 bC = *(const LAS bf16x8*)(lds + CI + (16 * vt + l15) * RS + (8 * kg + 32 * s) * 2); a = __builtin_amdgcn_mfma_f32_16x16x32_bf16(qf[s], bC, a, 0, 0, 0); }
                MFMA_FENCE(a);
#pragma unroll
                for (int r = 0; r < 4; ++r) a[r] *= wi[r];
#pragma unroll
                for (int s = 0; s < 2; ++s) { const bf16x8 bV = tr8(lds + VI + (32 * s + 8 * kg + q4) * VS + (16 * vt + 4 * p4) * 2, 4 * VS); a = __builtin_amdgcn_mfma_f32_16x16x32_bf16(aS[s], bV, a, 0, 0, 0); }
                MFMA_FENCE(a); nacc[t] = a; }
            float inv[4];
#pragma unroll
            for (int r = 0; r < 4; ++r) { const float den = __shfl(nacc[2][r], lane & 48); inv[r] = 1.f / fmaxf(fabsf(den), __expf(-mt[r])); }
#pragma unroll
            for (int t = 0; t < 2; ++t) { const int vt = 2 * t + vg;
#pragma unroll
                for (int r = 0; r < 4; ++r) *(LAS unsigned short*)(lds + QI + (i0 + r) * RS + (16 * vt + l15) * 2) = f2bf(nacc[t][r] * inv[r]); }
        }
        LDS_BARRIER();
        if (lat) { const u32x4 hv = *(const LAS u32x4*)(lds + QI + srow * RS + sch * 16);
            if (DUMMY) { const u32x4 rv = *(const u32x4*)(HM + ((size_t)d * ML + R) * 512 + h * 128 + vh * 64 + sch * 8);
#define CMPH(a_, b_) do { const float x_ = (a_), y_ = (b_); if (fabsf(x_ - y_) > 0.05f * fmaxf(fabsf(x_), fabsf(y_)) + 0.02f) ++nbad; } while (0)
                CMPH(bf_lo(hv.x), bf_lo(rv.x)); CMPH(bf_hi(hv.x), bf_hi(rv.x)); CMPH(bf_lo(hv.y), bf_lo(rv.y)); CMPH(bf_hi(hv.y), bf_hi(rv.y));
                CMPH(bf_lo(hv.z), bf_lo(rv.z)); CMPH(bf_hi(hv.z), bf_hi(rv.z)); CMPH(bf_lo(hv.w), bf_lo(rv.w)); CMPH(bf_hi(hv.w), bf_hi(rv.w));
#undef CMPH
            } else *(u32x4*)(HM + ((size_t)d * ML + R) * 512 + h * 128 + vh * 64 + sch * 8) = hv; }
#pragma unroll
        for (int t = 0; t < 3; ++t) { cacc[t] = cnew[t]; const int vt = (t == 2) ? 4 : 2 * t + vg;
            if (t < 2 || wid < 4) { u32x2 o; o.x = pk2(cnew[t][0], cnew[t][1]); o.y = pk2(cnew[t][2], cnew[t][3]); *(LAS u32x2*)(lds + CI + (16 * vt + l15) * RS + (16 * it + 4 * kg) * 2) = o; } }
    }
#undef MLSTM_LOADS
    if (DUMMY) atomicAdd((unsigned*)(ws + WS_CTL) + 64, nbad);
    __syncthreads();
}

#ifndef MK_N_LAUNCHES
#define MK_N_LAUNCHES 1
#endif
constexpr int N_PHASES = 12;
constexpr int LDS_BYTES = 147456;
constexpr int RING_BYTES = 131072, MISC_OFF = RING_BYTES + 320;
constexpr int CW_BAR = 4096;

struct Args { const float* in[21]; float* out; unsigned char* ws; int ph_lo, ph_hi; };

__global__ void __launch_bounds__(NTHREADS, 2) hybrid_fwd(Args args) {
    extern __shared__ __attribute__((aligned(16))) unsigned char lds_raw[];
    LAS unsigned char* lds = (LAS unsigned char*)lds_raw;
    const int G = gridDim.x, bx = blockIdx.x;
    const int vcu = (G % 8 == 0) ? (bx % 8) * (G / 8) + bx / 8 : bx;
    typedef const __attribute__((address_space(4))) Args* ArgsP;
    ArgsP AP = (ArgsP)__builtin_amdgcn_kernarg_segment_ptr();
    asm volatile("" : "+s"(AP));
    unsigned char* ws = AP->ws;
#define I_x AP->in[0]
#define I_cvec AP->in[1]
#define I_ctx AP->in[2]
#define I_c_ctx AP->in[3]
#define I_mod_w AP->in[4]
#define I_mod_b AP->in[5]
#define I_pre_w AP->in[6]
#define I_post_w AP->in[7]
#define I_e_w_in AP->in[8]
#define I_e_sink AP->in[9]
#define I_e_conv_w AP->in[10]
#define I_e_w_out AP->in[11]
#define I_o_w_in AP->in[12]
#define I_o_qn AP->in[13]
#define I_o_kvn AP->in[14]
#define I_o_w_uq AP->in[15]
#define I_o_w_ukv AP->in[16]
#define I_o_ib AP->in[17]
#define I_o_fb AP->in[18]
#define I_o_hn AP->in[19]
#define I_o_w_out AP->in[20]
#define I_out AP->out
    float* MOD = (float*)(ws + WS_MOD);

    for (int u = threadIdx.x; u < (LDS_BYTES - RING_BYTES) / 4; u += NTHREADS) ((LAS unsigned*)(lds + RING_BYTES))[u] = 0u;
    __syncthreads();
    XcdBarrier bar; bar.bar = (unsigned*)(ws + WS_CTL) + CW_BAR; bar.x = 0; bar.st = nullptr;
    if (MK_N_LAUNCHES == 1) bar = xcd_barrier_post((unsigned*)(ws + WS_CTL) + CW_BAR, (volatile LAS unsigned*)(lds + MISC_OFF) + 8);
    const int lo = AP->ph_lo, hi = AP->ph_hi;
#ifndef PROBE_REP
#define PROBE_REP 0
#endif
#define NREP(k) ((((PROBE_REP) >> (k)) & 1) ? 2 : 1)
#ifndef PHASE_MASK
#define PHASE_MASK 0xFFF
#endif
#define IN(k) (((PHASE_MASK >> (k)) & 1) && lo <= (k) && (k) < hi)
#ifndef PROBE_DBLBAR
#define PROBE_DBLBAR 0
#endif
#ifndef PROBE_TS
#define PROBE_TS -1
#endif
#define STAMP(k) do { if (PROBE_TS >= 0 && bx == 0 && threadIdx.x == 0) ((unsigned long long*)(ws + WS_CTL + 512 * 1024))[(k)] = __builtin_amdgcn_s_memrealtime(); } while (0)
#define SEAM(k) do { if (MK_N_LAUNCHES == 1 && IN((k) + 1)) { xcd_barrier(bar); if (PROBE_DBLBAR) xcd_barrier(bar); } STAMP((k) + 1); } while (0)
    const int ngw = G * NWAVES;
#define PH_IDS const int tid = my_tid(), lane = tid & 63, wave = __builtin_amdgcn_readfirstlane(tid >> 6), gw = vcu * NWAVES + wave; (void)lane; (void)gw

    STAMP(0);
    if (IN(0)) { asm volatile("" : "+s"(AP)); PH_IDS;
        for (int rep_ = 0; rep_ < NREP(0); ++rep_) { if (rep_) __syncthreads();
        STAMP(20); p0_mod(lds, I_cvec, I_c_ctx, I_mod_w, I_mod_b, MOD, G);
        __syncthreads(); STAMP(21);
        LAS float* scr = (LAS float*)(lds + wave * 16384);
        constexpr int I0 = 16 * (E_N / 32), I1 = 16 * 32;
        { const bool split = (G == 256); const int cw0 = split ? (bx - 192) * NWAVES + wave : gw, ncw = split ? 64 * NWAVES : ngw;
          if (!split || bx >= 192) for (int it = cw0; it < I0 + I1; it += ncw) {
            if (it < I0) p0_transpose_item(I_e_w_in, 1024, E_N, (bf16_t*)(ws + WS_WEIN), 0, nullptr, scr, it, E_N / 32, lane);
            else p0_transpose_item(I_e_w_out, 1024, 1024, (bf16_t*)(ws + WS_WEOUT), 1, nullptr, scr, it - I0, 32, lane); } }
        STAMP(22);
        float* ropeA = (float*)(ws + WS_ROPEA); float* ropeC = (float*)(ws + WS_ROPEC);
        for (int idx = bx * NTHREADS + tid; idx < 2048 * 48; idx += G * NTHREADS) {
            const int pos = idx / 48, j = idx % 48; const float rowf = (float)(pos >> 6), colf = (float)(pos & 63);
            if (j < 32) { const int f = j & 15; const float inv = exp2f(-(float)f * (13.287712379549449f / 16.f)); const float ang = ((j < 16) ? rowf : colf) * inv;
                ropeA[pos * 64 + j] = __cosf(ang); ropeA[pos * 64 + 32 + j] = __sinf(ang); }
            else { const int jj = j - 32, f = jj & 7; const float inv = exp2f(-(float)f * (13.287712379549449f / 8.f)); const float ang = ((jj < 8) ? rowf : colf) * inv;
                ropeC[pos * 32 + jj] = __cosf(ang); ropeC[pos * 32 + 16 + jj] = __sinf(ang); }
        }
        STAMP(23);
        }
        SEAM(0); STAMP(24);
    }
    if (IN(1)) { asm volatile("" : "+s"(AP)); PH_IDS; for (int rep_ = 0; rep_ < NREP(1); ++rep_) { if (rep_) __syncthreads();
        { LAS float* scr = (LAS float*)(lds + wave * 16384);
          constexpr int I2 = 16 * (O_N / 32), I3 = 12 * 24, I4 = 4 * 32, I5 = 16 * 32;
          for (int it = gw; it < I2 + I3 + I4 + I5; it += ngw) { int r = it;
            if (r < I2) { p0_transpose_item(I_o_w_in, 1024, O_NSRC, (bf16_t*)(ws + WS_WOIN), 2, nullptr, scr, r, O_N / 32, lane); continue; } r -= I2;
            if (r < I3) { p0_transpose_item(I_o_w_uq, 768, 768, (bf16_t*)(ws + WS_WUQ), 3, I_o_qn, scr, r, 24, lane); continue; } r -= I3;
            if (r < I4) { p0_transpose_item(I_o_w_ukv, 256, 1024, (bf16_t*)(ws + WS_WUKV), 4, I_o_kvn, scr, r, 32, lane); continue; } r -= I4;
            p0_transpose_item(I_o_w_out, 1024, 1024, (bf16_t*)(ws + WS_WOOUT), 5, nullptr, scr, r, 32, lane); } }
        p1_prenorm(I_x, I_ctx, I_pre_w, MOD, (bf16_t*)(ws + WS_H), gw, ngw, lane); }
        SEAM(1); }
    if (IN(2)) { asm volatile("" : "+s"(AP)); PH_IDS;
        for (int rep_ = 0; rep_ < NREP(2); ++rep_) { if (rep_) __syncthreads();
        pg8::Gemm g{(const bf16_t*)(ws + WS_H), (const bf16_t*)(ws + WS_WEIN), MT, E_N, 1024}; pg8::RectOrder S; S.init(MT / 256, E_N / 256, 0, 0, 0, G, bx);
        EpiEin E{ws}; pg8::gemm_phase<EpiEin, pg8::RectOrder, true, true>(lds, g, S, E);
        }
        SEAM(2);
    }
    if (IN(3)) { asm volatile("" : "+s"(AP)); PH_IDS;
        for (int rep_ = 0; rep_ < NREP(3) + NREP(14) - 1; ++rep_) {
        for (int un = vcu; un < 1024; un += G) attn_unit<0>(lds, ws, nullptr, I_e_sink, un);
        for (int un = bx; un < 128; un += G) attn_unit<1>(lds, ws, nullptr, I_e_sink, un);
        }
        for (int rep_ = 0; rep_ < NREP(3) + NREP(15) - 1; ++rep_) { p3_conv(ws, I_e_conv_w, bx * NTHREADS + tid, G * NTHREADS);
        }
        SEAM(3);
    }
    if (IN(4)) { asm volatile("" : "+s"(AP)); PH_IDS;
        for (int rep_ = 0; rep_ < NREP(4); ++rep_) { if (rep_) __syncthreads();
        pg8::Gemm g{(const bf16_t*)(ws + WS_U), (const bf16_t*)(ws + WS_WEOUT), MT, 1024, 1024}; pg8::RectOrder S; S.init(MT / 256, 4, 0, 0, 0, G, bx);
        EpiY E{(bf16_t*)(ws + WS_Y), (float*)(ws + WS_SSQY0)}; pg8::gemm_phase<EpiY, pg8::RectOrder, true, true>(lds, g, S, E);
        }
        SEAM(4);
    }
    if (IN(5)) { asm volatile("" : "+s"(AP)); PH_IDS; for (int rep_ = 0; rep_ < NREP(5); ++rep_) { if (rep_) __syncthreads();
        p5_post_pre(I_x, I_ctx, I_post_w, I_pre_w + 1024, MOD, (const bf16_t*)(ws + WS_Y), (const float*)(ws + WS_SSQY0), (bf16_t*)(ws + WS_X1), (bf16_t*)(ws + WS_H), gw, ngw, lane); }
        SEAM(5); }
    if (IN(6)) { asm volatile("" : "+s"(AP)); PH_IDS;
        for (int rep_ = 0; rep_ < NREP(6); ++rep_) { if (rep_) __syncthreads();
        pg8::Gemm g{(const bf16_t*)(ws + WS_H), (const bf16_t*)(ws + WS_WOIN), MT, O_N, 1024}; pg8::RectOrder S; S.init(ML / 256, O_N / 256, ML / 256, MC / 256, 5, G, bx);
        EpiOin E{ws, (unsigned char*)I_out}; pg8::gemm_phase<EpiOin, pg8::RectOrder, true, true>(lds, g, S, E);
        }
        SEAM(6);
    }
    if (IN(7)) { asm volatile("" : "+s"(AP)); PH_IDS;
        for (int rep_ = 0; rep_ < NREP(7); ++rep_) { if (rep_) __syncthreads();
        { pg8::Gemm g{(const bf16_t*)(ws + WS_CQ), (const bf16_t*)(ws + WS_WUQ), ML, 768, 768}; pg8::RectOrder S; S.init(ML / 256, 3, 0, 0, 0, G, bx);
          EpiUq E{ws}; pg8::gemm_phase<EpiUq, pg8::RectOrder, true, true>(lds, g, S, E); }
        __syncthreads();
        { pg8::Gemm g{(const bf16_t*)(ws + WS_CKV), (const bf16_t*)(ws + WS_WUKV), MT, 1024, 256}; EpiUkv E{ws};
          if (G == 256) {
              pg8::ListOrder4 S; if (bx < 128) { S.start = bx; S.cnt = 1; } else if (bx < 192) { S.start = 128 + 3 * (bx - 128); S.cnt = 3; } else { S.start = 320 + 4 * (bx - 192); S.cnt = 4; }
              pg8::gemm_phase<EpiUkv, pg8::ListOrder4, true, true>(lds, g, S, E);
          } else { pg8::RectOrder S; S.init(MT / 256, 4, 0, 0, 0, G, G - 1 - bx); pg8::gemm_phase<EpiUkv, pg8::RectOrder, true, true>(lds, g, S, E); } }
        }
        SEAM(7);
    }
    if (IN(8)) { asm volatile("" : "+s"(AP)); PH_IDS;
        for (int rep_ = 0; rep_ < NREP(8) + NREP(12) - 1; ++rep_) { for (int ch = bx; ch < 256; ch += G) { STAMP(30); mlstm_chain_mfma<false>(lds, ws, (unsigned char*)I_out, I_o_ib, I_o_fb, ch); STAMP(31); }
        }
        for (int rep_ = 0; rep_ < NREP(8) + NREP(13) - 1; ++rep_) {
        for (int un = vcu; un < 1024; un += G) attn_unit<2>(lds, ws, (unsigned char*)I_out, nullptr, un);
        }
        STAMP(32); SEAM(8); STAMP(33);
    }
    if (IN(9)) { asm volatile("" : "+s"(AP)); PH_IDS; for (int rep_ = 0; rep_ < NREP(9); ++rep_) { if (rep_) __syncthreads();
        p9_readout(ws, (unsigned char*)I_out, I_o_hn, gw, ngw, lane); }
        SEAM(9); }
    if (IN(10)) { asm volatile("" : "+s"(AP)); PH_IDS;
        for (int rep_ = 0; rep_ < NREP(10); ++rep_) { if (rep_) __syncthreads();
        pg8::Gemm g{(const bf16_t*)(ws + WS_U), (const bf16_t*)(ws + WS_WOOUT), ML, 1024, 1024}; pg8::RectOrder S; S.init(ML / 256, 4, 0, 0, 0, G, bx);
        EpiY E{(bf16_t*)(ws + WS_Y), (float*)(ws + WS_SSQY1)}; pg8::gemm_phase<EpiY, pg8::RectOrder, true, true>(lds, g, S, E);
        }
        SEAM(10);
    }
    if (IN(11)) { asm volatile("" : "+s"(AP)); PH_IDS; p11_final(I_post_w + 1024, MOD, (const bf16_t*)(ws + WS_Y), (const float*)(ws + WS_SSQY1), (const bf16_t*)(ws + WS_X1), I_out, gw, ngw, lane);
        if (PROBE_TS >= 0 && bx == 0 && threadIdx.x == 0) { asm volatile("s_waitcnt vmcnt(0)" ::: "memory"); const unsigned long long* ts = (const unsigned long long*)(ws + WS_CTL + 512 * 1024);
            const unsigned long long t1 = (PROBE_TS == 11) ? __builtin_amdgcn_s_memrealtime() : ts[PROBE_TS + 1]; I_out[5 * 1024 * 7 + 3] += floorf((float)(t1 - ts[PROBE_TS]) * 0.01f * (1.f / 50.f)) * 50.f; } }
#undef IN
#undef SEAM
#undef I_x
#undef I_cvec
#undef I_ctx
#undef I_c_ctx
#undef I_mod_w
#undef I_mod_b
#undef I_pre_w
#undef I_post_w
#undef I_e_w_in
#undef I_e_sink
#undef I_e_conv_w
#undef I_e_w_out
#undef I_o_w_in
#undef I_o_qn
#undef I_o_kvn
#undef I_o_w_uq
#undef I_o_w_ukv
#undef I_o_ib
#undef I_o_fb
#undef I_o_hn
#undef I_o_w_out
#undef I_out
}

extern "C" void kernel_launch(void* const* d_in, const int* in_sizes, int n_in, void* d_out, int out_size, void* d_ws, size_t ws_size, hipStream_t stream) {
    static int grid = 0;
    if (grid == 0) {
        if (n_in != 21 || in_sizes[0] != ML * DM || out_size != ML * DM || ws_size < WS_END) { fprintf(stderr, "kernel_launch: unexpected shapes / workspace (n_in %d, ws %zu < %zu); nothing launched\n", n_in, ws_size, (size_t)WS_END); grid = -1; return; }
        int dev = 0, cus = 0, per_cu = 0;
        if (hipGetDevice(&dev) != hipSuccess || hipDeviceGetAttribute(&cus, hipDeviceAttributeMultiprocessorCount, dev) != hipSuccess) { grid = -1; return; }
        if (hipFuncSetAttribute((const void*)hybrid_fwd, hipFuncAttributeMaxDynamicSharedMemorySize, LDS_BYTES) != hipSuccess) { fprintf(stderr, "kernel_launch: hipFuncSetAttribute failed\n"); grid = -1; return; }
        if (hipOccupancyMaxActiveBlocksPerMultiprocessor(&per_cu, (const void*)hybrid_fwd, NTHREADS, LDS_BYTES) != hipSuccess || per_cu < 1) fprintf(stderr, "kernel_launch: note: occupancy query reports %d workgroups per CU\n", per_cu);
        (void)hipGetLastError();
        grid = cus;
    }
    if (grid < 0) return;
    if (hipMemsetAsync((char*)d_ws + WS_CTL, 0, CTL_ZERO_BYTES, stream) != hipSuccess) { fprintf(stderr, "kernel_launch: hipMemsetAsync failed\n"); return; }
    Args a{};
    for (int i = 0; i < 21; ++i) a.in[i] = (const float*)d_in[i];
    a.out = (float*)d_out; a.ws = (unsigned char*)d_ws;
    if (MK_N_LAUNCHES == 1) { a.ph_lo = 0; a.ph_hi = N_PHASES; hipLaunchKernelGGL(hybrid_fwd, dim3(grid), dim3(NTHREADS), LDS_BYTES, stream, a); }
    else for (int p = 0; p < N_PHASES; ++p) { a.ph_lo = p; a.ph_hi = p + 1; hipLaunchKernelGGL(hybrid_fwd, dim3(grid), dim3(NTHREADS), LDS_BYTES, stream, a); }
    const hipError_t le = hipPeekAtLastError();
    if (le != hipSuccess) fprintf(stderr, "kernel_launch: launch failed: %s\n", hipGetErrorName(le));
}
```

```cpp
#include <hip/hip_runtime.h>
#include <cstdio>
#include <cstdint>

#define LAS __attribute__((address_space(3)))
#define GAS __attribute__((address_space(1)))
typedef unsigned short bf16_t;
typedef short bf16x8 __attribute__((ext_vector_type(8)));
typedef short s16x4 __attribute__((ext_vector_type(4)));
typedef float f32x4 __attribute__((ext_vector_type(4)));
typedef float f32x16 __attribute__((ext_vector_type(16)));
typedef unsigned u32x4 __attribute__((ext_vector_type(4)));
typedef unsigned u32x2 __attribute__((ext_vector_type(2)));
typedef float f32x2_t __attribute__((ext_vector_type(2)));
typedef __bf16 bf16x2_t __attribute__((ext_vector_type(2)));

constexpr int NB = 16, SEQ = 2048, DM = 1024, CL = 256;
constexpr int ML = NB * SEQ, MC = NB * CL, MT = ML + MC;
constexpr float EPS = 1e-6f, LOG2E = 1.4426950408889634f;
constexpr int E_N = 3328, O_NSRC = 3632, O_N = 3840;
constexpr int NWAVES = 8, NTHREADS = 512;

__device__ __forceinline__ float bf_lo(unsigned w) { return __uint_as_float(w << 16); }
__device__ __forceinline__ float bf_hi(unsigned w) { return __uint_as_float(w & 0xffff0000u); }
__device__ __forceinline__ unsigned pk2(float lo, float hi) { f32x2_t v = {lo, hi}; bf16x2_t b = __builtin_convertvector(v, bf16x2_t); return __builtin_bit_cast(unsigned, b); }
__device__ __forceinline__ float silu_f(float x) { return x * __builtin_amdgcn_rcpf(1.f + __expf(-x)); }
__device__ __forceinline__ float sigmoid_f(float x) { return __builtin_amdgcn_rcpf(1.f + __expf(-x)); }
__device__ __forceinline__ float wave_sum(float v) {
#pragma unroll
    for (int o = 1; o < 64; o <<= 1) v += __shfl_xor(v, o);
    return v;
}
#define LDS_WAIT() asm volatile("s_waitcnt lgkmcnt(0)" ::: "memory")
#define VM_WAIT() asm volatile("s_waitcnt vmcnt(0)" ::: "memory")

__device__ __forceinline__ int my_tid() { int t = threadIdx.x; asm volatile("" : "+v"(t)); return t; }

namespace pg8 {
#define PG8_LAS __attribute__((address_space(3)))
typedef unsigned short bf16_t;
typedef short bf16x8 __attribute__((ext_vector_type(8)));
typedef float f32x4 __attribute__((ext_vector_type(4)));
typedef unsigned u32x4 __attribute__((ext_vector_type(4)));
constexpr int BM = 256, BK = 64, HALF = 128, HTB = HALF * BK * 2  , STAGE_BYTES = 8 * HTB, NXCD = 8, WGM = 8;

__host__ __device__ __forceinline__ int lds_byte(int r, int c) { const int st = (r >> 4) * 2 + (c >> 5), rr = r & 15, cc = c & 31, ob = rr * 64 + cc * 2; return st * 1024 + (ob ^ (((ob >> 9) & 1) << 5)); }
__host__ __device__ __forceinline__ void stage_rc(int b, int& R, int& C) { const int st = b / 1024, sb = b % 1024, swz = sb ^ (((sb >> 9) & 1) << 5); R = (st >> 1) * 16 + swz / 64; C = (st & 1) * 32 + (swz % 64) / 2; }
__host__ __device__ __forceinline__ int perm32(int rho) { const int n = rho >> 4, i = rho & 15; return 8 * (i >> 2) + 4 * n + (i & 3); }

struct Unit { int pm, pn; };
struct Gemm { const bf16_t* A; const bf16_t* Bt; int M, N, K; };

struct RectOrder {
    int nM0, nN0, n0, pm1, nM1, nN1, n1, G, c;
    __device__ __forceinline__ void init(int nM0_, int nN0_, int pm1_, int nM1_, int nN1_, int G_, int c_) { nM0 = nM0_; nN0 = nN0_; n0 = nM0_ * nN0_; pm1 = pm1_; nM1 = nM1_; nN1 = nN1_; n1 = nM1_ * nN1_; G = G_; c = c_; }
    __device__ __forceinline__ static void rect(int w, int nM, int nN, int& pm, int& pn) {
        const int nig = WGM * nN, gid = w / nig, fm = gid * WGM, gsz = (nM - fm) < WGM ? (nM - fm) : WGM;
        pm = fm + ((w % nig) % gsz); pn = (w % nig) / gsz;
    }
    __device__ __forceinline__ bool next(int i, Unit& u) const {
        const int nwg = n0 + n1; const long L = (long)i * G + c; if (L >= nwg) return false;
        int wgid = (int)L; { const int q = nwg / NXCD, r = nwg % NXCD, xcd = wgid % NXCD, off = wgid / NXCD; wgid = (xcd < r ? xcd * (q + 1) : r * (q + 1) + (xcd - r) * q) + off; }
        if (wgid < n0) rect(wgid, nM0, nN0, u.pm, u.pn); else { rect(wgid - n0, nM1, nN1, u.pm, u.pn); u.pm += pm1; }
        return true;
    }
    __device__ __forceinline__ void a_ready(const Unit&) const {}
    __device__ __forceinline__ void done(const Unit&) const {}
};

struct ListOrder4 {
    int start, cnt;
    __device__ __forceinline__ bool next(int i, Unit& u) const { if (i >= cnt) return false; const int L = start + i; u.pm = L >> 2; u.pn = L & 3; return true; }
    __device__ __forceinline__ void a_ready(const Unit&) const {}
    __device__ __forceinline__ void done(const Unit&) const {}
};

struct PanelOrder {
    int nM0, nN0, nN1, total, first, step, cnt;
    const unsigned* ready; unsigned need; unsigned* tmo;
    __device__ __forceinline__ bool next(int i, Unit& u) const {
        if (i >= cnt) return false; int L = first + step * i; if (L >= total) return false;
        const int n0 = nM0 * nN0; if (L < n0) { u.pm = L / nN0; u.pn = L - u.pm * nN0; } else { L -= n0; const int q = L / nN1; u.pm = nM0 + q; u.pn = L - q * nN1; }
        return true;
    }
    __device__ __forceinline__ void a_ready(const Unit& u) const {
        if (ready == nullptr) return;
        if (threadIdx.x < 64) {
            const unsigned long long t0 = __builtin_amdgcn_s_memrealtime(); unsigned polls = 0;
            while ((unsigned)__builtin_amdgcn_readfirstlane(__hip_atomic_load(ready + 64 * u.pm, __ATOMIC_RELAXED, __HIP_MEMORY_SCOPE_AGENT)) < need) {
                if ((++polls & 255u) == 0u && __builtin_amdgcn_readfirstlane(__hip_atomic_load(tmo, __ATOMIC_RELAXED, __HIP_MEMORY_SCOPE_AGENT)) != 0u) break;
                if (__builtin_amdgcn_s_memrealtime() - t0 > 2000000ull) { if (threadIdx.x == 0) __hip_atomic_store(tmo, 1u, __ATOMIC_RELAXED, __HIP_MEMORY_SCOPE_AGENT); break; }
                __builtin_amdgcn_s_sleep(2); }
            asm volatile("s_waitcnt vmcnt(0)" ::: "memory");
        }
        asm volatile("" ::: "memory"); __builtin_amdgcn_s_barrier(); asm volatile("" ::: "memory");
    }
    __device__ __forceinline__ void done(const Unit&) const {}
};

template <class Epi, class Sched, bool ALIGN_EPI = false, bool SP2 = false>
__device__ __forceinline__ void gemm_phase(PG8_LAS unsigned char* lds, const Gemm g, const Sched& S, const Epi& E) {
    const int tid = my_tid(), wid = __builtin_amdgcn_readfirstlane(tid >> 6), lane = tid & 63, wr = wid >> 2, wc = wid & 3, fr = lane & 15, fq = lane >> 4;
    const int K = g.K, nt = K / BK;
    unsigned voffA[2], voffB[2];
#pragma unroll
    for (int i = 0; i < 2; ++i) { int R, C; stage_rc(tid * 16 + i * 8192, R, C); const int Rb = Epi::PERM ? ((R & ~31) + perm32(R & 31)) : R;
        voffA[i] = (unsigned)(R * K + C) * 2u; voffB[i] = (unsigned)(Rb * K + C) * 2u; }
    const size_t kstep = (size_t)(BK * 2);
    const size_t hstep = (size_t)HALF * K * 2;
    const size_t tstep = 2 * hstep;
    const unsigned ldsw = (unsigned)wid * 1024u;
    const int aoff = lds_byte(wr * 64 + fr, fq * 8), boff = lds_byte(wc * 32 + fr, fq * 8);
#define PG8_SA(b, h) (((b) * 2 + (h)) * HTB)
#define PG8_SB(b, h) ((4 + (b) * 2 + (h)) * HTB)
#define PG8_STAGE(bufoff, gbase, voff) do { _Pragma("unroll") for (int _i = 0; _i < 2; ++_i) \
        __builtin_amdgcn_global_load_lds((const unsigned*)((const char*)(gbase) + (voff)[_i]), (PG8_LAS unsigned*)(lds + (bufoff) + ldsw + _i * 8192), 16, 0, 0); } while (0)
#define PG8_LDA(dst, b, h) do { _Pragma("unroll") for (int m = 0; m < 4; ++m) _Pragma("unroll") for (int k = 0; k < 2; ++k) dst[m][k] = *(const PG8_LAS bf16x8*)(lds + PG8_SA(b, h) + aoff + m * 2048 + k * 1024); } while (0)
#define PG8_LDB(dst, b, h) do { _Pragma("unroll") for (int n = 0; n < 2; ++n) _Pragma("unroll") for (int k = 0; k < 2; ++k) dst[n][k] = *(const PG8_LAS bf16x8*)(lds + PG8_SB(b, h) + boff + n * 2048 + k * 1024); } while (0)
#define PG8_MMA(ai, bj, At, Bt) do { __builtin_amdgcn_s_setprio(1); _Pragma("unroll") for (int m = 0; m < 4; ++m) _Pragma("unroll") for (int n = 0; n < 2; ++n) _Pragma("unroll") for (int k = 0; k < 2; ++k) \
        acc[ai][bj][m][n] = __builtin_amdgcn_mfma_f32_16x16x32_bf16(Bt[n][k], At[m][k], acc[ai][bj][m][n], 0, 0, 0); __builtin_amdgcn_s_setprio(0); } while (0)
#define PG8_WAIT_V(n) asm volatile("s_waitcnt vmcnt(" #n ")" ::: "memory")
#define PG8_WAIT_L(n) asm volatile("s_waitcnt lgkmcnt(" #n ")" ::: "memory")
#define PG8_BAR __builtin_amdgcn_s_barrier()
#define PG8_SCHED __builtin_amdgcn_sched_barrier(0)
    Unit cur, nxt; int ui = 0;
    if (!S.next(0, cur)) return;
    f32x4 acc[2][2][4][2];
#pragma unroll
    for (int a = 0; a < 2; ++a)
#pragma unroll
        for (int b = 0; b < 2; ++b)
#pragma unroll
            for (int m = 0; m < 4; ++m)
#pragma unroll
                for (int n = 0; n < 2; ++n) acc[a][b][m][n] = (f32x4){0.f, 0.f, 0.f, 0.f};
    bf16x8 At[4][2], B0[2][2], B1[2][2];
    const char* cA = (const char*)g.A + (size_t)cur.pm * tstep; const char* cB = (const char*)g.Bt + (size_t)cur.pn * tstep;
    S.a_ready(cur);
    if constexpr (SP2) {
        PG8_STAGE(PG8_SB(0, 0), cB, voffB); PG8_STAGE(PG8_SB(0, 1), cB + hstep, voffB); PG8_STAGE(PG8_SA(0, 0), cA, voffA); PG8_STAGE(PG8_SA(0, 1), cA + hstep, voffA);
        if (wr == 1) PG8_BAR;
        PG8_WAIT_V(2); PG8_BAR;
        PG8_STAGE(PG8_SB(1, 0), cB + kstep, voffB); PG8_STAGE(PG8_SA(1, 0), cA + kstep, voffA); PG8_STAGE(PG8_SB(1, 1), cB + hstep + kstep, voffB);
        PG8_WAIT_V(6); PG8_BAR;
    } else {
        PG8_STAGE(PG8_SB(0, 0), cB, voffB); PG8_STAGE(PG8_SA(0, 0), cA, voffA); PG8_STAGE(PG8_SB(0, 1), cB + hstep, voffB); PG8_STAGE(PG8_SA(0, 1), cA + hstep, voffA);
        if (wr == 1) PG8_BAR;
        PG8_WAIT_V(4); PG8_BAR;
        PG8_STAGE(PG8_SB(1, 0), cB + kstep, voffB); PG8_STAGE(PG8_SA(1, 0), cA + kstep, voffA); PG8_STAGE(PG8_SB(1, 1), cB + hstep + kstep, voffB);
        PG8_WAIT_V(6); PG8_BAR;
    }
    for (;;) {
        const bool has_next = S.next(ui + 1, nxt);
        const char* nA = has_next ? (const char*)g.A + (size_t)nxt.pm * tstep : cA; const char* nB = has_next ? (const char*)g.Bt + (size_t)nxt.pn * tstep : cB;
        for (int t = 0; t < nt; t += 2) {
            const bool last = (t == nt - 2);
            const char* a1 = cA + (size_t)(t + 1) * kstep;
            const char* a2 = last ? nA : cA + (size_t)(t + 2) * kstep; const char* b2 = last ? nB : cB + (size_t)(t + 2) * kstep;
            const char* a3 = a2 + kstep; const char* b3 = b2 + kstep;
            if (last && has_next) S.a_ready(nxt);
            if constexpr (SP2) {
            PG8_LDB(B0, 0, 0); PG8_LDB(B1, 0, 1); PG8_SCHED; PG8_LDA(At, 0, 0); PG8_STAGE(PG8_SA(1, 1), a1 + hstep, voffA);
            PG8_WAIT_V(8); PG8_WAIT_L(0); PG8_BAR; PG8_MMA(0, 0, At, B0); PG8_MMA(0, 1, At, B1); PG8_BAR; PG8_SCHED;
            PG8_LDA(At, 0, 1); PG8_STAGE(PG8_SB(0, 0), b2, voffB); PG8_STAGE(PG8_SB(0, 1), b2 + hstep, voffB); PG8_STAGE(PG8_SA(0, 0), a2, voffA);
            PG8_WAIT_V(8); PG8_WAIT_L(0); PG8_BAR; PG8_MMA(1, 0, At, B0); PG8_MMA(1, 1, At, B1); PG8_BAR; PG8_SCHED;
            PG8_LDB(B0, 1, 0); PG8_LDB(B1, 1, 1); PG8_SCHED; PG8_LDA(At, 1, 0); PG8_STAGE(PG8_SA(0, 1), a2 + hstep, voffA);
            PG8_WAIT_V(8); PG8_WAIT_L(0); PG8_BAR; PG8_MMA(0, 0, At, B0); PG8_MMA(0, 1, At, B1); PG8_BAR; PG8_SCHED;
            PG8_LDA(At, 1, 1); PG8_STAGE(PG8_SB(1, 0), b3, voffB); PG8_STAGE(PG8_SB(1, 1), b3 + hstep, voffB); PG8_STAGE(PG8_SA(1, 0), a3, voffA);
            PG8_WAIT_V(8); PG8_WAIT_L(0); PG8_BAR; PG8_MMA(1, 0, At, B0); PG8_MMA(1, 1, At, B1); PG8_BAR; PG8_SCHED;
            } else {
            PG8_LDB(B0, 0, 0); PG8_SCHED; PG8_LDA(At, 0, 0); PG8_STAGE(PG8_SA(1, 1), a1 + hstep, voffA);
            PG8_WAIT_L(8); PG8_BAR; PG8_WAIT_L(0); PG8_MMA(0, 0, At, B0); PG8_BAR; PG8_SCHED;
            PG8_LDB(B1, 0, 1); PG8_STAGE(PG8_SB(0, 0), b2, voffB);
            PG8_BAR; PG8_WAIT_L(0); PG8_MMA(0, 1, At, B1); PG8_BAR;
            PG8_LDA(At, 0, 1); PG8_STAGE(PG8_SA(0, 0), a2, voffA);
            PG8_BAR; PG8_WAIT_L(0); PG8_MMA(1, 0, At, B0); PG8_BAR; PG8_SCHED;
            PG8_STAGE(PG8_SB(0, 1), b2 + hstep, voffB);
            PG8_WAIT_V(6); PG8_BAR; PG8_MMA(1, 1, At, B1); PG8_BAR;
            PG8_LDB(B0, 1, 0); PG8_SCHED; PG8_LDA(At, 1, 0); PG8_STAGE(PG8_SA(0, 1), a2 + hstep, voffA);
            PG8_WAIT_L(8); PG8_BAR; PG8_WAIT_L(0); PG8_MMA(0, 0, At, B0); PG8_BAR; PG8_SCHED;
            PG8_LDB(B1, 1, 1); PG8_STAGE(PG8_SB(1, 0), b3, voffB);
            PG8_BAR; PG8_WAIT_L(0); PG8_MMA(0, 1, At, B1); PG8_BAR;
            PG8_LDA(At, 1, 1); PG8_STAGE(PG8_SA(1, 0), a3, voffA);
            PG8_BAR; PG8_WAIT_L(0); PG8_MMA(1, 0, At, B0); PG8_BAR; PG8_SCHED;
            PG8_STAGE(PG8_SB(1, 1), b3 + hstep, voffB);
            PG8_WAIT_V(6); PG8_BAR; PG8_MMA(1, 1, At, B1); PG8_BAR;
            }
        }
        if constexpr (ALIGN_EPI) { if (wr == 0) PG8_BAR; }
        if constexpr (!Epi::AFTER_DRAIN) { E(acc, cur, wr, wc, fr, fq); S.done(cur); }
        if (!has_next) break;
#pragma unroll
        for (int a = 0; a < 2; ++a)
#pragma unroll
            for (int b = 0; b < 2; ++b)
#pragma unroll
                for (int m = 0; m < 4; ++m)
#pragma unroll
                    for (int n = 0; n < 2; ++n) acc[a][b][m][n] = (f32x4){0.f, 0.f, 0.f, 0.f};
        cur = nxt; cA = nA; cB = nB; ++ui;
        if constexpr (ALIGN_EPI) { if (wr == 1) PG8_BAR; }
    }
    PG8_WAIT_V(0);
    if constexpr (!ALIGN_EPI) { if (wr == 0) PG8_BAR; }
    PG8_BAR;
    if constexpr (Epi::AFTER_DRAIN) { E.fused(acc, cur, wr, wc, fr, fq, lds, wid, lane); S.done(cur); }
#undef PG8_SA
#undef PG8_SB
#undef PG8_STAGE
#undef PG8_LDA
#undef PG8_LDB
#undef PG8_MMA
#undef PG8_WAIT_V
#undef PG8_WAIT_L
#undef PG8_BAR
#undef PG8_SCHED
}
}

constexpr size_t MiB = 1u << 20;
constexpr size_t WS_CTL = 0, CTL_ZERO_BYTES = 128 * 1024;
constexpr int CW_PANEL = 8192, PANEL_BANK = 144 * 64;
constexpr size_t WS_MOD = 1 * MiB;
constexpr size_t WS_ROPEA = 2 * MiB;
constexpr size_t WS_ROPEC = 2 * MiB + 512 * 1024;
constexpr size_t WS_WEIN = 3 * MiB, WS_WEOUT = 10 * MiB, WS_WOIN = 12 * MiB, WS_WUQ = 20 * MiB, WS_WUKV = 21 * MiB + 512 * 1024, WS_WOOUT = 22 * MiB;
constexpr size_t WS_H = 24 * MiB;
constexpr size_t WS_U = 96 * MiB;
constexpr size_t WS_Y = 168 * MiB;
constexpr size_t WS_R = 240 * MiB;
constexpr size_t WS_KVE = WS_R  , WS_QE = WS_R + 18 * MiB, WS_PE = WS_R + 54 * MiB, WS_GE = WS_R + 90 * MiB, WS_ZA = WS_R + 126 * MiB, WS_SSQY0 = WS_R + 241 * MiB  ;
constexpr size_t WS_CKV = WS_R, WS_CQ = WS_R + 18 * MiB, WS_HM = WS_R  , WS_MK = WS_R + 66 * MiB, WS_MV = WS_R + 84 * MiB, WS_KR = WS_R + 120 * MiB, WS_GATES = WS_R + 123 * MiB,
                 WS_SSQCKV = WS_R + 126 * MiB, WS_SSQCQ = WS_R + 127 * MiB, WS_X1 = WS_R + 129 * MiB  , WS_SSQY1 = WS_R + 241 * MiB;
constexpr size_t AUX_MQ = 0, AUX_MO = 16 * MiB, AUX_ZO = 48 * MiB;
constexpr size_t WS_KNV = WS_H  , WS_QO = WS_Y;
constexpr size_t WS_END = WS_R + 244 * MiB;
static_assert(WS_ZA + (size_t)MT * 512 * 2 <= WS_R + 162 * MiB && WS_X1 + (size_t)ML * 1024 * 2 <= WS_R + 241 * MiB && WS_HM + (size_t)2 * ML * 512 * 2 <= WS_MK && WS_SSQY1 + (size_t)MT * 16 * 4 <= WS_END, "ws map");

__device__ __forceinline__ void st8(bf16_t* p, f32x4 a, f32x4 b) { u32x4 w; w.x = pk2(a[0], a[1]); w.y = pk2(a[2], a[3]); w.z = pk2(b[0], b[1]); w.w = pk2(b[2], b[3]); *(u32x4*)p = w; }
__device__ __forceinline__ bf16_t f2bf(float v) { return (bf16_t)(pk2(v, 0.f) & 0xffffu); }
__device__ __forceinline__ void rope8(f32x4& a, f32x4& b, const float* cosp, const float* sinp) {
    const f32x4 cs = *(const f32x4*)cosp, sn = *(const f32x4*)sinp;
    const float a0 = a[0] * cs[0] - a[1] * sn[0], a1 = a[0] * sn[0] + a[1] * cs[0], a2 = a[2] * cs[1] - a[3] * sn[1], a3 = a[2] * sn[1] + a[3] * cs[1];
    const float b0 = b[0] * cs[2] - b[1] * sn[2], b1 = b[0] * sn[2] + b[1] * cs[2], b2 = b[2] * cs[3] - b[3] * sn[3], b3 = b[2] * sn[3] + b[3] * cs[3];
    a = (f32x4){a0, a1, a2, a3}; b = (f32x4){b0, b1, b2, b3};
}
__device__ __forceinline__ f32x4 silu4(f32x4 v) { return (f32x4){silu_f(v[0]), silu_f(v[1]), silu_f(v[2]), silu_f(v[3])}; }
__device__ __forceinline__ f32x4 sigm4(f32x4 v) { return (f32x4){sigmoid_f(v[0]), sigmoid_f(v[1]), sigmoid_f(v[2]), sigmoid_f(v[3])}; }
__device__ __forceinline__ float sq4(f32x4 v) { return (v[0] * v[0] + v[1] * v[1]) + (v[2] * v[2] + v[3] * v[3]); }

struct EpiEin {
    static constexpr bool PERM = true, AFTER_DRAIN = false;
    unsigned char* ws;
    __device__ __forceinline__ void operator()(const f32x4 (&acc)[2][2][4][2], const pg8::Unit& u, int wr, int wc, int fr, int fq) const {
        const int pn = u.pn, rbase = u.pm * 256 + wr * 64 + fr, cw = wc * 32 + 8 * fq;
        const float* ropeA = (const float*)(ws + WS_ROPEA);
#pragma unroll
        for (int ai = 0; ai < 2; ++ai)
#pragma unroll
            for (int m = 0; m < 4; ++m) {
                asm volatile("" ::: "memory"); const int R = rbase + ai * 128 + m * 16; const bool lat = R < ML; const int pos = R & 2047;
                if (pn == 0) {
                    f32x4 a = acc[ai][0][m][0], b = acc[ai][0][m][1];
                    if (lat) { const int i0 = (cw & 63) >> 1; rope8(a, b, ropeA + pos * 64 + i0, ropeA + pos * 64 + 32 + i0); }
                    st8((bf16_t*)(ws + WS_KVE) + (size_t)R * 256 + cw, a, b);
                    st8((bf16_t*)(ws + WS_KVE) + (size_t)R * 256 + 128 + cw, acc[ai][1][m][0], acc[ai][1][m][1]);
                } else if (pn <= 2) {
#pragma unroll
                    for (int bj = 0; bj < 2; ++bj) {
                        f32x4 a = acc[ai][bj][m][0], b = acc[ai][bj][m][1];
                        if (lat) { const int i0 = (cw & 63) >> 1; rope8(a, b, ropeA + pos * 64 + i0, ropeA + pos * 64 + 32 + i0); }
                        const float sc = 0.125f * LOG2E; a = a * sc; b = b * sc;
                        st8((bf16_t*)(ws + WS_QE) + (size_t)R * 512 + (pn - 1) * 256 + bj * 128 + cw, a, b);
                    }
                } else if (pn <= 6) {
                    st8((bf16_t*)(ws + WS_PE) + (size_t)R * 512 + (pn - 3) * 128 + cw, acc[ai][0][m][0] * acc[ai][1][m][0], acc[ai][0][m][1] * acc[ai][1][m][1]);
                } else if (pn <= 10) {
                    st8((bf16_t*)(ws + WS_GE) + (size_t)R * 512 + (pn - 7) * 128 + cw, acc[ai][0][m][0] * silu4(acc[ai][1][m][0]), acc[ai][0][m][1] * silu4(acc[ai][1][m][1]));
                } else {
#pragma unroll
                    for (int bj = 0; bj < 2; ++bj)
                        st8((bf16_t*)(ws + WS_ZA) + (size_t)R * 512 + (pn - 11) * 256 + bj * 128 + cw, silu4(acc[ai][bj][m][0]), silu4(acc[ai][bj][m][1]));
                }
            }
    }
};

struct EpiY {
    static constexpr bool PERM = true, AFTER_DRAIN = false;
    bf16_t* Y; float* SSQ;
    __device__ __forceinline__ void operator()(const f32x4 (&acc)[2][2][4][2], const pg8::Unit& u, int wr, int wc, int fr, int fq) const {
        const int pn = u.pn, rbase = u.pm * 256 + wr * 64 + fr, cw = wc * 32 + 8 * fq;
#pragma unroll
        for (int ai = 0; ai < 2; ++ai)
#pragma unroll
            for (int m = 0; m < 4; ++m) {
                asm volatile("" ::: "memory"); const int R = rbase + ai * 128 + m * 16; float s = 0.f;
#pragma unroll
                for (int bj = 0; bj < 2; ++bj) { st8(Y + (size_t)R * 1024 + pn * 256 + bj * 128 + cw, acc[ai][bj][m][0], acc[ai][bj][m][1]); s += sq4(acc[ai][bj][m][0]) + sq4(acc[ai][bj][m][1]); }
                s += __shfl_xor(s, 16); s += __shfl_xor(s, 32);
                if (fq == 0) SSQ[(size_t)R * 16 + pn * 4 + wc] = s;
            }
    }
};

struct EpiOin {
    static constexpr bool PERM = true, AFTER_DRAIN = false;
    unsigned char* ws; unsigned char* aux;
    __device__ __forceinline__ void operator()(const f32x4 (&acc)[2][2][4][2], const pg8::Unit& u, int wr, int wc, int fr, int fq) const {
        const int pn = u.pn, rbase = u.pm * 256 + wr * 64 + fr, cw = wc * 32 + 8 * fq;
        const float* ropeC = (const float*)(ws + WS_ROPEC);
#pragma unroll
        for (int ai = 0; ai < 2; ++ai)
#pragma unroll
            for (int m = 0; m < 4; ++m) {
                asm volatile("" ::: "memory"); const int R = rbase + ai * 128 + m * 16; const bool lat = R < ML; const int pos = R & 2047;
                if (pn == 0 || (pn >= 5 && pn <= 7)) {
                    float s = 0.f;
                    bf16_t* dst = (pn == 0) ? (bf16_t*)(ws + WS_CKV) + (size_t)R * 256 : (bf16_t*)(ws + WS_CQ) + (size_t)R * 768 + (pn - 5) * 256;
#pragma unroll
                    for (int bj = 0; bj < 2; ++bj) { st8(dst + bj * 128 + cw, acc[ai][bj][m][0], acc[ai][bj][m][1]); s += sq4(acc[ai][bj][m][0]) + sq4(acc[ai][bj][m][1]); }
                    s += __shfl_xor(s, 16); s += __shfl_xor(s, 32);
                    if (fq == 0) { if (pn == 0) ((float*)(ws + WS_SSQCKV))[(size_t)R * 4 + wc] = s; else ((float*)(ws + WS_SSQCQ))[(size_t)R * 12 + (pn - 5) * 4 + wc] = s; }
                } else if (pn == 4) {
                    if (wc == 0) {
                        f32x4 a = acc[ai][0][m][0], b = acc[ai][0][m][1];
                        if (lat) { const int i0 = cw >> 1; rope8(a, b, ropeC + pos * 32 + i0, ropeC + pos * 32 + 16 + i0); }
                        st8((bf16_t*)(ws + WS_KR) + (size_t)R * 32 + cw, a, b);
                    } else if (wc == 1 && fq < 2) {
                        float* g = (float*)(ws + WS_GATES) + (size_t)R * 16 + 8 * fq;
                        *(f32x4*)g = acc[ai][0][m][0]; *(f32x4*)(g + 4) = acc[ai][0][m][1];
                    }
                } else {
#pragma unroll
                    for (int bj = 0; bj < 2; ++bj) {
                        const f32x4 a = acc[ai][bj][m][0], b = acc[ai][bj][m][1]; const int col = bj * 128 + cw;
                        if (pn == 1) st8((bf16_t*)(ws + WS_MK) + (size_t)R * 256 + col, a * 0.125f, b * 0.125f);
                        else if (pn <= 3) st8((bf16_t*)(ws + WS_MV) + (size_t)R * 512 + (pn - 2) * 256 + col, a, b);
                        else if (pn == 8) st8((bf16_t*)(aux + AUX_MQ) + (size_t)R * 256 + col, a, b);
                        else if (pn >= 13) st8((bf16_t*)(aux + AUX_ZO) + (size_t)R * 512 + (pn - 13) * 256 + col, silu4(a), silu4(b));
                        else if (bj == 0) st8((bf16_t*)(aux + AUX_MO) + (size_t)R * 512 + (pn - 9) * 128 + cw, sigm4(a) * silu4(acc[ai][1][m][0]), sigm4(b) * silu4(acc[ai][1][m][1]));
                    }
                }
            }
    }
};

struct EpiUkv {
    static constexpr bool PERM = true, AFTER_DRAIN = false;
    unsigned char* ws;
    __device__ __forceinline__ void operator()(const f32x4 (&acc)[2][2][4][2], const pg8::Unit& u, int wr, int wc, int fr, int fq) const {
        const int pn = u.pn, rbase = u.pm * 256 + wr * 64 + fr, cw = wc * 32 + 8 * fq;
#pragma unroll
        for (int ai = 0; ai < 2; ++ai)
#pragma unroll
            for (int m = 0; m < 4; ++m) {
                asm volatile("" ::: "memory"); const int R = rbase + ai * 128 + m * 16;
                const f32x4 sp = *(const f32x4*)((const float*)(ws + WS_SSQCKV) + (size_t)R * 4);
                const float rstd = rsqrtf(((sp[0] + sp[1]) + (sp[2] + sp[3])) * (1.f / 256.f) + EPS);
                int b, pos; if (R < ML) { b = R >> 11; pos = 256 + (R & 2047); } else { const int rc = R - ML; b = rc >> 8; pos = rc & 255; }
#pragma unroll
                for (int bj = 0; bj < 2; ++bj) {
                    const int head = pn * 2 + bj;
                    st8((bf16_t*)(ws + WS_KNV) + ((size_t)(b * 8 + head) * 2304 + pos) * 128 + cw, acc[ai][bj][m][0] * rstd, acc[ai][bj][m][1] * rstd);
                }
            }
    }
};

struct EpiUq {
    static constexpr bool PERM = true, AFTER_DRAIN = false;
    unsigned char* ws;
    __device__ __forceinline__ void operator()(const f32x4 (&acc)[2][2][4][2], const pg8::Unit& u, int wr, int wc, int fr, int fq) const {
        const int pn = u.pn, rbase = u.pm * 256 + wr * 64 + fr, cw = wc * 32 + 8 * fq;
        const float* ropeC = (const float*)(ws + WS_ROPEC);
#pragma unroll
        for (int ai = 0; ai < 2; ++ai)
#pragma unroll
            for (int m = 0; m < 4; ++m) {
                asm volatile("" ::: "memory"); const int R = rbase + ai * 128 + m * 16, pos = R & 2047;
                const float* sp = (const float*)(ws + WS_SSQCQ) + (size_t)R * 12;
                const f32x4 s0 = *(const f32x4*)sp, s1 = *(const f32x4*)(sp + 4), s2 = *(const f32x4*)(sp + 8);
                const float ss = (((s0[0] + s0[1]) + (s0[2] + s0[3])) + ((s1[0] + s1[1]) + (s1[2] + s1[3]))) + ((s2[0] + s2[1]) + (s2[2] + s2[3]));
                const float sc = rsqrtf(ss * (1.f / 768.f) + EPS) * (0.10206207261596575f * LOG2E);
#pragma unroll
                for (int bj = 0; bj < 2; ++bj) {
                    const int c = pn * 256 + bj * 128 + cw, head = c / 96, dd = c - head * 96;
                    f32x4 a = acc[ai][bj][m][0], b = acc[ai][bj][m][1];
                    if (dd >= 64) { const int i0 = (dd - 64) >> 1; rope8(a, b, ropeC + pos * 32 + i0, ropeC + pos * 32 + 16 + i0); }
                    st8((bf16_t*)(ws + WS_QO) + (size_t)R * 768 + c, a * sc, b * sc);
                }
            }
    }
};

#define RLX_AGENT __ATOMIC_RELAXED, __HIP_MEMORY_SCOPE_AGENT
#define XB_TMO      128
#define XB_XCNT(j)  (256  + 64 * (j))
#define XB_XSUB(j)  (1280 + 64 * (j))
#define XB_XGEN(j)  (2304 + 64 * (j))
#define XB_TOP      3328
#define XB_TOPGEN   3392
#define XCD_BAR_WORDS 3456
#define XB_SPIN_CAP (1u << 18)

__device__ __forceinline__ unsigned xb_ld(unsigned* p)              { return __hip_atomic_load(p, __ATOMIC_RELAXED, __HIP_MEMORY_SCOPE_AGENT); }
__device__ __forceinline__ unsigned xb_add(unsigned* p, unsigned v) { return __hip_atomic_fetch_add(p, v, __ATOMIC_RELAXED, __HIP_MEMORY_SCOPE_AGENT); }
__device__ __forceinline__ unsigned xb_xcc_id() { return (unsigned)__builtin_amdgcn_s_getreg((3 << 11) | 20) & 0xFu; }
#define XB_SPIN(cond, bar) do { unsigned _sp = 0; while (cond) { __builtin_amdgcn_s_sleep(1); \
    if ((++_sp & 255u) == 0u) { if (xb_ld(&(bar)[XB_TMO])) break; if (_sp > XB_SPIN_CAP) { atomicAdd(&(bar)[XB_TMO], 1u); break; } } } } while (0)

struct XcdBarrier {
    unsigned* bar; unsigned x;
    volatile LAS unsigned* st;
};

__device__ __forceinline__ XcdBarrier xcd_barrier_post(unsigned* bar, volatile LAS unsigned* st) {
    XcdBarrier b; b.bar = bar; b.x = xb_xcc_id(); b.st = st;
    if (threadIdx.x == 0) (void)xb_add(&bar[XB_XCNT(b.x)], 1u);
    return b;
}
__device__ __forceinline__ void xcd_barrier_complete(unsigned* bar, unsigned x, unsigned& nloc, unsigned& nx) {
    const unsigned G = gridDim.x * gridDim.y * gridDim.z;
    unsigned sum, cnt, mine, sp = 0u;
    for (;;) {
        sum = 0u; cnt = 0u; mine = 0u;
#pragma unroll
        for (unsigned j = 0; j < 16; ++j) { const unsigned c = xb_ld(&bar[XB_XCNT(j)]); sum += c; cnt += (c > 0u) ? 1u : 0u; mine = (j == x) ? c : mine; }
        if (sum == G) break;
        __builtin_amdgcn_s_sleep(1);
        if ((++sp & 255u) == 0u) { if (xb_ld(&bar[XB_TMO])) break; if (sp > XB_SPIN_CAP) { atomicAdd(&bar[XB_TMO], 1u); break; } }
    }
    nloc = mine > 0u ? mine : 1u; nx = cnt > 0u ? cnt : 1u;
}

__device__ __forceinline__ void xcd_barrier(const XcdBarrier& b) {
    asm volatile("s_waitcnt vmcnt(0)" ::: "memory");
    __syncthreads();
    if (threadIdx.x == 0) {
        unsigned* bar = b.bar;
        __builtin_amdgcn_s_waitcnt(0);
        unsigned nloc = b.st[0], nx = b.st[1];
        if (nloc == 0u) { xcd_barrier_complete(bar, b.x, nloc, nx); b.st[0] = nloc; b.st[1] = nx; }
        const unsigned old = xb_add(&bar[XB_XSUB(b.x)], 1u);
        const unsigned gen = old / nloc;
        if (old + 1u == (gen + 1u) * nloc) {
            __builtin_amdgcn_fence(__ATOMIC_RELEASE, "agent");
            asm volatile("s_waitcnt vmcnt(0)" ::: "memory");
            (void)xb_add(&bar[XB_TOP], 1u);
        }
        const unsigned target = (gen + 1u) * nx;
        XB_SPIN((int)(xb_ld(&bar[XB_TOP]) - target) < 0, bar);
        __builtin_amdgcn_fence(__ATOMIC_ACQUIRE, "agent");
        asm volatile("s_waitcnt vmcnt(0)" ::: "memory");
    }
    __syncthreads();
}

__device__ __forceinline__ int crow(int r, int hi) { return (r & 3) + 8 * (r >> 2) + 4 * hi; }
typedef short v4i16_t __attribute__((ext_vector_type(4)));
__device__ __forceinline__ s16x4 vtr(const LAS unsigned char* p) { return __builtin_bit_cast(s16x4, __builtin_amdgcn_ds_read_tr16_b64_v4i16((LAS v4i16_t*)p)); }

template <int MODE>
__device__ __forceinline__ void attn_unit(LAS unsigned char* lds, unsigned char* ws, unsigned char* aux, const float* sink, int unit) {
    constexpr int DQK = (MODE == 2) ? 96 : 64, KST = DQK / 16, KS = DQK * 2 + 16, VS = 192, KBUF = 64 * KS, VBUF = 64 * VS;
    const int tid = my_tid(), lane = tid & 63, wid = __builtin_amdgcn_readfirstlane(tid >> 6), r32 = lane & 31, hi = lane >> 5;
    int b, head, hkv = 0, n = 0, Rq0, qpos0 = 0, nt, jlo = 0;
    const bf16_t* Qp; int qstride;
    if (MODE == 0) {
        const int hp = unit & 1; n = (unit >> 1) & 15; hkv = (unit >> 5) & 1; b = unit >> 6;
        head = hkv * 4 + hp * 2 + (wid >> 2); qpos0 = 128 * n + 32 * (wid & 3); Rq0 = b * 2048 + qpos0;
        Qp = (const bf16_t*)(ws + WS_QE) + (size_t)Rq0 * 512 + head * 64; qstride = 512;
        jlo = (n == 0) ? 2 : 0; const int jhi = (n == 15) ? 4 : 6; nt = 4 + (jhi - jlo);
    } else if (MODE == 1) {
        const int qh = unit & 1, hp = (unit >> 1) & 1; hkv = (unit >> 2) & 1; b = unit >> 3;
        head = hkv * 4 + hp * 2 + (wid >> 2); Rq0 = ML + b * 256 + 128 * qh + 32 * (wid & 3);
        Qp = (const bf16_t*)(ws + WS_QE) + (size_t)Rq0 * 512 + head * 64; qstride = 512; nt = 4;
    } else {
        const int qb = unit & 7; head = (unit >> 3) & 7; b = unit >> 6; Rq0 = b * 2048 + 256 * qb + 32 * wid;
        Qp = (const bf16_t*)(ws + WS_QO) + (size_t)Rq0 * 768 + head * 96; qstride = 768; nt = 36;
    }
    bf16x8 qf[KST];
#pragma unroll
    for (int s = 0; s < KST; ++s) qf[s] = *(const bf16x8*)(Qp + (size_t)r32 * qstride + 16 * s + 8 * hi);
    constexpr float THR = 6.0f;
    float mref, l_run;
    if (MODE == 2) { mref = 0.f; l_run = 0.f; } else { mref = sink[head] * LOG2E; l_run = (hi == 0) ? 1.f : 0.f; }
    f32x16 negm;
#pragma unroll
    for (int r = 0; r < 16; ++r) negm[r] = -mref;
    f32x16 o0, o1;
#pragma unroll
    for (int r = 0; r < 16; ++r) { o0[r] = 0.f; o1[r] = 0.f; }

    const int srow = tid >> 3, sch = tid & 7;
    const int voff = (4 * hi + ((lane & 15) >> 2)) * VS + (((lane >> 4) & 1) * 16 + 4 * (lane & 3)) * 2;
    u32x4 kregA, vregA, kreg2A, kregB, vregB, kreg2B;
    kreg2A = (u32x4){0u, 0u, 0u, 0u}; kreg2B = kreg2A;
#define ATT_SRC(t, kp, vp, k2p, kpos0v) do { \
        if (MODE == 0 || MODE == 1) { \
            if ((t) < 4) { kp = (const bf16_t*)(ws + WS_KVE) + (size_t)(ML + b * 256 + 64 * (t) + srow) * 256 + hkv * 64 + sch * 8; kpos0v = -100000; } \
            else { const int kp0_ = 128 * n - 128 + 64 * (jlo + (t) - 4); kpos0v = kp0_; \
                   kp = (const bf16_t*)(ws + WS_KVE) + (size_t)(b * 2048 + kp0_ + srow) * 256 + hkv * 64 + sch * 8; } \
            vp = kp + 128; k2p = kp; \
        } else { \
            const int pos0_ = 64 * (t); kpos0v = -100000; \
            kp = (const bf16_t*)(ws + WS_KNV) + ((size_t)(b * 8 + head) * 2304 + pos0_ + srow) * 128 + sch * 8; \
            vp = kp + 64; \
            const int krow_ = ((t) < 4) ? (ML + b * 256 + pos0_) : (b * 2048 + pos0_ - 256); \
            k2p = (const bf16_t*)(ws + WS_KR) + (size_t)(krow_ + (tid >> 2)) * 32 + (tid & 3) * 8; \
        } } while (0)
#define ATT_LOAD(t, KR_, VR_, K2_) do { const bf16_t *kp_, *vp_, *k2p_; int kq_; ATT_SRC(t, kp_, vp_, k2p_, kq_); (void)kq_; \
        KR_ = *(const u32x4*)kp_; VR_ = *(const u32x4*)vp_; if (MODE == 2 && tid < 256) K2_ = *(const u32x4*)k2p_; } while (0)
#define ATT_STORE(buf, KR_, VR_, K2_) do { LAS unsigned char* kb_ = lds + (buf) * KBUF; LAS unsigned char* vb_ = lds + 4 * KBUF + (buf) * VBUF; \
        *(LAS u32x4*)(kb_ + srow * KS + sch * 16) = KR_; \
        if (MODE == 2 && tid < 256) *(LAS u32x4*)(kb_ + (tid >> 2) * KS + 128 + (tid & 3) * 16) = K2_; \
        *(LAS u32x4*)(vb_ + srow * VS + sch * 16) = VR_; } while (0)
#define ATT_BARRIER() do { asm volatile("s_waitcnt lgkmcnt(0)" ::: "memory"); __builtin_amdgcn_s_barrier(); asm volatile("" ::: "memory"); } while (0)

#define ATT_COMPUTE(TT) do { const int buf = (TT) & 3; \
        int kpos0 = -100000; \
        if (MODE == 0 && (TT) >= 4) kpos0 = 128 * n - 128 + 64 * (jlo + (TT) - 4); \
        bool active = true; \
        if (MODE == 0 && (TT) >= 4) active = (kpos0 + 63 >= qpos0 - 128) && (kpos0 <= qpos0 + 31 + 128); \
        if (active) { \
            const LAS unsigned char* kb = lds + buf * KBUF; const LAS unsigned char* vb = lds + 4 * KBUF + buf * VBUF; \
            f32x16 p0 = negm, p1 = negm; \
_Pragma("unroll") \
            for (int s = 0; s < KST; ++s) { \
                const bf16x8 a0 = *(const LAS bf16x8*)(kb + r32 * KS + (16 * s + 8 * hi) * 2); \
                const bf16x8 a1 = *(const LAS bf16x8*)(kb + (32 + r32) * KS + (16 * s + 8 * hi) * 2); \
                p0 = __builtin_amdgcn_mfma_f32_32x32x16_bf16(a0, qf[s], p0, 0, 0, 0); \
                p1 = __builtin_amdgcn_mfma_f32_32x32x16_bf16(a1, qf[s], p1, 0, 0, 0); \
            } \
            if (MODE == 0 && (TT) >= 4 && !((kpos0 >= qpos0 - 97) && (kpos0 <= qpos0 + 65))) {     \
                const int qpos = qpos0 + r32; \
_Pragma("unroll") \
                for (int r = 0; r < 16; ++r) { const int d0 = kpos0 + crow(r, hi) - qpos, d1 = d0 + 32; \
                    if (d0 > 128 || d0 < -128) p0[r] = -INFINITY; if (d1 > 128 || d1 < -128) p1[r] = -INFINITY; } \
            } \
            float mxa = __builtin_fmaxf(__builtin_fmaxf(p0[0], p0[1]), p1[0]), mxb = __builtin_fmaxf(__builtin_fmaxf(p0[2], p0[3]), p1[1]); \
            mxa = __builtin_fmaxf(__builtin_fmaxf(mxa, p1[2]), p1[3]); \
_Pragma("unroll") \
            for (int r = 4; r < 16; r += 4) { mxa = __builtin_fmaxf(__builtin_fmaxf(mxa, p0[r]), p0[r + 1]); mxb = __builtin_fmaxf(__builtin_fmaxf(mxb, p0[r + 2]), p0[r + 3]); \
                mxa = __builtin_fmaxf(__builtin_fmaxf(mxa, p1[r]), p1[r + 1]); mxb = __builtin_fmaxf(__builtin_fmaxf(mxb, p1[r + 2]), p1[r + 3]); } \
            float mx = __builtin_fmaxf(mxa, mxb); \
            mx = __builtin_fmaxf(mx, __shfl_xor(mx, 32)); \
            const bool first = (MODE == 2) && ((TT) == 0); \
            if (first || __any(mx > THR)) { \
                const float delta = first ? mx : __builtin_fmaxf(mx, 0.f), alpha = first ? 1.f : __builtin_amdgcn_exp2f(-delta); \
                mref += delta; l_run *= alpha; \
_Pragma("unroll") \
                for (int r = 0; r < 16; ++r) { o0[r] *= alpha; o1[r] *= alpha; p0[r] -= delta; p1[r] -= delta; negm[r] = -mref; } \
            } \
            float rs0 = 0.f, rs1 = 0.f; \
_Pragma("unroll") \
            for (int r = 0; r < 16; ++r) { p0[r] = __builtin_amdgcn_exp2f(p0[r]); p1[r] = __builtin_amdgcn_exp2f(p1[r]); rs0 += p0[r]; rs1 += p1[r]; } \
            l_run += rs0 + rs1; \
            u32x4 pw[4]; \
            pw[0] = (u32x4){pk2(p0[0], p0[1]), pk2(p0[2], p0[3]), pk2(p0[4], p0[5]), pk2(p0[6], p0[7])}; \
            pw[1] = (u32x4){pk2(p0[8], p0[9]), pk2(p0[10], p0[11]), pk2(p0[12], p0[13]), pk2(p0[14], p0[15])}; \
            pw[2] = (u32x4){pk2(p1[0], p1[1]), pk2(p1[2], p1[3]), pk2(p1[4], p1[5]), pk2(p1[6], p1[7])}; \
            pw[3] = (u32x4){pk2(p1[8], p1[9]), pk2(p1[10], p1[11]), pk2(p1[12], p1[13]), pk2(p1[14], p1[15])}; \
_Pragma("unroll") \
            for (int s2 = 0; s2 < 4; ++s2) { \
                const bf16x8 pb = __builtin_bit_cast(bf16x8, pw[s2]); \
                const LAS unsigned char* va0 = vb + (16 * s2) * VS + voff; \
                const s16x4 l0 = vtr(va0), h0 = vtr(va0 + 8 * VS), l1 = vtr(va0 + 64), h1 = vtr(va0 + 8 * VS + 64); \
                const bf16x8 v0 = (bf16x8){l0[0], l0[1], l0[2], l0[3], h0[0], h0[1], h0[2], h0[3]}; \
                const bf16x8 v1 = (bf16x8){l1[0], l1[1], l1[2], l1[3], h1[0], h1[1], h1[2], h1[3]}; \
                o0 = __builtin_amdgcn_mfma_f32_32x32x16_bf16(v0, pb, o0, 0, 0, 0); \
                o1 = __builtin_amdgcn_mfma_f32_32x32x16_bf16(v1, pb, o1, 0, 0, 0); \
            } \
        } \
        } while (0)

    ATT_LOAD(0, kregA, vregA, kreg2A); ATT_LOAD(1, kregB, vregB, kreg2B);
    ATT_STORE(0, kregA, vregA, kreg2A); ATT_STORE(1, kregB, vregB, kreg2B);
    if (2 < nt) { ATT_LOAD(2, kregA, vregA, kreg2A); ATT_LOAD(3, kregB, vregB, kreg2B); }
    ATT_BARRIER();
    const int Rq = Rq0 + r32;
    const bf16_t* zrow = (MODE == 2) ? (const bf16_t*)(aux + AUX_ZO) + (size_t)Rq * 512 + head * 64 : (const bf16_t*)(ws + WS_ZA) + (size_t)Rq * 512 + head * 64;
    u32x2 zz[8];
#pragma unroll
    for (int g = 0; g < 8; ++g) zz[g] = (u32x2){0u, 0u};
    for (int t = 0; t < nt; t += 2) {
        if (t + 2 >= nt) {
#pragma unroll
            for (int g = 0; g < 4; ++g) { zz[2 * g] = *(const u32x2*)(zrow + 8 * g + 4 * hi); zz[2 * g + 1] = *(const u32x2*)(zrow + 32 + 8 * g + 4 * hi); } }
        ATT_COMPUTE(t);
        ATT_COMPUTE(t + 1);
        if (t + 2 < nt) { ATT_STORE((t + 2) & 3, kregA, vregA, kreg2A); ATT_STORE((t + 3) & 3, kregB, vregB, kreg2B); }
        if (t + 4 < nt) { ATT_LOAD(t + 4, kregA, vregA, kreg2A); ATT_LOAD(t + 5, kregB, vregB, kreg2B); }
        ATT_BARRIER();
    }
#undef ATT_COMPUTE
#undef ATT_BARRIER
#undef ATT_SRC
#undef ATT_LOAD
#undef ATT_STORE
    const float l_tot = l_run + __shfl_xor(l_run, 32), inv = __builtin_amdgcn_rcpf(l_tot);
    bf16_t* urow = (bf16_t*)(ws + WS_U) + (size_t)Rq * 1024 + head * 64;
#pragma unroll
    for (int g = 0; g < 4; ++g) {
        const int dv = 8 * g + 4 * hi;
        { const u32x2 z = zz[2 * g];
          u32x2 w; w.x = pk2(o0[4 * g] * inv * bf_lo(z.x), o0[4 * g + 1] * inv * bf_hi(z.x)); w.y = pk2(o0[4 * g + 2] * inv * bf_lo(z.y), o0[4 * g + 3] * inv * bf_hi(z.y));
          *(u32x2*)(urow + dv) = w; }
        { const u32x2 z = zz[2 * g + 1];
          u32x2 w; w.x = pk2(o1[4 * g] * inv * bf_lo(z.x), o1[4 * g + 1] * inv * bf_hi(z.x)); w.y = pk2(o1[4 * g + 2] * inv * bf_lo(z.y), o1[4 * g + 3] * inv * bf_hi(z.y));
          *(u32x2*)(urow + 32 + dv) = w; }
    }
}


__device__ __forceinline__ int srcmap(int mat, int dn) {
    if (mat == 0) {
        if (dn < 128) { const int d = dn & 63; return (dn & 64) + (d >> 1) + 32 * (d & 1); }
        if (dn < 256) return dn;
        if (dn < 768) { const int j = dn - 256, d = j & 63; return 256 + (j & ~63) + (d >> 1) + 32 * (d & 1); }
        if (dn < 1792) { const int j = dn - 768, blk = j >> 8, w = j & 255; return (w < 128) ? 1280 + blk * 128 + w : 1792 + blk * 128 + (w - 128); }
        if (dn < 2816) { const int j = dn - 1792, blk = j >> 8, w = j & 255; return (w < 128) ? 768 + blk * 128 + w : 2816 + blk * 128 + (w - 128); }
        return 2304 + (dn - 2816);
    }
    if (mat == 2) {
        if (dn < 256) return dn;
        if (dn < 512) return 288 + (dn - 256);
        if (dn < 1024) return 544 + (dn - 512);
        if (dn < 1280) { const int w = dn - 1024; if (w < 32) return 256 + (w >> 1) + 16 * (w & 1); if (w < 48) return 1056 + (w - 32); return -1; }
        if (dn < 2048) return 1072 + (dn - 1280);
        if (dn < 2304) return 1840 + (dn - 2048);
        if (dn < 3328) { const int j = dn - 2304, blk = j >> 8, w = j & 255; return (w < 128) ? 2096 + blk * 128 + w : 2608 + 512 + blk * 128 + (w - 128); }
        return 2608 + (dn - 3328);
    }
    if (mat == 3) {
        const int head = dn / 96, d = dn - head * 96; if (d < 64) return dn; const int w = d - 64; return head * 96 + 64 + (w >> 1) + 16 * (w & 1);
    }
    return dn;
}
__device__ __forceinline__ void p0_transpose_item(const float* W, int K, int Nsrc, bf16_t* WT, int mat, const float* kscale, LAS float* scr, int item, int nblk, int lane) {
    const int kb = item / nblk, nb = item % nblk, k0 = 64 * kb, n0 = 32 * nb;
    const int sc = srcmap(mat, n0 + (lane & 31));
    float v[32];
    const float* wp = W + (size_t)(k0 + (lane >> 5)) * Nsrc + (sc >= 0 ? sc : 0);
#pragma unroll
    for (int i = 0; i < 32; ++i) v[i] = wp[(size_t)(2 * i) * Nsrc];
#pragma unroll
    for (int i = 0; i < 32; ++i) { const int kk = 2 * i + (lane >> 5); float x = (sc >= 0) ? v[i] : 0.f; if (kscale) x *= kscale[k0 + kk]; scr[kk * 33 + (lane & 31)] = x; }
    LDS_WAIT(); asm volatile("" ::: "memory");
    const int c = lane & 7;
#pragma unroll
    for (int j = 0; j < 4; ++j) { const int n = (lane >> 3) + 8 * j; const LAS float* s = scr + (8 * c) * 33 + n;
        u32x4 o; o.x = pk2(s[0 * 33], s[1 * 33]); o.y = pk2(s[2 * 33], s[3 * 33]); o.z = pk2(s[4 * 33], s[5 * 33]); o.w = pk2(s[6 * 33], s[7 * 33]);
        *(u32x4*)(WT + (size_t)(n0 + n) * K + k0 + 8 * c) = o; }
    LDS_WAIT(); asm volatile("" ::: "memory");
}

__device__ __forceinline__ void p0_mod(LAS unsigned char* lds, const float* c, const float* c_ctx, const float* mod_w, const float* mod_b, float* MOD, int G) {
    const int tid = my_tid();
    if ((int)blockIdx.x >= 192) return;
    LAS float* scs = (LAS float*)lds;
    LAS float* red = (LAS float*)(lds + 1024 * 20 * 4);
    { float cv[34];
#pragma unroll
      for (int u = 0; u < 34; ++u) { const int idx = tid + u * NTHREADS, r = idx >> 10, k = idx & 1023; cv[u] = (r < 16) ? c[r * 1024 + k] : c_ctx[k]; }
#pragma unroll
      for (int u = 0; u < 34; ++u) { const int idx = tid + u * NTHREADS, r = idx >> 10, k = idx & 1023; scs[k * 20 + r] = silu_f(cv[u]); } }
    __syncthreads();
    for (int item = blockIdx.x; item < 192; item += G) {
        const int l = item / 96, n0 = (item % 96) * 32, col = tid & 31, kg = tid >> 5;
        float acc[20];
#pragma unroll
        for (int r = 0; r < 20; ++r) acc[r] = 0.f;
        const float* wp = mod_w + ((size_t)l * 1024 + kg * 64) * 3072 + n0 + col;
#pragma unroll
        for (int kb = 0; kb < 4; ++kb) {
            float w[16];
#pragma unroll
            for (int u = 0; u < 16; ++u) w[u] = wp[(size_t)(kb * 16 + u) * 3072];
#pragma unroll
            for (int u = 0; u < 16; ++u) { const LAS f32x4* sp = (const LAS f32x4*)(scs + (kg * 64 + kb * 16 + u) * 20);
#pragma unroll
                for (int q = 0; q < 5; ++q) { const f32x4 s = sp[q]; acc[4 * q] += s[0] * w[u]; acc[4 * q + 1] += s[1] * w[u]; acc[4 * q + 2] += s[2] * w[u]; acc[4 * q + 3] += s[3] * w[u]; } }
        }
#pragma unroll
        for (int r = 0; r < 17; ++r) red[(kg * 17 + r) * 32 + col] = acc[r];
        __syncthreads();
        for (int o = tid; o < 17 * 32; o += NTHREADS) { const int r = o >> 5, cc = o & 31; float s = mod_b[l * 3072 + n0 + cc];
#pragma unroll
            for (int g = 0; g < 16; ++g) s += red[(g * 17 + r) * 32 + cc];
            MOD[((size_t)l * 17 + r) * 3072 + n0 + cc] = s; }
        __syncthreads();
    }
}

__device__ __forceinline__ void norm_mod_store(const f32x4 (&v)[4], const float* pre_w, const float* modrow, bf16_t* hrow, int lane) {
    float ss = 0.f;
#pragma unroll
    for (int j = 0; j < 4; ++j) ss += sq4(v[j]);
    const float rstd = rsqrtf(wave_sum(ss) * (1.f / 1024.f) + EPS);
#pragma unroll
    for (int j = 0; j < 4; ++j) { const int k = 4 * (lane + 64 * j);
        const f32x4 w = *(const f32x4*)(pre_w + k), sh = *(const f32x4*)(modrow + k), sc = *(const f32x4*)(modrow + 1024 + k);
        const f32x4 h = v[j] * rstd * w * (sc + 1.0f) + sh;
        u32x2 o; o.x = pk2(h[0], h[1]); o.y = pk2(h[2], h[3]); *(u32x2*)(hrow + k) = o; }
}
__device__ __forceinline__ void norm_mod_store_wt(const f32x4 (&v)[4], const float* pre_w, const float* modrow, bf16_t* hrow, int lane) {
    float ss = 0.f;
#pragma unroll
    for (int j = 0; j < 4; ++j) ss += sq4(v[j]);
    const float rstd = rsqrtf(wave_sum(ss) * (1.f / 1024.f) + EPS);
#pragma unroll
    for (int j = 0; j < 4; ++j) { const int k = 4 * (lane + 64 * j);
        const f32x4 w = *(const f32x4*)(pre_w + k), sh = *(const f32x4*)(modrow + k), sc = *(const f32x4*)(modrow + 1024 + k);
        const f32x4 h = v[j] * rstd * w * (sc + 1.0f) + sh;
        __hip_atomic_store((unsigned long long*)(hrow + k), (unsigned long long)pk2(h[0], h[1]) | ((unsigned long long)pk2(h[2], h[3]) << 32), __ATOMIC_RELAXED, __HIP_MEMORY_SCOPE_AGENT); }
}
__device__ __forceinline__ void p1_stream(const float* x, const float* ctx, const float* pre_w, const float* MOD, bf16_t* H, unsigned* ready, int sw, int nsw, int lane) {
    f32x4 cur[4][4], nxt[4][4];
#define P1_LOAD(dst, R_) do { if ((R_) < MT) { const float* src_ = ((R_) < ML) ? x + (size_t)(R_) * 1024 : ctx + (size_t)((R_) - ML) * 1024; \
        _Pragma("unroll") for (int j = 0; j < 4; ++j) dst[j] = *(const f32x4*)(src_ + 4 * (lane + 64 * j)); } } while (0)
#pragma unroll
    for (int q = 0; q < 4; ++q) P1_LOAD(cur[q], sw + nsw * q);
    for (int R0 = sw; R0 < MT; R0 += 4 * nsw) {
#pragma unroll
        for (int q = 0; q < 4; ++q) P1_LOAD(nxt[q], R0 + nsw * (4 + q));
#pragma unroll
        for (int q = 0; q < 4; ++q) { const int R = R0 + nsw * q; if (R < MT) { const int bi = (R < ML) ? (R >> 11) : 16;
            norm_mod_store_wt(cur[q], pre_w, MOD + (size_t)bi * 3072, H + (size_t)R * 1024, lane); } }
        asm volatile("s_waitcnt vmcnt(0)" ::: "memory");
        if (lane < 4) { const int R = R0 + nsw * lane; if (R < MT) __hip_atomic_fetch_add(ready + 64 * (R >> 8), 1u, __ATOMIC_RELAXED, __HIP_MEMORY_SCOPE_AGENT); }
#pragma unroll
        for (int q = 0; q < 4; ++q)
#pragma unroll
            for (int j = 0; j < 4; ++j) cur[q][j] = nxt[q][j];
    }
#undef P1_LOAD
}
__device__ __forceinline__ void p1_prenorm(const float* x, const float* ctx, const float* pre_w, const float* MOD, bf16_t* H, int gw, int ngw, int lane) {
    const int per = (MT + ngw - 1) / ngw, r0 = gw * per, r1 = (r0 + per < MT) ? r0 + per : MT;
    f32x4 cur[4], nxt[4], w[4], sc1[4], sh[4];
#pragma unroll
    for (int j = 0; j < 4; ++j) { w[j] = *(const f32x4*)(pre_w + 4 * (lane + 64 * j)); sc1[j] = w[j]; sh[j] = w[j]; }
#define P1_LOAD(dst, R_) do { const float* src_ = ((R_) < ML) ? x + (size_t)(R_) * 1024 : ctx + (size_t)((R_) - ML) * 1024; \
        _Pragma("unroll") for (int j = 0; j < 4; ++j) dst[j] = *(const f32x4*)(src_ + 4 * (lane + 64 * j)); } while (0)
    if (r0 < r1) P1_LOAD(cur, r0);
    int cur_bi = -1;
    for (int R = r0; R < r1; ++R) {
        if (R + 1 < r1) P1_LOAD(nxt, R + 1);
        const int bi = (R < ML) ? (R >> 11) : 16;
        if (bi != cur_bi) { cur_bi = bi; const float* m0 = MOD + (size_t)bi * 3072;
#pragma unroll
            for (int j = 0; j < 4; ++j) { const int k = 4 * (lane + 64 * j); sh[j] = *(const f32x4*)(m0 + k); sc1[j] = *(const f32x4*)(m0 + 1024 + k) + 1.0f; } }
        float ss = 0.f;
#pragma unroll
        for (int j = 0; j < 4; ++j) ss += sq4(cur[j]);
        const float rstd = rsqrtf(wave_sum(ss) * (1.f / 1024.f) + EPS);
#pragma unroll
        for (int j = 0; j < 4; ++j) { const int k = 4 * (lane + 64 * j);
            const f32x4 h = cur[j] * rstd * w[j] * sc1[j] + sh[j];
            u32x2 o; o.x = pk2(h[0], h[1]); o.y = pk2(h[2], h[3]); *(u32x2*)(H + (size_t)R * 1024 + k) = o; }
#pragma unroll
        for (int j = 0; j < 4; ++j) cur[j] = nxt[j];
    }
#undef P1_LOAD
}
__device__ __forceinline__ float ssq16(const float* p) {
    const f32x4 a = *(const f32x4*)p, b = *(const f32x4*)(p + 4), c = *(const f32x4*)(p + 8), d = *(const f32x4*)(p + 12);
    return (((a[0] + a[1]) + (a[2] + a[3])) + ((b[0] + b[1]) + (b[2] + b[3]))) + (((c[0] + c[1]) + (c[2] + c[3])) + ((d[0] + d[1]) + (d[2] + d[3])));
}
__device__ __forceinline__ void p5_post_pre(const float* x, const float* ctx, const float* post_w0, const float* pre_w1, const float* MOD, const bf16_t* Y, const float* SSQ, bf16_t* X1, bf16_t* H, int gw, int ngw, int lane) {
    const int per = (MT + ngw - 1) / ngw, r0 = gw * per, r1 = (r0 + per < MT) ? r0 + per : MT;
    f32x4 xc[4], xn[4], sqc[4], sqn[4]; u32x2 yc[4], yn[4];
    f32x4 pg[4], pw[4], w1[4], sc1[4], sh1[4];
#pragma unroll
    for (int j = 0; j < 4; ++j) { const int k = 4 * (lane + 64 * j); pw[j] = *(const f32x4*)(post_w0 + k); w1[j] = *(const f32x4*)(pre_w1 + k); pg[j] = pw[j]; sc1[j] = pw[j]; sh1[j] = pw[j]; }
#define P5_LOAD(xd, yd, sd, R_) do { const float* src_ = ((R_) < ML) ? x + (size_t)(R_) * 1024 : ctx + (size_t)((R_) - ML) * 1024; \
        _Pragma("unroll") for (int j = 0; j < 4; ++j) { xd[j] = *(const f32x4*)(src_ + 4 * (lane + 64 * j)); yd[j] = *(const u32x2*)(Y + (size_t)(R_) * 1024 + 4 * (lane + 64 * j)); \
            sd[j] = *(const f32x4*)(SSQ + (size_t)(R_) * 16 + 4 * j); } } while (0)
    if (r0 < r1) P5_LOAD(xc, yc, sqc, r0);
    int cur_bi = -1;
    for (int R = r0; R < r1; ++R) {
        if (R + 1 < r1) P5_LOAD(xn, yn, sqn, R + 1);
        const int bi = (R < ML) ? (R >> 11) : 16;
        if (bi != cur_bi) { cur_bi = bi; const float* m0 = MOD + (size_t)bi * 3072; const float* m1 = MOD + (size_t)(17 + bi) * 3072;
#pragma unroll
            for (int j = 0; j < 4; ++j) { const int k = 4 * (lane + 64 * j); pg[j] = *(const f32x4*)(m0 + 2048 + k); sh1[j] = *(const f32x4*)(m1 + k); sc1[j] = *(const f32x4*)(m1 + 1024 + k) + 1.0f; } }
        const float ssy = (((sqc[0][0] + sqc[0][1]) + (sqc[0][2] + sqc[0][3])) + ((sqc[1][0] + sqc[1][1]) + (sqc[1][2] + sqc[1][3]))) + (((sqc[2][0] + sqc[2][1]) + (sqc[2][2] + sqc[2][3])) + ((sqc[3][0] + sqc[3][1]) + (sqc[3][2] + sqc[3][3])));
        const float rstd_y = rsqrtf(ssy * (1.f / 1024.f) + EPS);
        f32x4 v[4]; float ss = 0.f;
#pragma unroll
        for (int j = 0; j < 4; ++j) { const int k = 4 * (lane + 64 * j);
            const f32x4 y = (f32x4){bf_lo(yc[j].x), bf_hi(yc[j].x), bf_lo(yc[j].y), bf_hi(yc[j].y)};
            v[j] = xc[j] + pg[j] * (y * rstd_y * pw[j]);
            ss += sq4(v[j]);
            if (R < ML) { u32x2 o; o.x = pk2(v[j][0], v[j][1]); o.y = pk2(v[j][2], v[j][3]); *(u32x2*)(X1 + (size_t)R * 1024 + k) = o; } }
        const float rstd = rsqrtf(wave_sum(ss) * (1.f / 1024.f) + EPS);
#pragma unroll
        for (int j = 0; j < 4; ++j) { const int k = 4 * (lane + 64 * j);
            const f32x4 h = v[j] * rstd * w1[j] * sc1[j] + sh1[j];
            u32x2 o; o.x = pk2(h[0], h[1]); o.y = pk2(h[2], h[3]); *(u32x2*)(H + (size_t)R * 1024 + k) = o; }
#pragma unroll
        for (int j = 0; j < 4; ++j) { xc[j] = xn[j]; yc[j] = yn[j]; sqc[j] = sqn[j]; }
    }
#undef P5_LOAD
}
__device__ __forceinline__ void p11_final(const float* post_w1, const float* MOD, const bf16_t* Y, const float* SSQ, const bf16_t* X1, float* out, int gw, int ngw, int lane) {
    const int per = (ML + ngw - 1) / ngw, r0 = gw * per, r1 = (r0 + per < ML) ? r0 + per : ML;
    u32x2 xc[4], xn[4], yc[4], yn[4]; f32x4 sqc[4], sqn[4], pg[4], pw[4];
#pragma unroll
    for (int j = 0; j < 4; ++j) { pw[j] = *(const f32x4*)(post_w1 + 4 * (lane + 64 * j)); pg[j] = pw[j]; }
#define P11_LOAD(xd, yd, sd, R_) do { _Pragma("unroll") for (int j = 0; j < 4; ++j) { xd[j] = *(const u32x2*)(X1 + (size_t)(R_) * 1024 + 4 * (lane + 64 * j)); yd[j] = *(const u32x2*)(Y + (size_t)(R_) * 1024 + 4 * (lane + 64 * j)); \
        sd[j] = *(const f32x4*)(SSQ + (size_t)(R_) * 16 + 4 * j); } } while (0)
    if (r0 < r1) P11_LOAD(xc, yc, sqc, r0);
    int cur_b = -1;
    for (int R = r0; R < r1; ++R) {
        if (R + 1 < r1) P11_LOAD(xn, yn, sqn, R + 1);
        const int bb = R >> 11;
        if (bb != cur_b) { cur_b = bb; const float* m1 = MOD + (size_t)(17 + bb) * 3072;
#pragma unroll
            for (int j = 0; j < 4; ++j) pg[j] = *(const f32x4*)(m1 + 2048 + 4 * (lane + 64 * j)); }
        const float ssy = (((sqc[0][0] + sqc[0][1]) + (sqc[0][2] + sqc[0][3])) + ((sqc[1][0] + sqc[1][1]) + (sqc[1][2] + sqc[1][3]))) + (((sqc[2][0] + sqc[2][1]) + (sqc[2][2] + sqc[2][3])) + ((sqc[3][0] + sqc[3][1]) + (sqc[3][2] + sqc[3][3])));
        const float rstd_y = rsqrtf(ssy * (1.f / 1024.f) + EPS);
#pragma unroll
        for (int j = 0; j < 4; ++j) { const int k = 4 * (lane + 64 * j);
            const f32x4 y = (f32x4){bf_lo(yc[j].x), bf_hi(yc[j].x), bf_lo(yc[j].y), bf_hi(yc[j].y)};
            const f32x4 xv = (f32x4){bf_lo(xc[j].x), bf_hi(xc[j].x), bf_lo(xc[j].y), bf_hi(xc[j].y)};
            *(f32x4*)(out + (size_t)R * 1024 + k) = xv + pg[j] * (y * rstd_y * pw[j]); }
#pragma unroll
        for (int j = 0; j < 4; ++j) { xc[j] = xn[j]; yc[j] = yn[j]; sqc[j] = sqn[j]; }
    }
#undef P11_LOAD
}
__device__ __forceinline__ void p3_conv(unsigned char* ws, const float* conv_w, int gtid, int ngt) {
    const bf16_t* PE = (const bf16_t*)(ws + WS_PE); const bf16_t* GE = (const bf16_t*)(ws + WS_GE); bf16_t* U = (bf16_t*)(ws + WS_U);
    const int ch = (gtid & 63) * 8;
    const f32x4 w0a = *(const f32x4*)(conv_w + ch), w0b = *(const f32x4*)(conv_w + ch + 4), w1a = *(const f32x4*)(conv_w + 512 + ch), w1b = *(const f32x4*)(conv_w + 512 + ch + 4),
                w2a = *(const f32x4*)(conv_w + 1024 + ch), w2b = *(const f32x4*)(conv_w + 1024 + ch + 4);
    for (int it = gtid; it < MT * 64; it += ngt) {
        const int R = it >> 6;
        int t, T; if (R < ML) { t = R & 2047; T = 2048; } else { t = (R - ML) & 255; T = 256; }
        const u32x4 z4 = (u32x4){0u, 0u, 0u, 0u};
        const u32x4 pc = *(const u32x4*)(PE + (size_t)R * 512 + ch);
        const u32x4 pm = (t > 0) ? *(const u32x4*)(PE + (size_t)(R - 1) * 512 + ch) : z4;
        const u32x4 pp = (t < T - 1) ? *(const u32x4*)(PE + (size_t)(R + 1) * 512 + ch) : z4;
        const u32x4 g = *(const u32x4*)(GE + (size_t)R * 512 + ch);
        u32x4 o;
#define CV(pmw, pcw, ppw, gw_, wa, wb, wc_, e0, e1) pk2(bf_lo(gw_) * (wa[e0] * bf_lo(pmw) + wb[e0] * bf_lo(pcw) + wc_[e0] * bf_lo(ppw)), bf_hi(gw_) * (wa[e1] * bf_hi(pmw) + wb[e1] * bf_hi(pcw) + wc_[e1] * bf_hi(ppw)))
        o.x = CV(pm.x, pc.x, pp.x, g.x, w0a, w1a, w2a, 0, 1); o.y = CV(pm.y, pc.y, pp.y, g.y, w0a, w1a, w2a, 2, 3);
        o.z = CV(pm.z, pc.z, pp.z, g.z, w0b, w1b, w2b, 0, 1); o.w = CV(pm.w, pc.w, pp.w, g.w, w0b, w1b, w2b, 2, 3);
#undef CV
        *(u32x4*)(U + (size_t)R * 1024 + 512 + ch) = o;
    }
}
__device__ __forceinline__ void p9_readout(unsigned char* ws, unsigned char* aux, const float* hn_w, int gw, int ngw, int lane) {
    const bf16_t* HM = (const bf16_t*)(ws + WS_HM); const bf16_t* MO = (const bf16_t*)(aux + AUX_MO); bf16_t* U = (bf16_t*)(ws + WS_U);
    const int ch = 8 * lane;
    const f32x4 wa = *(const f32x4*)(hn_w + ch), wb = *(const f32x4*)(hn_w + ch + 4);
    u32x4 h0, h1, mo, h0n, h1n, mon;
#define P9_LOAD(a_, b_, c_, R_) do { a_ = *(const u32x4*)(HM + (size_t)(R_) * 512 + ch); b_ = *(const u32x4*)(HM + ((size_t)ML + (R_)) * 512 + ch); c_ = *(const u32x4*)(MO + (size_t)(R_) * 512 + ch); } while (0)
    h0n = (u32x4){0u, 0u, 0u, 0u}; h1n = h0n; mon = h0n;
    if (gw < ML) P9_LOAD(h0, h1, mo, gw);
    for (int R = gw; R < ML; R += ngw) {
        if (R + ngw < ML) P9_LOAD(h0n, h1n, mon, R + ngw);
        float hs[8] = {bf_lo(h0.x) + bf_lo(h1.x), bf_hi(h0.x) + bf_hi(h1.x), bf_lo(h0.y) + bf_lo(h1.y), bf_hi(h0.y) + bf_hi(h1.y),
                       bf_lo(h0.z) + bf_lo(h1.z), bf_hi(h0.z) + bf_hi(h1.z), bf_lo(h0.w) + bf_lo(h1.w), bf_hi(h0.w) + bf_hi(h1.w)};
        float ss = 0.f;
#pragma unroll
        for (int e = 0; e < 8; ++e) ss += hs[e] * hs[e];
        ss += __shfl_xor(ss, 1); ss += __shfl_xor(ss, 2); ss += __shfl_xor(ss, 4); ss += __shfl_xor(ss, 8);
        const float rstd = rsqrtf(ss * (1.f / 128.f) + EPS);
        u32x4 o;
        o.x = pk2(hs[0] * rstd * wa[0] * bf_lo(mo.x), hs[1] * rstd * wa[1] * bf_hi(mo.x));
        o.y = pk2(hs[2] * rstd * wa[2] * bf_lo(mo.y), hs[3] * rstd * wa[3] * bf_hi(mo.y));
        o.z = pk2(hs[4] * rstd * wb[0] * bf_lo(mo.z), hs[5] * rstd * wb[1] * bf_hi(mo.z));
        o.w = pk2(hs[6] * rstd * wb[2] * bf_lo(mo.w), hs[7] * rstd * wb[3] * bf_hi(mo.w));
        *(u32x4*)(U + (size_t)R * 1024 + 512 + ch) = o;
        h0 = h0n; h1 = h1n; mo = mon;
    }
#undef P9_LOAD
}


typedef float f32x4v __attribute__((ext_vector_type(4)));
#define LDS_BARRIER() do { asm volatile("s_waitcnt lgkmcnt(0)" ::: "memory"); __builtin_amdgcn_s_barrier(); asm volatile("" ::: "memory"); } while (0)
#define MFMA_FENCE(x) do { __builtin_amdgcn_sched_barrier(0); asm volatile("s_nop 15\n\ts_nop 15" : "+v"(x)); __builtin_amdgcn_sched_barrier(0); } while (0)
__device__ __forceinline__ bf16x8 tr8(const LAS unsigned char* p, int halfstride) {
    const s16x4 lo = vtr(p), hi = vtr(p + halfstride);
    return (bf16x8){lo[0], lo[1], lo[2], lo[3], hi[0], hi[1], hi[2], hi[3]};
}
__device__ __forceinline__ bf16x8 gather8(const LAS unsigned char* img, int stride, int row0, int col) {
    bf16x8 r;
#pragma unroll
    for (int e = 0; e < 8; ++e) r[e] = *(const LAS short*)(img + (row0 + e) * stride + col * 2);
    return r;
}
template <int CTRL, int RM> __device__ __forceinline__ float dppf(float oldv, float v) {
    return __int_as_float(__builtin_amdgcn_update_dpp(__float_as_int(oldv), __float_as_int(v), CTRL, RM, 0xf, false));
}
__device__ __forceinline__ float wave_scan_add(float v) {
    v += dppf<0x111, 0xf>(0.f, v); v += dppf<0x112, 0xf>(0.f, v); v += dppf<0x114, 0xf>(0.f, v); v += dppf<0x118, 0xf>(0.f, v);
    v += dppf<0x142, 0xa>(0.f, v); v += dppf<0x143, 0xc>(0.f, v);
    return v;
}
__device__ __forceinline__ float wave_scan_max(float v) {
    const float ninf = -INFINITY;
    v = fmaxf(v, dppf<0x111, 0xf>(ninf, v)); v = fmaxf(v, dppf<0x112, 0xf>(ninf, v)); v = fmaxf(v, dppf<0x114, 0xf>(ninf, v)); v = fmaxf(v, dppf<0x118, 0xf>(ninf, v));
    v = fmaxf(v, dppf<0x142, 0xa>(ninf, v)); v = fmaxf(v, dppf<0x143, 0xc>(ninf, v));
    return v;
}
template <bool DUMMY> __device__ __forceinline__ void mlstm_chain_mfma(LAS unsigned char* lds, unsigned char* ws, unsigned char* aux, const float* i_bias, const float* f_bias, int chain) {
    constexpr int RS = 144, VS = 176;
    constexpr int QI = 0, KI = 9216, SC = 18432, CI = 27648, VI = 39168, VW = 50432, VEC = 61696;
    const int tid = my_tid(), lane = tid & 63, wid = __builtin_amdgcn_readfirstlane(tid >> 6), l15 = lane & 15, kg = lane >> 4;
    const int vh = chain & 1, d = (chain >> 1) & 1, h = (chain >> 2) & 3, b = chain >> 4;
    LAS float* vb_ = (LAS float*)(lds + VEC); LAS float* vab = vb_ + 64; LAS float* vcm = vab + 64; LAS float* vwp = vcm + 64; LAS float* vsc = vwp + 64;
    const bf16_t* MK = (const bf16_t*)(ws + WS_MK); const bf16_t* MV = (const bf16_t*)(ws + WS_MV); const bf16_t* MQ = (const bf16_t*)(aux + AUX_MQ);
    const float* GT = (const float*)(ws + WS_GATES); bf16_t* HM = (bf16_t*)(ws + WS_HM);
    const float ib = i_bias[d * 4 + h], fb = f_bias[d * 4 + h];
    for (int idx = tid; idx < 80 * RS / 4; idx += NTHREADS) ((LAS unsigned*)(lds + CI))[idx] = 0u;
    if (tid < 64) { LAS unsigned* a = (LAS unsigned*)(lds + VI + tid * VS + 128); LAS unsigned* w = (LAS unsigned*)(lds + VW + tid * VS + 128);
#pragma unroll
        for (int e = 0; e < 8; ++e) { a[e] = (e == 0) ? 0x3F80u : 0u; w[e] = 0u; } }
    const int it = wid & 3, vg = wid >> 2;
    f32x4v cacc[3];
#pragma unroll
    for (int t = 0; t < 3; ++t) cacc[t] = (f32x4v){0.f, 0.f, 0.f, 0.f};
    float mst = 0.f;
    unsigned nbad = 0u;
    const int srow = tid >> 3, sch = tid & 7;
    const int q4 = l15 >> 2, p4 = l15 & 3;
    u32x4 kkN, vvN, qqN = (u32x4){0u, 0u, 0u, 0u}; float liN = 0.f, fpN = 0.f;
#define MLSTM_LOADS(S_) do { const bool lat_ = (S_) >= 4; const int c_ = lat_ ? (S_) - 4 : (S_), T_ = lat_ ? 2048 : 256, rowb_ = lat_ ? b * 2048 : ML + b * 256; \
        const int tok_ = (d == 0) ? 64 * c_ + srow : T_ - 1 - (64 * c_ + srow); const size_t R_ = (size_t)(rowb_ + tok_); \
        kkN = *(const u32x4*)(MK + R_ * 256 + h * 64 + sch * 8); vvN = *(const u32x4*)(MV + R_ * 512 + h * 128 + vh * 64 + sch * 8); \
        if (lat_) qqN = *(const u32x4*)(MQ + R_ * 256 + h * 64 + sch * 8); \
        if (wid == 0) { const int tk_ = (d == 0) ? 64 * c_ + lane : T_ - 1 - (64 * c_ + lane); const float* gp_ = GT + (size_t)(rowb_ + tk_) * 16 + d * 8 + h; liN = gp_[0]; fpN = gp_[4]; } } while (0)
    MLSTM_LOADS(0);
    for (int step = 0; step < 36; ++step) {
        const bool lat = step >= 4; const int c = lat ? step - 4 : step, T = lat ? 2048 : 256, rowb = lat ? b * 2048 : ML + b * 256;
        const int tok = (d == 0) ? 64 * c + srow : T - 1 - (64 * c + srow); const size_t R = (size_t)(rowb + tok);
        const u32x4 kk = kkN, vv = vvN, qq = qqN;
        if (wid == 0) {
            const float li = liN + ib, fp = fpN + fb;
            const float lf = fminf(fp, 0.f) - __logf(1.f + __expf(-fabsf(fp)));
            const float bc = wave_scan_add(lf);
            const float ab = li - bc; const float cm = wave_scan_max(ab);
            const float g = __int_as_float(__builtin_amdgcn_readlane(__float_as_int(bc), 63)), mloc = g + __int_as_float(__builtin_amdgcn_readlane(__float_as_int(cm), 63)), m_new = fmaxf(g + mst, mloc);
            vb_[lane] = bc; vab[lane] = ab; vcm[lane] = cm; vwp[lane] = __expf(g + ab - m_new);
            if (lane == 0) { vsc[0] = mst; vsc[1] = __expf(g + mst - m_new); }
            mst = m_new;
        }
        LDS_BARRIER();
        { const float wj = vwp[srow];
          *(LAS u32x4*)(lds + KI + srow * RS + sch * 16) = kk;
          *(LAS u32x4*)(lds + VI + srow * VS + sch * 16) = vv;
          u32x4 vw; vw.x = pk2(bf_lo(vv.x) * wj, bf_hi(vv.x) * wj); vw.y = pk2(bf_lo(vv.y) * wj, bf_hi(vv.y) * wj); vw.z = pk2(bf_lo(vv.z) * wj, bf_hi(vv.z) * wj); vw.w = pk2(bf_lo(vv.w) * wj, bf_hi(vv.w) * wj);
          *(LAS u32x4*)(lds + VW + srow * VS + sch * 16) = vw;
          if (sch == 0) *(LAS unsigned short*)(lds + VW + srow * VS + 128) = f2bf(wj);
          if (lat) *(LAS u32x4*)(lds + QI + srow * RS + sch * 16) = qq; }
        LDS_BARRIER();
        const float m_in = vsc[0], a_prev = vsc[1];
        if (step + 1 < 36) MLSTM_LOADS(step + 1);
        bf16x8 qf[2];
        if (lat) {
            qf[0] = *(const LAS bf16x8*)(lds + QI + (16 * it + l15) * RS + (8 * kg) * 2); qf[1] = *(const LAS bf16x8*)(lds + QI + (16 * it + l15) * RS + (8 * kg + 32) * 2);
            const int i = 16 * it + l15; const float mi = fmaxf(m_in, vcm[i]);
#pragma unroll
            for (int t = 0; t < 2; ++t) {
                const int jt = 2 * vg + t; u32x2 o = (u32x2){0u, 0u};
                if (jt <= it) {
                    const bf16x8 k0 = *(const LAS bf16x8*)(lds + KI + (16 * jt + l15) * RS + (8 * kg) * 2), k1 = *(const LAS bf16x8*)(lds + KI + (16 * jt + l15) * RS + (8 * kg + 32) * 2);
                    f32x4v s = (f32x4v){0.f, 0.f, 0.f, 0.f};
                    s = __builtin_amdgcn_mfma_f32_16x16x32_bf16(k0, qf[0], s, 0, 0, 0); s = __builtin_amdgcn_mfma_f32_16x16x32_bf16(k1, qf[1], s, 0, 0, 0); MFMA_FENCE(s);
                    const int j0 = 16 * jt + 4 * kg; const f32x4v abv = *(const LAS f32x4v*)(vab + j0);
                    float e[4];
#pragma unroll
                    for (int r = 0; r < 4; ++r) e[r] = (j0 + r <= i) ? s[r] * __expf(abv[r] - mi) : 0.f;
                    o.x = pk2(e[0], e[1]); o.y = pk2(e[2], e[3]);
                }
                *(LAS u32x2*)(lds + SC + i * RS + (16 * jt + 4 * kg) * 2) = o;
            }
        }
        LDS_BARRIER();
        f32x4v cnew[3];
        { bf16x8 aK[2];
#pragma unroll
          for (int s = 0; s < 2; ++s) aK[s] = tr8(lds + KI + (32 * s + 8 * kg + q4) * RS + (16 * it + 4 * p4) * 2, 4 * RS);
#pragma unroll
          for (int t = 0; t < 3; ++t) { const int vt = (t == 2) ? 4 : 2 * t + vg; f32x4v a = cacc[t] * a_prev;
#pragma unroll
              for (int s = 0; s < 2; ++s) { const bf16x8 bW = tr8(lds + VW + (32 * s + 8 * kg + q4) * VS + (16 * vt + 4 * p4) * 2, 4 * VS); a = __builtin_amdgcn_mfma_f32_16x16x32_bf16(aK[s], bW, a, 0, 0, 0); }
              MFMA_FENCE(a); cnew[t] = a; } }
        if (lat) {
            const int i0 = 16 * it + 4 * kg; const f32x4v cmv = *(const LAS f32x4v*)(vcm + i0), bv = *(const LAS f32x4v*)(vb_ + i0);
            float wi[4], mt[4];
#pragma unroll
            for (int r = 0; r < 4; ++r) { const float mi = fmaxf(m_in, cmv[r]); wi[r] = __expf(m_in - mi); mt[r] = bv[r] + mi; }
            bf16x8 aS[2];
            aS[0] = *(const LAS bf16x8*)(lds + SC + (16 * it + l15) * RS + (8 * kg) * 2); aS[1] = *(const LAS bf16x8*)(lds + SC + (16 * it + l15) * RS + (8 * kg + 32) * 2);
            f32x4v nacc[3];
#pragma unroll
            for (int t = 0; t < 3; ++t) { const int vt = (t == 2) ? 4 : 2 * t + vg; f32x4v a = (f32x4v){0.f, 0.f, 0.f, 0.f};
#pragma unroll
                for (int s = 0; s < 2; ++s) { const bf16x8 bC = *(const LAS bf16x8*)(lds + CI + (16 * vt + l15) * RS + (8 * kg + 32 * s) * 2); a = __builtin_amdgcn_mfma_f32_16x16x32_bf16(qf[s], bC, a, 0, 0, 0); }
                MFMA_FENCE(a);
#pragma unroll
                for (int r = 0; r < 4; ++r) a[r] *= wi[r];
#pragma unroll
                for (int s = 0; s < 2; ++s) { const bf16x8 bV = tr8(lds + VI + (32 * s + 8 * kg + q4) * VS + (16 * vt + 4 * p4) * 2, 4 * VS); a = __builtin_amdgcn_mfma_f32_16x16x32_bf16(aS[s], bV, a, 0, 0, 0); }
                MFMA_FENCE(a); nacc[t] = a; }
            float inv[4];
#pragma unroll
            for (int r = 0; r < 4; ++r) { const float den = __shfl(nacc[2][r], lane & 48); inv[r] = 1.f / fmaxf(fabsf(den), __expf(-mt[r])); }
#pragma unroll
            for (int t = 0; t < 2; ++t) { const int vt = 2 * t + vg;
#pragma unroll
                for (int r = 0; r < 4; ++r) *(LAS unsigned short*)(lds + QI + (i0 + r) * RS + (16 * vt + l15) * 2) = f2bf(nacc[t][r] * inv[r]); }
        }
        LDS_BARRIER();
        if (lat) { const u32x4 hv = *(const LAS u32x4*)(lds + QI + srow * RS + sch * 16);
            if (DUMMY) { const u32x4 rv = *(const u32x4*)(HM + ((size_t)d * ML + R) * 512 + h * 128 + vh * 64 + sch * 8);
#define CMPH(a_, b_) do { const float x_ = (a_), y_ = (b_); if (fabsf(x_ - y_) > 0.05f * fmaxf(fabsf(x_), fabsf(y_)) + 0.02f) ++nbad; } while (0)
                CMPH(bf_lo(hv.x), bf_lo(rv.x)); CMPH(bf_hi(hv.x), bf_hi(rv.x)); CMPH(bf_lo(hv.y), bf_lo(rv.y)); CMPH(bf_hi(hv.y), bf_hi(rv.y));
                CMPH(bf_lo(hv.z), bf_lo(rv.z)); CMPH(bf_hi(hv.z), bf_hi(rv.z)); CMPH(bf_lo(hv.w), bf_lo(rv.w)); CMPH(bf_hi(hv.w), bf_hi(rv.w));
#undef CMPH
            } else *(u32x4*)(HM + ((size_t)d * ML + R) * 512 + h * 128 + vh * 64 + sch * 8) = hv; }
#pragma unroll
        for (int t = 0; t < 3; ++t) { cacc[t] = cnew[t]; const int vt = (t == 2) ? 4 : 2 * t + vg;
            if (t < 2 || wid < 4) { u32x2 o; o.x = pk2(cnew[t][0], cnew[t][1]); o.y = pk2(cnew[t][2], cnew[t][3]); *(LAS u32x2*)(lds + CI + (16 * vt + l15) * RS + (16 * it + 4 * kg) * 2) = o; } }
    }
#undef MLSTM_LOADS
    if (DUMMY) atomicAdd((unsigned*)(ws + WS_CTL) + 64, nbad);
    __syncthreads();
}

#ifndef MK_N_LAUNCHES
#define MK_N_LAUNCHES 1
#endif
constexpr int N_PHASES = 12;
constexpr int LDS_BYTES = 147456;
constexpr int RING_BYTES = 131072, MISC_OFF = RING_BYTES + 320;
constexpr int CW_BAR = 4096;

struct Args { const float* in[21]; float* out; unsigned char* ws; int ph_lo, ph_hi; };

__global__ void __launch_bounds__(NTHREADS, 2) hybrid_fwd(Args args) {
    extern __shared__ __attribute__((aligned(16))) unsigned char lds_raw[];
    LAS unsigned char* lds = (LAS unsigned char*)lds_raw;
    const int G = gridDim.x, bx = blockIdx.x;
    const int vcu = (G % 8 == 0) ? (bx % 8) * (G / 8) + bx / 8 : bx;
    typedef const __attribute__((address_space(4))) Args* ArgsP;
    ArgsP AP = (ArgsP)__builtin_amdgcn_kernarg_segment_ptr();
    asm volatile("" : "+s"(AP));
    unsigned char* ws = AP->ws;
#define I_x AP->in[0]
#define I_cvec AP->in[1]
#define I_ctx AP->in[2]
#define I_c_ctx AP->in[3]
#define I_mod_w AP->in[4]
#define I_mod_b AP->in[5]
#define I_pre_w AP->in[6]
#define I_post_w AP->in[7]
#define I_e_w_in AP->in[8]
#define I_e_sink AP->in[9]
#define I_e_conv_w AP->in[10]
#define I_e_w_out AP->in[11]
#define I_o_w_in AP->in[12]
#define I_o_qn AP->in[13]
#define I_o_kvn AP->in[14]
#define I_o_w_uq AP->in[15]
#define I_o_w_ukv AP->in[16]
#define I_o_ib AP->in[17]
#define I_o_fb AP->in[18]
#define I_o_hn AP->in[19]
#define I_o_w_out AP->in[20]
#define I_out AP->out
    float* MOD = (float*)(ws + WS_MOD);

    for (int u = threadIdx.x; u < (LDS_BYTES - RING_BYTES) / 4; u += NTHREADS) ((LAS unsigned*)(lds + RING_BYTES))[u] = 0u;
    __syncthreads();
    XcdBarrier bar; bar.bar = (unsigned*)(ws + WS_CTL) + CW_BAR; bar.x = 0; bar.st = nullptr;
    if (MK_N_LAUNCHES == 1) bar = xcd_barrier_post((unsigned*)(ws + WS_CTL) + CW_BAR, (volatile LAS unsigned*)(lds + MISC_OFF) + 8);
    const int lo = AP->ph_lo, hi = AP->ph_hi;
#ifndef PROBE_REP
#define PROBE_REP 0
#endif
#define NREP(k) ((((PROBE_REP) >> (k)) & 1) ? 2 : 1)
#ifndef PHASE_MASK
#define PHASE_MASK 0xFFF
#endif
#define IN(k) (((PHASE_MASK >> (k)) & 1) && lo <= (k) && (k) < hi)
#ifndef PROBE_DBLBAR
#define PROBE_DBLBAR 0
#endif
#ifndef PROBE_TS
#define PROBE_TS -1
#endif
#define STAMP(k) do { if (PROBE_TS >= 0 && bx == 0 && threadIdx.x == 0) ((unsigned long long*)(ws + WS_CTL + 512 * 1024))[(k)] = __builtin_amdgcn_s_memrealtime(); } while (0)
#define SEAM(k) do { if (MK_N_LAUNCHES == 1 && IN((k) + 1)) { xcd_barrier(bar); if (PROBE_DBLBAR) xcd_barrier(bar); } STAMP((k) + 1); } while (0)
    const int ngw = G * NWAVES;
#define PH_IDS const int tid = my_tid(), lane = tid & 63, wave = __builtin_amdgcn_readfirstlane(tid >> 6), gw = vcu * NWAVES + wave; (void)lane; (void)gw

    STAMP(0);
    if (IN(0)) { asm volatile("" : "+s"(AP)); PH_IDS;
        for (int rep_ = 0; rep_ < NREP(0); ++rep_) { if (rep_) __syncthreads();
        STAMP(20); p0_mod(lds, I_cvec, I_c_ctx, I_mod_w, I_mod_b, MOD, G);
        __syncthreads(); STAMP(21);
        LAS float* scr = (LAS float*)(lds + wave * 16384);
        constexpr int I0 = 16 * (E_N / 32), I1 = 16 * 32;
        { const bool split = (G == 256); const int cw0 = split ? (bx - 192) * NWAVES + wave : gw, ncw = split ? 64 * NWAVES : ngw;
          if (!split || bx >= 192) for (int it = cw0; it < I0 + I1; it += ncw) {
            if (it < I0) p0_transpose_item(I_e_w_in, 1024, E_N, (bf16_t*)(ws + WS_WEIN), 0, nullptr, scr, it, E_N / 32, lane);
            else p0_transpose_item(I_e_w_out, 1024, 1024, (bf16_t*)(ws + WS_WEOUT), 1, nullptr, scr, it - I0, 32, lane); } }
        STAMP(22);
        float* ropeA = (float*)(ws + WS_ROPEA); float* ropeC = (float*)(ws + WS_ROPEC);
        for (int idx = bx * NTHREADS + tid; idx < 2048 * 48; idx += G * NTHREADS) {
            const int pos = idx / 48, j = idx % 48; const float rowf = (float)(pos >> 6), colf = (float)(pos & 63);
            if (j < 32) { const int f = j & 15; const float inv = exp2f(-(float)f * (13.287712379549449f / 16.f)); const float ang = ((j < 16) ? rowf : colf) * inv;
                ropeA[pos * 64 + j] = __cosf(ang); ropeA[pos * 64 + 32 + j] = __sinf(ang); }
            else { const int jj = j - 32, f = jj & 7; const float inv = exp2f(-(float)f * (13.287712379549449f / 8.f)); const float ang = ((jj < 8) ? rowf : colf) * inv;
                ropeC[pos * 32 + jj] = __cosf(ang); ropeC[pos * 32 + 16 + jj] = __sinf(ang); }
        }
        STAMP(23);
        }
        SEAM(0); STAMP(24);
    }
    if (IN(1)) { asm volatile("" : "+s"(AP)); PH_IDS; for (int rep_ = 0; rep_ < NREP(1); ++rep_) { if (rep_) __syncthreads();
        { LAS float* scr = (LAS float*)(lds + wave * 16384);
          constexpr int I2 = 16 * (O_N / 32), I3 = 12 * 24, I4 = 4 * 32, I5 = 16 * 32;
          for (int it = gw; it < I2 + I3 + I4 + I5; it += ngw) { int r = it;
            if (r < I2) { p0_transpose_item(I_o_w_in, 1024, O_NSRC, (bf16_t*)(ws + WS_WOIN), 2, nullptr, scr, r, O_N / 32, lane); continue; } r -= I2;
            if (r < I3) { p0_transpose_item(I_o_w_uq, 768, 768, (bf16_t*)(ws + WS_WUQ), 3, I_o_qn, scr, r, 24, lane); continue; } r -= I3;
            if (r < I4) { p0_transpose_item(I_o_w_ukv, 256, 1024, (bf16_t*)(ws + WS_WUKV), 4, I_o_kvn, scr, r, 32, lane); continue; } r -= I4;
            p0_transpose_item(I_o_w_out, 1024, 1024, (bf16_t*)(ws + WS_WOOUT), 5, nullptr, scr, r, 32, lane); } }
        p1_prenorm(I_x, I_ctx, I_pre_w, MOD, (bf16_t*)(ws + WS_H), gw, ngw, lane); }
        SEAM(1); }
    if (IN(2)) { asm volatile("" : "+s"(AP)); PH_IDS;
        for (int rep_ = 0; rep_ < NREP(2); ++rep_) { if (rep_) __syncthreads();
        pg8::Gemm g{(const bf16_t*)(ws + WS_H), (const bf16_t*)(ws + WS_WEIN), MT, E_N, 1024}; pg8::RectOrder S; S.init(MT / 256, E_N / 256, 0, 0, 0, G, bx);
        EpiEin E{ws}; pg8::gemm_phase<EpiEin, pg8::RectOrder, true, true>(lds, g, S, E);
        }
        SEAM(2);
    }
    if (IN(3)) { asm volatile("" : "+s"(AP)); PH_IDS;
        for (int rep_ = 0; rep_ < NREP(3) + NREP(14) - 1; ++rep_) {
        for (int un = vcu; un < 1024; un += G) attn_unit<0>(lds, ws, nullptr, I_e_sink, un);
        for (int un = bx; un < 128; un += G) attn_unit<1>(lds, ws, nullptr, I_e_sink, un);
        }
        for (int rep_ = 0; rep_ < NREP(3) + NREP(15) - 1; ++rep_) { p3_conv(ws, I_e_conv_w, bx * NTHREADS + tid, G * NTHREADS);
        }
        SEAM(3);
    }
    if (IN(4)) { asm volatile("" : "+s"(AP)); PH_IDS;
        for (int rep_ = 0; rep_ < NREP(4); ++rep_) { if (rep_) __syncthreads();
        pg8::Gemm g{(const bf16_t*)(ws + WS_U), (const bf16_t*)(ws + WS_WEOUT), MT, 1024, 1024}; pg8::RectOrder S; S.init(MT / 256, 4, 0, 0, 0, G, bx);
        EpiY E{(bf16_t*)(ws + WS_Y), (float*)(ws + WS_SSQY0)}; pg8::gemm_phase<EpiY, pg8::RectOrder, true, true>(lds, g, S, E);
        }
        SEAM(4);
    }
    if (IN(5)) { asm volatile("" : "+s"(AP)); PH_IDS; for (int rep_ = 0; rep_ < NREP(5); ++rep_) { if (rep_) __syncthreads();
        p5_post_pre(I_x, I_ctx, I_post_w, I_pre_w + 1024, MOD, (const bf16_t*)(ws + WS_Y), (const float*)(ws + WS_SSQY0), (bf16_t*)(ws + WS_X1), (bf16_t*)(ws + WS_H), gw, ngw, lane); }
        SEAM(5); }
    if (IN(6)) { asm volatile("" : "+s"(AP)); PH_IDS;
        for (int rep_ = 0; rep_ < NREP(6); ++rep_) { if (rep_) __syncthreads();
        pg8::Gemm g{(const bf16_t*)(ws + WS_H), (const bf16_t*)(ws + WS_WOIN), MT, O_N, 1024}; pg8::RectOrder S; S.init(ML / 256, O_N / 256, ML / 256, MC / 256, 5, G, bx);
        EpiOin E{ws, (unsigned char*)I_out}; pg8::gemm_phase<EpiOin, pg8::RectOrder, true, true>(lds, g, S, E);
        }
        SEAM(6);
    }
    if (IN(7)) { asm volatile("" : "+s"(AP)); PH_IDS;
        for (int rep_ = 0; rep_ < NREP(7); ++rep_) { if (rep_) __syncthreads();
        { pg8::Gemm g{(const bf16_t*)(ws + WS_CQ), (const bf16_t*)(ws + WS_WUQ), ML, 768, 768}; pg8::RectOrder S; S.init(ML / 256, 3, 0, 0, 0, G, bx);
          EpiUq E{ws}; pg8::gemm_phase<EpiUq, pg8::RectOrder, true, true>(lds, g, S, E); }
        __syncthreads();
        { pg8::Gemm g{(const bf16_t*)(ws + WS_CKV), (const bf16_t*)(ws + WS_WUKV), MT, 1024, 256}; EpiUkv E{ws};
          if (G == 256) {
              pg8::ListOrder4 S; if (bx < 128) { S.start = bx; S.cnt = 1; } else if (bx < 192) { S.start = 128 + 3 * (bx - 128); S.cnt = 3; } else { S.start = 320 + 4 * (bx - 192); S.cnt = 4; }
              pg8::gemm_phase<EpiUkv, pg8::ListOrder4, true, true>(lds, g, S, E);
          } else { pg8::RectOrder S; S.init(MT / 256, 4, 0, 0, 0, G, G - 1 - bx); pg8::gemm_phase<EpiUkv, pg8::RectOrder, true, true>(lds, g, S, E); } }
        }
        SEAM(7);
    }
    if (IN(8)) { asm volatile("" : "+s"(AP)); PH_IDS;
        for (int rep_ = 0; rep_ < NREP(8) + NREP(12) - 1; ++rep_) { for (int ch = bx; ch < 256; ch += G) { STAMP(30); mlstm_chain_mfma<false>(lds, ws, (unsigned char*)I_out, I_o_ib, I_o_fb, ch); STAMP(31); }
        }
        for (int rep_ = 0; rep_ < NREP(8) + NREP(13) - 1; ++rep_) {
        for (int un = vcu; un < 1024; un += G) attn_unit<2>(lds, ws, (unsigned char*)I_out, nullptr, un);
        }
        STAMP(32); SEAM(8); STAMP(33);
    }
    if (IN(9)) { asm volatile("" : "+s"(AP)); PH_IDS; for (int rep_ = 0; rep_ < NREP(9); ++rep_) { if (rep_) __syncthreads();
        p9_readout(ws, (unsigned char*)I_out, I_o_hn, gw, ngw, lane); }
        SEAM(9); }
    if (IN(10)) { asm volatile("" : "+s"(AP)); PH_IDS;
        for (int rep_ = 0; rep_ < NREP(10); ++rep_) { if (rep_) __syncthreads();
        pg8::Gemm g{(const bf16_t*)(ws + WS_U), (const bf16_t*)(ws + WS_WOOUT), ML, 1024, 1024}; pg8::RectOrder S; S.init(ML / 256, 4, 0, 0, 0, G, bx);
        EpiY E{(bf16_t*)(ws + WS_Y), (float*)(ws + WS_SSQY1)}; pg8::gemm_phase<EpiY, pg8::RectOrder, true, true>(lds, g, S, E);
        }
        SEAM(10);
    }
    if (IN(11)) { asm volatile("" : "+s"(AP)); PH_IDS; p11_final(I_post_w + 1024, MOD, (const bf16_t*)(ws + WS_Y), (const float*)(ws + WS_SSQY1), (const bf16_t*)(ws + WS_X1), I_out, gw, ngw, lane);
        if (PROBE_TS >= 0 && bx == 0 && threadIdx.x == 0) { asm volatile("s_waitcnt vmcnt(0)" ::: "memory"); const unsigned long long* ts = (const unsigned long long*)(ws + WS_CTL + 512 * 1024);
            const unsigned long long t1 = (PROBE_TS == 11) ? __builtin_amdgcn_s_memrealtime() : ts[PROBE_TS + 1]; I_out[5 * 1024 * 7 + 3] += floorf((float)(t1 - ts[PROBE_TS]) * 0.01f * (1.f / 50.f)) * 50.f; } }
#undef IN
#undef SEAM
#undef I_x
#undef I_cvec
#undef I_ctx
#undef I_c_ctx
#undef I_mod_w
#undef I_mod_b
#undef I_pre_w
#undef I_post_w
#undef I_e_w_in
#undef I_e_sink
#undef I_e_conv_w
#undef I_e_w_out
#undef I_o_w_in
#undef I_o_qn
#undef I_o_kvn
#undef I_o_w_uq
#undef I_o_w_ukv
#undef I_o_ib
#undef I_o_fb
#undef I_o_hn
#undef I_o_w_out
#undef I_out
}

extern "C" void kernel_launch(void* const* d_in, const int* in_sizes, int n_in, void* d_out, int out_size, void* d_ws, size_t ws_size, hipStream_t stream) {
    static int grid = 0;
    if (grid == 0) {
        if (n_in != 21 || in_sizes[0] != ML * DM || out_size != ML * DM || ws_size < WS_END) { fprintf(stderr, "kernel_launch: unexpected shapes / workspace (n_in %d, ws %zu < %zu); nothing launched\n", n_in, ws_size, (size_t)WS_END); grid = -1; return; }
        int dev = 0, cus = 0, per_cu = 0;
        if (hipGetDevice(&dev) != hipSuccess || hipDeviceGetAttribute(&cus, hipDeviceAttributeMultiprocessorCount, dev) != hipSuccess) { grid = -1; return; }
        if (hipFuncSetAttribute((const void*)hybrid_fwd, hipFuncAttributeMaxDynamicSharedMemorySize, LDS_BYTES) != hipSuccess) { fprintf(stderr, "kernel_launch: hipFuncSetAttribute failed\n"); grid = -1; return; }
        if (hipOccupancyMaxActiveBlocksPerMultiprocessor(&per_cu, (const void*)hybrid_fwd, NTHREADS, LDS_BYTES) != hipSuccess || per_cu < 1) fprintf(stderr, "kernel_launch: note: occupancy query reports %d workgroups per CU\n", per_cu);
        (void)hipGetLastError();
        grid = cus;
    }
    if (grid < 0) return;
    if (hipMemsetAsync((char*)d_ws + WS_CTL, 0, CTL_ZERO_BYTES, stream) != hipSuccess) { fprintf(stderr, "kernel_launch: hipMemsetAsync failed\n"); return; }
    Args a{};
    for (int i = 0; i < 21; ++i) a.in[i] = (const float*)d_in[i];
    a.out = (float*)d_out; a.ws = (unsigned char*)d_ws;
    if (MK_N_LAUNCHES == 1) { a.ph_lo = 0; a.ph_hi = N_PHASES; hipLaunchKernelGGL(hybrid_fwd, dim3(grid), dim3(NTHREADS), LDS_BYTES, stream, a); }
    else for (int p = 0; p < N_PHASES; ++p) { a.ph_lo = p; a.ph_hi = p + 1; hipLaunchKernelGGL(hybrid_fwd, dim3(grid), dim3(NTHREADS), LDS_BYTES, stream, a); }
    const hipError_t le = hipPeekAtLastError();
    if (le != hipSuccess) fprintf(stderr, "kernel_launch: launch failed: %s\n", hipGetErrorName(le));
}
```

```cpp
#include <hip/hip_runtime.h>
#include <cstdio>
#include <cstdint>

#define LAS __attribute__((address_space(3)))
#define GAS __attribute__((address_space(1)))
typedef unsigned short bf16_t;
typedef short bf16x8 __attribute__((ext_vector_type(8)));
typedef short s16x4 __attribute__((ext_vector_type(4)));
typedef float f32x4 __attribute__((ext_vector_type(4)));
typedef float f32x16 __attribute__((ext_vector_type(16)));
typedef unsigned u32x4 __attribute__((ext_vector_type(4)));
typedef unsigned u32x2 __attribute__((ext_vector_type(2)));
typedef float f32x2_t __attribute__((ext_vector_type(2)));
typedef __bf16 bf16x2_t __attribute__((ext_vector_type(2)));

constexpr int NB = 16, SEQ = 2048, DM = 1024, CL = 256;
constexpr int ML = NB * SEQ, MC = NB * CL, MT = ML + MC;
constexpr float EPS = 1e-6f, LOG2E = 1.4426950408889634f;
constexpr int E_N = 3328, O_NSRC = 3632, O_N = 3840;
constexpr int NWAVES = 8, NTHREADS = 512;

__device__ __forceinline__ float bf_lo(unsigned w) { return __uint_as_float(w << 16); }
__device__ __forceinline__ float bf_hi(unsigned w) { return __uint_as_float(w & 0xffff0000u); }
__device__ __forceinline__ unsigned pk2(float lo, float hi) { f32x2_t v = {lo, hi}; bf16x2_t b = __builtin_convertvector(v, bf16x2_t); return __builtin_bit_cast(unsigned, b); }
__device__ __forceinline__ float silu_f(float x) { return x * __builtin_amdgcn_rcpf(1.f + __expf(-x)); }
__device__ __forceinline__ float sigmoid_f(float x) { return __builtin_amdgcn_rcpf(1.f + __expf(-x)); }
__device__ __forceinline__ float wave_sum(float v) {
#pragma unroll
    for (int o = 1; o < 64; o <<= 1) v += __shfl_xor(v, o);
    return v;
}
#define LDS_WAIT() asm volatile("s_waitcnt lgkmcnt(0)" ::: "memory")
#define VM_WAIT() asm volatile("s_waitcnt vmcnt(0)" ::: "memory")

__device__ __forceinline__ int my_tid() { int t = threadIdx.x; asm volatile("" : "+v"(t)); return t; }

namespace pg8 {
#define PG8_LAS __attribute__((address_space(3)))
typedef unsigned short bf16_t;
typedef short bf16x8 __attribute__((ext_vector_type(8)));
typedef float f32x4 __attribute__((ext_vector_type(4)));
typedef unsigned u32x4 __attribute__((ext_vector_type(4)));
constexpr int BM = 256, BK = 64, HALF = 128, HTB = HALF * BK * 2  , STAGE_BYTES = 8 * HTB, NXCD = 8, WGM = 8;

__host__ __device__ __forceinline__ int lds_byte(int r, int c) { const int st = (r >> 4) * 2 + (c >> 5), rr = r & 15, cc = c & 31, ob = rr * 64 + cc * 2; return st * 1024 + (ob ^ (((ob >> 9) & 1) << 5)); }
__host__ __device__ __forceinline__ void stage_rc(int b, int& R, int& C) { const int st = b / 1024, sb = b % 1024, swz = sb ^ (((sb >> 9) & 1) << 5); R = (st >> 1) * 16 + swz / 64; C = (st & 1) * 32 + (swz % 64) / 2; }
__host__ __device__ __forceinline__ int perm32(int rho) { const int n = rho >> 4, i = rho & 15; return 8 * (i >> 2) + 4 * n + (i & 3); }

struct Unit { int pm, pn; };
struct Gemm { const bf16_t* A; const bf16_t* Bt; int M, N, K; };

struct RectOrder {
    int nM0, nN0, n0, pm1, nM1, nN1, n1, G, c;
    __device__ __forceinline__ void init(int nM0_, int nN0_, int pm1_, int nM1_, int nN1_, int G_, int c_) { nM0 = nM0_; nN0 = nN0_; n0 = nM0_ * nN0_; pm1 = pm1_; nM1 = nM1_; nN1 = nN1_; n1 = nM1_ * nN1_; G = G_; c = c_; }
    __device__ __forceinline__ static void rect(int w, int nM, int nN, int& pm, int& pn) {
        const int nig = WGM * nN, gid = w / nig, fm = gid * WGM, gsz = (nM - fm) < WGM ? (nM - fm) : WGM;
        pm = fm + ((w % nig) % gsz); pn = (w % nig) / gsz;
    }
    __device__ __forceinline__ bool next(int i, Unit& u) const {
        const int nwg = n0 + n1; const long L = (long)i * G + c; if (L >= nwg) return false;
        int wgid = (int)L; { const int q = nwg / NXCD, r = nwg % NXCD, xcd = wgid % NXCD, off = wgid / NXCD; wgid = (xcd < r ? xcd * (q + 1) : r * (q + 1) + (xcd - r) * q) + off; }
        if (wgid < n0) rect(wgid, nM0, nN0, u.pm, u.pn); else { rect(wgid - n0, nM1, nN1, u.pm, u.pn); u.pm += pm1; }
        return true;
    }
    __device__ __forceinline__ void a_ready(const Unit&) const {}
    __device__ __forceinline__ void done(const Unit&) const {}
};

struct ListOrder4 {
    int start, cnt;
    __device__ __forceinline__ bool next(int i, Unit& u) const { if (i >= cnt) return false; const int L = start + i; u.pm = L >> 2; u.pn = L & 3; return true; }
    __device__ __forceinline__ void a_ready(const Unit&) const {}
    __device__ __forceinline__ void done(const Unit&) const {}
};

struct PanelOrder {
    int nM0, nN0, nN1, total, first, step, cnt;
    const unsigned* ready; unsigned need; unsigned* tmo;
    __device__ __forceinline__ bool next(int i, Unit& u) const {
        if (i >= cnt) return false; int L = first + step * i; if (L >= total) return false;
        const int n0 = nM0 * nN0; if (L < n0) { u.pm = L / nN0; u.pn = L - u.pm * nN0; } else { L -= n0; const int q = L / nN1; u.pm = nM0 + q; u.pn = L - q * nN1; }
        return true;
    }
    __device__ __forceinline__ void a_ready(const Unit& u) const {
        if (ready == nullptr) return;
        if (threadIdx.x < 64) {
            const unsigned long long t0 = __builtin_amdgcn_s_memrealtime(); unsigned polls = 0;
            while ((unsigned)__builtin_amdgcn_readfirstlane(__hip_atomic_load(ready + 64 * u.pm, __ATOMIC_RELAXED, __HIP_MEMORY_SCOPE_AGENT)) < need) {
                if ((++polls & 255u) == 0u && __builtin_amdgcn_readfirstlane(__hip_atomic_load(tmo, __ATOMIC_RELAXED, __HIP_MEMORY_SCOPE_AGENT)) != 0u) break;
                if (__builtin_amdgcn_s_memrealtime() - t0 > 2000000ull) { if (threadIdx.x == 0) __hip_atomic_store(tmo, 1u, __ATOMIC_RELAXED, __HIP_MEMORY_SCOPE_AGENT); break; }
                __builtin_amdgcn_s_sleep(2); }
            asm volatile("s_waitcnt vmcnt(0)" ::: "memory");
        }
        asm volatile("" ::: "memory"); __builtin_amdgcn_s_barrier(); asm volatile("" ::: "memory");
    }
    __device__ __forceinline__ void done(const Unit&) const {}
};

template <class Epi, class Sched, bool ALIGN_EPI = false, bool SP2 = false>
__device__ __forceinline__ void gemm_phase(PG8_LAS unsigned char* lds, const Gemm g, const Sched& S, const Epi& E) {
    const int tid = my_tid(), wid = __builtin_amdgcn_readfirstlane(tid >> 6), lane = tid & 63, wr = wid >> 2, wc = wid & 3, fr = lane & 15, fq = lane >> 4;
    const int K = g.K, nt = K / BK;
    unsigned voffA[2], voffB[2];
#pragma unroll
    for (int i = 0; i < 2; ++i) { int R, C; stage_rc(tid * 16 + i * 8192, R, C); const int Rb = Epi::PERM ? ((R & ~31) + perm32(R & 31)) : R;
        voffA[i] = (unsigned)(R * K + C) * 2u; voffB[i] = (unsigned)(Rb * K + C) * 2u; }
    const size_t kstep = (size_t)(BK * 2);
    const size_t hstep = (size_t)HALF * K * 2;
    const size_t tstep = 2 * hstep;
    const unsigned ldsw = (unsigned)wid * 1024u;
    const int aoff = lds_byte(wr * 64 + fr, fq * 8), boff = lds_byte(wc * 32 + fr, fq * 8);
#define PG8_SA(b, h) (((b) * 2 + (h)) * HTB)
#define PG8_SB(b, h) ((4 + (b) * 2 + (h)) * HTB)
#define PG8_STAGE(bufoff, gbase, voff) do { _Pragma("unroll") for (int _i = 0; _i < 2; ++_i) \
        __builtin_amdgcn_global_load_lds((const unsigned*)((const char*)(gbase) + (voff)[_i]), (PG8_LAS unsigned*)(lds + (bufoff) + ldsw + _i * 8192), 16, 0, 0); } while (0)
#define PG8_LDA(dst, b, h) do { _Pragma("unroll") for (int m = 0; m < 4; ++m) _Pragma("unroll") for (int k = 0; k < 2; ++k) dst[m][k] = *(const PG8_LAS bf16x8*)(lds + PG8_SA(b, h) + aoff + m * 2048 + k * 1024); } while (0)
#define PG8_LDB(dst, b, h) do { _Pragma("unroll") for (int n = 0; n < 2; ++n) _Pragma("unroll") for (int k = 0; k < 2; ++k) dst[n][k] = *(const PG8_LAS bf16x8*)(lds + PG8_SB(b, h) + boff + n * 2048 + k * 1024); } while (0)
#define PG8_MMA(ai, bj, At, Bt) do { __builtin_amdgcn_s_setprio(1); _Pragma("unroll") for (int m = 0; m < 4; ++m) _Pragma("unroll") for (int n = 0; n < 2; ++n) _Pragma("unroll") for (int k = 0; k < 2; ++k) \
        acc[ai][bj][m][n] = __builtin_amdgcn_mfma_f32_16x16x32_bf16(Bt[n][k], At[m][k], acc[ai][bj][m][n], 0, 0, 0); __builtin_amdgcn_s_setprio(0); } while (0)
#define PG8_WAIT_V(n) asm volatile("s_waitcnt vmcnt(" #n ")" ::: "memory")
#define PG8_WAIT_L(n) asm volatile("s_waitcnt lgkmcnt(" #n ")" ::: "memory")
#define PG8_BAR __builtin_amdgcn_s_barrier()
#define PG8_SCHED __builtin_amdgcn_sched_barrier(0)
    Unit cur, nxt; int ui = 0;
    if (!S.next(0, cur)) return;
    f32x4 acc[2][2][4][2];
#pragma unroll
    for (int a = 0; a < 2; ++a)
#pragma unroll
        for (int b = 0; b < 2; ++b)
#pragma unroll
            for (int m = 0; m < 4; ++m)
#pragma unroll
                for (int n = 0; n < 2; ++n) acc[a][b][m][n] = (f32x4){0.f, 0.f, 0.f, 0.f};
    bf16x8 At[4][2], B0[2][2], B1[2][2];
    const char* cA = (const char*)g.A + (size_t)cur.pm * tstep; const char* cB = (const char*)g.Bt + (size_t)cur.pn * tstep;
    S.a_ready(cur);
    if constexpr (SP2) {
        PG8_STAGE(PG8_SB(0, 0), cB, voffB); PG8_STAGE(PG8_SB(0, 1), cB + hstep, voffB); PG8_STAGE(PG8_SA(0, 0), cA, voffA); PG8_STAGE(PG8_SA(0, 1), cA + hstep, voffA);
        if (wr == 1) PG8_BAR;
        PG8_WAIT_V(2); PG8_BAR;
        PG8_STAGE(PG8_SB(1, 0), cB + kstep, voffB); PG8_STAGE(PG8_SA(1, 0), cA + kstep, voffA); PG8_STAGE(PG8_SB(1, 1), cB + hstep + kstep, voffB);
        PG8_WAIT_V(6); PG8_BAR;
    } else {
        PG8_STAGE(PG8_SB(0, 0), cB, voffB); PG8_STAGE(PG8_SA(0, 0), cA, voffA); PG8_STAGE(PG8_SB(0, 1), cB + hstep, voffB); PG8_STAGE(PG8_SA(0, 1), cA + hstep, voffA);
        if (wr == 1) PG8_BAR;
        PG8_WAIT_V(4); PG8_BAR;
        PG8_STAGE(PG8_SB(1, 0), cB + kstep, voffB); PG8_STAGE(PG8_SA(1, 0), cA + kstep, voffA); PG8_STAGE(PG8_SB(1, 1), cB + hstep + kstep, voffB);
        PG8_WAIT_V(6); PG8_BAR;
    }
    for (;;) {
        const bool has_next = S.next(ui + 1, nxt);
        const char* nA = has_next ? (const char*)g.A + (size_t)nxt.pm * tstep : cA; const char* nB = has_next ? (const char*)g.Bt + (size_t)nxt.pn * tstep : cB;
        for (int t = 0; t < nt; t += 2) {
            const bool last = (t == nt - 2);
            const char* a1 = cA + (size_t)(t + 1) * kstep;
            const char* a2 = last ? nA : cA + (size_t)(t + 2) * kstep; const char* b2 = last ? nB : cB + (size_t)(t + 2) * kstep;
            const char* a3 = a2 + kstep; const char* b3 = b2 + kstep;
            if (last && has_next) S.a_ready(nxt);
            if constexpr (SP2) {
            PG8_LDB(B0, 0, 0); PG8_LDB(B1, 0, 1); PG8_SCHED; PG8_LDA(At, 0, 0); PG8_STAGE(PG8_SA(1, 1), a1 + hstep, voffA);
            PG8_WAIT_V(8); PG8_WAIT_L(0); PG8_BAR; PG8_MMA(0, 0, At, B0); PG8_MMA(0, 1, At, B1); PG8_BAR; PG8_SCHED;
            PG8_LDA(At, 0, 1); PG8_STAGE(PG8_SB(0, 0), b2, voffB); PG8_STAGE(PG8_SB(0, 1), b2 + hstep, voffB); PG8_STAGE(PG8_SA(0, 0), a2, voffA);
            PG8_WAIT_V(8); PG8_WAIT_L(0); PG8_BAR; PG8_MMA(1, 0, At, B0); PG8_MMA(1, 1, At, B1); PG8_BAR; PG8_SCHED;
            PG8_LDB(B0, 1, 0); PG8_LDB(B1, 1, 1); PG8_SCHED; PG8_LDA(At, 1, 0); PG8_STAGE(PG8_SA(0, 1), a2 + hstep, voffA);
            PG8_WAIT_V(8); PG8_WAIT_L(0); PG8_BAR; PG8_MMA(0, 0, At, B0); PG8_MMA(0, 1, At, B1); PG8_BAR; PG8_SCHED;
            PG8_LDA(At, 1, 1); PG8_STAGE(PG8_SB(1, 0), b3, voffB); PG8_STAGE(PG8_SB(1, 1), b3 + hstep, voffB); PG8_STAGE(PG8_SA(1, 0), a3, voffA);
            PG8_WAIT_V(8); PG8_WAIT_L(0); PG8_BAR; PG8_MMA(1, 0, At, B0); PG8_MMA(1, 1, At, B1); PG8_BAR; PG8_SCHED;
            } else {
            PG8_LDB(B0, 0, 0); PG8_SCHED; PG8_LDA(At, 0, 0); PG8_STAGE(PG8_SA(1, 1), a1 + hstep, voffA);
            PG8_WAIT_L(8); PG8_BAR; PG8_WAIT_L(0); PG8_MMA(0, 0, At, B0); PG8_BAR; PG8_SCHED;
            PG8_LDB(B1, 0, 1); PG8_STAGE(PG8_SB(0, 0), b2, voffB);
            PG8_BAR; PG8_WAIT_L(0); PG8_MMA(0, 1, At, B1); PG8_BAR;
            PG8_LDA(At, 0, 1); PG8_STAGE(PG8_SA(0, 0), a2, voffA);
            PG8_BAR; PG8_WAIT_L(0); PG8_MMA(1, 0, At, B0); PG8_BAR; PG8_SCHED;
            PG8_STAGE(PG8_SB(0, 1), b2 + hstep, voffB);
            PG8_WAIT_V(6); PG8_BAR; PG8_MMA(1, 1, At, B1); PG8_BAR;
            PG8_LDB(B0, 1, 0); PG8_SCHED; PG8_LDA(At, 1, 0); PG8_STAGE(PG8_SA(0, 1), a2 + hstep, voffA);
            PG8_WAIT_L(8); PG8_BAR; PG8_WAIT_L(0); PG8_MMA(0, 0, At, B0); PG8_BAR; PG8_SCHED;
            PG8_LDB(B1, 1, 1); PG8_STAGE(PG8_SB(1, 0), b3, voffB);
            PG8_BAR; PG8_WAIT_L(0); PG8_MMA(0, 1, At, B1); PG8_BAR;
            PG8_LDA(At, 1, 1); PG8_STAGE(PG8_SA(1, 0), a3, voffA);
            PG8_BAR; PG8_WAIT_L(0); PG8_MMA(1, 0, At, B0); PG8_BAR; PG8_SCHED;
            PG8_STAGE(PG8_SB(1, 1), b3 + hstep, voffB);
            PG8_WAIT_V(6); PG8_BAR; PG8_MMA(1, 1, At, B1); PG8_BAR;
            }
        }
        if constexpr (ALIGN_EPI) { if (wr == 0) PG8_BAR; }
        if constexpr (!Epi::AFTER_DRAIN) { E(acc, cur, wr, wc, fr, fq); S.done(cur); }
        if (!has_next) break;
#pragma unroll
        for (int a = 0; a < 2; ++a)
#pragma unroll
            for (int b = 0; b < 2; ++b)
#pragma unroll
                for (int m = 0; m < 4; ++m)
#pragma unroll
                    for (int n = 0; n < 2; ++n) acc[a][b][m][n] = (f32x4){0.f, 0.f, 0.f, 0.f};
        cur = nxt; cA = nA; cB = nB; ++ui;
        if constexpr (ALIGN_EPI) { if (wr == 1) PG8_BAR; }
    }
    PG8_WAIT_V(0);
    if constexpr (!ALIGN_EPI) { if (wr == 0) PG8_BAR; }
    PG8_BAR;
    if constexpr (Epi::AFTER_DRAIN) { E.fused(acc, cur, wr, wc, fr, fq, lds, wid, lane); S.done(cur); }
#undef PG8_SA
#undef PG8_SB
#undef PG8_STAGE
#undef PG8_LDA
#undef PG8_LDB
#undef PG8_MMA
#undef PG8_WAIT_V
#undef PG8_WAIT_L
#undef PG8_BAR
#undef PG8_SCHED
}
}

constexpr size_t MiB = 1u << 20;
constexpr size_t WS_CTL = 0, CTL_ZERO_BYTES = 128 * 1024;
constexpr int CW_PANEL = 8192, PANEL_BANK = 144 * 64;
constexpr size_t WS_MOD = 1 * MiB;
constexpr size_t WS_ROPEA = 2 * MiB;
constexpr size_t WS_ROPEC = 2 * MiB + 512 * 1024;
constexpr size_t WS_WEIN = 3 * MiB, WS_WEOUT = 10 * MiB, WS_WOIN = 12 * MiB, WS_WUQ = 20 * MiB, WS_WUKV = 21 * MiB + 512 * 1024, WS_WOOUT = 22 * MiB;
constexpr size_t WS_H = 24 * MiB;
constexpr size_t WS_U = 96 * MiB;
constexpr size_t WS_Y = 168 * MiB;
constexpr size_t WS_R = 240 * MiB;
constexpr size_t WS_KVE = WS_R  , WS_QE = WS_R + 18 * MiB, WS_PE = WS_R + 54 * MiB, WS_GE = WS_R + 90 * MiB, WS_ZA = WS_R + 126 * MiB, WS_SSQY0 = WS_R + 241 * MiB  ;
constexpr size_t WS_CKV = WS_R, WS_CQ = WS_R + 18 * MiB, WS_HM = WS_R  , WS_MK = WS_R + 66 * MiB, WS_MV = WS_R + 84 * MiB, WS_KR = WS_R + 120 * MiB, WS_GATES = WS_R + 123 * MiB,
                 WS_SSQCKV = WS_R + 126 * MiB, WS_SSQCQ = WS_R + 127 * MiB, WS_X1 = WS_R + 129 * MiB  , WS_SSQY1 = WS_R + 241 * MiB;
constexpr size_t AUX_MQ = 0, AUX_MO = 16 * MiB, AUX_ZO = 48 * MiB;
constexpr size_t WS_KNV = WS_H  , WS_QO = WS_Y;
constexpr size_t WS_END = WS_R + 244 * MiB;
static_assert(WS_ZA + (size_t)MT * 512 * 2 <= WS_R + 162 * MiB && WS_X1 + (size_t)ML * 1024 * 2 <= WS_R + 241 * MiB && WS_HM + (size_t)2 * ML * 512 * 2 <= WS_MK && WS_SSQY1 + (size_t)MT * 16 * 4 <= WS_END, "ws map");

__device__ __forceinline__ void st8(bf16_t* p, f32x4 a, f32x4 b) { u32x4 w; w.x = pk2(a[0], a[1]); w.y = pk2(a[2], a[3]); w.z = pk2(b[0], b[1]); w.w = pk2(b[2], b[3]); *(u32x4*)p = w; }
__device__ __forceinline__ bf16_t f2bf(float v) { return (bf16_t)(pk2(v, 0.f) & 0xffffu); }
__device__ __forceinline__ void rope8(f32x4& a, f32x4& b, const float* cosp, const float* sinp) {
    const f32x4 cs = *(const f32x4*)cosp, sn = *(const f32x4*)sinp;
    const float a0 = a[0] * cs[0] - a[1] * sn[0], a1 = a[0] * sn[0] + a[1] * cs[0], a2 = a[2] * cs[1] - a[3] * sn[1], a3 = a[2] * sn[1] + a[3] * cs[1];
    const float b0 = b[0] * cs[2] - b[1] * sn[2], b1 = b[0] * sn[2] + b[1] * cs[2], b2 = b[2] * cs[3] - b[3] * sn[3], b3 = b[2] * sn[3] + b[3] * cs[3];
    a = (f32x4){a0, a1, a2, a3}; b = (f32x4){b0, b1, b2, b3};
}
__device__ __forceinline__ f32x4 silu4(f32x4 v) { return (f32x4){silu_f(v[0]), silu_f(v[1]), silu_f(v[2]), silu_f(v[3])}; }
__device__ __forceinline__ f32x4 sigm4(f32x4 v) { return (f32x4){sigmoid_f(v[0]), sigmoid_f(v[1]), sigmoid_f(v[2]), sigmoid_f(v[3])}; }
__device__ __forceinline__ float sq4(f32x4 v) { return (v[0] * v[0] + v[1] * v[1]) + (v[2] * v[2] + v[3] * v[3]); }

struct EpiEin {
    static constexpr bool PERM = true, AFTER_DRAIN = false;
    unsigned char* ws;
    __device__ __forceinline__ void operator()(const f32x4 (&acc)[2][2][4][2], const pg8::Unit& u, int wr, int wc, int fr, int fq) const {
        const int pn = u.pn, rbase = u.pm * 256 + wr * 64 + fr, cw = wc * 32 + 8 * fq;
        const float* ropeA = (const float*)(ws + WS_ROPEA);
#pragma unroll
        for (int ai = 0; ai < 2; ++ai)
#pragma unroll
            for (int m = 0; m < 4; ++m) {
                asm volatile("" ::: "memory"); const int R = rbase + ai * 128 + m * 16; const bool lat = R < ML; const int pos = R & 2047;
                if (pn == 0) {
                    f32x4 a = acc[ai][0][m][0], b = acc[ai][0][m][1];
                    if (lat) { const int i0 = (cw & 63) >> 1; rope8(a, b, ropeA + pos * 64 + i0, ropeA + pos * 64 + 32 + i0); }
                    st8((bf16_t*)(ws + WS_KVE) + (size_t)R * 256 + cw, a, b);
                    st8((bf16_t*)(ws + WS_KVE) + (size_t)R * 256 + 128 + cw, acc[ai][1][m][0], acc[ai][1][m][1]);
                } else if (pn <= 2) {
#pragma unroll
                    for (int bj = 0; bj < 2; ++bj) {
                        f32x4 a = acc[ai][bj][m][0], b = acc[ai][bj][m][1];
                        if (lat) { const int i0 = (cw & 63) >> 1; rope8(a, b, ropeA + pos * 64 + i0, ropeA + pos * 64 + 32 + i0); }
                        const float sc = 0.125f * LOG2E; a = a * sc; b = b * sc;
                        st8((bf16_t*)(ws + WS_QE) + (size_t)R * 512 + (pn - 1) * 256 + bj * 128 + cw, a, b);
                    }
                } else if (pn <= 6) {
                    st8((bf16_t*)(ws + WS_PE) + (size_t)R * 512 + (pn - 3) * 128 + cw, acc[ai][0][m][0] * acc[ai][1][m][0], acc[ai][0][m][1] * acc[ai][1][m][1]);
                } else if (pn <= 10) {
                    st8((bf16_t*)(ws + WS_GE) + (size_t)R * 512 + (pn - 7) * 128 + cw, acc[ai][0][m][0] * silu4(acc[ai][1][m][0]), acc[ai][0][m][1] * silu4(acc[ai][1][m][1]));
                } else {
#pragma unroll
                    for (int bj = 0; bj < 2; ++bj)
                        st8((bf16_t*)(ws + WS_ZA) + (size_t)R * 512 + (pn - 11) * 256 + bj * 128 + cw, silu4(acc[ai][bj][m][0]), silu4(acc[ai][bj][m][1]));
                }
            }
    }
};

struct EpiY {
    static constexpr bool PERM = true, AFTER_DRAIN = false;
    bf16_t* Y; float* SSQ;
    __device__ __forceinline__ void operator()(const f32x4 (&acc)[2][2][4][2], const pg8::Unit& u, int wr, int wc, int fr, int fq) const {
        const int pn = u.pn, rbase = u.pm * 256 + wr * 64 + fr, cw = wc * 32 + 8 * fq;
#pragma unroll
        for (int ai = 0; ai < 2; ++ai)
#pragma unroll
            for (int m = 0; m < 4; ++m) {
                asm volatile("" ::: "memory"); const int R = rbase + ai * 128 + m * 16; float s = 0.f;
#pragma unroll
                for (int bj = 0; bj < 2; ++bj) { st8(Y + (size_t)R * 1024 + pn * 256 + bj * 128 + cw, acc[ai][bj][m][0], acc[ai][bj][m][1]); s += sq4(acc[ai][bj][m][0]) + sq4(acc[ai][bj][m][1]); }
                s += __shfl_xor(s, 16); s += __shfl_xor(s, 32);
                if (fq == 0) SSQ[(size_t)R * 16 + pn * 4 + wc] = s;
            }
    }
};

struct EpiOin {
    static constexpr bool PERM = true, AFTER_DRAIN = false;
    unsigned char* ws; unsigned char* aux;
    __device__ __forceinline__ void operator()(const f32x4 (&acc)[2][2][4][2], const pg8::Unit& u, int wr, int wc, int fr, int fq) const {
        const int pn = u.pn, rbase = u.pm * 256 + wr * 64 + fr, cw = wc * 32 + 8 * fq;
        const float* ropeC = (const float*)(ws + WS_ROPEC);
#pragma unroll
        for (int ai = 0; ai < 2; ++ai)
#pragma unroll
            for (int m = 0; m < 4; ++m) {
                asm volatile("" ::: "memory"); const int R = rbase + ai * 128 + m * 16; const bool lat = R < ML; const int pos = R & 2047;
                if (pn == 0 || (pn >= 5 && pn <= 7)) {
                    float s = 0.f;
                    bf16_t* dst = (pn == 0) ? (bf16_t*)(ws + WS_CKV) + (size_t)R * 256 : (bf16_t*)(ws + WS_CQ) + (size_t)R * 768 + (pn - 5) * 256;
#pragma unroll
                    for (int bj = 0; bj < 2; ++bj) { st8(dst + bj * 128 + cw, acc[ai][bj][m][0], acc[ai][bj][m][1]); s += sq4(acc[ai][bj][m][0]) + sq4(acc[ai][bj][m][1]); }
                    s += __shfl_xor(s, 16); s += __shfl_xor(s, 32);
                    if (fq == 0) { if (pn == 0) ((float*)(ws + WS_SSQCKV))[(size_t)R * 4 + wc] = s; else ((float*)(ws + WS_SSQCQ))[(size_t)R * 12 + (pn - 5) * 4 + wc] = s; }
                } else if (pn == 4) {
                    if (wc == 0) {
                        f32x4 a = acc[ai][0][m][0], b = acc[ai][0][m][1];
                        if (lat) { const int i0 = cw >> 1; rope8(a, b, ropeC + pos * 32 + i0, ropeC + pos * 32 + 16 + i0); }
                        st8((bf16_t*)(ws + WS_KR) + (size_t)R * 32 + cw, a, b);
                    } else if (wc == 1 && fq < 2) {
                        float* g = (float*)(ws + WS_GATES) + (size_t)R * 16 + 8 * fq;
                        *(f32x4*)g = acc[ai][0][m][0]; *(f32x4*)(g + 4) = acc[ai][0][m][1];
                    }
                } else {
#pragma unroll
                    for (int bj = 0; bj < 2; ++bj) {
                        const f32x4 a = acc[ai][bj][m][0], b = acc[ai][bj][m][1]; const int col = bj * 128 + cw;
                        if (pn == 1) st8((bf16_t*)(ws + WS_MK) + (size_t)R * 256 + col, a * 0.125f, b * 0.125f);
                        else if (pn <= 3) st8((bf16_t*)(ws + WS_MV) + (size_t)R * 512 + (pn - 2) * 256 + col, a, b);
                        else if (pn == 8) st8((bf16_t*)(aux + AUX_MQ) + (size_t)R * 256 + col, a, b);
                        else if (pn >= 13) st8((bf16_t*)(aux + AUX_ZO) + (size_t)R * 512 + (pn - 13) * 256 + col, silu4(a), silu4(b));
                        else if (bj == 0) st8((bf16_t*)(aux + AUX_MO) + (size_t)R * 512 + (pn - 9) * 128 + cw, sigm4(a) * silu4(acc[ai][1][m][0]), sigm4(b) * silu4(acc[ai][1][m][1]));
                    }
                }
            }
    }
};

struct EpiUkv {
    static constexpr bool PERM = true, AFTER_DRAIN = false;
    unsigned char* ws;
    __device__ __forceinline__ void operator()(const f32x4 (&acc)[2][2][4][2], const pg8::Unit& u, int wr, int wc, int fr, int fq) const {
        const int pn = u.pn, rbase = u.pm * 256 + wr * 64 + fr, cw = wc * 32 + 8 * fq;
#pragma unroll
        for (int ai = 0; ai < 2; ++ai)
#pragma unroll
            for (int m = 0; m < 4; ++m) {
                asm volatile("" ::: "memory"); const int R = rbase + ai * 128 + m * 16;
                const f32x4 sp = *(const f32x4*)((const float*)(ws + WS_SSQCKV) + (size_t)R * 4);
                const float rstd = rsqrtf(((sp[0] + sp[1]) + (sp[2] + sp[3])) * (1.f / 256.f) + EPS);
                int b, pos; if (R < ML) { b = R >> 11; pos = 256 + (R & 2047); } else { const int rc = R - ML; b = rc >> 8; pos = rc & 255; }
#pragma unroll
                for (int bj = 0; bj < 2; ++bj) {
                    const int head = pn * 2 + bj;
                    st8((bf16_t*)(ws + WS_KNV) + ((size_t)(b * 8 + head) * 2304 + pos) * 128 + cw, acc[ai][bj][m][0] * rstd, acc[ai][bj][m][1] * rstd);
                }
            }
    }
};

struct EpiUq {
    static constexpr bool PERM = true, AFTER_DRAIN = false;
    unsigned char* ws;
    __device__ __forceinline__ void operator()(const f32x4 (&acc)[2][2][4][2], const pg8::Unit& u, int wr, int wc, int fr, int fq) const {
        const int pn = u.pn, rbase = u.pm * 256 + wr * 64 + fr, cw = wc * 32 + 8 * fq;
        const float* ropeC = (const float*)(ws + WS_ROPEC);
#pragma unroll
        for (int ai = 0; ai < 2; ++ai)
#pragma unroll
            for (int m = 0; m < 4; ++m) {
                asm volatile("" ::: "memory"); const int R = rbase + ai * 128 + m * 16, pos = R & 2047;
                const float* sp = (const float*)(ws + WS_SSQCQ) + (size_t)R * 12;
                const f32x4 s0 = *(const f32x4*)sp, s1 = *(const f32x4*)(sp + 4), s2 = *(const f32x4*)(sp + 8);
                const float ss = (((s0[0] + s0[1]) + (s0[2] + s0[3])) + ((s1[0] + s1[1]) + (s1[2] + s1[3]))) + ((s2[0] + s2[1]) + (s2[2] + s2[3]));
                const float sc = rsqrtf(ss * (1.f / 768.f) + EPS) * (0.10206207261596575f * LOG2E);
#pragma unroll
                for (int bj = 0; bj < 2; ++bj) {
                    const int c = pn * 256 + bj * 128 + cw, head = c / 96, dd = c - head * 96;
                    f32x4 a = acc[ai][bj][m][0], b = acc[ai][bj][m][1];
                    if (dd >= 64) { const int i0 = (dd - 64) >> 1; rope8(a, b, ropeC + pos * 32 + i0, ropeC + pos * 32 + 16 + i0); }
                    st8((bf16_t*)(ws + WS_QO) + (size_t)R * 768 + c, a * sc, b * sc);
                }
            }
    }
};

#define RLX_AGENT __ATOMIC_RELAXED, __HIP_MEMORY_SCOPE_AGENT
#define XB_TMO      128
#define XB_XCNT(j)  (256  + 64 * (j))
#define XB_XSUB(j)  (1280 + 64 * (j))
#define XB_XGEN(j)  (2304 + 64 * (j))
#define XB_TOP      3328
#define XB_TOPGEN   3392
#define XCD_BAR_WORDS 3456
#define XB_SPIN_CAP (1u << 18)

__device__ __forceinline__ unsigned xb_ld(unsigned* p)              { return __hip_atomic_load(p, __ATOMIC_RELAXED, __HIP_MEMORY_SCOPE_AGENT); }
__device__ __forceinline__ unsigned xb_add(unsigned* p, unsigned v) { return __hip_atomic_fetch_add(p, v, __ATOMIC_RELAXED, __HIP_MEMORY_SCOPE_AGENT); }
__device__ __forceinline__ unsigned xb_xcc_id() { return (unsigned)__builtin_amdgcn_s_getreg((3 << 11) | 20) & 0xFu; }
#define XB_SPIN(cond, bar) do { unsigned _sp = 0; while (cond) { __builtin_amdgcn_s_sleep(1); \
    if ((++_sp & 255u) == 0u) { if (xb_ld(&(bar)[XB_TMO])) break; if (_sp > XB_SPIN_CAP) { atomicAdd(&(bar)[XB_TMO], 1u); break; } } } } while (0)

struct XcdBarrier {
    unsigned* bar; unsigned x;
    volatile LAS unsigned* st;
};

__device__ __forceinline__ XcdBarrier xcd_barrier_post(unsigned* bar, volatile LAS unsigned* st) {
    XcdBarrier b; b.bar = bar; b.x = xb_xcc_id(); b.st = st;
    if (threadIdx.x == 0) (void)xb_add(&bar[XB_XCNT(b.x)], 1u);
    return b;
}
__device__ __forceinline__ void xcd_barrier_complete(unsigned* bar, unsigned x, unsigned& nloc, unsigned& nx) {
    const unsigned G = gridDim.x * gridDim.y * gridDim.z;
    unsigned sum, cnt, mine, sp = 0u;
    for (;;) {
        sum = 0u; cnt = 0u; mine = 0u;
#pragma unroll
        for (unsigned j = 0; j < 16; ++j) { const unsigned c = xb_ld(&bar[XB_XCNT(j)]); sum += c; cnt += (c > 0u) ? 1u : 0u; mine = (j == x) ? c : mine; }
        if (sum == G) break;
        __builtin_amdgcn_s_sleep(1);
        if ((++sp & 255u) == 0u) { if (xb_ld(&bar[XB_TMO])) break; if (sp > XB_SPIN_CAP) { atomicAdd(&bar[XB_TMO], 1u); break; } }
    }
    nloc = mine > 0u ? mine : 1u; nx = cnt > 0u ? cnt : 1u;
}

__device__ __forceinline__ void xcd_barrier(const XcdBarrier& b) {
    asm volatile("s_waitcnt vmcnt(0)" ::: "memory");
    __syncthreads();
    if (threadIdx.x == 0) {
        unsigned* bar = b.bar;
        __builtin_amdgcn_s_waitcnt(0);
        unsigned nloc = b.st[0], nx = b.st[1];
        if (nloc == 0u) { xcd_barrier_complete(bar, b.x, nloc, nx); b.st[0] = nloc; b.st[1] = nx; }
        const unsigned old = xb_add(&bar[XB_XSUB(b.x)], 1u);
        asm volatile("buffer_inv sc1" ::: "memory");
        const unsigned gen = old / nloc;
        if (old + 1u == (gen + 1u) * nloc) {
            __builtin_amdgcn_fence(__ATOMIC_RELEASE, "agent");
            asm volatile("s_waitcnt vmcnt(0)" ::: "memory");
            (void)xb_add(&bar[XB_TOP], 1u);
        }
        const unsigned target = (gen + 1u) * nx;
        XB_SPIN((int)(xb_ld(&bar[XB_TOP]) - target) < 0, bar);
        asm volatile("s_waitcnt vmcnt(0)" ::: "memory");
    }
    __syncthreads();
}

__device__ __forceinline__ int crow(int r, int hi) { return (r & 3) + 8 * (r >> 2) + 4 * hi; }
typedef short v4i16_t __attribute__((ext_vector_type(4)));
__device__ __forceinline__ s16x4 vtr(const LAS unsigned char* p) { return __builtin_bit_cast(s16x4, __builtin_amdgcn_ds_read_tr16_b64_v4i16((LAS v4i16_t*)p)); }

template <int MODE>
__device__ __forceinline__ void attn_unit(LAS unsigned char* lds, unsigned char* ws, unsigned char* aux, const float* sink, int unit) {
    constexpr int DQK = (MODE == 2) ? 96 : 64, KST = DQK / 16, KS = DQK * 2 + 16, VS = 192, KBUF = 64 * KS, VBUF = 64 * VS;
    const int tid = my_tid(), lane = tid & 63, wid = __builtin_amdgcn_readfirstlane(tid >> 6), r32 = lane & 31, hi = lane >> 5;
    int b, head, hkv = 0, n = 0, Rq0, qpos0 = 0, nt, jlo = 0;
    const bf16_t* Qp; int qstride;
    if (MODE == 0) {
        const int hp = unit & 1; n = (unit >> 1) & 15; hkv = (unit >> 5) & 1; b = unit >> 6;
        head = hkv * 4 + hp * 2 + (wid >> 2); qpos0 = 128 * n + 32 * (wid & 3); Rq0 = b * 2048 + qpos0;
        Qp = (const bf16_t*)(ws + WS_QE) + (size_t)Rq0 * 512 + head * 64; qstride = 512;
        jlo = (n == 0) ? 2 : 0; const int jhi = (n == 15) ? 4 : 6; nt = 4 + (jhi - jlo);
    } else if (MODE == 1) {
        const int qh = unit & 1, hp = (unit >> 1) & 1; hkv = (unit >> 2) & 1; b = unit >> 3;
        head = hkv * 4 + hp * 2 + (wid >> 2); Rq0 = ML + b * 256 + 128 * qh + 32 * (wid & 3);
        Qp = (const bf16_t*)(ws + WS_QE) + (size_t)Rq0 * 512 + head * 64; qstride = 512; nt = 4;
    } else {
        const int qb = unit & 7; head = (unit >> 3) & 7; b = unit >> 6; Rq0 = b * 2048 + 256 * qb + 32 * wid;
        Qp = (const bf16_t*)(ws + WS_QO) + (size_t)Rq0 * 768 + head * 96; qstride = 768; nt = 36;
    }
    bf16x8 qf[KST];
#pragma unroll
    for (int s = 0; s < KST; ++s) qf[s] = *(const bf16x8*)(Qp + (size_t)r32 * qstride + 16 * s + 8 * hi);
    constexpr float THR = 6.0f;
    float mref, l_run;
    if (MODE == 2) { mref = 0.f; l_run = 0.f; } else { mref = sink[head] * LOG2E; l_run = (hi == 0) ? 1.f : 0.f; }
    f32x16 negm;
#pragma unroll
    for (int r = 0; r < 16; ++r) negm[r] = -mref;
    f32x16 o0, o1;
#pragma unroll
    for (int r = 0; r < 16; ++r) { o0[r] = 0.f; o1[r] = 0.f; }

    const int srow = tid >> 3, sch = tid & 7;
    const int voff = (4 * hi + ((lane & 15) >> 2)) * VS + (((lane >> 4) & 1) * 16 + 4 * (lane & 3)) * 2;
    u32x4 kregA, vregA, kreg2A, kregB, vregB, kreg2B;
    kreg2A = (u32x4){0u, 0u, 0u, 0u}; kreg2B = kreg2A;
#define ATT_SRC(t, kp, vp, k2p, kpos0v) do { \
        if (MODE == 0 || MODE == 1) { \
            if ((t) < 4) { kp = (const bf16_t*)(ws + WS_KVE) + (size_t)(ML + b * 256 + 64 * (t) + srow) * 256 + hkv * 64 + sch * 8; kpos0v = -100000; } \
            else { const int kp0_ = 128 * n - 128 + 64 * (jlo + (t) - 4); kpos0v = kp0_; \
                   kp = (const bf16_t*)(ws + WS_KVE) + (size_t)(b * 2048 + kp0_ + srow) * 256 + hkv * 64 + sch * 8; } \
            vp = kp + 128; k2p = kp; \
        } else { \
            const int pos0_ = 64 * (t); kpos0v = -100000; \
            kp = (const bf16_t*)(ws + WS_KNV) + ((size_t)(b * 8 + head) * 2304 + pos0_ + srow) * 128 + sch * 8; \
            vp = kp + 64; \
            const int krow_ = ((t) < 4) ? (ML + b * 256 + pos0_) : (b * 2048 + pos0_ - 256); \
            k2p = (const bf16_t*)(ws + WS_KR) + (size_t)(krow_ + (tid >> 2)) * 32 + (tid & 3) * 8; \
        } } while (0)
#define ATT_LOAD(t, KR_, VR_, K2_) do { const bf16_t *kp_, *vp_, *k2p_; int kq_; ATT_SRC(t, kp_, vp_, k2p_, kq_); (void)kq_; \
        KR_ = *(const u32x4*)kp_; VR_ = *(const u32x4*)vp_; if (MODE == 2 && tid < 256) K2_ = *(const u32x4*)k2p_; } while (0)
#define ATT_STORE(buf, KR_, VR_, K2_) do { LAS unsigned char* kb_ = lds + (buf) * KBUF; LAS unsigned char* vb_ = lds + 4 * KBUF + (buf) * VBUF; \
        *(LAS u32x4*)(kb_ + srow * KS + sch * 16) = KR_; \
        if (MODE == 2 && tid < 256) *(LAS u32x4*)(kb_ + (tid >> 2) * KS + 128 + (tid & 3) * 16) = K2_; \
        *(LAS u32x4*)(vb_ + srow * VS + sch * 16) = VR_; } while (0)
#define ATT_BARRIER() do { asm volatile("s_waitcnt lgkmcnt(0)" ::: "memory"); __builtin_amdgcn_s_barrier(); asm volatile("" ::: "memory"); } while (0)

#define ATT_COMPUTE(TT) do { const int buf = (TT) & 3; \
        int kpos0 = -100000; \
        if (MODE == 0 && (TT) >= 4) kpos0 = 128 * n - 128 + 64 * (jlo + (TT) - 4); \
        bool active = true; \
        if (MODE == 0 && (TT) >= 4) active = (kpos0 + 63 >= qpos0 - 128) && (kpos0 <= qpos0 + 31 + 128); \
        if (active) { \
            const LAS unsigned char* kb = lds + buf * KBUF; const LAS unsigned char* vb = lds + 4 * KBUF + buf * VBUF; \
            f32x16 p0 = negm, p1 = negm; \
_Pragma("unroll") \
            for (int s = 0; s < KST; ++s) { \
                const bf16x8 a0 = *(const LAS bf16x8*)(kb + r32 * KS + (16 * s + 8 * hi) * 2); \
                const bf16x8 a1 = *(const LAS bf16x8*)(kb + (32 + r32) * KS + (16 * s + 8 * hi) * 2); \
                p0 = __builtin_amdgcn_mfma_f32_32x32x16_bf16(a0, qf[s], p0, 0, 0, 0); \
                p1 = __builtin_amdgcn_mfma_f32_32x32x16_bf16(a1, qf[s], p1, 0, 0, 0); \
            } \
            if (MODE == 0 && (TT) >= 4 && !((kpos0 >= qpos0 - 97) && (kpos0 <= qpos0 + 65))) {     \
                const int qpos = qpos0 + r32; \
_Pragma("unroll") \
                for (int r = 0; r < 16; ++r) { const int d0 = kpos0 + crow(r, hi) - qpos, d1 = d0 + 32; \
                    if (d0 > 128 || d0 < -128) p0[r] = -INFINITY; if (d1 > 128 || d1 < -128) p1[r] = -INFINITY; } \
            } \
            float mxa = __builtin_fmaxf(__builtin_fmaxf(p0[0], p0[1]), p1[0]), mxb = __builtin_fmaxf(__builtin_fmaxf(p0[2], p0[3]), p1[1]); \
            mxa = __builtin_fmaxf(__builtin_fmaxf(mxa, p1[2]), p1[3]); \
_Pragma("unroll") \
            for (int r = 4; r < 16; r += 4) { mxa = __builtin_fmaxf(__builtin_fmaxf(mxa, p0[r]), p0[r + 1]); mxb = __builtin_fmaxf(__builtin_fmaxf(mxb, p0[r + 2]), p0[r + 3]); \
                mxa = __builtin_fmaxf(__builtin_fmaxf(mxa, p1[r]), p1[r + 1]); mxb = __builtin_fmaxf(__builtin_fmaxf(mxb, p1[r + 2]), p1[r + 3]); } \
            float mx = __builtin_fmaxf(mxa, mxb); \
            mx = __builtin_fmaxf(mx, __shfl_xor(mx, 32)); \
            const bool first = (MODE == 2) && ((TT) == 0); \
            if (first || __any(mx > THR)) { \
                const float delta = first ? mx : __builtin_fmaxf(mx, 0.f), alpha = first ? 1.f : __builtin_amdgcn_exp2f(-delta); \
                mref += delta; l_run *= alpha; \
_Pragma("unroll") \
                for (int r = 0; r < 16; ++r) { o0[r] *= alpha; o1[r] *= alpha; p0[r] -= delta; p1[r] -= delta; negm[r] = -mref; } \
            } \
            float rs0 = 0.f, rs1 = 0.f; \
_Pragma("unroll") \
            for (int r = 0; r < 16; ++r) { p0[r] = __builtin_amdgcn_exp2f(p0[r]); p1[r] = __builtin_amdgcn_exp2f(p1[r]); rs0 += p0[r]; rs1 += p1[r]; } \
            l_run += rs0 + rs1; \
            u32x4 pw[4]; \
            pw[0] = (u32x4){pk2(p0[0], p0[1]), pk2(p0[2], p0[3]), pk2(p0[4], p0[5]), pk2(p0[6], p0[7])}; \
            pw[1] = (u32x4){pk2(p0[8], p0[9]), pk2(p0[10], p0[11]), pk2(p0[12], p0[13]), pk2(p0[14], p0[15])}; \
            pw[2] = (u32x4){pk2(p1[0], p1[1]), pk2(p1[2], p1[3]), pk2(p1[4], p1[5]), pk2(p1[6], p1[7])}; \
            pw[3] = (u32x4){pk2(p1[8], p1[9]), pk2(p1[10], p1[11]), pk2(p1[12], p1[13]), pk2(p1[14], p1[15])}; \
_Pragma("unroll") \
            for (int s2 = 0; s2 < 4; ++s2) { \
                const bf16x8 pb = __builtin_bit_cast(bf16x8, pw[s2]); \
                const LAS unsigned char* va0 = vb + (16 * s2) * VS + voff; \
                const s16x4 l0 = vtr(va0), h0 = vtr(va0 + 8 * VS), l1 = vtr(va0 + 64), h1 = vtr(va0 + 8 * VS + 64); \
                const bf16x8 v0 = (bf16x8){l0[0], l0[1], l0[2], l0[3], h0[0], h0[1], h0[2], h0[3]}; \
                const bf16x8 v1 = (bf16x8){l1[0], l1[1], l1[2], l1[3], h1[0], h1[1], h1[2], h1[3]}; \
                o0 = __builtin_amdgcn_mfma_f32_32x32x16_bf16(v0, pb, o0, 0, 0, 0); \
                o1 = __builtin_amdgcn_mfma_f32_32x32x16_bf16(v1, pb, o1, 0, 0, 0); \
            } \
        } \
        } while (0)

    ATT_LOAD(0, kregA, vregA, kreg2A); ATT_LOAD(1, kregB, vregB, kreg2B);
    ATT_STORE(0, kregA, vregA, kreg2A); ATT_STORE(1, kregB, vregB, kreg2B);
    if (2 < nt) { ATT_LOAD(2, kregA, vregA, kreg2A); ATT_LOAD(3, kregB, vregB, kreg2B); }
    ATT_BARRIER();
    const int Rq = Rq0 + r32;
    const bf16_t* zrow = (MODE == 2) ? (const bf16_t*)(aux + AUX_ZO) + (size_t)Rq * 512 + head * 64 : (const bf16_t*)(ws + WS_ZA) + (size_t)Rq * 512 + head * 64;
    u32x2 zz[8];
#pragma unroll
    for (int g = 0; g < 8; ++g) zz[g] = (u32x2){0u, 0u};
    for (int t = 0; t < nt; t += 2) {
        if (t + 2 >= nt) {
#pragma unroll
            for (int g = 0; g < 4; ++g) { zz[2 * g] = *(const u32x2*)(zrow + 8 * g + 4 * hi); zz[2 * g + 1] = *(const u32x2*)(zrow + 32 + 8 * g + 4 * hi); } }
        ATT_COMPUTE(t);
        ATT_COMPUTE(t + 1);
        if (t + 2 < nt) { ATT_STORE((t + 2) & 3, kregA, vregA, kreg2A); ATT_STORE((t + 3) & 3, kregB, vregB, kreg2B); }
        if (t + 4 < nt) { ATT_LOAD(t + 4, kregA, vregA, kreg2A); ATT_LOAD(t + 5, kregB, vregB, kreg2B); }
        ATT_BARRIER();
    }
#undef ATT_COMPUTE
#undef ATT_BARRIER
#undef ATT_SRC
#undef ATT_LOAD
#undef ATT_STORE
    const float l_tot = l_run + __shfl_xor(l_run, 32), inv = __builtin_amdgcn_rcpf(l_tot);
    bf16_t* urow = (bf16_t*)(ws + WS_U) + (size_t)Rq * 1024 + head * 64;
#pragma unroll
    for (int g = 0; g < 4; ++g) {
        const int dv = 8 * g + 4 * hi;
        { const u32x2 z = zz[2 * g];
          u32x2 w; w.x = pk2(o0[4 * g] * inv * bf_lo(z.x), o0[4 * g + 1] * inv * bf_hi(z.x)); w.y = pk2(o0[4 * g + 2] * inv * bf_lo(z.y), o0[4 * g + 3] * inv * bf_hi(z.y));
          *(u32x2*)(urow + dv) = w; }
        { const u32x2 z = zz[2 * g + 1];
          u32x2 w; w.x = pk2(o1[4 * g] * inv * bf_lo(z.x), o1[4 * g + 1] * inv * bf_hi(z.x)); w.y = pk2(o1[4 * g + 2] * inv * bf_lo(z.y), o1[4 * g + 3] * inv * bf_hi(z.y));
          *(u32x2*)(urow + 32 + dv) = w; }
    }
}


__device__ __forceinline__ int srcmap(int mat, int dn) {
    if (mat == 0) {
        if (dn < 128) { const int d = dn & 63; return (dn & 64) + (d >> 1) + 32 * (d & 1); }
        if (dn < 256) return dn;
        if (dn < 768) { const int j = dn - 256, d = j & 63; return 256 + (j & ~63) + (d >> 1) + 32 * (d & 1); }
        if (dn < 1792) { const int j = dn - 768, blk = j >> 8, w = j & 255; return (w < 128) ? 1280 + blk * 128 + w : 1792 + blk * 128 + (w - 128); }
        if (dn < 2816) { const int j = dn - 1792, blk = j >> 8, w = j & 255; return (w < 128) ? 768 + blk * 128 + w : 2816 + blk * 128 + (w - 128); }
        return 2304 + (dn - 2816);
    }
    if (mat == 2) {
        if (dn < 256) return dn;
        if (dn < 512) return 288 + (dn - 256);
        if (dn < 1024) return 544 + (dn - 512);
        if (dn < 1280) { const int w = dn - 1024; if (w < 32) return 256 + (w >> 1) + 16 * (w & 1); if (w < 48) return 1056 + (w - 32); return -1; }
        if (dn < 2048) return 1072 + (dn - 1280);
        if (dn < 2304) return 1840 + (dn - 2048);
        if (dn < 3328) { const int j = dn - 2304, blk = j >> 8, w = j & 255; return (w < 128) ? 2096 + blk * 128 + w : 2608 + 512 + blk * 128 + (w - 128); }
        return 2608 + (dn - 3328);
    }
    if (mat == 3) {
        const int head = dn / 96, d = dn - head * 96; if (d < 64) return dn; const int w = d - 64; return head * 96 + 64 + (w >> 1) + 16 * (w & 1);
    }
    return dn;
}
__device__ __forceinline__ void p0_transpose_item(const float* W, int K, int Nsrc, bf16_t* WT, int mat, const float* kscale, LAS float* scr, int item, int nblk, int lane) {
    const int kb = item / nblk, nb = item % nblk, k0 = 64 * kb, n0 = 32 * nb;
    const int sc = srcmap(mat, n0 + (lane & 31));
    float v[32];
    const float* wp = W + (size_t)(k0 + (lane >> 5)) * Nsrc + (sc >= 0 ? sc : 0);
#pragma unroll
    for (int i = 0; i < 32; ++i) v[i] = wp[(size_t)(2 * i) * Nsrc];
#pragma unroll
    for (int i = 0; i < 32; ++i) { const int kk = 2 * i + (lane >> 5); float x = (sc >= 0) ? v[i] : 0.f; if (kscale) x *= kscale[k0 + kk]; scr[kk * 33 + (lane & 31)] = x; }
    LDS_WAIT(); asm volatile("" ::: "memory");
    const int c = lane & 7;
#pragma unroll
    for (int j = 0; j < 4; ++j) { const int n = (lane >> 3) + 8 * j; const LAS float* s = scr + (8 * c) * 33 + n;
        u32x4 o; o.x = pk2(s[0 * 33], s[1 * 33]); o.y = pk2(s[2 * 33], s[3 * 33]); o.z = pk2(s[4 * 33], s[5 * 33]); o.w = pk2(s[6 * 33], s[7 * 33]);
        *(u32x4*)(WT + (size_t)(n0 + n) * K + k0 + 8 * c) = o; }
    LDS_WAIT(); asm volatile("" ::: "memory");
}

__device__ __forceinline__ void p0_mod(LAS unsigned char* lds, const float* c, const float* c_ctx, const float* mod_w, const float* mod_b, float* MOD, int G) {
    const int tid = my_tid();
    if ((int)blockIdx.x >= 192) return;
    LAS float* scs = (LAS float*)lds;
    LAS float* red = (LAS float*)(lds + 1024 * 20 * 4);
    { float cv[34];
#pragma unroll
      for (int u = 0; u < 34; ++u) { const int idx = tid + u * NTHREADS, r = idx >> 10, k = idx & 1023; cv[u] = (r < 16) ? c[r * 1024 + k] : c_ctx[k]; }
#pragma unroll
      for (int u = 0; u < 34; ++u) { const int idx = tid + u * NTHREADS, r = idx >> 10, k = idx & 1023; scs[k * 20 + r] = silu_f(cv[u]); } }
    __syncthreads();
    for (int item = blockIdx.x; item < 192; item += G) {
        const int l = item / 96, n0 = (item % 96) * 32, col = tid & 31, kg = tid >> 5;
        float acc[20];
#pragma unroll
        for (int r = 0; r < 20; ++r) acc[r] = 0.f;
        const float* wp = mod_w + ((size_t)l * 1024 + kg * 64) * 3072 + n0 + col;
#pragma unroll
        for (int kb = 0; kb < 4; ++kb) {
            float w[16];
#pragma unroll
            for (int u = 0; u < 16; ++u) w[u] = wp[(size_t)(kb * 16 + u) * 3072];
#pragma unroll
            for (int u = 0; u < 16; ++u) { const LAS f32x4* sp = (const LAS f32x4*)(scs + (kg * 64 + kb * 16 + u) * 20);
#pragma unroll
                for (int q = 0; q < 5; ++q) { const f32x4 s = sp[q]; acc[4 * q] += s[0] * w[u]; acc[4 * q + 1] += s[1] * w[u]; acc[4 * q + 2] += s[2] * w[u]; acc[4 * q + 3] += s[3] * w[u]; } }
        }
#pragma unroll
        for (int r = 0; r < 17; ++r) red[(kg * 17 + r) * 32 + col] = acc[r];
        __syncthreads();
        for (int o = tid; o < 17 * 32; o += NTHREADS) { const int r = o >> 5, cc = o & 31; float s = mod_b[l * 3072 + n0 + cc];
#pragma unroll
            for (int g = 0; g < 16; ++g) s += red[(g * 17 + r) * 32 + cc];
            MOD[((size_t)l * 17 + r) * 3072 + n0 + cc] = s; }
        __syncthreads();
    }
}

__device__ __forceinline__ void norm_mod_store(const f32x4 (&v)[4], const float* pre_w, const float* modrow, bf16_t* hrow, int lane) {
    float ss = 0.f;
#pragma unroll
    for (int j = 0; j < 4; ++j) ss += sq4(v[j]);
    const float rstd = rsqrtf(wave_sum(ss) * (1.f / 1024.f) + EPS);
#pragma unroll
    for (int j = 0; j < 4; ++j) { const int k = 4 * (lane + 64 * j);
        const f32x4 w = *(const f32x4*)(pre_w + k), sh = *(const f32x4*)(modrow + k), sc = *(const f32x4*)(modrow + 1024 + k);
        const f32x4 h = v[j] * rstd * w * (sc + 1.0f) + sh;
        u32x2 o; o.x = pk2(h[0], h[1]); o.y = pk2(h[2], h[3]); *(u32x2*)(hrow + k) = o; }
}
__device__ __forceinline__ void norm_mod_store_wt(const f32x4 (&v)[4], const float* pre_w, const float* modrow, bf16_t* hrow, int lane) {
    float ss = 0.f;
#pragma unroll
    for (int j = 0; j < 4; ++j) ss += sq4(v[j]);
    const float rstd = rsqrtf(wave_sum(ss) * (1.f / 1024.f) + EPS);
#pragma unroll
    for (int j = 0; j < 4; ++j) { const int k = 4 * (lane + 64 * j);
        const f32x4 w = *(const f32x4*)(pre_w + k), sh = *(const f32x4*)(modrow + k), sc = *(const f32x4*)(modrow + 1024 + k);
        const f32x4 h = v[j] * rstd * w * (sc + 1.0f) + sh;
        __hip_atomic_store((unsigned long long*)(hrow + k), (unsigned long long)pk2(h[0], h[1]) | ((unsigned long long)pk2(h[2], h[3]) << 32), __ATOMIC_RELAXED, __HIP_MEMORY_SCOPE_AGENT); }
}
__device__ __forceinline__ void p1_stream(const float* x, const float* ctx, const float* pre_w, const float* MOD, bf16_t* H, unsigned* ready, int sw, int nsw, int lane) {
    f32x4 cur[4][4], nxt[4][4];
#define P1_LOAD(dst, R_) do { if ((R_) < MT) { const float* src_ = ((R_) < ML) ? x + (size_t)(R_) * 1024 : ctx + (size_t)((R_) - ML) * 1024; \
        _Pragma("unroll") for (int j = 0; j < 4; ++j) dst[j] = *(const f32x4*)(src_ + 4 * (lane + 64 * j)); } } while (0)
#pragma unroll
    for (int q = 0; q < 4; ++q) P1_LOAD(cur[q], sw + nsw * q);
    for (int R0 = sw; R0 < MT; R0 += 4 * nsw) {
#pragma unroll
        for (int q = 0; q < 4; ++q) P1_LOAD(nxt[q], R0 + nsw * (4 + q));
#pragma unroll
        for (int q = 0; q < 4; ++q) { const int R = R0 + nsw * q; if (R < MT) { const int bi = (R < ML) ? (R >> 11) : 16;
            norm_mod_store_wt(cur[q], pre_w, MOD + (size_t)bi * 3072, H + (size_t)R * 1024, lane); } }
        asm volatile("s_waitcnt vmcnt(0)" ::: "memory");
        if (lane < 4) { const int R = R0 + nsw * lane; if (R < MT) __hip_atomic_fetch_add(ready + 64 * (R >> 8), 1u, __ATOMIC_RELAXED, __HIP_MEMORY_SCOPE_AGENT); }
#pragma unroll
        for (int q = 0; q < 4; ++q)
#pragma unroll
            for (int j = 0; j < 4; ++j) cur[q][j] = nxt[q][j];
    }
#undef P1_LOAD
}
__device__ __forceinline__ void p1_prenorm(const float* x, const float* ctx, const float* pre_w, const float* MOD, bf16_t* H, int gw, int ngw, int lane) {
    const int per = (MT + ngw - 1) / ngw, r0 = gw * per, r1 = (r0 + per < MT) ? r0 + per : MT;
    f32x4 cur[4], nxt[4], w[4], sc1[4], sh[4];
#pragma unroll
    for (int j = 0; j < 4; ++j) { w[j] = *(const f32x4*)(pre_w + 4 * (lane + 64 * j)); sc1[j] = w[j]; sh[j] = w[j]; }
#define P1_LOAD(dst, R_) do { const float* src_ = ((R_) < ML) ? x + (size_t)(R_) * 1024 : ctx + (size_t)((R_) - ML) * 1024; \
        _Pragma("unroll") for (int j = 0; j < 4; ++j) dst[j] = *(const f32x4*)(src_ + 4 * (lane + 64 * j)); } while (0)
    if (r0 < r1) P1_LOAD(cur, r0);
    int cur_bi = -1;
    for (int R = r0; R < r1; ++R) {
        if (R + 1 < r1) P1_LOAD(nxt, R + 1);
        const int bi = (R < ML) ? (R >> 11) : 16;
        if (bi != cur_bi) { cur_bi = bi; const float* m0 = MOD + (size_t)bi * 3072;
#pragma unroll
            for (int j = 0; j < 4; ++j) { const int k = 4 * (lane + 64 * j); sh[j] = *(const f32x4*)(m0 + k); sc1[j] = *(const f32x4*)(m0 + 1024 + k) + 1.0f; } }
        float ss = 0.f;
#pragma unroll
        for (int j = 0; j < 4; ++j) ss += sq4(cur[j]);
        const float rstd = rsqrtf(wave_sum(ss) * (1.f / 1024.f) + EPS);
#pragma unroll
        for (int j = 0; j < 4; ++j) { const int k = 4 * (lane + 64 * j);
            const f32x4 h = cur[j] * rstd * w[j] * sc1[j] + sh[j];
            u32x2 o; o.x = pk2(h[0], h[1]); o.y = pk2(h[2], h[3]); *(u32x2*)(H + (size_t)R * 1024 + k) = o; }
#pragma unroll
        for (int j = 0; j < 4; ++j) cur[j] = nxt[j];
    }
#undef P1_LOAD
}
__device__ __forceinline__ float ssq16(const float* p) {
    const f32x4 a = *(const f32x4*)p, b = *(const f32x4*)(p + 4), c = *(const f32x4*)(p + 8), d = *(const f32x4*)(p + 12);
    return (((a[0] + a[1]) + (a[2] + a[3])) + ((b[0] + b[1]) + (b[2] + b[3]))) + (((c[0] + c[1]) + (c[2] + c[3])) + ((d[0] + d[1]) + (d[2] + d[3])));
}
__device__ __forceinline__ void p5_post_pre(const float* x, const float* ctx, const float* post_w0, const float* pre_w1, const float* MOD, const bf16_t* Y, const float* SSQ, bf16_t* X1, bf16_t* H, int gw, int ngw, int lane) {
    const int per = (MT + ngw - 1) / ngw, r0 = gw * per, r1 = (r0 + per < MT) ? r0 + per : MT;
    f32x4 xc[4], xn[4], sqc[4], sqn[4]; u32x2 yc[4], yn[4];
    f32x4 pg[4], pw[4], w1[4], sc1[4], sh1[4];
#pragma unroll
    for (int j = 0; j < 4; ++j) { const int k = 4 * (lane + 64 * j); pw[j] = *(const f32x4*)(post_w0 + k); w1[j] = *(const f32x4*)(pre_w1 + k); pg[j] = pw[j]; sc1[j] = pw[j]; sh1[j] = pw[j]; }
#define P5_LOAD(xd, yd, sd, R_) do { const float* src_ = ((R_) < ML) ? x + (size_t)(R_) * 1024 : ctx + (size_t)((R_) - ML) * 1024; \
        _Pragma("unroll") for (int j = 0; j < 4; ++j) { xd[j] = *(const f32x4*)(src_ + 4 * (lane + 64 * j)); yd[j] = *(const u32x2*)(Y + (size_t)(R_) * 1024 + 4 * (lane + 64 * j)); \
            sd[j] = *(const f32x4*)(SSQ + (size_t)(R_) * 16 + 4 * j); } } while (0)
    if (r0 < r1) P5_LOAD(xc, yc, sqc, r0);
    int cur_bi = -1;
    for (int R = r0; R < r1; ++R) {
        if (R + 1 < r1) P5_LOAD(xn, yn, sqn, R + 1);
        const int bi = (R < ML) ? (R >> 11) : 16;
        if (bi != cur_bi) { cur_bi = bi; const float* m0 = MOD + (size_t)bi * 3072; const float* m1 = MOD + (size_t)(17 + bi) * 3072;
#pragma unroll
            for (int j = 0; j < 4; ++j) { const int k = 4 * (lane + 64 * j); pg[j] = *(const f32x4*)(m0 + 2048 + k); sh1[j] = *(const f32x4*)(m1 + k); sc1[j] = *(const f32x4*)(m1 + 1024 + k) + 1.0f; } }
        const float ssy = (((sqc[0][0] + sqc[0][1]) + (sqc[0][2] + sqc[0][3])) + ((sqc[1][0] + sqc[1][1]) + (sqc[1][2] + sqc[1][3]))) + (((sqc[2][0] + sqc[2][1]) + (sqc[2][2] + sqc[2][3])) + ((sqc[3][0] + sqc[3][1]) + (sqc[3][2] + sqc[3][3])));
        const float rstd_y = rsqrtf(ssy * (1.f / 1024.f) + EPS);
        f32x4 v[4]; float ss = 0.f;
#pragma unroll
        for (int j = 0; j < 4; ++j) { const int k = 4 * (lane + 64 * j);
            const f32x4 y = (f32x4){bf_lo(yc[j].x), bf_hi(yc[j].x), bf_lo(yc[j].y), bf_hi(yc[j].y)};
            v[j] = xc[j] + pg[j] * (y * rstd_y * pw[j]);
            ss += sq4(v[j]);
            if (R < ML) { u32x2 o; o.x = pk2(v[j][0], v[j][1]); o.y = pk2(v[j][2], v[j][3]); *(u32x2*)(X1 + (size_t)R * 1024 + k) = o; } }
        const float rstd = rsqrtf(wave_sum(ss) * (1.f / 1024.f) + EPS);
#pragma unroll
        for (int j = 0; j < 4; ++j) { const int k = 4 * (lane + 64 * j);
            const f32x4 h = v[j] * rstd * w1[j] * sc1[j] + sh1[j];
            u32x2 o; o.x = pk2(h[0], h[1]); o.y = pk2(h[2], h[3]); *(u32x2*)(H + (size_t)R * 1024 + k) = o; }
#pragma unroll
        for (int j = 0; j < 4; ++j) { xc[j] = xn[j]; yc[j] = yn[j]; sqc[j] = sqn[j]; }
    }
#undef P5_LOAD
}
__device__ __forceinline__ void p11_final(const float* post_w1, const float* MOD, const bf16_t* Y, const float* SSQ, const bf16_t* X1, float* out, int gw, int ngw, int lane) {
    const int per = (ML + ngw - 1) / ngw, r0 = gw * per, r1 = (r0 + per < ML) ? r0 + per : ML;
    u32x2 xc[4], xn[4], yc[4], yn[4]; f32x4 sqc[4], sqn[4], pg[4], pw[4];
#pragma unroll
    for (int j = 0; j < 4; ++j) { pw[j] = *(const f32x4*)(post_w1 + 4 * (lane + 64 * j)); pg[j] = pw[j]; }
#define P11_LOAD(xd, yd, sd, R_) do { _Pragma("unroll") for (int j = 0; j < 4; ++j) { xd[j] = *(const u32x2*)(X1 + (size_t)(R_) * 1024 + 4 * (lane + 64 * j)); yd[j] = *(const u32x2*)(Y + (size_t)(R_) * 1024 + 4 * (lane + 64 * j)); \
        sd[j] = *(const f32x4*)(SSQ + (size_t)(R_) * 16 + 4 * j); } } while (0)
    if (r0 < r1) P11_LOAD(xc, yc, sqc, r0);
    int cur_b = -1;
    for (int R = r0; R < r1; ++R) {
        if (R + 1 < r1) P11_LOAD(xn, yn, sqn, R + 1);
        const int bb = R >> 11;
        if (bb != cur_b) { cur_b = bb; const float* m1 = MOD + (size_t)(17 + bb) * 3072;
#pragma unroll
            for (int j = 0; j < 4; ++j) pg[j] = *(const f32x4*)(m1 + 2048 + 4 * (lane + 64 * j)); }
        const float ssy = (((sqc[0][0] + sqc[0][1]) + (sqc[0][2] + sqc[0][3])) + ((sqc[1][0] + sqc[1][1]) + (sqc[1][2] + sqc[1][3]))) + (((sqc[2][0] + sqc[2][1]) + (sqc[2][2] + sqc[2][3])) + ((sqc[3][0] + sqc[3][1]) + (sqc[3][2] + sqc[3][3])));
        const float rstd_y = rsqrtf(ssy * (1.f / 1024.f) + EPS);
#pragma unroll
        for (int j = 0; j < 4; ++j) { const int k = 4 * (lane + 64 * j);
            const f32x4 y = (f32x4){bf_lo(yc[j].x), bf_hi(yc[j].x), bf_lo(yc[j].y), bf_hi(yc[j].y)};
            const f32x4 xv = (f32x4){bf_lo(xc[j].x), bf_hi(xc[j].x), bf_lo(xc[j].y), bf_hi(xc[j].y)};
            *(f32x4*)(out + (size_t)R * 1024 + k) = xv + pg[j] * (y * rstd_y * pw[j]); }
#pragma unroll
        for (int j = 0; j < 4; ++j) { xc[j] = xn[j]; yc[j] = yn[j]; sqc[j] = sqn[j]; }
    }
#undef P11_LOAD
}
__device__ __forceinline__ void p3_conv(unsigned char* ws, const float* conv_w, int gtid, int ngt) {
    const bf16_t* PE = (const bf16_t*)(ws + WS_PE); const bf16_t* GE = (const bf16_t*)(ws + WS_GE); bf16_t* U = (bf16_t*)(ws + WS_U);
    const int ch = (gtid & 63) * 8;
    const f32x4 w0a = *(const f32x4*)(conv_w + ch), w0b = *(const f32x4*)(conv_w + ch + 4), w1a = *(const f32x4*)(conv_w + 512 + ch), w1b = *(const f32x4*)(conv_w + 512 + ch + 4),
                w2a = *(const f32x4*)(conv_w + 1024 + ch), w2b = *(const f32x4*)(conv_w + 1024 + ch + 4);
    for (int it = gtid; it < MT * 64; it += ngt) {
        const int R = it >> 6;
        int t, T; if (R < ML) { t = R & 2047; T = 2048; } else { t = (R - ML) & 255; T = 256; }
        const u32x4 z4 = (u32x4){0u, 0u, 0u, 0u};
        const u32x4 pc = *(const u32x4*)(PE + (size_t)R * 512 + ch);
        const u32x4 pm = (t > 0) ? *(const u32x4*)(PE + (size_t)(R - 1) * 512 + ch) : z4;
        const u32x4 pp = (t < T - 1) ? *(const u32x4*)(PE + (size_t)(R + 1) * 512 + ch) : z4;
        const u32x4 g = *(const u32x4*)(GE + (size_t)R * 512 + ch);
        u32x4 o;
#define CV(pmw, pcw, ppw, gw_, wa, wb, wc_, e0, e1) pk2(bf_lo(gw_) * (wa[e0] * bf_lo(pmw) + wb[e0] * bf_lo(pcw) + wc_[e0] * bf_lo(ppw)), bf_hi(gw_) * (wa[e1] * bf_hi(pmw) + wb[e1] * bf_hi(pcw) + wc_[e1] * bf_hi(ppw)))
        o.x = CV(pm.x, pc.x, pp.x, g.x, w0a, w1a, w2a, 0, 1); o.y = CV(pm.y, pc.y, pp.y, g.y, w0a, w1a, w2a, 2, 3);
        o.z = CV(pm.z, pc.z, pp.z, g.z, w0b, w1b, w2b, 0, 1); o.w = CV(pm.w, pc.w, pp.w, g.w, w0b, w1b, w2b, 2, 3);
#undef CV
        *(u32x4*)(U + (size_t)R * 1024 + 512 + ch) = o;
    }
}
__device__ __forceinline__ void p9_readout(unsigned char* ws, unsigned char* aux, const float* hn_w, int gw, int ngw, int lane) {
    const bf16_t* HM = (const bf16_t*)(ws + WS_HM); const bf16_t* MO = (const bf16_t*)(aux + AUX_MO); bf16_t* U = (bf16_t*)(ws + WS_U);
    const int ch = 8 * lane;
    const f32x4 wa = *(const f32x4*)(hn_w + ch), wb = *(const f32x4*)(hn_w + ch + 4);
    u32x4 h0, h1, mo, h0n, h1n, mon;
#define P9_LOAD(a_, b_, c_, R_) do { a_ = *(const u32x4*)(HM + (size_t)(R_) * 512 + ch); b_ = *(const u32x4*)(HM + ((size_t)ML + (R_)) * 512 + ch); c_ = *(const u32x4*)(MO + (size_t)(R_) * 512 + ch); } while (0)
    h0n = (u32x4){0u, 0u, 0u, 0u}; h1n = h0n; mon = h0n;
    if (gw < ML) P9_LOAD(h0, h1, mo, gw);
    for (int R = gw; R < ML; R += ngw) {
        if (R + ngw < ML) P9_LOAD(h0n, h1n, mon, R + ngw);
        float hs[8] = {bf_lo(h0.x) + bf_lo(h1.x), bf_hi(h0.x) + bf_hi(h1.x), bf_lo(h0.y) + bf_lo(h1.y), bf_hi(h0.y) + bf_hi(h1.y),
                       bf_lo(h0.z) + bf_lo(h1.z), bf_hi(h0.z) + bf_hi(h1.z), bf_lo(h0.w) + bf_lo(h1.w), bf_hi(h0.w) + bf_hi(h1.w)};
        float ss = 0.f;
#pragma unroll
        for (int e = 0; e < 8; ++e) ss += hs[e] * hs[e];
        ss += __shfl_xor(ss, 1); ss += __shfl_xor(ss, 2); ss += __shfl_xor(ss, 4); ss += __shfl_xor(ss, 8);
        const float rstd = rsqrtf(ss * (1.f / 128.f) + EPS);
        u32x4 o;
        o.x = pk2(hs[0] * rstd * wa[0] * bf_lo(mo.x), hs[1] * rstd * wa[1] * bf_hi(mo.x));
        o.y = pk2(hs[2] * rstd * wa[2] * bf_lo(mo.y), hs[3] * rstd * wa[3] * bf_hi(mo.y));
        o.z = pk2(hs[4] * rstd * wb[0] * bf_lo(mo.z), hs[5] * rstd * wb[1] * bf_hi(mo.z));
        o.w = pk2(hs[6] * rstd * wb[2] * bf_lo(mo.w), hs[7] * rstd * wb[3] * bf_hi(mo.w));
        *(u32x4*)(U + (size_t)R * 1024 + 512 + ch) = o;
        h0 = h0n; h1 = h1n; mo = mon;
    }
#undef P9_LOAD
}


typedef float f32x4v __attribute__((ext_vector_type(4)));
#define LDS_BARRIER() do { asm volatile("s_waitcnt lgkmcnt(0)" ::: "memory"); __builtin_amdgcn_s_barrier(); asm volatile("" ::: "memory"); } while (0)
#define MFMA_FENCE(x) do { __builtin_amdgcn_sched_barrier(0); asm volatile("s_nop 15\n\ts_nop 15" : "+v"(x)); __builtin_amdgcn_sched_barrier(0); } while (0)
__device__ __forceinline__ bf16x8 tr8(const LAS unsigned char* p, int halfstride) {
    const s16x4 lo = vtr(p), hi = vtr(p + halfstride);
    return (bf16x8){lo[0], lo[1], lo[2], lo[3], hi[0], hi[1], hi[2], hi[3]};
}
__device__ __forceinline__ bf16x8 gather8(const LAS unsigned char* img, int stride, int row0, int col) {
    bf16x8 r;
#pragma unroll
    for (int e = 0; e < 8; ++e) r[e] = *(const LAS short*)(img + (row0 + e) * stride + col * 2);
    return r;
}
template <int CTRL, int RM> __device__ __forceinline__ float dppf(float oldv, float v) {
    return __int_as_float(__builtin_amdgcn_update_dpp(__float_as_int(oldv), __float_as_int(v), CTRL, RM, 0xf, false));
}
__device__ __forceinline__ float wave_scan_add(float v) {
    v += dppf<0x111, 0xf>(0.f, v); v += dppf<0x112, 0xf>(0.f, v); v += dppf<0x114, 0xf>(0.f, v); v += dppf<0x118, 0xf>(0.f, v);
    v += dppf<0x142, 0xa>(0.f, v); v += dppf<0x143, 0xc>(0.f, v);
    return v;
}
__device__ __forceinline__ float wave_scan_max(float v) {
    const float ninf = -INFINITY;
    v = fmaxf(v, dppf<0x111, 0xf>(ninf, v)); v = fmaxf(v, dppf<0x112, 0xf>(ninf, v)); v = fmaxf(v, dppf<0x114, 0xf>(ninf, v)); v = fmaxf(v, dppf<0x118, 0xf>(ninf, v));
    v = fmaxf(v, dppf<0x142, 0xa>(ninf, v)); v = fmaxf(v, dppf<0x143, 0xc>(ninf, v));
    return v;
}
template <bool DUMMY> __device__ __forceinline__ void mlstm_chain_mfma(LAS unsigned char* lds, unsigned char* ws, unsigned char* aux, const float* i_bias, const float* f_bias, int chain) {
    constexpr int RS = 144, VS = 176;
    constexpr int QI = 0, KI = 9216, SC = 18432, CI = 27648, VI = 39168, VW = 50432, VEC = 61696;
    const int tid = my_tid(), lane = tid & 63, wid = __builtin_amdgcn_readfirstlane(tid >> 6), l15 = lane & 15, kg = lane >> 4;
    const int vh = chain & 1, d = (chain >> 1) & 1, h = (chain >> 2) & 3, b = chain >> 4;
    LAS float* vb_ = (LAS float*)(lds + VEC); LAS float* vab = vb_ + 64; LAS float* vcm = vab + 64; LAS float* vwp = vcm + 64; LAS float* vsc = vwp + 64;
    const bf16_t* MK = (const bf16_t*)(ws + WS_MK); const bf16_t* MV = (const bf16_t*)(ws + WS_MV); const bf16_t* MQ = (const bf16_t*)(aux + AUX_MQ);
    const float* GT = (const float*)(ws + WS_GATES); bf16_t* HM = (bf16_t*)(ws + WS_HM);
    const float ib = i_bias[d * 4 + h], fb = f_bias[d * 4 + h];
    for (int idx = tid; idx < 80 * RS / 4; idx += NTHREADS) ((LAS unsigned*)(lds + CI))[idx] = 0u;
    if (tid < 64) { LAS unsigned* a = (LAS unsigned*)(lds + VI + tid * VS + 128); LAS unsigned* w = (LAS unsigned*)(lds + VW + tid * VS + 128);
#pragma unroll
        for (int e = 0; e < 8; ++e) { a[e] = (e == 0) ? 0x3F80u : 0u; w[e] = 0u; } }
    const int it = wid & 3, vg = wid >> 2;
    f32x4v cacc[3];
#pragma unroll
    for (int t = 0; t < 3; ++t) cacc[t] = (f32x4v){0.f, 0.f, 0.f, 0.f};
    float mst = 0.f;
    unsigned nbad = 0u;
    const int srow = tid >> 3, sch = tid & 7;
    const int q4 = l15 >> 2, p4 = l15 & 3;
    u32x4 kkN, vvN, qqN = (u32x4){0u, 0u, 0u, 0u}; float liN = 0.f, fpN = 0.f;
#define MLSTM_LOADS(S_) do { const bool lat_ = (S_) >= 4; const int c_ = lat_ ? (S_) - 4 : (S_), T_ = lat_ ? 2048 : 256, rowb_ = lat_ ? b * 2048 : ML + b * 256; \
        const int tok_ = (d == 0) ? 64 * c_ + srow : T_ - 1 - (64 * c_ + srow); const size_t R_ = (size_t)(rowb_ + tok_); \
        kkN = *(const u32x4*)(MK + R_ * 256 + h * 64 + sch * 8); vvN = *(const u32x4*)(MV + R_ * 512 + h * 128 + vh * 64 + sch * 8); \
        if (lat_) qqN = *(const u32x4*)(MQ + R_ * 256 + h * 64 + sch * 8); \
        if (wid == 0) { const int tk_ = (d == 0) ? 64 * c_ + lane : T_ - 1 - (64 * c_ + lane); const float* gp_ = GT + (size_t)(rowb_ + tk_) * 16 + d * 8 + h; liN = gp_[0]; fpN = gp_[4]; } } while (0)
    MLSTM_LOADS(0);
    for (int step = 0; step < 36; ++step) {
        const bool lat = step >= 4; const int c = lat ? step - 4 : step, T = lat ? 2048 : 256, rowb = lat ? b * 2048 : ML + b * 256;
        const int tok = (d == 0) ? 64 * c + srow : T - 1 - (64 * c + srow); const size_t R = (size_t)(rowb + tok);
        const u32x4 kk = kkN, vv = vvN, qq = qqN;
        if (wid == 0) {
            const float li = liN + ib, fp = fpN + fb;
            const float lf = fminf(fp, 0.f) - __logf(1.f + __expf(-fabsf(fp)));
            const float bc = wave_scan_add(lf);
            const float ab = li - bc; const float cm = wave_scan_max(ab);
            const float g = __int_as_float(__builtin_amdgcn_readlane(__float_as_int(bc), 63)), mloc = g + __int_as_float(__builtin_amdgcn_readlane(__float_as_int(cm), 63)), m_new = fmaxf(g + mst, mloc);
            vb_[lane] = bc; vab[lane] = ab; vcm[lane] = cm; vwp[lane] = __expf(g + ab - m_new);
            if (lane == 0) { vsc[0] = mst; vsc[1] = __expf(g + mst - m_new); }
            mst = m_new;
        }
        LDS_BARRIER();
        { const float wj = vwp[srow];
          *(LAS u32x4*)(lds + KI + srow * RS + sch * 16) = kk;
          *(LAS u32x4*)(lds + VI + srow * VS + sch * 16) = vv;
          u32x4 vw; vw.x = pk2(bf_lo(vv.x) * wj, bf_hi(vv.x) * wj); vw.y = pk2(bf_lo(vv.y) * wj, bf_hi(vv.y) * wj); vw.z = pk2(bf_lo(vv.z) * wj, bf_hi(vv.z) * wj); vw.w = pk2(bf_lo(vv.w) * wj, bf_hi(vv.w) * wj);
          *(LAS u32x4*)(lds + VW + srow * VS + sch * 16) = vw;
          if (sch == 0) *(LAS unsigned short*)(lds + VW + srow * VS + 128) = f2bf(wj);
          if (lat) *(LAS u32x4*)(lds + QI + srow * RS + sch * 16) = qq; }
        LDS_BARRIER();
        const float m_in = vsc[0], a_prev = vsc[1];
        if (step + 1 < 36) MLSTM_LOADS(step + 1);
        bf16x8 qf[2];
        if (lat) {
            qf[0] = *(const LAS bf16x8*)(lds + QI + (16 * it + l15) * RS + (8 * kg) * 2); qf[1] = *(const LAS bf16x8*)(lds + QI + (16 * it + l15) * RS + (8 * kg + 32) * 2);
            const int i = 16 * it + l15; const float mi = fmaxf(m_in, vcm[i]);
#pragma unroll
            for (int t = 0; t < 2; ++t) {
                const int jt = 2 * vg + t; u32x2 o = (u32x2){0u, 0u};
                if (jt <= it) {
                    const bf16x8 k0 = *(const LAS bf16x8*)(lds + KI + (16 * jt + l15) * RS + (8 * kg) * 2), k1 = *(const LAS bf16x8*)(lds + KI + (16 * jt + l15) * RS + (8 * kg + 32) * 2);
                    f32x4v s = (f32x4v){0.f, 0.f, 0.f, 0.f};
                    s = __builtin_amdgcn_mfma_f32_16x16x32_bf16(k0, qf[0], s, 0, 0, 0); s = __builtin_amdgcn_mfma_f32_16x16x32_bf16(k1, qf[1], s, 0, 0, 0); MFMA_FENCE(s);
                    const int j0 = 16 * jt + 4 * kg; const f32x4v abv = *(const LAS f32x4v*)(vab + j0);
                    float e[4];
#pragma unroll
                    for (int r = 0; r < 4; ++r) e[r] = (j0 + r <= i) ? s[r] * __expf(abv[r] - mi) : 0.f;
                    o.x = pk2(e[0], e[1]); o.y = pk2(e[2], e[3]);
                }
                *(LAS u32x2*)(lds + SC + i * RS + (16 * jt + 4 * kg) * 2) = o;
            }
        }
        LDS_BARRIER();
        f32x4v cnew[3];
        { bf16x8 aK[2];
#pragma unroll
          for (int s = 0; s < 2; ++s) aK[s] = tr8(lds + KI + (32 * s + 8 * kg + q4) * RS + (16 * it + 4 * p4) * 2, 4 * RS);
#pragma unroll
          for (int t = 0; t < 3; ++t) { const int vt = (t == 2) ? 4 : 2 * t + vg; f32x4v a = cacc[t] * a_prev;
#pragma unroll
              for (int s = 0; s < 2; ++s) { const bf16x8 bW = tr8(lds + VW + (32 * s + 8 * kg + q4) * VS + (16 * vt + 4 * p4) * 2, 4 * VS); a = __builtin_amdgcn_mfma_f32_16x16x32_bf16(aK[s], bW, a, 0, 0, 0); }
              MFMA_FENCE(a); cnew[t] = a; } }
        if (lat) {
            const int i0 = 16 * it + 4 * kg; const f32x4v cmv = *(const LAS f32x4v*)(vcm + i0), bv = *(const LAS f32x4v*)(vb_ + i0);
            float wi[4], mt[4];
#pragma unroll
            for (int r = 0; r < 4; ++r) { const float mi = fmaxf(m_in, cmv[r]); wi[r] = __expf(m_in - mi); mt[r] = bv[r] + mi; }
            bf16x8 aS[2];
            aS[0] = *(const LAS bf16x8*)(lds + SC + (16 * it + l15) * RS + (8 * kg) * 2); aS[1] = *(const LAS bf16x8*)(lds + SC + (16 * it + l15) * RS + (8 * kg + 32) * 2);
            f32x4v nacc[3];
#pragma unroll
            for (int t = 0; t < 3; ++t) { const int vt = (t == 2) ? 4 : 2 * t + vg; f32x4v a = (f32x4v){0.f, 0.f, 0.f, 0.f};
#pragma unroll
                for (int s = 0; s < 2; ++s) { const bf16x8 bC = *(const LAS bf16x8*)(lds + CI + (16 * vt + l15) * RS + (8 * kg + 32 * s) * 2); a = __builtin_amdgcn_mfma_f32_16x16x32_bf16(qf[s], bC, a, 0, 0, 0); }
                MFMA_FENCE(a);
#pragma unroll
                for (int r = 0; r < 4; ++r) a[r] *= wi[r];
#pragma unroll
                for (int s = 0; s < 2; ++s) { const bf16x8 bV = tr8(lds + VI + (32 * s + 8 * kg + q4) * VS + (16 * vt + 4 * p4) * 2, 4 * VS); a = __builtin_amdgcn_mfma_f32_16x16x32_bf16(aS[s], bV, a, 0, 0, 0); }
                MFMA_FENCE(a); nacc[t] = a; }
            float inv[4];
#pragma unroll
            for (int r = 0; r < 4; ++r) { const float den = __shfl(nacc[2][r], lane & 48); inv[r] = 1.f / fmaxf(fabsf(den), __expf(-mt[r])); }
#pragma unroll
            for (int t = 0; t < 2; ++t) { const int vt = 2 * t + vg;
#pragma unroll
                for (int r = 0; r < 4; ++r) *(LAS unsigned short*)(lds + QI + (i0 + r) * RS + (16 * vt + l15) * 2) = f2bf(nacc[t][r] * inv[r]); }
        }
        LDS_BARRIER();
        if (lat) { const u32x4 hv = *(const LAS u32x4*)(lds + QI + srow * RS + sch * 16);
            if (DUMMY) { const u32x4 rv = *(const u32x4*)(HM + ((size_t)d * ML + R) * 512 + h * 128 + vh * 64 + sch * 8);
#define CMPH(a_, b_) do { const float x_ = (a_), y_ = (b_); if (fabsf(x_ - y_) > 0.05f * fmaxf(fabsf(x_), fabsf(y_)) + 0.02f) ++nbad; } while (0)
                CMPH(bf_lo(hv.x), bf_lo(rv.x)); CMPH(bf_hi(hv.x), bf_hi(rv.x)); CMPH(bf_lo(hv.y), bf_lo(rv.y)); CMPH(bf_hi(hv.y), bf_hi(rv.y));
                CMPH(bf_lo(hv.z), bf_lo(rv.z)); CMPH(bf_hi(hv.z), bf_hi(rv.z)); CMPH(bf_lo(hv.w), bf_lo(rv.w)); CMPH(bf_hi(hv.w), bf_hi(rv.w));
#undef CMPH
            } else *(u32x4*)(HM + ((size_t)d * ML + R) * 512 + h * 128 + vh * 64 + sch * 8) = hv; }
#pragma unroll
        for (int t = 0; t < 3; ++t) { cacc[t] = cnew[t]; const int vt = (t == 2) ? 4 : 2 * t + vg;
            if (t < 2 || wid < 4) { u32x2 o; o.x = pk2(cnew[t][0], cnew[t][1]); o.y = pk2(cnew[t][2], cnew[t][3]); *(LAS u32x2*)(lds + CI + (16 * vt + l15) * RS + (16 * it + 4 * kg) * 2) = o; } }
    }
#undef MLSTM_LOADS
    if (DUMMY) atomicAdd((unsigned*)(ws + WS_CTL) + 64, nbad);
    __syncthreads();
}

#ifndef MK_N_LAUNCHES
#define MK_N_LAUNCHES 1
#endif
constexpr int N_PHASES = 12;
constexpr int LDS_BYTES = 147456;
constexpr int RING_BYTES = 131072, MISC_OFF = RING_BYTES + 320;
constexpr int CW_BAR = 4096;

struct Args { const float* in[21]; float* out; unsigned char* ws; int ph_lo, ph_hi; };

__global__ void __launch_bounds__(NTHREADS, 2) hybrid_fwd(Args args) {
    extern __shared__ __attribute__((aligned(16))) unsigned char lds_raw[];
    LAS unsigned char* lds = (LAS unsigned char*)lds_raw;
    const int G = gridDim.x, bx = blockIdx.x;
    const int vcu = (G % 8 == 0) ? (bx % 8) * (G / 8) + bx / 8 : bx;
    typedef const __attribute__((address_space(4))) Args* ArgsP;
    ArgsP AP = (ArgsP)__builtin_amdgcn_kernarg_segment_ptr();
    asm volatile("" : "+s"(AP));
    unsigned char* ws = AP->ws;
#define I_x AP->in[0]
#define I_cvec AP->in[1]
#define I_ctx AP->in[2]
#define I_c_ctx AP->in[3]
#define I_mod_w AP->in[4]
#define I_mod_b AP->in[5]
#define I_pre_w AP->in[6]
#define I_post_w AP->in[7]
#define I_e_w_in AP->in[8]
#define I_e_sink AP->in[9]
#define I_e_conv_w AP->in[10]
#define I_e_w_out AP->in[11]
#define I_o_w_in AP->in[12]
#define I_o_qn AP->in[13]
#define I_o_kvn AP->in[14]
#define I_o_w_uq AP->in[15]
#define I_o_w_ukv AP->in[16]
#define I_o_ib AP->in[17]
#define I_o_fb AP->in[18]
#define I_o_hn AP->in[19]
#define I_o_w_out AP->in[20]
#define I_out AP->out
    float* MOD = (float*)(ws + WS_MOD);

    for (int u = threadIdx.x; u < (LDS_BYTES - RING_BYTES) / 4; u += NTHREADS) ((LAS unsigned*)(lds + RING_BYTES))[u] = 0u;
    __syncthreads();
    XcdBarrier bar; bar.bar = (unsigned*)(ws + WS_CTL) + CW_BAR; bar.x = 0; bar.st = nullptr;
    if (MK_N_LAUNCHES == 1) bar = xcd_barrier_post((unsigned*)(ws + WS_CTL) + CW_BAR, (volatile LAS unsigned*)(lds + MISC_OFF) + 8);
    const int lo = AP->ph_lo, hi = AP->ph_hi;
#ifndef PROBE_REP
#define PROBE_REP 0
#endif
#define NREP(k) ((((PROBE_REP) >> (k)) & 1) ? 2 : 1)
#ifndef PHASE_MASK
#define PHASE_MASK 0xFFF
#endif
#define IN(k) (((PHASE_MASK >> (k)) & 1) && lo <= (k) && (k) < hi)
#ifndef PROBE_DBLBAR
#define PROBE_DBLBAR 0
#endif
#ifndef PROBE_TS
#define PROBE_TS -1
#endif
#define STAMP(k) do { if (PROBE_TS >= 0 && bx == 0 && threadIdx.x == 0) ((unsigned long long*)(ws + WS_CTL + 512 * 1024))[(k)] = __builtin_amdgcn_s_memrealtime(); } while (0)
#define SEAM(k) do { if (MK_N_LAUNCHES == 1 && IN((k) + 1)) { xcd_barrier(bar); if (PROBE_DBLBAR) xcd_barrier(bar); } STAMP((k) + 1); } while (0)
    const int ngw = G * NWAVES;
#define PH_IDS const int tid = my_tid(), lane = tid & 63, wave = __builtin_amdgcn_readfirstlane(tid >> 6), gw = vcu * NWAVES + wave; (void)lane; (void)gw

    STAMP(0);
    if (IN(0)) { asm volatile("" : "+s"(AP)); PH_IDS;
        for (int rep_ = 0; rep_ < NREP(0); ++rep_) { if (rep_) __syncthreads();
        STAMP(20); p0_mod(lds, I_cvec, I_c_ctx, I_mod_w, I_mod_b, MOD, G);
        __syncthreads(); STAMP(21);
        LAS float* scr = (LAS float*)(lds + wave * 16384);
        constexpr int I0 = 16 * (E_N / 32), I1 = 16 * 32;
        { const bool split = (G == 256); const int cw0 = split ? (bx - 192) * NWAVES + wave : gw, ncw = split ? 64 * NWAVES : ngw;
          if (!split || bx >= 192) for (int it = cw0; it < I0 + I1; it += ncw) {
            if (it < I0) p0_transpose_item(I_e_w_in, 1024, E_N, (bf16_t*)(ws + WS_WEIN), 0, nullptr, scr, it, E_N / 32, lane);
            else p0_transpose_item(I_e_w_out, 1024, 1024, (bf16_t*)(ws + WS_WEOUT), 1, nullptr, scr, it - I0, 32, lane); } }
        STAMP(22);
        float* ropeA = (float*)(ws + WS_ROPEA); float* ropeC = (float*)(ws + WS_ROPEC);
        for (int idx = bx * NTHREADS + tid; idx < 2048 * 48; idx += G * NTHREADS) {
            const int pos = idx / 48, j = idx % 48; const float rowf = (float)(pos >> 6), colf = (float)(pos & 63);
            if (j < 32) { const int f = j & 15; const float inv = exp2f(-(float)f * (13.287712379549449f / 16.f)); const float ang = ((j < 16) ? rowf : colf) * inv;
                ropeA[pos * 64 + j] = __cosf(ang); ropeA[pos * 64 + 32 + j] = __sinf(ang); }
            else { const int jj = j - 32, f = jj & 7; const float inv = exp2f(-(float)f * (13.287712379549449f / 8.f)); const float ang = ((jj < 8) ? rowf : colf) * inv;
                ropeC[pos * 32 + jj] = __cosf(ang); ropeC[pos * 32 + 16 + jj] = __sinf(ang); }
        }
        STAMP(23);
        }
        SEAM(0); STAMP(24);
    }
    if (IN(1)) { asm volatile("" : "+s"(AP)); PH_IDS; for (int rep_ = 0; rep_ < NREP(1); ++rep_) { if (rep_) __syncthreads();
        { LAS float* scr = (LAS float*)(lds + wave * 16384);
          constexpr int I2 = 16 * (O_N / 32), I3 = 12 * 24, I4 = 4 * 32, I5 = 16 * 32;
          for (int it = gw; it < I2 + I3 + I4 + I5; it += ngw) { int r = it;
            if (r < I2) { p0_transpose_item(I_o_w_in, 1024, O_NSRC, (bf16_t*)(ws + WS_WOIN), 2, nullptr, scr, r, O_N / 32, lane); continue; } r -= I2;
            if (r < I3) { p0_transpose_item(I_o_w_uq, 768, 768, (bf16_t*)(ws + WS_WUQ), 3, I_o_qn, scr, r, 24, lane); continue; } r -= I3;
            if (r < I4) { p0_transpose_item(I_o_w_ukv, 256, 1024, (bf16_t*)(ws + WS_WUKV), 4, I_o_kvn, scr, r, 32, lane); continue; } r -= I4;
            p0_transpose_item(I_o_w_out, 1024, 1024, (bf16_t*)(ws + WS_WOOUT), 5, nullptr, scr, r, 32, lane); } }
        p1_prenorm(I_x, I_ctx, I_pre_w, MOD, (bf16_t*)(ws + WS_H), gw, ngw, lane); }
        SEAM(1); }
    if (IN(2)) { asm volatile("" : "+s"(AP)); PH_IDS;
        for (int rep_ = 0; rep_ < NREP(2); ++rep_) { if (rep_) __syncthreads();
        pg8::Gemm g{(const bf16_t*)(ws + WS_H), (const bf16_t*)(ws + WS_WEIN), MT, E_N, 1024}; pg8::RectOrder S; S.init(MT / 256, E_N / 256, 0, 0, 0, G, bx);
        EpiEin E{ws}; pg8::gemm_phase<EpiEin, pg8::RectOrder, true, true>(lds, g, S, E);
        }
        SEAM(2);
    }
    if (IN(3)) { asm volatile("" : "+s"(AP)); PH_IDS;
        for (int rep_ = 0; rep_ < NREP(3) + NREP(14) - 1; ++rep_) {
        for (int un = vcu; un < 1024; un += G) attn_unit<0>(lds, ws, nullptr, I_e_sink, un);
        for (int un = bx; un < 128; un += G) attn_unit<1>(lds, ws, nullptr, I_e_sink, un);
        }
        for (int rep_ = 0; rep_ < NREP(3) + NREP(15) - 1; ++rep_) { p3_conv(ws, I_e_conv_w, bx * NTHREADS + tid, G * NTHREADS);
        }
        SEAM(3);
    }
    if (IN(4)) { asm volatile("" : "+s"(AP)); PH_IDS;
        for (int rep_ = 0; rep_ < NREP(4); ++rep_) { if (rep_) __syncthreads();
        pg8::Gemm g{(const bf16_t*)(ws + WS_U), (const bf16_t*)(ws + WS_WEOUT), MT, 1024, 1024}; pg8::RectOrder S; S.init(MT / 256, 4, 0, 0, 0, G, bx);
        EpiY E{(bf16_t*)(ws + WS_Y), (float*)(ws + WS_SSQY0)}; pg8::gemm_phase<EpiY, pg8::RectOrder, true, true>(lds, g, S, E);
        }
        SEAM(4);
    }
    if (IN(5)) { asm volatile("" : "+s"(AP)); PH_IDS; for (int rep_ = 0; rep_ < NREP(5); ++rep_) { if (rep_) __syncthreads();
        p5_post_pre(I_x, I_ctx, I_post_w, I_pre_w + 1024, MOD, (const bf16_t*)(ws + WS_Y), (const float*)(ws + WS_SSQY0), (bf16_t*)(ws + WS_X1), (bf16_t*)(ws + WS_H), gw, ngw, lane); }
        SEAM(5); }
    if (IN(6)) { asm volatile("" : "+s"(AP)); PH_IDS;
        for (int rep_ = 0; rep_ < NREP(6); ++rep_) { if (rep_) __syncthreads();
        pg8::Gemm g{(const bf16_t*)(ws + WS_H), (const bf16_t*)(ws + WS_WOIN), MT, O_N, 1024}; pg8::RectOrder S; S.init(ML / 256, O_N / 256, ML / 256, MC / 256, 5, G, bx);
        EpiOin E{ws, (unsigned char*)I_out}; pg8::gemm_phase<EpiOin, pg8::RectOrder, true, true>(lds, g, S, E);
        }
        SEAM(6);
    }
    if (IN(7)) { asm volatile("" : "+s"(AP)); PH_IDS;
        for (int rep_ = 0; rep_ < NREP(7); ++rep_) { if (rep_) __syncthreads();
        { pg8::Gemm g{(const bf16_t*)(ws + WS_CQ), (const bf16_t*)(ws + WS_WUQ), ML, 768, 768}; pg8::RectOrder S; S.init(ML / 256, 3, 0, 0, 0, G, bx);
          EpiUq E{ws}; pg8::gemm_phase<EpiUq, pg8::RectOrder, true, true>(lds, g, S, E); }
        __syncthreads();
        { pg8::Gemm g{(const bf16_t*)(ws + WS_CKV), (const bf16_t*)(ws + WS_WUKV), MT, 1024, 256}; EpiUkv E{ws};
          if (G == 256) {
              pg8::ListOrder4 S; if (bx < 128) { S.start = bx; S.cnt = 1; } else if (bx < 192) { S.start = 128 + 3 * (bx - 128); S.cnt = 3; } else { S.start = 320 + 4 * (bx - 192); S.cnt = 4; }
              pg8::gemm_phase<EpiUkv, pg8::ListOrder4, true, true>(lds, g, S, E);
          } else { pg8::RectOrder S; S.init(MT / 256, 4, 0, 0, 0, G, G - 1 - bx); pg8::gemm_phase<EpiUkv, pg8::RectOrder, true, true>(lds, g, S, E); } }
        }
        SEAM(7);
    }
    if (IN(8)) { asm volatile("" : "+s"(AP)); PH_IDS;
        for (int rep_ = 0; rep_ < NREP(8) + NREP(12) - 1; ++rep_) { for (int ch = bx; ch < 256; ch += G) { STAMP(30); mlstm_chain_mfma<false>(lds, ws, (unsigned char*)I_out, I_o_ib, I_o_fb, ch); STAMP(31); }
        }
        for (int rep_ = 0; rep_ < NREP(8) + NREP(13) - 1; ++rep_) {
        for (int un = vcu; un < 1024; un += G) attn_unit<2>(lds, ws, (unsigned char*)I_out, nullptr, un);
        }
        STAMP(32); SEAM(8); STAMP(33);
    }
    if (IN(9)) { asm volatile("" : "+s"(AP)); PH_IDS; for (int rep_ = 0; rep_ < NREP(9); ++rep_) { if (rep_) __syncthreads();
        p9_readout(ws, (unsigned char*)I_out, I_o_hn, gw, ngw, lane); }
        SEAM(9); }
    if (IN(10)) { asm volatile("" : "+s"(AP)); PH_IDS;
        for (int rep_ = 0; rep_ < NREP(10); ++rep_) { if (rep_) __syncthreads();
        pg8::Gemm g{(const bf16_t*)(ws + WS_U), (const bf16_t*)(ws + WS_WOOUT), ML, 1024, 1024}; pg8::RectOrder S; S.init(ML / 256, 4, 0, 0, 0, G, bx);
        EpiY E{(bf16_t*)(ws + WS_Y), (float*)(ws + WS_SSQY1)}; pg8::gemm_phase<EpiY, pg8::RectOrder, true, true>(lds, g, S, E);
        }
        SEAM(10);
    }
    if (IN(11)) { asm volatile("" : "+s"(AP)); PH_IDS; p11_final(I_post_w + 1024, MOD, (const bf16_t*)(ws + WS_Y), (const float*)(ws + WS_SSQY1), (const bf16_t*)(ws + WS_X1), I_out, gw, ngw, lane);
        if (PROBE_TS >= 0 && bx == 0 && threadIdx.x == 0) { asm volatile("s_waitcnt vmcnt(0)" ::: "memory"); const unsigned long long* ts = (const unsigned long long*)(ws + WS_CTL + 512 * 1024);
            const unsigned long long t1 = (PROBE_TS == 11) ? __builtin_amdgcn_s_memrealtime() : ts[PROBE_TS + 1]; I_out[5 * 1024 * 7 + 3] += floorf((float)(t1 - ts[PROBE_TS]) * 0.01f * (1.f / 50.f)) * 50.f; } }
#undef IN
#undef SEAM
#undef I_x
#undef I_cvec
#undef I_ctx
#undef I_c_ctx
#undef I_mod_w
#undef I_mod_b
#undef I_pre_w
#undef I_post_w
#undef I_e_w_in
#undef I_e_sink
#undef I_e_conv_w
#undef I_e_w_out
#undef I_o_w_in
#undef I_o_qn
#undef I_o_kvn
#undef I_o_w_uq
#undef I_o_w_ukv
#undef I_o_ib
#undef I_o_fb
#undef I_o_hn
#undef I_o_w_out
#undef I_out
}

extern "C" void kernel_launch(void* const* d_in, const int* in_sizes, int n_in, void* d_out, int out_size, void* d_ws, size_t ws_size, hipStream_t stream) {
    static int grid = 0;
    if (grid == 0) {
        if (n_in != 21 || in_sizes[0] != ML * DM || out_size != ML * DM || ws_size < WS_END) { fprintf(stderr, "kernel_launch: unexpected shapes / workspace (n_in %d, ws %zu < %zu); nothing launched\n", n_in, ws_size, (size_t)WS_END); grid = -1; return; }
        int dev = 0, cus = 0, per_cu = 0;
        if (hipGetDevice(&dev) != hipSuccess || hipDeviceGetAttribute(&cus, hipDeviceAttributeMultiprocessorCount, dev) != hipSuccess) { grid = -1; return; }
        if (hipFuncSetAttribute((const void*)hybrid_fwd, hipFuncAttributeMaxDynamicSharedMemorySize, LDS_BYTES) != hipSuccess) { fprintf(stderr, "kernel_launch: hipFuncSetAttribute failed\n"); grid = -1; return; }
        if (hipOccupancyMaxActiveBlocksPerMultiprocessor(&per_cu, (const void*)hybrid_fwd, NTHREADS, LDS_BYTES) != hipSuccess || per_cu < 1) fprintf(stderr, "kernel_launch: note: occupancy query reports %d workgroups per CU\n", per_cu);
        (void)hipGetLastError();
        grid = cus;
    }
    if (grid < 0) return;
    if (hipMemsetAsync((char*)d_ws + WS_CTL, 0, CTL_ZERO_BYTES, stream) != hipSuccess) { fprintf(stderr, "kernel_launch: hipMemsetAsync failed\n"); return; }
    Args a{};
    for (int i = 0; i < 21; ++i) a.in[i] = (const float*)d_in[i];
    a.out = (float*)d_out; a.ws = (unsigned char*)d_ws;
    if (MK_N_LAUNCHES == 1) { a.ph_lo = 0; a.ph_hi = N_PHASES; hipLaunchKernelGGL(hybrid_fwd, dim3(grid), dim3(NTHREADS), LDS_BYTES, stream, a); }
    else for (int p = 0; p < N_PHASES; ++p) { a.ph_lo = p; a.ph_hi = p + 1; hipLaunchKernelGGL(hybrid_fwd, dim3(grid), dim3(NTHREADS), LDS_BYTES, stream, a); }
    const hipError_t le = hipPeekAtLastError();
    if (le != hipSuccess) fprintf(stderr, "kernel_launch: launch failed: %s\n", hipGetErrorName(le));
}
```

```cpp
#include <hip/hip_runtime.h>
#include <cstdio>
#include <cstdint>

#define LAS __attribute__((address_space(3)))
#define GAS __attribute__((address_space(1)))
typedef unsigned short bf16_t;
typedef short bf16x8 __attribute__((ext_vector_type(8)));
typedef short s16x4 __attribute__((ext_vector_type(4)));
typedef float f32x4 __attribute__((ext_vector_type(4)));
typedef float f32x16 __attribute__((ext_vector_type(16)));
typedef unsigned u32x4 __attribute__((ext_vector_type(4)));
typedef unsigned u32x2 __attribute__((ext_vector_type(2)));
typedef float f32x2_t __attribute__((ext_vector_type(2)));
typedef __bf16 bf16x2_t __attribute__((ext_vector_type(2)));

constexpr int NB = 16, SEQ = 2048, DM = 1024, CL = 256;
constexpr int ML = NB * SEQ, MC = NB * CL, MT = ML + MC;
constexpr float EPS = 1e-6f, LOG2E = 1.4426950408889634f;
constexpr int E_N = 3328, O_NSRC = 3632, O_N = 3840;
constexpr int NWAVES = 8, NTHREADS = 512;

__device__ __forceinline__ float bf_lo(unsigned w) { return __uint_as_float(w << 16); }
__device__ __forceinline__ float bf_hi(unsigned w) { return __uint_as_float(w & 0xffff0000u); }
__device__ __forceinline__ unsigned pk2(float lo, float hi) { f32x2_t v = {lo, hi}; bf16x2_t b = __builtin_convertvector(v, bf16x2_t); return __builtin_bit_cast(unsigned, b); }
__device__ __forceinline__ float silu_f(float x) { return x * __builtin_amdgcn_rcpf(1.f + __expf(-x)); }
__device__ __forceinline__ float sigmoid_f(float x) { return __builtin_amdgcn_rcpf(1.f + __expf(-x)); }
__device__ __forceinline__ float wave_sum(float v) {
#pragma unroll
    for (int o = 1; o < 64; o <<= 1) v += __shfl_xor(v, o);
    return v;
}
#define LDS_WAIT() asm volatile("s_waitcnt lgkmcnt(0)" ::: "memory")
#define VM_WAIT() asm volatile("s_waitcnt vmcnt(0)" ::: "memory")

__device__ __forceinline__ int my_tid() { int t = threadIdx.x; asm volatile("" : "+v"(t)); return t; }

namespace pg8 {
#define PG8_LAS __attribute__((address_space(3)))
typedef unsigned short bf16_t;
typedef short bf16x8 __attribute__((ext_vector_type(8)));
typedef float f32x4 __attribute__((ext_vector_type(4)));
typedef unsigned u32x4 __attribute__((ext_vector_type(4)));
constexpr int BM = 256, BK = 64, HALF = 128, HTB = HALF * BK * 2  , STAGE_BYTES = 8 * HTB, NXCD = 8, WGM = 8;

__host__ __device__ __forceinline__ int lds_byte(int r, int c) { const int st = (r >> 4) * 2 + (c >> 5), rr = r & 15, cc = c & 31, ob = rr * 64 + cc * 2; return st * 1024 + (ob ^ (((ob >> 9) & 1) << 5)); }
__host__ __device__ __forceinline__ void stage_rc(int b, int& R, int& C) { const int st = b / 1024, sb = b % 1024, swz = sb ^ (((sb >> 9) & 1) << 5); R = (st >> 1) * 16 + swz / 64; C = (st & 1) * 32 + (swz % 64) / 2; }
__host__ __device__ __forceinline__ int perm32(int rho) { const int n = rho >> 4, i = rho & 15; return 8 * (i >> 2) + 4 * n + (i & 3); }

struct Unit { int pm, pn; };
struct Gemm { const bf16_t* A; const bf16_t* Bt; int M, N, K; };

struct RectOrder {
    int nM0, nN0, n0, pm1, nM1, nN1, n1, G, c;
    __device__ __forceinline__ void init(int nM0_, int nN0_, int pm1_, int nM1_, int nN1_, int G_, int c_) { nM0 = nM0_; nN0 = nN0_; n0 = nM0_ * nN0_; pm1 = pm1_; nM1 = nM1_; nN1 = nN1_; n1 = nM1_ * nN1_; G = G_; c = c_; }
    __device__ __forceinline__ static void rect(int w, int nM, int nN, int& pm, int& pn) {
        const int nig = WGM * nN, gid = w / nig, fm = gid * WGM, gsz = (nM - fm) < WGM ? (nM - fm) : WGM;
        pm = fm + ((w % nig) % gsz); pn = (w % nig) / gsz;
    }
    __device__ __forceinline__ bool next(int i, Unit& u) const {
        const int nwg = n0 + n1; const long L = (long)i * G + c; if (L >= nwg) return false;
        int wgid = (int)L; { const int q = nwg / NXCD, r = nwg % NXCD, xcd = wgid % NXCD, off = wgid / NXCD; wgid = (xcd < r ? xcd * (q + 1) : r * (q + 1) + (xcd - r) * q) + off; }
        if (wgid < n0) rect(wgid, nM0, nN0, u.pm, u.pn); else { rect(wgid - n0, nM1, nN1, u.pm, u.pn); u.pm += pm1; }
        return true;
    }
    __device__ __forceinline__ void a_ready(const Unit&) const {}
    __device__ __forceinline__ void done(const Unit&) const {}
};

struct ListOrder4 {
    int start, cnt;
    __device__ __forceinline__ bool next(int i, Unit& u) const { if (i >= cnt) return false; const int L = start + i; u.pm = L >> 2; u.pn = L & 3; return true; }
    __device__ __forceinline__ void a_ready(const Unit&) const {}
    __device__ __forceinline__ void done(const Unit&) const {}
};

struct PanelOrder {
    int nM0, nN0, nN1, total, first, step, cnt;
    const unsigned* ready; unsigned need; unsigned* tmo;
    __device__ __forceinline__ bool next(int i, Unit& u) const {
        if (i >= cnt) return false; int L = first + step * i; if (L >= total) return false;
        const int n0 = nM0 * nN0; if (L < n0) { u.pm = L / nN0; u.pn = L - u.pm * nN0; } else { L -= n0; const int q = L / nN1; u.pm = nM0 + q; u.pn = L - q * nN1; }
        return true;
    }
    __device__ __forceinline__ void a_ready(const Unit& u) const {
        if (ready == nullptr) return;
        if (threadIdx.x < 64) {
            const unsigned long long t0 = __builtin_amdgcn_s_memrealtime(); unsigned polls = 0;
            while ((unsigned)__builtin_amdgcn_readfirstlane(__hip_atomic_load(ready + 64 * u.pm, __ATOMIC_RELAXED, __HIP_MEMORY_SCOPE_AGENT)) < need) {
                if ((++polls & 255u) == 0u && __builtin_amdgcn_readfirstlane(__hip_atomic_load(tmo, __ATOMIC_RELAXED, __HIP_MEMORY_SCOPE_AGENT)) != 0u) break;
                if (__builtin_amdgcn_s_memrealtime() - t0 > 2000000ull) { if (threadIdx.x == 0) __hip_atomic_store(tmo, 1u, __ATOMIC_RELAXED, __HIP_MEMORY_SCOPE_AGENT); break; }
                __builtin_amdgcn_s_sleep(2); }
            asm volatile("s_waitcnt vmcnt(0)" ::: "memory");
        }
        asm volatile("" ::: "memory"); __builtin_amdgcn_s_barrier(); asm volatile("" ::: "memory");
    }
    __device__ __forceinline__ void done(const Unit&) const {}
};

template <class Epi, class Sched, bool ALIGN_EPI = false, bool SP2 = false>
__device__ __forceinline__ void gemm_phase(PG8_LAS unsigned char* lds, const Gemm g, const Sched& S, const Epi& E) {
    const int tid = my_tid(), wid = __builtin_amdgcn_readfirstlane(tid >> 6), lane = tid & 63, wr = wid >> 2, wc = wid & 3, fr = lane & 15, fq = lane >> 4;
    const int K = g.K, nt = K / BK;
    unsigned voffA[2], voffB[2];
#pragma unroll
    for (int i = 0; i < 2; ++i) { int R, C; stage_rc(tid * 16 + i * 8192, R, C); const int Rb = Epi::PERM ? ((R & ~31) + perm32(R & 31)) : R;
        voffA[i] = (unsigned)(R * K + C) * 2u; voffB[i] = (unsigned)(Rb * K + C) * 2u; }
    const size_t kstep = (size_t)(BK * 2);
    const size_t hstep = (size_t)HALF * K * 2;
    const size_t tstep = 2 * hstep;
    const unsigned ldsw = (unsigned)wid * 1024u;
    const int aoff = lds_byte(wr * 64 + fr, fq * 8), boff = lds_byte(wc * 32 + fr, fq * 8);
#define PG8_SA(b, h) (((b) * 2 + (h)) * HTB)
#define PG8_SB(b, h) ((4 + (b) * 2 + (h)) * HTB)
#define PG8_STAGE(bufoff, gbase, voff) do { _Pragma("unroll") for (int _i = 0; _i < 2; ++_i) \
        __builtin_amdgcn_global_load_lds((const unsigned*)((const char*)(gbase) + (voff)[_i]), (PG8_LAS unsigned*)(lds + (bufoff) + ldsw + _i * 8192), 16, 0, 0); } while (0)
#define PG8_LDA(dst, b, h) do { _Pragma("unroll") for (int m = 0; m < 4; ++m) _Pragma("unroll") for (int k = 0; k < 2; ++k) dst[m][k] = *(const PG8_LAS bf16x8*)(lds + PG8_SA(b, h) + aoff + m * 2048 + k * 1024); } while (0)
#define PG8_LDB(dst, b, h) do { _Pragma("unroll") for (int n = 0; n < 2; ++n) _Pragma("unroll") for (int k = 0; k < 2; ++k) dst[n][k] = *(const PG8_LAS bf16x8*)(lds + PG8_SB(b, h) + boff + n * 2048 + k * 1024); } while (0)
#define PG8_MMA(ai, bj, At, Bt) do { __builtin_amdgcn_s_setprio(1); _Pragma("unroll") for (int m = 0; m < 4; ++m) _Pragma("unroll") for (int n = 0; n < 2; ++n) _Pragma("unroll") for (int k = 0; k < 2; ++k) \
        acc[ai][bj][m][n] = __builtin_amdgcn_mfma_f32_16x16x32_bf16(Bt[n][k], At[m][k], acc[ai][bj][m][n], 0, 0, 0); __builtin_amdgcn_s_setprio(0); } while (0)
#define PG8_WAIT_V(n) asm volatile("s_waitcnt vmcnt(" #n ")" ::: "memory")
#define PG8_WAIT_L(n) asm volatile("s_waitcnt lgkmcnt(" #n ")" ::: "memory")
#define PG8_BAR __builtin_amdgcn_s_barrier()
#define PG8_SCHED __builtin_amdgcn_sched_barrier(0)
    Unit cur, nxt; int ui = 0;
    if (!S.next(0, cur)) return;
    f32x4 acc[2][2][4][2];
#pragma unroll
    for (int a = 0; a < 2; ++a)
#pragma unroll
        for (int b = 0; b < 2; ++b)
#pragma unroll
            for (int m = 0; m < 4; ++m)
#pragma unroll
                for (int n = 0; n < 2; ++n) acc[a][b][m][n] = (f32x4){0.f, 0.f, 0.f, 0.f};
    bf16x8 At[4][2], B0[2][2], B1[2][2];
    const char* cA = (const char*)g.A + (size_t)cur.pm * tstep; const char* cB = (const char*)g.Bt + (size_t)cur.pn * tstep;
    S.a_ready(cur);
    if constexpr (SP2) {
        PG8_STAGE(PG8_SB(0, 0), cB, voffB); PG8_STAGE(PG8_SB(0, 1), cB + hstep, voffB); PG8_STAGE(PG8_SA(0, 0), cA, voffA); PG8_STAGE(PG8_SA(0, 1), cA + hstep, voffA);
        if (wr == 1) PG8_BAR;
        PG8_WAIT_V(2); PG8_BAR;
        PG8_STAGE(PG8_SB(1, 0), cB + kstep, voffB); PG8_STAGE(PG8_SA(1, 0), cA + kstep, voffA); PG8_STAGE(PG8_SB(1, 1), cB + hstep + kstep, voffB);
        PG8_WAIT_V(6); PG8_BAR;
    } else {
        PG8_STAGE(PG8_SB(0, 0), cB, voffB); PG8_STAGE(PG8_SA(0, 0), cA, voffA); PG8_STAGE(PG8_SB(0, 1), cB + hstep, voffB); PG8_STAGE(PG8_SA(0, 1), cA + hstep, voffA);
        if (wr == 1) PG8_BAR;
        PG8_WAIT_V(4); PG8_BAR;
        PG8_STAGE(PG8_SB(1, 0), cB + kstep, voffB); PG8_STAGE(PG8_SA(1, 0), cA + kstep, voffA); PG8_STAGE(PG8_SB(1, 1), cB + hstep + kstep, voffB);
        PG8_WAIT_V(6); PG8_BAR;
    }
    for (;;) {
        const bool has_next = S.next(ui + 1, nxt);
        const char* nA = has_next ? (const char*)g.A + (size_t)nxt.pm * tstep : cA; const char* nB = has_next ? (const char*)g.Bt + (size_t)nxt.pn * tstep : cB;
        for (int t = 0; t < nt; t += 2) {
            const bool last = (t == nt - 2);
            const char* a1 = cA + (size_t)(t + 1) * kstep;
            const char* a2 = last ? nA : cA + (size_t)(t + 2) * kstep; const char* b2 = last ? nB : cB + (size_t)(t + 2) * kstep;
            const char* a3 = a2 + kstep; const char* b3 = b2 + kstep;
            if (last && has_next) S.a_ready(nxt);
            if constexpr (SP2) {
            PG8_LDB(B0, 0, 0); PG8_LDB(B1, 0, 1); PG8_SCHED; PG8_LDA(At, 0, 0); PG8_STAGE(PG8_SA(1, 1), a1 + hstep, voffA);
            PG8_WAIT_V(8); PG8_WAIT_L(0); PG8_BAR; PG8_MMA(0, 0, At, B0); PG8_MMA(0, 1, At, B1); PG8_BAR; PG8_SCHED;
            PG8_LDA(At, 0, 1); PG8_STAGE(PG8_SB(0, 0), b2, voffB); PG8_STAGE(PG8_SB(0, 1), b2 + hstep, voffB); PG8_STAGE(PG8_SA(0, 0), a2, voffA);
            PG8_WAIT_V(8); PG8_WAIT_L(0); PG8_BAR; PG8_MMA(1, 0, At, B0); PG8_MMA(1, 1, At, B1); PG8_BAR; PG8_SCHED;
            PG8_LDB(B0, 1, 0); PG8_LDB(B1, 1, 1); PG8_SCHED; PG8_LDA(At, 1, 0); PG8_STAGE(PG8_SA(0, 1), a2 + hstep, voffA);
            PG8_WAIT_V(8); PG8_WAIT_L(0); PG8_BAR; PG8_MMA(0, 0, At, B0); PG8_MMA(0, 1, At, B1); PG8_BAR; PG8_SCHED;
            PG8_LDA(At, 1, 1); PG8_STAGE(PG8_SB(1, 0), b3, voffB); PG8_STAGE(PG8_SB(1, 1), b3 + hstep, voffB); PG8_STAGE(PG8_SA(1, 0), a3, voffA);
            PG8_WAIT_V(8); PG8_WAIT_L(0); PG8_BAR; PG8_MMA(1, 0, At, B0); PG8_MMA(1, 1, At, B1); PG8_BAR; PG8_SCHED;
            } else {
            PG8_LDB(B0, 0, 0); PG8_SCHED; PG8_LDA(At, 0, 0); PG8_STAGE(PG8_SA(1, 1), a1 + hstep, voffA);
            PG8_WAIT_L(8); PG8_BAR; PG8_WAIT_L(0); PG8_MMA(0, 0, At, B0); PG8_BAR; PG8_SCHED;
            PG8_LDB(B1, 0, 1); PG8_STAGE(PG8_SB(0, 0), b2, voffB);
            PG8_BAR; PG8_WAIT_L(0); PG8_MMA(0, 1, At, B1); PG8_BAR;
            PG8_LDA(At, 0, 1); PG8_STAGE(PG8_SA(0, 0), a2, voffA);
            PG8_BAR; PG8_WAIT_L(0); PG8_MMA(1, 0, At, B0); PG8_BAR; PG8_SCHED;
            PG8_STAGE(PG8_SB(0, 1), b2 + hstep, voffB);
            PG8_WAIT_V(6); PG8_BAR; PG8_MMA(1, 1, At, B1); PG8_BAR;
            PG8_LDB(B0, 1, 0); PG8_SCHED; PG8_LDA(At, 1, 0); PG8_STAGE(PG8_SA(0, 1), a2 + hstep, voffA);
            PG8_WAIT_L(8); PG8_BAR; PG8_WAIT_L(0); PG8_MMA(0, 0, At, B0); PG8_BAR; PG8_SCHED;
            PG8_LDB(B1, 1, 1); PG8_STAGE(PG8_SB(1, 0), b3, voffB);
            PG8_BAR; PG8_WAIT_L(0); PG8_MMA(0, 1, At, B1); PG8_BAR;
            PG8_LDA(At, 1, 1); PG8_STAGE(PG8_SA(1, 0), a3, voffA);
            PG8_BAR; PG8_WAIT_L(0); PG8_MMA(1, 0, At, B0); PG8_BAR; PG8_SCHED;
            PG8_STAGE(PG8_SB(1, 1), b3 + hstep, voffB);
            PG8_WAIT_V(6); PG8_BAR; PG8_MMA(1, 1, At, B1); PG8_BAR;
            }
        }
        if constexpr (ALIGN_EPI) { if (wr == 0) PG8_BAR; }
        if constexpr (!Epi::AFTER_DRAIN) { E(acc, cur, wr, wc, fr, fq); S.done(cur); }
        if (!has_next) break;
#pragma unroll
        for (int a = 0; a < 2; ++a)
#pragma unroll
            for (int b = 0; b < 2; ++b)
#pragma unroll
                for (int m = 0; m < 4; ++m)
#pragma unroll
                    for (int n = 0; n < 2; ++n) acc[a][b][m][n] = (f32x4){0.f, 0.f, 0.f, 0.f};
        cur = nxt; cA = nA; cB = nB; ++ui;
        if constexpr (ALIGN_EPI) { if (wr == 1) PG8_BAR; }
    }
    PG8_WAIT_V(0);
    if constexpr (!ALIGN_EPI) { if (wr == 0) PG8_BAR; }
    PG8_BAR;
    if constexpr (Epi::AFTER_DRAIN) { E.fused(acc, cur, wr, wc, fr, fq, lds, wid, lane); S.done(cur); }
#undef PG8_SA
#undef PG8_SB
#undef PG8_STAGE
#undef PG8_LDA
#undef PG8_LDB
#undef PG8_MMA
#undef PG8_WAIT_V
#undef PG8_WAIT_L
#undef PG8_BAR
#undef PG8_SCHED
}
}

constexpr size_t MiB = 1u << 20;
constexpr size_t WS_CTL = 0, CTL_ZERO_BYTES = 128 * 1024;
constexpr int CW_PANEL = 8192, PANEL_BANK = 144 * 64;
constexpr size_t WS_MOD = 1 * MiB;
constexpr size_t WS_ROPEA = 2 * MiB;
constexpr size_t WS_ROPEC = 2 * MiB + 512 * 1024;
constexpr size_t WS_WEIN = 3 * MiB, WS_WEOUT = 10 * MiB, WS_WOIN = 12 * MiB, WS_WUQ = 20 * MiB, WS_WUKV = 21 * MiB + 512 * 1024, WS_WOOUT = 22 * MiB;
constexpr size_t WS_H = 24 * MiB;
constexpr size_t WS_U = 96 * MiB;
constexpr size_t WS_Y = 168 * MiB;
constexpr size_t WS_R = 240 * MiB;
constexpr size_t WS_KVE = WS_R  , WS_QE = WS_R + 18 * MiB, WS_PE = WS_R + 54 * MiB, WS_GE = WS_R + 90 * MiB, WS_ZA = WS_R + 126 * MiB, WS_SSQY0 = WS_R + 241 * MiB  ;
constexpr size_t WS_CKV = WS_R, WS_CQ = WS_R + 18 * MiB, WS_HM = WS_R  , WS_MK = WS_R + 66 * MiB, WS_MV = WS_R + 84 * MiB, WS_KR = WS_R + 120 * MiB, WS_GATES = WS_R + 123 * MiB,
                 WS_SSQCKV = WS_R + 126 * MiB, WS_SSQCQ = WS_R + 127 * MiB, WS_X1 = WS_R + 129 * MiB  , WS_SSQY1 = WS_R + 241 * MiB;
constexpr size_t AUX_MQ = 0, AUX_MO = 16 * MiB, AUX_ZO = 48 * MiB;
constexpr size_t WS_KNV = WS_H  , WS_QO = WS_Y;
constexpr size_t WS_END = WS_R + 244 * MiB;
static_assert(WS_ZA + (size_t)MT * 512 * 2 <= WS_R + 162 * MiB && WS_X1 + (size_t)ML * 1024 * 2 <= WS_R + 241 * MiB && WS_HM + (size_t)2 * ML * 512 * 2 <= WS_MK && WS_SSQY1 + (size_t)MT * 16 * 4 <= WS_END, "ws map");

__device__ __forceinline__ void st8(bf16_t* p, f32x4 a, f32x4 b) { u32x4 w; w.x = pk2(a[0], a[1]); w.y = pk2(a[2], a[3]); w.z = pk2(b[0], b[1]); w.w = pk2(b[2], b[3]); *(u32x4*)p = w; }
__device__ __forceinline__ bf16_t f2bf(float v) { return (bf16_t)(pk2(v, 0.f) & 0xffffu); }
__device__ __forceinline__ void rope8(f32x4& a, f32x4& b, const float* cosp, const float* sinp) {
    const f32x4 cs = *(const f32x4*)cosp, sn = *(const f32x4*)sinp;
    const float a0 = a[0] * cs[0] - a[1] * sn[0], a1 = a[0] * sn[0] + a[1] * cs[0], a2 = a[2] * cs[1] - a[3] * sn[1], a3 = a[2] * sn[1] + a[3] * cs[1];
    const float b0 = b[0] * cs[2] - b[1] * sn[2], b1 = b[0] * sn[2] + b[1] * cs[2], b2 = b[2] * cs[3] - b[3] * sn[3], b3 = b[2] * sn[3] + b[3] * cs[3];
    a = (f32x4){a0, a1, a2, a3}; b = (f32x4){b0, b1, b2, b3};
}
__device__ __forceinline__ f32x4 silu4(f32x4 v) { return (f32x4){silu_f(v[0]), silu_f(v[1]), silu_f(v[2]), silu_f(v[3])}; }
__device__ __forceinline__ f32x4 sigm4(f32x4 v) { return (f32x4){sigmoid_f(v[0]), sigmoid_f(v[1]), sigmoid_f(v[2]), sigmoid_f(v[3])}; }
__device__ __forceinline__ float sq4(f32x4 v) { return (v[0] * v[0] + v[1] * v[1]) + (v[2] * v[2] + v[3] * v[3]); }

struct EpiEin {
    static constexpr bool PERM = true, AFTER_DRAIN = false;
    unsigned char* ws;
    __device__ __forceinline__ void operator()(const f32x4 (&acc)[2][2][4][2], const pg8::Unit& u, int wr, int wc, int fr, int fq) const {
        const int pn = u.pn, rbase = u.pm * 256 + wr * 64 + fr, cw = wc * 32 + 8 * fq;
        const float* ropeA = (const float*)(ws + WS_ROPEA);
#pragma unroll
        for (int ai = 0; ai < 2; ++ai)
#pragma unroll
            for (int m = 0; m < 4; ++m) {
                asm volatile("" ::: "memory"); const int R = rbase + ai * 128 + m * 16; const bool lat = R < ML; const int pos = R & 2047;
                if (pn == 0) {
                    f32x4 a = acc[ai][0][m][0], b = acc[ai][0][m][1];
                    if (lat) { const int i0 = (cw & 63) >> 1; rope8(a, b, ropeA + pos * 64 + i0, ropeA + pos * 64 + 32 + i0); }
                    st8((bf16_t*)(ws + WS_KVE) + (size_t)R * 256 + cw, a, b);
                    st8((bf16_t*)(ws + WS_KVE) + (size_t)R * 256 + 128 + cw, acc[ai][1][m][0], acc[ai][1][m][1]);
                } else if (pn <= 2) {
#pragma unroll
                    for (int bj = 0; bj < 2; ++bj) {
                        f32x4 a = acc[ai][bj][m][0], b = acc[ai][bj][m][1];
                        if (lat) { const int i0 = (cw & 63) >> 1; rope8(a, b, ropeA + pos * 64 + i0, ropeA + pos * 64 + 32 + i0); }
                        const float sc = 0.125f * LOG2E; a = a * sc; b = b * sc;
                        st8((bf16_t*)(ws + WS_QE) + (size_t)R * 512 + (pn - 1) * 256 + bj * 128 + cw, a, b);
                    }
                } else if (pn <= 6) {
                    st8((bf16_t*)(ws + WS_PE) + (size_t)R * 512 + (pn - 3) * 128 + cw, acc[ai][0][m][0] * acc[ai][1][m][0], acc[ai][0][m][1] * acc[ai][1][m][1]);
                } else if (pn <= 10) {
                    st8((bf16_t*)(ws + WS_GE) + (size_t)R * 512 + (pn - 7) * 128 + cw, acc[ai][0][m][0] * silu4(acc[ai][1][m][0]), acc[ai][0][m][1] * silu4(acc[ai][1][m][1]));
                } else {
#pragma unroll
                    for (int bj = 0; bj < 2; ++bj)
                        st8((bf16_t*)(ws + WS_ZA) + (size_t)R * 512 + (pn - 11) * 256 + bj * 128 + cw, silu4(acc[ai][bj][m][0]), silu4(acc[ai][bj][m][1]));
                }
            }
    }
};

struct EpiY {
    static constexpr bool PERM = true, AFTER_DRAIN = false;
    bf16_t* Y; float* SSQ;
    __device__ __forceinline__ void operator()(const f32x4 (&acc)[2][2][4][2], const pg8::Unit& u, int wr, int wc, int fr, int fq) const {
        const int pn = u.pn, rbase = u.pm * 256 + wr * 64 + fr, cw = wc * 32 + 8 * fq;
#pragma unroll
        for (int ai = 0; ai < 2; ++ai)
#pragma unroll
            for (int m = 0; m < 4; ++m) {
                asm volatile("" ::: "memory"); const int R = rbase + ai * 128 + m * 16; float s = 0.f;
#pragma unroll
                for (int bj = 0; bj < 2; ++bj) { st8(Y + (size_t)R * 1024 + pn * 256 + bj * 128 + cw, acc[ai][bj][m][0], acc[ai][bj][m][1]); s += sq4(acc[ai][bj][m][0]) + sq4(acc[ai][bj][m][1]); }
                s += __shfl_xor(s, 16); s += __shfl_xor(s, 32);
                if (fq == 0) SSQ[(size_t)R * 16 + pn * 4 + wc] = s;
            }
    }
};

struct EpiOin {
    static constexpr bool PERM = true, AFTER_DRAIN = false;
    unsigned char* ws; unsigned char* aux;
    __device__ __forceinline__ void operator()(const f32x4 (&acc)[2][2][4][2], const pg8::Unit& u, int wr, int wc, int fr, int fq) const {
        const int pn = u.pn, rbase = u.pm * 256 + wr * 64 + fr, cw = wc * 32 + 8 * fq;
        const float* ropeC = (const float*)(ws + WS_ROPEC);
#pragma unroll
        for (int ai = 0; ai < 2; ++ai)
#pragma unroll
            for (int m = 0; m < 4; ++m) {
                asm volatile("" ::: "memory"); const int R = rbase + ai * 128 + m * 16; const bool lat = R < ML; const int pos = R & 2047;
                if (pn == 0 || (pn >= 5 && pn <= 7)) {
                    float s = 0.f;
                    bf16_t* dst = (pn == 0) ? (bf16_t*)(ws + WS_CKV) + (size_t)R * 256 : (bf16_t*)(ws + WS_CQ) + (size_t)R * 768 + (pn - 5) * 256;
#pragma unroll
                    for (int bj = 0; bj < 2; ++bj) { st8(dst + bj * 128 + cw, acc[ai][bj][m][0], acc[ai][bj][m][1]); s += sq4(acc[ai][bj][m][0]) + sq4(acc[ai][bj][m][1]); }
                    s += __shfl_xor(s, 16); s += __shfl_xor(s, 32);
                    if (fq == 0) { if (pn == 0) ((float*)(ws + WS_SSQCKV))[(size_t)R * 4 + wc] = s; else ((float*)(ws + WS_SSQCQ))[(size_t)R * 12 + (pn - 5) * 4 + wc] = s; }
                } else if (pn == 4) {
                    if (wc == 0) {
                        f32x4 a = acc[ai][0][m][0], b = acc[ai][0][m][1];
                        if (lat) { const int i0 = cw >> 1; rope8(a, b, ropeC + pos * 32 + i0, ropeC + pos * 32 + 16 + i0); }
                        st8((bf16_t*)(ws + WS_KR) + (size_t)R * 32 + cw, a, b);
                    } else if (wc == 1 && fq < 2) {
                        float* g = (float*)(ws + WS_GATES) + (size_t)R * 16 + 8 * fq;
                        *(f32x4*)g = acc[ai][0][m][0]; *(f32x4*)(g + 4) = acc[ai][0][m][1];
                    }
                } else {
#pragma unroll
                    for (int bj = 0; bj < 2; ++bj) {
                        const f32x4 a = acc[ai][bj][m][0], b = acc[ai][bj][m][1]; const int col = bj * 128 + cw;
                        if (pn == 1) st8((bf16_t*)(ws + WS_MK) + (size_t)R * 256 + col, a * 0.125f, b * 0.125f);
                        else if (pn <= 3) st8((bf16_t*)(ws + WS_MV) + (size_t)R * 512 + (pn - 2) * 256 + col, a, b);
                        else if (pn == 8) st8((bf16_t*)(aux + AUX_MQ) + (size_t)R * 256 + col, a, b);
                        else if (pn >= 13) st8((bf16_t*)(aux + AUX_ZO) + (size_t)R * 512 + (pn - 13) * 256 + col, silu4(a), silu4(b));
                        else if (bj == 0) st8((bf16_t*)(aux + AUX_MO) + (size_t)R * 512 + (pn - 9) * 128 + cw, sigm4(a) * silu4(acc[ai][1][m][0]), sigm4(b) * silu4(acc[ai][1][m][1]));
                    }
                }
            }
    }
};

struct EpiUkv {
    static constexpr bool PERM = true, AFTER_DRAIN = false;
    unsigned char* ws;
    __device__ __forceinline__ void operator()(const f32x4 (&acc)[2][2][4][2], const pg8::Unit& u, int wr, int wc, int fr, int fq) const {
        const int pn = u.pn, rbase = u.pm * 256 + wr * 64 + fr, cw = wc * 32 + 8 * fq;
#pragma unroll
        for (int ai = 0; ai < 2; ++ai)
#pragma unroll
            for (int m = 0; m < 4; ++m) {
                asm volatile("" ::: "memory"); const int R = rbase + ai * 128 + m * 16;
                const f32x4 sp = *(const f32x4*)((const float*)(ws + WS_SSQCKV) + (size_t)R * 4);
                const float rstd = rsqrtf(((sp[0] + sp[1]) + (sp[2] + sp[3])) * (1.f / 256.f) + EPS);
                int b, pos; if (R < ML) { b = R >> 11; pos = 256 + (R & 2047); } else { const int rc = R - ML; b = rc >> 8; pos = rc & 255; }
#pragma unroll
                for (int bj = 0; bj < 2; ++bj) {
                    const int head = pn * 2 + bj;
                    st8((bf16_t*)(ws + WS_KNV) + ((size_t)(b * 8 + head) * 2304 + pos) * 128 + cw, acc[ai][bj][m][0] * rstd, acc[ai][bj][m][1] * rstd);
                }
            }
    }
};

struct EpiUq {
    static constexpr bool PERM = true, AFTER_DRAIN = false;
    unsigned char* ws; LAS unsigned char* lds;
    __device__ __forceinline__ void operator()(const f32x4 (&acc)[2][2][4][2], const pg8::Unit& u, int wr, int wc, int fr, int fq) const {
        const int pn = u.pn, rbase = u.pm * 256 + wr * 64 + fr, cw = wc * 32 + 8 * fq;
        const float* ropeC = (const float*)(ws + WS_ROPEC);
        LAS float* rt = (LAS float*)(lds + pg8::STAGE_BYTES + 8192);
        { const int t = (wr * 4 + wc) * 64 + fq * 16 + fr;
          if (t < 256) { const float* sp = (const float*)(ws + WS_SSQCQ) + (size_t)(u.pm * 256 + t) * 12;
              const f32x4 s0 = *(const f32x4*)sp, s1 = *(const f32x4*)(sp + 4), s2 = *(const f32x4*)(sp + 8);
              const float ss = (((s0[0] + s0[1]) + (s0[2] + s0[3])) + ((s1[0] + s1[1]) + (s1[2] + s1[3]))) + ((s2[0] + s2[1]) + (s2[2] + s2[3]));
              rt[t] = rsqrtf(ss * (1.f / 768.f) + EPS) * (0.10206207261596575f * LOG2E); }
          asm volatile("s_waitcnt lgkmcnt(0)" ::: "memory"); __builtin_amdgcn_s_barrier(); asm volatile("" ::: "memory"); }
#pragma unroll
        for (int ai = 0; ai < 2; ++ai)
#pragma unroll
            for (int m = 0; m < 4; ++m) {
                asm volatile("" ::: "memory"); const int R = rbase + ai * 128 + m * 16, pos = R & 2047;
                const float sc = rt[wr * 64 + fr + ai * 128 + m * 16];
#pragma unroll
                for (int bj = 0; bj < 2; ++bj) {
                    const int c = pn * 256 + bj * 128 + cw, head = c / 96, dd = c - head * 96;
                    f32x4 a = acc[ai][bj][m][0], b = acc[ai][bj][m][1];
                    if (dd >= 64) { const int i0 = (dd - 64) >> 1; rope8(a, b, ropeC + pos * 32 + i0, ropeC + pos * 32 + 16 + i0); }
                    st8((bf16_t*)(ws + WS_QO) + (size_t)R * 768 + c, a * sc, b * sc);
                }
            }
    }
};

#define RLX_AGENT __ATOMIC_RELAXED, __HIP_MEMORY_SCOPE_AGENT
#define XB_TMO      128
#define XB_XCNT(j)  (256  + 64 * (j))
#define XB_XSUB(j)  (1280 + 64 * (j))
#define XB_XGEN(j)  (2304 + 64 * (j))
#define XB_TOP      3328
#define XB_TOPGEN   3392
#define XCD_BAR_WORDS 3456
#define XB_SPIN_CAP (1u << 18)

__device__ __forceinline__ unsigned xb_ld(unsigned* p)              { return __hip_atomic_load(p, __ATOMIC_RELAXED, __HIP_MEMORY_SCOPE_AGENT); }
__device__ __forceinline__ unsigned xb_add(unsigned* p, unsigned v) { return __hip_atomic_fetch_add(p, v, __ATOMIC_RELAXED, __HIP_MEMORY_SCOPE_AGENT); }
__device__ __forceinline__ unsigned xb_xcc_id() { return (unsigned)__builtin_amdgcn_s_getreg((3 << 11) | 20) & 0xFu; }
#define XB_SPIN(cond, bar) do { unsigned _sp = 0; while (cond) { __builtin_amdgcn_s_sleep(1); \
    if ((++_sp & 255u) == 0u) { if (xb_ld(&(bar)[XB_TMO])) break; if (_sp > XB_SPIN_CAP) { atomicAdd(&(bar)[XB_TMO], 1u); break; } } } } while (0)

struct XcdBarrier {
    unsigned* bar; unsigned x;
    volatile LAS unsigned* st;
};

__device__ __forceinline__ XcdBarrier xcd_barrier_post(unsigned* bar, volatile LAS unsigned* st) {
    XcdBarrier b; b.bar = bar; b.x = xb_xcc_id(); b.st = st;
    if (threadIdx.x == 0) (void)xb_add(&bar[XB_XCNT(b.x)], 1u);
    return b;
}
__device__ __forceinline__ void xcd_barrier_complete(unsigned* bar, unsigned x, unsigned& nloc, unsigned& nx) {
    const unsigned G = gridDim.x * gridDim.y * gridDim.z;
    unsigned sum, cnt, mine, sp = 0u;
    for (;;) {
        sum = 0u; cnt = 0u; mine = 0u;
#pragma unroll
        for (unsigned j = 0; j < 16; ++j) { const unsigned c = xb_ld(&bar[XB_XCNT(j)]); sum += c; cnt += (c > 0u) ? 1u : 0u; mine = (j == x) ? c : mine; }
        if (sum == G) break;
        __builtin_amdgcn_s_sleep(1);
        if ((++sp & 255u) == 0u) { if (xb_ld(&bar[XB_TMO])) break; if (sp > XB_SPIN_CAP) { atomicAdd(&bar[XB_TMO], 1u); break; } }
    }
    nloc = mine > 0u ? mine : 1u; nx = cnt > 0u ? cnt : 1u;
}

__device__ __forceinline__ void xcd_barrier(const XcdBarrier& b) {
    asm volatile("s_waitcnt vmcnt(0)" ::: "memory");
    __syncthreads();
    if (threadIdx.x == 0) {
        unsigned* bar = b.bar;
        __builtin_amdgcn_s_waitcnt(0);
        unsigned nloc = b.st[0], nx = b.st[1];
        if (nloc == 0u) { xcd_barrier_complete(bar, b.x, nloc, nx); b.st[0] = nloc; b.st[1] = nx; }
        const unsigned old = xb_add(&bar[XB_XSUB(b.x)], 1u);
        asm volatile("buffer_inv sc1" ::: "memory");
        const unsigned gen = old / nloc;
        if (old + 1u == (gen + 1u) * nloc) {
            __builtin_amdgcn_fence(__ATOMIC_RELEASE, "agent");
            asm volatile("s_waitcnt vmcnt(0)" ::: "memory");
            (void)xb_add(&bar[XB_TOP], 1u);
        }
        const unsigned target = (gen + 1u) * nx;
        XB_SPIN((int)(xb_ld(&bar[XB_TOP]) - target) < 0, bar);
        asm volatile("s_waitcnt vmcnt(0)" ::: "memory");
    }
    __syncthreads();
}

__device__ __forceinline__ int crow(int r, int hi) { return (r & 3) + 8 * (r >> 2) + 4 * hi; }
typedef short v4i16_t __attribute__((ext_vector_type(4)));
__device__ __forceinline__ s16x4 vtr(const LAS unsigned char* p) { return __builtin_bit_cast(s16x4, __builtin_amdgcn_ds_read_tr16_b64_v4i16((LAS v4i16_t*)p)); }

template <int MODE>
__device__ __forceinline__ void attn_unit(LAS unsigned char* lds, unsigned char* ws, unsigned char* aux, const float* sink, int unit) {
    constexpr int DQK = (MODE == 2) ? 96 : 64, KST = DQK / 16, KS = DQK * 2 + 16, VS = 192, KBUF = 64 * KS, VBUF = 64 * VS;
    const int tid = my_tid(), lane = tid & 63, wid = __builtin_amdgcn_readfirstlane(tid >> 6), r32 = lane & 31, hi = lane >> 5;
    int b, head, hkv = 0, n = 0, Rq0, qpos0 = 0, nt, jlo = 0;
    const bf16_t* Qp; int qstride;
    if (MODE == 0) {
        const int hp = unit & 1; n = (unit >> 1) & 15; hkv = (unit >> 5) & 1; b = unit >> 6;
        head = hkv * 4 + hp * 2 + (wid >> 2); qpos0 = 128 * n + 32 * (wid & 3); Rq0 = b * 2048 + qpos0;
        Qp = (const bf16_t*)(ws + WS_QE) + (size_t)Rq0 * 512 + head * 64; qstride = 512;
        jlo = (n == 0) ? 2 : 0; const int jhi = (n == 15) ? 4 : 6; nt = 4 + (jhi - jlo);
    } else if (MODE == 1) {
        const int qh = unit & 1, hp = (unit >> 1) & 1; hkv = (unit >> 2) & 1; b = unit >> 3;
        head = hkv * 4 + hp * 2 + (wid >> 2); Rq0 = ML + b * 256 + 128 * qh + 32 * (wid & 3);
        Qp = (const bf16_t*)(ws + WS_QE) + (size_t)Rq0 * 512 + head * 64; qstride = 512; nt = 4;
    } else {
        const int qb = unit & 7; head = (unit >> 3) & 7; b = unit >> 6; Rq0 = b * 2048 + 256 * qb + 32 * wid;
        Qp = (const bf16_t*)(ws + WS_QO) + (size_t)Rq0 * 768 + head * 96; qstride = 768; nt = 36;
    }
    bf16x8 qf[KST];
#pragma unroll
    for (int s = 0; s < KST; ++s) qf[s] = *(const bf16x8*)(Qp + (size_t)r32 * qstride + 16 * s + 8 * hi);
    constexpr float THR = 6.0f;
    float mref, l_run;
    if (MODE == 2) { mref = 0.f; l_run = 0.f; } else { mref = sink[head] * LOG2E; l_run = (hi == 0) ? 1.f : 0.f; }
    f32x16 negm;
#pragma unroll
    for (int r = 0; r < 16; ++r) negm[r] = -mref;
    f32x16 o0, o1;
#pragma unroll
    for (int r = 0; r < 16; ++r) { o0[r] = 0.f; o1[r] = 0.f; }

    const int srow = tid >> 3, sch = tid & 7;
    const int voff = (4 * hi + ((lane & 15) >> 2)) * VS + (((lane >> 4) & 1) * 16 + 4 * (lane & 3)) * 2;
    u32x4 kregA, vregA, kreg2A, kregB, vregB, kreg2B;
    kreg2A = (u32x4){0u, 0u, 0u, 0u}; kreg2B = kreg2A;
#define ATT_SRC(t, kp, vp, k2p, kpos0v) do { \
        if (MODE == 0 || MODE == 1) { \
            if ((t) < 4) { kp = (const bf16_t*)(ws + WS_KVE) + (size_t)(ML + b * 256 + 64 * (t) + srow) * 256 + hkv * 64 + sch * 8; kpos0v = -100000; } \
            else { const int kp0_ = 128 * n - 128 + 64 * (jlo + (t) - 4); kpos0v = kp0_; \
                   kp = (const bf16_t*)(ws + WS_KVE) + (size_t)(b * 2048 + kp0_ + srow) * 256 + hkv * 64 + sch * 8; } \
            vp = kp + 128; k2p = kp; \
        } else { \
            const int pos0_ = 64 * (t); kpos0v = -100000; \
            kp = (const bf16_t*)(ws + WS_KNV) + ((size_t)(b * 8 + head) * 2304 + pos0_ + srow) * 128 + sch * 8; \
            vp = kp + 64; \
            const int krow_ = ((t) < 4) ? (ML + b * 256 + pos0_) : (b * 2048 + pos0_ - 256); \
            k2p = (const bf16_t*)(ws + WS_KR) + (size_t)(krow_ + (tid >> 2)) * 32 + (tid & 3) * 8; \
        } } while (0)
#define ATT_LOAD(t, KR_, VR_, K2_) do { const bf16_t *kp_, *vp_, *k2p_; int kq_; ATT_SRC(t, kp_, vp_, k2p_, kq_); (void)kq_; \
        KR_ = *(const u32x4*)kp_; VR_ = *(const u32x4*)vp_; if (MODE == 2 && tid < 256) K2_ = *(const u32x4*)k2p_; } while (0)
#define ATT_STORE(buf, KR_, VR_, K2_) do { LAS unsigned char* kb_ = lds + (buf) * KBUF; LAS unsigned char* vb_ = lds + 4 * KBUF + (buf) * VBUF; \
        *(LAS u32x4*)(kb_ + srow * KS + sch * 16) = KR_; \
        if (MODE == 2 && tid < 256) *(LAS u32x4*)(kb_ + (tid >> 2) * KS + 128 + (tid & 3) * 16) = K2_; \
        *(LAS u32x4*)(vb_ + srow * VS + sch * 16) = VR_; } while (0)
#define ATT_BARRIER() do { asm volatile("s_waitcnt lgkmcnt(0)" ::: "memory"); __builtin_amdgcn_s_barrier(); asm volatile("" ::: "memory"); } while (0)

#define ATT_COMPUTE(TT) do { const int buf = (TT) & 3; \
        int kpos0 = -100000; \
        if (MODE == 0 && (TT) >= 4) kpos0 = 128 * n - 128 + 64 * (jlo + (TT) - 4); \
        bool active = true; \
        if (MODE == 0 && (TT) >= 4) active = (kpos0 + 63 >= qpos0 - 128) && (kpos0 <= qpos0 + 31 + 128); \
        if (active) { \
            const LAS unsigned char* kb = lds + buf * KBUF; const LAS unsigned char* vb = lds + 4 * KBUF + buf * VBUF; \
            f32x16 p0 = negm, p1 = negm; \
_Pragma("unroll") \
            for (int s = 0; s < KST; ++s) { \
                const bf16x8 a0 = *(const LAS bf16x8*)(kb + r32 * KS + (16 * s + 8 * hi) * 2); \
                const bf16x8 a1 = *(const LAS bf16x8*)(kb + (32 + r32) * KS + (16 * s + 8 * hi) * 2); \
                p0 = __builtin_amdgcn_mfma_f32_32x32x16_bf16(a0, qf[s], p0, 0, 0, 0); \
                p1 = __builtin_amdgcn_mfma_f32_32x32x16_bf16(a1, qf[s], p1, 0, 0, 0); \
            } \
            if (MODE == 0 && (TT) >= 4 && !((kpos0 >= qpos0 - 97) && (kpos0 <= qpos0 + 65))) {     \
                const int qpos = qpos0 + r32; \
_Pragma("unroll") \
                for (int r = 0; r < 16; ++r) { const int d0 = kpos0 + crow(r, hi) - qpos, d1 = d0 + 32; \
                    if (d0 > 128 || d0 < -128) p0[r] = -INFINITY; if (d1 > 128 || d1 < -128) p1[r] = -INFINITY; } \
            } \
            float mxa = __builtin_fmaxf(__builtin_fmaxf(p0[0], p0[1]), p1[0]), mxb = __builtin_fmaxf(__builtin_fmaxf(p0[2], p0[3]), p1[1]); \
            mxa = __builtin_fmaxf(__builtin_fmaxf(mxa, p1[2]), p1[3]); \
_Pragma("unroll") \
            for (int r = 4; r < 16; r += 4) { mxa = __builtin_fmaxf(__builtin_fmaxf(mxa, p0[r]), p0[r + 1]); mxb = __builtin_fmaxf(__builtin_fmaxf(mxb, p0[r + 2]), p0[r + 3]); \
                mxa = __builtin_fmaxf(__builtin_fmaxf(mxa, p1[r]), p1[r + 1]); mxb = __builtin_fmaxf(__builtin_fmaxf(mxb, p1[r + 2]), p1[r + 3]); } \
            float mx = __builtin_fmaxf(mxa, mxb); \
            mx = __builtin_fmaxf(mx, __shfl_xor(mx, 32)); \
            const bool first = (MODE == 2) && ((TT) == 0); \
            if (first || __any(mx > THR)) { \
                const float delta = first ? mx : __builtin_fmaxf(mx, 0.f), alpha = first ? 1.f : __builtin_amdgcn_exp2f(-delta); \
                mref += delta; l_run *= alpha; \
_Pragma("unroll") \
                for (int r = 0; r < 16; ++r) { o0[r] *= alpha; o1[r] *= alpha; p0[r] -= delta; p1[r] -= delta; negm[r] = -mref; } \
            } \
            float rs0 = 0.f, rs1 = 0.f; \
_Pragma("unroll") \
            for (int r = 0; r < 16; ++r) { p0[r] = __builtin_amdgcn_exp2f(p0[r]); p1[r] = __builtin_amdgcn_exp2f(p1[r]); rs0 += p0[r]; rs1 += p1[r]; } \
            l_run += rs0 + rs1; \
            u32x4 pw[4]; \
            pw[0] = (u32x4){pk2(p0[0], p0[1]), pk2(p0[2], p0[3]), pk2(p0[4], p0[5]), pk2(p0[6], p0[7])}; \
            pw[1] = (u32x4){pk2(p0[8], p0[9]), pk2(p0[10], p0[11]), pk2(p0[12], p0[13]), pk2(p0[14], p0[15])}; \
            pw[2] = (u32x4){pk2(p1[0], p1[1]), pk2(p1[2], p1[3]), pk2(p1[4], p1[5]), pk2(p1[6], p1[7])}; \
            pw[3] = (u32x4){pk2(p1[8], p1[9]), pk2(p1[10], p1[11]), pk2(p1[12], p1[13]), pk2(p1[14], p1[15])}; \
_Pragma("unroll") \
            for (int s2 = 0; s2 < 4; ++s2) { \
                const bf16x8 pb = __builtin_bit_cast(bf16x8, pw[s2]); \
                const LAS unsigned char* va0 = vb + (16 * s2) * VS + voff; \
                const s16x4 l0 = vtr(va0), h0 = vtr(va0 + 8 * VS), l1 = vtr(va0 + 64), h1 = vtr(va0 + 8 * VS + 64); \
                const bf16x8 v0 = (bf16x8){l0[0], l0[1], l0[2], l0[3], h0[0], h0[1], h0[2], h0[3]}; \
                const bf16x8 v1 = (bf16x8){l1[0], l1[1], l1[2], l1[3], h1[0], h1[1], h1[2], h1[3]}; \
                o0 = __builtin_amdgcn_mfma_f32_32x32x16_bf16(v0, pb, o0, 0, 0, 0); \
                o1 = __builtin_amdgcn_mfma_f32_32x32x16_bf16(v1, pb, o1, 0, 0, 0); \
            } \
        } \
        } while (0)

    ATT_LOAD(0, kregA, vregA, kreg2A); ATT_LOAD(1, kregB, vregB, kreg2B);
    ATT_STORE(0, kregA, vregA, kreg2A); ATT_STORE(1, kregB, vregB, kreg2B);
    if (2 < nt) { ATT_LOAD(2, kregA, vregA, kreg2A); ATT_LOAD(3, kregB, vregB, kreg2B); }
    ATT_BARRIER();
    const int Rq = Rq0 + r32;
    const bf16_t* zrow = (MODE == 2) ? (const bf16_t*)(aux + AUX_ZO) + (size_t)Rq * 512 + head * 64 : (const bf16_t*)(ws + WS_ZA) + (size_t)Rq * 512 + head * 64;
    u32x2 zz[8];
#pragma unroll
    for (int g = 0; g < 8; ++g) zz[g] = (u32x2){0u, 0u};
    for (int t = 0; t < nt; t += 2) {
        if (t + 2 >= nt) {
#pragma unroll
            for (int g = 0; g < 4; ++g) { zz[2 * g] = *(const u32x2*)(zrow + 8 * g + 4 * hi); zz[2 * g + 1] = *(const u32x2*)(zrow + 32 + 8 * g + 4 * hi); } }
        ATT_COMPUTE(t);
        ATT_COMPUTE(t + 1);
        if (t + 2 < nt) { ATT_STORE((t + 2) & 3, kregA, vregA, kreg2A); ATT_STORE((t + 3) & 3, kregB, vregB, kreg2B); }
        if (t + 4 < nt) { ATT_LOAD(t + 4, kregA, vregA, kreg2A); ATT_LOAD(t + 5, kregB, vregB, kreg2B); }
        ATT_BARRIER();
    }
#undef ATT_COMPUTE
#undef ATT_BARRIER
#undef ATT_SRC
#undef ATT_LOAD
#undef ATT_STORE
    const float l_tot = l_run + __shfl_xor(l_run, 32), inv = __builtin_amdgcn_rcpf(l_tot);
    bf16_t* urow = (bf16_t*)(ws + WS_U) + (size_t)Rq * 1024 + head * 64;
#pragma unroll
    for (int g = 0; g < 4; ++g) {
        const int dv = 8 * g + 4 * hi;
        { const u32x2 z = zz[2 * g];
          u32x2 w; w.x = pk2(o0[4 * g] * inv * bf_lo(z.x), o0[4 * g + 1] * inv * bf_hi(z.x)); w.y = pk2(o0[4 * g + 2] * inv * bf_lo(z.y), o0[4 * g + 3] * inv * bf_hi(z.y));
          *(u32x2*)(urow + dv) = w; }
        { const u32x2 z = zz[2 * g + 1];
          u32x2 w; w.x = pk2(o1[4 * g] * inv * bf_lo(z.x), o1[4 * g + 1] * inv * bf_hi(z.x)); w.y = pk2(o1[4 * g + 2] * inv * bf_lo(z.y), o1[4 * g + 3] * inv * bf_hi(z.y));
          *(u32x2*)(urow + 32 + dv) = w; }
    }
}


__device__ __forceinline__ int srcmap(int mat, int dn) {
    if (mat == 0) {
        if (dn < 128) { const int d = dn & 63; return (dn & 64) + (d >> 1) + 32 * (d & 1); }
        if (dn < 256) return dn;
        if (dn < 768) { const int j = dn - 256, d = j & 63; return 256 + (j & ~63) + (d >> 1) + 32 * (d & 1); }
        if (dn < 1792) { const int j = dn - 768, blk = j >> 8, w = j & 255; return (w < 128) ? 1280 + blk * 128 + w : 1792 + blk * 128 + (w - 128); }
        if (dn < 2816) { const int j = dn - 1792, blk = j >> 8, w = j & 255; return (w < 128) ? 768 + blk * 128 + w : 2816 + blk * 128 + (w - 128); }
        return 2304 + (dn - 2816);
    }
    if (mat == 2) {
        if (dn < 256) return dn;
        if (dn < 512) return 288 + (dn - 256);
        if (dn < 1024) return 544 + (dn - 512);
        if (dn < 1280) { const int w = dn - 1024; if (w < 32) return 256 + (w >> 1) + 16 * (w & 1); if (w < 48) return 1056 + (w - 32); return -1; }
        if (dn < 2048) return 1072 + (dn - 1280);
        if (dn < 2304) return 1840 + (dn - 2048);
        if (dn < 3328) { const int j = dn - 2304, blk = j >> 8, w = j & 255; return (w < 128) ? 2096 + blk * 128 + w : 2608 + 512 + blk * 128 + (w - 128); }
        return 2608 + (dn - 3328);
    }
    if (mat == 3) {
        const int head = dn / 96, d = dn - head * 96; if (d < 64) return dn; const int w = d - 64; return head * 96 + 64 + (w >> 1) + 16 * (w & 1);
    }
    return dn;
}
__device__ __forceinline__ void p0_transpose_item(const float* W, int K, int Nsrc, bf16_t* WT, int mat, const float* kscale, LAS float* scr, int item, int nblk, int lane) {
    const int kb = item / nblk, nb = item % nblk, k0 = 64 * kb, n0 = 32 * nb;
    const int sc = srcmap(mat, n0 + (lane & 31));
    float v[32];
    const float* wp = W + (size_t)(k0 + (lane >> 5)) * Nsrc + (sc >= 0 ? sc : 0);
#pragma unroll
    for (int i = 0; i < 32; ++i) v[i] = wp[(size_t)(2 * i) * Nsrc];
#pragma unroll
    for (int i = 0; i < 32; ++i) { const int kk = 2 * i + (lane >> 5); float x = (sc >= 0) ? v[i] : 0.f; if (kscale) x *= kscale[k0 + kk]; scr[kk * 33 + (lane & 31)] = x; }
    LDS_WAIT(); asm volatile("" ::: "memory");
    const int c = lane & 7;
#pragma unroll
    for (int j = 0; j < 4; ++j) { const int n = (lane >> 3) + 8 * j; const LAS float* s = scr + (8 * c) * 33 + n;
        u32x4 o; o.x = pk2(s[0 * 33], s[1 * 33]); o.y = pk2(s[2 * 33], s[3 * 33]); o.z = pk2(s[4 * 33], s[5 * 33]); o.w = pk2(s[6 * 33], s[7 * 33]);
        *(u32x4*)(WT + (size_t)(n0 + n) * K + k0 + 8 * c) = o; }
    LDS_WAIT(); asm volatile("" ::: "memory");
}

__device__ __forceinline__ void p0_mod(LAS unsigned char* lds, const float* c, const float* c_ctx, const float* mod_w, const float* mod_b, float* MOD, int G) {
    const int tid = my_tid();
    if ((int)blockIdx.x >= 192) return;
    LAS float* scs = (LAS float*)lds;
    LAS float* red = (LAS float*)(lds + 1024 * 20 * 4);
    { float cv[34];
#pragma unroll
      for (int u = 0; u < 34; ++u) { const int idx = tid + u * NTHREADS, r = idx >> 10, k = idx & 1023; cv[u] = (r < 16) ? c[r * 1024 + k] : c_ctx[k]; }
#pragma unroll
      for (int u = 0; u < 34; ++u) { const int idx = tid + u * NTHREADS, r = idx >> 10, k = idx & 1023; scs[k * 20 + r] = silu_f(cv[u]); } }
    __syncthreads();
    for (int item = blockIdx.x; item < 192; item += G) {
        const int l = item / 96, n0 = (item % 96) * 32, col = tid & 31, kg = tid >> 5;
        float acc[20];
#pragma unroll
        for (int r = 0; r < 20; ++r) acc[r] = 0.f;
        const float* wp = mod_w + ((size_t)l * 1024 + kg * 64) * 3072 + n0 + col;
#pragma unroll
        for (int kb = 0; kb < 4; ++kb) {
            float w[16];
#pragma unroll
            for (int u = 0; u < 16; ++u) w[u] = wp[(size_t)(kb * 16 + u) * 3072];
#pragma unroll
            for (int u = 0; u < 16; ++u) { const LAS f32x4* sp = (const LAS f32x4*)(scs + (kg * 64 + kb * 16 + u) * 20);
#pragma unroll
                for (int q = 0; q < 5; ++q) { const f32x4 s = sp[q]; acc[4 * q] += s[0] * w[u]; acc[4 * q + 1] += s[1] * w[u]; acc[4 * q + 2] += s[2] * w[u]; acc[4 * q + 3] += s[3] * w[u]; } }
        }
#pragma unroll
        for (int r = 0; r < 17; ++r) red[(kg * 17 + r) * 32 + col] = acc[r];
        __syncthreads();
        for (int o = tid; o < 17 * 32; o += NTHREADS) { const int r = o >> 5, cc = o & 31; float s = mod_b[l * 3072 + n0 + cc];
#pragma unroll
            for (int g = 0; g < 16; ++g) s += red[(g * 17 + r) * 32 + cc];
            MOD[((size_t)l * 17 + r) * 3072 + n0 + cc] = s; }
        __syncthreads();
    }
}

__device__ __forceinline__ void norm_mod_store(const f32x4 (&v)[4], const float* pre_w, const float* modrow, bf16_t* hrow, int lane) {
    float ss = 0.f;
#pragma unroll
    for (int j = 0; j < 4; ++j) ss += sq4(v[j]);
    const float rstd = rsqrtf(wave_sum(ss) * (1.f / 1024.f) + EPS);
#pragma unroll
    for (int j = 0; j < 4; ++j) { const int k = 4 * (lane + 64 * j);
        const f32x4 w = *(const f32x4*)(pre_w + k), sh = *(const f32x4*)(modrow + k), sc = *(const f32x4*)(modrow + 1024 + k);
        const f32x4 h = v[j] * rstd * w * (sc + 1.0f) + sh;
        u32x2 o; o.x = pk2(h[0], h[1]); o.y = pk2(h[2], h[3]); *(u32x2*)(hrow + k) = o; }
}
__device__ __forceinline__ void norm_mod_store_wt(const f32x4 (&v)[4], const float* pre_w, const float* modrow, bf16_t* hrow, int lane) {
    float ss = 0.f;
#pragma unroll
    for (int j = 0; j < 4; ++j) ss += sq4(v[j]);
    const float rstd = rsqrtf(wave_sum(ss) * (1.f / 1024.f) + EPS);
#pragma unroll
    for (int j = 0; j < 4; ++j) { const int k = 4 * (lane + 64 * j);
        const f32x4 w = *(const f32x4*)(pre_w + k), sh = *(const f32x4*)(modrow + k), sc = *(const f32x4*)(modrow + 1024 + k);
        const f32x4 h = v[j] * rstd * w * (sc + 1.0f) + sh;
        __hip_atomic_store((unsigned long long*)(hrow + k), (unsigned long long)pk2(h[0], h[1]) | ((unsigned long long)pk2(h[2], h[3]) << 32), __ATOMIC_RELAXED, __HIP_MEMORY_SCOPE_AGENT); }
}
__device__ __forceinline__ void p1_stream(const float* x, const float* ctx, const float* pre_w, const float* MOD, bf16_t* H, unsigned* ready, int sw, int nsw, int lane) {
    f32x4 cur[4][4], nxt[4][4];
#define P1_LOAD(dst, R_) do { if ((R_) < MT) { const float* src_ = ((R_) < ML) ? x + (size_t)(R_) * 1024 : ctx + (size_t)((R_) - ML) * 1024; \
        _Pragma("unroll") for (int j = 0; j < 4; ++j) dst[j] = *(const f32x4*)(src_ + 4 * (lane + 64 * j)); } } while (0)
#pragma unroll
    for (int q = 0; q < 4; ++q) P1_LOAD(cur[q], sw + nsw * q);
    for (int R0 = sw; R0 < MT; R0 += 4 * nsw) {
#pragma unroll
        for (int q = 0; q < 4; ++q) P1_LOAD(nxt[q], R0 + nsw * (4 + q));
#pragma unroll
        for (int q = 0; q < 4; ++q) { const int R = R0 + nsw * q; if (R < MT) { const int bi = (R < ML) ? (R >> 11) : 16;
            norm_mod_store_wt(cur[q], pre_w, MOD + (size_t)bi * 3072, H + (size_t)R * 1024, lane); } }
        asm volatile("s_waitcnt vmcnt(0)" ::: "memory");
        if (lane < 4) { const int R = R0 + nsw * lane; if (R < MT) __hip_atomic_fetch_add(ready + 64 * (R >> 8), 1u, __ATOMIC_RELAXED, __HIP_MEMORY_SCOPE_AGENT); }
#pragma unroll
        for (int q = 0; q < 4; ++q)
#pragma unroll
            for (int j = 0; j < 4; ++j) cur[q][j] = nxt[q][j];
    }
#undef P1_LOAD
}
__device__ __forceinline__ void p1_prenorm(const float* x, const float* ctx, const float* pre_w, const float* MOD, bf16_t* H, int gw, int ngw, int lane) {
    const int per = (MT + ngw - 1) / ngw, r0 = gw * per, r1 = (r0 + per < MT) ? r0 + per : MT;
    f32x4 cur[4], nxt[4], w[4], sc1[4], sh[4];
#pragma unroll
    for (int j = 0; j < 4; ++j) { w[j] = *(const f32x4*)(pre_w + 4 * (lane + 64 * j)); sc1[j] = w[j]; sh[j] = w[j]; }
#define P1_LOAD(dst, R_) do { const float* src_ = ((R_) < ML) ? x + (size_t)(R_) * 1024 : ctx + (size_t)((R_) - ML) * 1024; \
        _Pragma("unroll") for (int j = 0; j < 4; ++j) dst[j] = *(const f32x4*)(src_ + 4 * (lane + 64 * j)); } while (0)
    if (r0 < r1) P1_LOAD(cur, r0);
    int cur_bi = -1;
    for (int R = r0; R < r1; ++R) {
        if (R + 1 < r1) P1_LOAD(nxt, R + 1);
        const int bi = (R < ML) ? (R >> 11) : 16;
        if (bi != cur_bi) { cur_bi = bi; const float* m0 = MOD + (size_t)bi * 3072;
#pragma unroll
            for (int j = 0; j < 4; ++j) { const int k = 4 * (lane + 64 * j); sh[j] = *(const f32x4*)(m0 + k); sc1[j] = *(const f32x4*)(m0 + 1024 + k) + 1.0f; } }
        float ss = 0.f;
#pragma unroll
        for (int j = 0; j < 4; ++j) ss += sq4(cur[j]);
        const float rstd = rsqrtf(wave_sum(ss) * (1.f / 1024.f) + EPS);
#pragma unroll
        for (int j = 0; j < 4; ++j) { const int k = 4 * (lane + 64 * j);
            const f32x4 h = cur[j] * rstd * w[j] * sc1[j] + sh[j];
            u32x2 o; o.x = pk2(h[0], h[1]); o.y = pk2(h[2], h[3]); *(u32x2*)(H + (size_t)R * 1024 + k) = o; }
#pragma unroll
        for (int j = 0; j < 4; ++j) cur[j] = nxt[j];
    }
#undef P1_LOAD
}
__device__ __forceinline__ float ssq16(const float* p) {
    const f32x4 a = *(const f32x4*)p, b = *(const f32x4*)(p + 4), c = *(const f32x4*)(p + 8), d = *(const f32x4*)(p + 12);
    return (((a[0] + a[1]) + (a[2] + a[3])) + ((b[0] + b[1]) + (b[2] + b[3]))) + (((c[0] + c[1]) + (c[2] + c[3])) + ((d[0] + d[1]) + (d[2] + d[3])));
}
__device__ __forceinline__ void p5_post_pre(const float* x, const float* ctx, const float* post_w0, const float* pre_w1, const float* MOD, const bf16_t* Y, const float* SSQ, bf16_t* X1, bf16_t* H, int gw, int ngw, int lane) {
    const int per = (MT + ngw - 1) / ngw, r0 = gw * per, r1 = (r0 + per < MT) ? r0 + per : MT;
    f32x4 xc[4], xn[4], sqc[4], sqn[4]; u32x2 yc[4], yn[4];
    f32x4 pg[4], pw[4], w1[4], sc1[4], sh1[4];
#pragma unroll
    for (int j = 0; j < 4; ++j) { const int k = 4 * (lane + 64 * j); pw[j] = *(const f32x4*)(post_w0 + k); w1[j] = *(const f32x4*)(pre_w1 + k); pg[j] = pw[j]; sc1[j] = pw[j]; sh1[j] = pw[j]; }
#define P5_LOAD(xd, yd, sd, R_) do { const float* src_ = ((R_) < ML) ? x + (size_t)(R_) * 1024 : ctx + (size_t)((R_) - ML) * 1024; \
        _Pragma("unroll") for (int j = 0; j < 4; ++j) { xd[j] = *(const f32x4*)(src_ + 4 * (lane + 64 * j)); yd[j] = *(const u32x2*)(Y + (size_t)(R_) * 1024 + 4 * (lane + 64 * j)); \
            sd[j] = *(const f32x4*)(SSQ + (size_t)(R_) * 16 + 4 * j); } } while (0)
    if (r0 < r1) P5_LOAD(xc, yc, sqc, r0);
    int cur_bi = -1;
    for (int R = r0; R < r1; ++R) {
        if (R + 1 < r1) P5_LOAD(xn, yn, sqn, R + 1);
        const int bi = (R < ML) ? (R >> 11) : 16;
        if (bi != cur_bi) { cur_bi = bi; const float* m0 = MOD + (size_t)bi * 3072; const float* m1 = MOD + (size_t)(17 + bi) * 3072;
#pragma unroll
            for (int j = 0; j < 4; ++j) { const int k = 4 * (lane + 64 * j); pg[j] = *(const f32x4*)(m0 + 2048 + k); sh1[j] = *(const f32x4*)(m1 + k); sc1[j] = *(const f32x4*)(m1 + 1024 + k) + 1.0f; } }
        const float ssy = (((sqc[0][0] + sqc[0][1]) + (sqc[0][2] + sqc[0][3])) + ((sqc[1][0] + sqc[1][1]) + (sqc[1][2] + sqc[1][3]))) + (((sqc[2][0] + sqc[2][1]) + (sqc[2][2] + sqc[2][3])) + ((sqc[3][0] + sqc[3][1]) + (sqc[3][2] + sqc[3][3])));
        const float rstd_y = rsqrtf(ssy * (1.f / 1024.f) + EPS);
        f32x4 v[4]; float ss = 0.f;
#pragma unroll
        for (int j = 0; j < 4; ++j) { const int k = 4 * (lane + 64 * j);
            const f32x4 y = (f32x4){bf_lo(yc[j].x), bf_hi(yc[j].x), bf_lo(yc[j].y), bf_hi(yc[j].y)};
            v[j] = xc[j] + pg[j] * (y * rstd_y * pw[j]);
            ss += sq4(v[j]);
            if (R < ML) { u32x2 o; o.x = pk2(v[j][0], v[j][1]); o.y = pk2(v[j][2], v[j][3]); *(u32x2*)(X1 + (size_t)R * 1024 + k) = o; } }
        const float rstd = rsqrtf(wave_sum(ss) * (1.f / 1024.f) + EPS);
#pragma unroll
        for (int j = 0; j < 4; ++j) { const int k = 4 * (lane + 64 * j);
            const f32x4 h = v[j] * rstd * w1[j] * sc1[j] + sh1[j];
            u32x2 o; o.x = pk2(h[0], h[1]); o.y = pk2(h[2], h[3]); *(u32x2*)(H + (size_t)R * 1024 + k) = o; }
#pragma unroll
        for (int j = 0; j < 4; ++j) { xc[j] = xn[j]; yc[j] = yn[j]; sqc[j] = sqn[j]; }
    }
#undef P5_LOAD
}
__device__ __forceinline__ void p11_final(const float* post_w1, const float* MOD, const bf16_t* Y, const float* SSQ, const bf16_t* X1, float* out, int gw, int ngw, int lane) {
    const int per = (ML + ngw - 1) / ngw, r0 = gw * per, r1 = (r0 + per < ML) ? r0 + per : ML;
    u32x2 xc[4], xn[4], yc[4], yn[4]; f32x4 sqc[4], sqn[4], pg[4], pw[4];
#pragma unroll
    for (int j = 0; j < 4; ++j) { pw[j] = *(const f32x4*)(post_w1 + 4 * (lane + 64 * j)); pg[j] = pw[j]; }
#define P11_LOAD(xd, yd, sd, R_) do { _Pragma("unroll") for (int j = 0; j < 4; ++j) { xd[j] = *(const u32x2*)(X1 + (size_t)(R_) * 1024 + 4 * (lane + 64 * j)); yd[j] = *(const u32x2*)(Y + (size_t)(R_) * 1024 + 4 * (lane + 64 * j)); \
        sd[j] = *(const f32x4*)(SSQ + (size_t)(R_) * 16 + 4 * j); } } while (0)
    if (r0 < r1) P11_LOAD(xc, yc, sqc, r0);
    int cur_b = -1;
    for (int R = r0; R < r1; ++R) {
        if (R + 1 < r1) P11_LOAD(xn, yn, sqn, R + 1);
        const int bb = R >> 11;
        if (bb != cur_b) { cur_b = bb; const float* m1 = MOD + (size_t)(17 + bb) * 3072;
#pragma unroll
            for (int j = 0; j < 4; ++j) pg[j] = *(const f32x4*)(m1 + 2048 + 4 * (lane + 64 * j)); }
        const float ssy = (((sqc[0][0] + sqc[0][1]) + (sqc[0][2] + sqc[0][3])) + ((sqc[1][0] + sqc[1][1]) + (sqc[1][2] + sqc[1][3]))) + (((sqc[2][0] + sqc[2][1]) + (sqc[2][2] + sqc[2][3])) + ((sqc[3][0] + sqc[3][1]) + (sqc[3][2] + sqc[3][3])));
        const float rstd_y = rsqrtf(ssy * (1.f / 1024.f) + EPS);
#pragma unroll
        for (int j = 0; j < 4; ++j) { const int k = 4 * (lane + 64 * j);
            const f32x4 y = (f32x4){bf_lo(yc[j].x), bf_hi(yc[j].x), bf_lo(yc[j].y), bf_hi(yc[j].y)};
            const f32x4 xv = (f32x4){bf_lo(xc[j].x), bf_hi(xc[j].x), bf_lo(xc[j].y), bf_hi(xc[j].y)};
            *(f32x4*)(out + (size_t)R * 1024 + k) = xv + pg[j] * (y * rstd_y * pw[j]); }
#pragma unroll
        for (int j = 0; j < 4; ++j) { xc[j] = xn[j]; yc[j] = yn[j]; sqc[j] = sqn[j]; }
    }
#undef P11_LOAD
}
__device__ __forceinline__ void p3_conv(unsigned char* ws, const float* conv_w, int gtid, int ngt) {
    const bf16_t* PE = (const bf16_t*)(ws + WS_PE); const bf16_t* GE = (const bf16_t*)(ws + WS_GE); bf16_t* U = (bf16_t*)(ws + WS_U);
    const int ch = (gtid & 63) * 8;
    const f32x4 w0a = *(const f32x4*)(conv_w + ch), w0b = *(const f32x4*)(conv_w + ch + 4), w1a = *(const f32x4*)(conv_w + 512 + ch), w1b = *(const f32x4*)(conv_w + 512 + ch + 4),
                w2a = *(const f32x4*)(conv_w + 1024 + ch), w2b = *(const f32x4*)(conv_w + 1024 + ch + 4);
    for (int it = gtid; it < MT * 64; it += ngt) {
        const int R = it >> 6;
        int t, T; if (R < ML) { t = R & 2047; T = 2048; } else { t = (R - ML) & 255; T = 256; }
        const u32x4 z4 = (u32x4){0u, 0u, 0u, 0u};
        const u32x4 pc = *(const u32x4*)(PE + (size_t)R * 512 + ch);
        const u32x4 pm = (t > 0) ? *(const u32x4*)(PE + (size_t)(R - 1) * 512 + ch) : z4;
        const u32x4 pp = (t < T - 1) ? *(const u32x4*)(PE + (size_t)(R + 1) * 512 + ch) : z4;
        const u32x4 g = *(const u32x4*)(GE + (size_t)R * 512 + ch);
        u32x4 o;
#define CV(pmw, pcw, ppw, gw_, wa, wb, wc_, e0, e1) pk2(bf_lo(gw_) * (wa[e0] * bf_lo(pmw) + wb[e0] * bf_lo(pcw) + wc_[e0] * bf_lo(ppw)), bf_hi(gw_) * (wa[e1] * bf_hi(pmw) + wb[e1] * bf_hi(pcw) + wc_[e1] * bf_hi(ppw)))
        o.x = CV(pm.x, pc.x, pp.x, g.x, w0a, w1a, w2a, 0, 1); o.y = CV(pm.y, pc.y, pp.y, g.y, w0a, w1a, w2a, 2, 3);
        o.z = CV(pm.z, pc.z, pp.z, g.z, w0b, w1b, w2b, 0, 1); o.w = CV(pm.w, pc.w, pp.w, g.w, w0b, w1b, w2b, 2, 3);
#undef CV
        *(u32x4*)(U + (size_t)R * 1024 + 512 + ch) = o;
    }
}
__device__ __forceinline__ void p9_readout(unsigned char* ws, unsigned char* aux, const float* hn_w, int gw, int ngw, int lane) {
    const bf16_t* HM = (const bf16_t*)(ws + WS_HM); const bf16_t* MO = (const bf16_t*)(aux + AUX_MO); bf16_t* U = (bf16_t*)(ws + WS_U);
    const int ch = 8 * lane;
    const f32x4 wa = *(const f32x4*)(hn_w + ch), wb = *(const f32x4*)(hn_w + ch + 4);
    u32x4 h0, h1, mo, h0n, h1n, mon;
#define P9_LOAD(a_, b_, c_, R_) do { a_ = *(const u32x4*)(HM + (size_t)(R_) * 512 + ch); b_ = *(const u32x4*)(HM + ((size_t)ML + (R_)) * 512 + ch); c_ = *(const u32x4*)(MO + (size_t)(R_) * 512 + ch); } while (0)
    h0n = (u32x4){0u, 0u, 0u, 0u}; h1n = h0n; mon = h0n;
    if (gw < ML) P9_LOAD(h0, h1, mo, gw);
    for (int R = gw; R < ML; R += ngw) {
        if (R + ngw < ML) P9_LOAD(h0n, h1n, mon, R + ngw);
        float hs[8] = {bf_lo(h0.x) + bf_lo(h1.x), bf_hi(h0.x) + bf_hi(h1.x), bf_lo(h0.y) + bf_lo(h1.y), bf_hi(h0.y) + bf_hi(h1.y),
                       bf_lo(h0.z) + bf_lo(h1.z), bf_hi(h0.z) + bf_hi(h1.z), bf_lo(h0.w) + bf_lo(h1.w), bf_hi(h0.w) + bf_hi(h1.w)};
        float ss = 0.f;
#pragma unroll
        for (int e = 0; e < 8; ++e) ss += hs[e] * hs[e];
        ss += __shfl_xor(ss, 1); ss += __shfl_xor(ss, 2); ss += __shfl_xor(ss, 4); ss += __shfl_xor(ss, 8);
        const float rstd = rsqrtf(ss * (1.f / 128.f) + EPS);
        u32x4 o;
        o.x = pk2(hs[0] * rstd * wa[0] * bf_lo(mo.x), hs[1] * rstd * wa[1] * bf_hi(mo.x));
        o.y = pk2(hs[2] * rstd * wa[2] * bf_lo(mo.y), hs[3] * rstd * wa[3] * bf_hi(mo.y));
        o.z = pk2(hs[4] * rstd * wb[0] * bf_lo(mo.z), hs[5] * rstd * wb[1] * bf_hi(mo.z));
        o.w = pk2(hs[6] * rstd * wb[2] * bf_lo(mo.w), hs[7] * rstd * wb[3] * bf_hi(mo.w));
        *(u32x4*)(U + (size_t)R * 1024 + 512 + ch) = o;
        h0 = h0n; h1 = h1n; mo = mon;
    }
#undef P9_LOAD
}


typedef float f32x4v __attribute__((ext_vector_type(4)));
#define LDS_BARRIER() do { asm volatile("s_waitcnt lgkmcnt(0)" ::: "memory"); __builtin_amdgcn_s_barrier(); asm volatile("" ::: "memory"); } while (0)
#define MFMA_FENCE(x) do { __builtin_amdgcn_sched_barrier(0); asm volatile("s_nop 15\n\ts_nop 15" : "+v"(x)); __builtin_amdgcn_sched_barrier(0); } while (0)
__device__ __forceinline__ bf16x8 tr8(const LAS unsigned char* p, int halfstride) {
    const s16x4 lo = vtr(p), hi = vtr(p + halfstride);
    return (bf16x8){lo[0], lo[1], lo[2], lo[3], hi[0], hi[1], hi[2], hi[3]};
}
__device__ __forceinline__ bf16x8 gather8(const LAS unsigned char* img, int stride, int row0, int col) {
    bf16x8 r;
#pragma unroll
    for (int e = 0; e < 8; ++e) r[e] = *(const LAS short*)(img + (row0 + e) * stride + col * 2);
    return r;
}
template <int CTRL, int RM> __device__ __forceinline__ float dppf(float oldv, float v) {
    return __int_as_float(__builtin_amdgcn_update_dpp(__float_as_int(oldv), __float_as_int(v), CTRL, RM, 0xf, false));
}
__device__ __forceinline__ float wave_scan_add(float v) {
    v += dppf<0x111, 0xf>(0.f, v); v += dppf<0x112, 0xf>(0.f, v); v += dppf<0x114, 0xf>(0.f, v); v += dppf<0x118, 0xf>(0.f, v);
    v += dppf<0x142, 0xa>(0.f, v); v += dppf<0x143, 0xc>(0.f, v);
    return v;
}
__device__ __forceinline__ float wave_scan_max(float v) {
    const float ninf = -INFINITY;
    v = fmaxf(v, dppf<0x111, 0xf>(ninf, v)); v = fmaxf(v, dppf<0x112, 0xf>(ninf, v)); v = fmaxf(v, dppf<0x114, 0xf>(ninf, v)); v = fmaxf(v, dppf<0x118, 0xf>(ninf, v));
    v = fmaxf(v, dppf<0x142, 0xa>(ninf, v)); v = fmaxf(v, dppf<0x143, 0xc>(ninf, v));
    return v;
}
template <bool DUMMY> __device__ __forceinline__ void mlstm_chain_mfma(LAS unsigned char* lds, unsigned char* ws, unsigned char* aux, const float* i_bias, const float* f_bias, int chain) {
    constexpr int RS = 144, VS = 176;
    constexpr int QI = 0, KI = 9216, SC = 18432, CI = 27648, VI = 39168, VW = 50432, VEC = 61696;
    const int tid = my_tid(), lane = tid & 63, wid = __builtin_amdgcn_readfirstlane(tid >> 6), l15 = lane & 15, kg = lane >> 4;
    const int vh = chain & 1, d = (chain >> 1) & 1, h = (chain >> 2) & 3, b = chain >> 4;
    LAS float* vb_ = (LAS float*)(lds + VEC); LAS float* vab = vb_ + 64; LAS float* vcm = vab + 64; LAS float* vwp = vcm + 64; LAS float* vsc = vwp + 64;
    const bf16_t* MK = (const bf16_t*)(ws + WS_MK); const bf16_t* MV = (const bf16_t*)(ws + WS_MV); const bf16_t* MQ = (const bf16_t*)(aux + AUX_MQ);
    const float* GT = (const float*)(ws + WS_GATES); bf16_t* HM = (bf16_t*)(ws + WS_HM);
    const float ib = i_bias[d * 4 + h], fb = f_bias[d * 4 + h];
    for (int idx = tid; idx < 80 * RS / 4; idx += NTHREADS) ((LAS unsigned*)(lds + CI))[idx] = 0u;
    if (tid < 64) { LAS unsigned* a = (LAS unsigned*)(lds + VI + tid * VS + 128); LAS unsigned* w = (LAS unsigned*)(lds + VW + tid * VS + 128);
#pragma unroll
        for (int e = 0; e < 8; ++e) { a[e] = (e == 0) ? 0x3F80u : 0u; w[e] = 0u; } }
    const int it = wid & 3, vg = wid >> 2;
    f32x4v cacc[3];
#pragma unroll
    for (int t = 0; t < 3; ++t) cacc[t] = (f32x4v){0.f, 0.f, 0.f, 0.f};
    float mst = 0.f;
    unsigned nbad = 0u;
    const int srow = tid >> 3, sch = tid & 7;
    const int q4 = l15 >> 2, p4 = l15 & 3;
    u32x4 kkN, vvN, qqN = (u32x4){0u, 0u, 0u, 0u}; float liN = 0.f, fpN = 0.f;
#define MLSTM_LOADS(S_) do { const bool lat_ = (S_) >= 4; const int c_ = lat_ ? (S_) - 4 : (S_), T_ = lat_ ? 2048 : 256, rowb_ = lat_ ? b * 2048 : ML + b * 256; \
        const int tok_ = (d == 0) ? 64 * c_ + srow : T_ - 1 - (64 * c_ + srow); const size_t R_ = (size_t)(rowb_ + tok_); \
        kkN = *(const u32x4*)(MK + R_ * 256 + h * 64 + sch * 8); vvN = *(const u32x4*)(MV + R_ * 512 + h * 128 + vh * 64 + sch * 8); \
        if (lat_) qqN = *(const u32x4*)(MQ + R_ * 256 + h * 64 + sch * 8); \
        if (wid == 0) { const int tk_ = (d == 0) ? 64 * c_ + lane : T_ - 1 - (64 * c_ + lane); const float* gp_ = GT + (size_t)(rowb_ + tk_) * 16 + d * 8 + h; liN = gp_[0]; fpN = gp_[4]; } } while (0)
    MLSTM_LOADS(0);
    for (int step = 0; step < 36; ++step) {
        const bool lat = step >= 4; const int c = lat ? step - 4 : step, T = lat ? 2048 : 256, rowb = lat ? b * 2048 : ML + b * 256;
        const int tok = (d == 0) ? 64 * c + srow : T - 1 - (64 * c + srow); const size_t R = (size_t)(rowb + tok);
        const u32x4 kk = kkN, vv = vvN, qq = qqN;
        if (wid == 0) {
            const float li = liN + ib, fp = fpN + fb;
            const float lf = fminf(fp, 0.f) - __logf(1.f + __expf(-fabsf(fp)));
            const float bc = wave_scan_add(lf);
            const float ab = li - bc; const float cm = wave_scan_max(ab);
            const float g = __int_as_float(__builtin_amdgcn_readlane(__float_as_int(bc), 63)), mloc = g + __int_as_float(__builtin_amdgcn_readlane(__float_as_int(cm), 63)), m_new = fmaxf(g + mst, mloc);
            vb_[lane] = bc; vab[lane] = ab; vcm[lane] = cm; vwp[lane] = __expf(g + ab - m_new);
            if (lane == 0) { vsc[0] = mst; vsc[1] = __expf(g + mst - m_new); }
            mst = m_new;
        }
        LDS_BARRIER();
        { const float wj = vwp[srow];
          *(LAS u32x4*)(lds + KI + srow * RS + sch * 16) = kk;
          *(LAS u32x4*)(lds + VI + srow * VS + sch * 16) = vv;
          u32x4 vw; vw.x = pk2(bf_lo(vv.x) * wj, bf_hi(vv.x) * wj); vw.y = pk2(bf_lo(vv.y) * wj, bf_hi(vv.y) * wj); vw.z = pk2(bf_lo(vv.z) * wj, bf_hi(vv.z) * wj); vw.w = pk2(bf_lo(vv.w) * wj, bf_hi(vv.w) * wj);
          *(LAS u32x4*)(lds + VW + srow * VS + sch * 16) = vw;
          if (sch == 0) *(LAS unsigned short*)(lds + VW + srow * VS + 128) = f2bf(wj);
          if (lat) *(LAS u32x4*)(lds + QI + srow * RS + sch * 16) = qq; }
        LDS_BARRIER();
        const float m_in = vsc[0], a_prev = vsc[1];
        if (step + 1 < 36) MLSTM_LOADS(step + 1);
        bf16x8 qf[2];
        if (lat) {
            qf[0] = *(const LAS bf16x8*)(lds + QI + (16 * it + l15) * RS + (8 * kg) * 2); qf[1] = *(const LAS bf16x8*)(lds + QI + (16 * it + l15) * RS + (8 * kg + 32) * 2);
            const int i = 16 * it + l15; const float mi = fmaxf(m_in, vcm[i]);
#pragma unroll
            for (int t = 0; t < 2; ++t) {
                const int jt = 2 * vg + t; u32x2 o = (u32x2){0u, 0u};
                if (jt <= it) {
                    const bf16x8 k0 = *(const LAS bf16x8*)(lds + KI + (16 * jt + l15) * RS + (8 * kg) * 2), k1 = *(const LAS bf16x8*)(lds + KI + (16 * jt + l15) * RS + (8 * kg + 32) * 2);
                    f32x4v s = (f32x4v){0.f, 0.f, 0.f, 0.f};
                    s = __builtin_amdgcn_mfma_f32_16x16x32_bf16(k0, qf[0], s, 0, 0, 0); s = __builtin_amdgcn_mfma_f32_16x16x32_bf16(k1, qf[1], s, 0, 0, 0); MFMA_FENCE(s);
                    const int j0 = 16 * jt + 4 * kg; const f32x4v abv = *(const LAS f32x4v*)(vab + j0);
                    float e[4];
#pragma unroll
                    for (int r = 0; r < 4; ++r) e[r] = (j0 + r <= i) ? s[r] * __expf(abv[r] - mi) : 0.f;
                    o.x = pk2(e[0], e[1]); o.y = pk2(e[2], e[3]);
                }
                *(LAS u32x2*)(lds + SC + i * RS + (16 * jt + 4 * kg) * 2) = o;
            }
        }
        LDS_BARRIER();
        f32x4v cnew[3];
        { bf16x8 aK[2];
#pragma unroll
          for (int s = 0; s < 2; ++s) aK[s] = tr8(lds + KI + (32 * s + 8 * kg + q4) * RS + (16 * it + 4 * p4) * 2, 4 * RS);
#pragma unroll
          for (int t = 0; t < 3; ++t) { const int vt = (t == 2) ? 4 : 2 * t + vg; f32x4v a = cacc[t] * a_prev;
#pragma unroll
              for (int s = 0; s < 2; ++s) { const bf16x8 bW = tr8(lds + VW + (32 * s + 8 * kg + q4) * VS + (16 * vt + 4 * p4) * 2, 4 * VS); a = __builtin_amdgcn_mfma_f32_16x16x32_bf16(aK[s], bW, a, 0, 0, 0); }
              MFMA_FENCE(a); cnew[t] = a; } }
        if (lat) {
            const int i0 = 16 * it + 4 * kg; const f32x4v cmv = *(const LAS f32x4v*)(vcm + i0), bv = *(const LAS f32x4v*)(vb_ + i0);
            float wi[4], mt[4];
#pragma unroll
            for (int r = 0; r < 4; ++r) { const float mi = fmaxf(m_in, cmv[r]); wi[r] = __expf(m_in - mi); mt[r] = bv[r] + mi; }
            bf16x8 aS[2];
            aS[0] = *(const LAS bf16x8*)(lds + SC + (16 * it + l15) * RS + (8 * kg) * 2); aS[1] = *(const LAS bf16x8*)(lds + SC + (16 * it + l15) * RS + (8 * kg + 32) * 2);
            f32x4v nacc[3];
#pragma unroll
            for (int t = 0; t < 3; ++t) { const int vt = (t == 2) ? 4 : 2 * t + vg; f32x4v a = (f32x4v){0.f, 0.f, 0.f, 0.f};
#pragma unroll
                for (int s = 0; s < 2; ++s) { const bf16x8 bC = *(const LAS bf16x8*)(lds + CI + (16 * vt + l15) * RS + (8 * kg + 32 * s) * 2); a = __builtin_amdgcn_mfma_f32_16x16x32_bf16(qf[s], bC, a, 0, 0, 0); }
                MFMA_FENCE(a);
#pragma unroll
                for (int r = 0; r < 4; ++r) a[r] *= wi[r];
#pragma unroll
                for (int s = 0; s < 2; ++s) { const bf16x8 bV = tr8(lds + VI + (32 * s + 8 * kg + q4) * VS + (16 * vt + 4 * p4) * 2, 4 * VS); a = __builtin_amdgcn_mfma_f32_16x16x32_bf16(aS[s], bV, a, 0, 0, 0); }
                MFMA_FENCE(a); nacc[t] = a; }
            float inv[4];
#pragma unroll
            for (int r = 0; r < 4; ++r) { const float den = __shfl(nacc[2][r], lane & 48); inv[r] = 1.f / fmaxf(fabsf(den), __expf(-mt[r])); }
#pragma unroll
            for (int t = 0; t < 2; ++t) { const int vt = 2 * t + vg;
#pragma unroll
                for (int r = 0; r < 4; ++r) *(LAS unsigned short*)(lds + QI + (i0 + r) * RS + (16 * vt + l15) * 2) = f2bf(nacc[t][r] * inv[r]); }
        }
        LDS_BARRIER();
        if (lat) { const u32x4 hv = *(const LAS u32x4*)(lds + QI + srow * RS + sch * 16);
            if (DUMMY) { const u32x4 rv = *(const u32x4*)(HM + ((size_t)d * ML + R) * 512 + h * 128 + vh * 64 + sch * 8);
#define CMPH(a_, b_) do { const float x_ = (a_), y_ = (b_); if (fabsf(x_ - y_) > 0.05f * fmaxf(fabsf(x_), fabsf(y_)) + 0.02f) ++nbad; } while (0)
                CMPH(bf_lo(hv.x), bf_lo(rv.x)); CMPH(bf_hi(hv.x), bf_hi(rv.x)); CMPH(bf_lo(hv.y), bf_lo(rv.y)); CMPH(bf_hi(hv.y), bf_hi(rv.y));
                CMPH(bf_lo(hv.z), bf_lo(rv.z)); CMPH(bf_hi(hv.z), bf_hi(rv.z)); CMPH(bf_lo(hv.w), bf_lo(rv.w)); CMPH(bf_hi(hv.w), bf_hi(rv.w));
#undef CMPH
            } else *(u32x4*)(HM + ((size_t)d * ML + R) * 512 + h * 128 + vh * 64 + sch * 8) = hv; }
#pragma unroll
        for (int t = 0; t < 3; ++t) { cacc[t] = cnew[t]; const int vt = (t == 2) ? 4 : 2 * t + vg;
            if (t < 2 || wid < 4) { u32x2 o; o.x = pk2(cnew[t][0], cnew[t][1]); o.y = pk2(cnew[t][2], cnew[t][3]); *(LAS u32x2*)(lds + CI + (16 * vt + l15) * RS + (16 * it + 4 * kg) * 2) = o; } }
    }
#undef MLSTM_LOADS
    if (DUMMY) atomicAdd((unsigned*)(ws + WS_CTL) + 64, nbad);
    __syncthreads();
}

#ifndef MK_N_LAUNCHES
#define MK_N_LAUNCHES 1
#endif
constexpr int N_PHASES = 12;
constexpr int LDS_BYTES = 147456;
constexpr int RING_BYTES = 131072, MISC_OFF = RING_BYTES + 320;
constexpr int CW_BAR = 4096;

struct Args { const float* in[21]; float* out; unsigned char* ws; int ph_lo, ph_hi; };

__global__ void __launch_bounds__(NTHREADS, 2) hybrid_fwd(Args args) {
    extern __shared__ __attribute__((aligned(16))) unsigned char lds_raw[];
    LAS unsigned char* lds = (LAS unsigned char*)lds_raw;
    const int G = gridDim.x, bx = blockIdx.x;
    const int vcu = (G % 8 == 0) ? (bx % 8) * (G / 8) + bx / 8 : bx;
    typedef const __attribute__((address_space(4))) Args* ArgsP;
    ArgsP AP = (ArgsP)__builtin_amdgcn_kernarg_segment_ptr();
    asm volatile("" : "+s"(AP));
    unsigned char* ws = AP->ws;
#define I_x AP->in[0]
#define I_cvec AP->in[1]
#define I_ctx AP->in[2]
#define I_c_ctx AP->in[3]
#define I_mod_w AP->in[4]
#define I_mod_b AP->in[5]
#define I_pre_w AP->in[6]
#define I_post_w AP->in[7]
#define I_e_w_in AP->in[8]
#define I_e_sink AP->in[9]
#define I_e_conv_w AP->in[10]
#define I_e_w_out AP->in[11]
#define I_o_w_in AP->in[12]
#define I_o_qn AP->in[13]
#define I_o_kvn AP->in[14]
#define I_o_w_uq AP->in[15]
#define I_o_w_ukv AP->in[16]
#define I_o_ib AP->in[17]
#define I_o_fb AP->in[18]
#define I_o_hn AP->in[19]
#define I_o_w_out AP->in[20]
#define I_out AP->out
    float* MOD = (float*)(ws + WS_MOD);

    for (int u = threadIdx.x; u < (LDS_BYTES - RING_BYTES) / 4; u += NTHREADS) ((LAS unsigned*)(lds + RING_BYTES))[u] = 0u;
    __syncthreads();
    XcdBarrier bar; bar.bar = (unsigned*)(ws + WS_CTL) + CW_BAR; bar.x = 0; bar.st = nullptr;
    if (MK_N_LAUNCHES == 1) bar = xcd_barrier_post((unsigned*)(ws + WS_CTL) + CW_BAR, (volatile LAS unsigned*)(lds + MISC_OFF) + 8);
    const int lo = AP->ph_lo, hi = AP->ph_hi;
#ifndef PROBE_REP
#define PROBE_REP 0
#endif
#define NREP(k) ((((PROBE_REP) >> (k)) & 1) ? 2 : 1)
#ifndef PHASE_MASK
#define PHASE_MASK 0xFFF
#endif
#define IN(k) (((PHASE_MASK >> (k)) & 1) && lo <= (k) && (k) < hi)
#ifndef PROBE_DBLBAR
#define PROBE_DBLBAR 0
#endif
#ifndef PROBE_TS
#define PROBE_TS -1
#endif
#define STAMP(k) do { if (PROBE_TS >= 0 && bx == 0 && threadIdx.x == 0) ((unsigned long long*)(ws + WS_CTL + 512 * 1024))[(k)] = __builtin_amdgcn_s_memrealtime(); } while (0)
#define SEAM(k) do { if (MK_N_LAUNCHES == 1 && IN((k) + 1)) { xcd_barrier(bar); if (PROBE_DBLBAR) xcd_barrier(bar); } STAMP((k) + 1); } while (0)
    const int ngw = G * NWAVES;
#define PH_IDS const int tid = my_tid(), lane = tid & 63, wave = __builtin_amdgcn_readfirstlane(tid >> 6), gw = vcu * NWAVES + wave; (void)lane; (void)gw

    STAMP(0);
    if (IN(0)) { asm volatile("" : "+s"(AP)); PH_IDS;
        for (int rep_ = 0; rep_ < NREP(0); ++rep_) { if (rep_) __syncthreads();
        STAMP(20); p0_mod(lds, I_cvec, I_c_ctx, I_mod_w, I_mod_b, MOD, G);
        __syncthreads(); STAMP(21);
        LAS float* scr = (LAS float*)(lds + wave * 16384);
        constexpr int I0 = 16 * (E_N / 32), I1 = 16 * 32;
        { const bool split = (G == 256); const int cw0 = split ? (bx - 192) * NWAVES + wave : gw, ncw = split ? 64 * NWAVES : ngw;
          if (!split || bx >= 192) for (int it = cw0; it < I0 + I1; it += ncw) {
            if (it < I0) p0_transpose_item(I_e_w_in, 1024, E_N, (bf16_t*)(ws + WS_WEIN), 0, nullptr, scr, it, E_N / 32, lane);
            else p0_transpose_item(I_e_w_out, 1024, 1024, (bf16_t*)(ws + WS_WEOUT), 1, nullptr, scr, it - I0, 32, lane); } }
        STAMP(22);
        float* ropeA = (float*)(ws + WS_ROPEA); float* ropeC = (float*)(ws + WS_ROPEC);
        for (int idx = bx * NTHREADS + tid; idx < 2048 * 48; idx += G * NTHREADS) {
            const int pos = idx / 48, j = idx % 48; const float rowf = (float)(pos >> 6), colf = (float)(pos & 63);
            if (j < 32) { const int f = j & 15; const float inv = exp2f(-(float)f * (13.287712379549449f / 16.f)); const float ang = ((j < 16) ? rowf : colf) * inv;
                ropeA[pos * 64 + j] = __cosf(ang); ropeA[pos * 64 + 32 + j] = __sinf(ang); }
            else { const int jj = j - 32, f = jj & 7; const float inv = exp2f(-(float)f * (13.287712379549449f / 8.f)); const float ang = ((jj < 8) ? rowf : colf) * inv;
                ropeC[pos * 32 + jj] = __cosf(ang); ropeC[pos * 32 + 16 + jj] = __sinf(ang); }
        }
        STAMP(23);
        }
        SEAM(0); STAMP(24);
    }
    if (IN(1)) { asm volatile("" : "+s"(AP)); PH_IDS; for (int rep_ = 0; rep_ < NREP(1); ++rep_) { if (rep_) __syncthreads();
        { LAS float* scr = (LAS float*)(lds + wave * 16384);
          constexpr int I2 = 16 * (O_N / 32), I3 = 12 * 24, I4 = 4 * 32, I5 = 16 * 32;
          for (int it = gw; it < I2 + I3 + I4 + I5; it += ngw) { int r = it;
            if (r < I2) { p0_transpose_item(I_o_w_in, 1024, O_NSRC, (bf16_t*)(ws + WS_WOIN), 2, nullptr, scr, r, O_N / 32, lane); continue; } r -= I2;
            if (r < I3) { p0_transpose_item(I_o_w_uq, 768, 768, (bf16_t*)(ws + WS_WUQ), 3, I_o_qn, scr, r, 24, lane); continue; } r -= I3;
            if (r < I4) { p0_transpose_item(I_o_w_ukv, 256, 1024, (bf16_t*)(ws + WS_WUKV), 4, I_o_kvn, scr, r, 32, lane); continue; } r -= I4;
            p0_transpose_item(I_o_w_out, 1024, 1024, (bf16_t*)(ws + WS_WOOUT), 5, nullptr, scr, r, 32, lane); } }
        p1_prenorm(I_x, I_ctx, I_pre_w, MOD, (bf16_t*)(ws + WS_H), gw, ngw, lane); }
        SEAM(1); }
    if (IN(2)) { asm volatile("" : "+s"(AP)); PH_IDS;
        for (int rep_ = 0; rep_ < NREP(2); ++rep_) { if (rep_) __syncthreads();
        pg8::Gemm g{(const bf16_t*)(ws + WS_H), (const bf16_t*)(ws + WS_WEIN), MT, E_N, 1024}; pg8::RectOrder S; S.init(MT / 256, E_N / 256, 0, 0, 0, G, bx);
        EpiEin E{ws}; pg8::gemm_phase<EpiEin, pg8::RectOrder, true, true>(lds, g, S, E);
        }
        SEAM(2);
    }
    if (IN(3)) { asm volatile("" : "+s"(AP)); PH_IDS;
        for (int rep_ = 0; rep_ < NREP(3) + NREP(14) - 1; ++rep_) {
        for (int un = vcu; un < 1024; un += G) attn_unit<0>(lds, ws, nullptr, I_e_sink, un);
        for (int un = bx; un < 128; un += G) attn_unit<1>(lds, ws, nullptr, I_e_sink, un);
        }
        for (int rep_ = 0; rep_ < NREP(3) + NREP(15) - 1; ++rep_) { p3_conv(ws, I_e_conv_w, bx * NTHREADS + tid, G * NTHREADS);
        }
        SEAM(3);
    }
    if (IN(4)) { asm volatile("" : "+s"(AP)); PH_IDS;
        for (int rep_ = 0; rep_ < NREP(4); ++rep_) { if (rep_) __syncthreads();
        pg8::Gemm g{(const bf16_t*)(ws + WS_U), (const bf16_t*)(ws + WS_WEOUT), MT, 1024, 1024}; pg8::RectOrder S; S.init(MT / 256, 4, 0, 0, 0, G, bx);
        EpiY E{(bf16_t*)(ws + WS_Y), (float*)(ws + WS_SSQY0)}; pg8::gemm_phase<EpiY, pg8::RectOrder, true, true>(lds, g, S, E);
        }
        SEAM(4);
    }
    if (IN(5)) { asm volatile("" : "+s"(AP)); PH_IDS; for (int rep_ = 0; rep_ < NREP(5); ++rep_) { if (rep_) __syncthreads();
        p5_post_pre(I_x, I_ctx, I_post_w, I_pre_w + 1024, MOD, (const bf16_t*)(ws + WS_Y), (const float*)(ws + WS_SSQY0), (bf16_t*)(ws + WS_X1), (bf16_t*)(ws + WS_H), gw, ngw, lane); }
        SEAM(5); }
    if (IN(6)) { asm volatile("" : "+s"(AP)); PH_IDS;
        for (int rep_ = 0; rep_ < NREP(6); ++rep_) { if (rep_) __syncthreads();
        pg8::Gemm g{(const bf16_t*)(ws + WS_H), (const bf16_t*)(ws + WS_WOIN), MT, O_N, 1024}; pg8::RectOrder S; S.init(ML / 256, O_N / 256, ML / 256, MC / 256, 5, G, bx);
        EpiOin E{ws, (unsigned char*)I_out}; pg8::gemm_phase<EpiOin, pg8::RectOrder, true, true>(lds, g, S, E);
        }
        SEAM(6);
    }
    if (IN(7)) { asm volatile("" : "+s"(AP)); PH_IDS;
        for (int rep_ = 0; rep_ < NREP(7); ++rep_) { if (rep_) __syncthreads();
        { pg8::Gemm g{(const bf16_t*)(ws + WS_CQ), (const bf16_t*)(ws + WS_WUQ), ML, 768, 768}; pg8::RectOrder S; S.init(ML / 256, 3, 0, 0, 0, G, bx);
          EpiUq E{ws, lds}; pg8::gemm_phase<EpiUq, pg8::RectOrder, true, true>(lds, g, S, E); }
        __syncthreads();
        { pg8::Gemm g{(const bf16_t*)(ws + WS_CKV), (const bf16_t*)(ws + WS_WUKV), MT, 1024, 256}; EpiUkv E{ws};
          if (G == 256) {
              pg8::ListOrder4 S; if (bx < 128) { S.start = bx; S.cnt = 1; } else if (bx < 192) { S.start = 128 + 3 * (bx - 128); S.cnt = 3; } else { S.start = 320 + 4 * (bx - 192); S.cnt = 4; }
              pg8::gemm_phase<EpiUkv, pg8::ListOrder4, true, true>(lds, g, S, E);
          } else { pg8::RectOrder S; S.init(MT / 256, 4, 0, 0, 0, G, G - 1 - bx); pg8::gemm_phase<EpiUkv, pg8::RectOrder, true, true>(lds, g, S, E); } }
        }
        SEAM(7);
    }
    if (IN(8)) { asm volatile("" : "+s"(AP)); PH_IDS;
        for (int rep_ = 0; rep_ < NREP(8) + NREP(12) - 1; ++rep_) { for (int ch = bx; ch < 256; ch += G) { STAMP(30); mlstm_chain_mfma<false>(lds, ws, (unsigned char*)I_out, I_o_ib, I_o_fb, ch); STAMP(31); }
        }
        for (int rep_ = 0; rep_ < NREP(8) + NREP(13) - 1; ++rep_) {
        for (int un = vcu; un < 1024; un += G) attn_unit<2>(lds, ws, (unsigned char*)I_out, nullptr, un);
        }
        STAMP(32); SEAM(8); STAMP(33);
    }
    if (IN(9)) { asm volatile("" : "+s"(AP)); PH_IDS; for (int rep_ = 0; rep_ < NREP(9); ++rep_) { if (rep_) __syncthreads();
        p9_readout(ws, (unsigned char*)I_out, I_o_hn, gw, ngw, lane); }
        SEAM(9); }
    if (IN(10)) { asm volatile("" : "+s"(AP)); PH_IDS;
        for (int rep_ = 0; rep_ < NREP(10); ++rep_) { if (rep_) __syncthreads();
        pg8::Gemm g{(const bf16_t*)(ws + WS_U), (const bf16_t*)(ws + WS_WOOUT), ML, 1024, 1024}; pg8::RectOrder S; S.init(ML / 256, 4, 0, 0, 0, G, bx);
        EpiY E{(bf16_t*)(ws + WS_Y), (float*)(ws + WS_SSQY1)}; pg8::gemm_phase<EpiY, pg8::RectOrder, true, true>(lds, g, S, E);
        }
        SEAM(10);
    }
    if (IN(11)) { asm volatile("" : "+s"(AP)); PH_IDS; p11_final(I_post_w + 1024, MOD, (const bf16_t*)(ws + WS_Y), (const float*)(ws + WS_SSQY1), (const bf16_t*)(ws + WS_X1), I_out, gw, ngw, lane);
        if (PROBE_TS >= 0 && bx == 0 && threadIdx.x == 0) { asm volatile("s_waitcnt vmcnt(0)" ::: "memory"); const unsigned long long* ts = (const unsigned long long*)(ws + WS_CTL + 512 * 1024);
            const unsigned long long t1 = (PROBE_TS == 11) ? __builtin_amdgcn_s_memrealtime() : ts[PROBE_TS + 1]; I_out[5 * 1024 * 7 + 3] += floorf((float)(t1 - ts[PROBE_TS]) * 0.01f * (1.f / 50.f)) * 50.f; } }
#undef IN
#undef SEAM
#undef I_x
#undef I_cvec
#undef I_ctx
#undef I_c_ctx
#undef I_mod_w
#undef I_mod_b
#undef I_pre_w
#undef I_post_w
#undef I_e_w_in
#undef I_e_sink
#undef I_e_conv_w
#undef I_e_w_out
#undef I_o_w_in
#undef I_o_qn
#undef I_o_kvn
#undef I_o_w_uq
#undef I_o_w_ukv
#undef I_o_ib
#undef I_o_fb
#undef I_o_hn
#undef I_o_w_out
#undef I_out
}

extern "C" void kernel_launch(void* const* d_in, const int* in_sizes, int n_in, void* d_out, int out_size, void* d_ws, size_t ws_size, hipStream_t stream) {
    static int grid = 0;
    if (grid == 0) {
        if (n_in != 21 || in_sizes[0] != ML * DM || out_size != ML * DM || ws_size < WS_END) { fprintf(stderr, "kernel_launch: unexpected shapes / workspace (n_in %d, ws %zu < %zu); nothing launched\n", n_in, ws_size, (size_t)WS_END); grid = -1; return; }
        int dev = 0, cus = 0, per_cu = 0;
        if (hipGetDevice(&dev) != hipSuccess || hipDeviceGetAttribute(&cus, hipDeviceAttributeMultiprocessorCount, dev) != hipSuccess) { grid = -1; return; }
        if (hipFuncSetAttribute((const void*)hybrid_fwd, hipFuncAttributeMaxDynamicSharedMemorySize, LDS_BYTES) != hipSuccess) { fprintf(stderr, "kernel_launch: hipFuncSetAttribute failed\n"); grid = -1; return; }
        if (hipOccupancyMaxActiveBlocksPerMultiprocessor(&per_cu, (const void*)hybrid_fwd, NTHREADS, LDS_BYTES) != hipSuccess || per_cu < 1) fprintf(stderr, "kernel_launch: note: occupancy query reports %d workgroups per CU\n", per_cu);
        (void)hipGetLastError();
        grid = cus;
    }
    if (grid < 0) return;
    if (hipMemsetAsync((char*)d_ws + WS_CTL, 0, CTL_ZERO_BYTES, stream) != hipSuccess) { fprintf(stderr, "kernel_launch: hipMemsetAsync failed\n"); return; }
    Args a{};
    for (int i = 0; i < 21; ++i) a.in[i] = (const float*)d_in[i];
    a.out = (float*)d_out; a.ws = (unsigned char*)d_ws;
    if (MK_N_LAUNCHES == 1) { a.ph_lo = 0; a.ph_hi = N_PHASES; hipLaunchKernelGGL(hybrid_fwd, dim3(grid), dim3(NTHREADS), LDS_BYTES, stream, a); }
    else for (int p = 0; p < N_PHASES; ++p) { a.ph_lo = p; a.ph_hi = p + 1; hipLaunchKernelGGL(hybrid_fwd, dim3(grid), dim3(NTHREADS), LDS_BYTES, stream, a); }
    const hipError_t le = hipPeekAtLastError();
    if (le != hipSuccess) fprintf(stderr, "kernel_launch: launch failed: %s\n", hipGetErrorName(le));
}
```

```cpp
#include <hip/hip_runtime.h>
#include <cstdio>
#include <cstdint>

#define LAS __attribute__((address_space(3)))
#define GAS __attribute__((address_space(1)))
typedef unsigned short bf16_t;
typedef short bf16x8 __attribute__((ext_vector_type(8)));
typedef short s16x4 __attribute__((ext_vector_type(4)));
typedef float f32x4 __attribute__((ext_vector_type(4)));
typedef float f32x16 __attribute__((ext_vector_type(16)));
typedef unsigned u32x4 __attribute__((ext_vector_type(4)));
typedef unsigned u32x2 __attribute__((ext_vector_type(2)));
typedef float f32x2_t __attribute__((ext_vector_type(2)));
typedef __bf16 bf16x2_t __attribute__((ext_vector_type(2)));

constexpr int NB = 16, SEQ = 2048, DM = 1024, CL = 256;
constexpr int ML = NB * SEQ, MC = NB * CL, MT = ML + MC;
constexpr float EPS = 1e-6f, LOG2E = 1.4426950408889634f;
constexpr int E_N = 3328, O_NSRC = 3632, O_N = 3840;
constexpr int NWAVES = 8, NTHREADS = 512;

__device__ __forceinline__ float bf_lo(unsigned w) { return __uint_as_float(w << 16); }
__device__ __forceinline__ float bf_hi(unsigned w) { return __uint_as_float(w & 0xffff0000u); }
__device__ __forceinline__ unsigned pk2(float lo, float hi) { f32x2_t v = {lo, hi}; bf16x2_t b = __builtin_convertvector(v, bf16x2_t); return __builtin_bit_cast(unsigned, b); }
__device__ __forceinline__ float silu_f(float x) { return x * __builtin_amdgcn_rcpf(1.f + __expf(-x)); }
__device__ __forceinline__ float sigmoid_f(float x) { return __builtin_amdgcn_rcpf(1.f + __expf(-x)); }
__device__ __forceinline__ float wave_sum(float v) {
#pragma unroll
    for (int o = 1; o < 64; o <<= 1) v += __shfl_xor(v, o);
    return v;
}
#define LDS_WAIT() asm volatile("s_waitcnt lgkmcnt(0)" ::: "memory")
#define VM_WAIT() asm volatile("s_waitcnt vmcnt(0)" ::: "memory")

__device__ __forceinline__ int my_tid() { int t = threadIdx.x; asm volatile("" : "+v"(t)); return t; }

namespace pg8 {
#define PG8_LAS __attribute__((address_space(3)))
typedef unsigned short bf16_t;
typedef short bf16x8 __attribute__((ext_vector_type(8)));
typedef float f32x4 __attribute__((ext_vector_type(4)));
typedef unsigned u32x4 __attribute__((ext_vector_type(4)));
constexpr int BM = 256, BK = 64, HALF = 128, HTB = HALF * BK * 2  , STAGE_BYTES = 8 * HTB, NXCD = 8, WGM = 8;

__host__ __device__ __forceinline__ int lds_byte(int r, int c) { const int st = (r >> 4) * 2 + (c >> 5), rr = r & 15, cc = c & 31, ob = rr * 64 + cc * 2; return st * 1024 + (ob ^ (((ob >> 9) & 1) << 5)); }
__host__ __device__ __forceinline__ void stage_rc(int b, int& R, int& C) { const int st = b / 1024, sb = b % 1024, swz = sb ^ (((sb >> 9) & 1) << 5); R = (st >> 1) * 16 + swz / 64; C = (st & 1) * 32 + (swz % 64) / 2; }
__host__ __device__ __forceinline__ int perm32(int rho) { const int n = rho >> 4, i = rho & 15; return 8 * (i >> 2) + 4 * n + (i & 3); }

struct Unit { int pm, pn; };
struct Gemm { const bf16_t* A; const bf16_t* Bt; int M, N, K; };

struct RectOrder {
    int nM0, nN0, n0, pm1, nM1, nN1, n1, G, c;
    __device__ __forceinline__ void init(int nM0_, int nN0_, int pm1_, int nM1_, int nN1_, int G_, int c_) { nM0 = nM0_; nN0 = nN0_; n0 = nM0_ * nN0_; pm1 = pm1_; nM1 = nM1_; nN1 = nN1_; n1 = nM1_ * nN1_; G = G_; c = c_; }
    __device__ __forceinline__ static void rect(int w, int nM, int nN, int& pm, int& pn) {
        const int nig = WGM * nN, gid = w / nig, fm = gid * WGM, gsz = (nM - fm) < WGM ? (nM - fm) : WGM;
        pm = fm + ((w % nig) % gsz); pn = (w % nig) / gsz;
    }
    __device__ __forceinline__ bool next(int i, Unit& u) const {
        const int nwg = n0 + n1; const long L = (long)i * G + c; if (L >= nwg) return false;
        int wgid = (int)L; { const int q = nwg / NXCD, r = nwg % NXCD, xcd = wgid % NXCD, off = wgid / NXCD; wgid = (xcd < r ? xcd * (q + 1) : r * (q + 1) + (xcd - r) * q) + off; }
        if (wgid < n0) rect(wgid, nM0, nN0, u.pm, u.pn); else { rect(wgid - n0, nM1, nN1, u.pm, u.pn); u.pm += pm1; }
        return true;
    }
    __device__ __forceinline__ void a_ready(const Unit&) const {}
    __device__ __forceinline__ void done(const Unit&) const {}
};

struct ListOrder4 {
    int start, cnt;
    __device__ __forceinline__ bool next(int i, Unit& u) const { if (i >= cnt) return false; const int L = start + i; u.pm = L >> 2; u.pn = L & 3; return true; }
    __device__ __forceinline__ void a_ready(const Unit&) const {}
    __device__ __forceinline__ void done(const Unit&) const {}
};

struct PanelOrder {
    int nM0, nN0, nN1, total, first, step, cnt;
    const unsigned* ready; unsigned need; unsigned* tmo;
    __device__ __forceinline__ bool next(int i, Unit& u) const {
        if (i >= cnt) return false; int L = first + step * i; if (L >= total) return false;
        const int n0 = nM0 * nN0; if (L < n0) { u.pm = L / nN0; u.pn = L - u.pm * nN0; } else { L -= n0; const int q = L / nN1; u.pm = nM0 + q; u.pn = L - q * nN1; }
        return true;
    }
    __device__ __forceinline__ void a_ready(const Unit& u) const {
        if (ready == nullptr) return;
        if (threadIdx.x < 64) {
            const unsigned long long t0 = __builtin_amdgcn_s_memrealtime(); unsigned polls = 0;
            while ((unsigned)__builtin_amdgcn_readfirstlane(__hip_atomic_load(ready + 64 * u.pm, __ATOMIC_RELAXED, __HIP_MEMORY_SCOPE_AGENT)) < need) {
                if ((++polls & 255u) == 0u && __builtin_amdgcn_readfirstlane(__hip_atomic_load(tmo, __ATOMIC_RELAXED, __HIP_MEMORY_SCOPE_AGENT)) != 0u) break;
                if (__builtin_amdgcn_s_memrealtime() - t0 > 2000000ull) { if (threadIdx.x == 0) __hip_atomic_store(tmo, 1u, __ATOMIC_RELAXED, __HIP_MEMORY_SCOPE_AGENT); break; }
                __builtin_amdgcn_s_sleep(2); }
            asm volatile("s_waitcnt vmcnt(0)" ::: "memory");
        }
        asm volatile("" ::: "memory"); __builtin_amdgcn_s_barrier(); asm volatile("" ::: "memory");
    }
    __device__ __forceinline__ void done(const Unit&) const {}
};

template <class Epi, class Sched, bool ALIGN_EPI = false, bool SP2 = false>
__device__ __forceinline__ void gemm_phase(PG8_LAS unsigned char* lds, const Gemm g, const Sched& S, const Epi& E) {
    const int tid = my_tid(), wid = __builtin_amdgcn_readfirstlane(tid >> 6), lane = tid & 63, wr = wid >> 2, wc = wid & 3, fr = lane & 15, fq = lane >> 4;
    const int K = g.K, nt = K / BK;
    unsigned voffA[2], voffB[2];
#pragma unroll
    for (int i = 0; i < 2; ++i) { int R, C; stage_rc(tid * 16 + i * 8192, R, C); const int Rb = Epi::PERM ? ((R & ~31) + perm32(R & 31)) : R;
        voffA[i] = (unsigned)(R * K + C) * 2u; voffB[i] = (unsigned)(Rb * K + C) * 2u; }
    const size_t kstep = (size_t)(BK * 2);
    const size_t hstep = (size_t)HALF * K * 2;
    const size_t tstep = 2 * hstep;
    const unsigned ldsw = (unsigned)wid * 1024u;
    const int aoff = lds_byte(wr * 64 + fr, fq * 8), boff = lds_byte(wc * 32 + fr, fq * 8);
#define PG8_SA(b, h) (((b) * 2 + (h)) * HTB)
#define PG8_SB(b, h) ((4 + (b) * 2 + (h)) * HTB)
#define PG8_STAGE(bufoff, gbase, voff) do { _Pragma("unroll") for (int _i = 0; _i < 2; ++_i) \
        __builtin_amdgcn_global_load_lds((const unsigned*)((const char*)(gbase) + (voff)[_i]), (PG8_LAS unsigned*)(lds + (bufoff) + ldsw + _i * 8192), 16, 0, 0); } while (0)
#define PG8_LDA(dst, b, h) do { _Pragma("unroll") for (int m = 0; m < 4; ++m) _Pragma("unroll") for (int k = 0; k < 2; ++k) dst[m][k] = *(const PG8_LAS bf16x8*)(lds + PG8_SA(b, h) + aoff + m * 2048 + k * 1024); } while (0)
#define PG8_LDB(dst, b, h) do { _Pragma("unroll") for (int n = 0; n < 2; ++n) _Pragma("unroll") for (int k = 0; k < 2; ++k) dst[n][k] = *(const PG8_LAS bf16x8*)(lds + PG8_SB(b, h) + boff + n * 2048 + k * 1024); } while (0)
#define PG8_MMA(ai, bj, At, Bt) do { __builtin_amdgcn_s_setprio(1); _Pragma("unroll") for (int m = 0; m < 4; ++m) _Pragma("unroll") for (int n = 0; n < 2; ++n) _Pragma("unroll") for (int k = 0; k < 2; ++k) \
        acc[ai][bj][m][n] = __builtin_amdgcn_mfma_f32_16x16x32_bf16(Bt[n][k], At[m][k], acc[ai][bj][m][n], 0, 0, 0); __builtin_amdgcn_s_setprio(0); } while (0)
#define PG8_WAIT_V(n) asm volatile("s_waitcnt vmcnt(" #n ")" ::: "memory")
#define PG8_WAIT_L(n) asm volatile("s_waitcnt lgkmcnt(" #n ")" ::: "memory")
#define PG8_BAR __builtin_amdgcn_s_barrier()
#define PG8_SCHED __builtin_amdgcn_sched_barrier(0)
    Unit cur, nxt; int ui = 0;
    if (!S.next(0, cur)) return;
    f32x4 acc[2][2][4][2];
#pragma unroll
    for (int a = 0; a < 2; ++a)
#pragma unroll
        for (int b = 0; b < 2; ++b)
#pragma unroll
            for (int m = 0; m < 4; ++m)
#pragma unroll
                for (int n = 0; n < 2; ++n) acc[a][b][m][n] = (f32x4){0.f, 0.f, 0.f, 0.f};
    bf16x8 At[4][2], B0[2][2], B1[2][2];
    const char* cA = (const char*)g.A + (size_t)cur.pm * tstep; const char* cB = (const char*)g.Bt + (size_t)cur.pn * tstep;
    S.a_ready(cur);
    if constexpr (SP2) {
        PG8_STAGE(PG8_SB(0, 0), cB, voffB); PG8_STAGE(PG8_SB(0, 1), cB + hstep, voffB); PG8_STAGE(PG8_SA(0, 0), cA, voffA); PG8_STAGE(PG8_SA(0, 1), cA + hstep, voffA);
        if (wr == 1) PG8_BAR;
        PG8_WAIT_V(2); PG8_BAR;
        PG8_STAGE(PG8_SB(1, 0), cB + kstep, voffB); PG8_STAGE(PG8_SA(1, 0), cA + kstep, voffA); PG8_STAGE(PG8_SB(1, 1), cB + hstep + kstep, voffB);
        PG8_WAIT_V(6); PG8_BAR;
    } else {
        PG8_STAGE(PG8_SB(0, 0), cB, voffB); PG8_STAGE(PG8_SA(0, 0), cA, voffA); PG8_STAGE(PG8_SB(0, 1), cB + hstep, voffB); PG8_STAGE(PG8_SA(0, 1), cA + hstep, voffA);
        if (wr == 1) PG8_BAR;
        PG8_WAIT_V(4); PG8_BAR;
        PG8_STAGE(PG8_SB(1, 0), cB + kstep, voffB); PG8_STAGE(PG8_SA(1, 0), cA + kstep, voffA); PG8_STAGE(PG8_SB(1, 1), cB + hstep + kstep, voffB);
        PG8_WAIT_V(6); PG8_BAR;
    }
    for (;;) {
        const bool has_next = S.next(ui + 1, nxt);
        const char* nA = has_next ? (const char*)g.A + (size_t)nxt.pm * tstep : cA; const char* nB = has_next ? (const char*)g.Bt + (size_t)nxt.pn * tstep : cB;
        for (int t = 0; t < nt; t += 2) {
            const bool last = (t == nt - 2);
            const char* a1 = cA + (size_t)(t + 1) * kstep;
            const char* a2 = last ? nA : cA + (size_t)(t + 2) * kstep; const char* b2 = last ? nB : cB + (size_t)(t + 2) * kstep;
            const char* a3 = a2 + kstep; const char* b3 = b2 + kstep;
            if (last && has_next) S.a_ready(nxt);
            if constexpr (SP2) {
            PG8_LDB(B0, 0, 0); PG8_LDB(B1, 0, 1); PG8_SCHED; PG8_LDA(At, 0, 0); PG8_STAGE(PG8_SA(1, 1), a1 + hstep, voffA);
            PG8_WAIT_V(8); PG8_WAIT_L(0); PG8_BAR; PG8_MMA(0, 0, At, B0); PG8_MMA(0, 1, At, B1); PG8_BAR; PG8_SCHED;
            PG8_LDA(At, 0, 1); PG8_STAGE(PG8_SB(0, 0), b2, voffB); PG8_STAGE(PG8_SB(0, 1), b2 + hstep, voffB); PG8_STAGE(PG8_SA(0, 0), a2, voffA);
            PG8_WAIT_V(8); PG8_WAIT_L(0); PG8_BAR; PG8_MMA(1, 0, At, B0); PG8_MMA(1, 1, At, B1); PG8_BAR; PG8_SCHED;
            PG8_LDB(B0, 1, 0); PG8_LDB(B1, 1, 1); PG8_SCHED; PG8_LDA(At, 1, 0); PG8_STAGE(PG8_SA(0, 1), a2 + hstep, voffA);
            PG8_WAIT_V(8); PG8_WAIT_L(0); PG8_BAR; PG8_MMA(0, 0, At, B0); PG8_MMA(0, 1, At, B1); PG8_BAR; PG8_SCHED;
            PG8_LDA(At, 1, 1); PG8_STAGE(PG8_SB(1, 0), b3, voffB); PG8_STAGE(PG8_SB(1, 1), b3 + hstep, voffB); PG8_STAGE(PG8_SA(1, 0), a3, voffA);
            PG8_WAIT_V(8); PG8_WAIT_L(0); PG8_BAR; PG8_MMA(1, 0, At, B0); PG8_MMA(1, 1, At, B1); PG8_BAR; PG8_SCHED;
            } else {
            PG8_LDB(B0, 0, 0); PG8_SCHED; PG8_LDA(At, 0, 0); PG8_STAGE(PG8_SA(1, 1), a1 + hstep, voffA);
            PG8_WAIT_L(8); PG8_BAR; PG8_WAIT_L(0); PG8_MMA(0, 0, At, B0); PG8_BAR; PG8_SCHED;
            PG8_LDB(B1, 0, 1); PG8_STAGE(PG8_SB(0, 0), b2, voffB);
            PG8_BAR; PG8_WAIT_L(0); PG8_MMA(0, 1, At, B1); PG8_BAR;
            PG8_LDA(At, 0, 1); PG8_STAGE(PG8_SA(0, 0), a2, voffA);
            PG8_BAR; PG8_WAIT_L(0); PG8_MMA(1, 0, At, B0); PG8_BAR; PG8_SCHED;
            PG8_STAGE(PG8_SB(0, 1), b2 + hstep, voffB);
            PG8_WAIT_V(6); PG8_BAR; PG8_MMA(1, 1, At, B1); PG8_BAR;
            PG8_LDB(B0, 1, 0); PG8_SCHED; PG8_LDA(At, 1, 0); PG8_STAGE(PG8_SA(0, 1), a2 + hstep, voffA);
            PG8_WAIT_L(8); PG8_BAR; PG8_WAIT_L(0); PG8_MMA(0, 0, At, B0); PG8_BAR; PG8_SCHED;
            PG8_LDB(B1, 1, 1); PG8_STAGE(PG8_SB(1, 0), b3, voffB);
            PG8_BAR; PG8_WAIT_L(0); PG8_MMA(0, 1, At, B1); PG8_BAR;
            PG8_LDA(At, 1, 1); PG8_STAGE(PG8_SA(1, 0), a3, voffA);
            PG8_BAR; PG8_WAIT_L(0); PG8_MMA(1, 0, At, B0); PG8_BAR; PG8_SCHED;
            PG8_STAGE(PG8_SB(1, 1), b3 + hstep, voffB);
            PG8_WAIT_V(6); PG8_BAR; PG8_MMA(1, 1, At, B1); PG8_BAR;
            }
        }
        if constexpr (ALIGN_EPI) { if (wr == 0) PG8_BAR; }
        if constexpr (!Epi::AFTER_DRAIN) { E(acc, cur, wr, wc, fr, fq); S.done(cur); }
        if (!has_next) break;
#pragma unroll
        for (int a = 0; a < 2; ++a)
#pragma unroll
            for (int b = 0; b < 2; ++b)
#pragma unroll
                for (int m = 0; m < 4; ++m)
#pragma unroll
                    for (int n = 0; n < 2; ++n) acc[a][b][m][n] = (f32x4){0.f, 0.f, 0.f, 0.f};
        cur = nxt; cA = nA; cB = nB; ++ui;
        if constexpr (ALIGN_EPI) { if (wr == 1) PG8_BAR; }
    }
    PG8_WAIT_V(0);
    if constexpr (!ALIGN_EPI) { if (wr == 0) PG8_BAR; }
    PG8_BAR;
    if constexpr (Epi::AFTER_DRAIN) { E.fused(acc, cur, wr, wc, fr, fq, lds, wid, lane); S.done(cur); }
#undef PG8_SA
#undef PG8_SB
#undef PG8_STAGE
#undef PG8_LDA
#undef PG8_LDB
#undef PG8_MMA
#undef PG8_WAIT_V
#undef PG8_WAIT_L
#undef PG8_BAR
#undef PG8_SCHED
}
}

constexpr size_t MiB = 1u << 20;
constexpr size_t WS_CTL = 0, CTL_ZERO_BYTES = 128 * 1024;
constexpr int CW_PANEL = 8192, PANEL_BANK = 144 * 64;
constexpr size_t WS_MOD = 1 * MiB;
constexpr size_t WS_ROPEA = 2 * MiB;
constexpr size_t WS_ROPEC = 2 * MiB + 512 * 1024;
constexpr size_t WS_WEIN = 3 * MiB, WS_WEOUT = 10 * MiB, WS_WOIN = 12 * MiB, WS_WUQ = 20 * MiB, WS_WUKV = 21 * MiB + 512 * 1024, WS_WOOUT = 22 * MiB;
constexpr size_t WS_H = 24 * MiB;
constexpr size_t WS_U = 96 * MiB;
constexpr size_t WS_Y = 168 * MiB;
constexpr size_t WS_R = 240 * MiB;
constexpr size_t WS_KVE = WS_R  , WS_QE = WS_R + 18 * MiB, WS_PE = WS_R + 54 * MiB, WS_GE = WS_R + 90 * MiB, WS_ZA = WS_R + 126 * MiB, WS_SSQY0 = WS_R + 241 * MiB  ;
constexpr size_t WS_CKV = WS_R, WS_CQ = WS_R + 18 * MiB, WS_HM = WS_R  , WS_MK = WS_R + 66 * MiB, WS_MV = WS_R + 84 * MiB, WS_KR = WS_R + 120 * MiB, WS_GATES = WS_R + 123 * MiB,
                 WS_SSQCKV = WS_R + 126 * MiB, WS_SSQCQ = WS_R + 127 * MiB, WS_X1 = WS_R + 129 * MiB  , WS_SSQY1 = WS_R + 241 * MiB;
constexpr size_t AUX_MQ = 0, AUX_MO = 16 * MiB, AUX_ZO = 48 * MiB;
constexpr size_t WS_KNV = WS_H  , WS_QO = WS_Y;
constexpr size_t WS_END = WS_R + 244 * MiB;
static_assert(WS_ZA + (size_t)MT * 512 * 2 <= WS_R + 162 * MiB && WS_X1 + (size_t)ML * 1024 * 2 <= WS_R + 241 * MiB && WS_HM + (size_t)2 * ML * 512 * 2 <= WS_MK && WS_SSQY1 + (size_t)MT * 16 * 4 <= WS_END, "ws map");

__device__ __forceinline__ void st8(bf16_t* p, f32x4 a, f32x4 b) { u32x4 w; w.x = pk2(a[0], a[1]); w.y = pk2(a[2], a[3]); w.z = pk2(b[0], b[1]); w.w = pk2(b[2], b[3]); *(u32x4*)p = w; }
__device__ __forceinline__ bf16_t f2bf(float v) { return (bf16_t)(pk2(v, 0.f) & 0xffffu); }
__device__ __forceinline__ void rope8(f32x4& a, f32x4& b, const float* cosp, const float* sinp) {
    const f32x4 cs = *(const f32x4*)cosp, sn = *(const f32x4*)sinp;
    const float a0 = a[0] * cs[0] - a[1] * sn[0], a1 = a[0] * sn[0] + a[1] * cs[0], a2 = a[2] * cs[1] - a[3] * sn[1], a3 = a[2] * sn[1] + a[3] * cs[1];
    const float b0 = b[0] * cs[2] - b[1] * sn[2], b1 = b[0] * sn[2] + b[1] * cs[2], b2 = b[2] * cs[3] - b[3] * sn[3], b3 = b[2] * sn[3] + b[3] * cs[3];
    a = (f32x4){a0, a1, a2, a3}; b = (f32x4){b0, b1, b2, b3};
}
__device__ __forceinline__ f32x4 silu4(f32x4 v) { return (f32x4){silu_f(v[0]), silu_f(v[1]), silu_f(v[2]), silu_f(v[3])}; }
__device__ __forceinline__ f32x4 sigm4(f32x4 v) { return (f32x4){sigmoid_f(v[0]), sigmoid_f(v[1]), sigmoid_f(v[2]), sigmoid_f(v[3])}; }
__device__ __forceinline__ float sq4(f32x4 v) { return (v[0] * v[0] + v[1] * v[1]) + (v[2] * v[2] + v[3] * v[3]); }

struct EpiEin {
    static constexpr bool PERM = true, AFTER_DRAIN = false;
    unsigned char* ws;
    __device__ __forceinline__ void operator()(const f32x4 (&acc)[2][2][4][2], const pg8::Unit& u, int wr, int wc, int fr, int fq) const {
        const int pn = u.pn, rbase = u.pm * 256 + wr * 64 + fr, cw = wc * 32 + 8 * fq;
        const float* ropeA = (const float*)(ws + WS_ROPEA);
#pragma unroll
        for (int ai = 0; ai < 2; ++ai)
#pragma unroll
            for (int m = 0; m < 4; ++m) {
                asm volatile("" ::: "memory"); const int R = rbase + ai * 128 + m * 16; const bool lat = R < ML; const int pos = R & 2047;
                if (pn == 0) {
                    f32x4 a = acc[ai][0][m][0], b = acc[ai][0][m][1];
                    if (lat) { const int i0 = (cw & 63) >> 1; rope8(a, b, ropeA + pos * 64 + i0, ropeA + pos * 64 + 32 + i0); }
                    st8((bf16_t*)(ws + WS_KVE) + (size_t)R * 256 + cw, a, b);
                    st8((bf16_t*)(ws + WS_KVE) + (size_t)R * 256 + 128 + cw, acc[ai][1][m][0], acc[ai][1][m][1]);
                } else if (pn <= 2) {
#pragma unroll
                    for (int bj = 0; bj < 2; ++bj) {
                        f32x4 a = acc[ai][bj][m][0], b = acc[ai][bj][m][1];
                        if (lat) { const int i0 = (cw & 63) >> 1; rope8(a, b, ropeA + pos * 64 + i0, ropeA + pos * 64 + 32 + i0); }
                        const float sc = 0.125f * LOG2E; a = a * sc; b = b * sc;
                        st8((bf16_t*)(ws + WS_QE) + (size_t)R * 512 + (pn - 1) * 256 + bj * 128 + cw, a, b);
                    }
                } else if (pn <= 6) {
                    st8((bf16_t*)(ws + WS_PE) + (size_t)R * 512 + (pn - 3) * 128 + cw, acc[ai][0][m][0] * acc[ai][1][m][0], acc[ai][0][m][1] * acc[ai][1][m][1]);
                } else if (pn <= 10) {
                    st8((bf16_t*)(ws + WS_GE) + (size_t)R * 512 + (pn - 7) * 128 + cw, acc[ai][0][m][0] * silu4(acc[ai][1][m][0]), acc[ai][0][m][1] * silu4(acc[ai][1][m][1]));
                } else {
#pragma unroll
                    for (int bj = 0; bj < 2; ++bj)
                        st8((bf16_t*)(ws + WS_ZA) + (size_t)R * 512 + (pn - 11) * 256 + bj * 128 + cw, silu4(acc[ai][bj][m][0]), silu4(acc[ai][bj][m][1]));
                }
            }
    }
};

struct EpiY {
    static constexpr bool PERM = true, AFTER_DRAIN = false;
    bf16_t* Y; float* SSQ;
    __device__ __forceinline__ void operator()(const f32x4 (&acc)[2][2][4][2], const pg8::Unit& u, int wr, int wc, int fr, int fq) const {
        const int pn = u.pn, rbase = u.pm * 256 + wr * 64 + fr, cw = wc * 32 + 8 * fq;
#pragma unroll
        for (int ai = 0; ai < 2; ++ai)
#pragma unroll
            for (int m = 0; m < 4; ++m) {
                asm volatile("" ::: "memory"); const int R = rbase + ai * 128 + m * 16; float s = 0.f;
#pragma unroll
                for (int bj = 0; bj < 2; ++bj) { st8(Y + (size_t)R * 1024 + pn * 256 + bj * 128 + cw, acc[ai][bj][m][0], acc[ai][bj][m][1]); s += sq4(acc[ai][bj][m][0]) + sq4(acc[ai][bj][m][1]); }
                s += __shfl_xor(s, 16); s += __shfl_xor(s, 32);
                if (fq == 0) SSQ[(size_t)R * 16 + pn * 4 + wc] = s;
            }
    }
};

struct EpiOin {
    static constexpr bool PERM = true, AFTER_DRAIN = false;
    unsigned char* ws; unsigned char* aux;
    __device__ __forceinline__ void operator()(const f32x4 (&acc)[2][2][4][2], const pg8::Unit& u, int wr, int wc, int fr, int fq) const {
        const int pn = u.pn, rbase = u.pm * 256 + wr * 64 + fr, cw = wc * 32 + 8 * fq;
        const float* ropeC = (const float*)(ws + WS_ROPEC);
#pragma unroll
        for (int ai = 0; ai < 2; ++ai)
#pragma unroll
            for (int m = 0; m < 4; ++m) {
                asm volatile("" ::: "memory"); const int R = rbase + ai * 128 + m * 16; const bool lat = R < ML; const int pos = R & 2047;
                if (pn == 0 || (pn >= 5 && pn <= 7)) {
                    float s = 0.f;
                    bf16_t* dst = (pn == 0) ? (bf16_t*)(ws + WS_CKV) + (size_t)R * 256 : (bf16_t*)(ws + WS_CQ) + (size_t)R * 768 + (pn - 5) * 256;
#pragma unroll
                    for (int bj = 0; bj < 2; ++bj) { st8(dst + bj * 128 + cw, acc[ai][bj][m][0], acc[ai][bj][m][1]); s += sq4(acc[ai][bj][m][0]) + sq4(acc[ai][bj][m][1]); }
                    s += __shfl_xor(s, 16); s += __shfl_xor(s, 32);
                    if (fq == 0) { if (pn == 0) ((float*)(ws + WS_SSQCKV))[(size_t)R * 4 + wc] = s; else ((float*)(ws + WS_SSQCQ))[(size_t)R * 12 + (pn - 5) * 4 + wc] = s; }
                } else if (pn == 4) {
                    if (wc == 0) {
                        f32x4 a = acc[ai][0][m][0], b = acc[ai][0][m][1];
                        if (lat) { const int i0 = cw >> 1; rope8(a, b, ropeC + pos * 32 + i0, ropeC + pos * 32 + 16 + i0); }
                        st8((bf16_t*)(ws + WS_KR) + (size_t)R * 32 + cw, a, b);
                    } else if (wc == 1 && fq < 2) {
                        float* g = (float*)(ws + WS_GATES) + (size_t)R * 16 + 8 * fq;
                        *(f32x4*)g = acc[ai][0][m][0]; *(f32x4*)(g + 4) = acc[ai][0][m][1];
                    }
                } else {
#pragma unroll
                    for (int bj = 0; bj < 2; ++bj) {
                        const f32x4 a = acc[ai][bj][m][0], b = acc[ai][bj][m][1]; const int col = bj * 128 + cw;
                        if (pn == 1) st8((bf16_t*)(ws + WS_MK) + (size_t)R * 256 + col, a * 0.125f, b * 0.125f);
                        else if (pn <= 3) st8((bf16_t*)(ws + WS_MV) + (size_t)R * 512 + (pn - 2) * 256 + col, a, b);
                        else if (pn == 8) st8((bf16_t*)(aux + AUX_MQ) + (size_t)R * 256 + col, a, b);
                        else if (pn >= 13) st8((bf16_t*)(aux + AUX_ZO) + (size_t)R * 512 + (pn - 13) * 256 + col, silu4(a), silu4(b));
                        else if (bj == 0) st8((bf16_t*)(aux + AUX_MO) + (size_t)R * 512 + (pn - 9) * 128 + cw, sigm4(a) * silu4(acc[ai][1][m][0]), sigm4(b) * silu4(acc[ai][1][m][1]));
                    }
                }
            }
    }
};

struct EpiUkv {
    static constexpr bool PERM = true, AFTER_DRAIN = false;
    unsigned char* ws;
    __device__ __forceinline__ void operator()(const f32x4 (&acc)[2][2][4][2], const pg8::Unit& u, int wr, int wc, int fr, int fq) const {
        const int pn = u.pn, rbase = u.pm * 256 + wr * 64 + fr, cw = wc * 32 + 8 * fq;
#pragma unroll
        for (int ai = 0; ai < 2; ++ai)
#pragma unroll
            for (int m = 0; m < 4; ++m) {
                asm volatile("" ::: "memory"); const int R = rbase + ai * 128 + m * 16;
                const f32x4 sp = *(const f32x4*)((const float*)(ws + WS_SSQCKV) + (size_t)R * 4);
                const float rstd = rsqrtf(((sp[0] + sp[1]) + (sp[2] + sp[3])) * (1.f / 256.f) + EPS);
                int b, pos; if (R < ML) { b = R >> 11; pos = 256 + (R & 2047); } else { const int rc = R - ML; b = rc >> 8; pos = rc & 255; }
#pragma unroll
                for (int bj = 0; bj < 2; ++bj) {
                    const int head = pn * 2 + bj;
                    st8((bf16_t*)(ws + WS_KNV) + ((size_t)(b * 8 + head) * 2304 + pos) * 128 + cw, acc[ai][bj][m][0] * rstd, acc[ai][bj][m][1] * rstd);
                }
            }
    }
};

struct EpiUq {
    static constexpr bool PERM = true, AFTER_DRAIN = false;
    unsigned char* ws; LAS unsigned char* lds;
    __device__ __forceinline__ void operator()(const f32x4 (&acc)[2][2][4][2], const pg8::Unit& u, int wr, int wc, int fr, int fq) const {
        const int pn = u.pn, rbase = u.pm * 256 + wr * 64 + fr, cw = wc * 32 + 8 * fq;
        const float* ropeC = (const float*)(ws + WS_ROPEC);
        LAS float* rt = (LAS float*)(lds + pg8::STAGE_BYTES + 8192);
        { const int t = (wr * 4 + wc) * 64 + fq * 16 + fr;
          if (t < 256) { const float* sp = (const float*)(ws + WS_SSQCQ) + (size_t)(u.pm * 256 + t) * 12;
              const f32x4 s0 = *(const f32x4*)sp, s1 = *(const f32x4*)(sp + 4), s2 = *(const f32x4*)(sp + 8);
              const float ss = (((s0[0] + s0[1]) + (s0[2] + s0[3])) + ((s1[0] + s1[1]) + (s1[2] + s1[3]))) + ((s2[0] + s2[1]) + (s2[2] + s2[3]));
              rt[t] = rsqrtf(ss * (1.f / 768.f) + EPS) * (0.10206207261596575f * LOG2E); }
          asm volatile("s_waitcnt lgkmcnt(0)" ::: "memory"); __builtin_amdgcn_s_barrier(); asm volatile("" ::: "memory"); }
#pragma unroll
        for (int ai = 0; ai < 2; ++ai)
#pragma unroll
            for (int m = 0; m < 4; ++m) {
                asm volatile("" ::: "memory"); const int R = rbase + ai * 128 + m * 16, pos = R & 2047;
                const float sc = rt[wr * 64 + fr + ai * 128 + m * 16];
#pragma unroll
                for (int bj = 0; bj < 2; ++bj) {
                    const int c = pn * 256 + bj * 128 + cw, head = c / 96, dd = c - head * 96;
                    f32x4 a = acc[ai][bj][m][0], b = acc[ai][bj][m][1];
                    if (dd >= 64) { const int i0 = (dd - 64) >> 1; rope8(a, b, ropeC + pos * 32 + i0, ropeC + pos * 32 + 16 + i0); }
                    st8((bf16_t*)(ws + WS_QO) + (size_t)R * 768 + c, a * sc, b * sc);
                }
            }
    }
};

#define RLX_AGENT __ATOMIC_RELAXED, __HIP_MEMORY_SCOPE_AGENT
#define XB_TMO      128
#define XB_XCNT(j)  (256  + 64 * (j))
#define XB_XSUB(j)  (1280 + 64 * (j))
#define XB_XGEN(j)  (2304 + 64 * (j))
#define XB_TOP      3328
#define XB_TOPGEN   3392
#define XCD_BAR_WORDS 3456
#define XB_SPIN_CAP (1u << 18)

__device__ __forceinline__ unsigned xb_ld(unsigned* p)              { return __hip_atomic_load(p, __ATOMIC_RELAXED, __HIP_MEMORY_SCOPE_AGENT); }
__device__ __forceinline__ unsigned xb_add(unsigned* p, unsigned v) { return __hip_atomic_fetch_add(p, v, __ATOMIC_RELAXED, __HIP_MEMORY_SCOPE_AGENT); }
__device__ __forceinline__ unsigned xb_xcc_id() { return (unsigned)__builtin_amdgcn_s_getreg((3 << 11) | 20) & 0xFu; }
#define XB_SPIN(cond, bar) do { unsigned _sp = 0; while (cond) { __builtin_amdgcn_s_sleep(1); \
    if ((++_sp & 255u) == 0u) { if (xb_ld(&(bar)[XB_TMO])) break; if (_sp > XB_SPIN_CAP) { atomicAdd(&(bar)[XB_TMO], 1u); break; } } } } while (0)

struct XcdBarrier {
    unsigned* bar; unsigned x;
    volatile LAS unsigned* st;
};

__device__ __forceinline__ XcdBarrier xcd_barrier_post(unsigned* bar, volatile LAS unsigned* st) {
    XcdBarrier b; b.bar = bar; b.x = xb_xcc_id(); b.st = st;
    if (threadIdx.x == 0) (void)xb_add(&bar[XB_XCNT(b.x)], 1u);
    return b;
}
__device__ __forceinline__ void xcd_barrier_complete(unsigned* bar, unsigned x, unsigned& nloc, unsigned& nx) {
    const unsigned G = gridDim.x * gridDim.y * gridDim.z;
    unsigned sum, cnt, mine, sp = 0u;
    for (;;) {
        sum = 0u; cnt = 0u; mine = 0u;
#pragma unroll
        for (unsigned j = 0; j < 16; ++j) { const unsigned c = xb_ld(&bar[XB_XCNT(j)]); sum += c; cnt += (c > 0u) ? 1u : 0u; mine = (j == x) ? c : mine; }
        if (sum == G) break;
        __builtin_amdgcn_s_sleep(1);
        if ((++sp & 255u) == 0u) { if (xb_ld(&bar[XB_TMO])) break; if (sp > XB_SPIN_CAP) { atomicAdd(&bar[XB_TMO], 1u); break; } }
    }
    nloc = mine > 0u ? mine : 1u; nx = cnt > 0u ? cnt : 1u;
}

__device__ __forceinline__ void xcd_barrier(const XcdBarrier& b) {
    asm volatile("s_waitcnt vmcnt(0)" ::: "memory");
    __syncthreads();
    if (threadIdx.x == 0) {
        unsigned* bar = b.bar;
        __builtin_amdgcn_s_waitcnt(0);
        unsigned nloc = b.st[0], nx = b.st[1];
        if (nloc == 0u) { xcd_barrier_complete(bar, b.x, nloc, nx); b.st[0] = nloc; b.st[1] = nx; }
        const unsigned old = xb_add(&bar[XB_XSUB(b.x)], 1u);
        asm volatile("buffer_inv sc1" ::: "memory");
        const unsigned gen = old / nloc;
        if (old + 1u == (gen + 1u) * nloc) {
            __builtin_amdgcn_fence(__ATOMIC_RELEASE, "agent");
            asm volatile("s_waitcnt vmcnt(0)" ::: "memory");
            (void)xb_add(&bar[XB_TOP], 1u);
        }
        const unsigned target = (gen + 1u) * nx;
        XB_SPIN((int)(xb_ld(&bar[XB_TOP]) - target) < 0, bar);
        asm volatile("s_waitcnt vmcnt(0)" ::: "memory");
    }
    __syncthreads();
}

__device__ __forceinline__ int crow(int r, int hi) { return (r & 3) + 8 * (r >> 2) + 4 * hi; }
typedef short v4i16_t __attribute__((ext_vector_type(4)));
__device__ __forceinline__ s16x4 vtr(const LAS unsigned char* p) { return __builtin_bit_cast(s16x4, __builtin_amdgcn_ds_read_tr16_b64_v4i16((LAS v4i16_t*)p)); }

template <int MODE>
__device__ __forceinline__ void attn_unit(LAS unsigned char* lds, unsigned char* ws, unsigned char* aux, const float* sink, int unit) {
    constexpr int DQK = (MODE == 2) ? 96 : 64, KST = DQK / 16, KS = DQK * 2 + 16, VS = 192, KBUF = 64 * KS, VBUF = 64 * VS;
    const int tid = my_tid(), lane = tid & 63, wid = __builtin_amdgcn_readfirstlane(tid >> 6), r32 = lane & 31, hi = lane >> 5;
    int b, head, hkv = 0, n = 0, Rq0, qpos0 = 0, nt, jlo = 0;
    const bf16_t* Qp; int qstride;
    if (MODE == 0) {
        const int hp = unit & 1; n = (unit >> 1) & 15; hkv = (unit >> 5) & 1; b = unit >> 6;
        head = hkv * 4 + hp * 2 + (wid >> 2); qpos0 = 128 * n + 32 * (wid & 3); Rq0 = b * 2048 + qpos0;
        Qp = (const bf16_t*)(ws + WS_QE) + (size_t)Rq0 * 512 + head * 64; qstride = 512;
        jlo = (n == 0) ? 2 : 0; const int jhi = (n == 15) ? 4 : 6; nt = 4 + (jhi - jlo);
    } else if (MODE == 1) {
        const int qh = unit & 1, hp = (unit >> 1) & 1; hkv = (unit >> 2) & 1; b = unit >> 3;
        head = hkv * 4 + hp * 2 + (wid >> 2); Rq0 = ML + b * 256 + 128 * qh + 32 * (wid & 3);
        Qp = (const bf16_t*)(ws + WS_QE) + (size_t)Rq0 * 512 + head * 64; qstride = 512; nt = 4;
    } else {
        const int qb = unit & 7; head = (unit >> 3) & 7; b = unit >> 6; Rq0 = b * 2048 + 256 * qb + 32 * wid;
        Qp = (const bf16_t*)(ws + WS_QO) + (size_t)Rq0 * 768 + head * 96; qstride = 768; nt = 36;
    }
    bf16x8 qf[KST];
#pragma unroll
    for (int s = 0; s < KST; ++s) qf[s] = *(const bf16x8*)(Qp + (size_t)r32 * qstride + 16 * s + 8 * hi);
    constexpr float THR = 6.0f;
    float mref, l_run;
    if (MODE == 2) { mref = 0.f; l_run = 0.f; } else { mref = sink[head] * LOG2E; l_run = (hi == 0) ? 1.f : 0.f; }
    f32x16 negm;
#pragma unroll
    for (int r = 0; r < 16; ++r) negm[r] = -mref;
    f32x16 o0, o1;
#pragma unroll
    for (int r = 0; r < 16; ++r) { o0[r] = 0.f; o1[r] = 0.f; }

    const int srow = tid >> 3, sch = tid & 7;
    const int voff = (4 * hi + ((lane & 15) >> 2)) * VS + (((lane >> 4) & 1) * 16 + 4 * (lane & 3)) * 2;
    u32x4 kregA, vregA, kreg2A, kregB, vregB, kreg2B;
    kreg2A = (u32x4){0u, 0u, 0u, 0u}; kreg2B = kreg2A;
#define ATT_SRC(t, kp, vp, k2p, kpos0v) do { \
        if (MODE == 0 || MODE == 1) { \
            if ((t) < 4) { kp = (const bf16_t*)(ws + WS_KVE) + (size_t)(ML + b * 256 + 64 * (t) + srow) * 256 + hkv * 64 + sch * 8; kpos0v = -100000; } \
            else { const int kp0_ = 128 * n - 128 + 64 * (jlo + (t) - 4); kpos0v = kp0_; \
                   kp = (const bf16_t*)(ws + WS_KVE) + (size_t)(b * 2048 + kp0_ + srow) * 256 + hkv * 64 + sch * 8; } \
            vp = kp + 128; k2p = kp; \
        } else { \
            const int pos0_ = 64 * (t); kpos0v = -100000; \
            kp = (const bf16_t*)(ws + WS_KNV) + ((size_t)(b * 8 + head) * 2304 + pos0_ + srow) * 128 + sch * 8; \
            vp = kp + 64; \
            const int krow_ = ((t) < 4) ? (ML + b * 256 + pos0_) : (b * 2048 + pos0_ - 256); \
            k2p = (const bf16_t*)(ws + WS_KR) + (size_t)(krow_ + (tid >> 2)) * 32 + (tid & 3) * 8; \
        } } while (0)
#define ATT_LOAD(t, KR_, VR_, K2_) do { const bf16_t *kp_, *vp_, *k2p_; int kq_; ATT_SRC(t, kp_, vp_, k2p_, kq_); (void)kq_; \
        KR_ = *(const u32x4*)kp_; VR_ = *(const u32x4*)vp_; if (MODE == 2 && tid < 256) K2_ = *(const u32x4*)k2p_; } while (0)
#define ATT_STORE(buf, KR_, VR_, K2_) do { LAS unsigned char* kb_ = lds + (buf) * KBUF; LAS unsigned char* vb_ = lds + 4 * KBUF + (buf) * VBUF; \
        *(LAS u32x4*)(kb_ + srow * KS + sch * 16) = KR_; \
        if (MODE == 2 && tid < 256) *(LAS u32x4*)(kb_ + (tid >> 2) * KS + 128 + (tid & 3) * 16) = K2_; \
        *(LAS u32x4*)(vb_ + srow * VS + sch * 16) = VR_; } while (0)
#define ATT_BARRIER() do { asm volatile("s_waitcnt lgkmcnt(0)" ::: "memory"); __builtin_amdgcn_s_barrier(); asm volatile("" ::: "memory"); } while (0)

#define ATT_COMPUTE(TT) do { const int buf = (TT) & 3; \
        int kpos0 = -100000; \
        if (MODE == 0 && (TT) >= 4) kpos0 = 128 * n - 128 + 64 * (jlo + (TT) - 4); \
        bool active = true; \
        if (MODE == 0 && (TT) >= 4) active = (kpos0 + 63 >= qpos0 - 128) && (kpos0 <= qpos0 + 31 + 128); \
        if (active) { \
            const LAS unsigned char* kb = lds + buf * KBUF; const LAS unsigned char* vb = lds + 4 * KBUF + buf * VBUF; \
            f32x16 p0 = negm, p1 = negm; \
_Pragma("unroll") \
            for (int s = 0; s < KST; ++s) { \
                const bf16x8 a0 = *(const LAS bf16x8*)(kb + r32 * KS + (16 * s + 8 * hi) * 2); \
                const bf16x8 a1 = *(const LAS bf16x8*)(kb + (32 + r32) * KS + (16 * s + 8 * hi) * 2); \
                p0 = __builtin_amdgcn_mfma_f32_32x32x16_bf16(a0, qf[s], p0, 0, 0, 0); \
                p1 = __builtin_amdgcn_mfma_f32_32x32x16_bf16(a1, qf[s], p1, 0, 0, 0); \
            } \
            if (MODE == 0 && (TT) >= 4 && !((kpos0 >= qpos0 - 97) && (kpos0 <= qpos0 + 65))) {     \
                const int qpos = qpos0 + r32; \
_Pragma("unroll") \
                for (int r = 0; r < 16; ++r) { const int d0 = kpos0 + crow(r, hi) - qpos, d1 = d0 + 32; \
                    if (d0 > 128 || d0 < -128) p0[r] = -INFINITY; if (d1 > 128 || d1 < -128) p1[r] = -INFINITY; } \
            } \
            float mxa = __builtin_fmaxf(__builtin_fmaxf(p0[0], p0[1]), p1[0]), mxb = __builtin_fmaxf(__builtin_fmaxf(p0[2], p0[3]), p1[1]); \
            mxa = __builtin_fmaxf(__builtin_fmaxf(mxa, p1[2]), p1[3]); \
_Pragma("unroll") \
            for (int r = 4; r < 16; r += 4) { mxa = __builtin_fmaxf(__builtin_fmaxf(mxa, p0[r]), p0[r + 1]); mxb = __builtin_fmaxf(__builtin_fmaxf(mxb, p0[r + 2]), p0[r + 3]); \
                mxa = __builtin_fmaxf(__builtin_fmaxf(mxa, p1[r]), p1[r + 1]); mxb = __builtin_fmaxf(__builtin_fmaxf(mxb, p1[r + 2]), p1[r + 3]); } \
            float mx = __builtin_fmaxf(mxa, mxb); \
            mx = __builtin_fmaxf(mx, __shfl_xor(mx, 32)); \
            const bool first = (MODE == 2) && ((TT) == 0); \
            if (first || __any(mx > THR)) { \
                const float delta = first ? mx : __builtin_fmaxf(mx, 0.f), alpha = first ? 1.f : __builtin_amdgcn_exp2f(-delta); \
                mref += delta; l_run *= alpha; \
_Pragma("unroll") \
                for (int r = 0; r < 16; ++r) { o0[r] *= alpha; o1[r] *= alpha; p0[r] -= delta; p1[r] -= delta; negm[r] = -mref; } \
            } \
            float rs0 = 0.f, rs1 = 0.f; \
_Pragma("unroll") \
            for (int r = 0; r < 16; ++r) { p0[r] = __builtin_amdgcn_exp2f(p0[r]); p1[r] = __builtin_amdgcn_exp2f(p1[r]); rs0 += p0[r]; rs1 += p1[r]; } \
            l_run += rs0 + rs1; \
            u32x4 pw[4]; \
            pw[0] = (u32x4){pk2(p0[0], p0[1]), pk2(p0[2], p0[3]), pk2(p0[4], p0[5]), pk2(p0[6], p0[7])}; \
            pw[1] = (u32x4){pk2(p0[8], p0[9]), pk2(p0[10], p0[11]), pk2(p0[12], p0[13]), pk2(p0[14], p0[15])}; \
            pw[2] = (u32x4){pk2(p1[0], p1[1]), pk2(p1[2], p1[3]), pk2(p1[4], p1[5]), pk2(p1[6], p1[7])}; \
            pw[3] = (u32x4){pk2(p1[8], p1[9]), pk2(p1[10], p1[11]), pk2(p1[12], p1[13]), pk2(p1[14], p1[15])}; \
_Pragma("unroll") \
            for (int s2 = 0; s2 < 4; ++s2) { \
                const bf16x8 pb = __builtin_bit_cast(bf16x8, pw[s2]); \
                const LAS unsigned char* va0 = vb + (16 * s2) * VS + voff; \
                const s16x4 l0 = vtr(va0), h0 = vtr(va0 + 8 * VS), l1 = vtr(va0 + 64), h1 = vtr(va0 + 8 * VS + 64); \
                const bf16x8 v0 = (bf16x8){l0[0], l0[1], l0[2], l0[3], h0[0], h0[1], h0[2], h0[3]}; \
                const bf16x8 v1 = (bf16x8){l1[0], l1[1], l1[2], l1[3], h1[0], h1[1], h1[2], h1[3]}; \
                o0 = __builtin_amdgcn_mfma_f32_32x32x16_bf16(v0, pb, o0, 0, 0, 0); \
                o1 = __builtin_amdgcn_mfma_f32_32x32x16_bf16(v1, pb, o1, 0, 0, 0); \
            } \
        } \
        } while (0)

    ATT_LOAD(0, kregA, vregA, kreg2A); ATT_LOAD(1, kregB, vregB, kreg2B);
    ATT_STORE(0, kregA, vregA, kreg2A); ATT_STORE(1, kregB, vregB, kreg2B);
    if (2 < nt) { ATT_LOAD(2, kregA, vregA, kreg2A); ATT_LOAD(3, kregB, vregB, kreg2B); }
    ATT_BARRIER();
    const int Rq = Rq0 + r32;
    const bf16_t* zrow = (MODE == 2) ? (const bf16_t*)(aux + AUX_ZO) + (size_t)Rq * 512 + head * 64 : (const bf16_t*)(ws + WS_ZA) + (size_t)Rq * 512 + head * 64;
    u32x2 zz[8];
#pragma unroll
    for (int g = 0; g < 8; ++g) zz[g] = (u32x2){0u, 0u};
    for (int t = 0; t < nt; t += 2) {
        if (t + 2 >= nt) {
#pragma unroll
            for (int g = 0; g < 4; ++g) { zz[2 * g] = *(const u32x2*)(zrow + 8 * g + 4 * hi); zz[2 * g + 1] = *(const u32x2*)(zrow + 32 + 8 * g + 4 * hi); } }
        ATT_COMPUTE(t);
        ATT_COMPUTE(t + 1);
        if (t + 2 < nt) { ATT_STORE((t + 2) & 3, kregA, vregA, kreg2A); ATT_STORE((t + 3) & 3, kregB, vregB, kreg2B); }
        if (t + 4 < nt) { ATT_LOAD(t + 4, kregA, vregA, kreg2A); ATT_LOAD(t + 5, kregB, vregB, kreg2B); }
        ATT_BARRIER();
    }
#undef ATT_COMPUTE
#undef ATT_BARRIER
#undef ATT_SRC
#undef ATT_LOAD
#undef ATT_STORE
    const float l_tot = l_run + __shfl_xor(l_run, 32), inv = __builtin_amdgcn_rcpf(l_tot);
    bf16_t* urow = (bf16_t*)(ws + WS_U) + (size_t)Rq * 1024 + head * 64;
#pragma unroll
    for (int g = 0; g < 4; ++g) {
        const int dv = 8 * g + 4 * hi;
        { const u32x2 z = zz[2 * g];
          u32x2 w; w.x = pk2(o0[4 * g] * inv * bf_lo(z.x), o0[4 * g + 1] * inv * bf_hi(z.x)); w.y = pk2(o0[4 * g + 2] * inv * bf_lo(z.y), o0[4 * g + 3] * inv * bf_hi(z.y));
          *(u32x2*)(urow + dv) = w; }
        { const u32x2 z = zz[2 * g + 1];
          u32x2 w; w.x = pk2(o1[4 * g] * inv * bf_lo(z.x), o1[4 * g + 1] * inv * bf_hi(z.x)); w.y = pk2(o1[4 * g + 2] * inv * bf_lo(z.y), o1[4 * g + 3] * inv * bf_hi(z.y));
          *(u32x2*)(urow + 32 + dv) = w; }
    }
}


__device__ __forceinline__ int srcmap(int mat, int dn) {
    if (mat == 0) {
        if (dn < 128) { const int d = dn & 63; return (dn & 64) + (d >> 1) + 32 * (d & 1); }
        if (dn < 256) return dn;
        if (dn < 768) { const int j = dn - 256, d = j & 63; return 256 + (j & ~63) + (d >> 1) + 32 * (d & 1); }
        if (dn < 1792) { const int j = dn - 768, blk = j >> 8, w = j & 255; return (w < 128) ? 1280 + blk * 128 + w : 1792 + blk * 128 + (w - 128); }
        if (dn < 2816) { const int j = dn - 1792, blk = j >> 8, w = j & 255; return (w < 128) ? 768 + blk * 128 + w : 2816 + blk * 128 + (w - 128); }
        return 2304 + (dn - 2816);
    }
    if (mat == 2) {
        if (dn < 256) return dn;
        if (dn < 512) return 288 + (dn - 256);
        if (dn < 1024) return 544 + (dn - 512);
        if (dn < 1280) { const int w = dn - 1024; if (w < 32) return 256 + (w >> 1) + 16 * (w & 1); if (w < 48) return 1056 + (w - 32); return -1; }
        if (dn < 2048) return 1072 + (dn - 1280);
        if (dn < 2304) return 1840 + (dn - 2048);
        if (dn < 3328) { const int j = dn - 2304, blk = j >> 8, w = j & 255; return (w < 128) ? 2096 + blk * 128 + w : 2608 + 512 + blk * 128 + (w - 128); }
        return 2608 + (dn - 3328);
    }
    if (mat == 3) {
        const int head = dn / 96, d = dn - head * 96; if (d < 64) return dn; const int w = d - 64; return head * 96 + 64 + (w >> 1) + 16 * (w & 1);
    }
    return dn;
}
__device__ __forceinline__ void p0_transpose_item(const float* W, int K, int Nsrc, bf16_t* WT, int mat, const float* kscale, LAS float* scr, int item, int nblk, int lane) {
    const int kb = item / nblk, nb = item % nblk, k0 = 64 * kb, n0 = 32 * nb;
    const int sc = srcmap(mat, n0 + (lane & 31));
    float v[32];
    const float* wp = W + (size_t)(k0 + (lane >> 5)) * Nsrc + (sc >= 0 ? sc : 0);
#pragma unroll
    for (int i = 0; i < 32; ++i) v[i] = wp[(size_t)(2 * i) * Nsrc];
#pragma unroll
    for (int i = 0; i < 32; ++i) { const int kk = 2 * i + (lane >> 5); float x = (sc >= 0) ? v[i] : 0.f; if (kscale) x *= kscale[k0 + kk]; scr[kk * 33 + (lane & 31)] = x; }
    LDS_WAIT(); asm volatile("" ::: "memory");
    const int c = lane & 7;
#pragma unroll
    for (int j = 0; j < 4; ++j) { const int n = (lane >> 3) + 8 * j; const LAS float* s = scr + (8 * c) * 33 + n;
        u32x4 o; o.x = pk2(s[0 * 33], s[1 * 33]); o.y = pk2(s[2 * 33], s[3 * 33]); o.z = pk2(s[4 * 33], s[5 * 33]); o.w = pk2(s[6 * 33], s[7 * 33]);
        *(u32x4*)(WT + (size_t)(n0 + n) * K + k0 + 8 * c) = o; }
    LDS_WAIT(); asm volatile("" ::: "memory");
}

__device__ __forceinline__ void p0_mod(LAS unsigned char* lds, const float* c, const float* c_ctx, const float* mod_w, const float* mod_b, float* MOD, int G) {
    const int tid = my_tid();
    if ((int)blockIdx.x >= 192) return;
    LAS float* scs = (LAS float*)lds;
    LAS float* red = (LAS float*)(lds + 1024 * 20 * 4);
    { float cv[34];
#pragma unroll
      for (int u = 0; u < 34; ++u) { const int idx = tid + u * NTHREADS, r = idx >> 10, k = idx & 1023; cv[u] = (r < 16) ? c[r * 1024 + k] : c_ctx[k]; }
#pragma unroll
      for (int u = 0; u < 34; ++u) { const int idx = tid + u * NTHREADS, r = idx >> 10, k = idx & 1023; scs[k * 20 + r] = silu_f(cv[u]); } }
    __syncthreads();
    for (int item = blockIdx.x; item < 192; item += G) {
        const int l = item / 96, n0 = (item % 96) * 32, col = tid & 31, kg = tid >> 5;
        float acc[20];
#pragma unroll
        for (int r = 0; r < 20; ++r) acc[r] = 0.f;
        const float* wp = mod_w + ((size_t)l * 1024 + kg * 64) * 3072 + n0 + col;
#pragma unroll
        for (int kb = 0; kb < 4; ++kb) {
            float w[16];
#pragma unroll
            for (int u = 0; u < 16; ++u) w[u] = wp[(size_t)(kb * 16 + u) * 3072];
#pragma unroll
            for (int u = 0; u < 16; ++u) { const LAS f32x4* sp = (const LAS f32x4*)(scs + (kg * 64 + kb * 16 + u) * 20);
#pragma unroll
                for (int q = 0; q < 5; ++q) { const f32x4 s = sp[q]; acc[4 * q] += s[0] * w[u]; acc[4 * q + 1] += s[1] * w[u]; acc[4 * q + 2] += s[2] * w[u]; acc[4 * q + 3] += s[3] * w[u]; } }
        }
#pragma unroll
        for (int r = 0; r < 17; ++r) red[(kg * 17 + r) * 32 + col] = acc[r];
        __syncthreads();
        for (int o = tid; o < 17 * 32; o += NTHREADS) { const int r = o >> 5, cc = o & 31; float s = mod_b[l * 3072 + n0 + cc];
#pragma unroll
            for (int g = 0; g < 16; ++g) s += red[(g * 17 + r) * 32 + cc];
            MOD[((size_t)l * 17 + r) * 3072 + n0 + cc] = s; }
        __syncthreads();
    }
}

__device__ __forceinline__ void norm_mod_store(const f32x4 (&v)[4], const float* pre_w, const float* modrow, bf16_t* hrow, int lane) {
    float ss = 0.f;
#pragma unroll
    for (int j = 0; j < 4; ++j) ss += sq4(v[j]);
    const float rstd = rsqrtf(wave_sum(ss) * (1.f / 1024.f) + EPS);
#pragma unroll
    for (int j = 0; j < 4; ++j) { const int k = 4 * (lane + 64 * j);
        const f32x4 w = *(const f32x4*)(pre_w + k), sh = *(const f32x4*)(modrow + k), sc = *(const f32x4*)(modrow + 1024 + k);
        const f32x4 h = v[j] * rstd * w * (sc + 1.0f) + sh;
        u32x2 o; o.x = pk2(h[0], h[1]); o.y = pk2(h[2], h[3]); *(u32x2*)(hrow + k) = o; }
}
__device__ __forceinline__ void norm_mod_store_wt(const f32x4 (&v)[4], const float* pre_w, const float* modrow, bf16_t* hrow, int lane) {
    float ss = 0.f;
#pragma unroll
    for (int j = 0; j < 4; ++j) ss += sq4(v[j]);
    const float rstd = rsqrtf(wave_sum(ss) * (1.f / 1024.f) + EPS);
#pragma unroll
    for (int j = 0; j < 4; ++j) { const int k = 4 * (lane + 64 * j);
        const f32x4 w = *(const f32x4*)(pre_w + k), sh = *(const f32x4*)(modrow + k), sc = *(const f32x4*)(modrow + 1024 + k);
        const f32x4 h = v[j] * rstd * w * (sc + 1.0f) + sh;
        __hip_atomic_store((unsigned long long*)(hrow + k), (unsigned long long)pk2(h[0], h[1]) | ((unsigned long long)pk2(h[2], h[3]) << 32), __ATOMIC_RELAXED, __HIP_MEMORY_SCOPE_AGENT); }
}
__device__ __forceinline__ void p1_stream(const float* x, const float* ctx, const float* pre_w, const float* MOD, bf16_t* H, unsigned* ready, int sw, int nsw, int lane) {
    f32x4 cur[4][4], nxt[4][4];
#define P1_LOAD(dst, R_) do { if ((R_) < MT) { const float* src_ = ((R_) < ML) ? x + (size_t)(R_) * 1024 : ctx + (size_t)((R_) - ML) * 1024; \
        _Pragma("unroll") for (int j = 0; j < 4; ++j) dst[j] = *(const f32x4*)(src_ + 4 * (lane + 64 * j)); } } while (0)
#pragma unroll
    for (int q = 0; q < 4; ++q) P1_LOAD(cur[q], sw + nsw * q);
    for (int R0 = sw; R0 < MT; R0 += 4 * nsw) {
#pragma unroll
        for (int q = 0; q < 4; ++q) P1_LOAD(nxt[q], R0 + nsw * (4 + q));
#pragma unroll
        for (int q = 0; q < 4; ++q) { const int R = R0 + nsw * q; if (R < MT) { const int bi = (R < ML) ? (R >> 11) : 16;
            norm_mod_store_wt(cur[q], pre_w, MOD + (size_t)bi * 3072, H + (size_t)R * 1024, lane); } }
        asm volatile("s_waitcnt vmcnt(0)" ::: "memory");
        if (lane < 4) { const int R = R0 + nsw * lane; if (R < MT) __hip_atomic_fetch_add(ready + 64 * (R >> 8), 1u, __ATOMIC_RELAXED, __HIP_MEMORY_SCOPE_AGENT); }
#pragma unroll
        for (int q = 0; q < 4; ++q)
#pragma unroll
            for (int j = 0; j < 4; ++j) cur[q][j] = nxt[q][j];
    }
#undef P1_LOAD
}
__device__ __forceinline__ void p1_prenorm(const float* x, const float* ctx, const float* pre_w, const float* MOD, bf16_t* H, int gw, int ngw, int lane) {
    const int per = (MT + ngw - 1) / ngw, r0 = gw * per, r1 = (r0 + per < MT) ? r0 + per : MT;
    f32x4 cur[4], nxt[4], w[4], sc1[4], sh[4];
#pragma unroll
    for (int j = 0; j < 4; ++j) { w[j] = *(const f32x4*)(pre_w + 4 * (lane + 64 * j)); sc1[j] = w[j]; sh[j] = w[j]; }
#define P1_LOAD(dst, R_) do { const float* src_ = ((R_) < ML) ? x + (size_t)(R_) * 1024 : ctx + (size_t)((R_) - ML) * 1024; \
        _Pragma("unroll") for (int j = 0; j < 4; ++j) dst[j] = *(const f32x4*)(src_ + 4 * (lane + 64 * j)); } while (0)
    if (r0 < r1) P1_LOAD(cur, r0);
    int cur_bi = -1;
    for (int R = r0; R < r1; ++R) {
        if (R + 1 < r1) P1_LOAD(nxt, R + 1);
        const int bi = (R < ML) ? (R >> 11) : 16;
        if (bi != cur_bi) { cur_bi = bi; const float* m0 = MOD + (size_t)bi * 3072;
#pragma unroll
            for (int j = 0; j < 4; ++j) { const int k = 4 * (lane + 64 * j); sh[j] = *(const f32x4*)(m0 + k); sc1[j] = *(const f32x4*)(m0 + 1024 + k) + 1.0f; } }
        float ss = 0.f;
#pragma unroll
        for (int j = 0; j < 4; ++j) ss += sq4(cur[j]);
        const float rstd = rsqrtf(wave_sum(ss) * (1.f / 1024.f) + EPS);
#pragma unroll
        for (int j = 0; j < 4; ++j) { const int k = 4 * (lane + 64 * j);
            const f32x4 h = cur[j] * rstd * w[j] * sc1[j] + sh[j];
            u32x2 o; o.x = pk2(h[0], h[1]); o.y = pk2(h[2], h[3]); *(u32x2*)(H + (size_t)R * 1024 + k) = o; }
#pragma unroll
        for (int j = 0; j < 4; ++j) cur[j] = nxt[j];
    }
#undef P1_LOAD
}
__device__ __forceinline__ float ssq16(const float* p) {
    const f32x4 a = *(const f32x4*)p, b = *(const f32x4*)(p + 4), c = *(const f32x4*)(p + 8), d = *(const f32x4*)(p + 12);
    return (((a[0] + a[1]) + (a[2] + a[3])) + ((b[0] + b[1]) + (b[2] + b[3]))) + (((c[0] + c[1]) + (c[2] + c[3])) + ((d[0] + d[1]) + (d[2] + d[3])));
}
__device__ __forceinline__ void p5_post_pre(const float* x, const float* ctx, const float* post_w0, const float* pre_w1, const float* MOD, const bf16_t* Y, const float* SSQ, bf16_t* X1, bf16_t* H, int gw, int ngw, int lane) {
    const int per = (MT + ngw - 1) / ngw, r0 = gw * per, r1 = (r0 + per < MT) ? r0 + per : MT;
    f32x4 xc[4], xn[4], sqc[4], sqn[4]; u32x2 yc[4], yn[4];
    f32x4 pg[4], pw[4], w1[4], sc1[4], sh1[4];
#pragma unroll
    for (int j = 0; j < 4; ++j) { const int k = 4 * (lane + 64 * j); pw[j] = *(const f32x4*)(post_w0 + k); w1[j] = *(const f32x4*)(pre_w1 + k); pg[j] = pw[j]; sc1[j] = pw[j]; sh1[j] = pw[j]; }
#define P5_LOAD(xd, yd, sd, R_) do { const float* src_ = ((R_) < ML) ? x + (size_t)(R_) * 1024 : ctx + (size_t)((R_) - ML) * 1024; \
        _Pragma("unroll") for (int j = 0; j < 4; ++j) { xd[j] = *(const f32x4*)(src_ + 4 * (lane + 64 * j)); yd[j] = *(const u32x2*)(Y + (size_t)(R_) * 1024 + 4 * (lane + 64 * j)); \
            sd[j] = *(const f32x4*)(SSQ + (size_t)(R_) * 16 + 4 * j); } } while (0)
    if (r0 < r1) P5_LOAD(xc, yc, sqc, r0);
    int cur_bi = -1;
    for (int R = r0; R < r1; ++R) {
        if (R + 1 < r1) P5_LOAD(xn, yn, sqn, R + 1);
        const int bi = (R < ML) ? (R >> 11) : 16;
        if (bi != cur_bi) { cur_bi = bi; const float* m0 = MOD + (size_t)bi * 3072; const float* m1 = MOD + (size_t)(17 + bi) * 3072;
#pragma unroll
            for (int j = 0; j < 4; ++j) { const int k = 4 * (lane + 64 * j); pg[j] = *(const f32x4*)(m0 + 2048 + k); sh1[j] = *(const f32x4*)(m1 + k); sc1[j] = *(const f32x4*)(m1 + 1024 + k) + 1.0f; } }
        const float ssy = (((sqc[0][0] + sqc[0][1]) + (sqc[0][2] + sqc[0][3])) + ((sqc[1][0] + sqc[1][1]) + (sqc[1][2] + sqc[1][3]))) + (((sqc[2][0] + sqc[2][1]) + (sqc[2][2] + sqc[2][3])) + ((sqc[3][0] + sqc[3][1]) + (sqc[3][2] + sqc[3][3])));
        const float rstd_y = rsqrtf(ssy * (1.f / 1024.f) + EPS);
        f32x4 v[4]; float ss = 0.f;
#pragma unroll
        for (int j = 0; j < 4; ++j) { const int k = 4 * (lane + 64 * j);
            const f32x4 y = (f32x4){bf_lo(yc[j].x), bf_hi(yc[j].x), bf_lo(yc[j].y), bf_hi(yc[j].y)};
            v[j] = xc[j] + pg[j] * (y * rstd_y * pw[j]);
            ss += sq4(v[j]);
            if (R < ML) { u32x2 o; o.x = pk2(v[j][0], v[j][1]); o.y = pk2(v[j][2], v[j][3]); *(u32x2*)(X1 + (size_t)R * 1024 + k) = o; } }
        const float rstd = rsqrtf(wave_sum(ss) * (1.f / 1024.f) + EPS);
#pragma unroll
        for (int j = 0; j < 4; ++j) { const int k = 4 * (lane + 64 * j);
            const f32x4 h = v[j] * rstd * w1[j] * sc1[j] + sh1[j];
            u32x2 o; o.x = pk2(h[0], h[1]); o.y = pk2(h[2], h[3]); *(u32x2*)(H + (size_t)R * 1024 + k) = o; }
#pragma unroll
        for (int j = 0; j < 4; ++j) { xc[j] = xn[j]; yc[j] = yn[j]; sqc[j] = sqn[j]; }
    }
#undef P5_LOAD
}
__device__ __forceinline__ void p11_final(const float* post_w1, const float* MOD, const bf16_t* Y, const float* SSQ, const bf16_t* X1, float* out, int gw, int ngw, int lane) {
    const int per = (ML + ngw - 1) / ngw, r0 = gw * per, r1 = (r0 + per < ML) ? r0 + per : ML;
    u32x2 xc[4], xn[4], yc[4], yn[4]; f32x4 sqc[4], sqn[4], pg[4], pw[4];
#pragma unroll
    for (int j = 0; j < 4; ++j) { pw[j] = *(const f32x4*)(post_w1 + 4 * (lane + 64 * j)); pg[j] = pw[j]; }
#define P11_LOAD(xd, yd, sd, R_) do { _Pragma("unroll") for (int j = 0; j < 4; ++j) { xd[j] = *(const u32x2*)(X1 + (size_t)(R_) * 1024 + 4 * (lane + 64 * j)); yd[j] = *(const u32x2*)(Y + (size_t)(R_) * 1024 + 4 * (lane + 64 * j)); \
        sd[j] = *(const f32x4*)(SSQ + (size_t)(R_) * 16 + 4 * j); } } while (0)
    if (r0 < r1) P11_LOAD(xc, yc, sqc, r0);
    int cur_b = -1;
    for (int R = r0; R < r1; ++R) {
        if (R + 1 < r1) P11_LOAD(xn, yn, sqn, R + 1);
        const int bb = R >> 11;
        if (bb != cur_b) { cur_b = bb; const float* m1 = MOD + (size_t)(17 + bb) * 3072;
#pragma unroll
            for (int j = 0; j < 4; ++j) pg[j] = *(const f32x4*)(m1 + 2048 + 4 * (lane + 64 * j)); }
        const float ssy = (((sqc[0][0] + sqc[0][1]) + (sqc[0][2] + sqc[0][3])) + ((sqc[1][0] + sqc[1][1]) + (sqc[1][2] + sqc[1][3]))) + (((sqc[2][0] + sqc[2][1]) + (sqc[2][2] + sqc[2][3])) + ((sqc[3][0] + sqc[3][1]) + (sqc[3][2] + sqc[3][3])));
        const float rstd_y = rsqrtf(ssy * (1.f / 1024.f) + EPS);
#pragma unroll
        for (int j = 0; j < 4; ++j) { const int k = 4 * (lane + 64 * j);
            const f32x4 y = (f32x4){bf_lo(yc[j].x), bf_hi(yc[j].x), bf_lo(yc[j].y), bf_hi(yc[j].y)};
            const f32x4 xv = (f32x4){bf_lo(xc[j].x), bf_hi(xc[j].x), bf_lo(xc[j].y), bf_hi(xc[j].y)};
            *(f32x4*)(out + (size_t)R * 1024 + k) = xv + pg[j] * (y * rstd_y * pw[j]); }
#pragma unroll
        for (int j = 0; j < 4; ++j) { xc[j] = xn[j]; yc[j] = yn[j]; sqc[j] = sqn[j]; }
    }
#undef P11_LOAD
}
__device__ __forceinline__ void p3_conv(unsigned char* ws, const float* conv_w, int gtid, int ngt) {
    const bf16_t* PE = (const bf16_t*)(ws + WS_PE); const bf16_t* GE = (const bf16_t*)(ws + WS_GE); bf16_t* U = (bf16_t*)(ws + WS_U);
    const int ch = (gtid & 63) * 8;
    const f32x4 w0a = *(const f32x4*)(conv_w + ch), w0b = *(const f32x4*)(conv_w + ch + 4), w1a = *(const f32x4*)(conv_w + 512 + ch), w1b = *(const f32x4*)(conv_w + 512 + ch + 4),
                w2a = *(const f32x4*)(conv_w + 1024 + ch), w2b = *(const f32x4*)(conv_w + 1024 + ch + 4);
    for (int it = gtid; it < MT * 64; it += ngt) {
        const int R = it >> 6;
        int t, T; if (R < ML) { t = R & 2047; T = 2048; } else { t = (R - ML) & 255; T = 256; }
        const u32x4 z4 = (u32x4){0u, 0u, 0u, 0u};
        const u32x4 pc = *(const u32x4*)(PE + (size_t)R * 512 + ch);
        const u32x4 pm = (t > 0) ? *(const u32x4*)(PE + (size_t)(R - 1) * 512 + ch) : z4;
        const u32x4 pp = (t < T - 1) ? *(const u32x4*)(PE + (size_t)(R + 1) * 512 + ch) : z4;
        const u32x4 g = *(const u32x4*)(GE + (size_t)R * 512 + ch);
        u32x4 o;
#define CV(pmw, pcw, ppw, gw_, wa, wb, wc_, e0, e1) pk2(bf_lo(gw_) * (wa[e0] * bf_lo(pmw) + wb[e0] * bf_lo(pcw) + wc_[e0] * bf_lo(ppw)), bf_hi(gw_) * (wa[e1] * bf_hi(pmw) + wb[e1] * bf_hi(pcw) + wc_[e1] * bf_hi(ppw)))
        o.x = CV(pm.x, pc.x, pp.x, g.x, w0a, w1a, w2a, 0, 1); o.y = CV(pm.y, pc.y, pp.y, g.y, w0a, w1a, w2a, 2, 3);
        o.z = CV(pm.z, pc.z, pp.z, g.z, w0b, w1b, w2b, 0, 1); o.w = CV(pm.w, pc.w, pp.w, g.w, w0b, w1b, w2b, 2, 3);
#undef CV
        *(u32x4*)(U + (size_t)R * 1024 + 512 + ch) = o;
    }
}
__device__ __forceinline__ void p9_readout(unsigned char* ws, unsigned char* aux, const float* hn_w, int gw, int ngw, int lane) {
    const bf16_t* HM = (const bf16_t*)(ws + WS_HM); const bf16_t* MO = (const bf16_t*)(aux + AUX_MO); bf16_t* U = (bf16_t*)(ws + WS_U);
    const int ch = 8 * lane;
    const f32x4 wa = *(const f32x4*)(hn_w + ch), wb = *(const f32x4*)(hn_w + ch + 4);
    u32x4 h0, h1, mo, h0n, h1n, mon;
#define P9_LOAD(a_, b_, c_, R_) do { a_ = *(const u32x4*)(HM + (size_t)(R_) * 512 + ch); b_ = *(const u32x4*)(HM + ((size_t)ML + (R_)) * 512 + ch); c_ = *(const u32x4*)(MO + (size_t)(R_) * 512 + ch); } while (0)
    h0n = (u32x4){0u, 0u, 0u, 0u}; h1n = h0n; mon = h0n;
    if (gw < ML) P9_LOAD(h0, h1, mo, gw);
    for (int R = gw; R < ML; R += ngw) {
        if (R + ngw < ML) P9_LOAD(h0n, h1n, mon, R + ngw);
        float hs[8] = {bf_lo(h0.x) + bf_lo(h1.x), bf_hi(h0.x) + bf_hi(h1.x), bf_lo(h0.y) + bf_lo(h1.y), bf_hi(h0.y) + bf_hi(h1.y),
                       bf_lo(h0.z) + bf_lo(h1.z), bf_hi(h0.z) + bf_hi(h1.z), bf_lo(h0.w) + bf_lo(h1.w), bf_hi(h0.w) + bf_hi(h1.w)};
        float ss = 0.f;
#pragma unroll
        for (int e = 0; e < 8; ++e) ss += hs[e] * hs[e];
        ss += __shfl_xor(ss, 1); ss += __shfl_xor(ss, 2); ss += __shfl_xor(ss, 4); ss += __shfl_xor(ss, 8);
        const float rstd = rsqrtf(ss * (1.f / 128.f) + EPS);
        u32x4 o;
        o.x = pk2(hs[0] * rstd * wa[0] * bf_lo(mo.x), hs[1] * rstd * wa[1] * bf_hi(mo.x));
        o.y = pk2(hs[2] * rstd * wa[2] * bf_lo(mo.y), hs[3] * rstd * wa[3] * bf_hi(mo.y));
        o.z = pk2(hs[4] * rstd * wb[0] * bf_lo(mo.z), hs[5] * rstd * wb[1] * bf_hi(mo.z));
        o.w = pk2(hs[6] * rstd * wb[2] * bf_lo(mo.w), hs[7] * rstd * wb[3] * bf_hi(mo.w));
        *(u32x4*)(U + (size_t)R * 1024 + 512 + ch) = o;
        h0 = h0n; h1 = h1n; mo = mon;
    }
#undef P9_LOAD
}


typedef float f32x4v __attribute__((ext_vector_type(4)));
#define LDS_BARRIER() do { asm volatile("s_waitcnt lgkmcnt(0)" ::: "memory"); __builtin_amdgcn_s_barrier(); asm volatile("" ::: "memory"); } while (0)
#define MFMA_FENCE(x) do { __builtin_amdgcn_sched_barrier(0); asm volatile("s_nop 15\n\ts_nop 15" : "+v"(x)); __builtin_amdgcn_sched_barrier(0); } while (0)
__device__ __forceinline__ bf16x8 tr8(const LAS unsigned char* p, int halfstride) {
    const s16x4 lo = vtr(p), hi = vtr(p + halfstride);
    return (bf16x8){lo[0], lo[1], lo[2], lo[3], hi[0], hi[1], hi[2], hi[3]};
}
__device__ __forceinline__ bf16x8 gather8(const LAS unsigned char* img, int stride, int row0, int col) {
    bf16x8 r;
#pragma unroll
    for (int e = 0; e < 8; ++e) r[e] = *(const LAS short*)(img + (row0 + e) * stride + col * 2);
    return r;
}
template <int CTRL, int RM> __device__ __forceinline__ float dppf(float oldv, float v) {
    return __int_as_float(__builtin_amdgcn_update_dpp(__float_as_int(oldv), __float_as_int(v), CTRL, RM, 0xf, false));
}
__device__ __forceinline__ float wave_scan_add(float v) {
    v += dppf<0x111, 0xf>(0.f, v); v += dppf<0x112, 0xf>(0.f, v); v += dppf<0x114, 0xf>(0.f, v); v += dppf<0x118, 0xf>(0.f, v);
    v += dppf<0x142, 0xa>(0.f, v); v += dppf<0x143, 0xc>(0.f, v);
    return v;
}
__device__ __forceinline__ float wave_scan_max(float v) {
    const float ninf = -INFINITY;
    v = fmaxf(v, dppf<0x111, 0xf>(ninf, v)); v = fmaxf(v, dppf<0x112, 0xf>(ninf, v)); v = fmaxf(v, dppf<0x114, 0xf>(ninf, v)); v = fmaxf(v, dppf<0x118, 0xf>(ninf, v));
    v = fmaxf(v, dppf<0x142, 0xa>(ninf, v)); v = fmaxf(v, dppf<0x143, 0xc>(ninf, v));
    return v;
}
template <bool DUMMY> __device__ __forceinline__ void mlstm_chain_mfma(LAS unsigned char* lds, unsigned char* ws, unsigned char* aux, const float* i_bias, const float* f_bias, int chain) {
    constexpr int RS = 144, VS = 176;
    constexpr int QI = 0, KI = 9216, SC = 18432, CI = 27648, VI = 39168, VW = 50432, VEC = 61696;
    const int tid = my_tid(), lane = tid & 63, wid = __builtin_amdgcn_readfirstlane(tid >> 6), l15 = lane & 15, kg = lane >> 4;
    const int vh = chain & 1, d = (chain >> 1) & 1, h = (chain >> 2) & 3, b = chain >> 4;
    const bf16_t* MK = (const bf16_t*)(ws + WS_MK); const bf16_t* MV = (const bf16_t*)(ws + WS_MV); const bf16_t* MQ = (const bf16_t*)(aux + AUX_MQ);
    const float* GT = (const float*)(ws + WS_GATES); bf16_t* HM = (bf16_t*)(ws + WS_HM);
    const float ib = i_bias[d * 4 + h], fb = f_bias[d * 4 + h];
    for (int idx = tid; idx < 80 * RS / 4; idx += NTHREADS) ((LAS unsigned*)(lds + CI))[idx] = 0u;
    if (tid < 64) { LAS unsigned* a = (LAS unsigned*)(lds + VI + tid * VS + 128); LAS unsigned* w = (LAS unsigned*)(lds + VW + tid * VS + 128);
#pragma unroll
        for (int e = 0; e < 8; ++e) { a[e] = (e == 0) ? 0x3F80u : 0u; w[e] = 0u; } }
    const int it = wid & 3, vg = wid >> 2;
    f32x4v cacc[3];
#pragma unroll
    for (int t = 0; t < 3; ++t) cacc[t] = (f32x4v){0.f, 0.f, 0.f, 0.f};
    float mst = 0.f;
    unsigned nbad = 0u;
    const int srow = tid >> 3, sch = tid & 7;
    const int q4 = l15 >> 2, p4 = l15 & 3;
    u32x4 kkN, vvN, qqN = (u32x4){0u, 0u, 0u, 0u}; float liN = 0.f, fpN = 0.f;
#define MLSTM_LOADS(S_) do { const bool lat_ = (S_) >= 4; const int c_ = lat_ ? (S_) - 4 : (S_), T_ = lat_ ? 2048 : 256, rowb_ = lat_ ? b * 2048 : ML + b * 256; \
        const int tok_ = (d == 0) ? 64 * c_ + srow : T_ - 1 - (64 * c_ + srow); const size_t R_ = (size_t)(rowb_ + tok_); \
        kkN = *(const u32x4*)(MK + R_ * 256 + h * 64 + sch * 8); vvN = *(const u32x4*)(MV + R_ * 512 + h * 128 + vh * 64 + sch * 8); \
        if (lat_) qqN = *(const u32x4*)(MQ + R_ * 256 + h * 64 + sch * 8); \
        } while (0)
#define MLSTM_GATES(S_) do { const bool lat_ = (S_) >= 4; const int c_ = lat_ ? (S_) - 4 : (S_), T_ = lat_ ? 2048 : 256, rowb_ = lat_ ? b * 2048 : ML + b * 256; \
        const int tk_ = (d == 0) ? 64 * c_ + lane : T_ - 1 - (64 * c_ + lane); const float* gp_ = GT + (size_t)(rowb_ + tk_) * 16 + d * 8 + h; liN = gp_[0]; fpN = gp_[4]; } while (0)
#define MLSTM_SCAN(S_) do { LAS float* vs_ = (LAS float*)(lds + VEC) + ((S_) & 1) * 320; \
        const float li = liN + ib, fp = fpN + fb; \
        const float lf = fminf(fp, 0.f) - __logf(1.f + __expf(-fabsf(fp))); \
        const float bc = wave_scan_add(lf); \
        const float ab = li - bc; const float cm = wave_scan_max(ab); \
        const float g = __int_as_float(__builtin_amdgcn_readlane(__float_as_int(bc), 63)), mloc = g + __int_as_float(__builtin_amdgcn_readlane(__float_as_int(cm), 63)), m_new = fmaxf(g + mst, mloc); \
        vs_[lane] = bc; vs_[64 + lane] = ab; vs_[128 + lane] = cm; vs_[192 + lane] = __expf(g + ab - m_new); \
        if (lane == 0) { vs_[256] = mst; vs_[257] = __expf(g + mst - m_new); } \
        mst = m_new; } while (0)
    MLSTM_LOADS(0);
    if (wid == 4) { MLSTM_GATES(0); MLSTM_SCAN(0); MLSTM_GATES(1); }
    LDS_BARRIER();
    for (int step = 0; step < 36; ++step) {
        const bool lat = step >= 4; const int c = lat ? step - 4 : step, T = lat ? 2048 : 256, rowb = lat ? b * 2048 : ML + b * 256;
        const int tok = (d == 0) ? 64 * c + srow : T - 1 - (64 * c + srow); const size_t R = (size_t)(rowb + tok);
        const u32x4 kk = kkN, vv = vvN, qq = qqN;
        LAS float* vb_ = (LAS float*)(lds + VEC) + (step & 1) * 320; LAS float* vab = vb_ + 64; LAS float* vcm = vab + 64; LAS float* vwp = vcm + 64; LAS float* vsc = vwp + 64;
        { const float wj = vwp[srow];
          *(LAS u32x4*)(lds + KI + srow * RS + sch * 16) = kk;
          *(LAS u32x4*)(lds + VI + srow * VS + sch * 16) = vv;
          u32x4 vw; vw.x = pk2(bf_lo(vv.x) * wj, bf_hi(vv.x) * wj); vw.y = pk2(bf_lo(vv.y) * wj, bf_hi(vv.y) * wj); vw.z = pk2(bf_lo(vv.z) * wj, bf_hi(vv.z) * wj); vw.w = pk2(bf_lo(vv.w) * wj, bf_hi(vv.w) * wj);
          *(LAS u32x4*)(lds + VW + srow * VS + sch * 16) = vw;
          if (sch == 0) *(LAS unsigned short*)(lds + VW + srow * VS + 128) = f2bf(wj);
          if (lat) *(LAS u32x4*)(lds + QI + srow * RS + sch * 16) = qq; }
        LDS_BARRIER();
        const float m_in = vsc[0], a_prev = vsc[1];
        if (step + 1 < 36) MLSTM_LOADS(step + 1);
        bf16x8 qf[2];
        if (lat) {
            qf[0] = *(const LAS bf16x8*)(lds + QI + (16 * it + l15) * RS + (8 * kg) * 2); qf[1] = *(const LAS bf16x8*)(lds + QI + (16 * it + l15) * RS + (8 * kg + 32) * 2);
            const int i = 16 * it + l15; const float mi = fmaxf(m_in, vcm[i]);
#pragma unroll
            for (int t = 0; t < 2; ++t) {
                const int jt = 2 * vg + t; u32x2 o = (u32x2){0u, 0u};
                if (jt <= it) {
                    const bf16x8 k0 = *(const LAS bf16x8*)(lds + KI + (16 * jt + l15) * RS + (8 * kg) * 2), k1 = *(const LAS bf16x8*)(lds + KI + (16 * jt + l15) * RS + (8 * kg + 32) * 2);
                    f32x4v s = (f32x4v){0.f, 0.f, 0.f, 0.f};
                    s = __builtin_amdgcn_mfma_f32_16x16x32_bf16(k0, qf[0], s, 0, 0, 0); s = __builtin_amdgcn_mfma_f32_16x16x32_bf16(k1, qf[1], s, 0, 0, 0); MFMA_FENCE(s);
                    const int j0 = 16 * jt + 4 * kg; const f32x4v abv = *(const LAS f32x4v*)(vab + j0);
                    float e[4];
#pragma unroll
                    for (int r = 0; r < 4; ++r) e[r] = (j0 + r <= i) ? s[r] * __expf(abv[r] - mi) : 0.f;
                    o.x = pk2(e[0], e[1]); o.y = pk2(e[2], e[3]);
                }
                *(LAS u32x2*)(lds + SC + i * RS + (16 * jt + 4 * kg) * 2) = o;
            }
        }
        if (wid == 4 && step + 1 < 36) { MLSTM_SCAN(step + 1); if (step + 2 < 36) MLSTM_GATES(step + 2); }
        LDS_BARRIER();
        f32x4v cnew[3];
        { bf16x8 aK[2];
#pragma unroll
          for (int s = 0; s < 2; ++s) aK[s] = tr8(lds + KI + (32 * s + 8 * kg + q4) * RS + (16 * it + 4 * p4) * 2, 4 * RS);
#pragma unroll
          for (int t = 0; t < 3; ++t) { const int vt = (t == 2) ? 4 : 2 * t + vg; f32x4v a = cacc[t] * a_prev;
#pragma unroll
              for (int s = 0; s < 2; ++s) { const bf16x8 bW = tr8(lds + VW + (32 * s + 8 * kg + q4) * VS + (16 * vt + 4 * p4) * 2, 4 * VS); a = __builtin_amdgcn_mfma_f32_16x16x32_bf16(aK[s], bW, a, 0, 0, 0); }
              MFMA_FENCE(a); cnew[t] = a; } }
        if (lat) {
            const int i0 = 16 * it + 4 * kg; const f32x4v cmv = *(const LAS f32x4v*)(vcm + i0), bv = *(const LAS f32x4v*)(vb_ + i0);
            float wi[4], mt[4];
#pragma unroll
            for (int r = 0; r < 4; ++r) { const float mi = fmaxf(m_in, cmv[r]); wi[r] = __expf(m_in - mi); mt[r] = bv[r] + mi; }
            bf16x8 aS[2];
            aS[0] = *(const LAS bf16x8*)(lds + SC + (16 * it + l15) * RS + (8 * kg) * 2); aS[1] = *(const LAS bf16x8*)(lds + SC + (16 * it + l15) * RS + (8 * kg + 32) * 2);
            f32x4v nacc[3];
#pragma unroll
            for (int t = 0; t < 3; ++t) { const int vt = (t == 2) ? 4 : 2 * t + vg; f32x4v a = (f32x4v){0.f, 0.f, 0.f, 0.f};
#pragma unroll
                for (int s = 0; s < 2; ++s) { const bf16x8 bC = *(const LAS bf16x8*)(lds + CI + (16 * vt + l15) * RS + (8 * kg + 32 * s) * 2); a = __builtin_amdgcn_mfma_f32_16x16x32_bf16(qf[s], bC, a, 0, 0, 0); }
                MFMA_FENCE(a);
#pragma unroll
                for (int r = 0; r < 4; ++r) a[r] *= wi[r];
#pragma unroll
                for (int s = 0; s < 2; ++s) { const bf16x8 bV = tr8(lds + VI + (32 * s + 8 * kg + q4) * VS + (16 * vt + 4 * p4) * 2, 4 * VS); a = __builtin_amdgcn_mfma_f32_16x16x32_bf16(aS[s], bV, a, 0, 0, 0); }
                MFMA_FENCE(a); nacc[t] = a; }
            float inv[4];
#pragma unroll
            for (int r = 0; r < 4; ++r) { const float den = __shfl(nacc[2][r], lane & 48); inv[r] = 1.f / fmaxf(fabsf(den), __expf(-mt[r])); }
#pragma unroll
            for (int t = 0; t < 2; ++t) { const int vt = 2 * t + vg;
#pragma unroll
                for (int r = 0; r < 4; ++r) *(LAS unsigned short*)(lds + QI + (i0 + r) * RS + (16 * vt + l15) * 2) = f2bf(nacc[t][r] * inv[r]); }
        }
        LDS_BARRIER();
        if (lat) { const u32x4 hv = *(const LAS u32x4*)(lds + QI + srow * RS + sch * 16);
            if (DUMMY) { const u32x4 rv = *(const u32x4*)(HM + ((size_t)d * ML + R) * 512 + h * 128 + vh * 64 + sch * 8);
#define CMPH(a_, b_) do { const float x_ = (a_), y_ = (b_); if (fabsf(x_ - y_) > 0.05f * fmaxf(fabsf(x_), fabsf(y_)) + 0.02f) ++nbad; } while (0)
                CMPH(bf_lo(hv.x), bf_lo(rv.x)); CMPH(bf_hi(hv.x), bf_hi(rv.x)); CMPH(bf_lo(hv.y), bf_lo(rv.y)); CMPH(bf_hi(hv.y), bf_hi(rv.y));
                CMPH(bf_lo(hv.z), bf_lo(rv.z)); CMPH(bf_hi(hv.z), bf_hi(rv.z)); CMPH(bf_lo(hv.w), bf_lo(rv.w)); CMPH(bf_hi(hv.w), bf_hi(rv.w));
#undef CMPH
            } else *(u32x4*)(HM + ((size_t)d * ML + R) * 512 + h * 128 + vh * 64 + sch * 8) = hv; }
#pragma unroll
        for (int t = 0; t < 3; ++t) { cacc[t] = cnew[t]; const int vt = (t == 2) ? 4 : 2 * t + vg;
            if (t < 2 || wid < 4) { u32x2 o; o.x = pk2(cnew[t][0], cnew[t][1]); o.y = pk2(cnew[t][2], cnew[t][3]); *(LAS u32x2*)(lds + CI + (16 * vt + l15) * RS + (16 * it + 4 * kg) * 2) = o; } }
    }
#undef MLSTM_LOADS
#undef MLSTM_GATES
#undef MLSTM_SCAN
    if (DUMMY) atomicAdd((unsigned*)(ws + WS_CTL) + 64, nbad);
    __syncthreads();
}

#ifndef MK_N_LAUNCHES
#define MK_N_LAUNCHES 1
#endif
constexpr int N_PHASES = 12;
constexpr int LDS_BYTES = 147456;
constexpr int RING_BYTES = 131072, MISC_OFF = RING_BYTES + 320;
constexpr int CW_BAR = 4096;

struct Args { const float* in[21]; float* out; unsigned char* ws; int ph_lo, ph_hi; };

__global__ void __launch_bounds__(NTHREADS, 2) hybrid_fwd(Args args) {
    extern __shared__ __attribute__((aligned(16))) unsigned char lds_raw[];
    LAS unsigned char* lds = (LAS unsigned char*)lds_raw;
    const int G = gridDim.x, bx = blockIdx.x;
    const int vcu = (G % 8 == 0) ? (bx % 8) * (G / 8) + bx / 8 : bx;
    typedef const __attribute__((address_space(4))) Args* ArgsP;
    ArgsP AP = (ArgsP)__builtin_amdgcn_kernarg_segment_ptr();
    asm volatile("" : "+s"(AP));
    unsigned char* ws = AP->ws;
#define I_x AP->in[0]
#define I_cvec AP->in[1]
#define I_ctx AP->in[2]
#define I_c_ctx AP->in[3]
#define I_mod_w AP->in[4]
#define I_mod_b AP->in[5]
#define I_pre_w AP->in[6]
#define I_post_w AP->in[7]
#define I_e_w_in AP->in[8]
#define I_e_sink AP->in[9]
#define I_e_conv_w AP->in[10]
#define I_e_w_out AP->in[11]
#define I_o_w_in AP->in[12]
#define I_o_qn AP->in[13]
#define I_o_kvn AP->in[14]
#define I_o_w_uq AP->in[15]
#define I_o_w_ukv AP->in[16]
#define I_o_ib AP->in[17]
#define I_o_fb AP->in[18]
#define I_o_hn AP->in[19]
#define I_o_w_out AP->in[20]
#define I_out AP->out
    float* MOD = (float*)(ws + WS_MOD);

    for (int u = threadIdx.x; u < (LDS_BYTES - RING_BYTES) / 4; u += NTHREADS) ((LAS unsigned*)(lds + RING_BYTES))[u] = 0u;
    __syncthreads();
    XcdBarrier bar; bar.bar = (unsigned*)(ws + WS_CTL) + CW_BAR; bar.x = 0; bar.st = nullptr;
    if (MK_N_LAUNCHES == 1) bar = xcd_barrier_post((unsigned*)(ws + WS_CTL) + CW_BAR, (volatile LAS unsigned*)(lds + MISC_OFF) + 8);
    const int lo = AP->ph_lo, hi = AP->ph_hi;
#ifndef PROBE_REP
#define PROBE_REP 0
#endif
#define NREP(k) ((((PROBE_REP) >> (k)) & 1) ? 2 : 1)
#ifndef PHASE_MASK
#define PHASE_MASK 0xFFF
#endif
#define IN(k) (((PHASE_MASK >> (k)) & 1) && lo <= (k) && (k) < hi)
#ifndef PROBE_DBLBAR
#define PROBE_DBLBAR 0
#endif
#ifndef PROBE_TS
#define PROBE_TS -1
#endif
#define STAMP(k) do { if (PROBE_TS >= 0 && bx == 0 && threadIdx.x == 0) ((unsigned long long*)(ws + WS_CTL + 512 * 1024))[(k)] = __builtin_amdgcn_s_memrealtime(); } while (0)
#define SEAM(k) do { if (MK_N_LAUNCHES == 1 && IN((k) + 1)) { xcd_barrier(bar); if (PROBE_DBLBAR) xcd_barrier(bar); } STAMP((k) + 1); } while (0)
    const int ngw = G * NWAVES;
#define PH_IDS const int tid = my_tid(), lane = tid & 63, wave = __builtin_amdgcn_readfirstlane(tid >> 6), gw = vcu * NWAVES + wave; (void)lane; (void)gw

    STAMP(0);
    if (IN(0)) { asm volatile("" : "+s"(AP)); PH_IDS;
        for (int rep_ = 0; rep_ < NREP(0); ++rep_) { if (rep_) __syncthreads();
        STAMP(20); p0_mod(lds, I_cvec, I_c_ctx, I_mod_w, I_mod_b, MOD, G);
        __syncthreads(); STAMP(21);
        LAS float* scr = (LAS float*)(lds + wave * 16384);
        constexpr int I0 = 16 * (E_N / 32), I1 = 16 * 32;
        { const bool split = (G == 256); const int cw0 = split ? (bx - 192) * NWAVES + wave : gw, ncw = split ? 64 * NWAVES : ngw;
          if (!split || bx >= 192) for (int it = cw0; it < I0 + I1; it += ncw) {
            if (it < I0) p0_transpose_item(I_e_w_in, 1024, E_N, (bf16_t*)(ws + WS_WEIN), 0, nullptr, scr, it, E_N / 32, lane);
            else p0_transpose_item(I_e_w_out, 1024, 1024, (bf16_t*)(ws + WS_WEOUT), 1, nullptr, scr, it - I0, 32, lane); } }
        STAMP(22);
        float* ropeA = (float*)(ws + WS_ROPEA); float* ropeC = (float*)(ws + WS_ROPEC);
        for (int idx = bx * NTHREADS + tid; idx < 2048 * 48; idx += G * NTHREADS) {
            const int pos = idx / 48, j = idx % 48; const float rowf = (float)(pos >> 6), colf = (float)(pos & 63);
            if (j < 32) { const int f = j & 15; const float inv = exp2f(-(float)f * (13.287712379549449f / 16.f)); const float ang = ((j < 16) ? rowf : colf) * inv;
                ropeA[pos * 64 + j] = __cosf(ang); ropeA[pos * 64 + 32 + j] = __sinf(ang); }
            else { const int jj = j - 32, f = jj & 7; const float inv = exp2f(-(float)f * (13.287712379549449f / 8.f)); const float ang = ((jj < 8) ? rowf : colf) * inv;
                ropeC[pos * 32 + jj] = __cosf(ang); ropeC[pos * 32 + 16 + jj] = __sinf(ang); }
        }
        STAMP(23);
        }
        SEAM(0); STAMP(24);
    }
    if (IN(1)) { asm volatile("" : "+s"(AP)); PH_IDS; for (int rep_ = 0; rep_ < NREP(1); ++rep_) { if (rep_) __syncthreads();
        { LAS float* scr = (LAS float*)(lds + wave * 16384);
          constexpr int I2 = 16 * (O_N / 32), I3 = 12 * 24, I4 = 4 * 32, I5 = 16 * 32;
          for (int it = gw; it < I2 + I3 + I4 + I5; it += ngw) { int r = it;
            if (r < I2) { p0_transpose_item(I_o_w_in, 1024, O_NSRC, (bf16_t*)(ws + WS_WOIN), 2, nullptr, scr, r, O_N / 32, lane); continue; } r -= I2;
            if (r < I3) { p0_transpose_item(I_o_w_uq, 768, 768, (bf16_t*)(ws + WS_WUQ), 3, I_o_qn, scr, r, 24, lane); continue; } r -= I3;
            if (r < I4) { p0_transpose_item(I_o_w_ukv, 256, 1024, (bf16_t*)(ws + WS_WUKV), 4, I_o_kvn, scr, r, 32, lane); continue; } r -= I4;
            p0_transpose_item(I_o_w_out, 1024, 1024, (bf16_t*)(ws + WS_WOOUT), 5, nullptr, scr, r, 32, lane); } }
        p1_prenorm(I_x, I_ctx, I_pre_w, MOD, (bf16_t*)(ws + WS_H), gw, ngw, lane); }
        SEAM(1); }
    if (IN(2)) { asm volatile("" : "+s"(AP)); PH_IDS;
        for (int rep_ = 0; rep_ < NREP(2); ++rep_) { if (rep_) __syncthreads();
        pg8::Gemm g{(const bf16_t*)(ws + WS_H), (const bf16_t*)(ws + WS_WEIN), MT, E_N, 1024}; pg8::RectOrder S; S.init(MT / 256, E_N / 256, 0, 0, 0, G, bx);
        EpiEin E{ws}; pg8::gemm_phase<EpiEin, pg8::RectOrder, true, true>(lds, g, S, E);
        }
        SEAM(2);
    }
    if (IN(3)) { asm volatile("" : "+s"(AP)); PH_IDS;
        for (int rep_ = 0; rep_ < NREP(3) + NREP(14) - 1; ++rep_) {
        for (int un = vcu; un < 1024; un += G) attn_unit<0>(lds, ws, nullptr, I_e_sink, un);
        for (int un = bx; un < 128; un += G) attn_unit<1>(lds, ws, nullptr, I_e_sink, un);
        }
        for (int rep_ = 0; rep_ < NREP(3) + NREP(15) - 1; ++rep_) { p3_conv(ws, I_e_conv_w, bx * NTHREADS + tid, G * NTHREADS);
        }
        SEAM(3);
    }
    if (IN(4)) { asm volatile("" : "+s"(AP)); PH_IDS;
        for (int rep_ = 0; rep_ < NREP(4); ++rep_) { if (rep_) __syncthreads();
        pg8::Gemm g{(const bf16_t*)(ws + WS_U), (const bf16_t*)(ws + WS_WEOUT), MT, 1024, 1024}; pg8::RectOrder S; S.init(MT / 256, 4, 0, 0, 0, G, bx);
        EpiY E{(bf16_t*)(ws + WS_Y), (float*)(ws + WS_SSQY0)}; pg8::gemm_phase<EpiY, pg8::RectOrder, true, true>(lds, g, S, E);
        }
        SEAM(4);
    }
    if (IN(5)) { asm volatile("" : "+s"(AP)); PH_IDS; for (int rep_ = 0; rep_ < NREP(5); ++rep_) { if (rep_) __syncthreads();
        p5_post_pre(I_x, I_ctx, I_post_w, I_pre_w + 1024, MOD, (const bf16_t*)(ws + WS_Y), (const float*)(ws + WS_SSQY0), (bf16_t*)(ws + WS_X1), (bf16_t*)(ws + WS_H), gw, ngw, lane); }
        SEAM(5); }
    if (IN(6)) { asm volatile("" : "+s"(AP)); PH_IDS;
        for (int rep_ = 0; rep_ < NREP(6); ++rep_) { if (rep_) __syncthreads();
        pg8::Gemm g{(const bf16_t*)(ws + WS_H), (const bf16_t*)(ws + WS_WOIN), MT, O_N, 1024}; pg8::RectOrder S; S.init(ML / 256, O_N / 256, ML / 256, MC / 256, 5, G, bx);
        EpiOin E{ws, (unsigned char*)I_out}; pg8::gemm_phase<EpiOin, pg8::RectOrder, true, true>(lds, g, S, E);
        }
        SEAM(6);
    }
    if (IN(7)) { asm volatile("" : "+s"(AP)); PH_IDS;
        for (int rep_ = 0; rep_ < NREP(7); ++rep_) { if (rep_) __syncthreads();
        { pg8::Gemm g{(const bf16_t*)(ws + WS_CQ), (const bf16_t*)(ws + WS_WUQ), ML, 768, 768}; pg8::RectOrder S; S.init(ML / 256, 3, 0, 0, 0, G, bx);
          EpiUq E{ws, lds}; pg8::gemm_phase<EpiUq, pg8::RectOrder, true, true>(lds, g, S, E); }
        __syncthreads();
        { pg8::Gemm g{(const bf16_t*)(ws + WS_CKV), (const bf16_t*)(ws + WS_WUKV), MT, 1024, 256}; EpiUkv E{ws};
          if (G == 256) {
              pg8::ListOrder4 S; if (bx < 128) { S.start = bx; S.cnt = 1; } else if (bx < 192) { S.start = 128 + 3 * (bx - 128); S.cnt = 3; } else { S.start = 320 + 4 * (bx - 192); S.cnt = 4; }
              pg8::gemm_phase<EpiUkv, pg8::ListOrder4, true, true>(lds, g, S, E);
          } else { pg8::RectOrder S; S.init(MT / 256, 4, 0, 0, 0, G, G - 1 - bx); pg8::gemm_phase<EpiUkv, pg8::RectOrder, true, true>(lds, g, S, E); } }
        }
        SEAM(7);
    }
    if (IN(8)) { asm volatile("" : "+s"(AP)); PH_IDS;
        for (int rep_ = 0; rep_ < NREP(8) + NREP(12) - 1; ++rep_) { for (int ch = bx; ch < 256; ch += G) { STAMP(30); mlstm_chain_mfma<false>(lds, ws, (unsigned char*)I_out, I_o_ib, I_o_fb, ch); STAMP(31); }
        }
        for (int rep_ = 0; rep_ < NREP(8) + NREP(13) - 1; ++rep_) {
        for (int un = vcu; un < 1024; un += G) attn_unit<2>(lds, ws, (unsigned char*)I_out, nullptr, un);
        }
        STAMP(32); SEAM(8); STAMP(33);
    }
    if (IN(9)) { asm volatile("" : "+s"(AP)); PH_IDS; for (int rep_ = 0; rep_ < NREP(9); ++rep_) { if (rep_) __syncthreads();
        p9_readout(ws, (unsigned char*)I_out, I_o_hn, gw, ngw, lane); }
        SEAM(9); }
    if (IN(10)) { asm volatile("" : "+s"(AP)); PH_IDS;
        for (int rep_ = 0; rep_ < NREP(10); ++rep_) { if (rep_) __syncthreads();
        pg8::Gemm g{(const bf16_t*)(ws + WS_U), (const bf16_t*)(ws + WS_WOOUT), ML, 1024, 1024}; pg8::RectOrder S; S.init(ML / 256, 4, 0, 0, 0, G, bx);
        EpiY E{(bf16_t*)(ws + WS_Y), (float*)(ws + WS_SSQY1)}; pg8::gemm_phase<EpiY, pg8::RectOrder, true, true>(lds, g, S, E);
        }
        SEAM(10);
    }
    if (IN(11)) { asm volatile("" : "+s"(AP)); PH_IDS; p11_final(I_post_w + 1024, MOD, (const bf16_t*)(ws + WS_Y), (const float*)(ws + WS_SSQY1), (const bf16_t*)(ws + WS_X1), I_out, gw, ngw, lane);
        if (PROBE_TS >= 0 && bx == 0 && threadIdx.x == 0) { asm volatile("s_waitcnt vmcnt(0)" ::: "memory"); const unsigned long long* ts = (const unsigned long long*)(ws + WS_CTL + 512 * 1024);
            const unsigned long long t1 = (PROBE_TS == 11) ? __builtin_amdgcn_s_memrealtime() : ts[PROBE_TS + 1]; I_out[5 * 1024 * 7 + 3] += floorf((float)(t1 - ts[PROBE_TS]) * 0.01f * (1.f / 50.f)) * 50.f; } }
#undef IN
#undef SEAM
#undef I_x
#undef I_cvec
#undef I_ctx
#undef I_c_ctx
#undef I_mod_w
#undef I_mod_b
#undef I_pre_w
#undef I_post_w
#undef I_e_w_in
#undef I_e_sink
#undef I_e_conv_w
#undef I_e_w_out
#undef I_o_w_in
#undef I_o_qn
#undef I_o_kvn
#undef I_o_w_uq
#undef I_o_w_ukv
#undef I_o_ib
#undef I_o_fb
#undef I_o_hn
#undef I_o_w_out
#undef I_out
}

extern "C" void kernel_launch(void* const* d_in, const int* in_sizes, int n_in, void* d_out, int out_size, void* d_ws, size_t ws_size, hipStream_t stream) {
    static int grid = 0;
    if (grid == 0) {
        if (n_in != 21 || in_sizes[0] != ML * DM || out_size != ML * DM || ws_size < WS_END) { fprintf(stderr, "kernel_launch: unexpected shapes / workspace (n_in %d, ws %zu < %zu); nothing launched\n", n_in, ws_size, (size_t)WS_END); grid = -1; return; }
        int dev = 0, cus = 0, per_cu = 0;
        if (hipGetDevice(&dev) != hipSuccess || hipDeviceGetAttribute(&cus, hipDeviceAttributeMultiprocessorCount, dev) != hipSuccess) { grid = -1; return; }
        if (hipFuncSetAttribute((const void*)hybrid_fwd, hipFuncAttributeMaxDynamicSharedMemorySize, LDS_BYTES) != hipSuccess) { fprintf(stderr, "kernel_launch: hipFuncSetAttribute failed\n"); grid = -1; return; }
        if (hipOccupancyMaxActiveBlocksPerMultiprocessor(&per_cu, (const void*)hybrid_fwd, NTHREADS, LDS_BYTES) != hipSuccess || per_cu < 1) fprintf(stderr, "kernel_launch: note: occupancy query reports %d workgroups per CU\n", per_cu);
        (void)hipGetLastError();
        grid = cus;
    }
    if (grid < 0) return;
    if (hipMemsetAsync((char*)d_ws + WS_CTL, 0, CTL_ZERO_BYTES, stream) != hipSuccess) { fprintf(stderr, "kernel_launch: hipMemsetAsync failed\n"); return; }
    Args a{};
    for (int i = 0; i < 21; ++i) a.in[i] = (const float*)d_in[i];
    a.out = (float*)d_out; a.ws = (unsigned char*)d_ws;
    if (MK_N_LAUNCHES == 1) { a.ph_lo = 0; a.ph_hi = N_PHASES; hipLaunchKernelGGL(hybrid_fwd, dim3(grid), dim3(NTHREADS), LDS_BYTES, stream, a); }
    else for (int p = 0; p < N_PHASES; ++p) { a.ph_lo = p; a.ph_hi = p + 1; hipLaunchKernelGGL(hybrid_fwd, dim3(grid), dim3(NTHREADS), LDS_BYTES, stream, a); }
    const hipError_t le = hipPeekAtLastError();
    if (le != hipSuccess) fprintf(stderr, "kernel_launch: launch failed: %s\n", hipGetErrorName(le));
}
```

```cpp
#include <hip/hip_runtime.h>
#include <cstdio>
#include <cstdint>

#define LAS __attribute__((address_space(3)))
#define GAS __attribute__((address_space(1)))
typedef unsigned short bf16_t;
typedef short bf16x8 __attribute__((ext_vector_type(8)));
typedef short s16x4 __attribute__((ext_vector_type(4)));
typedef float f32x4 __attribute__((ext_vector_type(4)));
typedef float f32x16 __attribute__((ext_vector_type(16)));
typedef unsigned u32x4 __attribute__((ext_vector_type(4)));
typedef unsigned u32x2 __attribute__((ext_vector_type(2)));
typedef float f32x2_t __attribute__((ext_vector_type(2)));
typedef __bf16 bf16x2_t __attribute__((ext_vector_type(2)));

constexpr int NB = 16, SEQ = 2048, DM = 1024, CL = 256;
constexpr int ML = NB * SEQ, MC = NB * CL, MT = ML + MC;
constexpr float EPS = 1e-6f, LOG2E = 1.4426950408889634f;
constexpr int E_N = 3328, O_NSRC = 3632, O_N = 3840;
constexpr int NWAVES = 8, NTHREADS = 512;

__device__ __forceinline__ float bf_lo(unsigned w) { return __uint_as_float(w << 16); }
__device__ __forceinline__ float bf_hi(unsigned w) { return __uint_as_float(w & 0xffff0000u); }
__device__ __forceinline__ unsigned pk2(float lo, float hi) { f32x2_t v = {lo, hi}; bf16x2_t b = __builtin_convertvector(v, bf16x2_t); return __builtin_bit_cast(unsigned, b); }
__device__ __forceinline__ float silu_f(float x) { return x * __builtin_amdgcn_rcpf(1.f + __expf(-x)); }
__device__ __forceinline__ float sigmoid_f(float x) { return __builtin_amdgcn_rcpf(1.f + __expf(-x)); }
__device__ __forceinline__ float wave_sum(float v) {
#pragma unroll
    for (int o = 1; o < 64; o <<= 1) v += __shfl_xor(v, o);
    return v;
}
#define LDS_WAIT() asm volatile("s_waitcnt lgkmcnt(0)" ::: "memory")
#define VM_WAIT() asm volatile("s_waitcnt vmcnt(0)" ::: "memory")

__device__ __forceinline__ int my_tid() { int t = threadIdx.x; asm volatile("" : "+v"(t)); return t; }

namespace pg8 {
#define PG8_LAS __attribute__((address_space(3)))
typedef unsigned short bf16_t;
typedef short bf16x8 __attribute__((ext_vector_type(8)));
typedef float f32x4 __attribute__((ext_vector_type(4)));
typedef unsigned u32x4 __attribute__((ext_vector_type(4)));
constexpr int BM = 256, BK = 64, HALF = 128, HTB = HALF * BK * 2  , STAGE_BYTES = 8 * HTB, NXCD = 8, WGM = 8;

__host__ __device__ __forceinline__ int lds_byte(int r, int c) { const int st = (r >> 4) * 2 + (c >> 5), rr = r & 15, cc = c & 31, ob = rr * 64 + cc * 2; return st * 1024 + (ob ^ (((ob >> 9) & 1) << 5)); }
__host__ __device__ __forceinline__ void stage_rc(int b, int& R, int& C) { const int st = b / 1024, sb = b % 1024, swz = sb ^ (((sb >> 9) & 1) << 5); R = (st >> 1) * 16 + swz / 64; C = (st & 1) * 32 + (swz % 64) / 2; }
__host__ __device__ __forceinline__ int perm32(int rho) { const int n = rho >> 4, i = rho & 15; return 8 * (i >> 2) + 4 * n + (i & 3); }

struct Unit { int pm, pn; };
struct Gemm { const bf16_t* A; const bf16_t* Bt; int M, N, K; };

struct RectOrder {
    int nM0, nN0, n0, pm1, nM1, nN1, n1, G, c;
    __device__ __forceinline__ void init(int nM0_, int nN0_, int pm1_, int nM1_, int nN1_, int G_, int c_) { nM0 = nM0_; nN0 = nN0_; n0 = nM0_ * nN0_; pm1 = pm1_; nM1 = nM1_; nN1 = nN1_; n1 = nM1_ * nN1_; G = G_; c = c_; }
    __device__ __forceinline__ static void rect(int w, int nM, int nN, int& pm, int& pn) {
        const int nig = WGM * nN, gid = w / nig, fm = gid * WGM, gsz = (nM - fm) < WGM ? (nM - fm) : WGM;
        pm = fm + ((w % nig) % gsz); pn = (w % nig) / gsz;
    }
    __device__ __forceinline__ bool next(int i, Unit& u) const {
        const int nwg = n0 + n1; const long L = (long)i * G + c; if (L >= nwg) return false;
        int wgid = (int)L; { const int q = nwg / NXCD, r = nwg % NXCD, xcd = wgid % NXCD, off = wgid / NXCD; wgid = (xcd < r ? xcd * (q + 1) : r * (q + 1) + (xcd - r) * q) + off; }
        if (wgid < n0) rect(wgid, nM0, nN0, u.pm, u.pn); else { rect(wgid - n0, nM1, nN1, u.pm, u.pn); u.pm += pm1; }
        return true;
    }
    __device__ __forceinline__ void a_ready(const Unit&) const {}
    __device__ __forceinline__ void done(const Unit&, int, bool) const {}
};

struct RoundOrder {
    int nM0, nN0, n0, pm1, nM1, nN1, nwg, G, c, i0, i1; unsigned* cnt;
    __device__ __forceinline__ void init(int nM0_, int nN0_, int pm1_, int nM1_, int nN1_, int G_, int c_, int i0_, int i1_, unsigned* cnt_) { nM0 = nM0_; nN0 = nN0_; n0 = nM0_ * nN0_; pm1 = pm1_; nM1 = nM1_; nN1 = nN1_; nwg = n0 + nM1_ * nN1_; G = G_; c = c_; i0 = i0_; i1 = i1_; cnt = cnt_; }
    __device__ __forceinline__ bool next(int i_, Unit& u) const {
        const int i = i0 + i_; if (i >= i1) return false;
        const long base_l = (long)i * G; if (base_l >= nwg) return false;
        const int base = (int)base_l, cntR = (nwg - base) < G ? (nwg - base) : G; if (c >= cntR) return false;
        const int q = cntR / NXCD, r = cntR % NXCD, xcd = c % NXCD, off = c / NXCD;
        const int wgid = base + (xcd < r ? xcd * (q + 1) : r * (q + 1) + (xcd - r) * q) + off;
        if (wgid < n0) RectOrder::rect(wgid, nM0, nN0, u.pm, u.pn); else { RectOrder::rect(wgid - n0, nM1, nN1, u.pm, u.pn); u.pm += pm1; }
        return true;
    }
    __device__ __forceinline__ void a_ready(const Unit&) const {}
    __device__ __forceinline__ void done(const Unit& u, int ui, bool has_next) const {
        if (cnt == nullptr || (ui == 0 && has_next)) return;
        asm volatile("s_waitcnt vmcnt(0)" ::: "memory");
        if ((::my_tid() & 63) == 0) {
            if (ui == 1) { Unit u0; (void)next(0, u0); (void)__hip_atomic_fetch_add(cnt + 64 * u0.pm, 1u, __ATOMIC_RELAXED, __HIP_MEMORY_SCOPE_AGENT); }
            (void)__hip_atomic_fetch_add(cnt + 64 * u.pm, 1u, __ATOMIC_RELAXED, __HIP_MEMORY_SCOPE_AGENT);
        }
    }
};

struct ListOrder4 {
    int start, cnt;
    __device__ __forceinline__ bool next(int i, Unit& u) const { if (i >= cnt) return false; const int L = start + i; u.pm = L >> 2; u.pn = L & 3; return true; }
    __device__ __forceinline__ void a_ready(const Unit&) const {}
    __device__ __forceinline__ void done(const Unit&, int, bool) const {}
};

struct PanelOrder {
    int nM0, nN0, nN1, total, first, step, cnt;
    const unsigned* ready; unsigned need; unsigned* tmo;
    __device__ __forceinline__ bool next(int i, Unit& u) const {
        if (i >= cnt) return false; int L = first + step * i; if (L >= total) return false;
        const int n0 = nM0 * nN0; if (L < n0) { u.pm = L / nN0; u.pn = L - u.pm * nN0; } else { L -= n0; const int q = L / nN1; u.pm = nM0 + q; u.pn = L - q * nN1; }
        return true;
    }
    __device__ __forceinline__ void a_ready(const Unit& u) const {
        if (ready == nullptr) return;
        if (threadIdx.x < 64) {
            const unsigned long long t0 = __builtin_amdgcn_s_memrealtime(); unsigned polls = 0;
            while ((unsigned)__builtin_amdgcn_readfirstlane(__hip_atomic_load(ready + 64 * u.pm, __ATOMIC_RELAXED, __HIP_MEMORY_SCOPE_AGENT)) < need) {
                if ((++polls & 255u) == 0u && __builtin_amdgcn_readfirstlane(__hip_atomic_load(tmo, __ATOMIC_RELAXED, __HIP_MEMORY_SCOPE_AGENT)) != 0u) break;
                if (__builtin_amdgcn_s_memrealtime() - t0 > 2000000ull) { if (threadIdx.x == 0) __hip_atomic_store(tmo, 1u, __ATOMIC_RELAXED, __HIP_MEMORY_SCOPE_AGENT); break; }
                __builtin_amdgcn_s_sleep(2); }
            asm volatile("s_waitcnt vmcnt(0)" ::: "memory");
        }
        asm volatile("" ::: "memory"); __builtin_amdgcn_s_barrier(); asm volatile("" ::: "memory");
    }
    __device__ __forceinline__ void done(const Unit&, int, bool) const {}
};

template <class Epi, class Sched, bool ALIGN_EPI = false, bool SP2 = false>
__device__ __forceinline__ void gemm_phase(PG8_LAS unsigned char* lds, const Gemm g, const Sched& S, const Epi& E) {
    const int tid = my_tid(), wid = __builtin_amdgcn_readfirstlane(tid >> 6), lane = tid & 63, wr = wid >> 2, wc = wid & 3, fr = lane & 15, fq = lane >> 4;
    const int K = g.K, nt = K / BK;
    unsigned voffA[2], voffB[2];
#pragma unroll
    for (int i = 0; i < 2; ++i) { int R, C; stage_rc(tid * 16 + i * 8192, R, C); const int Rb = Epi::PERM ? ((R & ~31) + perm32(R & 31)) : R;
        voffA[i] = (unsigned)(R * K + C) * 2u; voffB[i] = (unsigned)(Rb * K + C) * 2u; }
    const size_t kstep = (size_t)(BK * 2);
    const size_t hstep = (size_t)HALF * K * 2;
    const size_t tstep = 2 * hstep;
    const unsigned ldsw = (unsigned)wid * 1024u;
    const int aoff = lds_byte(wr * 64 + fr, fq * 8), boff = lds_byte(wc * 32 + fr, fq * 8);
#define PG8_SA(b, h) (((b) * 2 + (h)) * HTB)
#define PG8_SB(b, h) ((4 + (b) * 2 + (h)) * HTB)
#define PG8_STAGE(bufoff, gbase, voff) do { _Pragma("unroll") for (int _i = 0; _i < 2; ++_i) \
        __builtin_amdgcn_global_load_lds((const unsigned*)((const char*)(gbase) + (voff)[_i]), (PG8_LAS unsigned*)(lds + (bufoff) + ldsw + _i * 8192), 16, 0, 0); } while (0)
#define PG8_LDA(dst, b, h) do { _Pragma("unroll") for (int m = 0; m < 4; ++m) _Pragma("unroll") for (int k = 0; k < 2; ++k) dst[m][k] = *(const PG8_LAS bf16x8*)(lds + PG8_SA(b, h) + aoff + m * 2048 + k * 1024); } while (0)
#define PG8_LDB(dst, b, h) do { _Pragma("unroll") for (int n = 0; n < 2; ++n) _Pragma("unroll") for (int k = 0; k < 2; ++k) dst[n][k] = *(const PG8_LAS bf16x8*)(lds + PG8_SB(b, h) + boff + n * 2048 + k * 1024); } while (0)
#define PG8_MMA(ai, bj, At, Bt) do { __builtin_amdgcn_s_setprio(1); _Pragma("unroll") for (int m = 0; m < 4; ++m) _Pragma("unroll") for (int n = 0; n < 2; ++n) _Pragma("unroll") for (int k = 0; k < 2; ++k) \
        acc[ai][bj][m][n] = __builtin_amdgcn_mfma_f32_16x16x32_bf16(Bt[n][k], At[m][k], acc[ai][bj][m][n], 0, 0, 0); __builtin_amdgcn_s_setprio(0); } while (0)
#define PG8_WAIT_V(n) asm volatile("s_waitcnt vmcnt(" #n ")" ::: "memory")
#define PG8_WAIT_L(n) asm volatile("s_waitcnt lgkmcnt(" #n ")" ::: "memory")
#define PG8_BAR __builtin_amdgcn_s_barrier()
#define PG8_SCHED __builtin_amdgcn_sched_barrier(0)
    Unit cur, nxt; int ui = 0;
    if (!S.next(0, cur)) return;
    f32x4 acc[2][2][4][2];
#pragma unroll
    for (int a = 0; a < 2; ++a)
#pragma unroll
        for (int b = 0; b < 2; ++b)
#pragma unroll
            for (int m = 0; m < 4; ++m)
#pragma unroll
                for (int n = 0; n < 2; ++n) acc[a][b][m][n] = (f32x4){0.f, 0.f, 0.f, 0.f};
    bf16x8 At[4][2], B0[2][2], B1[2][2];
    const char* cA = (const char*)g.A + (size_t)cur.pm * tstep; const char* cB = (const char*)g.Bt + (size_t)cur.pn * tstep;
    S.a_ready(cur);
    if constexpr (SP2) {
        PG8_STAGE(PG8_SB(0, 0), cB, voffB); PG8_STAGE(PG8_SB(0, 1), cB + hstep, voffB); PG8_STAGE(PG8_SA(0, 0), cA, voffA); PG8_STAGE(PG8_SA(0, 1), cA + hstep, voffA);
        if (wr == 1) PG8_BAR;
        PG8_WAIT_V(2); PG8_BAR;
        PG8_STAGE(PG8_SB(1, 0), cB + kstep, voffB); PG8_STAGE(PG8_SA(1, 0), cA + kstep, voffA); PG8_STAGE(PG8_SB(1, 1), cB + hstep + kstep, voffB);
        PG8_WAIT_V(6); PG8_BAR;
    } else {
        PG8_STAGE(PG8_SB(0, 0), cB, voffB); PG8_STAGE(PG8_SA(0, 0), cA, voffA); PG8_STAGE(PG8_SB(0, 1), cB + hstep, voffB); PG8_STAGE(PG8_SA(0, 1), cA + hstep, voffA);
        if (wr == 1) PG8_BAR;
        PG8_WAIT_V(4); PG8_BAR;
        PG8_STAGE(PG8_SB(1, 0), cB + kstep, voffB); PG8_STAGE(PG8_SA(1, 0), cA + kstep, voffA); PG8_STAGE(PG8_SB(1, 1), cB + hstep + kstep, voffB);
        PG8_WAIT_V(6); PG8_BAR;
    }
    for (;;) {
        const bool has_next = S.next(ui + 1, nxt);
        const char* nA = has_next ? (const char*)g.A + (size_t)nxt.pm * tstep : cA; const char* nB = has_next ? (const char*)g.Bt + (size_t)nxt.pn * tstep : cB;
        for (int t = 0; t < nt; t += 2) {
            const bool last = (t == nt - 2);
            const char* a1 = cA + (size_t)(t + 1) * kstep;
            const char* a2 = last ? nA : cA + (size_t)(t + 2) * kstep; const char* b2 = last ? nB : cB + (size_t)(t + 2) * kstep;
            const char* a3 = a2 + kstep; const char* b3 = b2 + kstep;
            if (last && has_next) S.a_ready(nxt);
            if constexpr (SP2) {
            PG8_LDB(B0, 0, 0); PG8_LDB(B1, 0, 1); PG8_SCHED; PG8_LDA(At, 0, 0); PG8_STAGE(PG8_SA(1, 1), a1 + hstep, voffA);
            PG8_WAIT_V(8); PG8_WAIT_L(0); PG8_BAR; PG8_MMA(0, 0, At, B0); PG8_MMA(0, 1, At, B1); PG8_BAR; PG8_SCHED;
            PG8_LDA(At, 0, 1); PG8_STAGE(PG8_SB(0, 0), b2, voffB); PG8_STAGE(PG8_SB(0, 1), b2 + hstep, voffB); PG8_STAGE(PG8_SA(0, 0), a2, voffA);
            PG8_WAIT_V(8); PG8_WAIT_L(0); PG8_BAR; PG8_MMA(1, 0, At, B0); PG8_MMA(1, 1, At, B1); PG8_BAR; PG8_SCHED;
            PG8_LDB(B0, 1, 0); PG8_LDB(B1, 1, 1); PG8_SCHED; PG8_LDA(At, 1, 0); PG8_STAGE(PG8_SA(0, 1), a2 + hstep, voffA);
            PG8_WAIT_V(8); PG8_WAIT_L(0); PG8_BAR; PG8_MMA(0, 0, At, B0); PG8_MMA(0, 1, At, B1); PG8_BAR; PG8_SCHED;
            PG8_LDA(At, 1, 1); PG8_STAGE(PG8_SB(1, 0), b3, voffB); PG8_STAGE(PG8_SB(1, 1), b3 + hstep, voffB); PG8_STAGE(PG8_SA(1, 0), a3, voffA);
            PG8_WAIT_V(8); PG8_WAIT_L(0); PG8_BAR; PG8_MMA(1, 0, At, B0); PG8_MMA(1, 1, At, B1); PG8_BAR; PG8_SCHED;
            } else {
            PG8_LDB(B0, 0, 0); PG8_SCHED; PG8_LDA(At, 0, 0); PG8_STAGE(PG8_SA(1, 1), a1 + hstep, voffA);
            PG8_WAIT_L(8); PG8_BAR; PG8_WAIT_L(0); PG8_MMA(0, 0, At, B0); PG8_BAR; PG8_SCHED;
            PG8_LDB(B1, 0, 1); PG8_STAGE(PG8_SB(0, 0), b2, voffB);
            PG8_BAR; PG8_WAIT_L(0); PG8_MMA(0, 1, At, B1); PG8_BAR;
            PG8_LDA(At, 0, 1); PG8_STAGE(PG8_SA(0, 0), a2, voffA);
            PG8_BAR; PG8_WAIT_L(0); PG8_MMA(1, 0, At, B0); PG8_BAR; PG8_SCHED;
            PG8_STAGE(PG8_SB(0, 1), b2 + hstep, voffB);
            PG8_WAIT_V(6); PG8_BAR; PG8_MMA(1, 1, At, B1); PG8_BAR;
            PG8_LDB(B0, 1, 0); PG8_SCHED; PG8_LDA(At, 1, 0); PG8_STAGE(PG8_SA(0, 1), a2 + hstep, voffA);
            PG8_WAIT_L(8); PG8_BAR; PG8_WAIT_L(0); PG8_MMA(0, 0, At, B0); PG8_BAR; PG8_SCHED;
            PG8_LDB(B1, 1, 1); PG8_STAGE(PG8_SB(1, 0), b3, voffB);
            PG8_BAR; PG8_WAIT_L(0); PG8_MMA(0, 1, At, B1); PG8_BAR;
            PG8_LDA(At, 1, 1); PG8_STAGE(PG8_SA(1, 0), a3, voffA);
            PG8_BAR; PG8_WAIT_L(0); PG8_MMA(1, 0, At, B0); PG8_BAR; PG8_SCHED;
            PG8_STAGE(PG8_SB(1, 1), b3 + hstep, voffB);
            PG8_WAIT_V(6); PG8_BAR; PG8_MMA(1, 1, At, B1); PG8_BAR;
            }
        }
        if constexpr (ALIGN_EPI) { if (wr == 0) PG8_BAR; }
        if constexpr (!Epi::AFTER_DRAIN) { E(acc, cur, wr, wc, fr, fq); S.done(cur, ui, has_next); }
        if (!has_next) break;
#pragma unroll
        for (int a = 0; a < 2; ++a)
#pragma unroll
            for (int b = 0; b < 2; ++b)
#pragma unroll
                for (int m = 0; m < 4; ++m)
#pragma unroll
                    for (int n = 0; n < 2; ++n) acc[a][b][m][n] = (f32x4){0.f, 0.f, 0.f, 0.f};
        cur = nxt; cA = nA; cB = nB; ++ui;
        if constexpr (ALIGN_EPI) { if (wr == 1) PG8_BAR; }
    }
    PG8_WAIT_V(0);
    if constexpr (!ALIGN_EPI) { if (wr == 0) PG8_BAR; }
    PG8_BAR;
    if constexpr (Epi::AFTER_DRAIN) { E.fused(acc, cur, wr, wc, fr, fq, lds, wid, lane); S.done(cur, ui, false); }
#undef PG8_SA
#undef PG8_SB
#undef PG8_STAGE
#undef PG8_LDA
#undef PG8_LDB
#undef PG8_MMA
#undef PG8_WAIT_V
#undef PG8_WAIT_L
#undef PG8_BAR
#undef PG8_SCHED
}
}

constexpr size_t MiB = 1u << 20;
constexpr size_t WS_CTL = 0, CTL_ZERO_BYTES = 128 * 1024;
constexpr int CW_PANEL = 8192, PANEL_BANK = 144 * 64;
constexpr size_t WS_MOD = 1 * MiB;
constexpr size_t WS_ROPEA = 2 * MiB;
constexpr size_t WS_ROPEC = 2 * MiB + 512 * 1024;
constexpr size_t WS_WEIN = 3 * MiB, WS_WEOUT = 10 * MiB, WS_WOIN = 12 * MiB, WS_WUQ = 20 * MiB, WS_WUKV = 21 * MiB + 512 * 1024, WS_WOOUT = 22 * MiB;
constexpr size_t WS_H = 24 * MiB;
constexpr size_t WS_U = 96 * MiB;
constexpr size_t WS_Y = 168 * MiB;
constexpr size_t WS_R = 240 * MiB;
constexpr size_t WS_KVE = WS_R  , WS_QE = WS_R + 18 * MiB, WS_PE = WS_R + 54 * MiB, WS_GE = WS_R + 90 * MiB, WS_ZA = WS_R + 126 * MiB, WS_SSQY0 = WS_R + 241 * MiB  ;
constexpr size_t WS_CKV = WS_R, WS_CQ = WS_R + 18 * MiB, WS_HM = WS_R + 193 * MiB  , WS_MK = WS_R + 66 * MiB, WS_MV = WS_R + 84 * MiB, WS_KR = WS_R + 120 * MiB, WS_GATES = WS_R + 123 * MiB,
                 WS_SSQCKV = WS_R + 126 * MiB, WS_SSQCQ = WS_R + 127 * MiB, WS_X1 = WS_R + 129 * MiB  , WS_SSQY1 = WS_R + 126 * MiB  ;
constexpr size_t AUX_MQ = 0, AUX_MO = 16 * MiB, AUX_ZO = 48 * MiB;
constexpr size_t WS_KNV = WS_H  , WS_QO = WS_Y;
constexpr size_t WS_END = WS_R + 257 * MiB;
static_assert(WS_ZA + (size_t)MT * 512 * 2 <= WS_R + 162 * MiB && WS_X1 + (size_t)ML * 1024 * 2 <= WS_R + 241 * MiB && WS_HM + (size_t)2 * ML * 512 * 2 <= WS_END && WS_SSQY1 + (size_t)ML * 16 * 4 <= WS_X1 && WS_SSQY0 + (size_t)MT * 16 * 4 <= WS_END, "ws map");

__device__ __forceinline__ void st8(bf16_t* p, f32x4 a, f32x4 b) { u32x4 w; w.x = pk2(a[0], a[1]); w.y = pk2(a[2], a[3]); w.z = pk2(b[0], b[1]); w.w = pk2(b[2], b[3]); *(u32x4*)p = w; }
template <int AUX = 0>
__device__ __forceinline__ void st8b(__amdgpu_buffer_rsrc_t rs, unsigned byteoff, f32x4 a, f32x4 b) { u32x4 w; w.x = pk2(a[0], a[1]); w.y = pk2(a[2], a[3]); w.z = pk2(b[0], b[1]); w.w = pk2(b[2], b[3]);
    __builtin_amdgcn_raw_buffer_store_b128(w, rs, byteoff, 0, AUX); }
__device__ __forceinline__ bf16_t f2bf(float v) { return (bf16_t)(pk2(v, 0.f) & 0xffffu); }
__device__ __forceinline__ void rope8(f32x4& a, f32x4& b, const float* cosp, const float* sinp) {
    const f32x4 cs = *(const f32x4*)cosp, sn = *(const f32x4*)sinp;
    const float a0 = a[0] * cs[0] - a[1] * sn[0], a1 = a[0] * sn[0] + a[1] * cs[0], a2 = a[2] * cs[1] - a[3] * sn[1], a3 = a[2] * sn[1] + a[3] * cs[1];
    const float b0 = b[0] * cs[2] - b[1] * sn[2], b1 = b[0] * sn[2] + b[1] * cs[2], b2 = b[2] * cs[3] - b[3] * sn[3], b3 = b[2] * sn[3] + b[3] * cs[3];
    a = (f32x4){a0, a1, a2, a3}; b = (f32x4){b0, b1, b2, b3};
}
__device__ __forceinline__ f32x4 silu4(f32x4 v) { return (f32x4){silu_f(v[0]), silu_f(v[1]), silu_f(v[2]), silu_f(v[3])}; }
__device__ __forceinline__ f32x4 sigm4(f32x4 v) { return (f32x4){sigmoid_f(v[0]), sigmoid_f(v[1]), sigmoid_f(v[2]), sigmoid_f(v[3])}; }
__device__ __forceinline__ float sq4(f32x4 v) { return (v[0] * v[0] + v[1] * v[1]) + (v[2] * v[2] + v[3] * v[3]); }

struct EpiEin {
    static constexpr bool PERM = true, AFTER_DRAIN = false;
    unsigned char* ws;
    __device__ __forceinline__ void operator()(const f32x4 (&acc)[2][2][4][2], const pg8::Unit& u, int wr, int wc, int fr, int fq) const {
        const int pn = u.pn, rbase = u.pm * 256 + wr * 64 + fr, cw = wc * 32 + 8 * fq;
        const __amdgpu_buffer_rsrc_t rsw = __builtin_amdgcn_make_buffer_rsrc((void*)ws, 0, (unsigned)WS_END, 0x00020000);
        const float* ropeA = (const float*)(ws + WS_ROPEA);
#pragma unroll
        for (int ai = 0; ai < 2; ++ai)
#pragma unroll
            for (int m = 0; m < 4; ++m) {
                asm volatile("" ::: "memory"); const int R = rbase + ai * 128 + m * 16; const bool lat = R < ML; const int pos = R & 2047;
                if (pn == 0) {
                    f32x4 a = acc[ai][0][m][0], b = acc[ai][0][m][1];
                    if (lat) { const int i0 = (cw & 63) >> 1; rope8(a, b, ropeA + pos * 64 + i0, ropeA + pos * 64 + 32 + i0); }
                    st8b(rsw, (unsigned)(WS_KVE) + ((unsigned)R * 256 + cw) * 2u, a, b);
                    st8b(rsw, (unsigned)(WS_KVE) + ((unsigned)R * 256 + 128 + cw) * 2u, acc[ai][1][m][0], acc[ai][1][m][1]);
                } else if (pn <= 2) {
#pragma unroll
                    for (int bj = 0; bj < 2; ++bj) {
                        f32x4 a = acc[ai][bj][m][0], b = acc[ai][bj][m][1];
                        if (lat) { const int i0 = (cw & 63) >> 1; rope8(a, b, ropeA + pos * 64 + i0, ropeA + pos * 64 + 32 + i0); }
                        const float sc = 0.125f * LOG2E; a = a * sc; b = b * sc;
                        st8b(rsw, (unsigned)(WS_QE) + ((unsigned)R * 512 + (pn - 1) * 256 + bj * 128 + cw) * 2u, a, b);
                    }
                } else if (pn <= 6) {
                    st8b(rsw, (unsigned)(WS_PE) + ((unsigned)R * 512 + (pn - 3) * 128 + cw) * 2u, acc[ai][0][m][0] * acc[ai][1][m][0], acc[ai][0][m][1] * acc[ai][1][m][1]);
                } else if (pn <= 10) {
                    st8b(rsw, (unsigned)(WS_GE) + ((unsigned)R * 512 + (pn - 7) * 128 + cw) * 2u, acc[ai][0][m][0] * silu4(acc[ai][1][m][0]), acc[ai][0][m][1] * silu4(acc[ai][1][m][1]));
                } else {
#pragma unroll
                    for (int bj = 0; bj < 2; ++bj)
                        st8b(rsw, (unsigned)(WS_ZA) + ((unsigned)R * 512 + (pn - 11) * 256 + bj * 128 + cw) * 2u, silu4(acc[ai][bj][m][0]), silu4(acc[ai][bj][m][1]));
                }
            }
    }
};

struct EpiY {
    static constexpr bool PERM = true, AFTER_DRAIN = false;
    bf16_t* Y; float* SSQ;
    __device__ __forceinline__ void operator()(const f32x4 (&acc)[2][2][4][2], const pg8::Unit& u, int wr, int wc, int fr, int fq) const {
        const int pn = u.pn, rbase = u.pm * 256 + wr * 64 + fr, cw = wc * 32 + 8 * fq;
#pragma unroll
        for (int ai = 0; ai < 2; ++ai)
#pragma unroll
            for (int m = 0; m < 4; ++m) {
                asm volatile("" ::: "memory"); const int R = rbase + ai * 128 + m * 16; float s = 0.f;
#pragma unroll
                for (int bj = 0; bj < 2; ++bj) { st8(Y + (size_t)R * 1024 + pn * 256 + bj * 128 + cw, acc[ai][bj][m][0], acc[ai][bj][m][1]); s += sq4(acc[ai][bj][m][0]) + sq4(acc[ai][bj][m][1]); }
                s += __shfl_xor(s, 16); s += __shfl_xor(s, 32);
                if (fq == 0) SSQ[(size_t)R * 16 + pn * 4 + wc] = s;
            }
    }
};

struct EpiYW {
    static constexpr bool PERM = true, AFTER_DRAIN = false;
    unsigned char* ws;
    __device__ __forceinline__ void operator()(const f32x4 (&acc)[2][2][4][2], const pg8::Unit& u, int wr, int wc, int fr, int fq) const {
        const int pn = u.pn, rbase = u.pm * 256 + wr * 64 + fr, cw = wc * 32 + 8 * fq;
        const __amdgpu_buffer_rsrc_t rsw = __builtin_amdgcn_make_buffer_rsrc((void*)ws, 0, (unsigned)WS_END, 0x00020000);
#pragma unroll
        for (int ai = 0; ai < 2; ++ai)
#pragma unroll
            for (int m = 0; m < 4; ++m) {
                asm volatile("" ::: "memory"); const int R = rbase + ai * 128 + m * 16; float s = 0.f;
#pragma unroll
                for (int bj = 0; bj < 2; ++bj) { st8b<16>(rsw, (unsigned)(WS_Y) + ((unsigned)R * 1024 + pn * 256 + bj * 128 + cw) * 2u, acc[ai][bj][m][0], acc[ai][bj][m][1]); s += sq4(acc[ai][bj][m][0]) + sq4(acc[ai][bj][m][1]); }
                s += __shfl_xor(s, 16); s += __shfl_xor(s, 32);
                if (fq == 0) __builtin_amdgcn_raw_buffer_store_b32(__float_as_uint(s), rsw, (unsigned)(WS_SSQY0) + ((unsigned)R * 16 + pn * 4 + wc) * 4u, 0, 16);
            }
    }
};

struct EpiOin {
    static constexpr bool PERM = true, AFTER_DRAIN = false;
    unsigned char* ws; unsigned char* aux;
    __device__ __forceinline__ void operator()(const f32x4 (&acc)[2][2][4][2], const pg8::Unit& u, int wr, int wc, int fr, int fq) const {
        const int pn = u.pn, rbase = u.pm * 256 + wr * 64 + fr, cw = wc * 32 + 8 * fq;
        const __amdgpu_buffer_rsrc_t rsw = __builtin_amdgcn_make_buffer_rsrc((void*)ws, 0, (unsigned)WS_END, 0x00020000), rsa = __builtin_amdgcn_make_buffer_rsrc((void*)aux, 0, 128u << 20, 0x00020000);
        const float* ropeC = (const float*)(ws + WS_ROPEC);
#pragma unroll
        for (int ai = 0; ai < 2; ++ai)
#pragma unroll
            for (int m = 0; m < 4; ++m) {
                asm volatile("" ::: "memory"); const int R = rbase + ai * 128 + m * 16; const bool lat = R < ML; const int pos = R & 2047;
                if (pn == 0 || (pn >= 5 && pn <= 7)) {
                    float s = 0.f;
                    const unsigned dsto = (pn == 0) ? (unsigned)(WS_CKV) + (unsigned)R * 512u : (unsigned)(WS_CQ) + ((unsigned)R * 768u + (pn - 5) * 256) * 2u;
#pragma unroll
                    for (int bj = 0; bj < 2; ++bj) { st8b(rsw, dsto + (bj * 128 + cw) * 2u, acc[ai][bj][m][0], acc[ai][bj][m][1]); s += sq4(acc[ai][bj][m][0]) + sq4(acc[ai][bj][m][1]); }
                    s += __shfl_xor(s, 16); s += __shfl_xor(s, 32);
                    if (fq == 0) { if (pn == 0) ((float*)(ws + WS_SSQCKV))[(size_t)R * 4 + wc] = s; else ((float*)(ws + WS_SSQCQ))[(size_t)R * 12 + (pn - 5) * 4 + wc] = s; }
                } else if (pn == 4) {
                    if (wc == 0) {
                        f32x4 a = acc[ai][0][m][0], b = acc[ai][0][m][1];
                        if (lat) { const int i0 = cw >> 1; rope8(a, b, ropeC + pos * 32 + i0, ropeC + pos * 32 + 16 + i0); }
                        st8b(rsw, (unsigned)(WS_KR) + ((unsigned)R * 32 + cw) * 2u, a, b);
                    } else if (wc == 1 && fq < 2) {
                        float* g = (float*)(ws + WS_GATES) + (size_t)R * 16 + 8 * fq;
                        *(f32x4*)g = acc[ai][0][m][0]; *(f32x4*)(g + 4) = acc[ai][0][m][1];
                    }
                } else {
#pragma unroll
                    for (int bj = 0; bj < 2; ++bj) {
                        const f32x4 a = acc[ai][bj][m][0], b = acc[ai][bj][m][1]; const int col = bj * 128 + cw;
                        if (pn == 1) st8b(rsw, (unsigned)(WS_MK) + ((unsigned)R * 256 + col) * 2u, a * 0.125f, b * 0.125f);
                        else if (pn <= 3) st8b(rsw, (unsigned)(WS_MV) + ((unsigned)R * 512 + (pn - 2) * 256 + col) * 2u, a, b);
                        else if (pn == 8) st8b(rsa, (unsigned)(AUX_MQ) + ((unsigned)R * 256 + col) * 2u, a, b);
                        else if (pn >= 13) st8b(rsa, (unsigned)(AUX_ZO) + ((unsigned)R * 512 + (pn - 13) * 256 + col) * 2u, silu4(a), silu4(b));
                        else if (bj == 0) st8b(rsa, (unsigned)(AUX_MO) + ((unsigned)R * 512 + (pn - 9) * 128 + cw) * 2u, sigm4(a) * silu4(acc[ai][1][m][0]), sigm4(b) * silu4(acc[ai][1][m][1]));
                    }
                }
            }
    }
};

struct EpiUkv {
    static constexpr bool PERM = true, AFTER_DRAIN = false;
    unsigned char* ws;
    __device__ __forceinline__ void operator()(const f32x4 (&acc)[2][2][4][2], const pg8::Unit& u, int wr, int wc, int fr, int fq) const {
        const int pn = u.pn, rbase = u.pm * 256 + wr * 64 + fr, cw = wc * 32 + 8 * fq;
#pragma unroll
        for (int ai = 0; ai < 2; ++ai)
#pragma unroll
            for (int m = 0; m < 4; ++m) {
                asm volatile("" ::: "memory"); const int R = rbase + ai * 128 + m * 16;
                const f32x4 sp = *(const f32x4*)((const float*)(ws + WS_SSQCKV) + (size_t)R * 4);
                const float rstd = rsqrtf(((sp[0] + sp[1]) + (sp[2] + sp[3])) * (1.f / 256.f) + EPS);
                int b, pos; if (R < ML) { b = R >> 11; pos = 256 + (R & 2047); } else { const int rc = R - ML; b = rc >> 8; pos = rc & 255; }
#pragma unroll
                for (int bj = 0; bj < 2; ++bj) {
                    const int head = pn * 2 + bj;
                    st8((bf16_t*)(ws + WS_KNV) + ((size_t)(b * 8 + head) * 2304 + pos) * 128 + cw, acc[ai][bj][m][0] * rstd, acc[ai][bj][m][1] * rstd);
                }
            }
    }
};

struct EpiUq {
    static constexpr bool PERM = true, AFTER_DRAIN = false;
    unsigned char* ws; LAS unsigned char* lds;
    __device__ __forceinline__ void operator()(const f32x4 (&acc)[2][2][4][2], const pg8::Unit& u, int wr, int wc, int fr, int fq) const {
        const int pn = u.pn, rbase = u.pm * 256 + wr * 64 + fr, cw = wc * 32 + 8 * fq;
        const float* ropeC = (const float*)(ws + WS_ROPEC);
        LAS float* rt = (LAS float*)(lds + pg8::STAGE_BYTES + 8192);
        { const int t = (wr * 4 + wc) * 64 + fq * 16 + fr;
          if (t < 256) { const float* sp = (const float*)(ws + WS_SSQCQ) + (size_t)(u.pm * 256 + t) * 12;
              const f32x4 s0 = *(const f32x4*)sp, s1 = *(const f32x4*)(sp + 4), s2 = *(const f32x4*)(sp + 8);
              const float ss = (((s0[0] + s0[1]) + (s0[2] + s0[3])) + ((s1[0] + s1[1]) + (s1[2] + s1[3]))) + ((s2[0] + s2[1]) + (s2[2] + s2[3]));
              rt[t] = rsqrtf(ss * (1.f / 768.f) + EPS) * (0.10206207261596575f * LOG2E); }
          asm volatile("s_waitcnt lgkmcnt(0)" ::: "memory"); __builtin_amdgcn_s_barrier(); asm volatile("" ::: "memory"); }
#pragma unroll
        for (int ai = 0; ai < 2; ++ai)
#pragma unroll
            for (int m = 0; m < 4; ++m) {
                asm volatile("" ::: "memory"); const int R = rbase + ai * 128 + m * 16, pos = R & 2047;
                const float sc = rt[wr * 64 + fr + ai * 128 + m * 16];
#pragma unroll
                for (int bj = 0; bj < 2; ++bj) {
                    const int c = pn * 256 + bj * 128 + cw, head = c / 96, dd = c - head * 96;
                    f32x4 a = acc[ai][bj][m][0], b = acc[ai][bj][m][1];
                    if (dd >= 64) { const int i0 = (dd - 64) >> 1; rope8(a, b, ropeC + pos * 32 + i0, ropeC + pos * 32 + 16 + i0); }
                    st8((bf16_t*)(ws + WS_QO) + (size_t)R * 768 + c, a * sc, b * sc);
                }
            }
    }
};

#define RLX_AGENT __ATOMIC_RELAXED, __HIP_MEMORY_SCOPE_AGENT
#define XB_TMO      128
#define XB_XCNT(j)  (256  + 64 * (j))
#define XB_XSUB(j)  (1280 + 64 * (j))
#define XB_XGEN(j)  (2304 + 64 * (j))
#define XB_TOP      3328
#define XB_TOPGEN   3392
#define XCD_BAR_WORDS 3456
#define XB_SPIN_CAP (1u << 18)

__device__ __forceinline__ unsigned xb_ld(unsigned* p)              { return __hip_atomic_load(p, __ATOMIC_RELAXED, __HIP_MEMORY_SCOPE_AGENT); }
__device__ __forceinline__ unsigned xb_add(unsigned* p, unsigned v) { return __hip_atomic_fetch_add(p, v, __ATOMIC_RELAXED, __HIP_MEMORY_SCOPE_AGENT); }
__device__ __forceinline__ unsigned xb_xcc_id() { return (unsigned)__builtin_amdgcn_s_getreg((3 << 11) | 20) & 0xFu; }
#define XB_SPIN(cond, bar) do { unsigned _sp = 0; while (cond) { __builtin_amdgcn_s_sleep(1); \
    if ((++_sp & 255u) == 0u) { if (xb_ld(&(bar)[XB_TMO])) break; if (_sp > XB_SPIN_CAP) { atomicAdd(&(bar)[XB_TMO], 1u); break; } } } } while (0)

struct XcdBarrier {
    unsigned* bar; unsigned x;
    volatile LAS unsigned* st;
};

__device__ __forceinline__ XcdBarrier xcd_barrier_post(unsigned* bar, volatile LAS unsigned* st) {
    XcdBarrier b; b.bar = bar; b.x = xb_xcc_id(); b.st = st;
    if (threadIdx.x == 0) (void)xb_add(&bar[XB_XCNT(b.x)], 1u);
    return b;
}
__device__ __forceinline__ void xcd_barrier_complete(unsigned* bar, unsigned x, unsigned& nloc, unsigned& nx) {
    const unsigned G = gridDim.x * gridDim.y * gridDim.z;
    unsigned sum, cnt, mine, sp = 0u;
    for (;;) {
        sum = 0u; cnt = 0u; mine = 0u;
#pragma unroll
        for (unsigned j = 0; j < 16; ++j) { const unsigned c = xb_ld(&bar[XB_XCNT(j)]); sum += c; cnt += (c > 0u) ? 1u : 0u; mine = (j == x) ? c : mine; }
        if (sum == G) break;
        __builtin_amdgcn_s_sleep(1);
        if ((++sp & 255u) == 0u) { if (xb_ld(&bar[XB_TMO])) break; if (sp > XB_SPIN_CAP) { atomicAdd(&bar[XB_TMO], 1u); break; } }
    }
    nloc = mine > 0u ? mine : 1u; nx = cnt > 0u ? cnt : 1u;
}

__device__ __forceinline__ void xcd_barrier_arrive(const XcdBarrier& b) {
    asm volatile("s_waitcnt vmcnt(0)" ::: "memory");
    __syncthreads();
    if (threadIdx.x == 0) {
        unsigned* bar = b.bar;
        __builtin_amdgcn_s_waitcnt(0);
        unsigned nloc = b.st[0], nx = b.st[1];
        if (nloc == 0u) { xcd_barrier_complete(bar, b.x, nloc, nx); b.st[0] = nloc; b.st[1] = nx; }
        const unsigned old = xb_add(&bar[XB_XSUB(b.x)], 1u);
        asm volatile("buffer_inv sc1" ::: "memory");
        const unsigned gen = old / nloc;
        if (old + 1u == (gen + 1u) * nloc) {
            __builtin_amdgcn_fence(__ATOMIC_RELEASE, "agent");
            asm volatile("s_waitcnt vmcnt(0)" ::: "memory");
            (void)xb_add(&bar[XB_TOP], 1u);
        }
        b.st[2] = (gen + 1u) * nx;
    }
}
__device__ __forceinline__ void xcd_barrier_wait(const XcdBarrier& b) {
    if (threadIdx.x == 0) {
        unsigned* bar = b.bar; const unsigned target = b.st[2];
        XB_SPIN((int)(xb_ld(&bar[XB_TOP]) - target) < 0, bar);
        asm volatile("buffer_inv sc1\n\ts_waitcnt vmcnt(0)" ::: "memory");
    }
    __syncthreads();
}
__device__ __forceinline__ void xcd_barrier(const XcdBarrier& b) {
    asm volatile("s_waitcnt vmcnt(0)" ::: "memory");
    __syncthreads();
    if (threadIdx.x == 0) {
        unsigned* bar = b.bar;
        __builtin_amdgcn_s_waitcnt(0);
        unsigned nloc = b.st[0], nx = b.st[1];
        if (nloc == 0u) { xcd_barrier_complete(bar, b.x, nloc, nx); b.st[0] = nloc; b.st[1] = nx; }
        const unsigned old = xb_add(&bar[XB_XSUB(b.x)], 1u);
        asm volatile("buffer_inv sc1" ::: "memory");
        const unsigned gen = old / nloc;
        if (old + 1u == (gen + 1u) * nloc) {
            __builtin_amdgcn_fence(__ATOMIC_RELEASE, "agent");
            asm volatile("s_waitcnt vmcnt(0)" ::: "memory");
            (void)xb_add(&bar[XB_TOP], 1u);
        }
        const unsigned target = (gen + 1u) * nx;
        XB_SPIN((int)(xb_ld(&bar[XB_TOP]) - target) < 0, bar);
        asm volatile("s_waitcnt vmcnt(0)" ::: "memory");
    }
    __syncthreads();
}

__device__ __forceinline__ int crow(int r, int hi) { return (r & 3) + 8 * (r >> 2) + 4 * hi; }
typedef short v4i16_t __attribute__((ext_vector_type(4)));
__device__ __forceinline__ s16x4 vtr(const LAS unsigned char* p) { return __builtin_bit_cast(s16x4, __builtin_amdgcn_ds_read_tr16_b64_v4i16((LAS v4i16_t*)p)); }

template <int MODE>
__device__ __forceinline__ void attn_unit(LAS unsigned char* lds, unsigned char* ws, unsigned char* aux, const float* sink, int unit) {
    constexpr int DQK = (MODE == 2) ? 96 : 64, KST = DQK / 16, KS = DQK * 2 + 16, VS = 192, KBUF = 64 * KS, VBUF = 64 * VS;
    const int tid = my_tid(), lane = tid & 63, wid = __builtin_amdgcn_readfirstlane(tid >> 6), r32 = lane & 31, hi = lane >> 5;
    int b, head, hkv = 0, n = 0, Rq0, qpos0 = 0, nt, jlo = 0;
    const bf16_t* Qp; int qstride;
    if (MODE == 0) {
        const int hp = unit & 1; n = (unit >> 1) & 15; hkv = (unit >> 5) & 1; b = unit >> 6;
        head = hkv * 4 + hp * 2 + (wid >> 2); qpos0 = 128 * n + 32 * (wid & 3); Rq0 = b * 2048 + qpos0;
        Qp = (const bf16_t*)(ws + WS_QE) + (size_t)Rq0 * 512 + head * 64; qstride = 512;
        jlo = (n == 0) ? 2 : 0; const int jhi = (n == 15) ? 4 : 6; nt = 4 + (jhi - jlo);
    } else if (MODE == 1) {
        const int qh = unit & 1, hp = (unit >> 1) & 1; hkv = (unit >> 2) & 1; b = unit >> 3;
        head = hkv * 4 + hp * 2 + (wid >> 2); Rq0 = ML + b * 256 + 128 * qh + 32 * (wid & 3);
        Qp = (const bf16_t*)(ws + WS_QE) + (size_t)Rq0 * 512 + head * 64; qstride = 512; nt = 4;
    } else {
        const int qb = unit & 7; head = (unit >> 3) & 7; b = unit >> 6; Rq0 = b * 2048 + 256 * qb + 32 * wid;
        Qp = (const bf16_t*)(ws + WS_QO) + (size_t)Rq0 * 768 + head * 96; qstride = 768; nt = 36;
    }
    bf16x8 qf[KST];
#pragma unroll
    for (int s = 0; s < KST; ++s) qf[s] = *(const bf16x8*)(Qp + (size_t)r32 * qstride + 16 * s + 8 * hi);
    constexpr float THR = 6.0f;
    float mref, l_run;
    if (MODE == 2) { mref = 0.f; l_run = 0.f; } else { mref = sink[head] * LOG2E; l_run = (hi == 0) ? 1.f : 0.f; }
    f32x16 negm;
#pragma unroll
    for (int r = 0; r < 16; ++r) negm[r] = -mref;
    f32x16 o0, o1;
#pragma unroll
    for (int r = 0; r < 16; ++r) { o0[r] = 0.f; o1[r] = 0.f; }

    const int srow = tid >> 3, sch = tid & 7;
    const int voff = (4 * hi + ((lane & 15) >> 2)) * VS + (((lane >> 4) & 1) * 16 + 4 * (lane & 3)) * 2;
    u32x4 kregA, vregA, kreg2A, kregB, vregB, kreg2B;
    kreg2A = (u32x4){0u, 0u, 0u, 0u}; kreg2B = kreg2A;
#define ATT_SRC(t, kp, vp, k2p, kpos0v) do { \
        if (MODE == 0 || MODE == 1) { \
            if ((t) < 4) { kp = (const bf16_t*)(ws + WS_KVE) + (size_t)(ML + b * 256 + 64 * (t) + srow) * 256 + hkv * 64 + sch * 8; kpos0v = -100000; } \
            else { const int kp0_ = 128 * n - 128 + 64 * (jlo + (t) - 4); kpos0v = kp0_; \
                   kp = (const bf16_t*)(ws + WS_KVE) + (size_t)(b * 2048 + kp0_ + srow) * 256 + hkv * 64 + sch * 8; } \
            vp = kp + 128; k2p = kp; \
        } else { \
            const int pos0_ = 64 * (t); kpos0v = -100000; \
            kp = (const bf16_t*)(ws + WS_KNV) + ((size_t)(b * 8 + head) * 2304 + pos0_ + srow) * 128 + sch * 8; \
            vp = kp + 64; \
            const int krow_ = ((t) < 4) ? (ML + b * 256 + pos0_) : (b * 2048 + pos0_ - 256); \
            k2p = (const bf16_t*)(ws + WS_KR) + (size_t)(krow_ + (tid >> 2)) * 32 + (tid & 3) * 8; \
        } } while (0)
#define ATT_LOAD(t, KR_, VR_, K2_) do { const bf16_t *kp_, *vp_, *k2p_; int kq_; ATT_SRC(t, kp_, vp_, k2p_, kq_); (void)kq_; \
        KR_ = *(const u32x4*)kp_; VR_ = *(const u32x4*)vp_; if (MODE == 2 && tid < 256) K2_ = *(const u32x4*)k2p_; } while (0)
#define ATT_STORE(buf, KR_, VR_, K2_) do { LAS unsigned char* kb_ = lds + (buf) * KBUF; LAS unsigned char* vb_ = lds + 4 * KBUF + (buf) * VBUF; \
        *(LAS u32x4*)(kb_ + srow * KS + sch * 16) = KR_; \
        if (MODE == 2 && tid < 256) *(LAS u32x4*)(kb_ + (tid >> 2) * KS + 128 + (tid & 3) * 16) = K2_; \
        *(LAS u32x4*)(vb_ + srow * VS + sch * 16) = VR_; } while (0)
#define ATT_BARRIER() do { asm volatile("s_waitcnt lgkmcnt(0)" ::: "memory"); __builtin_amdgcn_s_barrier(); asm volatile("" ::: "memory"); } while (0)

#define ATT_COMPUTE(TT) do { const int buf = (TT) & 3; \
        int kpos0 = -100000; \
        if (MODE == 0 && (TT) >= 4) kpos0 = 128 * n - 128 + 64 * (jlo + (TT) - 4); \
        bool active = true; \
        if (MODE == 0 && (TT) >= 4) active = (kpos0 + 63 >= qpos0 - 128) && (kpos0 <= qpos0 + 31 + 128); \
        if (active) { \
            const LAS unsigned char* kb = lds + buf * KBUF; const LAS unsigned char* vb = lds + 4 * KBUF + buf * VBUF; \
            f32x16 p0 = negm, p1 = negm; \
_Pragma("unroll") \
            for (int s = 0; s < KST; ++s) { \
                const bf16x8 a0 = *(const LAS bf16x8*)(kb + r32 * KS + (16 * s + 8 * hi) * 2); \
                const bf16x8 a1 = *(const LAS bf16x8*)(kb + (32 + r32) * KS + (16 * s + 8 * hi) * 2); \
                p0 = __builtin_amdgcn_mfma_f32_32x32x16_bf16(a0, qf[s], p0, 0, 0, 0); \
                p1 = __builtin_amdgcn_mfma_f32_32x32x16_bf16(a1, qf[s], p1, 0, 0, 0); \
            } \
            if (MODE == 0 && (TT) >= 4 && !((kpos0 >= qpos0 - 97) && (kpos0 <= qpos0 + 65))) {     \
                const int qpos = qpos0 + r32; \
_Pragma("unroll") \
                for (int r = 0; r < 16; ++r) { const int d0 = kpos0 + crow(r, hi) - qpos, d1 = d0 + 32; \
                    if (d0 > 128 || d0 < -128) p0[r] = -INFINITY; if (d1 > 128 || d1 < -128) p1[r] = -INFINITY; } \
            } \
            float mxa = __builtin_fmaxf(__builtin_fmaxf(p0[0], p0[1]), p1[0]), mxb = __builtin_fmaxf(__builtin_fmaxf(p0[2], p0[3]), p1[1]); \
            mxa = __builtin_fmaxf(__builtin_fmaxf(mxa, p1[2]), p1[3]); \
_Pragma("unroll") \
            for (int r = 4; r < 16; r += 4) { mxa = __builtin_fmaxf(__builtin_fmaxf(mxa, p0[r]), p0[r + 1]); mxb = __builtin_fmaxf(__builtin_fmaxf(mxb, p0[r + 2]), p0[r + 3]); \
                mxa = __builtin_fmaxf(__builtin_fmaxf(mxa, p1[r]), p1[r + 1]); mxb = __builtin_fmaxf(__builtin_fmaxf(mxb, p1[r + 2]), p1[r + 3]); } \
            float mx = __builtin_fmaxf(mxa, mxb); \
            mx = __builtin_fmaxf(mx, __shfl_xor(mx, 32)); \
            const bool first = (MODE == 2) && ((TT) == 0); \
            if (first || __any(mx > THR)) { \
                const float delta = first ? mx : __builtin_fmaxf(mx, 0.f), alpha = first ? 1.f : __builtin_amdgcn_exp2f(-delta); \
                mref += delta; l_run *= alpha; \
_Pragma("unroll") \
                for (int r = 0; r < 16; ++r) { o0[r] *= alpha; o1[r] *= alpha; p0[r] -= delta; p1[r] -= delta; negm[r] = -mref; } \
            } \
            float rs0 = 0.f, rs1 = 0.f; \
_Pragma("unroll") \
            for (int r = 0; r < 16; ++r) { p0[r] = __builtin_amdgcn_exp2f(p0[r]); p1[r] = __builtin_amdgcn_exp2f(p1[r]); rs0 += p0[r]; rs1 += p1[r]; } \
            l_run += rs0 + rs1; \
            u32x4 pw[4]; \
            pw[0] = (u32x4){pk2(p0[0], p0[1]), pk2(p0[2], p0[3]), pk2(p0[4], p0[5]), pk2(p0[6], p0[7])}; \
            pw[1] = (u32x4){pk2(p0[8], p0[9]), pk2(p0[10], p0[11]), pk2(p0[12], p0[13]), pk2(p0[14], p0[15])}; \
            pw[2] = (u32x4){pk2(p1[0], p1[1]), pk2(p1[2], p1[3]), pk2(p1[4], p1[5]), pk2(p1[6], p1[7])}; \
            pw[3] = (u32x4){pk2(p1[8], p1[9]), pk2(p1[10], p1[11]), pk2(p1[12], p1[13]), pk2(p1[14], p1[15])}; \
_Pragma("unroll") \
            for (int s2 = 0; s2 < 4; ++s2) { \
                const bf16x8 pb = __builtin_bit_cast(bf16x8, pw[s2]); \
                const LAS unsigned char* va0 = vb + (16 * s2) * VS + voff; \
                const s16x4 l0 = vtr(va0), h0 = vtr(va0 + 8 * VS), l1 = vtr(va0 + 64), h1 = vtr(va0 + 8 * VS + 64); \
                const bf16x8 v0 = (bf16x8){l0[0], l0[1], l0[2], l0[3], h0[0], h0[1], h0[2], h0[3]}; \
                const bf16x8 v1 = (bf16x8){l1[0], l1[1], l1[2], l1[3], h1[0], h1[1], h1[2], h1[3]}; \
                o0 = __builtin_amdgcn_mfma_f32_32x32x16_bf16(v0, pb, o0, 0, 0, 0); \
                o1 = __builtin_amdgcn_mfma_f32_32x32x16_bf16(v1, pb, o1, 0, 0, 0); \
            } \
        } \
        } while (0)

    ATT_LOAD(0, kregA, vregA, kreg2A); ATT_LOAD(1, kregB, vregB, kreg2B);
    ATT_STORE(0, kregA, vregA, kreg2A); ATT_STORE(1, kregB, vregB, kreg2B);
    if (2 < nt) { ATT_LOAD(2, kregA, vregA, kreg2A); ATT_LOAD(3, kregB, vregB, kreg2B); }
    ATT_BARRIER();
    const int Rq = Rq0 + r32;
    const bf16_t* zrow = (MODE == 2) ? (const bf16_t*)(aux + AUX_ZO) + (size_t)Rq * 512 + head * 64 : (const bf16_t*)(ws + WS_ZA) + (size_t)Rq * 512 + head * 64;
    u32x2 zz[8];
#pragma unroll
    for (int g = 0; g < 8; ++g) zz[g] = (u32x2){0u, 0u};
    for (int t = 0; t < nt; t += 2) {
        if (t + 2 >= nt) {
#pragma unroll
            for (int g = 0; g < 4; ++g) { zz[2 * g] = *(const u32x2*)(zrow + 8 * g + 4 * hi); zz[2 * g + 1] = *(const u32x2*)(zrow + 32 + 8 * g + 4 * hi); } }
        ATT_COMPUTE(t);
        ATT_COMPUTE(t + 1);
        if (t + 2 < nt) { ATT_STORE((t + 2) & 3, kregA, vregA, kreg2A); ATT_STORE((t + 3) & 3, kregB, vregB, kreg2B); }
        if (t + 4 < nt) { ATT_LOAD(t + 4, kregA, vregA, kreg2A); ATT_LOAD(t + 5, kregB, vregB, kreg2B); }
        ATT_BARRIER();
    }
#undef ATT_COMPUTE
#undef ATT_BARRIER
#undef ATT_SRC
#undef ATT_LOAD
#undef ATT_STORE
    const float l_tot = l_run + __shfl_xor(l_run, 32), inv = __builtin_amdgcn_rcpf(l_tot);
    bf16_t* urow = (bf16_t*)(ws + WS_U) + (size_t)Rq * 1024 + head * 64;
#pragma unroll
    for (int g = 0; g < 4; ++g) {
        const int dv = 8 * g + 4 * hi;
        { const u32x2 z = zz[2 * g];
          u32x2 w; w.x = pk2(o0[4 * g] * inv * bf_lo(z.x), o0[4 * g + 1] * inv * bf_hi(z.x)); w.y = pk2(o0[4 * g + 2] * inv * bf_lo(z.y), o0[4 * g + 3] * inv * bf_hi(z.y));
          *(u32x2*)(urow + dv) = w; }
        { const u32x2 z = zz[2 * g + 1];
          u32x2 w; w.x = pk2(o1[4 * g] * inv * bf_lo(z.x), o1[4 * g + 1] * inv * bf_hi(z.x)); w.y = pk2(o1[4 * g + 2] * inv * bf_lo(z.y), o1[4 * g + 3] * inv * bf_hi(z.y));
          *(u32x2*)(urow + 32 + dv) = w; }
    }
}


__device__ __forceinline__ int srcmap(int mat, int dn) {
    if (mat == 0) {
        if (dn < 128) { const int d = dn & 63; return (dn & 64) + (d >> 1) + 32 * (d & 1); }
        if (dn < 256) return dn;
        if (dn < 768) { const int j = dn - 256, d = j & 63; return 256 + (j & ~63) + (d >> 1) + 32 * (d & 1); }
        if (dn < 1792) { const int j = dn - 768, blk = j >> 8, w = j & 255; return (w < 128) ? 1280 + blk * 128 + w : 1792 + blk * 128 + (w - 128); }
        if (dn < 2816) { const int j = dn - 1792, blk = j >> 8, w = j & 255; return (w < 128) ? 768 + blk * 128 + w : 2816 + blk * 128 + (w - 128); }
        return 2304 + (dn - 2816);
    }
    if (mat == 2) {
        if (dn < 256) return dn;
        if (dn < 512) return 288 + (dn - 256);
        if (dn < 1024) return 544 + (dn - 512);
        if (dn < 1280) { const int w = dn - 1024; if (w < 32) return 256 + (w >> 1) + 16 * (w & 1); if (w < 48) return 1056 + (w - 32); return -1; }
        if (dn < 2048) return 1072 + (dn - 1280);
        if (dn < 2304) return 1840 + (dn - 2048);
        if (dn < 3328) { const int j = dn - 2304, blk = j >> 8, w = j & 255; return (w < 128) ? 2096 + blk * 128 + w : 2608 + 512 + blk * 128 + (w - 128); }
        return 2608 + (dn - 3328);
    }
    if (mat == 3) {
        const int head = dn / 96, d = dn - head * 96; if (d < 64) return dn; const int w = d - 64; return head * 96 + 64 + (w >> 1) + 16 * (w & 1);
    }
    return dn;
}
__device__ __forceinline__ void p0_transpose_item(const float* W, int K, int Nsrc, bf16_t* WT, int mat, const float* kscale, LAS float* scr, int item, int nblk, int lane) {
    const int kb = item / nblk, nb = item % nblk, k0 = 64 * kb, n0 = 32 * nb;
    const int sc = srcmap(mat, n0 + (lane & 31));
    float v[32];
    const float* wp = W + (size_t)(k0 + (lane >> 5)) * Nsrc + (sc >= 0 ? sc : 0);
#pragma unroll
    for (int i = 0; i < 32; ++i) v[i] = wp[(size_t)(2 * i) * Nsrc];
#pragma unroll
    for (int i = 0; i < 32; ++i) { const int kk = 2 * i + (lane >> 5); float x = (sc >= 0) ? v[i] : 0.f; if (kscale) x *= kscale[k0 + kk]; scr[kk * 33 + (lane & 31)] = x; }
    LDS_WAIT(); asm volatile("" ::: "memory");
    const int c = lane & 7;
#pragma unroll
    for (int j = 0; j < 4; ++j) { const int n = (lane >> 3) + 8 * j; const LAS float* s = scr + (8 * c) * 33 + n;
        u32x4 o; o.x = pk2(s[0 * 33], s[1 * 33]); o.y = pk2(s[2 * 33], s[3 * 33]); o.z = pk2(s[4 * 33], s[5 * 33]); o.w = pk2(s[6 * 33], s[7 * 33]);
        *(u32x4*)(WT + (size_t)(n0 + n) * K + k0 + 8 * c) = o; }
    LDS_WAIT(); asm volatile("" ::: "memory");
}

struct P0Item { float v[32]; int sc, k0, n0; };
__device__ __forceinline__ void p0_item_load(P0Item& I, const float* W, int Nsrc, int mat, int item, int nblk, int lane) {
    const int kb = item / nblk, nb = item % nblk; I.k0 = 64 * kb; I.n0 = 32 * nb;
    I.sc = srcmap(mat, I.n0 + (lane & 31));
    const float* wp = W + (size_t)(I.k0 + (lane >> 5)) * Nsrc + (I.sc >= 0 ? I.sc : 0);
#pragma unroll
    for (int i = 0; i < 32; ++i) I.v[i] = __builtin_nontemporal_load(wp + (size_t)(2 * i) * Nsrc);
}
__device__ __forceinline__ void p0_item_finish(const P0Item& I, int K, bf16_t* WT, const float* kscale, LAS float* scr, int lane) {
#pragma unroll
    for (int i = 0; i < 32; ++i) { const int kk = 2 * i + (lane >> 5); float x = (I.sc >= 0) ? I.v[i] : 0.f; if (kscale) x *= kscale[I.k0 + kk]; scr[kk * 33 + (lane & 31)] = x; }
    LDS_WAIT(); asm volatile("" ::: "memory");
    const int c = lane & 7;
#pragma unroll
    for (int j = 0; j < 4; ++j) { const int n = (lane >> 3) + 8 * j; const LAS float* s = scr + (8 * c) * 33 + n;
        u32x4 o; o.x = pk2(s[0 * 33], s[1 * 33]); o.y = pk2(s[2 * 33], s[3 * 33]); o.z = pk2(s[4 * 33], s[5 * 33]); o.w = pk2(s[6 * 33], s[7 * 33]);
        *(u32x4*)(WT + (size_t)(I.n0 + n) * K + I.k0 + 8 * c) = o; }
    LDS_WAIT(); asm volatile("" ::: "memory");
}

__device__ __forceinline__ void p0_mod(LAS unsigned char* lds, const float* c, const float* c_ctx, const float* mod_w, const float* mod_b, float* MOD, int G) {
    const int tid = my_tid();
    if ((int)blockIdx.x >= 192) return;
    LAS float* scs = (LAS float*)lds;
    LAS float* red = (LAS float*)(lds + 1024 * 20 * 4);
    { float cv[34];
#pragma unroll
      for (int u = 0; u < 34; ++u) { const int idx = tid + u * NTHREADS, r = idx >> 10, k = idx & 1023; cv[u] = (r < 16) ? c[r * 1024 + k] : c_ctx[k]; }
#pragma unroll
      for (int u = 0; u < 34; ++u) { const int idx = tid + u * NTHREADS, r = idx >> 10, k = idx & 1023; scs[k * 20 + r] = silu_f(cv[u]); } }
    __syncthreads();
    for (int item = blockIdx.x; item < 192; item += G) {
        const int l = item / 96, n0 = (item % 96) * 32, col = tid & 31, kg = tid >> 5;
        float acc[20];
#pragma unroll
        for (int r = 0; r < 20; ++r) acc[r] = 0.f;
        const float* wp = mod_w + ((size_t)l * 1024 + kg * 64) * 3072 + n0 + col;
#pragma unroll
        for (int kb = 0; kb < 4; ++kb) {
            float w[16];
#pragma unroll
            for (int u = 0; u < 16; ++u) w[u] = __builtin_nontemporal_load(wp + (size_t)(kb * 16 + u) * 3072);
#pragma unroll
            for (int u = 0; u < 16; ++u) { const LAS f32x4* sp = (const LAS f32x4*)(scs + (kg * 64 + kb * 16 + u) * 20);
#pragma unroll
                for (int q = 0; q < 5; ++q) { const f32x4 s = sp[q]; acc[4 * q] += s[0] * w[u]; acc[4 * q + 1] += s[1] * w[u]; acc[4 * q + 2] += s[2] * w[u]; acc[4 * q + 3] += s[3] * w[u]; } }
        }
#pragma unroll
        for (int r = 0; r < 17; ++r) red[(kg * 17 + r) * 32 + col] = acc[r];
        __syncthreads();
        for (int o = tid; o < 17 * 32; o += NTHREADS) { const int r = o >> 5, cc = o & 31; float s = mod_b[l * 3072 + n0 + cc];
#pragma unroll
            for (int g = 0; g < 16; ++g) s += red[(g * 17 + r) * 32 + cc];
            MOD[((size_t)l * 17 + r) * 3072 + n0 + cc] = s; }
        __syncthreads();
    }
}

__device__ __forceinline__ void norm_mod_store(const f32x4 (&v)[4], const float* pre_w, const float* modrow, bf16_t* hrow, int lane) {
    float ss = 0.f;
#pragma unroll
    for (int j = 0; j < 4; ++j) ss += sq4(v[j]);
    const float rstd = rsqrtf(wave_sum(ss) * (1.f / 1024.f) + EPS);
#pragma unroll
    for (int j = 0; j < 4; ++j) { const int k = 4 * (lane + 64 * j);
        const f32x4 w = *(const f32x4*)(pre_w + k), sh = *(const f32x4*)(modrow + k), sc = *(const f32x4*)(modrow + 1024 + k);
        const f32x4 h = v[j] * rstd * w * (sc + 1.0f) + sh;
        u32x2 o; o.x = pk2(h[0], h[1]); o.y = pk2(h[2], h[3]); *(u32x2*)(hrow + k) = o; }
}
__device__ __forceinline__ void norm_mod_store_wt(const f32x4 (&v)[4], const float* pre_w, const float* modrow, bf16_t* hrow, int lane) {
    float ss = 0.f;
#pragma unroll
    for (int j = 0; j < 4; ++j) ss += sq4(v[j]);
    const float rstd = rsqrtf(wave_sum(ss) * (1.f / 1024.f) + EPS);
#pragma unroll
    for (int j = 0; j < 4; ++j) { const int k = 4 * (lane + 64 * j);
        const f32x4 w = *(const f32x4*)(pre_w + k), sh = *(const f32x4*)(modrow + k), sc = *(const f32x4*)(modrow + 1024 + k);
        const f32x4 h = v[j] * rstd * w * (sc + 1.0f) + sh;
        __hip_atomic_store((unsigned long long*)(hrow + k), (unsigned long long)pk2(h[0], h[1]) | ((unsigned long long)pk2(h[2], h[3]) << 32), __ATOMIC_RELAXED, __HIP_MEMORY_SCOPE_AGENT); }
}
__device__ __forceinline__ void p1_stream(const float* x, const float* ctx, const float* pre_w, const float* MOD, bf16_t* H, unsigned* ready, int sw, int nsw, int lane) {
    f32x4 cur[4][4], nxt[4][4];
#define P1_LOAD(dst, R_) do { if ((R_) < MT) { const float* src_ = ((R_) < ML) ? x + (size_t)(R_) * 1024 : ctx + (size_t)((R_) - ML) * 1024; \
        _Pragma("unroll") for (int j = 0; j < 4; ++j) dst[j] = *(const f32x4*)(src_ + 4 * (lane + 64 * j)); } } while (0)
#pragma unroll
    for (int q = 0; q < 4; ++q) P1_LOAD(cur[q], sw + nsw * q);
    for (int R0 = sw; R0 < MT; R0 += 4 * nsw) {
#pragma unroll
        for (int q = 0; q < 4; ++q) P1_LOAD(nxt[q], R0 + nsw * (4 + q));
#pragma unroll
        for (int q = 0; q < 4; ++q) { const int R = R0 + nsw * q; if (R < MT) { const int bi = (R < ML) ? (R >> 11) : 16;
            norm_mod_store_wt(cur[q], pre_w, MOD + (size_t)bi * 3072, H + (size_t)R * 1024, lane); } }
        asm volatile("s_waitcnt vmcnt(0)" ::: "memory");
        if (lane < 4) { const int R = R0 + nsw * lane; if (R < MT) __hip_atomic_fetch_add(ready + 64 * (R >> 8), 1u, __ATOMIC_RELAXED, __HIP_MEMORY_SCOPE_AGENT); }
#pragma unroll
        for (int q = 0; q < 4; ++q)
#pragma unroll
            for (int j = 0; j < 4; ++j) cur[q][j] = nxt[q][j];
    }
#undef P1_LOAD
}
__device__ __forceinline__ void p1_prenorm(const float* x, const float* ctx, const float* pre_w, const float* MOD, bf16_t* H, int gw, int ngw, int lane) {
    const int per = (MT + ngw - 1) / ngw, r0 = gw * per, r1 = (r0 + per < MT) ? r0 + per : MT;
    f32x4 cur[4], nxt[4], w[4], sc1[4], sh[4];
#pragma unroll
    for (int j = 0; j < 4; ++j) { w[j] = *(const f32x4*)(pre_w + 4 * (lane + 64 * j)); sc1[j] = w[j]; sh[j] = w[j]; }
#define P1_LOAD(dst, R_) do { const float* src_ = ((R_) < ML) ? x + (size_t)(R_) * 1024 : ctx + (size_t)((R_) - ML) * 1024; \
        _Pragma("unroll") for (int j = 0; j < 4; ++j) dst[j] = __builtin_nontemporal_load((const f32x4*)(src_ + 4 * (lane + 64 * j))); } while (0)
    if (r0 < r1) P1_LOAD(cur, r0);
    int cur_bi = -1;
    for (int R = r0; R < r1; ++R) {
        if (R + 1 < r1) P1_LOAD(nxt, R + 1);
        const int bi = (R < ML) ? (R >> 11) : 16;
        if (bi != cur_bi) { cur_bi = bi; const float* m0 = MOD + (size_t)bi * 3072;
#pragma unroll
            for (int j = 0; j < 4; ++j) { const int k = 4 * (lane + 64 * j); sh[j] = *(const f32x4*)(m0 + k); sc1[j] = *(const f32x4*)(m0 + 1024 + k) + 1.0f; } }
        float ss = 0.f;
#pragma unroll
        for (int j = 0; j < 4; ++j) ss += sq4(cur[j]);
        const float rstd = rsqrtf(wave_sum(ss) * (1.f / 1024.f) + EPS);
#pragma unroll
        for (int j = 0; j < 4; ++j) { const int k = 4 * (lane + 64 * j);
            const f32x4 h = cur[j] * rstd * w[j] * sc1[j] + sh[j];
            u32x2 o; o.x = pk2(h[0], h[1]); o.y = pk2(h[2], h[3]); *(u32x2*)(H + (size_t)R * 1024 + k) = o; }
#pragma unroll
        for (int j = 0; j < 4; ++j) cur[j] = nxt[j];
    }
#undef P1_LOAD
}
__device__ __forceinline__ float ssq16(const float* p) {
    const f32x4 a = *(const f32x4*)p, b = *(const f32x4*)(p + 4), c = *(const f32x4*)(p + 8), d = *(const f32x4*)(p + 12);
    return (((a[0] + a[1]) + (a[2] + a[3])) + ((b[0] + b[1]) + (b[2] + b[3]))) + (((c[0] + c[1]) + (c[2] + c[3])) + ((d[0] + d[1]) + (d[2] + d[3])));
}
__device__ __forceinline__ void p5_post_pre(const float* x, const float* ctx, const float* post_w0, const float* pre_w1, const float* MOD, const bf16_t* Y, const float* SSQ, bf16_t* X1, bf16_t* H, int r0, int r1, int lane) {
    f32x4 xc[4], xn[4], sqc[4], sqn[4]; u32x2 yc[4], yn[4];
    f32x4 pg[4], pw[4], w1[4], sc1[4], sh1[4];
#pragma unroll
    for (int j = 0; j < 4; ++j) { const int k = 4 * (lane + 64 * j); pw[j] = *(const f32x4*)(post_w0 + k); w1[j] = *(const f32x4*)(pre_w1 + k); pg[j] = pw[j]; sc1[j] = pw[j]; sh1[j] = pw[j]; }
#define P5_LOAD(xd, yd, sd, R_) do { const float* src_ = ((R_) < ML) ? x + (size_t)(R_) * 1024 : ctx + (size_t)((R_) - ML) * 1024; \
        _Pragma("unroll") for (int j = 0; j < 4; ++j) { xd[j] = __builtin_nontemporal_load((const f32x4*)(src_ + 4 * (lane + 64 * j))); yd[j] = __builtin_nontemporal_load((const u32x2*)(Y + (size_t)(R_) * 1024 + 4 * (lane + 64 * j))); \
            sd[j] = *(const f32x4*)(SSQ + (size_t)(R_) * 16 + 4 * j); } } while (0)
    if (r0 < r1) P5_LOAD(xc, yc, sqc, r0);
    int cur_bi = -1;
    for (int R = r0; R < r1; ++R) {
        if (R + 1 < r1) P5_LOAD(xn, yn, sqn, R + 1);
        const int bi = (R < ML) ? (R >> 11) : 16;
        if (bi != cur_bi) { cur_bi = bi; const float* m0 = MOD + (size_t)bi * 3072; const float* m1 = MOD + (size_t)(17 + bi) * 3072;
#pragma unroll
            for (int j = 0; j < 4; ++j) { const int k = 4 * (lane + 64 * j); pg[j] = *(const f32x4*)(m0 + 2048 + k); sh1[j] = *(const f32x4*)(m1 + k); sc1[j] = *(const f32x4*)(m1 + 1024 + k) + 1.0f; } }
        const float ssy = (((sqc[0][0] + sqc[0][1]) + (sqc[0][2] + sqc[0][3])) + ((sqc[1][0] + sqc[1][1]) + (sqc[1][2] + sqc[1][3]))) + (((sqc[2][0] + sqc[2][1]) + (sqc[2][2] + sqc[2][3])) + ((sqc[3][0] + sqc[3][1]) + (sqc[3][2] + sqc[3][3])));
        const float rstd_y = rsqrtf(ssy * (1.f / 1024.f) + EPS);
        f32x4 v[4]; float ss = 0.f;
#pragma unroll
        for (int j = 0; j < 4; ++j) { const int k = 4 * (lane + 64 * j);
            const f32x4 y = (f32x4){bf_lo(yc[j].x), bf_hi(yc[j].x), bf_lo(yc[j].y), bf_hi(yc[j].y)};
            v[j] = xc[j] + pg[j] * (y * rstd_y * pw[j]);
            ss += sq4(v[j]);
            if (R < ML) { u32x2 o; o.x = pk2(v[j][0], v[j][1]); o.y = pk2(v[j][2], v[j][3]); __builtin_nontemporal_store(o, (u32x2*)(X1 + (size_t)R * 1024 + k)); } }
        const float rstd = rsqrtf(wave_sum(ss) * (1.f / 1024.f) + EPS);
#pragma unroll
        for (int j = 0; j < 4; ++j) { const int k = 4 * (lane + 64 * j);
            const f32x4 h = v[j] * rstd * w1[j] * sc1[j] + sh1[j];
            u32x2 o; o.x = pk2(h[0], h[1]); o.y = pk2(h[2], h[3]); *(u32x2*)(H + (size_t)R * 1024 + k) = o; }
#pragma unroll
        for (int j = 0; j < 4; ++j) { xc[j] = xn[j]; yc[j] = yn[j]; sqc[j] = sqn[j]; }
    }
#undef P5_LOAD
}
__device__ __forceinline__ void p11_final(const float* post_w1, const float* MOD, const bf16_t* Y, const float* SSQ, const bf16_t* X1, float* out, int gw, int ngw, int lane) {
    const int per = (ML + ngw - 1) / ngw, r0 = gw * per, r1 = (r0 + per < ML) ? r0 + per : ML;
    u32x2 xc[4], xn[4], yc[4], yn[4]; f32x4 sqc[4], sqn[4], pg[4], pw[4];
#pragma unroll
    for (int j = 0; j < 4; ++j) { pw[j] = *(const f32x4*)(post_w1 + 4 * (lane + 64 * j)); pg[j] = pw[j]; }
#define P11_LOAD(xd, yd, sd, R_) do { _Pragma("unroll") for (int j = 0; j < 4; ++j) { xd[j] = __builtin_nontemporal_load((const u32x2*)(X1 + (size_t)(R_) * 1024 + 4 * (lane + 64 * j))); yd[j] = __builtin_nontemporal_load((const u32x2*)(Y + (size_t)(R_) * 1024 + 4 * (lane + 64 * j))); \
        sd[j] = *(const f32x4*)(SSQ + (size_t)(R_) * 16 + 4 * j); } } while (0)
    if (r0 < r1) P11_LOAD(xc, yc, sqc, r0);
    int cur_b = -1;
    for (int R = r0; R < r1; ++R) {
        if (R + 1 < r1) P11_LOAD(xn, yn, sqn, R + 1);
        const int bb = R >> 11;
        if (bb != cur_b) { cur_b = bb; const float* m1 = MOD + (size_t)(17 + bb) * 3072;
#pragma unroll
            for (int j = 0; j < 4; ++j) pg[j] = *(const f32x4*)(m1 + 2048 + 4 * (lane + 64 * j)); }
        const float ssy = (((sqc[0][0] + sqc[0][1]) + (sqc[0][2] + sqc[0][3])) + ((sqc[1][0] + sqc[1][1]) + (sqc[1][2] + sqc[1][3]))) + (((sqc[2][0] + sqc[2][1]) + (sqc[2][2] + sqc[2][3])) + ((sqc[3][0] + sqc[3][1]) + (sqc[3][2] + sqc[3][3])));
        const float rstd_y = rsqrtf(ssy * (1.f / 1024.f) + EPS);
#pragma unroll
        for (int j = 0; j < 4; ++j) { const int k = 4 * (lane + 64 * j);
            const f32x4 y = (f32x4){bf_lo(yc[j].x), bf_hi(yc[j].x), bf_lo(yc[j].y), bf_hi(yc[j].y)};
            const f32x4 xv = (f32x4){bf_lo(xc[j].x), bf_hi(xc[j].x), bf_lo(xc[j].y), bf_hi(xc[j].y)};
            __builtin_nontemporal_store(xv + pg[j] * (y * rstd_y * pw[j]), (f32x4*)(out + (size_t)R * 1024 + k)); }
#pragma unroll
        for (int j = 0; j < 4; ++j) { xc[j] = xn[j]; yc[j] = yn[j]; sqc[j] = sqn[j]; }
    }
#undef P11_LOAD
}
__device__ __forceinline__ void p3_conv(unsigned char* ws, const float* conv_w, int gtid, int ngt) {
    const bf16_t* PE = (const bf16_t*)(ws + WS_PE); const bf16_t* GE = (const bf16_t*)(ws + WS_GE); bf16_t* U = (bf16_t*)(ws + WS_U);
    const int ch = (gtid & 63) * 8;
    const f32x4 w0a = *(const f32x4*)(conv_w + ch), w0b = *(const f32x4*)(conv_w + ch + 4), w1a = *(const f32x4*)(conv_w + 512 + ch), w1b = *(const f32x4*)(conv_w + 512 + ch + 4),
                w2a = *(const f32x4*)(conv_w + 1024 + ch), w2b = *(const f32x4*)(conv_w + 1024 + ch + 4);
    for (int it = gtid; it < MT * 64; it += ngt) {
        const int R = it >> 6;
        int t, T; if (R < ML) { t = R & 2047; T = 2048; } else { t = (R - ML) & 255; T = 256; }
        const u32x4 z4 = (u32x4){0u, 0u, 0u, 0u};
        const u32x4 pc = *(const u32x4*)(PE + (size_t)R * 512 + ch);
        const u32x4 pm = (t > 0) ? *(const u32x4*)(PE + (size_t)(R - 1) * 512 + ch) : z4;
        const u32x4 pp = (t < T - 1) ? *(const u32x4*)(PE + (size_t)(R + 1) * 512 + ch) : z4;
        const u32x4 g = __builtin_nontemporal_load((const u32x4*)(GE + (size_t)R * 512 + ch));
        u32x4 o;
#define CV(pmw, pcw, ppw, gw_, wa, wb, wc_, e0, e1) pk2(bf_lo(gw_) * (wa[e0] * bf_lo(pmw) + wb[e0] * bf_lo(pcw) + wc_[e0] * bf_lo(ppw)), bf_hi(gw_) * (wa[e1] * bf_hi(pmw) + wb[e1] * bf_hi(pcw) + wc_[e1] * bf_hi(ppw)))
        o.x = CV(pm.x, pc.x, pp.x, g.x, w0a, w1a, w2a, 0, 1); o.y = CV(pm.y, pc.y, pp.y, g.y, w0a, w1a, w2a, 2, 3);
        o.z = CV(pm.z, pc.z, pp.z, g.z, w0b, w1b, w2b, 0, 1); o.w = CV(pm.w, pc.w, pp.w, g.w, w0b, w1b, w2b, 2, 3);
#undef CV
        *(u32x4*)(U + (size_t)R * 1024 + 512 + ch) = o;
    }
}
__device__ __forceinline__ void p9_readout(unsigned char* ws, unsigned char* aux, const float* hn_w, int gw, int ngw, int lane) {
    const bf16_t* HM = (const bf16_t*)(ws + WS_HM); const bf16_t* MO = (const bf16_t*)(aux + AUX_MO); bf16_t* U = (bf16_t*)(ws + WS_U);
    const int ch = 8 * lane;
    const f32x4 wa = *(const f32x4*)(hn_w + ch), wb = *(const f32x4*)(hn_w + ch + 4);
    u32x4 h0, h1, mo, h0n, h1n, mon;
#define P9_LOAD(a_, b_, c_, R_) do { a_ = __builtin_nontemporal_load((const u32x4*)(HM + (size_t)(R_) * 512 + ch)); b_ = __builtin_nontemporal_load((const u32x4*)(HM + ((size_t)ML + (R_)) * 512 + ch)); c_ = __builtin_nontemporal_load((const u32x4*)(MO + (size_t)(R_) * 512 + ch)); } while (0)
    h0n = (u32x4){0u, 0u, 0u, 0u}; h1n = h0n; mon = h0n;
    if (gw < ML) P9_LOAD(h0, h1, mo, gw);
    for (int R = gw; R < ML; R += ngw) {
        if (R + ngw < ML) P9_LOAD(h0n, h1n, mon, R + ngw);
        float hs[8] = {bf_lo(h0.x) + bf_lo(h1.x), bf_hi(h0.x) + bf_hi(h1.x), bf_lo(h0.y) + bf_lo(h1.y), bf_hi(h0.y) + bf_hi(h1.y),
                       bf_lo(h0.z) + bf_lo(h1.z), bf_hi(h0.z) + bf_hi(h1.z), bf_lo(h0.w) + bf_lo(h1.w), bf_hi(h0.w) + bf_hi(h1.w)};
        float ss = 0.f;
#pragma unroll
        for (int e = 0; e < 8; ++e) ss += hs[e] * hs[e];
        ss += __shfl_xor(ss, 1); ss += __shfl_xor(ss, 2); ss += __shfl_xor(ss, 4); ss += __shfl_xor(ss, 8);
        const float rstd = rsqrtf(ss * (1.f / 128.f) + EPS);
        u32x4 o;
        o.x = pk2(hs[0] * rstd * wa[0] * bf_lo(mo.x), hs[1] * rstd * wa[1] * bf_hi(mo.x));
        o.y = pk2(hs[2] * rstd * wa[2] * bf_lo(mo.y), hs[3] * rstd * wa[3] * bf_hi(mo.y));
        o.z = pk2(hs[4] * rstd * wb[0] * bf_lo(mo.z), hs[5] * rstd * wb[1] * bf_hi(mo.z));
        o.w = pk2(hs[6] * rstd * wb[2] * bf_lo(mo.w), hs[7] * rstd * wb[3] * bf_hi(mo.w));
        *(u32x4*)(U + (size_t)R * 1024 + 512 + ch) = o;
        h0 = h0n; h1 = h1n; mo = mon;
    }
#undef P9_LOAD
}


typedef float f32x4v __attribute__((ext_vector_type(4)));
#define LDS_BARRIER() do { asm volatile("s_waitcnt lgkmcnt(0)" ::: "memory"); __builtin_amdgcn_s_barrier(); asm volatile("" ::: "memory"); } while (0)
#define MFMA_FENCE(x) do { __builtin_amdgcn_sched_barrier(0); asm volatile("s_nop 15\n\ts_nop 15" : "+v"(x)); __builtin_amdgcn_sched_barrier(0); } while (0)
__device__ __forceinline__ bf16x8 tr8(const LAS unsigned char* p, int halfstride) {
    const s16x4 lo = vtr(p), hi = vtr(p + halfstride);
    return (bf16x8){lo[0], lo[1], lo[2], lo[3], hi[0], hi[1], hi[2], hi[3]};
}
__device__ __forceinline__ bf16x8 gather8(const LAS unsigned char* img, int stride, int row0, int col) {
    bf16x8 r;
#pragma unroll
    for (int e = 0; e < 8; ++e) r[e] = *(const LAS short*)(img + (row0 + e) * stride + col * 2);
    return r;
}
template <int CTRL, int RM> __device__ __forceinline__ float dppf(float oldv, float v) {
    return __int_as_float(__builtin_amdgcn_update_dpp(__float_as_int(oldv), __float_as_int(v), CTRL, RM, 0xf, false));
}
__device__ __forceinline__ float wave_scan_add(float v) {
    v += dppf<0x111, 0xf>(0.f, v); v += dppf<0x112, 0xf>(0.f, v); v += dppf<0x114, 0xf>(0.f, v); v += dppf<0x118, 0xf>(0.f, v);
    v += dppf<0x142, 0xa>(0.f, v); v += dppf<0x143, 0xc>(0.f, v);
    return v;
}
__device__ __forceinline__ float wave_scan_max(float v) {
    const float ninf = -INFINITY;
    v = fmaxf(v, dppf<0x111, 0xf>(ninf, v)); v = fmaxf(v, dppf<0x112, 0xf>(ninf, v)); v = fmaxf(v, dppf<0x114, 0xf>(ninf, v)); v = fmaxf(v, dppf<0x118, 0xf>(ninf, v));
    v = fmaxf(v, dppf<0x142, 0xa>(ninf, v)); v = fmaxf(v, dppf<0x143, 0xc>(ninf, v));
    return v;
}
template <bool DUMMY> __device__ __forceinline__ void mlstm_chain_mfma(LAS unsigned char* lds, unsigned char* ws, unsigned char* aux, const float* i_bias, const float* f_bias, int chain) {
    constexpr int RS = 144, VS = 176;
    constexpr int QI = 0, KI = 9216, SC = 18432, CI = 27648, VI = 39168, VW = 50432, VEC = 61696;
    const int tid = my_tid(), lane = tid & 63, wid = __builtin_amdgcn_readfirstlane(tid >> 6), l15 = lane & 15, kg = lane >> 4;
    const int vh = chain & 1, d = (chain >> 1) & 1, h = (chain >> 2) & 3, b = chain >> 4;
    const bf16_t* MK = (const bf16_t*)(ws + WS_MK); const bf16_t* MV = (const bf16_t*)(ws + WS_MV); const bf16_t* MQ = (const bf16_t*)(aux + AUX_MQ);
    const float* GT = (const float*)(ws + WS_GATES); bf16_t* HM = (bf16_t*)(ws + WS_HM);
    const float ib = i_bias[d * 4 + h], fb = f_bias[d * 4 + h];
    for (int idx = tid; idx < 80 * RS / 4; idx += NTHREADS) ((LAS unsigned*)(lds + CI))[idx] = 0u;
    if (tid < 64) { LAS unsigned* a = (LAS unsigned*)(lds + VI + tid * VS + 128); LAS unsigned* w = (LAS unsigned*)(lds + VW + tid * VS + 128);
#pragma unroll
        for (int e = 0; e < 8; ++e) { a[e] = (e == 0) ? 0x3F80u : 0u; w[e] = 0u; } }
    const int it = wid & 3, vg = wid >> 2;
    f32x4v cacc[3];
#pragma unroll
    for (int t = 0; t < 3; ++t) cacc[t] = (f32x4v){0.f, 0.f, 0.f, 0.f};
    float mst = 0.f;
    unsigned nbad = 0u;
    const int srow = tid >> 3, sch = tid & 7;
    const int q4 = l15 >> 2, p4 = l15 & 3;
    u32x4 kkN, vvN, qqN = (u32x4){0u, 0u, 0u, 0u}; float liN = 0.f, fpN = 0.f;
#define MLSTM_LOADS(S_) do { const bool lat_ = (S_) >= 4; const int c_ = lat_ ? (S_) - 4 : (S_), T_ = lat_ ? 2048 : 256, rowb_ = lat_ ? b * 2048 : ML + b * 256; \
        const int tok_ = (d == 0) ? 64 * c_ + srow : T_ - 1 - (64 * c_ + srow); const size_t R_ = (size_t)(rowb_ + tok_); \
        kkN = __builtin_nontemporal_load((const u32x4*)(MK + R_ * 256 + h * 64 + sch * 8)); vvN = __builtin_nontemporal_load((const u32x4*)(MV + R_ * 512 + h * 128 + vh * 64 + sch * 8)); \
        if (lat_) qqN = __builtin_nontemporal_load((const u32x4*)(MQ + R_ * 256 + h * 64 + sch * 8)); \
        } while (0)
#define MLSTM_GATES(S_) do { const bool lat_ = (S_) >= 4; const int c_ = lat_ ? (S_) - 4 : (S_), T_ = lat_ ? 2048 : 256, rowb_ = lat_ ? b * 2048 : ML + b * 256; \
        const int tk_ = (d == 0) ? 64 * c_ + lane : T_ - 1 - (64 * c_ + lane); const float* gp_ = GT + (size_t)(rowb_ + tk_) * 16 + d * 8 + h; liN = gp_[0]; fpN = gp_[4]; } while (0)
#define MLSTM_SCAN(S_) do { LAS float* vs_ = (LAS float*)(lds + VEC) + ((S_) & 1) * 320; \
        const float li = liN + ib, fp = fpN + fb; \
        const float lf = fminf(fp, 0.f) - __logf(1.f + __expf(-fabsf(fp))); \
        const float bc = wave_scan_add(lf); \
        const float ab = li - bc; const float cm = wave_scan_max(ab); \
        const float g = __int_as_float(__builtin_amdgcn_readlane(__float_as_int(bc), 63)), mloc = g + __int_as_float(__builtin_amdgcn_readlane(__float_as_int(cm), 63)), m_new = fmaxf(g + mst, mloc); \
        vs_[lane] = bc; vs_[64 + lane] = ab; vs_[128 + lane] = cm; vs_[192 + lane] = __expf(g + ab - m_new); \
        if (lane == 0) { vs_[256] = mst; vs_[257] = __expf(g + mst - m_new); } \
        mst = m_new; } while (0)
    MLSTM_LOADS(0);
    if (wid == 4) { MLSTM_GATES(0); MLSTM_SCAN(0); MLSTM_GATES(1); }
    LDS_BARRIER();
    for (int step = 0; step < 36; ++step) {
        const bool lat = step >= 4; const int c = lat ? step - 4 : step, T = lat ? 2048 : 256, rowb = lat ? b * 2048 : ML + b * 256;
        const int tok = (d == 0) ? 64 * c + srow : T - 1 - (64 * c + srow); const size_t R = (size_t)(rowb + tok);
        const u32x4 kk = kkN, vv = vvN, qq = qqN;
        LAS float* vb_ = (LAS float*)(lds + VEC) + (step & 1) * 320; LAS float* vab = vb_ + 64; LAS float* vcm = vab + 64; LAS float* vwp = vcm + 64; LAS float* vsc = vwp + 64;
        { const float wj = vwp[srow];
          *(LAS u32x4*)(lds + KI + srow * RS + sch * 16) = kk;
          *(LAS u32x4*)(lds + VI + srow * VS + sch * 16) = vv;
          u32x4 vw; vw.x = pk2(bf_lo(vv.x) * wj, bf_hi(vv.x) * wj); vw.y = pk2(bf_lo(vv.y) * wj, bf_hi(vv.y) * wj); vw.z = pk2(bf_lo(vv.z) * wj, bf_hi(vv.z) * wj); vw.w = pk2(bf_lo(vv.w) * wj, bf_hi(vv.w) * wj);
          *(LAS u32x4*)(lds + VW + srow * VS + sch * 16) = vw;
          if (sch == 0) *(LAS unsigned short*)(lds + VW + srow * VS + 128) = f2bf(wj);
          if (lat) *(LAS u32x4*)(lds + QI + srow * RS + sch * 16) = qq; }
        LDS_BARRIER();
        const float m_in = vsc[0], a_prev = vsc[1];
        if (step + 1 < 36) MLSTM_LOADS(step + 1);
        bf16x8 qf[2];
        if (lat) {
            qf[0] = *(const LAS bf16x8*)(lds + QI + (16 * it + l15) * RS + (8 * kg) * 2); qf[1] = *(const LAS bf16x8*)(lds + QI + (16 * it + l15) * RS + (8 * kg + 32) * 2);
            const int i = 16 * it + l15; const float mi = fmaxf(m_in, vcm[i]);
#pragma unroll
            for (int t = 0; t < 2; ++t) {
                const int jt = 2 * vg + t; u32x2 o = (u32x2){0u, 0u};
                if (jt <= it) {
                    const bf16x8 k0 = *(const LAS bf16x8*)(lds + KI + (16 * jt + l15) * RS + (8 * kg) * 2), k1 = *(const LAS bf16x8*)(lds + KI + (16 * jt + l15) * RS + (8 * kg + 32) * 2);
                    f32x4v s = (f32x4v){0.f, 0.f, 0.f, 0.f};
                    s = __builtin_amdgcn_mfma_f32_16x16x32_bf16(k0, qf[0], s, 0, 0, 0); s = __builtin_amdgcn_mfma_f32_16x16x32_bf16(k1, qf[1], s, 0, 0, 0); MFMA_FENCE(s);
                    const int j0 = 16 * jt + 4 * kg; const f32x4v abv = *(const LAS f32x4v*)(vab + j0);
                    float e[4];
#pragma unroll
                    for (int r = 0; r < 4; ++r) e[r] = (j0 + r <= i) ? s[r] * __expf(abv[r] - mi) : 0.f;
                    o.x = pk2(e[0], e[1]); o.y = pk2(e[2], e[3]);
                }
                *(LAS u32x2*)(lds + SC + i * RS + (16 * jt + 4 * kg) * 2) = o;
            }
        }
        if (wid == 4 && step + 1 < 36) { MLSTM_SCAN(step + 1); if (step + 2 < 36) MLSTM_GATES(step + 2); }
        LDS_BARRIER();
        f32x4v cnew[3];
        { bf16x8 aK[2];
#pragma unroll
          for (int s = 0; s < 2; ++s) aK[s] = tr8(lds + KI + (32 * s + 8 * kg + q4) * RS + (16 * it + 4 * p4) * 2, 4 * RS);
#pragma unroll
          for (int t = 0; t < 3; ++t) { const int vt = (t == 2) ? 4 : 2 * t + vg; f32x4v a = cacc[t] * a_prev;
#pragma unroll
              for (int s = 0; s < 2; ++s) { const bf16x8 bW = tr8(lds + VW + (32 * s + 8 * kg + q4) * VS + (16 * vt + 4 * p4) * 2, 4 * VS); a = __builtin_amdgcn_mfma_f32_16x16x32_bf16(aK[s], bW, a, 0, 0, 0); }
              MFMA_FENCE(a); cnew[t] = a; } }
        if (lat) {
            const int i0 = 16 * it + 4 * kg; const f32x4v cmv = *(const LAS f32x4v*)(vcm + i0), bv = *(const LAS f32x4v*)(vb_ + i0);
            float wi[4], mt[4];
#pragma unroll
            for (int r = 0; r < 4; ++r) { const float mi = fmaxf(m_in, cmv[r]); wi[r] = __expf(m_in - mi); mt[r] = bv[r] + mi; }
            bf16x8 aS[2];
            aS[0] = *(const LAS bf16x8*)(lds + SC + (16 * it + l15) * RS + (8 * kg) * 2); aS[1] = *(const LAS bf16x8*)(lds + SC + (16 * it + l15) * RS + (8 * kg + 32) * 2);
            f32x4v nacc[3];
#pragma unroll
            for (int t = 0; t < 3; ++t) { const int vt = (t == 2) ? 4 : 2 * t + vg; f32x4v a = (f32x4v){0.f, 0.f, 0.f, 0.f};
#pragma unroll
                for (int s = 0; s < 2; ++s) { const bf16x8 bC = *(const LAS bf16x8*)(lds + CI + (16 * vt + l15) * RS + (8 * kg + 32 * s) * 2); a = __builtin_amdgcn_mfma_f32_16x16x32_bf16(qf[s], bC, a, 0, 0, 0); }
                MFMA_FENCE(a);
#pragma unroll
                for (int r = 0; r < 4; ++r) a[r] *= wi[r];
#pragma unroll
                for (int s = 0; s < 2; ++s) { const bf16x8 bV = tr8(lds + VI + (32 * s + 8 * kg + q4) * VS + (16 * vt + 4 * p4) * 2, 4 * VS); a = __builtin_amdgcn_mfma_f32_16x16x32_bf16(aS[s], bV, a, 0, 0, 0); }
                MFMA_FENCE(a); nacc[t] = a; }
            float inv[4];
#pragma unroll
            for (int r = 0; r < 4; ++r) { const float den = __shfl(nacc[2][r], lane & 48); inv[r] = 1.f / fmaxf(fabsf(den), __expf(-mt[r])); }
#pragma unroll
            for (int t = 0; t < 2; ++t) { const int vt = 2 * t + vg;
#pragma unroll
                for (int r = 0; r < 4; ++r) *(LAS unsigned short*)(lds + QI + (i0 + r) * RS + (16 * vt + l15) * 2) = f2bf(nacc[t][r] * inv[r]); }
        }
        LDS_BARRIER();
        if (lat) { const u32x4 hv = *(const LAS u32x4*)(lds + QI + srow * RS + sch * 16);
            if (DUMMY) { const u32x4 rv = *(const u32x4*)(HM + ((size_t)d * ML + R) * 512 + h * 128 + vh * 64 + sch * 8);
#define CMPH(a_, b_) do { const float x_ = (a_), y_ = (b_); if (fabsf(x_ - y_) > 0.05f * fmaxf(fabsf(x_), fabsf(y_)) + 0.02f) ++nbad; } while (0)
                CMPH(bf_lo(hv.x), bf_lo(rv.x)); CMPH(bf_hi(hv.x), bf_hi(rv.x)); CMPH(bf_lo(hv.y), bf_lo(rv.y)); CMPH(bf_hi(hv.y), bf_hi(rv.y));
                CMPH(bf_lo(hv.z), bf_lo(rv.z)); CMPH(bf_hi(hv.z), bf_hi(rv.z)); CMPH(bf_lo(hv.w), bf_lo(rv.w)); CMPH(bf_hi(hv.w), bf_hi(rv.w));
#undef CMPH
            } else __builtin_nontemporal_store(hv, (u32x4*)(HM + ((size_t)d * ML + R) * 512 + h * 128 + vh * 64 + sch * 8)); }
#pragma unroll
        for (int t = 0; t < 3; ++t) { cacc[t] = cnew[t]; const int vt = (t == 2) ? 4 : 2 * t + vg;
            if (t < 2 || wid < 4) { u32x2 o; o.x = pk2(cnew[t][0], cnew[t][1]); o.y = pk2(cnew[t][2], cnew[t][3]); *(LAS u32x2*)(lds + CI + (16 * vt + l15) * RS + (16 * it + 4 * kg) * 2) = o; } }
    }
#undef MLSTM_LOADS
#undef MLSTM_GATES
#undef MLSTM_SCAN
    if (DUMMY) atomicAdd((unsigned*)(ws + WS_CTL) + 64, nbad);
    __syncthreads();
}

#ifndef MK_N_LAUNCHES
#define MK_N_LAUNCHES 1
#endif
constexpr int N_PHASES = 12;
constexpr int LDS_BYTES = 147456;
constexpr int RING_BYTES = 131072, MISC_OFF = RING_BYTES + 320;
constexpr int CW_BAR = 4096;

struct Args { const float* in[21]; float* out; unsigned char* ws; int ph_lo, ph_hi; };

__global__ void __launch_bounds__(NTHREADS, 2) hybrid_fwd(Args args) {
    extern __shared__ __attribute__((aligned(16))) unsigned char lds_raw[];
    LAS unsigned char* lds = (LAS unsigned char*)lds_raw;
    const int G = gridDim.x, bx = blockIdx.x;
    const int vcu = (G % 8 == 0) ? (bx % 8) * (G / 8) + bx / 8 : bx;
    typedef const __attribute__((address_space(4))) Args* ArgsP;
    ArgsP AP = (ArgsP)__builtin_amdgcn_kernarg_segment_ptr();
    asm volatile("" : "+s"(AP));
    unsigned char* ws = AP->ws;
#define I_x AP->in[0]
#define I_cvec AP->in[1]
#define I_ctx AP->in[2]
#define I_c_ctx AP->in[3]
#define I_mod_w AP->in[4]
#define I_mod_b AP->in[5]
#define I_pre_w AP->in[6]
#define I_post_w AP->in[7]
#define I_e_w_in AP->in[8]
#define I_e_sink AP->in[9]
#define I_e_conv_w AP->in[10]
#define I_e_w_out AP->in[11]
#define I_o_w_in AP->in[12]
#define I_o_qn AP->in[13]
#define I_o_kvn AP->in[14]
#define I_o_w_uq AP->in[15]
#define I_o_w_ukv AP->in[16]
#define I_o_ib AP->in[17]
#define I_o_fb AP->in[18]
#define I_o_hn AP->in[19]
#define I_o_w_out AP->in[20]
#define I_out AP->out
    float* MOD = (float*)(ws + WS_MOD);

    for (int u = threadIdx.x; u < (LDS_BYTES - RING_BYTES) / 4; u += NTHREADS) ((LAS unsigned*)(lds + RING_BYTES))[u] = 0u;
    __syncthreads();
    XcdBarrier bar; bar.bar = (unsigned*)(ws + WS_CTL) + CW_BAR; bar.x = 0; bar.st = nullptr;
    if (MK_N_LAUNCHES == 1) bar = xcd_barrier_post((unsigned*)(ws + WS_CTL) + CW_BAR, (volatile LAS unsigned*)(lds + MISC_OFF) + 8);
    const int lo = AP->ph_lo, hi = AP->ph_hi;
#ifndef PROBE_REP
#define PROBE_REP 0
#endif
#define NREP(k) ((((PROBE_REP) >> (k)) & 1) ? 2 : 1)
#ifndef PHASE_MASK
#define PHASE_MASK 0xFFF
#endif
#define IN(k) (((PHASE_MASK >> (k)) & 1) && lo <= (k) && (k) < hi)
#ifndef PROBE_DBLBAR
#define PROBE_DBLBAR 0
#endif
#ifndef PROBE_TS
#define PROBE_TS -1
#endif
#define STAMP(k) do { if (PROBE_TS >= 0 && bx == 0 && threadIdx.x == 0) ((unsigned long long*)(ws + WS_CTL + 512 * 1024))[(k)] = __builtin_amdgcn_s_memrealtime(); } while (0)
#define SEAM(k) do { if (MK_N_LAUNCHES == 1 && IN((k) + 1)) { xcd_barrier(bar); if (PROBE_DBLBAR) xcd_barrier(bar); } STAMP((k) + 1); } while (0)
    const int ngw = G * NWAVES;
#define PH_IDS const int tid = my_tid(), lane = tid & 63, wave = __builtin_amdgcn_readfirstlane(tid >> 6), gw = vcu * NWAVES + wave; (void)lane; (void)gw

    STAMP(0);
    if (IN(0)) { asm volatile("" : "+s"(AP)); PH_IDS;
        for (int rep_ = 0; rep_ < NREP(0); ++rep_) { if (rep_) __syncthreads();
        STAMP(20); p0_mod(lds, I_cvec, I_c_ctx, I_mod_w, I_mod_b, MOD, G);
        __syncthreads(); STAMP(21);
        LAS float* scr = (LAS float*)(lds + wave * 16384);
        constexpr int I0 = 16 * (E_N / 32), I1 = 16 * 32;
        { const bool split = (G == 256); const int cw0 = split ? (bx - 192) * NWAVES + wave : gw, ncw = split ? 64 * NWAVES : ngw;
          if (!split || bx >= 192) {
#define P0_LD(I_, it_) do { if ((it_) < I0) p0_item_load(I_, I_e_w_in, E_N, 0, (it_), E_N / 32, lane); else p0_item_load(I_, I_e_w_out, 1024, 1, (it_) - I0, 32, lane); } while (0)
#define P0_FN(I_, it_) do { if ((it_) < I0) p0_item_finish(I_, 1024, (bf16_t*)(ws + WS_WEIN), nullptr, scr, lane); else p0_item_finish(I_, 1024, (bf16_t*)(ws + WS_WEOUT), nullptr, scr, lane); } while (0)
            P0Item ia, ib; int it = cw0; if (it < I0 + I1) P0_LD(ia, it);
            while (it < I0 + I1) { const int itn = it + ncw; if (itn < I0 + I1) P0_LD(ib, itn); P0_FN(ia, it); ia = ib; it = itn; }
#undef P0_LD
#undef P0_FN
          } }
        STAMP(22);
        float* ropeA = (float*)(ws + WS_ROPEA); float* ropeC = (float*)(ws + WS_ROPEC);
        for (int idx = bx * NTHREADS + tid; idx < 2048 * 48; idx += G * NTHREADS) {
            const int pos = idx / 48, j = idx % 48; const float rowf = (float)(pos >> 6), colf = (float)(pos & 63);
            if (j < 32) { const int f = j & 15; const float inv = exp2f(-(float)f * (13.287712379549449f / 16.f)); const float ang = ((j < 16) ? rowf : colf) * inv;
                ropeA[pos * 64 + j] = __cosf(ang); ropeA[pos * 64 + 32 + j] = __sinf(ang); }
            else { const int jj = j - 32, f = jj & 7; const float inv = exp2f(-(float)f * (13.287712379549449f / 8.f)); const float ang = ((jj < 8) ? rowf : colf) * inv;
                ropeC[pos * 32 + jj] = __cosf(ang); ropeC[pos * 32 + 16 + jj] = __sinf(ang); }
        }
        STAMP(23);
        }
        SEAM(0); STAMP(24);
    }
    if (IN(1)) { asm volatile("" : "+s"(AP)); PH_IDS; for (int rep_ = 0; rep_ < NREP(1); ++rep_) { if (rep_) __syncthreads();
        p1_prenorm(I_x, I_ctx, I_pre_w, MOD, (bf16_t*)(ws + WS_H), gw, ngw, lane); }
        SEAM(1); }
    if (IN(2)) { asm volatile("" : "+s"(AP)); PH_IDS;
        for (int rep_ = 0; rep_ < NREP(2); ++rep_) { if (rep_) __syncthreads();
        pg8::Gemm g{(const bf16_t*)(ws + WS_H), (const bf16_t*)(ws + WS_WEIN), MT, E_N, 1024}; pg8::RectOrder S; S.init(MT / 256, E_N / 256, 0, 0, 0, G, bx);
        EpiEin E{ws}; pg8::gemm_phase<EpiEin, pg8::RectOrder, true, true>(lds, g, S, E);
        }
        { const int rem_ = ((MT / 256) * (E_N / 256)) % G, c0_ = rem_ ? rem_ : 0, cw0_ = (bx - c0_) * NWAVES + wave, ncw_ = (G - c0_) * NWAVES;
          if (bx >= c0_) {
        { LAS float* scr = (LAS float*)(lds + wave * 16384);
          constexpr int I2 = 16 * (O_N / 32), I3 = 12 * 24, I4 = 4 * 32, I5 = 16 * 32;
#define P1_LD(I_, it_) do { int r = (it_); \
            if (r < I2) { p0_item_load(I_, I_o_w_in, O_NSRC, 2, r, O_N / 32, lane); break; } r -= I2; \
            if (r < I3) { p0_item_load(I_, I_o_w_uq, 768, 3, r, 24, lane); break; } r -= I3; \
            if (r < I4) { p0_item_load(I_, I_o_w_ukv, 1024, 4, r, 32, lane); break; } r -= I4; \
            p0_item_load(I_, I_o_w_out, 1024, 5, r, 32, lane); } while (0)
#define P1_FN(I_, it_) do { int r = (it_); \
            if (r < I2) { p0_item_finish(I_, 1024, (bf16_t*)(ws + WS_WOIN), nullptr, scr, lane); break; } r -= I2; \
            if (r < I3) { p0_item_finish(I_, 768, (bf16_t*)(ws + WS_WUQ), I_o_qn, scr, lane); break; } r -= I3; \
            if (r < I4) { p0_item_finish(I_, 256, (bf16_t*)(ws + WS_WUKV), I_o_kvn, scr, lane); break; } \
            p0_item_finish(I_, 1024, (bf16_t*)(ws + WS_WOOUT), nullptr, scr, lane); } while (0)
          { P0Item ia, ib; int it = cw0_; if (it < I2 + I3 + I4 + I5) P1_LD(ia, it);
            while (it < I2 + I3 + I4 + I5) { const int itn = it + ncw_; if (itn < I2 + I3 + I4 + I5) P1_LD(ib, itn); P1_FN(ia, it); ia = ib; it = itn; } }
#undef P1_LD
#undef P1_FN
        }
          } }
        SEAM(2);
    }
    if (IN(3)) { asm volatile("" : "+s"(AP)); PH_IDS;
        for (int rep_ = 0; rep_ < NREP(3) + NREP(14) - 1; ++rep_) {
        for (int un = vcu; un < 1024; un += G) attn_unit<0>(lds, ws, nullptr, I_e_sink, un);
        for (int un = bx; un < 128; un += G) attn_unit<1>(lds, ws, nullptr, I_e_sink, un);
        }
        for (int rep_ = 0; rep_ < NREP(3) + NREP(15) - 1; ++rep_) { p3_conv(ws, I_e_conv_w, bx * NTHREADS + tid, G * NTHREADS);
        }
        SEAM(3);
    }
    const int p4_full = (G == 256) ? ((MT / 256) * 4) / G : 1 << 20;
    const bool p4_late = (G == 256) && bx < ((MT / 256) * 4) % G;
    if (IN(4)) { asm volatile("" : "+s"(AP)); PH_IDS;
        for (int rep_ = 0; rep_ < NREP(4); ++rep_) { if (rep_) __syncthreads();
        pg8::Gemm g{(const bf16_t*)(ws + WS_U), (const bf16_t*)(ws + WS_WEOUT), MT, 1024, 1024}; pg8::RoundOrder S; S.init(ML / 256, 4, ML / 256, MC / 256, 4, G, bx, 0, p4_full, nullptr);
        EpiY E{(bf16_t*)(ws + WS_Y), (float*)(ws + WS_SSQY0)}; pg8::gemm_phase<EpiY, pg8::RoundOrder, true, true>(lds, g, S, E);
        }
        if (MK_N_LAUNCHES == 1 && IN(5)) { xcd_barrier_arrive(bar); if (!p4_late) xcd_barrier_wait(bar); }
        STAMP(5);
    }
    if (IN(5)) { asm volatile("" : "+s"(AP)); PH_IDS;
#ifndef P5_C
#define P5_C 8
#endif
#ifndef P5_X
#define P5_X 6
#endif
        constexpr int NLAT_E = ML - 512 * P5_X, NCTX_E = MC - 512 * P5_C;
        int sa0, sa1, sb0, sb1;
        unsigned* pc_ = (unsigned*)(ws + WS_CTL) + CW_PANEL;
        if (G == 256) {
            if (p4_late) { const int lw_ = bx * NWAVES + wave; sa0 = ML + lw_ * P5_C; sa1 = sa0 + P5_C; sb0 = NLAT_E + lw_ * P5_X; sb1 = sb0 + P5_X; }
            else { const int w_ = (bx - 64) * NWAVES + wave; sa0 = (int)(((long)w_ * NLAT_E) / 1536); sa1 = (int)(((long)(w_ + 1) * NLAT_E) / 1536);
                   sb0 = ML + 512 * P5_C + (w_ * NCTX_E) / 1536; sb1 = ML + 512 * P5_C + ((w_ + 1) * NCTX_E) / 1536; }
        } else { const int per_ = (MT + ngw - 1) / ngw; sa0 = gw * per_; sa1 = (sa0 + per_ < MT) ? sa0 + per_ : MT; sb0 = sb1 = 0; }
        if (p4_late) {
            pg8::Gemm g{(const bf16_t*)(ws + WS_U), (const bf16_t*)(ws + WS_WEOUT), MT, 1024, 1024}; pg8::RoundOrder S; S.init(ML / 256, 4, ML / 256, MC / 256, 4, G, bx, p4_full, p4_full + 1, pc_);
            EpiYW E{ws}; pg8::gemm_phase<EpiYW, pg8::RoundOrder, true, true>(lds, g, S, E);
            if (MK_N_LAUNCHES == 1) xcd_barrier_wait(bar);
        }
        for (int seg_ = 0; seg_ < 2; ++seg_) {
            const int r0 = seg_ ? sb0 : sa0, r1 = seg_ ? sb1 : sa1;
            if (r0 >= r1) continue;
            if (G == 256 && r1 > ML) {
                for (int p_ = ((r0 > ML ? r0 : ML) >> 8); p_ <= ((r1 - 1) >> 8); ++p_) XB_SPIN(xb_ld(pc_ + 64 * p_) < 32u, bar.bar);
                asm volatile("buffer_inv sc1\n\ts_waitcnt vmcnt(0)" ::: "memory");
            }
            p5_post_pre(I_x, I_ctx, I_post_w, I_pre_w + 1024, MOD, (const bf16_t*)(ws + WS_Y), (const float*)(ws + WS_SSQY0), (bf16_t*)(ws + WS_X1), (bf16_t*)(ws + WS_H), r0, r1, lane);
        }
        SEAM(5); }
    if (IN(6)) { asm volatile("" : "+s"(AP)); PH_IDS;
        for (int rep_ = 0; rep_ < NREP(6); ++rep_) { if (rep_) __syncthreads();
        pg8::Gemm g{(const bf16_t*)(ws + WS_H), (const bf16_t*)(ws + WS_WOIN), MT, O_N, 1024}; pg8::RectOrder S; S.init(ML / 256, O_N / 256, ML / 256, MC / 256, 5, G, bx);
        EpiOin E{ws, (unsigned char*)I_out}; pg8::gemm_phase<EpiOin, pg8::RectOrder, true, true>(lds, g, S, E);
        }
        SEAM(6);
    }
    if (IN(7)) { asm volatile("" : "+s"(AP)); PH_IDS;
        for (int rep_ = 0; rep_ < NREP(7); ++rep_) { if (rep_) __syncthreads();
        { pg8::Gemm g{(const bf16_t*)(ws + WS_CQ), (const bf16_t*)(ws + WS_WUQ), ML, 768, 768}; pg8::RectOrder S; S.init(ML / 256, 3, 0, 0, 0, G, bx);
          EpiUq E{ws, lds}; pg8::gemm_phase<EpiUq, pg8::RectOrder, true, true>(lds, g, S, E); }
        __syncthreads();
        { pg8::Gemm g{(const bf16_t*)(ws + WS_CKV), (const bf16_t*)(ws + WS_WUKV), MT, 1024, 256}; EpiUkv E{ws};
          if (G == 256) {
              pg8::ListOrder4 S; if (bx < 128) { S.start = bx; S.cnt = 1; } else if (bx < 192) { S.start = 128 + 3 * (bx - 128); S.cnt = 3; } else { S.start = 320 + 4 * (bx - 192); S.cnt = 4; }
              pg8::gemm_phase<EpiUkv, pg8::ListOrder4, true, true>(lds, g, S, E);
          } else { pg8::RectOrder S; S.init(MT / 256, 4, 0, 0, 0, G, G - 1 - bx); pg8::gemm_phase<EpiUkv, pg8::RectOrder, true, true>(lds, g, S, E); } }
        }
        if (MK_N_LAUNCHES == 1 && IN(8)) xcd_barrier_arrive(bar); STAMP(8);
    }
    if (IN(8)) { asm volatile("" : "+s"(AP)); PH_IDS;
        for (int rep_ = 0; rep_ < NREP(8) + NREP(12) - 1; ++rep_) { for (int ch = bx; ch < 256; ch += G) { STAMP(30); mlstm_chain_mfma<false>(lds, ws, (unsigned char*)I_out, I_o_ib, I_o_fb, ch); STAMP(31); }
        }
        if (MK_N_LAUNCHES == 1) { if (lo <= 7) xcd_barrier_wait(bar); xcd_barrier_arrive(bar); }
        for (int rep_ = 0; rep_ < NREP(8) + NREP(13) - 1; ++rep_) {
        for (int un = vcu; un < 1024; un += G) attn_unit<2>(lds, ws, (unsigned char*)I_out, nullptr, un);
        }
        STAMP(32); if (MK_N_LAUNCHES == 1) xcd_barrier_wait(bar); STAMP(33);
    }
    if (IN(9)) { asm volatile("" : "+s"(AP)); PH_IDS; for (int rep_ = 0; rep_ < NREP(9); ++rep_) { if (rep_) __syncthreads();
        p9_readout(ws, (unsigned char*)I_out, I_o_hn, gw, ngw, lane); }
        SEAM(9); }
    if (IN(10)) { asm volatile("" : "+s"(AP)); PH_IDS;
        for (int rep_ = 0; rep_ < NREP(10); ++rep_) { if (rep_) __syncthreads();
        pg8::Gemm g{(const bf16_t*)(ws + WS_U), (const bf16_t*)(ws + WS_WOOUT), ML, 1024, 1024}; pg8::RectOrder S; S.init(ML / 256, 4, 0, 0, 0, G, bx);
        EpiY E{(bf16_t*)(ws + WS_Y), (float*)(ws + WS_SSQY1)}; pg8::gemm_phase<EpiY, pg8::RectOrder, true, true>(lds, g, S, E);
        }
        SEAM(10);
    }
    if (IN(11)) { asm volatile("" : "+s"(AP)); PH_IDS; p11_final(I_post_w + 1024, MOD, (const bf16_t*)(ws + WS_Y), (const float*)(ws + WS_SSQY1), (const bf16_t*)(ws + WS_X1), I_out, gw, ngw, lane);
        if (PROBE_TS >= 0 && bx == 0 && threadIdx.x == 0) { asm volatile("s_waitcnt vmcnt(0)" ::: "memory"); const unsigned long long* ts = (const unsigned long long*)(ws + WS_CTL + 512 * 1024);
            const unsigned long long t1 = (PROBE_TS == 11) ? __builtin_amdgcn_s_memrealtime() : ts[PROBE_TS + 1]; I_out[5 * 1024 * 7 + 3] += floorf((float)(t1 - ts[PROBE_TS]) * 0.01f * (1.f / 50.f)) * 50.f; } }
#undef IN
#undef SEAM
#undef I_x
#undef I_cvec
#undef I_ctx
#undef I_c_ctx
#undef I_mod_w
#undef I_mod_b
#undef I_pre_w
#undef I_post_w
#undef I_e_w_in
#undef I_e_sink
#undef I_e_conv_w
#undef I_e_w_out
#undef I_o_w_in
#undef I_o_qn
#undef I_o_kvn
#undef I_o_w_uq
#undef I_o_w_ukv
#undef I_o_ib
#undef I_o_fb
#undef I_o_hn
#undef I_o_w_out
#undef I_out
}

extern "C" void kernel_launch(void* const* d_in, const int* in_sizes, int n_in, void* d_out, int out_size, void* d_ws, size_t ws_size, hipStream_t stream) {
    static int grid = 0;
    if (grid == 0) {
        if (n_in != 21 || in_sizes[0] != ML * DM || out_size != ML * DM || ws_size < WS_END) { fprintf(stderr, "kernel_launch: unexpected shapes / workspace (n_in %d, ws %zu < %zu); nothing launched\n", n_in, ws_size, (size_t)WS_END); grid = -1; return; }
        int dev = 0, cus = 0, per_cu = 0;
        if (hipGetDevice(&dev) != hipSuccess || hipDeviceGetAttribute(&cus, hipDeviceAttributeMultiprocessorCount, dev) != hipSuccess) { grid = -1; return; }
        if (hipFuncSetAttribute((const void*)hybrid_fwd, hipFuncAttributeMaxDynamicSharedMemorySize, LDS_BYTES) != hipSuccess) { fprintf(stderr, "kernel_launch: hipFuncSetAttribute failed\n"); grid = -1; return; }
        if (hipOccupancyMaxActiveBlocksPerMultiprocessor(&per_cu, (const void*)hybrid_fwd, NTHREADS, LDS_BYTES) != hipSuccess || per_cu < 1) fprintf(stderr, "kernel_launch: note: occupancy query reports %d workgroups per CU\n", per_cu);
        (void)hipGetLastError();
        grid = cus;
    }
    if (grid < 0) return;
    if (hipMemsetAsync((char*)d_ws + WS_CTL, 0, CTL_ZERO_BYTES, stream) != hipSuccess) { fprintf(stderr, "kernel_launch: hipMemsetAsync failed\n"); return; }
    Args a{};
    for (int i = 0; i < 21; ++i) a.in[i] = (const float*)d_in[i];
    a.out = (float*)d_out; a.ws = (unsigned char*)d_ws;
    if (MK_N_LAUNCHES == 1) { a.ph_lo = 0; a.ph_hi = N_PHASES; hipLaunchKernelGGL(hybrid_fwd, dim3(grid), dim3(NTHREADS), LDS_BYTES, stream, a); }
    else for (int p = 0; p < N_PHASES; ++p) { a.ph_lo = p; a.ph_hi = p + 1; hipLaunchKernelGGL(hybrid_fwd, dim3(grid), dim3(NTHREADS), LDS_BYTES, stream, a); }
    const hipError_t le = hipPeekAtLastError();
    if (le != hipSuccess) fprintf(stderr, "kernel_launch: launch failed: %s\n", hipGetErrorName(le));
}
```
